# Optimizing an MI355X kernel written in HIP

```python
import math
import jax, jax.numpy as jnp
from jax import lax
import numpy as np

D_MODEL = 1024
BATCH = 8
SEQ = 8192
DEPTH = 2

MEM_LEN = 256
RMS_EPS = 1e-6
POOL_GROUPS = 4
POOL_GROUP_W = D_MODEL // 16
POOL_W = POOL_GROUPS * POOL_GROUP_W
POOL_WINDOWS = (2, 4, 8, 16)
MOBA_HEADS = 4
MOBA_HD = D_MODEL // 16
MOBA_W = MOBA_HEADS * MOBA_HD
MOBA_BLOCK = 256
MOBA_TOPK = 3
MOBA_Q_CHUNK = 16
ROPE_THETA = 500000.0
ROPE_DIMS = MOBA_HD // 4
DN_HEADS = 8
DN_HD = D_MODEL // 16
DN_W = DN_HEADS * DN_HD
DN_CONV = 4
DN_CHUNK = 64
N_BRANCH = 3
OFF_POOL = 0
OFF_MOBA = OFF_POOL + POOL_W
OFF_DN_QKV = OFF_MOBA + 3 * MOBA_W
OFF_DN_BETA = OFF_DN_QKV + 3 * DN_W
OFF_DN_ALPHA = OFF_DN_BETA + DN_HEADS
OFF_DN_Z = OFF_DN_ALPHA + DN_HEADS
OFF_GATE = OFF_DN_Z + DN_W
IN_COLS = OFF_GATE + N_BRANCH * D_MODEL
XA_HEADS = 4
XA_HD = D_MODEL // 8
XA_W = XA_HEADS * XA_HD
DENSE_FF = 2816
N_EXPERTS = 8
MOE_TOPK = 2
EXPERT_FF = DENSE_FF // 2
N_DENSE = (DEPTH + 1) // 2
N_MOE = DEPTH // 2

kernel_name = "hybrid_pool_moba_gdn_moe_block"


def rmsnorm(x, g):
    x32 = x.astype(jnp.float32)
    y = x32 * lax.rsqrt(jnp.mean(x32 * x32, axis=-1, keepdims=True) + RMS_EPS)
    return (y * g.astype(jnp.float32)).astype(x.dtype)


def l2norm(x):
    x32 = x.astype(jnp.float32)
    return x32 * lax.rsqrt(jnp.sum(x32 * x32, axis=-1, keepdims=True) + RMS_EPS)


def partial_rope(x, positions):
    half = ROPE_DIMS // 2
    inv_freq = jnp.power(ROPE_THETA, -jnp.arange(half, dtype=jnp.float32) * 2.0 / ROPE_DIMS)
    ang = positions.astype(jnp.float32)[:, :, None] * inv_freq
    cos = jnp.cos(ang)[:, :, None, :].astype(x.dtype)
    sin = jnp.sin(ang)[:, :, None, :].astype(x.dtype)
    x1 = x[..., :half]
    x2 = x[..., half:ROPE_DIMS]
    return jnp.concatenate([x1 * cos - x2 * sin, x2 * cos + x1 * sin, x[..., ROPE_DIMS:]], axis=-1)


def pool_mixer(p, pool_w, pool_scale):
    B, S, _ = p.shape
    pg = p.reshape(B, S, POOL_GROUPS, POOL_GROUP_W).astype(jnp.float32)
    cs = jnp.cumsum(pg, axis=1)
    t1 = jnp.arange(1, S + 1, dtype=jnp.float32)
    outs = []
    for gi, w in enumerate(POOL_WINDOWS):
        c = cs[:, :, gi]
        lagged = jnp.pad(c, ((0, 0), (w, 0), (0, 0)))[:, :S]
        count = jnp.minimum(t1, float(w))[None, :, None]
        outs.append((c - lagged) / count - pg[:, :, gi])
    pooled = jnp.stack(outs, axis=2).astype(p.dtype)
    mixed = jnp.einsum('bsgc,gcd->bsgd', pooled, pool_w)
    return mixed.reshape(B, S, POOL_W) * pool_scale


def moba_attention(q, k, v):
    B, S, H, hd = q.shape
    nb = -(-S // MOBA_BLOCK)
    s_pad = nb * MOBA_BLOCK
    topk = min(MOBA_TOPK, nb)
    pad = ((0, 0), (0, 0), (0, s_pad - S), (0, 0))
    qh = jnp.pad(q.transpose(0, 2, 1, 3), pad)
    kb = jnp.pad(k.transpose(0, 2, 1, 3), pad).reshape(B, H, nb, MOBA_BLOCK, hd)
    vb = jnp.pad(v.transpose(0, 2, 1, 3), pad).reshape(B, H, nb, MOBA_BLOCK, hd)
    kbar = jnp.mean(kb.astype(jnp.float32), axis=3)
    scale = hd ** -0.5
    bi = jnp.arange(B)[:, None, None, None]
    hi = jnp.arange(H)[None, :, None, None]
    blk_ids = jnp.arange(nb)

    def chunk(ci):
        start = ci * MOBA_Q_CHUNK
        c = start // MOBA_BLOCK
        qc = lax.dynamic_slice_in_dim(qh, start, MOBA_Q_CHUNK, axis=2)
        gate = jnp.einsum('bhqd,bhnd->bhqn', qc.astype(jnp.float32), kbar)
        gate = jnp.where(blk_ids < c, gate, -jnp.inf)
        _, idx = lax.top_k(gate, topk)
        valid = idx < c
        kg = kb[bi, hi, idx]
        vg = vb[bi, hi, idx]
        s_sel = jnp.einsum('bhqd,bhqknd->bhqkn', qc, kg).astype(jnp.float32) * scale
        s_sel = jnp.where(valid[..., None], s_sel, -jnp.inf)
        s_sel = s_sel.reshape(B, H, MOBA_Q_CHUNK, topk * MOBA_BLOCK)
        k_own = lax.dynamic_index_in_dim(kb, c, axis=2, keepdims=False)
        v_own = lax.dynamic_index_in_dim(vb, c, axis=2, keepdims=False)
        s_own = jnp.einsum('bhqd,bhnd->bhqn', qc, k_own).astype(jnp.float32) * scale
        qpos = start + jnp.arange(MOBA_Q_CHUNK)
        kpos = c * MOBA_BLOCK + jnp.arange(MOBA_BLOCK)
        s_own = jnp.where(kpos[None, :] <= qpos[:, None], s_own, -jnp.inf)
        p = jax.nn.softmax(jnp.concatenate([s_sel, s_own], axis=-1), axis=-1).astype(q.dtype)
        p_sel = p[..., :topk * MOBA_BLOCK].reshape(B, H, MOBA_Q_CHUNK, topk, MOBA_BLOCK)
        p_own = p[..., topk * MOBA_BLOCK:]
        return (jnp.einsum('bhqkn,bhqknd->bhqd', p_sel, vg)
                + jnp.einsum('bhqn,bhnd->bhqd', p_own, v_own))

    out = lax.map(chunk, jnp.arange(s_pad // MOBA_Q_CHUNK))
    out = out.transpose(1, 0, 3, 2, 4).reshape(B, s_pad, H, hd)[:, :S]
    return out.reshape(B, S, H * hd)


def short_conv(x, w):
    S = x.shape[1]
    K = w.shape[0]
    xp = jnp.pad(x, ((0, 0), (K - 1, 0), (0, 0)))
    y = w[0] * xp[:, :S]
    for j in range(1, K):
        y = y + w[j] * xp[:, j:j + S]
    return y


def gated_delta_rule(q, k, v, g, beta):
    B, H, S, dk = q.shape
    dv = v.shape[-1]
    C = DN_CHUNK
    nc = S // C

    def chunks(t):
        return t.reshape(t.shape[:2] + (nc, C) + t.shape[3:])

    q, k, v, g, beta = chunks(q), chunks(k), chunks(v), chunks(g), chunks(beta)
    G = jnp.cumsum(g, axis=-1)
    tril = jnp.tril(jnp.ones((C, C), dtype=bool))
    strict = jnp.tril(jnp.ones((C, C), dtype=bool), -1)
    decay = jnp.exp(jnp.where(tril, G[..., :, None] - G[..., None, :], -jnp.inf))
    kbeta = k * beta[..., None]
    a = jnp.where(strict, jnp.einsum('bhnid,bhnjd->bhnij', kbeta, k) * decay, 0.0)
    lhs = a + jnp.eye(C, dtype=jnp.float32)
    rhs = jnp.concatenate([v * beta[..., None], kbeta * jnp.exp(G)[..., None]], axis=-1)
    sol = lax.linalg.triangular_solve(lhs, rhs, left_side=True, lower=True, unit_diagonal=True)
    u = sol[..., :dv]
    w = sol[..., dv:]
    aqk = jnp.einsum('bhnid,bhnjd->bhnij', q, k) * decay
    q_dec = q * jnp.exp(G)[..., None]
    g_last = G[..., -1]
    k_dec = k * jnp.exp(g_last[..., None] - G)[..., None]

    def step(state, xs):
        u_c, w_c, qd_c, aqk_c, kd_c, gl_c = xs
        v_new = u_c - jnp.einsum('bhcd,bhde->bhce', w_c, state)
        o_c = (jnp.einsum('bhcd,bhde->bhce', qd_c, state)
               + jnp.einsum('bhij,bhje->bhie', aqk_c, v_new))
        state = state * jnp.exp(gl_c)[..., None, None] + jnp.einsum('bhcd,bhce->bhde', kd_c, v_new)
        return state, o_c

    xs = (jnp.moveaxis(u, 2, 0), jnp.moveaxis(w, 2, 0), jnp.moveaxis(q_dec, 2, 0),
          jnp.moveaxis(aqk, 2, 0), jnp.moveaxis(k_dec, 2, 0), jnp.moveaxis(g_last, 2, 0))
    _, o = lax.scan(step, jnp.zeros((B, H, dk, dv), jnp.float32), xs)
    return jnp.moveaxis(o, 0, 2).reshape(B, H, S, dv)


def deltanet_mixer(qkv, b_raw, a_raw, z, conv_w, a_log, dt_bias, norm_g):
    B, S, _ = qkv.shape
    qkv = jax.nn.silu(short_conv(qkv, conv_w))
    qkv = qkv.reshape(B, S, 3, DN_HEADS, DN_HD).transpose(2, 0, 3, 1, 4)
    q = l2norm(qkv[0]) * (DN_HD ** -0.5)
    k = l2norm(qkv[1])
    v = qkv[2].astype(jnp.float32)
    beta = jax.nn.sigmoid(b_raw.astype(jnp.float32)).transpose(0, 2, 1)
    g = -jnp.exp(a_log.astype(jnp.float32)) * jax.nn.softplus(
        a_raw.astype(jnp.float32) + dt_bias.astype(jnp.float32))
    g = g.transpose(0, 2, 1)
    o = gated_delta_rule(q, k, v, g, beta).transpose(0, 2, 1, 3)
    o = o * lax.rsqrt(jnp.mean(o * o, axis=-1, keepdims=True) + RMS_EPS) * norm_g.astype(jnp.float32)
    o = o * jax.nn.silu(z.astype(jnp.float32).reshape(B, S, DN_HEADS, DN_HD))
    return o.reshape(B, S, DN_W).astype(z.dtype)


def memory_cross_attention(h, mem_n, wq, wkv, wo):
    B, S, _ = h.shape
    M = mem_n.shape[1]
    q = (h @ wq).reshape(B, S, XA_HEADS, XA_HD)
    kv = (mem_n @ wkv).reshape(B, M, 2, XA_HEADS, XA_HD)
    s = jnp.einsum('bshd,bmhd->bhsm', q, kv[:, :, 0]).astype(jnp.float32) * (XA_HD ** -0.5)
    p = jax.nn.softmax(s, axis=-1).astype(h.dtype)
    o = jnp.einsum('bhsm,bmhd->bshd', p, kv[:, :, 1]).reshape(B, S, XA_W)
    return o @ wo


def swiglu(h, w_gate_up, w_down):
    gate, up = jnp.split(h @ w_gate_up, 2, axis=-1)
    return (jax.nn.silu(gate) * up) @ w_down


def moe_ffn(h, router, w_gate_up, w_down):
    B, S, D = h.shape
    hf = h.reshape(B * S, D)
    logits = (hf @ router).astype(jnp.float32)
    top_logit, top_idx = lax.top_k(logits, MOE_TOPK)
    top_w = jax.nn.softmax(top_logit, axis=-1)
    combine = jnp.sum(jax.nn.one_hot(top_idx, N_EXPERTS, dtype=jnp.float32) * top_w[..., None], axis=1)
    combine = combine.astype(h.dtype)
    y = jnp.zeros_like(hf)
    for e in range(N_EXPERTS):
        y = y + combine[:, e:e + 1] * swiglu(hf, w_gate_up[e], w_down[e])
    return y.reshape(B, S, D)


def setup_inputs(seed: int = 0) -> dict:
    f32 = jnp.float32
    ks = iter(jax.random.split(jax.random.key(seed), 40))

    def nrm(shape, scale):
        return jax.random.normal(next(ks), shape, f32) * scale

    def gain(shape):
        return 1.0 + nrm(shape, 0.02)

    x = nrm((BATCH, SEQ, D_MODEL), 1.0)
    mem = nrm((BATCH, MEM_LEN, D_MODEL), 1.0)
    positions = jnp.broadcast_to(jnp.arange(SEQ, dtype=jnp.int32)[None, :], (BATCH, SEQ))
    mix_norm_g = gain((DEPTH, D_MODEL))
    w_in = nrm((DEPTH, D_MODEL, IN_COLS), D_MODEL ** -0.5)
    pool_w = nrm((DEPTH, POOL_GROUPS, POOL_GROUP_W, POOL_GROUP_W), POOL_GROUP_W ** -0.5)
    pool_scale = 1.0 + nrm((DEPTH, POOL_W), 0.1)
    dn_conv_w = nrm((DEPTH, DN_CONV, 3 * DN_W), DN_CONV ** -0.5)
    dn_a_log = jnp.log(jax.random.uniform(next(ks), (DEPTH, DN_HEADS), f32, 1.0, 16.0))
    dt = jnp.exp(jax.random.uniform(next(ks), (DEPTH, DN_HEADS), f32, math.log(1e-3), math.log(1e-1)))
    dn_dt_bias = dt + jnp.log(-jnp.expm1(-dt))
    dn_norm_g = gain((DEPTH, DN_HD))
    w_up_pool = nrm((DEPTH, POOL_W, D_MODEL), POOL_W ** -0.5)
    w_up_moba = nrm((DEPTH, MOBA_W, D_MODEL), MOBA_W ** -0.5)
    w_up_dn = nrm((DEPTH, DN_W, D_MODEL), DN_W ** -0.5)
    w_out = nrm((DEPTH, D_MODEL, D_MODEL), D_MODEL ** -0.5)
    xa_norm_g = gain((DEPTH, D_MODEL))
    mem_norm_g = gain((DEPTH, D_MODEL))
    xa_wq = nrm((DEPTH, D_MODEL, XA_W), D_MODEL ** -0.5)
    xa_wkv = nrm((DEPTH, D_MODEL, 2 * XA_W), D_MODEL ** -0.5)
    xa_wo = nrm((DEPTH, XA_W, D_MODEL), XA_W ** -0.5)
    ffn_norm_g = gain((DEPTH, D_MODEL))
    dense_w_gate_up = nrm((N_DENSE, D_MODEL, 2 * DENSE_FF), D_MODEL ** -0.5)
    dense_w_down = nrm((N_DENSE, DENSE_FF, D_MODEL), DENSE_FF ** -0.5)
    moe_router = nrm((N_MOE, D_MODEL, N_EXPERTS), D_MODEL ** -0.5)
    moe_w_gate_up = nrm((N_MOE, N_EXPERTS, D_MODEL, 2 * EXPERT_FF), D_MODEL ** -0.5)
    moe_w_down = nrm((N_MOE, N_EXPERTS, EXPERT_FF, D_MODEL), EXPERT_FF ** -0.5)
    final_norm_g = gain((D_MODEL,))
    return {"x": x, "mem": mem, "positions": positions, "mix_norm_g": mix_norm_g, "w_in": w_in,
            "pool_w": pool_w, "pool_scale": pool_scale, "dn_conv_w": dn_conv_w, "dn_a_log": dn_a_log,
            "dn_dt_bias": dn_dt_bias, "dn_norm_g": dn_norm_g, "w_up_pool": w_up_pool,
            "w_up_moba": w_up_moba, "w_up_dn": w_up_dn, "w_out": w_out, "xa_norm_g": xa_norm_g,
            "mem_norm_g": mem_norm_g, "xa_wq": xa_wq, "xa_wkv": xa_wkv, "xa_wo": xa_wo,
            "ffn_norm_g": ffn_norm_g, "dense_w_gate_up": dense_w_gate_up, "dense_w_down": dense_w_down,
            "moe_router": moe_router, "moe_w_gate_up": moe_w_gate_up, "moe_w_down": moe_w_down,
            "final_norm_g": final_norm_g}


def reference(x, mem, positions, mix_norm_g, w_in, pool_w, pool_scale, dn_conv_w, dn_a_log,
              dn_dt_bias, dn_norm_g, w_up_pool, w_up_moba, w_up_dn, w_out, xa_norm_g, mem_norm_g,
              xa_wq, xa_wkv, xa_wo, ffn_norm_g, dense_w_gate_up, dense_w_down, moe_router,
              moe_w_gate_up, moe_w_down, final_norm_g):
    B, S, D = x.shape
    for layer in range(DEPTH):
        h = rmsnorm(x, mix_norm_g[layer])
        proj = h @ w_in[layer]
        p_in = proj[..., OFF_POOL:OFF_MOBA]
        mqkv = proj[..., OFF_MOBA:OFF_DN_QKV].reshape(B, S, 3, MOBA_HEADS, MOBA_HD)
        mq = partial_rope(mqkv[:, :, 0], positions)
        mk = partial_rope(mqkv[:, :, 1], positions)
        mv = mqkv[:, :, 2]
        dn_qkv = proj[..., OFF_DN_QKV:OFF_DN_BETA]
        dn_b = proj[..., OFF_DN_BETA:OFF_DN_ALPHA]
        dn_a = proj[..., OFF_DN_ALPHA:OFF_DN_Z]
        dn_z = proj[..., OFF_DN_Z:OFF_GATE]
        gates = jax.nn.sigmoid(proj[..., OFF_GATE:].astype(jnp.float32)).astype(x.dtype)
        gates = gates.reshape(B, S, N_BRANCH, D)

        y_pool = pool_mixer(p_in, pool_w[layer], pool_scale[layer]) @ w_up_pool[layer]
        y_moba = moba_attention(mq, mk, mv) @ w_up_moba[layer]
        y_dn = deltanet_mixer(dn_qkv, dn_b, dn_a, dn_z, dn_conv_w[layer], dn_a_log[layer],
                              dn_dt_bias[layer], dn_norm_g[layer]) @ w_up_dn[layer]
        merged = gates[:, :, 0] * y_pool + gates[:, :, 1] * y_moba + gates[:, :, 2] * y_dn
        x = x + merged @ w_out[layer]

        x = x + memory_cross_attention(rmsnorm(x, xa_norm_g[layer]), rmsnorm(mem, mem_norm_g[layer]),
                                       xa_wq[layer], xa_wkv[layer], xa_wo[layer])

        h = rmsnorm(x, ffn_norm_g[layer])
        if layer % 2 == 0:
            x = x + swiglu(h, dense_w_gate_up[layer // 2], dense_w_down[layer // 2])
        else:
            x = x + moe_ffn(h, moe_router[layer // 2], moe_w_gate_up[layer // 2], moe_w_down[layer // 2])
    return rmsnorm(x, final_norm_g)
```

```cpp
#include <hip/hip_runtime.h>
#include <cstdio>
#include <cstdint>

#define LAS __attribute__((address_space(3)))
#define DI __device__ __forceinline__
typedef unsigned short bf16_t;
typedef short bf16x8 __attribute__((ext_vector_type(8)));
typedef short s16x4 __attribute__((ext_vector_type(4)));
typedef float f32x4 __attribute__((ext_vector_type(4)));
typedef float f32x2 __attribute__((ext_vector_type(2)));
typedef unsigned u32x4 __attribute__((ext_vector_type(4)));
typedef unsigned u32x2 __attribute__((ext_vector_type(2)));

#ifndef MK_SINGLE
#define MK_SINGLE 1
#endif

constexpr int NTOK = 65536, DM = 1024, SEQ = 8192, NBATCH = 8;
constexpr int NGRP = 2, NG = NTOK / NGRP, GB = NBATCH / NGRP;
constexpr int PLD = 3072;
constexpr int PC_POOL = 0, PC_MQ = 256, PC_MK = 512, PC_MV = 768, PC_DQ = 1024, PC_DK = 1536, PC_DV = 2048, PC_Z = 2560;
constexpr int IN_COLS = 6160;
constexpr int FF = 2816, EFF = 1408, NEXP = 8;
constexpr int MEMLEN = 256;
constexpr float RMS_EPS = 1e-6f;
constexpr int NPH = 1 + 2 * (NGRP * 6 + 4) + 2 + 5;

constexpr size_t MiB = 1u << 20;
constexpr size_t WS_CTL = 0, CTL_BYTES = 1 * MiB;
constexpr size_t LW_WIN = 0, LW_WCAT = LW_WIN + (size_t)6144 * 1024 * 2, LW_WOUT = LW_WCAT + (size_t)1024 * 1024 * 2, LW_WQ = LW_WOUT + (size_t)1024 * 1024 * 2,
                 LW_WKV = LW_WQ + (size_t)512 * 1024 * 2, LW_WO = LW_WKV + (size_t)1024 * 1024 * 2, LW_WBA = LW_WO + (size_t)1024 * 512 * 2, LW_STRIDE = LW_WBA + (size_t)16 * 1024 * 2;
constexpr size_t WS_LW = WS_CTL + CTL_BYTES;
constexpr size_t WS_WGU = WS_LW + 2 * LW_STRIDE;
constexpr size_t WS_WD = WS_WGU + (size_t)2 * FF * 1024 * 2;
constexpr size_t WS_WMGU = WS_WD + (size_t)1024 * FF * 2;
constexpr size_t WS_WMD = WS_WMGU + (size_t)NEXP * 2 * EFF * 1024 * 2;
constexpr size_t WS_WR = WS_WMD + (size_t)NEXP * 1024 * EFF * 2;
constexpr size_t WS_XB = (WS_WR + 8 * 1024 * 4 + MiB - 1) / MiB * MiB;
constexpr size_t WS_SSQ = WS_XB + (size_t)NTOK * 1024 * 2;
constexpr size_t WS_ROPE = WS_SSQ + (size_t)NTOK * 16 * 4;
constexpr size_t WS_MEMN = WS_ROPE + (size_t)NTOK * 16 * 4;
constexpr size_t WS_KVM = WS_MEMN + (size_t)2 * 2048 * 1024 * 2;
constexpr size_t WS_SMALL = WS_KVM + (size_t)2 * 2048 * 1024 * 2;
constexpr int SM_CONVW = 0, SM_ALOG = SM_CONVW + 2 * 4 * 1536, SM_DTB = SM_ALOG + 16, SM_DNG = SM_DTB + 16, SM_FING = SM_DNG + 128, SM_END = SM_FING + 1024;
constexpr size_t WS_ARENA = WS_SMALL + 65536;
constexpr size_t AR_P = 0;
constexpr size_t AR_BA = AR_P + (size_t)NG * PLD * 2;
constexpr size_t AR_BR = AR_BA + (size_t)NG * 16 * 4;
constexpr size_t AR_KBAR = AR_BR + (size_t)NG * 1024 * 2;
constexpr size_t AR_VT = AR_KBAR + (size_t)GB * 4 * 32 * 64 * 4;
constexpr int NCH = GB * 128 * 8;
constexpr size_t AR_QD = AR_VT + (size_t)GB * 4 * 64 * SEQ * 2;
constexpr size_t AR_KDT = AR_QD + (size_t)NCH * 8192;
constexpr size_t AR_WN = AR_KDT + (size_t)NCH * 8192;
constexpr size_t AR_UT = AR_WN + (size_t)NCH * 8192;
constexpr size_t AR_AQK = AR_UT + (size_t)NCH * 8192;
constexpr size_t AR_NT = AR_AQK + (size_t)NCH * 8192;
constexpr size_t AR_SG = AR_NT + (size_t)NCH * 8192;
constexpr size_t AR_ZB = AR_SG + (size_t)NCH * 8192;
constexpr size_t AR_GL = AR_ZB + (size_t)NG * 512 * 2;
constexpr size_t AR_SELG = AR_GL + (size_t)NCH * 4 + 65536 - ((size_t)NCH * 4) % 65536;
constexpr size_t AR_CNTG = AR_SELG + (size_t)NG * 4 * 4;
constexpr size_t AR_LISTG = AR_CNTG + (size_t)GB * 4 * 32 * 32 * 4;
constexpr size_t AR_OPG = AR_LISTG + (size_t)GB * 4 * 32 * 32 * 256;
constexpr size_t AR_MLG = AR_OPG + (size_t)NG * 4 * 4 * 64 * 2;
constexpr size_t AR_MERGED = AR_MLG + (size_t)NG * 4 * 4 * 2 * 4;
constexpr size_t AR_MIX_END = AR_MERGED + (size_t)NTOK * 1024 * 2;
constexpr size_t AR_QX = 0, AR_AO = AR_QX + (size_t)NTOK * 512 * 2, AR_XA_END = AR_AO + (size_t)NTOK * 512 * 2;
constexpr size_t AR_HID = 0, AR_HID_END = (size_t)NTOK * FF * 2;
constexpr int MOE_ROWS = 2 * NTOK + 2048;
constexpr size_t AR_TE = 0, AR_TW = AR_TE + (size_t)NTOK * 8, AR_RR = AR_TW + (size_t)NTOK * 8, AR_POS = AR_RR + (size_t)NTOK * 4, AR_CNT = AR_POS + (size_t)NTOK * 8,
                 AR_XP = AR_CNT + 65536, AR_RP = AR_XP + (size_t)MOE_ROWS * 1024 * 2, AR_HM = AR_RP + (size_t)MOE_ROWS * 4 + 65536 - ((size_t)MOE_ROWS * 4) % 65536,
                 AR_MOE_END = AR_HM + (size_t)MOE_ROWS * EFF * 2;
constexpr size_t cmax(size_t a, size_t b) { return a > b ? a : b; }
constexpr size_t WS_END = WS_ARENA + cmax(cmax(AR_MIX_END, AR_XA_END), cmax(AR_HID_END, AR_MOE_END));
static_assert(AR_XA_END <= AR_MERGED, "xattn buffers must not overlap MERGED");
static_assert(SM_END * 4 <= 65536, "small-vector block");
static_assert(WS_END <= (size_t)1073741824, "workspace map exceeds 1 GiB");

constexpr int LDS_BYTES = 160 * 1024;
constexpr int LDS_MISC = 158 * 1024;

DI float bf2f(unsigned short b) { return __uint_as_float(((unsigned)b) << 16); }
DI unsigned f2bf(float f) { unsigned u = __float_as_uint(f); return (u + 0x7fffu + ((u >> 16) & 1u)) >> 16; }
DI unsigned pk2(float lo, float hi) { return f2bf(lo) | (f2bf(hi) << 16); }
typedef __bf16 bf16v2_t __attribute__((ext_vector_type(2)));
DI unsigned cvt_pk_bf16(float lo, float hi) { bf16v2_t v; v.x = (__bf16)lo; v.y = (__bf16)hi; return __builtin_bit_cast(unsigned, v); }
DI float wave_sum(float v) {
#pragma unroll
    for (int o = 1; o < 64; o <<= 1) v += __shfl_xor(v, o);
    return v;
}
DI float fsigmoid(float x) { return __builtin_amdgcn_rcpf(1.0f + __builtin_amdgcn_exp2f(-1.44269504089f * x)); }
DI float row_rstd(const float* ssqp, int row) {
    const f32x4* p = (const f32x4*)(ssqp + (size_t)row * 16);
    const f32x4 a = p[0], b = p[1], c = p[2], d = p[3];
    const float s = (((a.x + a.y) + (a.z + a.w)) + ((b.x + b.y) + (b.z + b.w))) + (((c.x + c.y) + (c.z + c.w)) + ((d.x + d.y) + (d.z + d.w)));
    return rsqrtf(s * (1.0f / 1024.0f) + RMS_EPS);
}
#define LAUNDER_V(x) asm volatile("" : "+v"(x))
#define LDS_WAIT() asm volatile("s_waitcnt lgkmcnt(0)" ::: "memory")
#define VM_WAIT() asm volatile("s_waitcnt vmcnt(0)" ::: "memory")
#define WG_BAR() do { asm volatile("s_waitcnt lgkmcnt(0)" ::: "memory"); __builtin_amdgcn_s_barrier(); asm volatile("" ::: "memory"); } while (0)
#define MFMA16(a, b, c) __builtin_amdgcn_mfma_f32_16x16x32_bf16((a), (b), (c), 0, 0, 0)

#define XB_TMO      128
#define XB_XCNT(j)  (256  + 64 * (j))
#define XB_XSUB(j)  (1280 + 64 * (j))
#define XB_XGEN(j)  (2304 + 64 * (j))
#define XB_TOP      3328
#define XB_TOPGEN   3392
#define XCD_BAR_WORDS 3456
#define XB_SPIN_CAP (1u << 22)

DI unsigned xb_ld(unsigned* p)              { return __hip_atomic_load(p, __ATOMIC_RELAXED, __HIP_MEMORY_SCOPE_AGENT); }
DI unsigned xb_add(unsigned* p, unsigned v) { return __hip_atomic_fetch_add(p, v, __ATOMIC_RELAXED, __HIP_MEMORY_SCOPE_AGENT); }
DI unsigned xb_xcc_id() { return (unsigned)__builtin_amdgcn_s_getreg((3 << 11) | 20) & 0xFu; }
#define XB_SPIN(cond, bar) do { unsigned _sp = 0; while (cond) { __builtin_amdgcn_s_sleep(1); \
    if ((++_sp & 255u) == 0u) { if (xb_ld(&(bar)[XB_TMO])) break; if (_sp > XB_SPIN_CAP) { atomicAdd(&(bar)[XB_TMO], 1u); break; } } } } while (0)

struct XcdBarrier { unsigned* bar; unsigned x; volatile LAS unsigned* st; };

DI XcdBarrier xcd_barrier_post(unsigned* bar, volatile LAS unsigned* st) {
    XcdBarrier b; b.bar = bar; b.x = xb_xcc_id(); b.st = st;
    if (threadIdx.x == 0) (void)xb_add(&bar[XB_XCNT(b.x)], 1u);
    return b;
}
DI void xcd_barrier_complete(unsigned* bar, unsigned x, unsigned& nloc, unsigned& nx) {
    const unsigned G = gridDim.x * gridDim.y * gridDim.z;
    unsigned sum, cnt, mine, sp = 0u;
    for (;;) {
        sum = 0u; cnt = 0u; mine = 0u;
#pragma unroll
        for (unsigned j = 0; j < 16; ++j) { const unsigned c = xb_ld(&bar[XB_XCNT(j)]); sum += c; cnt += (c > 0u) ? 1u : 0u; mine = (j == x) ? c : mine; }
        if (sum == G) break;
        __builtin_amdgcn_s_sleep(1);
        if ((++sp & 255u) == 0u) { if (xb_ld(&bar[XB_TMO])) break; if (sp > XB_SPIN_CAP) { atomicAdd(&bar[XB_TMO], 1u); break; } }
    }
    nloc = mine > 0u ? mine : 1u; nx = cnt > 0u ? cnt : 1u;
}
DI void xcd_barrier(const XcdBarrier& b) {
    asm volatile("s_waitcnt vmcnt(0)" ::: "memory");
    __syncthreads();
    if (threadIdx.x == 0) {
        unsigned* bar = b.bar;
        __builtin_amdgcn_s_waitcnt(0);
        unsigned nloc = b.st[0], nx = b.st[1];
        if (nloc == 0u) { xcd_barrier_complete(bar, b.x, nloc, nx); b.st[0] = nloc; b.st[1] = nx; }
        const unsigned old = xb_add(&bar[XB_XSUB(b.x)], 1u);
        const unsigned gen = old / nloc;
        if (old + 1u == (gen + 1u) * nloc) {
            __builtin_amdgcn_fence(__ATOMIC_RELEASE, "agent");
            asm volatile("s_waitcnt vmcnt(0)" ::: "memory");
            const unsigned og = xb_add(&bar[XB_TOP], 1u);
            const unsigned tg = og / nx;
            if (og + 1u == (tg + 1u) * nx) xb_add(&bar[XB_TOPGEN], 1u);
            else XB_SPIN(xb_ld(&bar[XB_TOPGEN]) == tg, bar);
            __builtin_amdgcn_fence(__ATOMIC_ACQUIRE, "agent");
            xb_add(&bar[XB_XGEN(b.x)], 1u);
            asm volatile("s_waitcnt vmcnt(0)" ::: "memory");
        } else {
            XB_SPIN(xb_ld(&bar[XB_XGEN(b.x)]) == gen, bar);
            __builtin_amdgcn_fence(__ATOMIC_ACQUIRE, "agent");
            asm volatile("s_waitcnt vmcnt(0)" ::: "memory");
        }
    }
    __syncthreads();
}
namespace pg8 {
constexpr int BM = 256, BK = 64, HALF = 128, HTB = HALF * BK * 2, STAGE_BYTES = 8 * HTB, NXCD = 8, WGM = 8;
__host__ __device__ __forceinline__ int lds_byte(int r, int c) { const int st = (r >> 4) * 2 + (c >> 5), rr = r & 15, cc = c & 31, ob = rr * 64 + cc * 2; return st * 1024 + (ob ^ (((ob >> 9) & 1) << 5)); }
__host__ __device__ __forceinline__ void stage_rc(int b, int& R, int& C) { const int st = b / 1024, sb = b % 1024, swz = sb ^ (((sb >> 9) & 1) << 5); R = (st >> 1) * 16 + swz / 64; C = (st & 1) * 32 + (swz % 64) / 2; }
__host__ __device__ __forceinline__ int perm32(int rho) { const int n = rho >> 4, i = rho & 15; return 8 * (i >> 2) + 4 * n + (i & 3); }

struct Unit { int pm, pn, nt, tag, ord; size_t aoff, boff; };
struct Gemm { const bf16_t* A; const bf16_t* Bt; int lda, ldb; };

struct TileOrder {
    int nM, nN, nwg, G, c;
    DI void init(int nM_, int nN_, int G_, int c_) { nM = nM_; nN = nN_; nwg = nM * nN; G = G_; c = c_; }
    DI bool tile(int i, int& pm, int& pn) const {
        const long L = (long)i * G + c; if (L >= nwg) return false;
        int wgid = (int)L; { const int q = nwg / NXCD, r = nwg % NXCD, xcd = wgid % NXCD, off = wgid / NXCD; wgid = (xcd < r ? xcd * (q + 1) : r * (q + 1) + (xcd - r) * q) + off; }
        const int nig = WGM * nN, gid = wgid / nig, fm = gid * WGM, gsz = (nM - fm) < WGM ? (nM - fm) : WGM;
        pm = fm + ((wgid % nig) % gsz); pn = (wgid % nig) / gsz; return true;
    }
};
struct SchedPlain {
    TileOrder T; int nt; size_t astep, bstep;
    DI void init(int M, int N, int K, int lda, int ldb, int G, int c) { T.init(M / BM, N / BM, G, c); nt = K / BK; astep = (size_t)BM * lda * 2; bstep = (size_t)BM * ldb * 2; }
    DI bool next(int i, Unit& u) const { if (!T.tile(i, u.pm, u.pn)) return false; u.nt = nt; u.tag = 0; u.ord = i; u.aoff = (size_t)u.pm * astep; u.boff = (size_t)u.pn * bstep; return true; }
};
struct SchedMerge {
    TileOrder T; size_t astep, bstep;
    DI void init(int M, int N, int lda, int ldb, int G, int c) { T.init(M / BM, N / BM, G, c); astep = (size_t)BM * lda * 2; bstep = (size_t)BM * ldb * 2; }
    DI bool next(int i, Unit& u) const {
        const int ti = i / 3, br = i - 3 * ti; if (!T.tile(ti, u.pm, u.pn)) return false;
        const int kofs = br == 0 ? 0 : (br == 1 ? 256 : 512);
        u.nt = br == 2 ? 8 : 4; u.tag = br; u.aoff = (size_t)u.pm * astep + (size_t)kofs * 2; u.boff = (size_t)u.pn * bstep + (size_t)kofs * 2; return true;
    }
};
struct SchedKV {
    int c; size_t lstride;
    DI bool next(int i, Unit& u) const {
        if (i != 0 || c < 0 || c >= 64) return false;
        const int layer = c >> 5, r = c & 31; u.pm = layer * 8 + (r >> 2); u.pn = r & 3; u.nt = 16; u.tag = 0; u.ord = 0;
        u.aoff = (size_t)u.pm * BM * 1024 * 2; u.boff = (size_t)layer * lstride + (size_t)u.pn * BM * 1024 * 2; return true;
    }
};
struct SchedMoe {
    int pbase[9]; int nN, nt, G, c; size_t astep, bstep, estep;
    DI bool next(int i, Unit& u) const {
        const long L = (long)i * G + c; const int tot = pbase[8] * nN; if (L >= tot) return false;
        const int gp = (int)(L / nN), pn = (int)(L - (long)gp * nN);
        int e = 0;
#pragma unroll
        for (int j = 1; j < 8; ++j) e += (gp >= pbase[j]) ? 1 : 0;
        u.pm = gp; u.pn = pn; u.nt = nt; u.tag = e; u.ord = i; u.aoff = (size_t)gp * astep; u.boff = (size_t)e * estep + (size_t)pn * bstep; return true;
    }
};

constexpr int RTAB_OFF = STAGE_BYTES, RTAB_MAX_UNITS = 26;
template <class Sched> DI void build_rtab(LAS unsigned char* lds, const Sched& S, const float* ssqp, const float* rvec, int tid) {
    LAS float* rt = (LAS float*)(lds + RTAB_OFF); Unit u;
    for (int i = tid >> 8; S.next(i, u); i += 2) { if (i >= RTAB_MAX_UNITS) break; const int r = tid & 255, row = u.pm * BM + r; rt[i * 256 + r] = rvec ? rvec[row] : row_rstd(ssqp, row); }
    __syncthreads();
}
struct EpiScaleBf16 { static constexpr bool MID = false;
    bf16_t* O; int ldo; const float* ssqp; int act; bf16_t* O2; int ldo2, pn2; const LAS float* rtab;
    DI void operator()(const f32x4 (&acc)[2][2][4][2], const Unit& u, int wr, int wc, int fr, int fq) const {
        const bool alt = u.pn >= pn2; bf16_t* const Ob = alt ? O2 : O; const int ld = alt ? ldo2 : ldo;
        const int row0 = u.pm * BM + wr * 64 + fr, col0 = (alt ? u.pn - pn2 : u.pn) * BM + wc * 32 + 8 * fq;
#pragma unroll
        for (int ai = 0; ai < 2; ++ai)
#pragma unroll
            for (int m = 0; m < 4; ++m) { const int row = row0 + ai * HALF + m * 16; const float r = ssqp ? rtab[u.ord * 256 + (row & 255)] : 1.0f; bf16_t* rowp = Ob + (size_t)row * ld + col0;
#pragma unroll
                for (int bj = 0; bj < 2; ++bj) { f32x4 v0 = acc[ai][bj][m][0] * r, v1 = acc[ai][bj][m][1] * r;
                    if (act) {
#pragma unroll
                        for (int j = 0; j < 4; ++j) { v0[j] = fsigmoid(v0[j]); v1[j] = fsigmoid(v1[j]); } }
                    u32x4 w; w.x = cvt_pk_bf16(v0[0], v0[1]); w.y = cvt_pk_bf16(v0[2], v0[3]); w.z = cvt_pk_bf16(v1[0], v1[1]); w.w = cvt_pk_bf16(v1[2], v1[3]);
                    *(u32x4*)(rowp + bj * HALF) = w; } }
    }
};
struct EpiResid { static constexpr bool MID = false;
    bf16_t* xb; float* ssqp;
    DI void operator()(const f32x4 (&acc)[2][2][4][2], const Unit& u, int wr, int wc, int fr, int fq) const {
        const int row0 = u.pm * BM + wr * 64 + fr, col0 = u.pn * BM + wc * 32 + 8 * fq;
#pragma unroll
        for (int ai = 0; ai < 2; ++ai)
#pragma unroll
            for (int m = 0; m < 4; ++m) { const int row = row0 + ai * HALF + m * 16; const size_t off = (size_t)row * 1024 + col0; float ss = 0.f;
#pragma unroll
                for (int bj = 0; bj < 2; ++bj) {
                    const u32x4 xo = *(const u32x4*)(xb + off + bj * HALF);
                    f32x4 x0 = (f32x4){__uint_as_float(xo.x << 16), __uint_as_float(xo.x & 0xffff0000u), __uint_as_float(xo.y << 16), __uint_as_float(xo.y & 0xffff0000u)};
                    f32x4 x1 = (f32x4){__uint_as_float(xo.z << 16), __uint_as_float(xo.z & 0xffff0000u), __uint_as_float(xo.w << 16), __uint_as_float(xo.w & 0xffff0000u)};
                    x0 += acc[ai][bj][m][0]; x1 += acc[ai][bj][m][1];
                    u32x4 w; w.x = cvt_pk_bf16(x0[0], x0[1]); w.y = cvt_pk_bf16(x0[2], x0[3]); w.z = cvt_pk_bf16(x1[0], x1[1]); w.w = cvt_pk_bf16(x1[2], x1[3]);
                    *(u32x4*)(xb + off + bj * HALF) = w;
                    ss += (x0[0] * x0[0] + x0[1] * x0[1]) + (x0[2] * x0[2] + x0[3] * x0[3]) + (x1[0] * x1[0] + x1[1] * x1[1]) + (x1[2] * x1[2] + x1[3] * x1[3]); }
                ss += __shfl_xor(ss, 16); ss += __shfl_xor(ss, 32);
                if (fq == 0) ssqp[(size_t)row * 16 + u.pn * 4 + wc] = ss; }
    }
};
struct EpiSwiglu { static constexpr bool MID = false;
    bf16_t* H; int ldh; const LAS float* rtab;
    DI void operator()(const f32x4 (&acc)[2][2][4][2], const Unit& u, int wr, int wc, int fr, int fq) const {
        const int row0 = u.pm * BM + wr * 64 + fr, col0 = u.pn * HALF + wc * 32 + 8 * fq;
#pragma unroll
        for (int ai = 0; ai < 2; ++ai)
#pragma unroll
            for (int m = 0; m < 4; ++m) { const int row = row0 + ai * HALF + m * 16; const float r = rtab[u.ord * 256 + (row & 255)];
                f32x4 h0, h1;
#pragma unroll
                for (int j = 0; j < 4; ++j) { const float g0 = acc[ai][0][m][0][j] * r, g1 = acc[ai][0][m][1][j] * r;
                    h0[j] = g0 * fsigmoid(g0) * (acc[ai][1][m][0][j] * r); h1[j] = g1 * fsigmoid(g1) * (acc[ai][1][m][1][j] * r); }
                u32x4 w; w.x = cvt_pk_bf16(h0[0], h0[1]); w.y = cvt_pk_bf16(h0[2], h0[3]); w.z = cvt_pk_bf16(h1[0], h1[1]); w.w = cvt_pk_bf16(h1[2], h1[3]);
                *(u32x4*)(H + (size_t)row * ldh + col0) = w; }
    }
};
struct EpiMerge { static constexpr bool MID = true;
    const bf16_t* gates; bf16_t* merged;
    static DI float gclamp(unsigned hi_bits) { return fmaxf(__uint_as_float(hi_bits), 1e-30f); }
    DI void mid(f32x4 (&acc)[2][2][4][2], const Unit& u, int seg, int wr, int wc, int fr, int fq) const {
        int row0 = u.pm * BM + wr * 64 + fr, col0 = u.pn * BM + wc * 32 + 8 * fq; LAUNDER_V(row0); LAUNDER_V(col0);
#pragma unroll
        for (int ai = 0; ai < 2; ++ai)
#pragma unroll
            for (int mp = 0; mp < 2; ++mp) {
                u32x4 ga[2][2], gb[2][2];
#pragma unroll
                for (int mm = 0; mm < 2; ++mm)
#pragma unroll
                    for (int bj = 0; bj < 2; ++bj) { const bf16_t* gp = gates + (size_t)(row0 + ai * HALF + (2 * mp + mm) * 16) * PLD + seg * 1024 + col0 + bj * HALF; ga[mm][bj] = *(const u32x4*)gp; gb[mm][bj] = *(const u32x4*)(gp + 1024); }
#pragma unroll
                for (int mm = 0; mm < 2; ++mm)
#pragma unroll
                    for (int bj = 0; bj < 2; ++bj)
#pragma unroll
                        for (int j = 0; j < 4; ++j) { const int m = 2 * mp + mm;
                            const float r_lo = gclamp(ga[mm][bj][j] << 16) * __builtin_amdgcn_rcpf(gclamp(gb[mm][bj][j] << 16)), r_hi = gclamp(ga[mm][bj][j] & 0xffff0000u) * __builtin_amdgcn_rcpf(gclamp(gb[mm][bj][j] & 0xffff0000u));
                            acc[ai][bj][m][j >> 1][(2 * j) & 3] *= r_lo; acc[ai][bj][m][j >> 1][(2 * j + 1) & 3] *= r_hi; }
                __builtin_amdgcn_sched_barrier(0);
            }
    }
    DI void operator()(const f32x4 (&acc)[2][2][4][2], const Unit& u, int wr, int wc, int fr, int fq) const {
        const int row0 = u.pm * BM + wr * 64 + fr, col0 = u.pn * BM + wc * 32 + 8 * fq;
#pragma unroll
        for (int ai = 0; ai < 2; ++ai)
#pragma unroll
            for (int m = 0; m < 4; ++m) { const int row = row0 + ai * HALF + m * 16;
#pragma unroll
                for (int bj = 0; bj < 2; ++bj) {
                    const u32x4 gv = *(const u32x4*)(gates + (size_t)row * PLD + 2 * 1024 + col0 + bj * HALF);
                    float v[8];
#pragma unroll
                    for (int j = 0; j < 4; ++j) { v[2 * j] = gclamp(gv[j] << 16); v[2 * j + 1] = gclamp(gv[j] & 0xffff0000u); }
#pragma unroll
                    for (int j = 0; j < 4; ++j) { v[j] *= acc[ai][bj][m][0][j]; v[4 + j] *= acc[ai][bj][m][1][j]; }
                    u32x4 w; w.x = cvt_pk_bf16(v[0], v[1]); w.y = cvt_pk_bf16(v[2], v[3]); w.z = cvt_pk_bf16(v[4], v[5]); w.w = cvt_pk_bf16(v[6], v[7]);
                    *(u32x4*)(merged + (size_t)row * 1024 + col0 + bj * HALF) = w; } }
    }
};

template <class Epi, class Sched>
DI void gemm_phase(LAS unsigned char* lds, const Gemm g, const Sched& S, const Epi& E, int wave_id) {
    int tid_ = (int)__builtin_amdgcn_mbcnt_hi(~0u, __builtin_amdgcn_mbcnt_lo(~0u, 0u)) + 64 * wave_id; asm volatile("" : "+v"(tid_));
    const int tid = tid_, wid = __builtin_amdgcn_readfirstlane(tid >> 6), lane = tid & 63, wr = wid >> 2, wc = wid & 3, fr = lane & 15, fq = lane >> 4;
    unsigned voffA[2], voffB[2];
#pragma unroll
    for (int i = 0; i < 2; ++i) { int R, C; stage_rc(tid * 16 + i * 8192, R, C); const int Rb = (R & ~31) + perm32(R & 31);
        voffA[i] = (unsigned)(R * g.lda + C) * 2u; voffB[i] = (unsigned)(Rb * g.ldb + C) * 2u; }
    const size_t kstep = (size_t)(BK * 2);
    const size_t hstepA = (size_t)HALF * g.lda * 2, hstepB = (size_t)HALF * g.ldb * 2;
    const unsigned ldsw = (unsigned)wid * 1024u;
    const int aoff = lds_byte(wr * 64 + fr, fq * 8), boff = lds_byte(wc * 32 + fr, fq * 8);
#define PG8_SA(b, h) (((b) * 2 + (h)) * HTB)
#define PG8_SB(b, h) ((4 + (b) * 2 + (h)) * HTB)
#define PG8_STAGE(bufoff, gbase, voff) do { _Pragma("unroll") for (int _i = 0; _i < 2; ++_i) \
        __builtin_amdgcn_global_load_lds((const unsigned*)((const char*)(gbase) + (voff)[_i]), (LAS unsigned*)(lds + (bufoff) + ldsw + _i * 8192), 16, 0, 0); } while (0)
#define PG8_LDA(dst, b, h) do { _Pragma("unroll") for (int m = 0; m < 4; ++m) _Pragma("unroll") for (int k = 0; k < 2; ++k) dst[m][k] = *(const LAS bf16x8*)(lds + PG8_SA(b, h) + aoff + m * 2048 + k * 1024); } while (0)
#define PG8_LDB(dst, b, h) do { _Pragma("unroll") for (int n = 0; n < 2; ++n) _Pragma("unroll") for (int k = 0; k < 2; ++k) dst[n][k] = *(const LAS bf16x8*)(lds + PG8_SB(b, h) + boff + n * 2048 + k * 1024); } while (0)
#define PG8_MMA(ai, bj, At, Bt) do { __builtin_amdgcn_s_setprio(1); _Pragma("unroll") for (int m = 0; m < 4; ++m) _Pragma("unroll") for (int n = 0; n < 2; ++n) _Pragma("unroll") for (int k = 0; k < 2; ++k) \
        acc[ai][bj][m][n] = __builtin_amdgcn_mfma_f32_16x16x32_bf16(Bt[n][k], At[m][k], acc[ai][bj][m][n], 0, 0, 0); __builtin_amdgcn_s_setprio(0); } while (0)
#define PG8_WAIT_V(n) asm volatile("s_waitcnt vmcnt(" #n ")" ::: "memory")
#define PG8_WAIT_L(n) asm volatile("s_waitcnt lgkmcnt(" #n ")" ::: "memory")
#define PG8_BAR __builtin_amdgcn_s_barrier()
#define PG8_SCHED __builtin_amdgcn_sched_barrier(0)
    Unit cur, nxt; int ui = 0;
    if (!S.next(0, cur)) return;
    f32x4 acc[2][2][4][2];
#pragma unroll
    for (int a = 0; a < 2; ++a)
#pragma unroll
        for (int b = 0; b < 2; ++b)
#pragma unroll
            for (int m = 0; m < 4; ++m)
#pragma unroll
                for (int n = 0; n < 2; ++n) acc[a][b][m][n] = (f32x4){0.f, 0.f, 0.f, 0.f};
    bf16x8 At[4][2], B0[2][2], B1[2][2];
    const char* cA = (const char*)g.A + cur.aoff; const char* cB = (const char*)g.Bt + cur.boff;
    PG8_STAGE(PG8_SB(0, 0), cB, voffB); PG8_STAGE(PG8_SB(0, 1), cB + hstepB, voffB); PG8_STAGE(PG8_SA(0, 0), cA, voffA); PG8_STAGE(PG8_SA(0, 1), cA + hstepA, voffA);
    if (wr == 1) PG8_BAR;
    PG8_WAIT_V(2); PG8_BAR;
    PG8_STAGE(PG8_SB(1, 0), cB + kstep, voffB); PG8_STAGE(PG8_SA(1, 0), cA + kstep, voffA); PG8_STAGE(PG8_SB(1, 1), cB + hstepB + kstep, voffB);
    PG8_WAIT_V(6); PG8_BAR;
    for (;;) {
        const bool has_next = S.next(ui + 1, nxt);
        const int nt = cur.nt;
        const char* nA = has_next ? (const char*)g.A + nxt.aoff : cA; const char* nB = has_next ? (const char*)g.Bt + nxt.boff : cB;
        for (int t = 0; t < nt; t += 2) {
            if constexpr (Epi::MID) { if (t == 4 || t == 8) { E.mid(acc, cur, t >> 3, wr, wc, fr, fq); } __builtin_amdgcn_sched_barrier(0); }
            const bool last = (t == nt - 2);
            const char* a1 = cA + (size_t)(t + 1) * kstep;
            const char* a2 = last ? nA : cA + (size_t)(t + 2) * kstep; const char* b2 = last ? nB : cB + (size_t)(t + 2) * kstep;
            const char* a3 = a2 + kstep; const char* b3 = b2 + kstep;
            PG8_LDB(B0, 0, 0); PG8_LDB(B1, 0, 1); PG8_SCHED; PG8_LDA(At, 0, 0); PG8_STAGE(PG8_SA(1, 1), a1 + hstepA, voffA);
            PG8_WAIT_V(8); PG8_WAIT_L(0); PG8_BAR; PG8_MMA(0, 0, At, B0); PG8_MMA(0, 1, At, B1); PG8_BAR; PG8_SCHED;
            PG8_LDA(At, 0, 1); PG8_STAGE(PG8_SB(0, 0), b2, voffB); PG8_STAGE(PG8_SB(0, 1), b2 + hstepB, voffB); PG8_STAGE(PG8_SA(0, 0), a2, voffA);
            PG8_WAIT_V(8); PG8_WAIT_L(0); PG8_BAR; PG8_MMA(1, 0, At, B0); PG8_MMA(1, 1, At, B1); PG8_BAR; PG8_SCHED;
            PG8_LDB(B0, 1, 0); PG8_LDB(B1, 1, 1); PG8_SCHED; PG8_LDA(At, 1, 0); PG8_STAGE(PG8_SA(0, 1), a2 + hstepA, voffA);
            PG8_WAIT_V(8); PG8_WAIT_L(0); PG8_BAR; PG8_MMA(0, 0, At, B0); PG8_MMA(0, 1, At, B1); PG8_BAR; PG8_SCHED;
            PG8_LDA(At, 1, 1); PG8_STAGE(PG8_SB(1, 0), b3, voffB); PG8_STAGE(PG8_SB(1, 1), b3 + hstepB, voffB); PG8_STAGE(PG8_SA(1, 0), a3, voffA);
            PG8_WAIT_V(8); PG8_WAIT_L(0); PG8_BAR; PG8_MMA(1, 0, At, B0); PG8_MMA(1, 1, At, B1); PG8_BAR; PG8_SCHED;
        }
        if (wr == 0) PG8_BAR;
        E(acc, cur, wr, wc, fr, fq);
        if (!has_next) break;
#pragma unroll
        for (int a = 0; a < 2; ++a)
#pragma unroll
            for (int b = 0; b < 2; ++b)
#pragma unroll
                for (int m = 0; m < 4; ++m)
#pragma unroll
                    for (int n = 0; n < 2; ++n) acc[a][b][m][n] = (f32x4){0.f, 0.f, 0.f, 0.f};
        cur = nxt; cA = nA; cB = nB; ++ui;
        if (wr == 1) PG8_BAR;
    }
    PG8_WAIT_V(0);
    PG8_BAR;
#undef PG8_SA
#undef PG8_SB
#undef PG8_STAGE
#undef PG8_LDA
#undef PG8_LDB
#undef PG8_MMA
#undef PG8_WAIT_V
#undef PG8_WAIT_L
#undef PG8_BAR
#undef PG8_SCHED
}
}
struct Params { const float* in[27]; float* out; unsigned char* ws; int ph_lo, ph_hi, pad0, pad1; };
enum { I_X = 0, I_MEM, I_POS, I_MIXG, I_WIN, I_POOLW, I_POOLS, I_CONVW, I_ALOG, I_DTB, I_DNG, I_WUPP, I_WUPM, I_WUPD, I_WOUT, I_XAG, I_MEMG, I_XAQ, I_XAKV, I_XAO,
       I_FFNG, I_DGU, I_DD, I_ROUTER, I_MGU, I_MD, I_FING };

struct Frame {
    LAS unsigned char* lds;
    int tid, lane, wave, G, blk;
    unsigned char* ws;
};

struct Job { const float* W; int K, N; bf16_t* WT; int ldt; int mode; int ff; const float* kscale; };
DI int job_map(int mode, int ff, int n) {
    if (mode == 0) return n;
    if (mode == 1) return n < 2560 ? n : (n < 2576 ? -1 : n - 16);
    if (n < ff) return (n >> 7) * 256 + (n & 127);
    const int m = n - ff; return (m >> 7) * 256 + 128 + (m & 127);
}
DI int job_items(const Job& J) { return (J.K / 64) * ((J.N + 31) / 32); }
DI void transpose_item(const Job& J, LAS float* scr, int item, int lane) {
    const int nblk = (J.N + 31) / 32, kb = item / nblk, nb = item - kb * nblk, k0 = 64 * kb, n0 = 32 * nb;
    const int nn = lane & 31; const bool ok = (n0 + nn) < J.N;
    float tv[32];
#pragma unroll
    for (int i = 0; i < 32; ++i) { const int kk = 2 * i + (lane >> 5); tv[i] = J.W[(size_t)(k0 + kk) * J.N + (ok ? n0 + nn : 0)]; }
#pragma unroll
    for (int i = 0; i < 32; ++i) { const int kk = 2 * i + (lane >> 5); float v = ok ? tv[i] : 0.f; if (J.kscale) v *= J.kscale[k0 + kk]; scr[kk * 33 + nn] = v; }
    LDS_WAIT();
    const int c = lane & 7;
#pragma unroll
    for (int j = 0; j < 4; ++j) { const int n = (lane >> 3) + 8 * j; const int sn = n0 + n; const int drow = sn < J.N ? job_map(J.mode, J.ff, sn) : -1;
        if (drow >= 0) { const LAS float* s = scr + (8 * c) * 33 + n;
            u32x4 o; o.x = pk2(s[0 * 33], s[1 * 33]); o.y = pk2(s[2 * 33], s[3 * 33]); o.z = pk2(s[4 * 33], s[5 * 33]); o.w = pk2(s[6 * 33], s[7 * 33]);
            *(u32x4*)(J.WT + (size_t)drow * J.ldt + k0 + 8 * c) = o; } }
    LDS_WAIT();
}
constexpr int NJOBS = 2 * 7 + 2 + 16;
DI void get_job(const Frame& F, const Params& P, int j, Job& J) {
    unsigned char* ws = F.ws;
    J.mode = 0; J.ff = 0; J.kscale = nullptr;
    if (j < 14) { const int l = j / 7, t = j - 7 * l; unsigned char* lw = ws + WS_LW + (size_t)l * LW_STRIDE;
        if (t == 0) { J.W = P.in[I_WIN] + (size_t)l * 1024 * IN_COLS; J.K = 1024; J.N = IN_COLS; J.WT = (bf16_t*)(lw + LW_WIN); J.ldt = 1024; J.mode = 1; J.kscale = P.in[I_MIXG] + l * 1024; }
        else if (t == 1) { J.W = P.in[I_WUPM] + (size_t)l * 256 * 1024; J.K = 256; J.N = 1024; J.WT = (bf16_t*)(lw + LW_WCAT) + 256; J.ldt = 1024; }
        else if (t == 2) { J.W = P.in[I_WUPD] + (size_t)l * 512 * 1024; J.K = 512; J.N = 1024; J.WT = (bf16_t*)(lw + LW_WCAT) + 512; J.ldt = 1024; }
        else if (t == 3) { J.W = P.in[I_WOUT] + (size_t)l * 1024 * 1024; J.K = 1024; J.N = 1024; J.WT = (bf16_t*)(lw + LW_WOUT); J.ldt = 1024; }
        else if (t == 4) { J.W = P.in[I_XAQ] + (size_t)l * 1024 * 512; J.K = 1024; J.N = 512; J.WT = (bf16_t*)(lw + LW_WQ); J.ldt = 1024; J.kscale = P.in[I_XAG] + l * 1024; }
        else if (t == 5) { J.W = P.in[I_XAKV] + (size_t)l * 1024 * 1024; J.K = 1024; J.N = 1024; J.WT = (bf16_t*)(lw + LW_WKV); J.ldt = 1024; }
        else { J.W = P.in[I_XAO] + (size_t)l * 512 * 1024; J.K = 512; J.N = 1024; J.WT = (bf16_t*)(lw + LW_WO); J.ldt = 512; }
    } else if (j == 14) { J.W = P.in[I_DGU]; J.K = 1024; J.N = 2 * FF; J.WT = (bf16_t*)(ws + WS_WGU); J.ldt = 1024; J.mode = 2; J.ff = FF; J.kscale = P.in[I_FFNG]; }
    else if (j == 15) { J.W = P.in[I_DD]; J.K = FF; J.N = 1024; J.WT = (bf16_t*)(ws + WS_WD); J.ldt = FF; }
    else { const int e = (j - 16) >> 1;
        if (((j - 16) & 1) == 0) { J.W = P.in[I_MGU] + (size_t)e * 1024 * 2 * EFF; J.K = 1024; J.N = 2 * EFF; J.WT = (bf16_t*)(ws + WS_WMGU) + (size_t)e * 2 * EFF * 1024; J.ldt = 1024; J.mode = 2; J.ff = EFF; J.kscale = P.in[I_FFNG] + 1024; }
        else { J.W = P.in[I_MD] + (size_t)e * EFF * 1024; J.K = EFF; J.N = 1024; J.WT = (bf16_t*)(ws + WS_WMD) + (size_t)e * 1024 * EFF; J.ldt = EFF; } }
}

DI void phase_prologue(const Frame& F, const Params& P) {
    unsigned char* ws = F.ws;
    const int gw = F.blk * 8 + F.wave, NGW = F.G * 8, lane = F.lane;
    const long gt = (long)F.blk * 512 + F.tid, NGT = (long)F.G * 512;
    { const float* x = P.in[I_X]; bf16_t* xb = (bf16_t*)(ws + WS_XB); float* ssq = (float*)(ws + WS_SSQ);
      for (int row0 = gw; row0 < NTOK; row0 += 4 * NGW) {
          f32x4 v[4][4];
#pragma unroll
          for (int q = 0; q < 4; ++q) { const int row = row0 + q * NGW; const f32x4* xr = (const f32x4*)(x + (size_t)(row < NTOK ? row : row0) * 1024) + lane;
#pragma unroll
              for (int j = 0; j < 4; ++j) v[q][j] = xr[64 * j]; }
#pragma unroll
          for (int q = 0; q < 4; ++q) { const int row = row0 + q * NGW; if (row < NTOK) { float s = 0.f;
#pragma unroll
              for (int j = 0; j < 4; ++j) s += (v[q][j].x * v[q][j].x + v[q][j].y * v[q][j].y) + (v[q][j].z * v[q][j].z + v[q][j].w * v[q][j].w);
              s = wave_sum(s);
              u32x2* o = (u32x2*)(xb + (size_t)row * 1024) + lane;
#pragma unroll
              for (int j = 0; j < 4; ++j) { u32x2 w; w.x = pk2(v[q][j].x, v[q][j].y); w.y = pk2(v[q][j].z, v[q][j].w); o[64 * j] = w; }
              if (lane < 16) ssq[(size_t)row * 16 + lane] = lane == 0 ? s : 0.f; } }
      } }
    { const float* mem = P.in[I_MEM]; bf16_t* mn = (bf16_t*)(ws + WS_MEMN);
      for (int row = gw; row < 2048; row += NGW) {
          const f32x4* xr = (const f32x4*)(mem + (size_t)row * 1024) + lane; f32x4 v[4]; float s = 0.f;
#pragma unroll
          for (int j = 0; j < 4; ++j) { v[j] = xr[64 * j]; s += (v[j].x * v[j].x + v[j].y * v[j].y) + (v[j].z * v[j].z + v[j].w * v[j].w); }
          s = wave_sum(s); const float r = rsqrtf(s * (1.0f / 1024.0f) + RMS_EPS);
#pragma unroll
          for (int l = 0; l < 2; ++l) { const f32x4* gr = (const f32x4*)(P.in[I_MEMG] + l * 1024) + lane; u32x2* o = (u32x2*)(mn + ((size_t)l * 2048 + row) * 1024) + lane;
#pragma unroll
              for (int j = 0; j < 4; ++j) { const f32x4 gg = gr[64 * j]; u32x2 w; w.x = pk2(v[j].x * r * gg.x, v[j].y * r * gg.y); w.y = pk2(v[j].z * r * gg.z, v[j].w * r * gg.w); o[64 * j] = w; } }
      } }
    { const int* pos = (const int*)P.in[I_POS]; float* rope = (float*)(ws + WS_ROPE);
      for (long i = gt; i < (long)NTOK * 8; i += NGT) { const int tok = (int)(i >> 3), f = (int)(i & 7);
          const float inv = powf(500000.0f, -(float)f * 2.0f / 16.0f); const float ang = (float)pos[tok] * inv; float sn, cs; sincosf(ang, &sn, &cs);
          rope[(size_t)tok * 16 + f] = cs; rope[(size_t)tok * 16 + 8 + f] = sn; } }
    for (long i = gt; i < 2 * 16 * 1024; i += NGT) { const int l = (int)(i >> 14), j = (int)((i >> 10) & 15), k = (int)(i & 1023);
        const float v = P.in[I_WIN][((size_t)l * 1024 + k) * IN_COLS + 2560 + j] * P.in[I_MIXG][l * 1024 + k];
        ((bf16_t*)(ws + WS_LW + (size_t)l * LW_STRIDE + LW_WBA))[j * 1024 + k] = (bf16_t)f2bf(v); }
    for (long i = gt; i < 8 * 1024; i += NGT) { const int e = (int)(i >> 10), k = (int)(i & 1023); ((float*)(ws + WS_WR))[e * 1024 + k] = P.in[I_ROUTER][k * 8 + e] * P.in[I_FFNG][1024 + k]; }
    for (long i = gt; i < 2L * 256 * 1024; i += NGT) { const int l = (int)(i >> 18), k = (int)((i >> 10) & 255), n = (int)(i & 1023), gi = k >> 6, c = k & 63;
        const float* pw = P.in[I_POOLW] + (((size_t)l * 4 + gi) * 64 + c) * 64; const float* ps = P.in[I_POOLS] + l * 256 + gi * 64; const float* wu = P.in[I_WUPP] + ((size_t)l * 256 + gi * 64) * 1024 + n;
        float s = 0.f;
#pragma unroll 16
        for (int d = 0; d < 64; ++d) s += pw[d] * ps[d] * wu[(size_t)d * 1024];
        ((bf16_t*)(ws + WS_LW + (size_t)l * LW_STRIDE + LW_WCAT))[(size_t)n * 1024 + k] = (bf16_t)f2bf(s); }
    { float* sm = (float*)(ws + WS_SMALL);
      for (long i = gt; i < 2 * 4 * 1536; i += NGT) sm[SM_CONVW + i] = P.in[I_CONVW][i];
      for (long i = gt; i < 16; i += NGT) { sm[SM_ALOG + i] = P.in[I_ALOG][i]; sm[SM_DTB + i] = P.in[I_DTB][i]; }
      for (long i = gt; i < 128; i += NGT) sm[SM_DNG + i] = P.in[I_DNG][i];
      for (long i = gt; i < 1024; i += NGT) sm[SM_FING + i] = P.in[I_FING][i]; }
    { LAS float* scr = (LAS float*)(F.lds + F.wave * 8704);
      int base = 0;
      for (int j = 0; j < NJOBS; ++j) { Job J; get_job(F, P, j, J); const int ni = job_items(J);
          int first = gw - (base % NGW); if (first < 0) first += NGW;
          for (int it = first; it < ni; it += NGW) transpose_item(J, scr, it, lane);
          base += ni; } }
}
DI void ba_tiles(const Frame& F, const bf16_t* xbg, const bf16_t* Wba, const float* ssqg, float* BA) {
    const int lane = F.lane, gw = F.blk * 8 + F.wave, NGW = F.G * 8;
    for (int tile = gw; tile < NG / 16; tile += NGW) {
        const int row0 = tile * 16; f32x4 acc = (f32x4){0.f, 0.f, 0.f, 0.f};
        const bf16_t* ap = xbg + (size_t)(row0 + (lane & 15)) * 1024 + (lane >> 4) * 8; const bf16_t* bp = Wba + (size_t)(lane & 15) * 1024 + (lane >> 4) * 8;
#pragma unroll 8
        for (int ks = 0; ks < 32; ++ks) { const bf16x8 a = *(const bf16x8*)(ap + 32 * ks); const bf16x8 b = *(const bf16x8*)(bp + 32 * ks); acc = MFMA16(a, b, acc); }
#pragma unroll
        for (int i = 0; i < 4; ++i) { const int row = row0 + 4 * (lane >> 4) + i; BA[(size_t)row * 16 + (lane & 15)] = acc[i] * row_rstd(ssqg, row); }
    }
}

template <int W> DI void prep_pool_w(const bf16_t* Pb, bf16_t* BR, int ch, int lr0, int s0) {
    const bf16_t* p = Pb + PC_POOL + ch; float v[32 + W - 1];
#pragma unroll
    for (int i = 0; i < 32 + W - 1; ++i) { const int d = i - (W - 1); const bool ok = s0 + d >= 0; const unsigned short raw = p[(size_t)(ok ? lr0 + d : lr0) * PLD]; v[i] = ok ? bf2f(raw) : 0.f; }
    float sum = 0.f;
#pragma unroll
    for (int i = 0; i < W - 1; ++i) sum += v[i];
#pragma unroll
    for (int t = 0; t < 32; ++t) { const float x = v[t + W - 1]; sum += x; const int s = s0 + t;
        const float o = (s + 1 >= W ? sum * (1.0f / (float)W) : sum / (float)(s + 1)) - x;
        BR[(size_t)(lr0 + t) * 1024 + ch] = (bf16_t)f2bf(o);
        sum -= v[t]; }
}
DI void prep_pool(const Frame& F, const bf16_t* Pb, bf16_t* BR, int unit) {
    int tid_ = F.tid; LAUNDER_V(tid_);
    const int ch = tid_ & 255, half = tid_ >> 8, lr0 = unit * 64 + half * 32, s0 = lr0 & (SEQ - 1), g = F.wave & 3;
    if (g == 0) prep_pool_w<2>(Pb, BR, ch, lr0, s0); else if (g == 1) prep_pool_w<4>(Pb, BR, ch, lr0, s0); else if (g == 2) prep_pool_w<8>(Pb, BR, ch, lr0, s0); else prep_pool_w<16>(Pb, BR, ch, lr0, s0);
}

DI void prep_moba(const Frame& F, bf16_t* Pb, const float* rope, float* KBAR, bf16_t* VT, int unit) {
    int tid_ = F.tid; LAUNDER_V(tid_);
    const int tid = tid_, bl = unit >> 5, j = unit & 31, lr0 = bl * SEQ + j * 256;
    { const int c = tid & 255, rh = tid >> 8, h = c >> 6, d = c & 63; float sum = 0.f;
        LAS float* KS = (LAS float*)F.lds;
        if (d < 16) { const int dp = d < 8 ? d + 8 : d - 8, f = d & 7;
#pragma unroll 8
            for (int r = 128 * rh; r < 128 * rh + 128; ++r) { const size_t lr = (size_t)(lr0 + r); const float v = bf2f(Pb[lr * PLD + PC_MK + c]), vp = bf2f(Pb[lr * PLD + PC_MK + h * 64 + dp]);
                const float cs = rope[lr * 16 + f], sn = rope[lr * 16 + 8 + f]; sum += d < 8 ? v * cs - vp * sn : v * cs + vp * sn; } }
        else {
#pragma unroll 16
            for (int r = 128 * rh; r < 128 * rh + 128; ++r) sum += bf2f(Pb[(size_t)(lr0 + r) * PLD + PC_MK + c]); }
        if (rh == 1) KS[c] = sum;
        __syncthreads();
        if (rh == 0) KBAR[((size_t)(bl * 4 + h) * 32 + j) * 64 + d] = (sum + KS[c]) * (1.0f / 256.0f); }
    __syncthreads();
    { const int r = tid & 255, hp = tid >> 8; const size_t lr = (size_t)(lr0 + r);
      const f32x4 c0 = *(const f32x4*)(rope + lr * 16), c1 = *(const f32x4*)(rope + lr * 16 + 4), s0 = *(const f32x4*)(rope + lr * 16 + 8), s1 = *(const f32x4*)(rope + lr * 16 + 12);
      const float cs[8] = {c0.x, c0.y, c0.z, c0.w, c1.x, c1.y, c1.z, c1.w}, sn[8] = {s0.x, s0.y, s0.z, s0.w, s1.x, s1.y, s1.z, s1.w};
#pragma unroll
      for (int hh = 0; hh < 2; ++hh)
#pragma unroll
          for (int which = 0; which < 2; ++which) { bf16_t* base = Pb + lr * PLD + (which ? PC_MK : PC_MQ) + (2 * hp + hh) * 64;
              const u32x4 a = *(const u32x4*)base, b = *(const u32x4*)(base + 8); float x1[8], x2[8];
#pragma unroll
              for (int q = 0; q < 4; ++q) { x1[2 * q] = __uint_as_float(a[q] << 16); x1[2 * q + 1] = __uint_as_float(a[q] & 0xffff0000u); x2[2 * q] = __uint_as_float(b[q] << 16); x2[2 * q + 1] = __uint_as_float(b[q] & 0xffff0000u); }
              u32x4 oa, ob;
#pragma unroll
              for (int q = 0; q < 4; ++q) { oa[q] = pk2(x1[2 * q] * cs[2 * q] - x2[2 * q] * sn[2 * q], x1[2 * q + 1] * cs[2 * q + 1] - x2[2 * q + 1] * sn[2 * q + 1]);
                                            ob[q] = pk2(x2[2 * q] * cs[2 * q] + x1[2 * q] * sn[2 * q], x2[2 * q + 1] * cs[2 * q + 1] + x1[2 * q + 1] * sn[2 * q + 1]); }
              *(u32x4*)base = oa; *(u32x4*)(base + 8) = ob; } }
    LAS bf16_t* Tt = (LAS bf16_t*)F.lds;
    for (int cc = 0; cc < 4; ++cc) {
        __syncthreads();
#pragma unroll
        for (int i = 0; i < 4; ++i) { const int q = tid + 512 * i, tok = q >> 5, c8 = q & 31; const u32x4 v = *(const u32x4*)(Pb + (size_t)(lr0 + cc * 64 + tok) * PLD + PC_MV + c8 * 8);
#pragma unroll
            for (int e = 0; e < 4; ++e) { Tt[(c8 * 8 + 2 * e) * 72 + tok] = (bf16_t)(v[e] & 0xffffu); Tt[(c8 * 8 + 2 * e + 1) * 72 + tok] = (bf16_t)(v[e] >> 16); } }
        __syncthreads();
#pragma unroll
        for (int i = 0; i < 4; ++i) { const int q = tid + 512 * i, col = q >> 3, t8 = q & 7; const u32x4 v = *(const LAS u32x4*)(Tt + col * 72 + t8 * 8);
            *(u32x4*)(VT + ((size_t)(bl * 256 + col)) * SEQ + j * 256 + cc * 64 + t8 * 8) = v; }
    }
    __syncthreads();
}

constexpr int DN_ROWB = 144;
constexpr int DN_TQ = 0, DN_TK = 9216, DN_TKB = 18432, DN_TVB = 27648, DN_MISC = 36864, DN_PAIR = 38400;
__host__ __device__ constexpr int ap_rowoff(int i) { return i == 0 ? 0 : 4 * (((i - 1) / 4) + 1) * (2 * ((i - 1) / 4) + ((i - 1) % 4)); }

template <int I> DI void subst_load(const LAS float* Ap, const LAS unsigned char* Rt, const LAS float* SCL, int lane, f32x4 (&av)[16], float& Ri) {
    constexpr int off = ap_rowoff(I);
#pragma unroll
    for (int j4 = 0; j4 < I; j4 += 4) av[j4 >> 2] = *(const LAS f32x4*)(Ap + off + j4);
    Ri = bf2f(*(const LAS bf16_t*)(Rt + I * DN_ROWB + lane * 2)) * SCL[I];
}
template <int I> struct Subst2 { static DI void run(float (&x)[64], const LAS float* Ap, const LAS unsigned char* Rt, const LAS float* SCL, int lane, f32x4 (&cur)[16], float Rc, f32x4 (&nxt)[16]) {
    float Rn = 0.f;
    if constexpr (I + 1 < 64) subst_load<I + 1>(Ap, Rt, SCL, lane, nxt, Rn);
    float a0 = Rc, a1 = 0.f, a2 = 0.f, a3 = 0.f;
#pragma unroll
    for (int j4 = 0; j4 < I; j4 += 4) { const f32x4 av = cur[j4 >> 2];
        a0 -= av.x * x[j4];
        if (j4 + 1 < I) a1 -= av.y * x[j4 + 1];
        if (j4 + 2 < I) a2 -= av.z * x[j4 + 2];
        if (j4 + 3 < I) a3 -= av.w * x[j4 + 3]; }
    x[I] = (a0 + a1) + (a2 + a3);
    asm volatile("" : "+v"(x[I])); __builtin_amdgcn_sched_barrier(0);
    if constexpr (I + 1 < 64) Subst2<I + 1>::run(x, Ap, Rt, SCL, lane, nxt, Rn, cur);
} };

DI void conv_w_load(const float* convw, int wcol, float (&w)[4][8]) {
#pragma unroll
    for (int j = 0; j < 4; ++j) { const f32x4 w0 = *(const f32x4*)(convw + j * 1536 + wcol), w1 = *(const f32x4*)(convw + j * 1536 + wcol + 4);
        w[j][0] = w0.x; w[j][1] = w0.y; w[j][2] = w0.z; w[j][3] = w0.w; w[j][4] = w1.x; w[j][5] = w1.y; w[j][6] = w1.z; w[j][7] = w1.w; }
}
DI void conv8(const bf16_t* Pb, const float (&w)[4][8], int lr, int s, int pcol8, float (&a)[8]) {
#pragma unroll
    for (int e = 0; e < 8; ++e) a[e] = 0.f;
    u32x4 xv[4];
#pragma unroll
    for (int j = 0; j < 4; ++j) { const bool valid = (s - 3 + j) >= 0; xv[j] = *(const u32x4*)(Pb + (size_t)(valid ? lr - 3 + j : lr) * PLD + pcol8);
        xv[j].x = valid ? xv[j].x : 0u; xv[j].y = valid ? xv[j].y : 0u; xv[j].z = valid ? xv[j].z : 0u; xv[j].w = valid ? xv[j].w : 0u; }
#pragma unroll
    for (int j = 0; j < 4; ++j) {
        a[0] += w[j][0] * __uint_as_float(xv[j][0] << 16); a[1] += w[j][1] * __uint_as_float(xv[j][0] & 0xffff0000u);
        a[2] += w[j][2] * __uint_as_float(xv[j][1] << 16); a[3] += w[j][3] * __uint_as_float(xv[j][1] & 0xffff0000u);
        a[4] += w[j][4] * __uint_as_float(xv[j][2] << 16); a[5] += w[j][5] * __uint_as_float(xv[j][2] & 0xffff0000u);
        a[6] += w[j][6] * __uint_as_float(xv[j][3] << 16); a[7] += w[j][7] * __uint_as_float(xv[j][3] & 0xffff0000u);
    }
#pragma unroll
    for (int e = 0; e < 8; ++e) a[e] = a[e] * fsigmoid(a[e]);
}
DI float ssq8(const float (&a)[8]) { float ss = 0.f;
#pragma unroll
    for (int e = 0; e < 8; ++e) ss += a[e] * a[e];
    ss += __shfl_xor(ss, 1); ss += __shfl_xor(ss, 2); ss += __shfl_xor(ss, 4); return ss; }
DI u32x4 pack8(const float (&a)[8], float sc) { u32x4 w; w.x = pk2(a[0] * sc, a[1] * sc); w.y = pk2(a[2] * sc, a[3] * sc); w.z = pk2(a[4] * sc, a[5] * sc); w.w = pk2(a[6] * sc, a[7] * sc); return w; }

#ifndef DBG_RA
#define DBG_RA 1
#endif
#ifndef DBG_RB
#define DBG_RB 1
#endif
#ifndef DBG_RC
#define DBG_RC 1
#endif
#ifndef DBG_RD
#define DBG_RD 1
#endif
#ifndef DBG_RB2
#define DBG_RB2 1
#endif
DI void prep_dn(const Frame& F, const bf16_t* Pb, const float* BA, const float* convw, const float* alog, const float* dtb,
                bf16_t* QD, bf16_t* MM, bf16_t* NT, bf16_t* WN, bf16_t* UT, bf16_t* AQK, float* GL, int unit) {
    int lane_ = F.lane; LAUNDER_V(lane_);
    const int lane = lane_, wave = F.wave, pr = wave >> 1, role = wave & 1;
    const int bl = unit >> 8, rem = unit & 255, n = rem >> 1, hq = rem & 1, h = 4 * hq + pr;
    const int lr0 = bl * SEQ + n * 64;
    const int chidx = (bl * 128 + n) * 8 + h;
    LAS unsigned char* L = F.lds + pr * DN_PAIR;
    LAS float* Gs = (LAS float*)(L + DN_MISC); LAS float* EG = Gs + 64; LAS float* EGL = Gs + 128; LAS float* ONES = Gs + 192; LAS float* BETA = Gs + 256 + 64 * role;
    {
        const int lr = lr0 + lane;
        const float braw = BA[(size_t)lr * 16 + h], araw = BA[(size_t)lr * 16 + 8 + h];
        const float beta = fsigmoid(braw);
        const float xa = araw + dtb[h]; const float sp = xa > 20.f ? xa : log1pf(__expf(xa));
        float G = -__expf(alog[h]) * sp;
#pragma unroll
        for (int o = 1; o < 64; o <<= 1) { const float up = __shfl_up(G, o); if (lane >= o) G += up; }
        const float Glast = __shfl(G, 63);
        BETA[lane] = beta;
        if (role == 0) { Gs[lane] = G; EG[lane] = __expf(G); EGL[lane] = __expf(Glast - G); ONES[lane] = 1.0f; if (lane == 0) GL[chidx] = __expf(Glast); }
    }
    LDS_WAIT();
    for (int rpA = 0; rpA < DBG_RA; ++rpA) {
        const int cg = lane & 7, tl = lane >> 3; float w[4][8];
        if (role == 0) {
            conv_w_load(convw, h * 64 + cg * 8, w);
#pragma unroll 4
            for (int ps = 0; ps < 8; ++ps) { const int t = ps * 8 + tl; float a[8]; conv8(Pb, w, lr0 + t, n * 64 + t, PC_DQ + h * 64 + cg * 8, a);
                const float rn = rsqrtf(ssq8(a) + RMS_EPS) * 0.125f;
                *(LAS u32x4*)(L + DN_TQ + t * DN_ROWB + cg * 16) = pack8(a, rn); }
        } else {
            conv_w_load(convw, 512 + h * 64 + cg * 8, w);
#pragma unroll 4
            for (int ps = 0; ps < 8; ++ps) { const int t = ps * 8 + tl; float a[8]; conv8(Pb, w, lr0 + t, n * 64 + t, PC_DK + h * 64 + cg * 8, a);
                const float rn = rsqrtf(ssq8(a) + RMS_EPS);
                *(LAS u32x4*)(L + DN_TK + t * DN_ROWB + cg * 16) = pack8(a, rn); *(LAS u32x4*)(L + DN_TKB + t * DN_ROWB + cg * 16) = pack8(a, rn * BETA[t]); }
        }
        conv_w_load(convw, 1024 + h * 64 + cg * 8, w);
#pragma unroll 4
        for (int ps = 4 * role; ps < 4 * role + 4; ++ps) { const int t = ps * 8 + tl; float a[8]; conv8(Pb, w, lr0 + t, n * 64 + t, PC_DV + h * 64 + cg * 8, a);
            *(LAS u32x4*)(L + DN_TVB + t * DN_ROWB + cg * 16) = pack8(a, BETA[t]); }
    }
    WG_BAR();
    for (int rpB = 0; rpB < DBG_RB; ++rpB) {
        const int fr = lane & 15, fq = lane >> 4;
#pragma unroll
        for (int tt = 0; tt < 8; ++tt) { const int tile = 2 * tt + role, it = tile >> 2, jt = tile & 3;
            f32x4 acc = (f32x4){0.f, 0.f, 0.f, 0.f};
            if (jt <= it) {
#pragma unroll
                for (int ks = 0; ks < 2; ++ks) { const bf16x8 a = *(const LAS bf16x8*)(L + DN_TK + (16 * jt + fr) * DN_ROWB + (fq * 8 + 32 * ks) * 2);
                    const bf16x8 b = *(const LAS bf16x8*)(L + DN_TQ + (16 * it + fr) * DN_ROWB + (fq * 8 + 32 * ks) * 2); acc = MFMA16(a, b, acc); } }
            const int ii = 16 * it + fr; const float Gi = Gs[ii]; float v[4];
#pragma unroll
            for (int r = 0; r < 4; ++r) { const int jj = 16 * jt + 4 * fq + r; v[r] = (jj <= ii) ? acc[r] * __expf(Gi - Gs[jj]) : 0.f; }
            u32x2 w; w.x = pk2(v[0], v[1]); w.y = pk2(v[2], v[3]);
            *(u32x2*)(AQK + (size_t)chidx * 4096 + ii * 64 + 16 * jt + 4 * fq) = w;
        }
#pragma unroll
        for (int i = 0; i < 4; ++i) { const int idx = lane + 64 * role + 128 * i, t = idx >> 3, cg = idx & 7; const u32x4 qv = *(const LAS u32x4*)(L + DN_TQ + t * DN_ROWB + cg * 16); const float eg = EG[t]; u32x4 w;
#pragma unroll
            for (int e = 0; e < 4; ++e) w[e] = pk2(__uint_as_float(qv[e] << 16) * eg, __uint_as_float(qv[e] & 0xffff0000u) * eg);
            *(u32x4*)(QD + (size_t)chidx * 4096 + t * 64 + cg * 8) = w; }
    }
    WG_BAR();
    for (int rpB2 = 0; rpB2 < DBG_RB2; ++rpB2) {
        const int fr = lane & 15, fq = lane >> 4; LAS float* Ap = (LAS float*)(L + DN_TQ);
#pragma unroll
        for (int tt = 0; tt < 5; ++tt) { const int q = 2 * tt + role;
            const int it = q < 1 ? 0 : (q < 3 ? 1 : (q < 6 ? 2 : 3)), jt = q - (it * (it + 1)) / 2;
            f32x4 acc = (f32x4){0.f, 0.f, 0.f, 0.f};
#pragma unroll
            for (int ks = 0; ks < 2; ++ks) { const bf16x8 a = *(const LAS bf16x8*)(L + DN_TKB + (16 * it + fr) * DN_ROWB + (fq * 8 + 32 * ks) * 2);
                const bf16x8 b = *(const LAS bf16x8*)(L + DN_TK + (16 * jt + fr) * DN_ROWB + (fq * 8 + 32 * ks) * 2); acc = MFMA16(a, b, acc); }
            const int jj = 16 * jt + fr; const float Gj = Gs[jj];
#pragma unroll
            for (int r = 0; r < 4; ++r) { const int ii = 16 * it + 4 * fq + r;
                if (jj < ii) { const int m1 = ii - 1, gf = m1 >> 2, rm = m1 & 3; Ap[4 * (gf + 1) * (2 * gf + rm) + jj] = acc[r] * __expf(Gs[ii] - Gj); } }
        }
    }
    u32x4 kdt[4];
#pragma unroll
    for (int i = 0; i < 4; ++i) { const int idx = lane + 64 * role + 128 * i, d = idx >> 3, tc = idx & 7; unsigned short kv[8];
#pragma unroll
        for (int e = 0; e < 8; ++e) kv[e] = *(const LAS bf16_t*)(L + DN_TK + (tc * 8 + e) * DN_ROWB + d * 2);
#pragma unroll
        for (int e = 0; e < 4; ++e) kdt[i][e] = pk2(bf2f(kv[2 * e]) * EGL[tc * 8 + 2 * e], bf2f(kv[2 * e + 1]) * EGL[tc * 8 + 2 * e + 1]); }
    WG_BAR();
#pragma unroll
    for (int i = 0; i < 4; ++i) { const int idx = lane + 64 * role + 128 * i, d = idx >> 3, tc = idx & 7; *(LAS u32x4*)(L + DN_TK + d * DN_ROWB + tc * 16) = kdt[i]; }
    for (int rpC = 0; rpC < DBG_RC; ++rpC) {
        float x[64];
        LAS unsigned char* const RT = L + DN_TVB - role * (DN_TVB - DN_TKB);
        { f32x4 avA[16], avB[16]; float R0; subst_load<0>((const LAS float*)(L + DN_TQ), RT, Gs + 192 - role * 128, lane, avA, R0);
          Subst2<0>::run(x, (const LAS float*)(L + DN_TQ), RT, Gs + 192 - role * 128, lane, avA, R0, avB); }
        { LAS unsigned char* T = RT + lane * DN_ROWB;
#pragma unroll
          for (int cg = 0; cg < 8; ++cg) { u32x4 w; w.x = pk2(x[cg * 8], x[cg * 8 + 1]); w.y = pk2(x[cg * 8 + 2], x[cg * 8 + 3]); w.z = pk2(x[cg * 8 + 4], x[cg * 8 + 5]); w.w = pk2(x[cg * 8 + 6], x[cg * 8 + 7]);
              *(LAS u32x4*)(T + cg * 16) = w; if (role == 0) *((u32x4*)(UT + (size_t)chidx * 4096 + lane * 64) + cg) = w; } }
    }
    WG_BAR();
#pragma unroll
    for (int i = 0; i < 4; ++i) { const int idx = lane + 64 * role + 128 * i, cg = idx >> 6, t = idx & 63; unsigned short wv[8];
#pragma unroll
        for (int e = 0; e < 8; ++e) wv[e] = *(const LAS bf16_t*)(L + DN_TKB + (cg * 8 + e) * DN_ROWB + t * 2);
        u32x4 w;
#pragma unroll
        for (int e = 0; e < 4; ++e) w[e] = ((unsigned)wv[2 * e] | ((unsigned)wv[2 * e + 1] << 16)) ^ 0x80008000u;
        *(u32x4*)(WN + (size_t)chidx * 4096 + t * 64 + cg * 8) = w; }
    for (int rpD = 0; rpD < DBG_RD; ++rpD) {
        const int fr = lane & 15, fq = lane >> 4; const float glast = EG[63];
#pragma unroll
        for (int tt = 0; tt < 8; ++tt) { const int tile = 2 * tt + role, mt = tile >> 2, nt = tile & 3;
            f32x4 acc = (f32x4){0.f, 0.f, 0.f, 0.f};
#pragma unroll
            for (int ks = 0; ks < 2; ++ks) { const bf16x8 a = *(const LAS bf16x8*)(L + DN_TKB + (16 * mt + fr) * DN_ROWB + (fq * 8 + 32 * ks) * 2);
                const bf16x8 b = *(const LAS bf16x8*)(L + DN_TK + (16 * nt + fr) * DN_ROWB + (fq * 8 + 32 * ks) * 2); acc = MFMA16(a, b, acc); }
            { const int dko = 16 * nt + fr, dki0 = 16 * mt + 4 * fq; u32x2 w;
              w.x = pk2((dko == dki0 ? glast : 0.f) - acc[0], (dko == dki0 + 1 ? glast : 0.f) - acc[1]); w.y = pk2((dko == dki0 + 2 ? glast : 0.f) - acc[2], (dko == dki0 + 3 ? glast : 0.f) - acc[3]);
              *(u32x2*)(MM + (size_t)chidx * 4096 + dko * 64 + dki0) = w; }
            acc = (f32x4){0.f, 0.f, 0.f, 0.f};
#pragma unroll
            for (int ks = 0; ks < 2; ++ks) { const bf16x8 a = *(const LAS bf16x8*)(L + DN_TK + (16 * mt + fr) * DN_ROWB + (fq * 8 + 32 * ks) * 2);
                const bf16x8 b = *(const LAS bf16x8*)(L + DN_TVB + (16 * nt + fr) * DN_ROWB + (fq * 8 + 32 * ks) * 2); acc = MFMA16(a, b, acc); }
            { u32x2 w; w.x = pk2(acc[0], acc[1]); w.y = pk2(acc[2], acc[3]); *(u32x2*)(NT + (size_t)chidx * 4096 + (16 * nt + fr) * 64 + 16 * mt + 4 * fq) = w; }
        }
    }
    WG_BAR();
}
constexpr int SC_ROWB = 144;
constexpr int SC_ST = 0, SC_VT = 64 * SC_ROWB, SC_RS = 2 * 64 * SC_ROWB;
DI void dn_scan(const Frame& F, int chain, const bf16_t* MM, const bf16_t* NT, bf16_t* SG, int nb, int ne, bool do_store = true) {
    const int lane = F.lane, wave = F.wave, rt = wave & 3, ch = wave >> 2, fr = lane & 15, fq = lane >> 4;
    const int bl = chain >> 3, h = chain & 7;
    LAS unsigned char* L = F.lds;
    if (nb == 0) for (int i = F.tid; i < 64 * SC_ROWB / 4; i += 512) ((LAS unsigned*)L)[i] = 0u;
    const size_t cstride = (size_t)8 * 4096;
    size_t cb = (size_t)((bl * 128 + nb) * 8 + h) * 4096;
    const int aoffs = (16 * rt + fr) * 64 + fq * 8;
    int coffs[2]; coffs[0] = (32 * ch + fr) * 64 + 16 * rt + 4 * fq; coffs[1] = coffs[0] + 16 * 64;
#pragma unroll
    for (int nt = 0; nt < 2; ++nt) if (nb == 0) *(u32x2*)(SG + cb + coffs[nt]) = (u32x2){0u, 0u};
    bf16x8 a[8][2]; u32x2 nc[8][2];
#pragma unroll
    for (int j = 0; j < 8; ++j) { const size_t cj = cb + (size_t)(nb + j < 127 ? j : 0) * cstride;
#pragma unroll
        for (int ks = 0; ks < 2; ++ks) a[j][ks] = *(const bf16x8*)(MM + cj + aoffs + 32 * ks);
#pragma unroll
        for (int nt = 0; nt < 2; ++nt) nc[j][nt] = *(const u32x2*)(NT + cj + coffs[nt]); }
    __syncthreads();
#pragma unroll 1
    for (int n0 = nb; n0 < ne; n0 += 16) {
#pragma unroll
        for (int jj = 0; jj < 16; ++jj) { const int j = jj & 7; const int n = n0 + jj;
            if (n < ne) {
                const size_t cbn = cb + cstride;
                LAS unsigned char* SR = L + (n & 1) * 64 * SC_ROWB; LAS unsigned char* SW = L + ((n + 1) & 1) * 64 * SC_ROWB;
#pragma unroll
                for (int nt = 0; nt < 2; ++nt) {
                    f32x4 acc = (f32x4){__uint_as_float(nc[j][nt].x << 16), __uint_as_float(nc[j][nt].x & 0xffff0000u), __uint_as_float(nc[j][nt].y << 16), __uint_as_float(nc[j][nt].y & 0xffff0000u)};
#pragma unroll
                    for (int ks = 0; ks < 2; ++ks) { const bf16x8 sb = *(const LAS bf16x8*)(SR + (32 * ch + 16 * nt + fr) * SC_ROWB + (fq * 8 + 32 * ks) * 2); acc = MFMA16(a[j][ks], sb, acc); }
                    u32x2 w; w.x = cvt_pk_bf16(acc[0], acc[1]); w.y = cvt_pk_bf16(acc[2], acc[3]);
                    *(LAS u32x2*)(SW + (32 * ch + 16 * nt + fr) * SC_ROWB + (16 * rt + 4 * fq) * 2) = w;
                    if (do_store) *(u32x2*)(SG + cbn + coffs[nt]) = w;
                }
                if (n + 8 < 127) { const size_t c4 = cb + 8 * cstride;
#pragma unroll
                    for (int ks = 0; ks < 2; ++ks) a[j][ks] = *(const bf16x8*)(MM + c4 + aoffs + 32 * ks);
#pragma unroll
                    for (int nt = 0; nt < 2; ++nt) nc[j][nt] = *(const u32x2*)(NT + c4 + coffs[nt]); }
                WG_BAR();
                cb = cbn;
            }
        }
    }
    __syncthreads();
}

struct OutOps { bf16x8 wn[2], qd[2], aq[2], sb[4][2]; u32x2 uv[4]; unsigned short zv[16]; };
DI void out_load(OutOps& o, int k, int rt, int fr, int fq, const bf16_t* QD, const bf16_t* WN, const bf16_t* UT, const bf16_t* AQK, const bf16_t* SG, const bf16_t* ZB) {
    const size_t cb = (size_t)k * 4096; const int arow = 16 * rt + fr; const int h = k & 7, n = (k >> 3) & 127, bl = k >> 10;
#pragma unroll
    for (int ks = 0; ks < 2; ++ks) { const size_t off = cb + arow * 64 + fq * 8 + 32 * ks;
        o.wn[ks] = *(const bf16x8*)(WN + off); o.qd[ks] = *(const bf16x8*)(QD + off); o.aq[ks] = *(const bf16x8*)(AQK + off); }
#pragma unroll
    for (int nt = 0; nt < 4; ++nt) { o.uv[nt] = *(const u32x2*)(UT + cb + (16 * nt + fr) * 64 + 16 * rt + 4 * fq);
#pragma unroll
        for (int ks = 0; ks < 2; ++ks) o.sb[nt][ks] = *(const bf16x8*)(SG + cb + (16 * nt + fr) * 64 + fq * 8 + 32 * ks); }
    const int lrb = bl * SEQ + n * 64 + 16 * rt + 4 * fq;
#pragma unroll
    for (int r = 0; r < 4; ++r)
#pragma unroll
        for (int nt = 0; nt < 4; ++nt) o.zv[r * 4 + nt] = ZB[(size_t)(lrb + r) * 512 + h * 64 + 16 * nt + fr];
}
DI void dn_out_pass(const Frame& F, const bf16_t* QD, const bf16_t* WN, const bf16_t* UT, const bf16_t* AQK, const bf16_t* SG, const bf16_t* ZB, const float* dng, bf16_t* BR) {
    int lane_ = F.lane; LAUNDER_V(lane_);
    const int lane = lane_, wave = F.wave, rt = wave & 3, half = wave >> 2, fr = lane & 15, fq = lane >> 4;
    LAS unsigned char* L = F.lds;
    float ng[4];
#pragma unroll
    for (int nt = 0; nt < 4; ++nt) ng[nt] = dng[16 * nt + fr];
    int p = F.blk; if (p >= NCH / 2) return;
    OutOps cur, nxt;
    out_load(cur, 2 * p + half, rt, fr, fq, QD, WN, UT, AQK, SG, ZB);
    __syncthreads();
    for (int it = 0; p < NCH / 2; p += F.G, ++it) {
        const int k = 2 * p + half, pn = p + F.G < NCH / 2 ? p + F.G : p;
        out_load(nxt, 2 * pn + half, rt, fr, fq, QD, WN, UT, AQK, SG, ZB);
        const int h = k & 7, n = (k >> 3) & 127, bl = k >> 10;
        LAS unsigned char* VT = L + ((it & 1) * 2 + half) * 64 * SC_ROWB;
        f32x4 vn[4], o[4];
#pragma unroll
        for (int nt = 0; nt < 4; ++nt) { vn[nt] = (f32x4){__uint_as_float(cur.uv[nt].x << 16), __uint_as_float(cur.uv[nt].x & 0xffff0000u), __uint_as_float(cur.uv[nt].y << 16), __uint_as_float(cur.uv[nt].y & 0xffff0000u)};
            o[nt] = (f32x4){0.f, 0.f, 0.f, 0.f};
#pragma unroll
            for (int ks = 0; ks < 2; ++ks) { vn[nt] = MFMA16(cur.wn[ks], cur.sb[nt][ks], vn[nt]); o[nt] = MFMA16(cur.qd[ks], cur.sb[nt][ks], o[nt]); } }
#pragma unroll
        for (int nt = 0; nt < 4; ++nt) { u32x2 w; w.x = cvt_pk_bf16(vn[nt][0], vn[nt][1]); w.y = cvt_pk_bf16(vn[nt][2], vn[nt][3]);
            *(LAS u32x2*)(VT + (16 * nt + fr) * SC_ROWB + (16 * rt + 4 * fq) * 2) = w; }
        WG_BAR();
#pragma unroll
        for (int nt = 0; nt < 4; ++nt)
#pragma unroll
            for (int ks = 0; ks < 2; ++ks) { const bf16x8 vb = *(const LAS bf16x8*)(VT + (16 * nt + fr) * SC_ROWB + (fq * 8 + 32 * ks) * 2); o[nt] = MFMA16(cur.aq[ks], vb, o[nt]); }
        const int lrb = bl * SEQ + n * 64 + 16 * rt + 4 * fq;
#pragma unroll
        for (int r = 0; r < 4; ++r) { float q = (o[0][r] * o[0][r] + o[1][r] * o[1][r]) + (o[2][r] * o[2][r] + o[3][r] * o[3][r]);
            q += __shfl_xor(q, 1); q += __shfl_xor(q, 2); q += __shfl_xor(q, 4); q += __shfl_xor(q, 8);
            const float rs = rsqrtf(q * (1.0f / 64.0f) + RMS_EPS); const size_t lr = (size_t)(lrb + r);
#pragma unroll
            for (int nt = 0; nt < 4; ++nt) { const float z = bf2f(cur.zv[r * 4 + nt]);
                BR[lr * 1024 + 512 + h * 64 + 16 * nt + fr] = (bf16_t)f2bf(o[nt][r] * rs * ng[nt] * (z * fsigmoid(z))); } }
        cur = nxt;
    }
    __syncthreads();
}

constexpr int MG_QS = 0, MG_KB = 36864, MG_SEL = MG_KB + 8192, MG_TOP = MG_SEL + 1024;
DI void moba_gate_unit(const Frame& F, const bf16_t* Pb, const float* KBAR, unsigned* SELG, unsigned char* LISTG, int* CNTG, int bl, int h, int c) {
    int lane_ = F.lane; LAUNDER_V(lane_);
    const int lane = lane_, wave = F.wave, tid = wave * 64 + lane;
    LAS unsigned char* L = F.lds; LAS float* KB = (LAS float*)(L + MG_KB); LAS unsigned* SEL = (LAS unsigned*)(L + MG_SEL);
    const int q0 = bl * SEQ + c * 256, bh = bl * 4 + h;
    __syncthreads();
#pragma unroll
    for (int i = 0; i < 4; ++i) { const int q = tid + 512 * i, r = q >> 3, c8 = q & 7; *(LAS u32x4*)(L + MG_QS + r * 144 + c8 * 16) = *(const u32x4*)(Pb + (size_t)(q0 + r) * PLD + PC_MQ + h * 64 + c8 * 8); }
    for (int i = tid; i < c * 64; i += 512) KB[i] = KBAR[(size_t)bh * 2048 + i];
    __syncthreads();
    {
        const int qi = tid & 255, par = tid >> 8;
        float qv[64];
#pragma unroll
        for (int c8 = 0; c8 < 8; ++c8) { const u32x4 v = *(const LAS u32x4*)(L + MG_QS + qi * 144 + c8 * 16);
#pragma unroll
            for (int e = 0; e < 4; ++e) { qv[c8 * 8 + 2 * e] = __uint_as_float(v[e] << 16); qv[c8 * 8 + 2 * e + 1] = __uint_as_float(v[e] & 0xffff0000u); } }
        float v1 = -INFINITY, v2 = -INFINITY, v3 = -INFINITY; int i1 = -1, i2 = -1, i3 = -1;
        for (int n = par; n < c; n += 2) { float g0 = 0.f, g1 = 0.f, g2 = 0.f, g3 = 0.f;
#pragma unroll
            for (int d4 = 0; d4 < 16; ++d4) { const f32x4 kb = *(const LAS f32x4*)(KB + n * 64 + d4 * 4); g0 += qv[4 * d4] * kb.x; g1 += qv[4 * d4 + 1] * kb.y; g2 += qv[4 * d4 + 2] * kb.z; g3 += qv[4 * d4 + 3] * kb.w; }
            const float g = (g0 + g1) + (g2 + g3);
            if (g > v1) { v3 = v2; i3 = i2; v2 = v1; i2 = i1; v1 = g; i1 = n; } else if (g > v2) { v3 = v2; i3 = i2; v2 = g; i2 = n; } else if (g > v3) { v3 = g; i3 = n; } }
        LAS float* TP = (LAS float*)(L + MG_TOP);
        if (par == 1) { TP[qi * 6 + 0] = v1; TP[qi * 6 + 1] = v2; TP[qi * 6 + 2] = v3; TP[qi * 6 + 3] = __int_as_float(i1); TP[qi * 6 + 4] = __int_as_float(i2); TP[qi * 6 + 5] = __int_as_float(i3); }
        __syncthreads();
        if (par == 0) {
#pragma unroll
            for (int k = 0; k < 3; ++k) { const float g = TP[qi * 6 + k]; const int n = __float_as_int(TP[qi * 6 + 3 + k]);
                if (n >= 0) { const bool b1 = g > v1 || (g == v1 && n < i1), b2 = g > v2 || (g == v2 && n < i2), b3 = g > v3 || (g == v3 && n < i3);
                    if (b1) { v3 = v2; i3 = i2; v2 = v1; i2 = i1; v1 = g; i1 = n; } else if (b2) { v3 = v2; i3 = i2; v2 = g; i2 = n; } else if (b3) { v3 = g; i3 = n; } } }
            const unsigned s4 = (unsigned)(i1 & 255) | ((unsigned)(i2 & 255) << 8) | ((unsigned)(i3 & 255) << 16) | 0xff000000u;
            SEL[qi] = s4; SELG[(size_t)(q0 + qi) * 4 + h] = s4;
        }
    }
    __syncthreads();
    for (int n = wave; n < c; n += 8) { int base = 0; unsigned char* lp = LISTG + ((size_t)(bh * 32 + c) * 32 + n) * 256;
#pragma unroll
        for (int ck = 0; ck < 4; ++ck) { const int q = ck * 64 + lane; const unsigned s4 = SEL[q]; const bool f = (s4 & 255u) == (unsigned)n || ((s4 >> 8) & 255u) == (unsigned)n || ((s4 >> 16) & 255u) == (unsigned)n;
            const unsigned long long bal = __ballot(f); const int pos = base + __popcll(bal & ((1ull << lane) - 1ull)); if (f) lp[pos] = (unsigned char)q; base += __popcll(bal); }
        if (lane == 0) CNTG[(bh * 32 + c) * 32 + n] = base; }
}
constexpr int KV_KL = 0, KV_VL = 36864, KV_PRE = KV_VL + 64 * 528;
DI void kv_tile(const LAS unsigned char* KL, const LAS unsigned char* VL, const bf16x8 (&qf)[2], int nsteps, bool causal, int qloc, int fr, int fq, f32x4 (&O)[4], float& m_out, float& l_out) {
    const float sc2 = 0.125f * 1.44269504089f;
    f32x4 s[16];
    const LAS unsigned char* kr0 = KL + (8 * (fr >> 2) + (fr & 3)) * 144 + fq * 16;
#pragma unroll
    for (int s8 = 0; s8 < 8; ++s8)
#pragma unroll
        for (int j = 0; j < 2; ++j) { f32x4 acc = (f32x4){0.f, 0.f, 0.f, 0.f};
#pragma unroll
            for (int ks = 0; ks < 2; ++ks) { const bf16x8 a = *(const LAS bf16x8*)(kr0 + (32 * s8 + 4 * j) * 144 + 64 * ks); acc = MFMA16(a, qf[ks], acc); }
            s[2 * s8 + j] = (s8 < nsteps) ? acc : (f32x4){-INFINITY, -INFINITY, -INFINITY, -INFINITY}; }
    if (causal) {
#pragma unroll
        for (int t = 0; t < 16; ++t)
#pragma unroll
            for (int r = 0; r < 4; ++r) { const int key = 32 * (t >> 1) + 8 * fq + 4 * (t & 1) + r; s[t][r] = key <= qloc ? s[t][r] : -INFINITY; } }
    float m = -INFINITY;
#pragma unroll
    for (int t = 0; t < 16; ++t) m = fmaxf(m, fmaxf(fmaxf(s[t][0], s[t][1]), fmaxf(s[t][2], s[t][3])));
    m = fmaxf(m, __shfl_xor(m, 16)); m = fmaxf(m, __shfl_xor(m, 32));
    const float mb = -m * sc2; float l = 0.f;
#pragma unroll
    for (int t = 0; t < 16; ++t)
#pragma unroll
        for (int r = 0; r < 4; ++r) { const float p = __builtin_amdgcn_exp2f(fmaf(s[t][r], sc2, mb)); s[t][r] = p; l += p; }
    l += __shfl_xor(l, 16); l += __shfl_xor(l, 32);
#pragma unroll
    for (int dt = 0; dt < 4; ++dt) O[dt] = (f32x4){0.f, 0.f, 0.f, 0.f};
    const LAS unsigned char* vr0 = VL + fr * 528 + fq * 16;
#pragma unroll
    for (int s8 = 0; s8 < 8; ++s8) {
        u32x4 pw; pw.x = cvt_pk_bf16(s[2 * s8][0], s[2 * s8][1]); pw.y = cvt_pk_bf16(s[2 * s8][2], s[2 * s8][3]); pw.z = cvt_pk_bf16(s[2 * s8 + 1][0], s[2 * s8 + 1][1]); pw.w = cvt_pk_bf16(s[2 * s8 + 1][2], s[2 * s8 + 1][3]);
        const bf16x8 pb = __builtin_bit_cast(bf16x8, pw);
#pragma unroll
        for (int dt = 0; dt < 4; ++dt) { const bf16x8 a = *(const LAS bf16x8*)(vr0 + (16 * dt) * 528 + 64 * s8); O[dt] = MFMA16(a, pb, O[dt]); } }
    m_out = m; l_out = l;
}
DI void kv_store(bf16_t* OPG, float* MLG, size_t row, int h, int slot, const f32x4 (&O)[4], float m, float l, int fq) {
    const float inv = 1.0f / l; const size_t base = ((row * 4 + h) * 4 + slot);
#pragma unroll
    for (int dt = 0; dt < 4; ++dt) { u32x2 w; w.x = cvt_pk_bf16(O[dt][0] * inv, O[dt][1] * inv); w.y = cvt_pk_bf16(O[dt][2] * inv, O[dt][3] * inv); *(u32x2*)(OPG + base * 64 + 16 * dt + 4 * fq) = w; }
    if (fq == 0) { MLG[base * 2] = m; MLG[base * 2 + 1] = l; }
}
DI void moba_kv_unit(const Frame& F, const bf16_t* Pb, const bf16_t* VT, const unsigned* SELG, const unsigned char* LISTG, const int* CNTG, bf16_t* OPG, float* MLG, int bl, int h, int n, int part, int nparts) {
    int lane_ = F.lane; LAUNDER_V(lane_);
    const int lane = lane_, wave = F.wave, tid = wave * 64 + lane, fr = lane & 15, fq = lane >> 4;
    LAS unsigned char* L = F.lds; LAS int* PRE = (LAS int*)(L + KV_PRE);
    const int bh = bl * 4 + h;
    const bf16_t* Kg = Pb + (size_t)(bl * SEQ + n * 256) * PLD + PC_MK + h * 64;
    const bf16_t* Vg = VT + (size_t)(bh * 64) * SEQ + n * 256;
    const bf16_t* Qg = Pb + (size_t)(bl * SEQ) * PLD + PC_MQ + h * 64;
    __syncthreads();
#pragma unroll
    for (int i = 0; i < 4; ++i) { const int q = tid + 512 * i, r = q >> 3, c8 = q & 7; *(LAS u32x4*)(L + KV_KL + r * 144 + c8 * 16) = *(const u32x4*)(Kg + (size_t)r * PLD + c8 * 8); }
#pragma unroll
    for (int i = 0; i < 4; ++i) { const int q = tid + 512 * i, d = q >> 5, c16 = q & 31; *(LAS u32x4*)(L + KV_VL + d * 528 + c16 * 16) = *(const u32x4*)(Vg + (size_t)d * SEQ + c16 * 8); }
    if (wave == 0) {
        const int cq = lane; int cnt = (cq > n && cq < 32) ? CNTG[(bh * 32 + cq) * 32 + n] : 0; int inc = cnt;
#pragma unroll
        for (int o = 1; o < 32; o <<= 1) { const int up = __shfl_up(inc, o); if (lane >= o) inc += up; }
        if (lane < 32) PRE[lane] = inc - cnt; if (lane == 31) PRE[32] = inc;
    }
    __syncthreads();
    const int T = PRE[32], nsp = (T + 15) >> 4, ntl = nsp + 16;
    for (int tt = part + nparts * wave; tt < ntl; tt += nparts * 8) {
        f32x4 O[4]; float m, l; bf16x8 qf[2];
        if (tt < nsp) {
            const int e = 16 * tt + fr; const bool valid = e < T; const int ee = valid ? e : 0;
            int cq = 0;
#pragma unroll
            for (int i = 1; i < 32; ++i) cq += (PRE[i] <= ee) ? 1 : 0;
            const int q = LISTG[((size_t)(bh * 32 + cq) * 32 + n) * 256 + (ee - PRE[cq])];
            const int tok = cq * 256 + q; const size_t row = (size_t)(bl * SEQ + tok);
#pragma unroll
            for (int ks = 0; ks < 2; ++ks) qf[ks] = *(const bf16x8*)(Qg + (size_t)tok * PLD + fq * 8 + 32 * ks);
            kv_tile(L + KV_KL, L + KV_VL, qf, 8, false, 0, fr, fq, O, m, l);
            const unsigned s4 = SELG[row * 4 + h]; const int slot = (s4 & 255u) == (unsigned)n ? 0 : (((s4 >> 8) & 255u) == (unsigned)n ? 1 : 2);
            if (valid) kv_store(OPG, MLG, row, h, slot, O, m, l, fq);
        } else {
            const int to = tt - nsp, qloc = 16 * to + fr, tok = n * 256 + qloc; const size_t row = (size_t)(bl * SEQ + tok);
#pragma unroll
            for (int ks = 0; ks < 2; ++ks) qf[ks] = *(const bf16x8*)(Qg + (size_t)tok * PLD + fq * 8 + 32 * ks);
            kv_tile(L + KV_KL, L + KV_VL, qf, (16 * to + 15) / 32 + 1, true, qloc, fr, fq, O, m, l);
            kv_store(OPG, MLG, row, h, 3, O, m, l, fq);
        }
    }
}
DI void moba_combine(const Frame& F, const unsigned* SELG, const bf16_t* OPG, const float* MLG, bf16_t* BR) {
    int lane_ = F.lane; LAUNDER_V(lane_);
    const int lane = lane_, sub = lane & 7, gw = F.blk * 8 + F.wave, NGW = F.G * 8;
    const float sc2 = 0.125f * 1.44269504089f;
    for (int it = gw; it < NG * 4 / 8; it += NGW) { const size_t idx = (size_t)it * 8 + (lane >> 3); const size_t row = idx >> 2; const int h = (int)(idx & 3);
        const unsigned s4 = SELG[idx]; float mk[4], lk[4]; float M = -INFINITY;
#pragma unroll
        for (int k = 0; k < 4; ++k) { const bool ok = (k == 3) || (((s4 >> (8 * k)) & 255u) != 255u); const f32x2 ml = *(const f32x2*)(MLG + (idx * 4 + k) * 2); mk[k] = ok ? ml.x : -INFINITY; lk[k] = ok ? ml.y : 0.f; M = fmaxf(M, mk[k]); }
        float o[8]; float den = 0.f;
#pragma unroll
        for (int e = 0; e < 8; ++e) o[e] = 0.f;
#pragma unroll
        for (int k = 0; k < 4; ++k) { const bool ok = (k == 3) || (((s4 >> (8 * k)) & 255u) != 255u); const float w = ok ? lk[k] * __builtin_amdgcn_exp2f((mk[k] - M) * sc2) : 0.f; den += w;
            u32x4 pv = *(const u32x4*)(OPG + (idx * 4 + k) * 64 + sub * 8);
            if (!ok) pv = (u32x4){0u, 0u, 0u, 0u};
#pragma unroll
            for (int e = 0; e < 4; ++e) { o[2 * e] += w * __uint_as_float(pv[e] << 16); o[2 * e + 1] += w * __uint_as_float(pv[e] & 0xffff0000u); } }
        const float inv = 1.0f / den; u32x4 wv;
#pragma unroll
        for (int e = 0; e < 4; ++e) wv[e] = cvt_pk_bf16(o[2 * e] * inv, o[2 * e + 1] * inv);
        *(u32x4*)(BR + row * 1024 + 256 + h * 64 + sub * 8) = wv; }
}
__host__ __device__ constexpr int kv_parts(int n) { return n == 0 ? 3 : (n < 8 ? 2 : 1); }
__host__ __device__ constexpr int kv_items_before(int n) { int s = 0; for (int i = 0; i < n; ++i) s += kv_parts(i) * GB * 4; return s; }
constexpr int KV_NITEMS = kv_items_before(32);

constexpr int XA_K = 0;
constexpr int XA_VT = 69632;
DI void xattn_wg(const Frame& F, const bf16_t* KVM, const bf16_t* QX, bf16_t* AO, int w) {
    int lane_ = F.lane; LAUNDER_V(lane_);
    const int lane = lane_, wave = F.wave, tid = wave * 64 + lane, fr = lane & 15, fq = lane >> 4;
    const int b = w >> 5, h = (w >> 3) & 3, qpart = w & 7;
    LAS unsigned char* L = F.lds;
    __syncthreads();
#pragma unroll
    for (int i = 0; i < 8; ++i) { const int q = tid + 512 * i, m = q >> 4, c16 = q & 15; *(LAS u32x4*)(L + XA_K + m * 272 + c16 * 16) = *(const u32x4*)(KVM + (size_t)(b * 256 + m) * 1024 + h * 128 + c16 * 8); }
#pragma unroll
    for (int i = 0; i < 8; ++i) { const int q = tid + 512 * i, m = q & 255, c16 = q >> 8; const u32x4 v = *(const u32x4*)(KVM + (size_t)(b * 256 + m) * 1024 + 512 + h * 128 + c16 * 8);
#pragma unroll
        for (int e = 0; e < 4; ++e) { *(LAS bf16_t*)(L + XA_VT + (c16 * 8 + 2 * e) * 528 + m * 2) = (bf16_t)(v[e] & 0xffffu); *(LAS bf16_t*)(L + XA_VT + (c16 * 8 + 2 * e + 1) * 528 + m * 2) = (bf16_t)(v[e] >> 16); } }
    __syncthreads();
    const float sc2 = 0.08838834764831845f * 1.44269504089f;
    for (int rtile = 0; rtile < 8; ++rtile) {
        const size_t tok = (size_t)b * SEQ + qpart * 1024 + wave * 128 + rtile * 16 + fr;
        bf16x8 qf[4];
#pragma unroll
        for (int ks = 0; ks < 4; ++ks) qf[ks] = *(const bf16x8*)(QX + tok * 512 + h * 128 + fq * 8 + 32 * ks);
        f32x4 s[16]; float mx = -INFINITY;
#pragma unroll
        for (int kt = 0; kt < 16; ++kt) { s[kt] = (f32x4){0.f, 0.f, 0.f, 0.f};
#pragma unroll
            for (int ks = 0; ks < 4; ++ks) { const bf16x8 a = *(const LAS bf16x8*)(L + XA_K + (16 * kt + fr) * 272 + (fq * 8 + 32 * ks) * 2); s[kt] = MFMA16(a, qf[ks], s[kt]); }
            mx = fmaxf(mx, fmaxf(fmaxf(s[kt][0], s[kt][1]), fmaxf(s[kt][2], s[kt][3]))); __builtin_amdgcn_sched_barrier(0); }
        mx = fmaxf(mx, __shfl_xor(mx, 16)); mx = fmaxf(mx, __shfl_xor(mx, 32));
        float l = 0.f;
#pragma unroll
        for (int kt = 0; kt < 16; ++kt)
#pragma unroll
            for (int r = 0; r < 4; ++r) { const float p = __builtin_amdgcn_exp2f((s[kt][r] - mx) * sc2); s[kt][r] = p; l += p; }
        l += __shfl_xor(l, 16); l += __shfl_xor(l, 32); const float inv = 1.0f / l;
        f32x4 O[8];
#pragma unroll
        for (int dt = 0; dt < 8; ++dt) O[dt] = (f32x4){0.f, 0.f, 0.f, 0.f};
#pragma unroll
        for (int s8 = 0; s8 < 8; ++s8) {
            u32x4 pw; pw.x = pk2(s[2 * s8][0], s[2 * s8][1]); pw.y = pk2(s[2 * s8][2], s[2 * s8][3]); pw.z = pk2(s[2 * s8 + 1][0], s[2 * s8 + 1][1]); pw.w = pk2(s[2 * s8 + 1][2], s[2 * s8 + 1][3]);
            const bf16x8 pb = __builtin_bit_cast(bf16x8, pw);
#pragma unroll
            for (int dt = 0; dt < 8; ++dt) {
                const u32x2 lo = *(const LAS u32x2*)(L + XA_VT + (16 * dt + fr) * 528 + (32 * s8 + 4 * fq) * 2), hi = *(const LAS u32x2*)(L + XA_VT + (16 * dt + fr) * 528 + (32 * s8 + 16 + 4 * fq) * 2);
                const u32x4 av = (u32x4){lo.x, lo.y, hi.x, hi.y};
                O[dt] = MFMA16(__builtin_bit_cast(bf16x8, av), pb, O[dt]); }
            __builtin_amdgcn_sched_barrier(0);
        }
#pragma unroll
        for (int dt = 0; dt < 8; ++dt) { u32x2 wv; wv.x = pk2(O[dt][0] * inv, O[dt][1] * inv); wv.y = pk2(O[dt][2] * inv, O[dt][3] * inv);
            *(u32x2*)(AO + tok * 512 + h * 128 + 16 * dt + 4 * fq) = wv; }
    }
    __syncthreads();
}
DI void moe_route1(const Frame& F, const bf16_t* x, const float* Wr, int* TE, float* TW, float* RR, int* CNT) {
    const int tid = F.tid, lane = F.lane, wave = F.wave;
    LAS float* WL = (LAS float*)F.lds; LAS int* HC = (LAS int*)(F.lds + 32768);
    __syncthreads();
    for (int i = tid; i < 8 * 1024 / 4; i += 512) ((LAS f32x4*)WL)[i] = ((const f32x4*)Wr)[i];
    for (int tb = F.blk; tb < NTOK / 256; tb += F.G) {
        if (tid < 8) HC[tid] = 0;
        __syncthreads();
        u32x2 vn[4];
        { const u32x2* xr = (const u32x2*)(x + (size_t)(tb * 256 + wave * 32) * 1024) + lane;
#pragma unroll
          for (int j = 0; j < 4; ++j) vn[j] = xr[64 * j]; }
        for (int rr = 0; rr < 32; ++rr) { const int row = tb * 256 + wave * 32 + rr;
            f32x4 v[4]; float ss = 0.f;
#pragma unroll
            for (int j = 0; j < 4; ++j) v[j] = (f32x4){__uint_as_float(vn[j].x << 16), __uint_as_float(vn[j].x & 0xffff0000u), __uint_as_float(vn[j].y << 16), __uint_as_float(vn[j].y & 0xffff0000u)};
            { const u32x2* xr = (const u32x2*)(x + (size_t)(rr + 1 < 32 ? row + 1 : row) * 1024) + lane;
#pragma unroll
              for (int j = 0; j < 4; ++j) vn[j] = xr[64 * j]; }
#pragma unroll
            for (int j = 0; j < 4; ++j) ss += (v[j].x * v[j].x + v[j].y * v[j].y) + (v[j].z * v[j].z + v[j].w * v[j].w);
            ss = wave_sum(ss); const float r = rsqrtf(ss * (1.0f / 1024.0f) + RMS_EPS);
            float lg[8];
#pragma unroll
            for (int e = 0; e < 8; ++e) { float a = 0.f;
#pragma unroll
                for (int j = 0; j < 4; ++j) { const f32x4 w = *(const LAS f32x4*)(WL + e * 1024 + 4 * lane + 256 * j); a += (v[j].x * w.x + v[j].y * w.y) + (v[j].z * w.z + v[j].w * w.w); }
                lg[e] = wave_sum(a) * r; }
            int e0 = 0; float l0 = lg[0];
#pragma unroll
            for (int e = 1; e < 8; ++e) if (lg[e] > l0) { l0 = lg[e]; e0 = e; }
            int e1 = -1; float l1 = -INFINITY;
#pragma unroll
            for (int e = 0; e < 8; ++e) if (e != e0 && lg[e] > l1) { l1 = lg[e]; e1 = e; }
            const float w0 = 1.0f / (1.0f + __expf(l1 - l0));
            if (lane == 0) { TE[2 * (size_t)row] = e0; TE[2 * (size_t)row + 1] = e1; TW[2 * (size_t)row] = w0; TW[2 * (size_t)row + 1] = 1.0f - w0; RR[row] = r;
                __hip_atomic_fetch_add(&HC[e0], 1, __ATOMIC_RELAXED, __HIP_MEMORY_SCOPE_WORKGROUP); __hip_atomic_fetch_add(&HC[e1], 1, __ATOMIC_RELAXED, __HIP_MEMORY_SCOPE_WORKGROUP); }
        }
        __syncthreads();
        if (tid < 8) CNT[tb * 8 + tid] = HC[tid];
        __syncthreads();
    }
}
DI void moe_bases(const Frame& F, const int* CNT, int tb, LAS int* OUT  ) {
    const int tid = F.tid; LAS int* SC = (LAS int*)(F.lds + 40960);
    __syncthreads();
    { const int e = tid & 7, seg = tid >> 3; int all = 0, lt = 0;
#pragma unroll
      for (int q = 0; q < 4; ++q) { const int w = 4 * seg + q; const int c = CNT[w * 8 + e]; all += c; lt += (w < tb) ? c : 0; }
      SC[seg * 8 + e] = all; SC[512 + seg * 8 + e] = lt; }
    __syncthreads();
    if (tid < 8) { int all = 0, lt = 0; for (int s = 0; s < 64; ++s) { all += SC[s * 8 + tid]; lt += SC[512 + s * 8 + tid]; } SC[1024 + tid] = (all + 255) >> 8; OUT[16 + tid] = lt; }
    __syncthreads();
    if (tid == 0) { int b = 0; for (int e = 0; e < 8; ++e) { OUT[e] = b; b += SC[1024 + e]; } OUT[8] = b; }
    __syncthreads();
}
DI void moe_route2(const Frame& F, const int* TE, const float* RR, const int* CNT, const bf16_t* xb, int* POS, bf16_t* XP, float* RP) {
    const int tid = F.tid, lane = F.lane, wave = F.wave;
    LAS int* MB = (LAS int*)(F.lds + 49152);
    LAS int* WT = (LAS int*)(F.lds + 49152 + 256);
    LAS int* PL = (LAS int*)(F.lds + 49152 + 512);
    for (int tb = F.blk; tb < NTOK / 256; tb += F.G) {
        moe_bases(F, CNT, tb, MB);
        int e0 = -1, e1 = -1; const int tok = tb * 256 + tid;
        if (tid < 256) { e0 = TE[2 * (size_t)tok]; e1 = TE[2 * (size_t)tok + 1]; }
        int pw[2] = {0, 0};
#pragma unroll
        for (int e = 0; e < 8; ++e) { const bool f = (e0 == e) || (e1 == e); const unsigned long long bal = __ballot(f);
            const int before = __popcll(bal & ((1ull << lane) - 1ull)); if (lane == 0 && wave < 4) WT[wave * 8 + e] = __popcll(bal);
            if (e0 == e) pw[0] = before; if (e1 == e) pw[1] = before; }
        __syncthreads();
        if (tid < 256) {
#pragma unroll
            for (int sl = 0; sl < 2; ++sl) { const int e = sl ? e1 : e0; int rank = pw[sl]; for (int w2 = 0; w2 < wave; ++w2) rank += WT[w2 * 8 + e];
                const int pos = MB[e] * 256 + MB[16 + e] + rank; PL[2 * tid + sl] = pos; POS[2 * (size_t)tok + sl] = pos; RP[pos] = RR[tok]; } }
        __syncthreads();
        for (int pr0 = wave * 64; pr0 < wave * 64 + 64; pr0 += 8) { u32x4 ra[8], rb[8];
#pragma unroll
            for (int q = 0; q < 8; ++q) { const int t2 = (pr0 + q) >> 1; const u32x4* src = (const u32x4*)(xb + (size_t)(tb * 256 + t2) * 1024); ra[q] = src[lane]; rb[q] = src[lane + 64]; }
#pragma unroll
            for (int q = 0; q < 8; ++q) { const int pos = PL[pr0 + q]; u32x4* dst = (u32x4*)(XP + (size_t)pos * 1024); dst[lane] = ra[q]; dst[lane + 64] = rb[q]; } }
        __syncthreads();
    }
}
DI void moe_final(const Frame& F, const bf16_t* xb, float* out, const bf16_t* Y, const int* POS, const float* TW, const float* fg) {
    const int lane = F.lane, gw = F.blk * 8 + F.wave, NGW = F.G * 8;
    int pn0 = 0, pn1 = 0; float wn0 = 0.f, wn1 = 0.f;
    if (gw < NTOK) { pn0 = POS[2 * (size_t)gw]; pn1 = POS[2 * (size_t)gw + 1]; wn0 = TW[2 * (size_t)gw]; wn1 = TW[2 * (size_t)gw + 1]; }
    for (int row = gw; row < NTOK; row += NGW) {
        const int p0 = pn0, p1 = pn1; const float w0 = wn0, w1 = wn1;
        { const size_t rn = (size_t)(row + NGW < NTOK ? row + NGW : row); pn0 = POS[2 * rn]; pn1 = POS[2 * rn + 1]; wn0 = TW[2 * rn]; wn1 = TW[2 * rn + 1]; }
        f32x4* xr = (f32x4*)(out + (size_t)row * 1024) + lane; const u32x2* xs = (const u32x2*)(xb + (size_t)row * 1024) + lane; const u32x2* y0 = (const u32x2*)(Y + (size_t)p0 * 1024) + lane; const u32x2* y1 = (const u32x2*)(Y + (size_t)p1 * 1024) + lane;
        f32x4 v[4]; float ss = 0.f; u32x2 ya[4], yb[4];
#pragma unroll
        for (int j = 0; j < 4; ++j) { const u32x2 xv = xs[64 * j]; v[j] = (f32x4){__uint_as_float(xv.x << 16), __uint_as_float(xv.x & 0xffff0000u), __uint_as_float(xv.y << 16), __uint_as_float(xv.y & 0xffff0000u)}; ya[j] = y0[64 * j]; yb[j] = y1[64 * j]; }
#pragma unroll
        for (int j = 0; j < 4; ++j) { const u32x2 a = ya[j], b = yb[j];
            v[j].x += w0 * __uint_as_float(a.x << 16) + w1 * __uint_as_float(b.x << 16); v[j].y += w0 * __uint_as_float(a.x & 0xffff0000u) + w1 * __uint_as_float(b.x & 0xffff0000u);
            v[j].z += w0 * __uint_as_float(a.y << 16) + w1 * __uint_as_float(b.y << 16); v[j].w += w0 * __uint_as_float(a.y & 0xffff0000u) + w1 * __uint_as_float(b.y & 0xffff0000u);
            ss += (v[j].x * v[j].x + v[j].y * v[j].y) + (v[j].z * v[j].z + v[j].w * v[j].w); }
        ss = wave_sum(ss); const float r = rsqrtf(ss * (1.0f / 1024.0f) + RMS_EPS);
#pragma unroll
        for (int j = 0; j < 4; ++j) { const f32x4 g = ((const f32x4*)fg)[lane + 64 * j]; xr[64 * j] = (f32x4){v[j].x * r * g.x, v[j].y * r * g.y, v[j].z * r * g.z, v[j].w * r * g.w}; }
    }
}
constexpr int SCAN_CUT = 32;
__global__ void __launch_bounds__(512, 2) mk_fwd(Params prm) {
    extern __shared__ __attribute__((aligned(16))) unsigned char lds_raw[];
    Frame F0;
    F0.lds = (LAS unsigned char*)lds_raw;
    F0.tid = threadIdx.x; F0.lane = F0.tid & 63; F0.wave = __builtin_amdgcn_readfirstlane(F0.tid >> 6); F0.G = gridDim.x; F0.blk = blockIdx.x;
    F0.ws = prm.ws;
    volatile LAS unsigned* MISC = (volatile LAS unsigned*)(F0.lds + LDS_MISC);
    if (F0.tid < 64) MISC[F0.tid] = 0u;
    __syncthreads();
    XcdBarrier bar; bar.bar = (unsigned*)(prm.ws + WS_CTL); bar.x = 0; bar.st = MISC;
#if MK_SINGLE
    bar = xcd_barrier_post((unsigned*)(prm.ws + WS_CTL), MISC);
#endif
    const int lo = prm.ph_lo, hi = prm.ph_hi; int ph = 0;
#ifndef DBG_REP_CLASS
#define DBG_REP_CLASS 0
#endif
#define REPEAT(cls) for (int rep_ = 0; rep_ < ((DBG_REP_CLASS == (cls)) ? 2 : 1); ++rep_)
#define REPBAR(cls) do { if (DBG_REP_CLASS == (cls) && rep_ == 0) xcd_barrier(bar); } while (0)
#define ACTIVE() (ph >= lo && ph < hi)
#define SEAM() do { if (ph + 1 < hi) xcd_barrier(bar); } while (0)
    LAS unsigned char* glds = F0.lds;
#define PTRS() unsigned char* ws = prm.ws; asm volatile("" : "+s"(ws)); Frame F = F0; { int w_ = F0.wave; asm volatile("" : "+s"(w_)); int l_ = (int)__builtin_amdgcn_mbcnt_hi(~0u, __builtin_amdgcn_mbcnt_lo(~0u, 0u)); asm volatile("" : "+v"(l_)); F.wave = w_; F.lane = l_; F.tid = w_ * 64 + l_; } F.ws = ws; unsigned char* ar = ws + WS_ARENA; (void)ar; \
    bf16_t* xb = (bf16_t*)(ws + WS_XB); float* ssq = (float*)(ws + WS_SSQ); const float* rope = (const float*)(ws + WS_ROPE); float* xout = prm.out; (void)xb; (void)ssq; (void)rope; (void)xout; \
    unsigned char* lw = ws + WS_LW + (size_t)layer * LW_STRIDE; (void)lw; const float* sm = (const float*)(ws + WS_SMALL); (void)sm
#define GPTRS() PTRS(); const bf16_t* xbg = xb + (size_t)grp * NG * 1024; const float* ssqg = ssq + (size_t)grp * NG * 16; const float* ropeg = rope + (size_t)grp * NG * 16; \
    bf16_t* Pb = (bf16_t*)(ar + AR_P); float* BA = (float*)(ar + AR_BA); bf16_t* BR = (bf16_t*)(ar + AR_BR); float* KBAR = (float*)(ar + AR_KBAR); bf16_t* VT = (bf16_t*)(ar + AR_VT); \
    bf16_t* QD = (bf16_t*)(ar + AR_QD); bf16_t* MM = (bf16_t*)(ar + AR_KDT); bf16_t* NT = (bf16_t*)(ar + AR_NT); bf16_t* SG = (bf16_t*)(ar + AR_SG); bf16_t* ZB = (bf16_t*)(ar + AR_ZB); unsigned* SELG = (unsigned*)(ar + AR_SELG); int* CNTG = (int*)(ar + AR_CNTG); unsigned char* LISTG = (unsigned char*)(ar + AR_LISTG); bf16_t* OPG = (bf16_t*)(ar + AR_OPG); float* MLG = (float*)(ar + AR_MLG); bf16_t* WN = (bf16_t*)(ar + AR_WN); bf16_t* UT = (bf16_t*)(ar + AR_UT); bf16_t* AQK = (bf16_t*)(ar + AR_AQK); float* GL = (float*)(ar + AR_GL); \
    bf16_t* MG = (bf16_t*)(ar + AR_MERGED) + (size_t)grp * NG * 1024; \
    (void)xbg; (void)ssqg; (void)ropeg; (void)Pb; (void)BA; (void)BR; (void)KBAR; (void)VT; (void)QD; (void)MM; (void)NT; (void)SG; (void)ZB; (void)SELG; (void)CNTG; (void)LISTG; (void)OPG; (void)MLG; (void)WN; (void)UT; (void)AQK; (void)GL; (void)MG
#define MPTRS() PTRS(); int* TE = (int*)(ar + AR_TE); float* TW = (float*)(ar + AR_TW); float* RR = (float*)(ar + AR_RR); int* POS = (int*)(ar + AR_POS); int* CNT = (int*)(ar + AR_CNT); \
    bf16_t* XP = (bf16_t*)(ar + AR_XP); float* RP = (float*)(ar + AR_RP); bf16_t* HM = (bf16_t*)(ar + AR_HM); (void)TE; (void)TW; (void)RR; (void)POS; (void)CNT; (void)XP; (void)RP; (void)HM

    if (ACTIVE()) { REPEAT(1) { const int layer = 0; PTRS();
        const __attribute__((address_space(4))) Params* kp = (const __attribute__((address_space(4))) Params*)__builtin_amdgcn_kernarg_segment_ptr(); asm volatile("" : "+s"(kp));
        Params lp;
#pragma unroll
        for (int i = 0; i < 27; ++i) lp.in[i] = kp->in[i];
        lp.out = nullptr; lp.ws = ws; lp.ph_lo = 0; lp.ph_hi = 0; lp.pad0 = 0; lp.pad1 = 0;
        phase_prologue(F, lp); REPBAR(1); } SEAM(); } ++ph;
    for (int layer = 0; layer < 2; ++layer) {
        for (int grp = 0; grp < NGRP; ++grp) {
            if (ACTIVE()) { REPEAT(3) {
                GPTRS();
                pg8::Gemm g{xbg, (const bf16_t*)(lw + LW_WIN), 1024, 1024};
                pg8::SchedPlain S; S.init(NG, 3072, 1024, 1024, 1024, F.G, F.blk);
                pg8::build_rtab(glds, S, ssqg, nullptr, F.tid);
                pg8::EpiScaleBf16 E{Pb, PLD, ssqg, 0, ZB, 512, 10, (const LAS float*)(glds + pg8::RTAB_OFF)};
                pg8::gemm_phase(glds, g, S, E, F.wave);
                ba_tiles(F, xbg, (const bf16_t*)(lw + LW_WBA), ssqg, BA);
                REPBAR(3); }
                SEAM();
            } ++ph;
            if (ACTIVE()) {
                GPTRS();
                REPEAT(4) {
                for (int u = F.blk; u < 1024; u += F.G)
                    prep_dn(F, Pb, BA, sm + SM_CONVW + (size_t)layer * 4 * 1536, sm + SM_ALOG + layer * 8, sm + SM_DTB + layer * 8, QD, MM, NT, WN, UT, AQK, GL, u);
#ifndef DBG_RPOOL
#define DBG_RPOOL 1
#endif
                for (int rpP = 0; rpP < DBG_RPOOL; ++rpP) for (int u = F.blk; u < NG / 64; u += F.G) prep_pool(F, Pb, BR, u);
                REPBAR(4); }
                for (int u = F.blk; u < GB * 32; u += F.G) prep_moba(F, Pb, ropeg, KBAR, VT, u);
                SEAM();
            } ++ph;
            if (ACTIVE()) { REPEAT(18) {
                GPTRS();
                if (F.blk < GB * 8) { if (MK_SINGLE) dn_scan(F, F.blk, MM, NT, SG, 0, SCAN_CUT); }
                else { const int nw = F.G - GB * 8;
                    for (int u = F.blk - GB * 8; u < GB * 4 * 32; u += nw) { const int c = 31 - u / (GB * 4), bh = u % (GB * 4); moba_gate_unit(F, Pb, KBAR, SELG, LISTG, CNTG, bh >> 2, bh & 3, c); } }
                REPBAR(18); }
                SEAM();
            } ++ph;
            if (ACTIVE()) { REPEAT(5) {
                GPTRS();
                if (F.blk < GB * 8) { for (int r2_ = 0; r2_ < ((DBG_REP_CLASS == 16) ? 2 : 1); ++r2_) dn_scan(F, F.blk, MM, NT, SG, MK_SINGLE ? SCAN_CUT : 0, 127, r2_ == 0); }
                else { const int nw = F.G - GB * 8, wq = F.blk - GB * 8;
                    for (int r2_ = 0; r2_ < ((DBG_REP_CLASS == 17) ? 2 : 1); ++r2_)
                    for (int rd = 0; rd * nw < KV_NITEMS; ++rd) { const int i = rd * nw + ((rd & 1) ? nw - 1 - wq : wq); if (i >= KV_NITEMS) continue;
                        int n, part, bh;
                        if (i < 48) { n = 0; part = i >> 4; bh = i & 15; } else if (i < 272) { const int j = i - 48; n = 1 + (j >> 5); part = (j >> 4) & 1; bh = j & 15; } else { const int j = i - 272; n = 8 + (j >> 4); part = 0; bh = j & 15; }
                        moba_kv_unit(F, Pb, VT, SELG, LISTG, CNTG, OPG, MLG, bh >> 2, bh & 3, n, part, n == 0 ? 3 : (n < 8 ? 2 : 1)); } }
                if (layer == 0 && grp == 0) {
                    __syncthreads();
                    pg8::Gemm gk{(const bf16_t*)(ws + WS_MEMN), (const bf16_t*)(ws + WS_LW + LW_WKV), 1024, 1024};
                    pg8::SchedKV Sk; Sk.c = F.blk - GB * 8; Sk.lstride = LW_STRIDE;
                    pg8::EpiScaleBf16 Ek{(bf16_t*)(ws + WS_KVM), 1024, nullptr, 0, nullptr, 0, 1 << 30, nullptr};
                    pg8::gemm_phase(glds, gk, Sk, Ek, F.wave); }
                REPBAR(5); }
                SEAM();
            } ++ph;
            if (ACTIVE()) { REPEAT(6) {
                GPTRS();
                pg8::Gemm g{xbg, (const bf16_t*)(lw + LW_WIN) + (size_t)3072 * 1024, 1024, 1024};
                pg8::SchedPlain S; S.init(NG, 3072, 1024, 1024, 1024, F.G, F.blk);
                moba_combine(F, SELG, OPG, MLG, BR);
                dn_out_pass(F, QD, WN, UT, AQK, SG, ZB, sm + SM_DNG + layer * 64, BR);
                pg8::build_rtab(glds, S, ssqg, nullptr, F.tid);
                pg8::EpiScaleBf16 E{Pb, PLD, ssqg, 1, nullptr, 0, 1 << 30, (const LAS float*)(glds + pg8::RTAB_OFF)};
                pg8::gemm_phase(glds, g, S, E, F.wave);
                REPBAR(6); }
                SEAM();
            } ++ph;
            if (ACTIVE()) { REPEAT(7) {
                GPTRS();
                pg8::Gemm g{BR, (const bf16_t*)(lw + LW_WCAT), 1024, 1024};
                pg8::SchedPlain S; S.init(NG, 1024, 1024, 1024, 1024, F.G, F.blk);
                pg8::EpiMerge E{Pb, MG};
                pg8::gemm_phase(glds, g, S, E, F.wave);
                REPBAR(7); }
                SEAM();
            } ++ph;
        }
        if (ACTIVE()) { for (int rep_ = 0; rep_ < ((DBG_REP_CLASS == 8 && layer == 0) ? 2 : 1); ++rep_) {
            PTRS();
            pg8::Gemm g{(const bf16_t*)(ar + AR_MERGED), (const bf16_t*)(lw + LW_WOUT), 1024, 1024};
            pg8::SchedPlain S; S.init(NTOK, 1024, 1024, 1024, 1024, F.G, F.blk);
            pg8::EpiResid E{xb, ssq};
            pg8::gemm_phase(glds, g, S, E, F.wave);
            REPBAR(8); }
            SEAM();
        } ++ph;
        if (ACTIVE()) { REPEAT(9) {
            PTRS();
            pg8::Gemm g{xb, (const bf16_t*)(lw + LW_WQ), 1024, 1024};
            pg8::SchedPlain S; S.init(NTOK, 512, 1024, 1024, 1024, F.G, F.blk);
            pg8::build_rtab(glds, S, ssq, nullptr, F.tid);
            pg8::EpiScaleBf16 E{(bf16_t*)(ar + AR_QX), 512, ssq, 0, nullptr, 0, 1 << 30, (const LAS float*)(glds + pg8::RTAB_OFF)};
            pg8::gemm_phase(glds, g, S, E, F.wave);
            REPBAR(9); }
                SEAM();
        } ++ph;
        if (ACTIVE()) { REPEAT(10) {
            PTRS();
            for (int w = F.blk; w < 256; w += F.G) xattn_wg(F, (const bf16_t*)(ws + WS_KVM) + (size_t)layer * 2048 * 1024, (const bf16_t*)(ar + AR_QX), (bf16_t*)(ar + AR_AO), w);
            REPBAR(10); }
                SEAM();
        } ++ph;
        if (ACTIVE()) {
            PTRS();
            pg8::Gemm g{(const bf16_t*)(ar + AR_AO), (const bf16_t*)(lw + LW_WO), 512, 512};
            pg8::SchedPlain S; S.init(NTOK, 1024, 512, 512, 512, F.G, F.blk);
            pg8::EpiResid E{xb, ssq};
            pg8::gemm_phase(glds, g, S, E, F.wave);
            SEAM();
        } ++ph;
        if (layer == 0) {
            if (ACTIVE()) { REPEAT(11) {
                PTRS();
                pg8::Gemm g{xb, (const bf16_t*)(ws + WS_WGU), 1024, 1024};
                pg8::SchedPlain S; S.init(NTOK, 2 * FF, 1024, 1024, 1024, F.G, F.blk);
                pg8::build_rtab(glds, S, ssq, nullptr, F.tid);
                pg8::EpiSwiglu E{(bf16_t*)(ar + AR_HID), FF, (const LAS float*)(glds + pg8::RTAB_OFF)};
                pg8::gemm_phase(glds, g, S, E, F.wave);
                REPBAR(11); }
                SEAM();
            } ++ph;
            if (ACTIVE()) {
                PTRS();
                pg8::Gemm g{(const bf16_t*)(ar + AR_HID), (const bf16_t*)(ws + WS_WD), FF, FF};
                pg8::SchedPlain S; S.init(NTOK, 1024, FF, FF, FF, F.G, F.blk);
                pg8::EpiResid E{xb, ssq};
                pg8::gemm_phase(glds, g, S, E, F.wave);
                SEAM();
            } ++ph;
        } else {
            if (ACTIVE()) { REPEAT(12) { MPTRS(); moe_route1(F, xb, (const float*)(ws + WS_WR), TE, TW, RR, CNT); REPBAR(12); } SEAM(); } ++ph;
            if (ACTIVE()) { REPEAT(13) { MPTRS(); moe_route2(F, TE, RR, CNT, xb, POS, XP, RP); REPBAR(13); } SEAM(); } ++ph;
            if (ACTIVE()) { REPEAT(14) {
                MPTRS();
                LAS int* MB = (LAS int*)(F.lds + 49152); moe_bases(F, CNT, 0, MB);
                pg8::SchedMoe S;
#pragma unroll
                for (int e = 0; e < 9; ++e) S.pbase[e] = MB[e];
                S.nN = 2 * EFF / 256; S.nt = 16; S.G = F.G; S.c = F.blk; S.astep = (size_t)256 * 1024 * 2; S.bstep = (size_t)256 * 1024 * 2; S.estep = (size_t)2 * EFF * 1024 * 2;
                __syncthreads();
                pg8::Gemm g{XP, (const bf16_t*)(ws + WS_WMGU), 1024, 1024};
                pg8::build_rtab(glds, S, nullptr, RP, F.tid);
                pg8::EpiSwiglu E{HM, EFF, (const LAS float*)(glds + pg8::RTAB_OFF)};
                pg8::gemm_phase(glds, g, S, E, F.wave);
                REPBAR(14); }
                SEAM();
            } ++ph;
            if (ACTIVE()) { REPEAT(15) {
                MPTRS();
                LAS int* MB = (LAS int*)(F.lds + 49152); moe_bases(F, CNT, 0, MB);
                pg8::SchedMoe S;
#pragma unroll
                for (int e = 0; e < 9; ++e) S.pbase[e] = MB[e];
                S.nN = 4; S.nt = EFF / 64; S.G = F.G; S.c = F.blk; S.astep = (size_t)256 * EFF * 2; S.bstep = (size_t)256 * EFF * 2; S.estep = (size_t)1024 * EFF * 2;
                __syncthreads();
                pg8::Gemm g{HM, (const bf16_t*)(ws + WS_WMD), EFF, EFF};
                pg8::EpiScaleBf16 E{XP, 1024, nullptr, 0, nullptr, 0, 1 << 30, nullptr};
                pg8::gemm_phase(glds, g, S, E, F.wave);
                REPBAR(15); }
                SEAM();
            } ++ph;
            if (ACTIVE()) { MPTRS(); moe_final(F, xb, xout, XP, POS, TW, sm + SM_FING); SEAM(); } ++ph;
        }
    }
#undef ACTIVE
#undef REPEAT
#undef REPBAR
#undef SEAM
#undef PTRS
#undef GPTRS
#undef MPTRS
}

#ifdef DBG_DUMP_OFF
__global__ void dbg_dump(float* out, const unsigned char* ws) {
    const bf16_t* src = (const bf16_t*)(ws + (size_t)DBG_DUMP_OFF);
    for (size_t i = (size_t)blockIdx.x * blockDim.x + threadIdx.x; i < (size_t)NTOK * 1024; i += (size_t)gridDim.x * blockDim.x) { float v = i < (size_t)DBG_DUMP_N ? bf2f(src[i]) : 0.f; if (!(v == v) || v > 1e30f || v < -1e30f) v = 12345.0f; out[i] = v; }
}
#endif
extern "C" void kernel_launch(void* const* d_in, const int* in_sizes, int n_in, void* d_out, int out_size, void* d_ws, size_t ws_size, hipStream_t stream) {
    static int grid = 0;
    if (grid == 0) {
        if (n_in != 27 || in_sizes[0] != NTOK * DM || out_size != NTOK * DM || ws_size < WS_END) {
            fprintf(stderr, "kernel_launch: unexpected problem (n_in %d, in0 %d, out %d, ws %zu < %zu); nothing launched\n", n_in, n_in > 0 ? in_sizes[0] : -1, out_size, ws_size, (size_t)WS_END); grid = -1; return; }
        int dev = 0, cus = 0;
        if (hipGetDevice(&dev) != hipSuccess || hipDeviceGetAttribute(&cus, hipDeviceAttributeMultiprocessorCount, dev) != hipSuccess) { grid = -1; return; }
        if (hipFuncSetAttribute((const void*)mk_fwd, hipFuncAttributeMaxDynamicSharedMemorySize, LDS_BYTES) != hipSuccess) { fprintf(stderr, "kernel_launch: hipFuncSetAttribute failed\n"); grid = -1; return; }
        int per_cu = 0;
        if (hipOccupancyMaxActiveBlocksPerMultiprocessor(&per_cu, (const void*)mk_fwd, 512, LDS_BYTES) != hipSuccess || per_cu < 1) { fprintf(stderr, "kernel_launch: occupancy query says %d\n", per_cu); }
        (void)hipGetLastError();
        grid = cus > 256 ? 256 : cus;
    }
    if (grid < 0) return;
    (void)hipMemsetAsync((char*)d_ws + WS_CTL, 0, CTL_BYTES, stream);
    Params p{};
    for (int i = 0; i < 27; ++i) p.in[i] = (const float*)d_in[i];
    p.out = (float*)d_out; p.ws = (unsigned char*)d_ws; p.pad0 = 0; p.pad1 = 0;
#if MK_SINGLE
    p.ph_lo = 0; p.ph_hi = NPH;
    hipLaunchKernelGGL(mk_fwd, dim3(grid), dim3(512), LDS_BYTES, stream, p);
#else
#ifndef DBG_NPH
#define DBG_NPH NPH
#endif
    for (int k = 0; k < DBG_NPH; ++k) { p.ph_lo = k; p.ph_hi = k + 1; hipLaunchKernelGGL(mk_fwd, dim3(grid), dim3(512), LDS_BYTES, stream, p); }
#ifdef DBG_DUMP_OFF
    hipLaunchKernelGGL(dbg_dump, dim3(2048), dim3(256), 0, stream, (float*)d_out, (const unsigned char*)d_ws);
#endif
#endif
}
```

```cpp
#include <hip/hip_runtime.h>
#include <cstdio>
#include <cstdint>

#define LAS __attribute__((address_space(3)))
#define DI __device__ __forceinline__
typedef unsigned short bf16_t;
typedef short bf16x8 __attribute__((ext_vector_type(8)));
typedef short s16x4 __attribute__((ext_vector_type(4)));
typedef float f32x4 __attribute__((ext_vector_type(4)));
typedef float f32x2 __attribute__((ext_vector_type(2)));
typedef unsigned u32x4 __attribute__((ext_vector_type(4)));
typedef unsigned u32x2 __attribute__((ext_vector_type(2)));

#ifndef MK_SINGLE
#define MK_SINGLE 1
#endif

constexpr int NTOK = 65536, DM = 1024, SEQ = 8192, NBATCH = 8;
constexpr int NGRP = 2, NG = NTOK / NGRP, GB = NBATCH / NGRP;
constexpr int PLD = 3072;
constexpr int PC_POOL = 0, PC_MQ = 256, PC_MK = 512, PC_MV = 768, PC_DQ = 1024, PC_DK = 1536, PC_DV = 2048, PC_Z = 2560;
constexpr int IN_COLS = 6160;
constexpr int FF = 2816, EFF = 1408, NEXP = 8;
constexpr int MEMLEN = 256;
constexpr float RMS_EPS = 1e-6f;
constexpr int NPH = 1 + 2 * (NGRP * 7 + 3) + 2 + 5;

constexpr size_t MiB = 1u << 20;
constexpr size_t WS_CTL = 0, CTL_BYTES = 1 * MiB;
constexpr size_t LW_WIN = 0, LW_WCAT = LW_WIN + (size_t)6144 * 1024 * 2, LW_WOUT = LW_WCAT + (size_t)1024 * 1024 * 2, LW_WQ = LW_WOUT + (size_t)1024 * 1024 * 2,
                 LW_WKV = LW_WQ + (size_t)512 * 1024 * 2, LW_WO = LW_WKV + (size_t)1024 * 1024 * 2, LW_WBA = LW_WO + (size_t)1024 * 512 * 2, LW_STRIDE = LW_WBA + (size_t)16 * 1024 * 2;
constexpr size_t WS_LW = WS_CTL + CTL_BYTES;
constexpr size_t WS_WGU = WS_LW + 2 * LW_STRIDE;
constexpr size_t WS_WD = WS_WGU + (size_t)2 * FF * 1024 * 2;
constexpr size_t WS_WMGU = WS_WD + (size_t)1024 * FF * 2;
constexpr size_t WS_WMD = WS_WMGU + (size_t)NEXP * 2 * EFF * 1024 * 2;
constexpr size_t WS_WR = WS_WMD + (size_t)NEXP * 1024 * EFF * 2;
constexpr size_t WS_XB = (WS_WR + 8 * 1024 * 4 + MiB - 1) / MiB * MiB;
constexpr size_t WS_SSQ = WS_XB + (size_t)NTOK * 1024 * 2;
constexpr size_t WS_ROPE = WS_SSQ + (size_t)NTOK * 16 * 4;
constexpr size_t WS_MEMN = WS_ROPE + (size_t)NTOK * 16 * 4;
constexpr size_t WS_KVM = WS_MEMN + (size_t)2 * 2048 * 1024 * 2;
constexpr size_t WS_SMALL = WS_KVM + (size_t)2 * 2048 * 1024 * 2;
constexpr int SM_CONVW = 0, SM_ALOG = SM_CONVW + 2 * 4 * 1536, SM_DTB = SM_ALOG + 16, SM_DNG = SM_DTB + 16, SM_FING = SM_DNG + 128, SM_END = SM_FING + 1024;
constexpr size_t WS_X8 = WS_SMALL + 65536;
constexpr size_t WS_WG8 = WS_X8 + (size_t)NTOK * 1024;
constexpr size_t WS_ARENA = WS_WG8 + (size_t)2 * 3072 * 1024;
constexpr size_t AR_P = 0;
constexpr size_t AR_BA = AR_P + (size_t)NG * PLD * 2;
constexpr size_t AR_BR = AR_BA + (size_t)NG * 16 * 4;
constexpr size_t AR_KBAR = AR_BR + (size_t)NG * 1024 * 2;
constexpr size_t AR_VT = AR_KBAR + (size_t)GB * 4 * 32 * 64 * 4;
constexpr int NCH = GB * 128 * 8;
constexpr size_t AR_QD = AR_VT + (size_t)GB * 4 * 64 * SEQ * 2;
constexpr size_t AR_KDT = AR_QD + (size_t)NCH * 8192;
constexpr size_t AR_WN = AR_KDT + (size_t)NCH * 8192;
constexpr size_t AR_UT = AR_WN + (size_t)NCH * 8192;
constexpr size_t AR_AQK = AR_UT + (size_t)NCH * 8192;
constexpr size_t AR_NT = AR_AQK + (size_t)NCH * 8192;
constexpr size_t AR_SG = AR_NT + (size_t)NCH * 8192;
constexpr size_t AR_ZB = AR_SG + (size_t)NCH * 8192;
constexpr size_t AR_GL = AR_ZB + (size_t)NG * 512 * 2;
constexpr size_t AR_SELG = AR_GL + (size_t)NCH * 4 + 65536 - ((size_t)NCH * 4) % 65536;
constexpr size_t AR_CNTG = AR_SELG + (size_t)NG * 4 * 4;
constexpr size_t AR_LISTG = AR_CNTG + (size_t)GB * 4 * 32 * 32 * 4;
constexpr size_t AR_OPG = AR_LISTG + (size_t)GB * 4 * 32 * 32 * 256;
constexpr size_t AR_MLG = AR_OPG + (size_t)NG * 4 * 4 * 64 * 2;
constexpr size_t AR_MERGED = AR_MLG + (size_t)NG * 4 * 4 * 2 * 4;
constexpr size_t AR_MIX_END = AR_MERGED + (size_t)NG * 1024 * 2;
constexpr size_t AR_QX = 0, AR_AO = AR_QX + (size_t)NTOK * 512 * 2, AR_XA_END = AR_AO + (size_t)NTOK * 512 * 2;
constexpr size_t AR_HID = 0, AR_HID_END = (size_t)NTOK * FF * 2;
constexpr int MOE_ROWS = 2 * NTOK + 2048;
constexpr size_t AR_TE = 0, AR_TW = AR_TE + (size_t)NTOK * 8, AR_RR = AR_TW + (size_t)NTOK * 8, AR_POS = AR_RR + (size_t)NTOK * 4, AR_CNT = AR_POS + (size_t)NTOK * 8,
                 AR_XP = AR_CNT + 65536, AR_RP = AR_XP + (size_t)MOE_ROWS * 1024 * 2, AR_HM = AR_RP + (size_t)MOE_ROWS * 4 + 65536 - ((size_t)MOE_ROWS * 4) % 65536,
                 AR_MOE_END = AR_HM + (size_t)MOE_ROWS * EFF * 2;
constexpr size_t cmax(size_t a, size_t b) { return a > b ? a : b; }
constexpr size_t WS_END = WS_ARENA + cmax(cmax(AR_MIX_END, AR_XA_END), cmax(AR_HID_END, AR_MOE_END));
static_assert(AR_XA_END <= AR_MERGED, "xattn buffers must not overlap MERGED");
static_assert(SM_END * 4 <= 65536, "small-vector block");
static_assert(WS_END <= (size_t)1073741824, "workspace map exceeds 1 GiB");

constexpr int LDS_BYTES = 160 * 1024;
constexpr int LDS_MISC = 158 * 1024;

DI float bf2f(unsigned short b) { return __uint_as_float(((unsigned)b) << 16); }
DI unsigned f2bf(float f) { unsigned u = __float_as_uint(f); return (u + 0x7fffu + ((u >> 16) & 1u)) >> 16; }
DI unsigned pk2(float lo, float hi) { return f2bf(lo) | (f2bf(hi) << 16); }
typedef __bf16 bf16v2_t __attribute__((ext_vector_type(2)));
DI unsigned cvt_pk_bf16(float lo, float hi) { bf16v2_t v; v.x = (__bf16)lo; v.y = (__bf16)hi; return __builtin_bit_cast(unsigned, v); }
DI unsigned cvt4_fp8(float a, float b, float c, float d) { unsigned w = 0u; w = __builtin_amdgcn_cvt_pk_fp8_f32(a, b, w, false); w = __builtin_amdgcn_cvt_pk_fp8_f32(c, d, w, true); return w; }
DI float wave_sum(float v) {
#pragma unroll
    for (int o = 1; o < 64; o <<= 1) v += __shfl_xor(v, o);
    return v;
}
DI float fsigmoid(float x) { return __builtin_amdgcn_rcpf(1.0f + __builtin_amdgcn_exp2f(-1.44269504089f * x)); }
DI float row_rstd(const float* ssqp, int row) {
    const f32x4* p = (const f32x4*)(ssqp + (size_t)row * 16);
    const f32x4 a = p[0], b = p[1], c = p[2], d = p[3];
    const float s = (((a.x + a.y) + (a.z + a.w)) + ((b.x + b.y) + (b.z + b.w))) + (((c.x + c.y) + (c.z + c.w)) + ((d.x + d.y) + (d.z + d.w)));
    return rsqrtf(s * (1.0f / 1024.0f) + RMS_EPS);
}
#define LAUNDER_V(x) asm volatile("" : "+v"(x))
#define LDS_WAIT() asm volatile("s_waitcnt lgkmcnt(0)" ::: "memory")
#define VM_WAIT() asm volatile("s_waitcnt vmcnt(0)" ::: "memory")
#define WG_BAR() do { asm volatile("s_waitcnt lgkmcnt(0)" ::: "memory"); __builtin_amdgcn_s_barrier(); asm volatile("" ::: "memory"); } while (0)
#define MFMA16(a, b, c) __builtin_amdgcn_mfma_f32_16x16x32_bf16((a), (b), (c), 0, 0, 0)

#define XB_TMO      128
#define XB_XCNT(j)  (256  + 64 * (j))
#define XB_XSUB(j)  (1280 + 64 * (j))
#define XB_XGEN(j)  (2304 + 64 * (j))
#define XB_TOP      3328
#define XB_TOPGEN   3392
#define XCD_BAR_WORDS 3456
#define XB_SPIN_CAP (1u << 22)

DI unsigned xb_ld(unsigned* p)              { return __hip_atomic_load(p, __ATOMIC_RELAXED, __HIP_MEMORY_SCOPE_AGENT); }
DI unsigned xb_add(unsigned* p, unsigned v) { return __hip_atomic_fetch_add(p, v, __ATOMIC_RELAXED, __HIP_MEMORY_SCOPE_AGENT); }
DI unsigned xb_xcc_id() { return (unsigned)__builtin_amdgcn_s_getreg((3 << 11) | 20) & 0xFu; }
#define XB_SPIN(cond, bar) do { unsigned _sp = 0; while (cond) { __builtin_amdgcn_s_sleep(1); \
    if ((++_sp & 255u) == 0u) { if (xb_ld(&(bar)[XB_TMO])) break; if (_sp > XB_SPIN_CAP) { atomicAdd(&(bar)[XB_TMO], 1u); break; } } } } while (0)

struct XcdBarrier { unsigned* bar; unsigned x; volatile LAS unsigned* st; };

DI XcdBarrier xcd_barrier_post(unsigned* bar, volatile LAS unsigned* st) {
    XcdBarrier b; b.bar = bar; b.x = xb_xcc_id(); b.st = st;
    if (threadIdx.x == 0) (void)xb_add(&bar[XB_XCNT(b.x)], 1u);
    return b;
}
DI void xcd_barrier_complete(unsigned* bar, unsigned x, unsigned& nloc, unsigned& nx) {
    const unsigned G = gridDim.x * gridDim.y * gridDim.z;
    unsigned sum, cnt, mine, sp = 0u;
    for (;;) {
        sum = 0u; cnt = 0u; mine = 0u;
#pragma unroll
        for (unsigned j = 0; j < 16; ++j) { const unsigned c = xb_ld(&bar[XB_XCNT(j)]); sum += c; cnt += (c > 0u) ? 1u : 0u; mine = (j == x) ? c : mine; }
        if (sum == G) break;
        __builtin_amdgcn_s_sleep(1);
        if ((++sp & 255u) == 0u) { if (xb_ld(&bar[XB_TMO])) break; if (sp > XB_SPIN_CAP) { atomicAdd(&bar[XB_TMO], 1u); break; } }
    }
    nloc = mine > 0u ? mine : 1u; nx = cnt > 0u ? cnt : 1u;
}
DI void xcd_barrier(const XcdBarrier& b) {
    asm volatile("s_waitcnt vmcnt(0)" ::: "memory");
    __syncthreads();
    if (threadIdx.x == 0) {
        unsigned* bar = b.bar;
        __builtin_amdgcn_s_waitcnt(0);
        unsigned nloc = b.st[0], nx = b.st[1];
        if (nloc == 0u) { xcd_barrier_complete(bar, b.x, nloc, nx); b.st[0] = nloc; b.st[1] = nx; }
        const unsigned old = xb_add(&bar[XB_XSUB(b.x)], 1u);
        const unsigned gen = old / nloc;
        if (old + 1u == (gen + 1u) * nloc) {
            __builtin_amdgcn_fence(__ATOMIC_RELEASE, "agent");
            asm volatile("s_waitcnt vmcnt(0)" ::: "memory");
            const unsigned og = xb_add(&bar[XB_TOP], 1u);
            const unsigned tg = og / nx;
            if (og + 1u == (tg + 1u) * nx) xb_add(&bar[XB_TOPGEN], 1u);
            else XB_SPIN(xb_ld(&bar[XB_TOPGEN]) == tg, bar);
            __builtin_amdgcn_fence(__ATOMIC_ACQUIRE, "agent");
            xb_add(&bar[XB_XGEN(b.x)], 1u);
            asm volatile("s_waitcnt vmcnt(0)" ::: "memory");
        } else {
            XB_SPIN(xb_ld(&bar[XB_XGEN(b.x)]) == gen, bar);
            __builtin_amdgcn_fence(__ATOMIC_ACQUIRE, "agent");
            asm volatile("s_waitcnt vmcnt(0)" ::: "memory");
        }
    }
    __syncthreads();
}
namespace pg8 {
constexpr int BM = 256, BK = 64, HALF = 128, HTB = HALF * BK * 2, STAGE_BYTES = 8 * HTB, NXCD = 8, WGM = 8;
__host__ __device__ __forceinline__ int lds_byte(int r, int c) { const int st = (r >> 4) * 2 + (c >> 5), rr = r & 15, cc = c & 31, ob = rr * 64 + cc * 2; return st * 1024 + (ob ^ (((ob >> 9) & 1) << 5)); }
__host__ __device__ __forceinline__ void stage_rc(int b, int& R, int& C) { const int st = b / 1024, sb = b % 1024, swz = sb ^ (((sb >> 9) & 1) << 5); R = (st >> 1) * 16 + swz / 64; C = (st & 1) * 32 + (swz % 64) / 2; }
__host__ __device__ __forceinline__ int perm32(int rho) { const int n = rho >> 4, i = rho & 15; return 8 * (i >> 2) + 4 * n + (i & 3); }

struct Unit { int pm, pn, nt, tag, ord; size_t aoff, boff; };
struct Gemm { const bf16_t* A; const bf16_t* Bt; int lda, ldb; };

struct TileOrder {
    int nM, nN, nwg, G, c;
    DI void init(int nM_, int nN_, int G_, int c_) { nM = nM_; nN = nN_; nwg = nM * nN; G = G_; c = c_; }
    DI bool tile(int i, int& pm, int& pn) const {
        const long L = (long)i * G + c; if (L >= nwg) return false;
        int wgid = (int)L; { const int q = nwg / NXCD, r = nwg % NXCD, xcd = wgid % NXCD, off = wgid / NXCD; wgid = (xcd < r ? xcd * (q + 1) : r * (q + 1) + (xcd - r) * q) + off; }
        const int nig = WGM * nN, gid = wgid / nig, fm = gid * WGM, gsz = (nM - fm) < WGM ? (nM - fm) : WGM;
        pm = fm + ((wgid % nig) % gsz); pn = (wgid % nig) / gsz; return true;
    }
};
struct SchedPlain {
    TileOrder T; int nt; size_t astep, bstep;
    DI void init(int M, int N, int K, int lda, int ldb, int G, int c, int esz = 2) { T.init(M / BM, N / BM, G, c); nt = K * esz / (BK * 2); astep = (size_t)BM * lda * esz; bstep = (size_t)BM * ldb * esz; }
    DI bool next(int i, Unit& u) const { if (!T.tile(i, u.pm, u.pn)) return false; u.nt = nt; u.tag = 0; u.ord = i; u.aoff = (size_t)u.pm * astep; u.boff = (size_t)u.pn * bstep; return true; }
};
struct SchedMerge {
    TileOrder T; size_t astep, bstep;
    DI void init(int M, int N, int lda, int ldb, int G, int c) { T.init(M / BM, N / BM, G, c); astep = (size_t)BM * lda * 2; bstep = (size_t)BM * ldb * 2; }
    DI bool next(int i, Unit& u) const {
        const int ti = i / 3, br = i - 3 * ti; if (!T.tile(ti, u.pm, u.pn)) return false;
        const int kofs = br == 0 ? 0 : (br == 1 ? 256 : 512);
        u.nt = br == 2 ? 8 : 4; u.tag = br; u.aoff = (size_t)u.pm * astep + (size_t)kofs * 2; u.boff = (size_t)u.pn * bstep + (size_t)kofs * 2; return true;
    }
};
struct SchedKV {
    int c; size_t lstride;
    DI bool next(int i, Unit& u) const {
        if (i != 0 || c < 0 || c >= 64) return false;
        const int layer = c >> 5, r = c & 31; u.pm = layer * 8 + (r >> 2); u.pn = r & 3; u.nt = 16; u.tag = 0; u.ord = 0;
        u.aoff = (size_t)u.pm * BM * 1024 * 2; u.boff = (size_t)layer * lstride + (size_t)u.pn * BM * 1024 * 2; return true;
    }
};
struct SchedMoe {
    int pbase[9]; int nN, nt, G, c; size_t astep, bstep, estep;
    DI bool next(int i, Unit& u) const {
        const long L = (long)i * G + c; const int tot = pbase[8] * nN; if (L >= tot) return false;
        const int gp = (int)(L / nN), pn = (int)(L - (long)gp * nN);
        int e = 0;
#pragma unroll
        for (int j = 1; j < 8; ++j) e += (gp >= pbase[j]) ? 1 : 0;
        u.pm = gp; u.pn = pn; u.nt = nt; u.tag = e; u.ord = i; u.aoff = (size_t)gp * astep; u.boff = (size_t)e * estep + (size_t)pn * bstep; return true;
    }
};

constexpr int RTAB_OFF = STAGE_BYTES, RTAB_MAX_UNITS = 26;
template <class Sched> DI void build_rtab(LAS unsigned char* lds, const Sched& S, const float* ssqp, const float* rvec, int tid) {
    LAS float* rt = (LAS float*)(lds + RTAB_OFF); Unit u;
    for (int i = tid >> 8; S.next(i, u); i += 2) { if (i >= RTAB_MAX_UNITS) break; const int r = tid & 255, row = u.pm * BM + r; rt[i * 256 + r] = rvec ? rvec[row] : row_rstd(ssqp, row); }
    __syncthreads();
}
struct EpiScaleBf16 { static constexpr bool MID = false;
    bf16_t* O; int ldo; const float* ssqp; int act; bf16_t* O2; int ldo2, pn2; const LAS float* rtab;
    DI void operator()(const f32x4 (&acc)[2][2][4][2], const Unit& u, int wr, int wc, int fr, int fq) const {
        const bool alt = u.pn >= pn2; bf16_t* const Ob = alt ? O2 : O; const int ld = alt ? ldo2 : ldo;
        const int row0 = u.pm * BM + wr * 64 + fr, col0 = (alt ? u.pn - pn2 : u.pn) * BM + wc * 32 + 8 * fq;
#pragma unroll
        for (int ai = 0; ai < 2; ++ai)
#pragma unroll
            for (int m = 0; m < 4; ++m) { const int row = row0 + ai * HALF + m * 16; const float r = ssqp ? rtab[u.ord * 256 + (row & 255)] : 1.0f; bf16_t* rowp = Ob + (size_t)row * ld + col0;
#pragma unroll
                for (int bj = 0; bj < 2; ++bj) { f32x4 v0 = acc[ai][bj][m][0] * r, v1 = acc[ai][bj][m][1] * r;
                    if (act) {
#pragma unroll
                        for (int j = 0; j < 4; ++j) { v0[j] = fsigmoid(v0[j]); v1[j] = fsigmoid(v1[j]); } }
                    u32x4 w; w.x = cvt_pk_bf16(v0[0], v0[1]); w.y = cvt_pk_bf16(v0[2], v0[3]); w.z = cvt_pk_bf16(v1[0], v1[1]); w.w = cvt_pk_bf16(v1[2], v1[3]);
                    *(u32x4*)(rowp + bj * HALF) = w; } }
    }
};
struct EpiResid { static constexpr bool MID = false;
    bf16_t* xb; float* ssqp; unsigned char* x8;
    DI void operator()(const f32x4 (&acc)[2][2][4][2], const Unit& u, int wr, int wc, int fr, int fq) const {
        const int row0 = u.pm * BM + wr * 64 + fr, col0 = u.pn * BM + wc * 32 + 8 * fq;
#pragma unroll
        for (int ai = 0; ai < 2; ++ai)
#pragma unroll
            for (int m = 0; m < 4; ++m) { const int row = row0 + ai * HALF + m * 16; const size_t off = (size_t)row * 1024 + col0; float ss = 0.f;
#pragma unroll
                for (int bj = 0; bj < 2; ++bj) {
                    const u32x4 xo = *(const u32x4*)(xb + off + bj * HALF);
                    f32x4 x0 = (f32x4){__uint_as_float(xo.x << 16), __uint_as_float(xo.x & 0xffff0000u), __uint_as_float(xo.y << 16), __uint_as_float(xo.y & 0xffff0000u)};
                    f32x4 x1 = (f32x4){__uint_as_float(xo.z << 16), __uint_as_float(xo.z & 0xffff0000u), __uint_as_float(xo.w << 16), __uint_as_float(xo.w & 0xffff0000u)};
                    x0 += acc[ai][bj][m][0]; x1 += acc[ai][bj][m][1];
                    u32x4 w; w.x = cvt_pk_bf16(x0[0], x0[1]); w.y = cvt_pk_bf16(x0[2], x0[3]); w.z = cvt_pk_bf16(x1[0], x1[1]); w.w = cvt_pk_bf16(x1[2], x1[3]);
                    *(u32x4*)(xb + off + bj * HALF) = w;
                    { u32x2 w8; w8.x = cvt4_fp8(x0[0], x0[1], x0[2], x0[3]); w8.y = cvt4_fp8(x1[0], x1[1], x1[2], x1[3]); *(u32x2*)(x8 + off + bj * HALF) = w8; }
                    ss += (x0[0] * x0[0] + x0[1] * x0[1]) + (x0[2] * x0[2] + x0[3] * x0[3]) + (x1[0] * x1[0] + x1[1] * x1[1]) + (x1[2] * x1[2] + x1[3] * x1[3]); }
                ss += __shfl_xor(ss, 16); ss += __shfl_xor(ss, 32);
                if (fq == 0) ssqp[(size_t)row * 16 + u.pn * 4 + wc] = ss; }
    }
};
struct EpiSwiglu { static constexpr bool MID = false;
    bf16_t* H; int ldh; const LAS float* rtab;
    DI void operator()(const f32x4 (&acc)[2][2][4][2], const Unit& u, int wr, int wc, int fr, int fq) const {
        const int row0 = u.pm * BM + wr * 64 + fr, col0 = u.pn * HALF + wc * 32 + 8 * fq;
#pragma unroll
        for (int ai = 0; ai < 2; ++ai)
#pragma unroll
            for (int m = 0; m < 4; ++m) { const int row = row0 + ai * HALF + m * 16; const float r = rtab[u.ord * 256 + (row & 255)];
                f32x4 h0, h1;
#pragma unroll
                for (int j = 0; j < 4; ++j) { const float g0 = acc[ai][0][m][0][j] * r, g1 = acc[ai][0][m][1][j] * r;
                    h0[j] = g0 * fsigmoid(g0) * (acc[ai][1][m][0][j] * r); h1[j] = g1 * fsigmoid(g1) * (acc[ai][1][m][1][j] * r); }
                u32x4 w; w.x = cvt_pk_bf16(h0[0], h0[1]); w.y = cvt_pk_bf16(h0[2], h0[3]); w.z = cvt_pk_bf16(h1[0], h1[1]); w.w = cvt_pk_bf16(h1[2], h1[3]);
                *(u32x4*)(H + (size_t)row * ldh + col0) = w; }
    }
};
struct EpiMerge { static constexpr bool MID = true;
    const bf16_t* gates; bf16_t* merged;
    static DI float gclamp(unsigned hi_bits) { return fmaxf(__uint_as_float(hi_bits), 1e-30f); }
    DI void mid(f32x4 (&acc)[2][2][4][2], const Unit& u, int seg, int wr, int wc, int fr, int fq) const {
        int row0 = u.pm * BM + wr * 64 + fr, col0 = u.pn * BM + wc * 32 + 8 * fq; LAUNDER_V(row0); LAUNDER_V(col0);
#pragma unroll
        for (int ai = 0; ai < 2; ++ai)
#pragma unroll
            for (int mp = 0; mp < 2; ++mp) {
                u32x4 ga[2][2], gb[2][2];
#pragma unroll
                for (int mm = 0; mm < 2; ++mm)
#pragma unroll
                    for (int bj = 0; bj < 2; ++bj) { const bf16_t* gp = gates + (size_t)(row0 + ai * HALF + (2 * mp + mm) * 16) * PLD + seg * 1024 + col0 + bj * HALF; ga[mm][bj] = *(const u32x4*)gp; gb[mm][bj] = *(const u32x4*)(gp + 1024); }
                __builtin_amdgcn_sched_barrier(0);
#pragma unroll
                for (int mm = 0; mm < 2; ++mm)
#pragma unroll
                    for (int bj = 0; bj < 2; ++bj) {
#pragma unroll
                        for (int j = 0; j < 4; ++j) { const int m = 2 * mp + mm;
                            const float r_lo = gclamp(ga[mm][bj][j] << 16) * __builtin_amdgcn_rcpf(gclamp(gb[mm][bj][j] << 16)), r_hi = gclamp(ga[mm][bj][j] & 0xffff0000u) * __builtin_amdgcn_rcpf(gclamp(gb[mm][bj][j] & 0xffff0000u));
                            acc[ai][bj][m][j >> 1][(2 * j) & 3] *= r_lo; acc[ai][bj][m][j >> 1][(2 * j + 1) & 3] *= r_hi; }
                        __builtin_amdgcn_sched_barrier(0); }
            }
    }
    DI void operator()(const f32x4 (&acc)[2][2][4][2], const Unit& u, int wr, int wc, int fr, int fq) const {
        const int row0 = u.pm * BM + wr * 64 + fr, col0 = u.pn * BM + wc * 32 + 8 * fq;
#pragma unroll
        for (int ai = 0; ai < 2; ++ai)
#pragma unroll
            for (int m = 0; m < 4; ++m) { const int row = row0 + ai * HALF + m * 16;
#pragma unroll
                for (int bj = 0; bj < 2; ++bj) {
                    const u32x4 gv = *(const u32x4*)(gates + (size_t)row * PLD + 2 * 1024 + col0 + bj * HALF);
                    float v[8];
#pragma unroll
                    for (int j = 0; j < 4; ++j) { v[2 * j] = gclamp(gv[j] << 16); v[2 * j + 1] = gclamp(gv[j] & 0xffff0000u); }
#pragma unroll
                    for (int j = 0; j < 4; ++j) { v[j] *= acc[ai][bj][m][0][j]; v[4 + j] *= acc[ai][bj][m][1][j]; }
                    u32x4 w; w.x = cvt_pk_bf16(v[0], v[1]); w.y = cvt_pk_bf16(v[2], v[3]); w.z = cvt_pk_bf16(v[4], v[5]); w.w = cvt_pk_bf16(v[6], v[7]);
                    *(u32x4*)(merged + (size_t)row * 1024 + col0 + bj * HALF) = w; } }
    }
};

template <class Epi, class Sched, bool F8 = false>
DI void gemm_phase(LAS unsigned char* lds, const Gemm g, const Sched& S, const Epi& E, int wave_id) {
    int tid_ = (int)__builtin_amdgcn_mbcnt_hi(~0u, __builtin_amdgcn_mbcnt_lo(~0u, 0u)) + 64 * wave_id; asm volatile("" : "+v"(tid_));
    const int tid = tid_, wid = __builtin_amdgcn_readfirstlane(tid >> 6), lane = tid & 63, wr = wid >> 2, wc = wid & 3, fr = lane & 15, fq = lane >> 4;
    unsigned voffA[2], voffB[2];
#pragma unroll
    for (int i = 0; i < 2; ++i) { int R, C; stage_rc(tid * 16 + i * 8192, R, C); const int Rb = (R & ~31) + perm32(R & 31);
        voffA[i] = F8 ? (unsigned)(R * g.lda + 2 * C) : (unsigned)(R * g.lda + C) * 2u; voffB[i] = F8 ? (unsigned)(Rb * g.ldb + 2 * C) : (unsigned)(Rb * g.ldb + C) * 2u; }
    const size_t kstep = (size_t)(BK * 2);
    const size_t hstepA = (size_t)HALF * g.lda * (F8 ? 1 : 2), hstepB = (size_t)HALF * g.ldb * (F8 ? 1 : 2);
    const unsigned ldsw = (unsigned)wid * 1024u;
    const int aoff = lds_byte(wr * 64 + fr, fq * 8), boff = lds_byte(wc * 32 + fr, fq * 8);
#define PG8_SA(b, h) (((b) * 2 + (h)) * HTB)
#define PG8_SB(b, h) ((4 + (b) * 2 + (h)) * HTB)
#define PG8_STAGE(bufoff, gbase, voff) do { _Pragma("unroll") for (int _i = 0; _i < 2; ++_i) \
        __builtin_amdgcn_global_load_lds((const unsigned*)((const char*)(gbase) + (voff)[_i]), (LAS unsigned*)(lds + (bufoff) + ldsw + _i * 8192), 16, 0, 0); } while (0)
#define PG8_LDA(dst, b, h) do { _Pragma("unroll") for (int m = 0; m < 4; ++m) { const v4i_t l0_ = *(const LAS v4i_t*)(lds + PG8_SA(b, h) + aoff + m * 2048), l1_ = *(const LAS v4i_t*)(lds + PG8_SA(b, h) + aoff + m * 2048 + 1024); \
        dst[m] = __builtin_shufflevector(l0_, l1_, 0, 1, 2, 3, 4, 5, 6, 7); } } while (0)
#define PG8_LDB(dst, b, h) do { _Pragma("unroll") for (int n = 0; n < 2; ++n) { const v4i_t l0_ = *(const LAS v4i_t*)(lds + PG8_SB(b, h) + boff + n * 2048), l1_ = *(const LAS v4i_t*)(lds + PG8_SB(b, h) + boff + n * 2048 + 1024); \
        dst[n] = __builtin_shufflevector(l0_, l1_, 0, 1, 2, 3, 4, 5, 6, 7); } } while (0)
#define PG8_MMA(ai, bj, At, Bt) do { __builtin_amdgcn_s_setprio(1); _Pragma("unroll") for (int m = 0; m < 4; ++m) _Pragma("unroll") for (int n = 0; n < 2; ++n) { \
        if constexpr (F8) asm volatile("v_mfma_scale_f32_16x16x128_f8f6f4 %0, %1, %2, %0, %3, %4 op_sel_hi:[0,0,0]" : "+v"(acc[ai][bj][m][n]) : "v"(Bt[n]), "v"(At[m]), "v"(f8scale_w), "v"(f8scale_x));   \
        else { const bf16x8 b0_ = __builtin_bit_cast(bf16x8, __builtin_shufflevector(Bt[n], Bt[n], 0, 1, 2, 3)), b1_ = __builtin_bit_cast(bf16x8, __builtin_shufflevector(Bt[n], Bt[n], 4, 5, 6, 7)), \
                            a0_ = __builtin_bit_cast(bf16x8, __builtin_shufflevector(At[m], At[m], 0, 1, 2, 3)), a1_ = __builtin_bit_cast(bf16x8, __builtin_shufflevector(At[m], At[m], 4, 5, 6, 7)); \
            acc[ai][bj][m][n] = __builtin_amdgcn_mfma_f32_16x16x32_bf16(b0_, a0_, acc[ai][bj][m][n], 0, 0, 0); acc[ai][bj][m][n] = __builtin_amdgcn_mfma_f32_16x16x32_bf16(b1_, a1_, acc[ai][bj][m][n], 0, 0, 0); } } \
        __builtin_amdgcn_s_setprio(0); } while (0)
#define PG8_WAIT_V(n) asm volatile("s_waitcnt vmcnt(" #n ")" ::: "memory")
#define PG8_WAIT_L(n) asm volatile("s_waitcnt lgkmcnt(" #n ")" ::: "memory")
#define PG8_BAR __builtin_amdgcn_s_barrier()
#define PG8_SCHED __builtin_amdgcn_sched_barrier(0)
    Unit cur, nxt; int ui = 0;
    if (!S.next(0, cur)) return;
    f32x4 acc[2][2][4][2];
#pragma unroll
    for (int a = 0; a < 2; ++a)
#pragma unroll
        for (int b = 0; b < 2; ++b)
#pragma unroll
            for (int m = 0; m < 4; ++m)
#pragma unroll
                for (int n = 0; n < 2; ++n) acc[a][b][m][n] = (f32x4){0.f, 0.f, 0.f, 0.f};
    typedef int v8i_t __attribute__((ext_vector_type(8))); typedef int v4i_t __attribute__((ext_vector_type(4)));
    const int f8scale_w = 0x7a7a7a7a, f8scale_x = 0x7f7f7f7f;
    v8i_t At[4], B0[2], B1[2];
    const char* cA = (const char*)g.A + cur.aoff; const char* cB = (const char*)g.Bt + cur.boff;
    PG8_STAGE(PG8_SB(0, 0), cB, voffB); PG8_STAGE(PG8_SB(0, 1), cB + hstepB, voffB); PG8_STAGE(PG8_SA(0, 0), cA, voffA); PG8_STAGE(PG8_SA(0, 1), cA + hstepA, voffA);
    if (wr == 1) PG8_BAR;
    PG8_WAIT_V(2); PG8_BAR;
    PG8_STAGE(PG8_SB(1, 0), cB + kstep, voffB); PG8_STAGE(PG8_SA(1, 0), cA + kstep, voffA); PG8_STAGE(PG8_SB(1, 1), cB + hstepB + kstep, voffB);
    PG8_WAIT_V(6); PG8_BAR;
    for (;;) {
        const bool has_next = S.next(ui + 1, nxt);
        const int nt = cur.nt;
        const char* nA = has_next ? (const char*)g.A + nxt.aoff : cA; const char* nB = has_next ? (const char*)g.Bt + nxt.boff : cB;
        for (int t = 0; t < nt; t += 2) {
            if constexpr (Epi::MID) { if (t == 4 || t == 8) { E.mid(acc, cur, t >> 3, wr, wc, fr, fq); } __builtin_amdgcn_sched_barrier(0); }
            const bool last = (t == nt - 2);
            const char* a1 = cA + (size_t)(t + 1) * kstep;
            const char* a2 = last ? nA : cA + (size_t)(t + 2) * kstep; const char* b2 = last ? nB : cB + (size_t)(t + 2) * kstep;
            const char* a3 = a2 + kstep; const char* b3 = b2 + kstep;
            PG8_LDB(B0, 0, 0); PG8_LDB(B1, 0, 1); PG8_SCHED; PG8_LDA(At, 0, 0); PG8_STAGE(PG8_SA(1, 1), a1 + hstepA, voffA);
            PG8_WAIT_V(8); PG8_WAIT_L(0); PG8_BAR; PG8_MMA(0, 0, At, B0); PG8_MMA(0, 1, At, B1); PG8_BAR; PG8_SCHED;
            PG8_LDA(At, 0, 1); PG8_STAGE(PG8_SB(0, 0), b2, voffB); PG8_STAGE(PG8_SB(0, 1), b2 + hstepB, voffB); PG8_STAGE(PG8_SA(0, 0), a2, voffA);
            PG8_WAIT_V(8); PG8_WAIT_L(0); PG8_BAR; PG8_MMA(1, 0, At, B0); PG8_MMA(1, 1, At, B1); PG8_BAR; PG8_SCHED;
            PG8_LDB(B0, 1, 0); PG8_LDB(B1, 1, 1); PG8_SCHED; PG8_LDA(At, 1, 0); PG8_STAGE(PG8_SA(0, 1), a2 + hstepA, voffA);
            PG8_WAIT_V(8); PG8_WAIT_L(0); PG8_BAR; PG8_MMA(0, 0, At, B0); PG8_MMA(0, 1, At, B1); PG8_BAR; PG8_SCHED;
            PG8_LDA(At, 1, 1); PG8_STAGE(PG8_SB(1, 0), b3, voffB); PG8_STAGE(PG8_SB(1, 1), b3 + hstepB, voffB); PG8_STAGE(PG8_SA(1, 0), a3, voffA);
            PG8_WAIT_V(8); PG8_WAIT_L(0); PG8_BAR; PG8_MMA(1, 0, At, B0); PG8_MMA(1, 1, At, B1); PG8_BAR; PG8_SCHED;
        }
        if (wr == 0) PG8_BAR;
        E(acc, cur, wr, wc, fr, fq);
        if (!has_next) break;
#pragma unroll
        for (int a = 0; a < 2; ++a)
#pragma unroll
            for (int b = 0; b < 2; ++b)
#pragma unroll
                for (int m = 0; m < 4; ++m)
#pragma unroll
                    for (int n = 0; n < 2; ++n) acc[a][b][m][n] = (f32x4){0.f, 0.f, 0.f, 0.f};
        cur = nxt; cA = nA; cB = nB; ++ui;
        if (wr == 1) PG8_BAR;
    }
    PG8_WAIT_V(0);
    PG8_BAR;
#undef PG8_SA
#undef PG8_SB
#undef PG8_STAGE
#undef PG8_LDA
#undef PG8_LDB
#undef PG8_MMA
#undef PG8_WAIT_V
#undef PG8_WAIT_L
#undef PG8_BAR
#undef PG8_SCHED
}
}
struct Params { const float* in[27]; float* out; unsigned char* ws; int ph_lo, ph_hi, pad0, pad1; };
enum { I_X = 0, I_MEM, I_POS, I_MIXG, I_WIN, I_POOLW, I_POOLS, I_CONVW, I_ALOG, I_DTB, I_DNG, I_WUPP, I_WUPM, I_WUPD, I_WOUT, I_XAG, I_MEMG, I_XAQ, I_XAKV, I_XAO,
       I_FFNG, I_DGU, I_DD, I_ROUTER, I_MGU, I_MD, I_FING };

struct Frame {
    LAS unsigned char* lds;
    int tid, lane, wave, G, blk;
    unsigned char* ws;
};

struct Job { const float* W; int K, N; bf16_t* WT; int ldt; int mode; int ff; const float* kscale; unsigned char* WT8; };
DI int job_map(int mode, int ff, int n) {
    if (mode == 0) return n;
    if (mode == 1) return n < 2560 ? n : (n < 2576 ? -1 : n - 16);
    if (n < ff) return (n >> 7) * 256 + (n & 127);
    const int m = n - ff; return (m >> 7) * 256 + 128 + (m & 127);
}
DI int job_items(const Job& J) { return (J.K / 64) * ((J.N + 31) / 32); }
DI void transpose_item(const Job& J, LAS float* scr, int item, int lane) {
    const int nblk = (J.N + 31) / 32, kb = item / nblk, nb = item - kb * nblk, k0 = 64 * kb, n0 = 32 * nb;
    const int nn = lane & 31; const bool ok = (n0 + nn) < J.N;
    float tv[32];
#pragma unroll
    for (int i = 0; i < 32; ++i) { const int kk = 2 * i + (lane >> 5); tv[i] = J.W[(size_t)(k0 + kk) * J.N + (ok ? n0 + nn : 0)]; }
#pragma unroll
    for (int i = 0; i < 32; ++i) { const int kk = 2 * i + (lane >> 5); float v = ok ? tv[i] : 0.f; if (J.kscale) v *= J.kscale[k0 + kk]; scr[kk * 33 + nn] = v; }
    LDS_WAIT();
    const int c = lane & 7;
#pragma unroll
    for (int j = 0; j < 4; ++j) { const int n = (lane >> 3) + 8 * j; const int sn = n0 + n; const int drow = sn < J.N ? job_map(J.mode, J.ff, sn) : -1;
        if (drow >= 0) { const LAS float* s = scr + (8 * c) * 33 + n;
            if (J.mode == 1 && drow >= 3072) { u32x2 o;
                o.x = cvt4_fp8(s[0 * 33] * 32.f, s[1 * 33] * 32.f, s[2 * 33] * 32.f, s[3 * 33] * 32.f); o.y = cvt4_fp8(s[4 * 33] * 32.f, s[5 * 33] * 32.f, s[6 * 33] * 32.f, s[7 * 33] * 32.f);
                *(u32x2*)(J.WT8 + (size_t)(drow - 3072) * 1024 + k0 + 8 * c) = o; }
            else { u32x4 o; o.x = pk2(s[0 * 33], s[1 * 33]); o.y = pk2(s[2 * 33], s[3 * 33]); o.z = pk2(s[4 * 33], s[5 * 33]); o.w = pk2(s[6 * 33], s[7 * 33]);
                *(u32x4*)(J.WT + (size_t)drow * J.ldt + k0 + 8 * c) = o; } } }
    LDS_WAIT();
}
constexpr int NJOBS = 2 * 7 + 2 + 16;
DI void get_job(const Frame& F, const Params& P, int j, Job& J) {
    unsigned char* ws = F.ws;
    J.mode = 0; J.ff = 0; J.kscale = nullptr; J.WT8 = nullptr;
    if (j < 14) { const int l = j / 7, t = j - 7 * l; unsigned char* lw = ws + WS_LW + (size_t)l * LW_STRIDE;
        if (t == 0) { J.W = P.in[I_WIN] + (size_t)l * 1024 * IN_COLS; J.K = 1024; J.N = IN_COLS; J.WT = (bf16_t*)(lw + LW_WIN); J.ldt = 1024; J.mode = 1; J.kscale = P.in[I_MIXG] + l * 1024; J.WT8 = ws + WS_WG8 + (size_t)l * 3072 * 1024; }
        else if (t == 1) { J.W = P.in[I_WUPM] + (size_t)l * 256 * 1024; J.K = 256; J.N = 1024; J.WT = (bf16_t*)(lw + LW_WCAT) + 256; J.ldt = 1024; }
        else if (t == 2) { J.W = P.in[I_WUPD] + (size_t)l * 512 * 1024; J.K = 512; J.N = 1024; J.WT = (bf16_t*)(lw + LW_WCAT) + 512; J.ldt = 1024; }
        else if (t == 3) { J.W = P.in[I_WOUT] + (size_t)l * 1024 * 1024; J.K = 1024; J.N = 1024; J.WT = (bf16_t*)(lw + LW_WOUT); J.ldt = 1024; }
        else if (t == 4) { J.W = P.in[I_XAQ] + (size_t)l * 1024 * 512; J.K = 1024; J.N = 512; J.WT = (bf16_t*)(lw + LW_WQ); J.ldt = 1024; J.kscale = P.in[I_XAG] + l * 1024; }
        else if (t == 5) { J.W = P.in[I_XAKV] + (size_t)l * 1024 * 1024; J.K = 1024; J.N = 1024; J.WT = (bf16_t*)(lw + LW_WKV); J.ldt = 1024; }
        else { J.W = P.in[I_XAO] + (size_t)l * 512 * 1024; J.K = 512; J.N = 1024; J.WT = (bf16_t*)(lw + LW_WO); J.ldt = 512; }
    } else if (j == 14) { J.W = P.in[I_DGU]; J.K = 1024; J.N = 2 * FF; J.WT = (bf16_t*)(ws + WS_WGU); J.ldt = 1024; J.mode = 2; J.ff = FF; J.kscale = P.in[I_FFNG]; }
    else if (j == 15) { J.W = P.in[I_DD]; J.K = FF; J.N = 1024; J.WT = (bf16_t*)(ws + WS_WD); J.ldt = FF; }
    else { const int e = (j - 16) >> 1;
        if (((j - 16) & 1) == 0) { J.W = P.in[I_MGU] + (size_t)e * 1024 * 2 * EFF; J.K = 1024; J.N = 2 * EFF; J.WT = (bf16_t*)(ws + WS_WMGU) + (size_t)e * 2 * EFF * 1024; J.ldt = 1024; J.mode = 2; J.ff = EFF; J.kscale = P.in[I_FFNG] + 1024; }
        else { J.W = P.in[I_MD] + (size_t)e * EFF * 1024; J.K = EFF; J.N = 1024; J.WT = (bf16_t*)(ws + WS_WMD) + (size_t)e * 1024 * EFF; J.ldt = EFF; } }
}

DI void phase_prologue(const Frame& F, const Params& P) {
    unsigned char* ws = F.ws;
    const int gw = F.blk * 8 + F.wave, NGW = F.G * 8, lane = F.lane;
    const long gt = (long)F.blk * 512 + F.tid, NGT = (long)F.G * 512;
    { const float* x = P.in[I_X]; bf16_t* xb = (bf16_t*)(ws + WS_XB); float* ssq = (float*)(ws + WS_SSQ); unsigned char* x8 = ws + WS_X8;
      for (int row0 = gw; row0 < NTOK; row0 += 4 * NGW) {
          f32x4 v[4][4];
#pragma unroll
          for (int q = 0; q < 4; ++q) { const int row = row0 + q * NGW; const f32x4* xr = (const f32x4*)(x + (size_t)(row < NTOK ? row : row0) * 1024) + lane;
#pragma unroll
              for (int j = 0; j < 4; ++j) v[q][j] = xr[64 * j]; }
#pragma unroll
          for (int q = 0; q < 4; ++q) { const int row = row0 + q * NGW; if (row < NTOK) { float s = 0.f;
#pragma unroll
              for (int j = 0; j < 4; ++j) s += (v[q][j].x * v[q][j].x + v[q][j].y * v[q][j].y) + (v[q][j].z * v[q][j].z + v[q][j].w * v[q][j].w);
              s = wave_sum(s);
              u32x2* o = (u32x2*)(xb + (size_t)row * 1024) + lane;
#pragma unroll
              for (int j = 0; j < 4; ++j) { u32x2 w; w.x = pk2(v[q][j].x, v[q][j].y); w.y = pk2(v[q][j].z, v[q][j].w); o[64 * j] = w;
                  ((unsigned*)(x8 + (size_t)row * 1024))[lane + 64 * j] = cvt4_fp8(v[q][j].x, v[q][j].y, v[q][j].z, v[q][j].w); }
              if (lane < 16) ssq[(size_t)row * 16 + lane] = lane == 0 ? s : 0.f; } }
      } }
    { const float* mem = P.in[I_MEM]; bf16_t* mn = (bf16_t*)(ws + WS_MEMN);
      for (int row = gw; row < 2048; row += NGW) {
          const f32x4* xr = (const f32x4*)(mem + (size_t)row * 1024) + lane; f32x4 v[4]; float s = 0.f;
#pragma unroll
          for (int j = 0; j < 4; ++j) { v[j] = xr[64 * j]; s += (v[j].x * v[j].x + v[j].y * v[j].y) + (v[j].z * v[j].z + v[j].w * v[j].w); }
          s = wave_sum(s); const float r = rsqrtf(s * (1.0f / 1024.0f) + RMS_EPS);
#pragma unroll
          for (int l = 0; l < 2; ++l) { const f32x4* gr = (const f32x4*)(P.in[I_MEMG] + l * 1024) + lane; u32x2* o = (u32x2*)(mn + ((size_t)l * 2048 + row) * 1024) + lane;
#pragma unroll
              for (int j = 0; j < 4; ++j) { const f32x4 gg = gr[64 * j]; u32x2 w; w.x = pk2(v[j].x * r * gg.x, v[j].y * r * gg.y); w.y = pk2(v[j].z * r * gg.z, v[j].w * r * gg.w); o[64 * j] = w; } }
      } }
    { const int* pos = (const int*)P.in[I_POS]; float* rope = (float*)(ws + WS_ROPE);
      for (long i = gt; i < (long)NTOK * 8; i += NGT) { const int tok = (int)(i >> 3), f = (int)(i & 7);
          const float inv = powf(500000.0f, -(float)f * 2.0f / 16.0f); const float ang = (float)pos[tok] * inv; float sn, cs; sincosf(ang, &sn, &cs);
          rope[(size_t)tok * 16 + f] = cs; rope[(size_t)tok * 16 + 8 + f] = sn; } }
    for (long i = gt; i < 2 * 16 * 1024; i += NGT) { const int l = (int)(i >> 14), j = (int)((i >> 10) & 15), k = (int)(i & 1023);
        const float v = P.in[I_WIN][((size_t)l * 1024 + k) * IN_COLS + 2560 + j] * P.in[I_MIXG][l * 1024 + k];
        ((bf16_t*)(ws + WS_LW + (size_t)l * LW_STRIDE + LW_WBA))[j * 1024 + k] = (bf16_t)f2bf(v); }
    for (long i = gt; i < 8 * 1024; i += NGT) { const int e = (int)(i >> 10), k = (int)(i & 1023); ((float*)(ws + WS_WR))[e * 1024 + k] = P.in[I_ROUTER][k * 8 + e] * P.in[I_FFNG][1024 + k]; }
    for (long i = gt; i < 2L * 256 * 1024; i += NGT) { const int l = (int)(i >> 18), k = (int)((i >> 10) & 255), n = (int)(i & 1023), gi = k >> 6, c = k & 63;
        const float* pw = P.in[I_POOLW] + (((size_t)l * 4 + gi) * 64 + c) * 64; const float* ps = P.in[I_POOLS] + l * 256 + gi * 64; const float* wu = P.in[I_WUPP] + ((size_t)l * 256 + gi * 64) * 1024 + n;
        float s = 0.f;
#pragma unroll 16
        for (int d = 0; d < 64; ++d) s += pw[d] * ps[d] * wu[(size_t)d * 1024];
        ((bf16_t*)(ws + WS_LW + (size_t)l * LW_STRIDE + LW_WCAT))[(size_t)n * 1024 + k] = (bf16_t)f2bf(s); }
    { float* sm = (float*)(ws + WS_SMALL);
      for (long i = gt; i < 2 * 4 * 1536; i += NGT) sm[SM_CONVW + i] = P.in[I_CONVW][i];
      for (long i = gt; i < 16; i += NGT) { sm[SM_ALOG + i] = P.in[I_ALOG][i]; sm[SM_DTB + i] = P.in[I_DTB][i]; }
      for (long i = gt; i < 128; i += NGT) sm[SM_DNG + i] = P.in[I_DNG][i];
      for (long i = gt; i < 1024; i += NGT) sm[SM_FING + i] = P.in[I_FING][i]; }
    { LAS float* scr = (LAS float*)(F.lds + F.wave * 8704);
      int base = 0;
      for (int j = 0; j < NJOBS; ++j) { Job J; get_job(F, P, j, J); const int ni = job_items(J);
          int first = gw - (base % NGW); if (first < 0) first += NGW;
          for (int it = first; it < ni; it += NGW) transpose_item(J, scr, it, lane);
          base += ni; } }
}
DI void ba_tiles(const Frame& F, const bf16_t* xbg, const bf16_t* Wba, const float* ssqg, float* BA) {
    const int lane = F.lane, gw = F.blk * 8 + F.wave, NGW = F.G * 8;
    for (int tile = gw; tile < NG / 16; tile += NGW) {
        const int row0 = tile * 16; f32x4 acc = (f32x4){0.f, 0.f, 0.f, 0.f};
        const bf16_t* ap = xbg + (size_t)(row0 + (lane & 15)) * 1024 + (lane >> 4) * 8; const bf16_t* bp = Wba + (size_t)(lane & 15) * 1024 + (lane >> 4) * 8;
#pragma unroll 8
        for (int ks = 0; ks < 32; ++ks) { const bf16x8 a = *(const bf16x8*)(ap + 32 * ks); const bf16x8 b = *(const bf16x8*)(bp + 32 * ks); acc = MFMA16(a, b, acc); }
#pragma unroll
        for (int i = 0; i < 4; ++i) { const int row = row0 + 4 * (lane >> 4) + i; BA[(size_t)row * 16 + (lane & 15)] = acc[i] * row_rstd(ssqg, row); }
    }
}

template <int W> DI void prep_pool_w(const bf16_t* Pb, bf16_t* BR, int ch, int lr0, int s0) {
    const bf16_t* p = Pb + PC_POOL + ch; float v[32 + W - 1];
#pragma unroll
    for (int i = 0; i < 32 + W - 1; ++i) { const int d = i - (W - 1); const bool ok = s0 + d >= 0; const unsigned short raw = p[(size_t)(ok ? lr0 + d : lr0) * PLD]; v[i] = ok ? bf2f(raw) : 0.f; }
    float sum = 0.f;
#pragma unroll
    for (int i = 0; i < W - 1; ++i) sum += v[i];
#pragma unroll
    for (int t = 0; t < 32; ++t) { const float x = v[t + W - 1]; sum += x; const int s = s0 + t;
        const float o = (s + 1 >= W ? sum * (1.0f / (float)W) : sum / (float)(s + 1)) - x;
        BR[(size_t)(lr0 + t) * 1024 + ch] = (bf16_t)f2bf(o);
        sum -= v[t]; }
}
DI void prep_pool(const Frame& F, const bf16_t* Pb, bf16_t* BR, int unit) {
    int tid_ = F.tid; LAUNDER_V(tid_);
    const int ch = tid_ & 255, half = tid_ >> 8, lr0 = unit * 64 + half * 32, s0 = lr0 & (SEQ - 1), g = F.wave & 3;
    if (g == 0) prep_pool_w<2>(Pb, BR, ch, lr0, s0); else if (g == 1) prep_pool_w<4>(Pb, BR, ch, lr0, s0); else if (g == 2) prep_pool_w<8>(Pb, BR, ch, lr0, s0); else prep_pool_w<16>(Pb, BR, ch, lr0, s0);
}

DI void prep_moba(const Frame& F, bf16_t* Pb, const float* rope, float* KBAR, bf16_t* VT, int unit) {
    int tid_ = F.tid; LAUNDER_V(tid_);
    const int tid = tid_, bl = unit >> 5, j = unit & 31, lr0 = bl * SEQ + j * 256;
    { const int c = tid & 255, rh = tid >> 8, h = c >> 6, d = c & 63; float sum = 0.f;
        LAS float* KS = (LAS float*)F.lds;
        if (d < 16) { const int dp = d < 8 ? d + 8 : d - 8, f = d & 7;
#pragma unroll 8
            for (int r = 128 * rh; r < 128 * rh + 128; ++r) { const size_t lr = (size_t)(lr0 + r); const float v = bf2f(Pb[lr * PLD + PC_MK + c]), vp = bf2f(Pb[lr * PLD + PC_MK + h * 64 + dp]);
                const float cs = rope[lr * 16 + f], sn = rope[lr * 16 + 8 + f]; sum += d < 8 ? v * cs - vp * sn : v * cs + vp * sn; } }
        else {
#pragma unroll 16
            for (int r = 128 * rh; r < 128 * rh + 128; ++r) sum += bf2f(Pb[(size_t)(lr0 + r) * PLD + PC_MK + c]); }
        if (rh == 1) KS[c] = sum;
        __syncthreads();
        if (rh == 0) KBAR[((size_t)(bl * 4 + h) * 32 + j) * 64 + d] = (sum + KS[c]) * (1.0f / 256.0f); }
    __syncthreads();
    { const int r = tid & 255, hp = tid >> 8; const size_t lr = (size_t)(lr0 + r);
      const f32x4 c0 = *(const f32x4*)(rope + lr * 16), c1 = *(const f32x4*)(rope + lr * 16 + 4), s0 = *(const f32x4*)(rope + lr * 16 + 8), s1 = *(const f32x4*)(rope + lr * 16 + 12);
      const float cs[8] = {c0.x, c0.y, c0.z, c0.w, c1.x, c1.y, c1.z, c1.w}, sn[8] = {s0.x, s0.y, s0.z, s0.w, s1.x, s1.y, s1.z, s1.w};
#pragma unroll
      for (int hh = 0; hh < 2; ++hh)
#pragma unroll
          for (int which = 0; which < 2; ++which) { bf16_t* base = Pb + lr * PLD + (which ? PC_MK : PC_MQ) + (2 * hp + hh) * 64;
              const u32x4 a = *(const u32x4*)base, b = *(const u32x4*)(base + 8); float x1[8], x2[8];
#pragma unroll
              for (int q = 0; q < 4; ++q) { x1[2 * q] = __uint_as_float(a[q] << 16); x1[2 * q + 1] = __uint_as_float(a[q] & 0xffff0000u); x2[2 * q] = __uint_as_float(b[q] << 16); x2[2 * q + 1] = __uint_as_float(b[q] & 0xffff0000u); }
              u32x4 oa, ob;
#pragma unroll
              for (int q = 0; q < 4; ++q) { oa[q] = pk2(x1[2 * q] * cs[2 * q] - x2[2 * q] * sn[2 * q], x1[2 * q + 1] * cs[2 * q + 1] - x2[2 * q + 1] * sn[2 * q + 1]);
                                            ob[q] = pk2(x2[2 * q] * cs[2 * q] + x1[2 * q] * sn[2 * q], x2[2 * q + 1] * cs[2 * q + 1] + x1[2 * q + 1] * sn[2 * q + 1]); }
              *(u32x4*)base = oa; *(u32x4*)(base + 8) = ob; } }
    LAS bf16_t* Tt = (LAS bf16_t*)F.lds;
    for (int cc = 0; cc < 4; ++cc) {
        __syncthreads();
#pragma unroll
        for (int i = 0; i < 4; ++i) { const int q = tid + 512 * i, tok = q >> 5, c8 = q & 31; const u32x4 v = *(const u32x4*)(Pb + (size_t)(lr0 + cc * 64 + tok) * PLD + PC_MV + c8 * 8);
#pragma unroll
            for (int e = 0; e < 4; ++e) { Tt[(c8 * 8 + 2 * e) * 72 + tok] = (bf16_t)(v[e] & 0xffffu); Tt[(c8 * 8 + 2 * e + 1) * 72 + tok] = (bf16_t)(v[e] >> 16); } }
        __syncthreads();
#pragma unroll
        for (int i = 0; i < 4; ++i) { const int q = tid + 512 * i, col = q >> 3, t8 = q & 7; const u32x4 v = *(const LAS u32x4*)(Tt + col * 72 + t8 * 8);
            *(u32x4*)(VT + ((size_t)(bl * 256 + col)) * SEQ + j * 256 + cc * 64 + t8 * 8) = v; }
    }
    __syncthreads();
}

constexpr int DN_ROWB = 144;
constexpr int DN_TQ = 0, DN_TK = 9216, DN_TKB = 18432, DN_TVB = 27648, DN_MISC = 36864, DN_PAIR = 38400;
__host__ __device__ constexpr int ap_rowoff(int i) { return i == 0 ? 0 : 4 * (((i - 1) / 4) + 1) * (2 * ((i - 1) / 4) + ((i - 1) % 4)); }

template <int I> DI void subst_load(const LAS float* Ap, const LAS unsigned char* Rt, const LAS float* SCL, int lane, f32x4 (&av)[16], float& Ri) {
    constexpr int off = ap_rowoff(I);
#pragma unroll
    for (int j4 = 0; j4 < I; j4 += 4) av[j4 >> 2] = *(const LAS f32x4*)(Ap + off + j4);
    Ri = bf2f(*(const LAS bf16_t*)(Rt + I * DN_ROWB + lane * 2)) * SCL[I];
}
template <int I> struct Subst2 { static DI void run(float (&x)[64], const LAS float* Ap, const LAS unsigned char* Rt, const LAS float* SCL, int lane, f32x4 (&cur)[16], float Rc, f32x4 (&nxt)[16]) {
    float Rn = 0.f;
    if constexpr (I + 1 < 64) subst_load<I + 1>(Ap, Rt, SCL, lane, nxt, Rn);
    float a0 = Rc, a1 = 0.f, a2 = 0.f, a3 = 0.f;
#pragma unroll
    for (int j4 = 0; j4 < I; j4 += 4) { const f32x4 av = cur[j4 >> 2];
        a0 -= av.x * x[j4];
        if (j4 + 1 < I) a1 -= av.y * x[j4 + 1];
        if (j4 + 2 < I) a2 -= av.z * x[j4 + 2];
        if (j4 + 3 < I) a3 -= av.w * x[j4 + 3]; }
    x[I] = (a0 + a1) + (a2 + a3);
    asm volatile("" : "+v"(x[I])); __builtin_amdgcn_sched_barrier(0);
    if constexpr (I + 1 < 64) Subst2<I + 1>::run(x, Ap, Rt, SCL, lane, nxt, Rn, cur);
} };

DI void conv_w_load(const float* convw, int wcol, float (&w)[4][8]) {
#pragma unroll
    for (int j = 0; j < 4; ++j) { const f32x4 w0 = *(const f32x4*)(convw + j * 1536 + wcol), w1 = *(const f32x4*)(convw + j * 1536 + wcol + 4);
        w[j][0] = w0.x; w[j][1] = w0.y; w[j][2] = w0.z; w[j][3] = w0.w; w[j][4] = w1.x; w[j][5] = w1.y; w[j][6] = w1.z; w[j][7] = w1.w; }
}
DI void conv8(const bf16_t* Pb, const float (&w)[4][8], int lr, int s, int pcol8, float (&a)[8]) {
#pragma unroll
    for (int e = 0; e < 8; ++e) a[e] = 0.f;
    u32x4 xv[4];
#pragma unroll
    for (int j = 0; j < 4; ++j) { const bool valid = (s - 3 + j) >= 0; xv[j] = *(const u32x4*)(Pb + (size_t)(valid ? lr - 3 + j : lr) * PLD + pcol8);
        xv[j].x = valid ? xv[j].x : 0u; xv[j].y = valid ? xv[j].y : 0u; xv[j].z = valid ? xv[j].z : 0u; xv[j].w = valid ? xv[j].w : 0u; }
#pragma unroll
    for (int j = 0; j < 4; ++j) {
        a[0] += w[j][0] * __uint_as_float(xv[j][0] << 16); a[1] += w[j][1] * __uint_as_float(xv[j][0] & 0xffff0000u);
        a[2] += w[j][2] * __uint_as_float(xv[j][1] << 16); a[3] += w[j][3] * __uint_as_float(xv[j][1] & 0xffff0000u);
        a[4] += w[j][4] * __uint_as_float(xv[j][2] << 16); a[5] += w[j][5] * __uint_as_float(xv[j][2] & 0xffff0000u);
        a[6] += w[j][6] * __uint_as_float(xv[j][3] << 16); a[7] += w[j][7] * __uint_as_float(xv[j][3] & 0xffff0000u);
    }
#pragma unroll
    for (int e = 0; e < 8; ++e) a[e] = a[e] * fsigmoid(a[e]);
}
DI float ssq8(const float (&a)[8]) { float ss = 0.f;
#pragma unroll
    for (int e = 0; e < 8; ++e) ss += a[e] * a[e];
    ss += __shfl_xor(ss, 1); ss += __shfl_xor(ss, 2); ss += __shfl_xor(ss, 4); return ss; }
DI u32x4 pack8(const float (&a)[8], float sc) { u32x4 w; w.x = pk2(a[0] * sc, a[1] * sc); w.y = pk2(a[2] * sc, a[3] * sc); w.z = pk2(a[4] * sc, a[5] * sc); w.w = pk2(a[6] * sc, a[7] * sc); return w; }

#ifndef DBG_RA
#define DBG_RA 1
#endif
#ifndef DBG_RB
#define DBG_RB 1
#endif
#ifndef DBG_RC
#define DBG_RC 1
#endif
#ifndef DBG_RD
#define DBG_RD 1
#endif
#ifndef DBG_RB2
#define DBG_RB2 1
#endif
DI void prep_dn(const Frame& F, const bf16_t* Pb, const float* BA, const float* convw, const float* alog, const float* dtb,
                bf16_t* QD, bf16_t* MM, bf16_t* NT, bf16_t* WN, bf16_t* UT, bf16_t* AQK, float* GL, int unit) {
    int lane_ = F.lane; LAUNDER_V(lane_);
    const int lane = lane_, wave = F.wave, pr = wave >> 1, role = wave & 1;
    const int bl = unit >> 8, rem = unit & 255, n = rem >> 1, hq = rem & 1, h = 4 * hq + pr;
    const int lr0 = bl * SEQ + n * 64;
    const int chidx = (bl * 128 + n) * 8 + h;
    LAS unsigned char* L = F.lds + pr * DN_PAIR;
    LAS float* Gs = (LAS float*)(L + DN_MISC); LAS float* EG = Gs + 64; LAS float* EGL = Gs + 128; LAS float* ONES = Gs + 192; LAS float* BETA = Gs + 256 + 64 * role;
    {
        const int lr = lr0 + lane;
        const float braw = BA[(size_t)lr * 16 + h], araw = BA[(size_t)lr * 16 + 8 + h];
        const float beta = fsigmoid(braw);
        const float xa = araw + dtb[h]; const float sp = xa > 20.f ? xa : log1pf(__expf(xa));
        float G = -__expf(alog[h]) * sp;
#pragma unroll
        for (int o = 1; o < 64; o <<= 1) { const float up = __shfl_up(G, o); if (lane >= o) G += up; }
        const float Glast = __shfl(G, 63);
        BETA[lane] = beta;
        if (role == 0) { Gs[lane] = G; EG[lane] = __expf(G); EGL[lane] = __expf(Glast - G); ONES[lane] = 1.0f; if (lane == 0) GL[chidx] = __expf(Glast); }
    }
    LDS_WAIT();
    for (int rpA = 0; rpA < DBG_RA; ++rpA) {
        const int cg = lane & 7, tl = lane >> 3; float w[4][8];
        if (role == 0) {
            conv_w_load(convw, h * 64 + cg * 8, w);
#pragma unroll 4
            for (int ps = 0; ps < 8; ++ps) { const int t = ps * 8 + tl; float a[8]; conv8(Pb, w, lr0 + t, n * 64 + t, PC_DQ + h * 64 + cg * 8, a);
                const float rn = rsqrtf(ssq8(a) + RMS_EPS) * 0.125f;
                *(LAS u32x4*)(L + DN_TQ + t * DN_ROWB + cg * 16) = pack8(a, rn); }
        } else {
            conv_w_load(convw, 512 + h * 64 + cg * 8, w);
#pragma unroll 4
            for (int ps = 0; ps < 8; ++ps) { const int t = ps * 8 + tl; float a[8]; conv8(Pb, w, lr0 + t, n * 64 + t, PC_DK + h * 64 + cg * 8, a);
                const float rn = rsqrtf(ssq8(a) + RMS_EPS);
                *(LAS u32x4*)(L + DN_TK + t * DN_ROWB + cg * 16) = pack8(a, rn); *(LAS u32x4*)(L + DN_TKB + t * DN_ROWB + cg * 16) = pack8(a, rn * BETA[t]); }
        }
        conv_w_load(convw, 1024 + h * 64 + cg * 8, w);
#pragma unroll 4
        for (int ps = 4 * role; ps < 4 * role + 4; ++ps) { const int t = ps * 8 + tl; float a[8]; conv8(Pb, w, lr0 + t, n * 64 + t, PC_DV + h * 64 + cg * 8, a);
            *(LAS u32x4*)(L + DN_TVB + t * DN_ROWB + cg * 16) = pack8(a, BETA[t]); }
    }
    WG_BAR();
    for (int rpB = 0; rpB < DBG_RB; ++rpB) {
        const int fr = lane & 15, fq = lane >> 4;
#pragma unroll
        for (int tt = 0; tt < 8; ++tt) { const int tile = 2 * tt + role, it = tile >> 2, jt = tile & 3;
            f32x4 acc = (f32x4){0.f, 0.f, 0.f, 0.f};
            if (jt <= it) {
#pragma unroll
                for (int ks = 0; ks < 2; ++ks) { const bf16x8 a = *(const LAS bf16x8*)(L + DN_TK + (16 * jt + fr) * DN_ROWB + (fq * 8 + 32 * ks) * 2);
                    const bf16x8 b = *(const LAS bf16x8*)(L + DN_TQ + (16 * it + fr) * DN_ROWB + (fq * 8 + 32 * ks) * 2); acc = MFMA16(a, b, acc); } }
            const int ii = 16 * it + fr; const float Gi = Gs[ii]; float v[4];
#pragma unroll
            for (int r = 0; r < 4; ++r) { const int jj = 16 * jt + 4 * fq + r; v[r] = (jj <= ii) ? acc[r] * __expf(Gi - Gs[jj]) : 0.f; }
            u32x2 w; w.x = pk2(v[0], v[1]); w.y = pk2(v[2], v[3]);
            *(u32x2*)(AQK + (size_t)chidx * 4096 + ii * 64 + 16 * jt + 4 * fq) = w;
        }
#pragma unroll
        for (int i = 0; i < 4; ++i) { const int idx = lane + 64 * role + 128 * i, t = idx >> 3, cg = idx & 7; const u32x4 qv = *(const LAS u32x4*)(L + DN_TQ + t * DN_ROWB + cg * 16); const float eg = EG[t]; u32x4 w;
#pragma unroll
            for (int e = 0; e < 4; ++e) w[e] = pk2(__uint_as_float(qv[e] << 16) * eg, __uint_as_float(qv[e] & 0xffff0000u) * eg);
            *(u32x4*)(QD + (size_t)chidx * 4096 + t * 64 + cg * 8) = w; }
    }
    WG_BAR();
    for (int rpB2 = 0; rpB2 < DBG_RB2; ++rpB2) {
        const int fr = lane & 15, fq = lane >> 4; LAS float* Ap = (LAS float*)(L + DN_TQ);
#pragma unroll
        for (int tt = 0; tt < 5; ++tt) { const int q = 2 * tt + role;
            const int it = q < 1 ? 0 : (q < 3 ? 1 : (q < 6 ? 2 : 3)), jt = q - (it * (it + 1)) / 2;
            f32x4 acc = (f32x4){0.f, 0.f, 0.f, 0.f};
#pragma unroll
            for (int ks = 0; ks < 2; ++ks) { const bf16x8 a = *(const LAS bf16x8*)(L + DN_TKB + (16 * it + fr) * DN_ROWB + (fq * 8 + 32 * ks) * 2);
                const bf16x8 b = *(const LAS bf16x8*)(L + DN_TK + (16 * jt + fr) * DN_ROWB + (fq * 8 + 32 * ks) * 2); acc = MFMA16(a, b, acc); }
            const int jj = 16 * jt + fr; const float Gj = Gs[jj];
#pragma unroll
            for (int r = 0; r < 4; ++r) { const int ii = 16 * it + 4 * fq + r;
                if (jj < ii) { const int m1 = ii - 1, gf = m1 >> 2, rm = m1 & 3; Ap[4 * (gf + 1) * (2 * gf + rm) + jj] = acc[r] * __expf(Gs[ii] - Gj); } }
        }
    }
    u32x4 kdt[4];
#pragma unroll
    for (int i = 0; i < 4; ++i) { const int idx = lane + 64 * role + 128 * i, d = idx >> 3, tc = idx & 7; unsigned short kv[8];
#pragma unroll
        for (int e = 0; e < 8; ++e) kv[e] = *(const LAS bf16_t*)(L + DN_TK + (tc * 8 + e) * DN_ROWB + d * 2);
#pragma unroll
        for (int e = 0; e < 4; ++e) kdt[i][e] = pk2(bf2f(kv[2 * e]) * EGL[tc * 8 + 2 * e], bf2f(kv[2 * e + 1]) * EGL[tc * 8 + 2 * e + 1]); }
    WG_BAR();
#pragma unroll
    for (int i = 0; i < 4; ++i) { const int idx = lane + 64 * role + 128 * i, d = idx >> 3, tc = idx & 7; *(LAS u32x4*)(L + DN_TK + d * DN_ROWB + tc * 16) = kdt[i]; }
    for (int rpC = 0; rpC < DBG_RC; ++rpC) {
        float x[64];
        LAS unsigned char* const RT = L + DN_TVB - role * (DN_TVB - DN_TKB);
        { f32x4 avA[16], avB[16]; float R0; subst_load<0>((const LAS float*)(L + DN_TQ), RT, Gs + 192 - role * 128, lane, avA, R0);
          Subst2<0>::run(x, (const LAS float*)(L + DN_TQ), RT, Gs + 192 - role * 128, lane, avA, R0, avB); }
        { LAS unsigned char* T = RT + lane * DN_ROWB;
#pragma unroll
          for (int cg = 0; cg < 8; ++cg) { u32x4 w; w.x = pk2(x[cg * 8], x[cg * 8 + 1]); w.y = pk2(x[cg * 8 + 2], x[cg * 8 + 3]); w.z = pk2(x[cg * 8 + 4], x[cg * 8 + 5]); w.w = pk2(x[cg * 8 + 6], x[cg * 8 + 7]);
              *(LAS u32x4*)(T + cg * 16) = w; if (role == 0) *((u32x4*)(UT + (size_t)chidx * 4096 + lane * 64) + cg) = w; } }
    }
    WG_BAR();
#pragma unroll
    for (int i = 0; i < 4; ++i) { const int idx = lane + 64 * role + 128 * i, cg = idx >> 6, t = idx & 63; unsigned short wv[8];
#pragma unroll
        for (int e = 0; e < 8; ++e) wv[e] = *(const LAS bf16_t*)(L + DN_TKB + (cg * 8 + e) * DN_ROWB + t * 2);
        u32x4 w;
#pragma unroll
        for (int e = 0; e < 4; ++e) w[e] = ((unsigned)wv[2 * e] | ((unsigned)wv[2 * e + 1] << 16)) ^ 0x80008000u;
        *(u32x4*)(WN + (size_t)chidx * 4096 + t * 64 + cg * 8) = w; }
    for (int rpD = 0; rpD < DBG_RD; ++rpD) {
        const int fr = lane & 15, fq = lane >> 4; const float glast = EG[63];
#pragma unroll
        for (int tt = 0; tt < 8; ++tt) { const int tile = 2 * tt + role, mt = tile >> 2, nt = tile & 3;
            f32x4 acc = (f32x4){0.f, 0.f, 0.f, 0.f};
#pragma unroll
            for (int ks = 0; ks < 2; ++ks) { const bf16x8 a = *(const LAS bf16x8*)(L + DN_TKB + (16 * mt + fr) * DN_ROWB + (fq * 8 + 32 * ks) * 2);
                const bf16x8 b = *(const LAS bf16x8*)(L + DN_TK + (16 * nt + fr) * DN_ROWB + (fq * 8 + 32 * ks) * 2); acc = MFMA16(a, b, acc); }
            { const int dko = 16 * nt + fr, dki0 = 16 * mt + 4 * fq; u32x2 w;
              w.x = pk2((dko == dki0 ? glast : 0.f) - acc[0], (dko == dki0 + 1 ? glast : 0.f) - acc[1]); w.y = pk2((dko == dki0 + 2 ? glast : 0.f) - acc[2], (dko == dki0 + 3 ? glast : 0.f) - acc[3]);
              *(u32x2*)(MM + (size_t)chidx * 4096 + dko * 64 + dki0) = w; }
            acc = (f32x4){0.f, 0.f, 0.f, 0.f};
#pragma unroll
            for (int ks = 0; ks < 2; ++ks) { const bf16x8 a = *(const LAS bf16x8*)(L + DN_TK + (16 * mt + fr) * DN_ROWB + (fq * 8 + 32 * ks) * 2);
                const bf16x8 b = *(const LAS bf16x8*)(L + DN_TVB + (16 * nt + fr) * DN_ROWB + (fq * 8 + 32 * ks) * 2); acc = MFMA16(a, b, acc); }
            { u32x2 w; w.x = pk2(acc[0], acc[1]); w.y = pk2(acc[2], acc[3]); *(u32x2*)(NT + (size_t)chidx * 4096 + (16 * nt + fr) * 64 + 16 * mt + 4 * fq) = w; }
        }
    }
    WG_BAR();
}
constexpr int SC_ROWB = 144;
constexpr int SC_ST = 0, SC_VT = 64 * SC_ROWB, SC_RS = 2 * 64 * SC_ROWB;
DI void dn_scan(const Frame& F, int chain, const bf16_t* MM, const bf16_t* NT, bf16_t* SG, int nb, int ne, bool do_store = true) {
    const int lane = F.lane, wave = F.wave, rt = wave & 3, ch = wave >> 2, fr = lane & 15, fq = lane >> 4;
    const int bl = chain >> 3, h = chain & 7;
    LAS unsigned char* L = F.lds;
    if (nb == 0) for (int i = F.tid; i < 64 * SC_ROWB / 4; i += 512) ((LAS unsigned*)L)[i] = 0u;
    const size_t cstride = (size_t)8 * 4096;
    size_t cb = (size_t)((bl * 128 + nb) * 8 + h) * 4096;
    const int aoffs = (16 * rt + fr) * 64 + fq * 8;
    int coffs[2]; coffs[0] = (32 * ch + fr) * 64 + 16 * rt + 4 * fq; coffs[1] = coffs[0] + 16 * 64;
#pragma unroll
    for (int nt = 0; nt < 2; ++nt) if (nb == 0) *(u32x2*)(SG + cb + coffs[nt]) = (u32x2){0u, 0u};
    bf16x8 a[8][2]; u32x2 nc[8][2];
#pragma unroll
    for (int j = 0; j < 8; ++j) { const size_t cj = cb + (size_t)(nb + j < 127 ? j : 0) * cstride;
#pragma unroll
        for (int ks = 0; ks < 2; ++ks) a[j][ks] = *(const bf16x8*)(MM + cj + aoffs + 32 * ks);
#pragma unroll
        for (int nt = 0; nt < 2; ++nt) nc[j][nt] = *(const u32x2*)(NT + cj + coffs[nt]); }
    __syncthreads();
#pragma unroll 1
    for (int n0 = nb; n0 < ne; n0 += 16) {
#pragma unroll
        for (int jj = 0; jj < 16; ++jj) { const int j = jj & 7; const int n = n0 + jj;
            if (n < ne) {
                const size_t cbn = cb + cstride;
                LAS unsigned char* SR = L + (n & 1) * 64 * SC_ROWB; LAS unsigned char* SW = L + ((n + 1) & 1) * 64 * SC_ROWB;
#pragma unroll
                for (int nt = 0; nt < 2; ++nt) {
                    f32x4 acc = (f32x4){__uint_as_float(nc[j][nt].x << 16), __uint_as_float(nc[j][nt].x & 0xffff0000u), __uint_as_float(nc[j][nt].y << 16), __uint_as_float(nc[j][nt].y & 0xffff0000u)};
#pragma unroll
                    for (int ks = 0; ks < 2; ++ks) { const bf16x8 sb = *(const LAS bf16x8*)(SR + (32 * ch + 16 * nt + fr) * SC_ROWB + (fq * 8 + 32 * ks) * 2); acc = MFMA16(a[j][ks], sb, acc); }
                    u32x2 w; w.x = cvt_pk_bf16(acc[0], acc[1]); w.y = cvt_pk_bf16(acc[2], acc[3]);
                    *(LAS u32x2*)(SW + (32 * ch + 16 * nt + fr) * SC_ROWB + (16 * rt + 4 * fq) * 2) = w;
                    if (do_store) *(u32x2*)(SG + cbn + coffs[nt]) = w;
                }
                if (n + 8 < 127) { const size_t c4 = cb + 8 * cstride;
#pragma unroll
                    for (int ks = 0; ks < 2; ++ks) a[j][ks] = *(const bf16x8*)(MM + c4 + aoffs + 32 * ks);
#pragma unroll
                    for (int nt = 0; nt < 2; ++nt) nc[j][nt] = *(const u32x2*)(NT + c4 + coffs[nt]); }
                WG_BAR();
                cb = cbn;
            }
        }
    }
    __syncthreads();
}

struct OutOps { bf16x8 wn[2], qd[2], aq[2], sb[4][2]; u32x2 uv[4]; unsigned short zv[16]; };
DI void out_load(OutOps& o, int k, int rt, int fr, int fq, const bf16_t* QD, const bf16_t* WN, const bf16_t* UT, const bf16_t* AQK, const bf16_t* SG, const bf16_t* ZB) {
    const size_t cb = (size_t)k * 4096; const int arow = 16 * rt + fr; const int h = k & 7, n = (k >> 3) & 127, bl = k >> 10;
#pragma unroll
    for (int ks = 0; ks < 2; ++ks) { const size_t off = cb + arow * 64 + fq * 8 + 32 * ks;
        o.wn[ks] = *(const bf16x8*)(WN + off); o.qd[ks] = *(const bf16x8*)(QD + off); o.aq[ks] = *(const bf16x8*)(AQK + off); }
#pragma unroll
    for (int nt = 0; nt < 4; ++nt) { o.uv[nt] = *(const u32x2*)(UT + cb + (16 * nt + fr) * 64 + 16 * rt + 4 * fq);
#pragma unroll
        for (int ks = 0; ks < 2; ++ks) o.sb[nt][ks] = *(const bf16x8*)(SG + cb + (16 * nt + fr) * 64 + fq * 8 + 32 * ks); }
    const int lrb = bl * SEQ + n * 64 + 16 * rt + 4 * fq;
#pragma unroll
    for (int r = 0; r < 4; ++r)
#pragma unroll
        for (int nt = 0; nt < 4; ++nt) o.zv[r * 4 + nt] = ZB[(size_t)(lrb + r) * 512 + h * 64 + 16 * nt + fr];
}
DI void dn_out_pass(const Frame& F, const bf16_t* QD, const bf16_t* WN, const bf16_t* UT, const bf16_t* AQK, const bf16_t* SG, const bf16_t* ZB, const float* dng, bf16_t* BR) {
    int lane_ = F.lane; LAUNDER_V(lane_);
    const int lane = lane_, wave = F.wave, rt = wave & 3, half = wave >> 2, fr = lane & 15, fq = lane >> 4;
    LAS unsigned char* L = F.lds;
    float ng[4];
#pragma unroll
    for (int nt = 0; nt < 4; ++nt) ng[nt] = dng[16 * nt + fr];
    int p = F.blk; if (p >= NCH / 2) return;
    OutOps cur, nxt;
    out_load(cur, 2 * p + half, rt, fr, fq, QD, WN, UT, AQK, SG, ZB);
    __syncthreads();
    for (int it = 0; p < NCH / 2; p += F.G, ++it) {
        const int k = 2 * p + half, pn = p + F.G < NCH / 2 ? p + F.G : p;
        out_load(nxt, 2 * pn + half, rt, fr, fq, QD, WN, UT, AQK, SG, ZB);
        const int h = k & 7, n = (k >> 3) & 127, bl = k >> 10;
        LAS unsigned char* VT = L + ((it & 1) * 2 + half) * 64 * SC_ROWB;
        f32x4 vn[4], o[4];
#pragma unroll
        for (int nt = 0; nt < 4; ++nt) { vn[nt] = (f32x4){__uint_as_float(cur.uv[nt].x << 16), __uint_as_float(cur.uv[nt].x & 0xffff0000u), __uint_as_float(cur.uv[nt].y << 16), __uint_as_float(cur.uv[nt].y & 0xffff0000u)};
            o[nt] = (f32x4){0.f, 0.f, 0.f, 0.f};
#pragma unroll
            for (int ks = 0; ks < 2; ++ks) { vn[nt] = MFMA16(cur.wn[ks], cur.sb[nt][ks], vn[nt]); o[nt] = MFMA16(cur.qd[ks], cur.sb[nt][ks], o[nt]); } }
#pragma unroll
        for (int nt = 0; nt < 4; ++nt) { u32x2 w; w.x = cvt_pk_bf16(vn[nt][0], vn[nt][1]); w.y = cvt_pk_bf16(vn[nt][2], vn[nt][3]);
            *(LAS u32x2*)(VT + (16 * nt + fr) * SC_ROWB + (16 * rt + 4 * fq) * 2) = w; }
        WG_BAR();
#pragma unroll
        for (int nt = 0; nt < 4; ++nt)
#pragma unroll
            for (int ks = 0; ks < 2; ++ks) { const bf16x8 vb = *(const LAS bf16x8*)(VT + (16 * nt + fr) * SC_ROWB + (fq * 8 + 32 * ks) * 2); o[nt] = MFMA16(cur.aq[ks], vb, o[nt]); }
        const int lrb = bl * SEQ + n * 64 + 16 * rt + 4 * fq;
#pragma unroll
        for (int r = 0; r < 4; ++r) { float q = (o[0][r] * o[0][r] + o[1][r] * o[1][r]) + (o[2][r] * o[2][r] + o[3][r] * o[3][r]);
            q += __shfl_xor(q, 1); q += __shfl_xor(q, 2); q += __shfl_xor(q, 4); q += __shfl_xor(q, 8);
            const float rs = rsqrtf(q * (1.0f / 64.0f) + RMS_EPS); const size_t lr = (size_t)(lrb + r);
#pragma unroll
            for (int nt = 0; nt < 4; ++nt) { const float z = bf2f(cur.zv[r * 4 + nt]);
                BR[lr * 1024 + 512 + h * 64 + 16 * nt + fr] = (bf16_t)f2bf(o[nt][r] * rs * ng[nt] * (z * fsigmoid(z))); } }
        cur = nxt;
    }
    __syncthreads();
}

constexpr int MG_QS = 0, MG_KB = 36864, MG_SEL = MG_KB + 8192, MG_TOP = MG_SEL + 1024;
DI void moba_gate_unit(const Frame& F, const bf16_t* Pb, const float* KBAR, unsigned* SELG, unsigned char* LISTG, int* CNTG, int bl, int h, int c) {
    int lane_ = F.lane; LAUNDER_V(lane_);
    const int lane = lane_, wave = F.wave, tid = wave * 64 + lane;
    LAS unsigned char* L = F.lds; LAS float* KB = (LAS float*)(L + MG_KB); LAS unsigned* SEL = (LAS unsigned*)(L + MG_SEL);
    const int q0 = bl * SEQ + c * 256, bh = bl * 4 + h;
    __syncthreads();
#pragma unroll
    for (int i = 0; i < 4; ++i) { const int q = tid + 512 * i, r = q >> 3, c8 = q & 7; *(LAS u32x4*)(L + MG_QS + r * 144 + c8 * 16) = *(const u32x4*)(Pb + (size_t)(q0 + r) * PLD + PC_MQ + h * 64 + c8 * 8); }
    for (int i = tid; i < c * 64; i += 512) KB[i] = KBAR[(size_t)bh * 2048 + i];
    __syncthreads();
    {
        const int qi = tid & 255, par = tid >> 8;
        float qv[64];
#pragma unroll
        for (int c8 = 0; c8 < 8; ++c8) { const u32x4 v = *(const LAS u32x4*)(L + MG_QS + qi * 144 + c8 * 16);
#pragma unroll
            for (int e = 0; e < 4; ++e) { qv[c8 * 8 + 2 * e] = __uint_as_float(v[e] << 16); qv[c8 * 8 + 2 * e + 1] = __uint_as_float(v[e] & 0xffff0000u); } }
        float v1 = -INFINITY, v2 = -INFINITY, v3 = -INFINITY; int i1 = -1, i2 = -1, i3 = -1;
        for (int n = par; n < c; n += 2) { float g0 = 0.f, g1 = 0.f, g2 = 0.f, g3 = 0.f;
#pragma unroll
            for (int d4 = 0; d4 < 16; ++d4) { const f32x4 kb = *(const LAS f32x4*)(KB + n * 64 + d4 * 4); g0 += qv[4 * d4] * kb.x; g1 += qv[4 * d4 + 1] * kb.y; g2 += qv[4 * d4 + 2] * kb.z; g3 += qv[4 * d4 + 3] * kb.w; }
            const float g = (g0 + g1) + (g2 + g3);
            if (g > v1) { v3 = v2; i3 = i2; v2 = v1; i2 = i1; v1 = g; i1 = n; } else if (g > v2) { v3 = v2; i3 = i2; v2 = g; i2 = n; } else if (g > v3) { v3 = g; i3 = n; } }
        LAS float* TP = (LAS float*)(L + MG_TOP);
        if (par == 1) { TP[qi * 6 + 0] = v1; TP[qi * 6 + 1] = v2; TP[qi * 6 + 2] = v3; TP[qi * 6 + 3] = __int_as_float(i1); TP[qi * 6 + 4] = __int_as_float(i2); TP[qi * 6 + 5] = __int_as_float(i3); }
        __syncthreads();
        if (par == 0) {
#pragma unroll
            for (int k = 0; k < 3; ++k) { const float g = TP[qi * 6 + k]; const int n = __float_as_int(TP[qi * 6 + 3 + k]);
                if (n >= 0) { const bool b1 = g > v1 || (g == v1 && n < i1), b2 = g > v2 || (g == v2 && n < i2), b3 = g > v3 || (g == v3 && n < i3);
                    if (b1) { v3 = v2; i3 = i2; v2 = v1; i2 = i1; v1 = g; i1 = n; } else if (b2) { v3 = v2; i3 = i2; v2 = g; i2 = n; } else if (b3) { v3 = g; i3 = n; } } }
            const unsigned s4 = (unsigned)(i1 & 255) | ((unsigned)(i2 & 255) << 8) | ((unsigned)(i3 & 255) << 16) | 0xff000000u;
            SEL[qi] = s4; SELG[(size_t)(q0 + qi) * 4 + h] = s4;
        }
    }
    __syncthreads();
    for (int n = wave; n < c; n += 8) { int base = 0; unsigned char* lp = LISTG + ((size_t)(bh * 32 + c) * 32 + n) * 256;
#pragma unroll
        for (int ck = 0; ck < 4; ++ck) { const int q = ck * 64 + lane; const unsigned s4 = SEL[q]; const bool f = (s4 & 255u) == (unsigned)n || ((s4 >> 8) & 255u) == (unsigned)n || ((s4 >> 16) & 255u) == (unsigned)n;
            const unsigned long long bal = __ballot(f); const int pos = base + __popcll(bal & ((1ull << lane) - 1ull)); if (f) lp[pos] = (unsigned char)q; base += __popcll(bal); }
        if (lane == 0) CNTG[(bh * 32 + c) * 32 + n] = base; }
}
constexpr int KV_KL = 0, KV_VL = 36864, KV_PRE = KV_VL + 64 * 528;
DI void kv_tile(const LAS unsigned char* KL, const LAS unsigned char* VL, const bf16x8 (&qf)[2], int nsteps, bool causal, int qloc, int fr, int fq, f32x4 (&O)[4], float& m_out, float& l_out) {
    const float sc2 = 0.125f * 1.44269504089f;
    f32x4 s[16];
    const LAS unsigned char* kr0 = KL + (8 * (fr >> 2) + (fr & 3)) * 144 + fq * 16;
#pragma unroll
    for (int s8 = 0; s8 < 8; ++s8)
#pragma unroll
        for (int j = 0; j < 2; ++j) { f32x4 acc = (f32x4){0.f, 0.f, 0.f, 0.f};
#pragma unroll
            for (int ks = 0; ks < 2; ++ks) { const bf16x8 a = *(const LAS bf16x8*)(kr0 + (32 * s8 + 4 * j) * 144 + 64 * ks); acc = MFMA16(a, qf[ks], acc); }
            s[2 * s8 + j] = (s8 < nsteps) ? acc : (f32x4){-INFINITY, -INFINITY, -INFINITY, -INFINITY}; }
    if (causal) {
#pragma unroll
        for (int t = 0; t < 16; ++t)
#pragma unroll
            for (int r = 0; r < 4; ++r) { const int key = 32 * (t >> 1) + 8 * fq + 4 * (t & 1) + r; s[t][r] = key <= qloc ? s[t][r] : -INFINITY; } }
    float m = -INFINITY;
#pragma unroll
    for (int t = 0; t < 16; ++t) m = fmaxf(m, fmaxf(fmaxf(s[t][0], s[t][1]), fmaxf(s[t][2], s[t][3])));
    m = fmaxf(m, __shfl_xor(m, 16)); m = fmaxf(m, __shfl_xor(m, 32));
    const float mb = -m * sc2; float l = 0.f;
#pragma unroll
    for (int t = 0; t < 16; ++t)
#pragma unroll
        for (int r = 0; r < 4; ++r) { const float p = __builtin_amdgcn_exp2f(fmaf(s[t][r], sc2, mb)); s[t][r] = p; l += p; }
    l += __shfl_xor(l, 16); l += __shfl_xor(l, 32);
#pragma unroll
    for (int dt = 0; dt < 4; ++dt) O[dt] = (f32x4){0.f, 0.f, 0.f, 0.f};
    const LAS unsigned char* vr0 = VL + fr * 528 + fq * 16;
#pragma unroll
    for (int s8 = 0; s8 < 8; ++s8) {
        u32x4 pw; pw.x = cvt_pk_bf16(s[2 * s8][0], s[2 * s8][1]); pw.y = cvt_pk_bf16(s[2 * s8][2], s[2 * s8][3]); pw.z = cvt_pk_bf16(s[2 * s8 + 1][0], s[2 * s8 + 1][1]); pw.w = cvt_pk_bf16(s[2 * s8 + 1][2], s[2 * s8 + 1][3]);
        const bf16x8 pb = __builtin_bit_cast(bf16x8, pw);
#pragma unroll
        for (int dt = 0; dt < 4; ++dt) { const bf16x8 a = *(const LAS bf16x8*)(vr0 + (16 * dt) * 528 + 64 * s8); O[dt] = MFMA16(a, pb, O[dt]); } }
    m_out = m; l_out = l;
}
DI void kv_store(bf16_t* OPG, float* MLG, size_t row, int h, int slot, const f32x4 (&O)[4], float m, float l, int fq) {
    const float inv = 1.0f / l; const size_t base = ((row * 4 + h) * 4 + slot);
#pragma unroll
    for (int dt = 0; dt < 4; ++dt) { u32x2 w; w.x = cvt_pk_bf16(O[dt][0] * inv, O[dt][1] * inv); w.y = cvt_pk_bf16(O[dt][2] * inv, O[dt][3] * inv); *(u32x2*)(OPG + base * 64 + 16 * dt + 4 * fq) = w; }
    if (fq == 0) { MLG[base * 2] = m; MLG[base * 2 + 1] = l; }
}
DI void moba_kv_unit(const Frame& F, const bf16_t* Pb, const bf16_t* VT, const unsigned* SELG, const unsigned char* LISTG, const int* CNTG, bf16_t* OPG, float* MLG, int bl, int h, int n, int part, int nparts) {
    int lane_ = F.lane; LAUNDER_V(lane_);
    const int lane = lane_, wave = F.wave, tid = wave * 64 + lane, fr = lane & 15, fq = lane >> 4;
    LAS unsigned char* L = F.lds; LAS int* PRE = (LAS int*)(L + KV_PRE);
    const int bh = bl * 4 + h;
    const bf16_t* Kg = Pb + (size_t)(bl * SEQ + n * 256) * PLD + PC_MK + h * 64;
    const bf16_t* Vg = VT + (size_t)(bh * 64) * SEQ + n * 256;
    const bf16_t* Qg = Pb + (size_t)(bl * SEQ) * PLD + PC_MQ + h * 64;
    __syncthreads();
#pragma unroll
    for (int i = 0; i < 4; ++i) { const int q = tid + 512 * i, r = q >> 3, c8 = q & 7; *(LAS u32x4*)(L + KV_KL + r * 144 + c8 * 16) = *(const u32x4*)(Kg + (size_t)r * PLD + c8 * 8); }
#pragma unroll
    for (int i = 0; i < 4; ++i) { const int q = tid + 512 * i, d = q >> 5, c16 = q & 31; *(LAS u32x4*)(L + KV_VL + d * 528 + c16 * 16) = *(const u32x4*)(Vg + (size_t)d * SEQ + c16 * 8); }
    if (wave == 0) {
        const int cq = lane; int cnt = (cq > n && cq < 32) ? CNTG[(bh * 32 + cq) * 32 + n] : 0; int inc = cnt;
#pragma unroll
        for (int o = 1; o < 32; o <<= 1) { const int up = __shfl_up(inc, o); if (lane >= o) inc += up; }
        if (lane < 32) PRE[lane] = inc - cnt; if (lane == 31) PRE[32] = inc;
    }
    __syncthreads();
    const int T = PRE[32], nsp = (T + 15) >> 4, ntl = nsp + 16;
    for (int tt = part + nparts * wave; tt < ntl; tt += nparts * 8) {
        f32x4 O[4]; float m, l; bf16x8 qf[2];
        if (tt < nsp) {
            const int e = 16 * tt + fr; const bool valid = e < T; const int ee = valid ? e : 0;
            int cq = 0;
#pragma unroll
            for (int i = 1; i < 32; ++i) cq += (PRE[i] <= ee) ? 1 : 0;
            const int q = LISTG[((size_t)(bh * 32 + cq) * 32 + n) * 256 + (ee - PRE[cq])];
            const int tok = cq * 256 + q; const size_t row = (size_t)(bl * SEQ + tok);
#pragma unroll
            for (int ks = 0; ks < 2; ++ks) qf[ks] = *(const bf16x8*)(Qg + (size_t)tok * PLD + fq * 8 + 32 * ks);
            kv_tile(L + KV_KL, L + KV_VL, qf, 8, false, 0, fr, fq, O, m, l);
            const unsigned s4 = SELG[row * 4 + h]; const int slot = (s4 & 255u) == (unsigned)n ? 0 : (((s4 >> 8) & 255u) == (unsigned)n ? 1 : 2);
            if (valid) kv_store(OPG, MLG, row, h, slot, O, m, l, fq);
        } else {
            const int to = tt - nsp, qloc = 16 * to + fr, tok = n * 256 + qloc; const size_t row = (size_t)(bl * SEQ + tok);
#pragma unroll
            for (int ks = 0; ks < 2; ++ks) qf[ks] = *(const bf16x8*)(Qg + (size_t)tok * PLD + fq * 8 + 32 * ks);
            kv_tile(L + KV_KL, L + KV_VL, qf, (16 * to + 15) / 32 + 1, true, qloc, fr, fq, O, m, l);
            kv_store(OPG, MLG, row, h, 3, O, m, l, fq);
        }
    }
}
DI void moba_combine(const Frame& F, const unsigned* SELG, const bf16_t* OPG, const float* MLG, bf16_t* BR) {
    int lane_ = F.lane; LAUNDER_V(lane_);
    const int lane = lane_, sub = lane & 7, gw = F.blk * 8 + F.wave, NGW = F.G * 8;
    const float sc2 = 0.125f * 1.44269504089f;
    for (int it = gw; it < NG * 4 / 8; it += NGW) { const size_t idx = (size_t)it * 8 + (lane >> 3); const size_t row = idx >> 2; const int h = (int)(idx & 3);
        const unsigned s4 = SELG[idx]; float mk[4], lk[4]; float M = -INFINITY;
#pragma unroll
        for (int k = 0; k < 4; ++k) { const bool ok = (k == 3) || (((s4 >> (8 * k)) & 255u) != 255u); const f32x2 ml = *(const f32x2*)(MLG + (idx * 4 + k) * 2); mk[k] = ok ? ml.x : -INFINITY; lk[k] = ok ? ml.y : 0.f; M = fmaxf(M, mk[k]); }
        float o[8]; float den = 0.f;
#pragma unroll
        for (int e = 0; e < 8; ++e) o[e] = 0.f;
#pragma unroll
        for (int k = 0; k < 4; ++k) { const bool ok = (k == 3) || (((s4 >> (8 * k)) & 255u) != 255u); const float w = ok ? lk[k] * __builtin_amdgcn_exp2f((mk[k] - M) * sc2) : 0.f; den += w;
            u32x4 pv = *(const u32x4*)(OPG + (idx * 4 + k) * 64 + sub * 8);
            if (!ok) pv = (u32x4){0u, 0u, 0u, 0u};
#pragma unroll
            for (int e = 0; e < 4; ++e) { o[2 * e] += w * __uint_as_float(pv[e] << 16); o[2 * e + 1] += w * __uint_as_float(pv[e] & 0xffff0000u); } }
        const float inv = 1.0f / den; u32x4 wv;
#pragma unroll
        for (int e = 0; e < 4; ++e) wv[e] = cvt_pk_bf16(o[2 * e] * inv, o[2 * e + 1] * inv);
        *(u32x4*)(BR + row * 1024 + 256 + h * 64 + sub * 8) = wv; }
}
__host__ __device__ constexpr int kv_parts(int n) { return n == 0 ? 3 : (n < 8 ? 2 : 1); }
__host__ __device__ constexpr int kv_items_before(int n) { int s = 0; for (int i = 0; i < n; ++i) s += kv_parts(i) * GB * 4; return s; }
constexpr int KV_NITEMS = kv_items_before(32);

constexpr int XA_K = 0;
constexpr int XA_VT = 69632;
DI void xattn_wg(const Frame& F, const bf16_t* KVM, const bf16_t* QX, bf16_t* AO, int w) {
    int lane_ = F.lane; LAUNDER_V(lane_);
    const int lane = lane_, wave = F.wave, tid = wave * 64 + lane, fr = lane & 15, fq = lane >> 4;
    const int b = w >> 5, h = (w >> 3) & 3, qpart = w & 7;
    LAS unsigned char* L = F.lds;
    __syncthreads();
#pragma unroll
    for (int i = 0; i < 8; ++i) { const int q = tid + 512 * i, m = q >> 4, c16 = q & 15; *(LAS u32x4*)(L + XA_K + m * 272 + c16 * 16) = *(const u32x4*)(KVM + (size_t)(b * 256 + m) * 1024 + h * 128 + c16 * 8); }
#pragma unroll
    for (int i = 0; i < 8; ++i) { const int q = tid + 512 * i, m = q & 255, c16 = q >> 8; const u32x4 v = *(const u32x4*)(KVM + (size_t)(b * 256 + m) * 1024 + 512 + h * 128 + c16 * 8);
#pragma unroll
        for (int e = 0; e < 4; ++e) { *(LAS bf16_t*)(L + XA_VT + (c16 * 8 + 2 * e) * 528 + m * 2) = (bf16_t)(v[e] & 0xffffu); *(LAS bf16_t*)(L + XA_VT + (c16 * 8 + 2 * e + 1) * 528 + m * 2) = (bf16_t)(v[e] >> 16); } }
    __syncthreads();
    const float sc2 = 0.08838834764831845f * 1.44269504089f;
    for (int rtile = 0; rtile < 8; ++rtile) {
        const size_t tok = (size_t)b * SEQ + qpart * 1024 + wave * 128 + rtile * 16 + fr;
        bf16x8 qf[4];
#pragma unroll
        for (int ks = 0; ks < 4; ++ks) qf[ks] = *(const bf16x8*)(QX + tok * 512 + h * 128 + fq * 8 + 32 * ks);
        f32x4 s[16]; float mx = -INFINITY;
#pragma unroll
        for (int kt = 0; kt < 16; ++kt) { s[kt] = (f32x4){0.f, 0.f, 0.f, 0.f};
#pragma unroll
            for (int ks = 0; ks < 4; ++ks) { const bf16x8 a = *(const LAS bf16x8*)(L + XA_K + (16 * kt + fr) * 272 + (fq * 8 + 32 * ks) * 2); s[kt] = MFMA16(a, qf[ks], s[kt]); }
            mx = fmaxf(mx, fmaxf(fmaxf(s[kt][0], s[kt][1]), fmaxf(s[kt][2], s[kt][3]))); __builtin_amdgcn_sched_barrier(0); }
        mx = fmaxf(mx, __shfl_xor(mx, 16)); mx = fmaxf(mx, __shfl_xor(mx, 32));
        float l = 0.f;
#pragma unroll
        for (int kt = 0; kt < 16; ++kt)
#pragma unroll
            for (int r = 0; r < 4; ++r) { const float p = __builtin_amdgcn_exp2f((s[kt][r] - mx) * sc2); s[kt][r] = p; l += p; }
        l += __shfl_xor(l, 16); l += __shfl_xor(l, 32); const float inv = 1.0f / l;
        f32x4 O[8];
#pragma unroll
        for (int dt = 0; dt < 8; ++dt) O[dt] = (f32x4){0.f, 0.f, 0.f, 0.f};
#pragma unroll
        for (int s8 = 0; s8 < 8; ++s8) {
            u32x4 pw; pw.x = pk2(s[2 * s8][0], s[2 * s8][1]); pw.y = pk2(s[2 * s8][2], s[2 * s8][3]); pw.z = pk2(s[2 * s8 + 1][0], s[2 * s8 + 1][1]); pw.w = pk2(s[2 * s8 + 1][2], s[2 * s8 + 1][3]);
            const bf16x8 pb = __builtin_bit_cast(bf16x8, pw);
#pragma unroll
            for (int dt = 0; dt < 8; ++dt) {
                const u32x2 lo = *(const LAS u32x2*)(L + XA_VT + (16 * dt + fr) * 528 + (32 * s8 + 4 * fq) * 2), hi = *(const LAS u32x2*)(L + XA_VT + (16 * dt + fr) * 528 + (32 * s8 + 16 + 4 * fq) * 2);
                const u32x4 av = (u32x4){lo.x, lo.y, hi.x, hi.y};
                O[dt] = MFMA16(__builtin_bit_cast(bf16x8, av), pb, O[dt]); }
            __builtin_amdgcn_sched_barrier(0);
        }
#pragma unroll
        for (int dt = 0; dt < 8; ++dt) { u32x2 wv; wv.x = pk2(O[dt][0] * inv, O[dt][1] * inv); wv.y = pk2(O[dt][2] * inv, O[dt][3] * inv);
            *(u32x2*)(AO + tok * 512 + h * 128 + 16 * dt + 4 * fq) = wv; }
    }
    __syncthreads();
}
DI void moe_route1(const Frame& F, const bf16_t* x, const float* Wr, int* TE, float* TW, float* RR, int* CNT) {
    const int tid = F.tid, lane = F.lane, wave = F.wave;
    LAS float* WL = (LAS float*)F.lds; LAS int* HC = (LAS int*)(F.lds + 32768);
    __syncthreads();
    for (int i = tid; i < 8 * 1024 / 4; i += 512) ((LAS f32x4*)WL)[i] = ((const f32x4*)Wr)[i];
    for (int tb = F.blk; tb < NTOK / 256; tb += F.G) {
        if (tid < 8) HC[tid] = 0;
        __syncthreads();
        u32x2 vn[4];
        { const u32x2* xr = (const u32x2*)(x + (size_t)(tb * 256 + wave * 32) * 1024) + lane;
#pragma unroll
          for (int j = 0; j < 4; ++j) vn[j] = xr[64 * j]; }
        for (int rr = 0; rr < 32; ++rr) { const int row = tb * 256 + wave * 32 + rr;
            f32x4 v[4]; float ss = 0.f;
#pragma unroll
            for (int j = 0; j < 4; ++j) v[j] = (f32x4){__uint_as_float(vn[j].x << 16), __uint_as_float(vn[j].x & 0xffff0000u), __uint_as_float(vn[j].y << 16), __uint_as_float(vn[j].y & 0xffff0000u)};
            { const u32x2* xr = (const u32x2*)(x + (size_t)(rr + 1 < 32 ? row + 1 : row) * 1024) + lane;
#pragma unroll
              for (int j = 0; j < 4; ++j) vn[j] = xr[64 * j]; }
#pragma unroll
            for (int j = 0; j < 4; ++j) ss += (v[j].x * v[j].x + v[j].y * v[j].y) + (v[j].z * v[j].z + v[j].w * v[j].w);
            ss = wave_sum(ss); const float r = rsqrtf(ss * (1.0f / 1024.0f) + RMS_EPS);
            float lg[8];
#pragma unroll
            for (int e = 0; e < 8; ++e) { float a = 0.f;
#pragma unroll
                for (int j = 0; j < 4; ++j) { const f32x4 w = *(const LAS f32x4*)(WL + e * 1024 + 4 * lane + 256 * j); a += (v[j].x * w.x + v[j].y * w.y) + (v[j].z * w.z + v[j].w * w.w); }
                lg[e] = wave_sum(a) * r; }
            int e0 = 0; float l0 = lg[0];
#pragma unroll
            for (int e = 1; e < 8; ++e) if (lg[e] > l0) { l0 = lg[e]; e0 = e; }
            int e1 = -1; float l1 = -INFINITY;
#pragma unroll
            for (int e = 0; e < 8; ++e) if (e != e0 && lg[e] > l1) { l1 = lg[e]; e1 = e; }
            const float w0 = 1.0f / (1.0f + __expf(l1 - l0));
            if (lane == 0) { TE[2 * (size_t)row] = e0; TE[2 * (size_t)row + 1] = e1; TW[2 * (size_t)row] = w0; TW[2 * (size_t)row + 1] = 1.0f - w0; RR[row] = r;
                __hip_atomic_fetch_add(&HC[e0], 1, __ATOMIC_RELAXED, __HIP_MEMORY_SCOPE_WORKGROUP); __hip_atomic_fetch_add(&HC[e1], 1, __ATOMIC_RELAXED, __HIP_MEMORY_SCOPE_WORKGROUP); }
        }
        __syncthreads();
        if (tid < 8) CNT[tb * 8 + tid] = HC[tid];
        __syncthreads();
    }
}
DI void moe_bases(const Frame& F, const int* CNT, int tb, LAS int* OUT  ) {
    const int tid = F.tid; LAS int* SC = (LAS int*)(F.lds + 40960);
    __syncthreads();
    { const int e = tid & 7, seg = tid >> 3; int all = 0, lt = 0;
#pragma unroll
      for (int q = 0; q < 4; ++q) { const int w = 4 * seg + q; const int c = CNT[w * 8 + e]; all += c; lt += (w < tb) ? c : 0; }
      SC[seg * 8 + e] = all; SC[512 + seg * 8 + e] = lt; }
    __syncthreads();
    if (tid < 8) { int all = 0, lt = 0; for (int s = 0; s < 64; ++s) { all += SC[s * 8 + tid]; lt += SC[512 + s * 8 + tid]; } SC[1024 + tid] = (all + 255) >> 8; OUT[16 + tid] = lt; }
    __syncthreads();
    if (tid == 0) { int b = 0; for (int e = 0; e < 8; ++e) { OUT[e] = b; b += SC[1024 + e]; } OUT[8] = b; }
    __syncthreads();
}
DI void moe_route2(const Frame& F, const int* TE, const float* RR, const int* CNT, const bf16_t* xb, int* POS, bf16_t* XP, float* RP) {
    const int tid = F.tid, lane = F.lane, wave = F.wave;
    LAS int* MB = (LAS int*)(F.lds + 49152);
    LAS int* WT = (LAS int*)(F.lds + 49152 + 256);
    LAS int* PL = (LAS int*)(F.lds + 49152 + 512);
    for (int tb = F.blk; tb < NTOK / 256; tb += F.G) {
        moe_bases(F, CNT, tb, MB);
        int e0 = -1, e1 = -1; const int tok = tb * 256 + tid;
        if (tid < 256) { e0 = TE[2 * (size_t)tok]; e1 = TE[2 * (size_t)tok + 1]; }
        int pw[2] = {0, 0};
#pragma unroll
        for (int e = 0; e < 8; ++e) { const bool f = (e0 == e) || (e1 == e); const unsigned long long bal = __ballot(f);
            const int before = __popcll(bal & ((1ull << lane) - 1ull)); if (lane == 0 && wave < 4) WT[wave * 8 + e] = __popcll(bal);
            if (e0 == e) pw[0] = before; if (e1 == e) pw[1] = before; }
        __syncthreads();
        if (tid < 256) {
#pragma unroll
            for (int sl = 0; sl < 2; ++sl) { const int e = sl ? e1 : e0; int rank = pw[sl]; for (int w2 = 0; w2 < wave; ++w2) rank += WT[w2 * 8 + e];
                const int pos = MB[e] * 256 + MB[16 + e] + rank; PL[2 * tid + sl] = pos; POS[2 * (size_t)tok + sl] = pos; RP[pos] = RR[tok]; } }
        __syncthreads();
        for (int pr0 = wave * 64; pr0 < wave * 64 + 64; pr0 += 8) { u32x4 ra[8], rb[8];
#pragma unroll
            for (int q = 0; q < 8; ++q) { const int t2 = (pr0 + q) >> 1; const u32x4* src = (const u32x4*)(xb + (size_t)(tb * 256 + t2) * 1024); ra[q] = src[lane]; rb[q] = src[lane + 64]; }
#pragma unroll
            for (int q = 0; q < 8; ++q) { const int pos = PL[pr0 + q]; u32x4* dst = (u32x4*)(XP + (size_t)pos * 1024); dst[lane] = ra[q]; dst[lane + 64] = rb[q]; } }
        __syncthreads();
    }
}
DI void moe_final(const Frame& F, const bf16_t* xb, float* out, const bf16_t* Y, const int* POS, const float* TW, const float* fg) {
    const int lane = F.lane, gw = F.blk * 8 + F.wave, NGW = F.G * 8;
    int pn0 = 0, pn1 = 0; float wn0 = 0.f, wn1 = 0.f;
    if (gw < NTOK) { pn0 = POS[2 * (size_t)gw]; pn1 = POS[2 * (size_t)gw + 1]; wn0 = TW[2 * (size_t)gw]; wn1 = TW[2 * (size_t)gw + 1]; }
    for (int row = gw; row < NTOK; row += NGW) {
        const int p0 = pn0, p1 = pn1; const float w0 = wn0, w1 = wn1;
        { const size_t rn = (size_t)(row + NGW < NTOK ? row + NGW : row); pn0 = POS[2 * rn]; pn1 = POS[2 * rn + 1]; wn0 = TW[2 * rn]; wn1 = TW[2 * rn + 1]; }
        f32x4* xr = (f32x4*)(out + (size_t)row * 1024) + lane; const u32x2* xs = (const u32x2*)(xb + (size_t)row * 1024) + lane; const u32x2* y0 = (const u32x2*)(Y + (size_t)p0 * 1024) + lane; const u32x2* y1 = (const u32x2*)(Y + (size_t)p1 * 1024) + lane;
        f32x4 v[4]; float ss = 0.f; u32x2 ya[4], yb[4];
#pragma unroll
        for (int j = 0; j < 4; ++j) { const u32x2 xv = xs[64 * j]; v[j] = (f32x4){__uint_as_float(xv.x << 16), __uint_as_float(xv.x & 0xffff0000u), __uint_as_float(xv.y << 16), __uint_as_float(xv.y & 0xffff0000u)}; ya[j] = y0[64 * j]; yb[j] = y1[64 * j]; }
#pragma unroll
        for (int j = 0; j < 4; ++j) { const u32x2 a = ya[j], b = yb[j];
            v[j].x += w0 * __uint_as_float(a.x << 16) + w1 * __uint_as_float(b.x << 16); v[j].y += w0 * __uint_as_float(a.x & 0xffff0000u) + w1 * __uint_as_float(b.x & 0xffff0000u);
            v[j].z += w0 * __uint_as_float(a.y << 16) + w1 * __uint_as_float(b.y << 16); v[j].w += w0 * __uint_as_float(a.y & 0xffff0000u) + w1 * __uint_as_float(b.y & 0xffff0000u);
            ss += (v[j].x * v[j].x + v[j].y * v[j].y) + (v[j].z * v[j].z + v[j].w * v[j].w); }
        ss = wave_sum(ss); const float r = rsqrtf(ss * (1.0f / 1024.0f) + RMS_EPS);
#pragma unroll
        for (int j = 0; j < 4; ++j) { const f32x4 g = ((const f32x4*)fg)[lane + 64 * j]; xr[64 * j] = (f32x4){v[j].x * r * g.x, v[j].y * r * g.y, v[j].z * r * g.z, v[j].w * r * g.w}; }
    }
}
constexpr int SCAN_CUT = 32;
__global__ void __launch_bounds__(512, 2) mk_fwd(Params prm) {
    extern __shared__ __attribute__((aligned(16))) unsigned char lds_raw[];
    Frame F0;
    F0.lds = (LAS unsigned char*)lds_raw;
    F0.tid = threadIdx.x; F0.lane = F0.tid & 63; F0.wave = __builtin_amdgcn_readfirstlane(F0.tid >> 6); F0.G = gridDim.x; F0.blk = blockIdx.x;
    F0.ws = prm.ws;
    volatile LAS unsigned* MISC = (volatile LAS unsigned*)(F0.lds + LDS_MISC);
    if (F0.tid < 64) MISC[F0.tid] = 0u;
    __syncthreads();
    XcdBarrier bar; bar.bar = (unsigned*)(prm.ws + WS_CTL); bar.x = 0; bar.st = MISC;
#if MK_SINGLE
    bar = xcd_barrier_post((unsigned*)(prm.ws + WS_CTL), MISC);
#endif
    const int lo = prm.ph_lo, hi = prm.ph_hi; int ph = 0;
#ifndef DBG_REP_CLASS
#define DBG_REP_CLASS 0
#endif
#define REPEAT(cls) for (int rep_ = 0; rep_ < ((DBG_REP_CLASS == (cls)) ? 2 : 1); ++rep_)
#define REPBAR(cls) do { if (DBG_REP_CLASS == (cls) && rep_ == 0) xcd_barrier(bar); } while (0)
#define ACTIVE() (ph >= lo && ph < hi)
#define SEAM() do { if (ph + 1 < hi) xcd_barrier(bar); } while (0)
    LAS unsigned char* glds = F0.lds;
#define PTRS() unsigned char* ws = prm.ws; asm volatile("" : "+s"(ws)); Frame F = F0; { int w_ = F0.wave; asm volatile("" : "+s"(w_)); int l_ = (int)__builtin_amdgcn_mbcnt_hi(~0u, __builtin_amdgcn_mbcnt_lo(~0u, 0u)); asm volatile("" : "+v"(l_)); F.wave = w_; F.lane = l_; F.tid = w_ * 64 + l_; } F.ws = ws; unsigned char* ar = ws + WS_ARENA; (void)ar; \
    bf16_t* xb = (bf16_t*)(ws + WS_XB); float* ssq = (float*)(ws + WS_SSQ); const float* rope = (const float*)(ws + WS_ROPE); float* xout = prm.out; (void)xb; (void)ssq; (void)rope; (void)xout; \
    unsigned char* lw = ws + WS_LW + (size_t)layer * LW_STRIDE; (void)lw; const float* sm = (const float*)(ws + WS_SMALL); (void)sm
#define GPTRS() PTRS(); const bf16_t* xbg = xb + (size_t)grp * NG * 1024; const float* ssqg = ssq + (size_t)grp * NG * 16; const float* ropeg = rope + (size_t)grp * NG * 16; \
    bf16_t* Pb = (bf16_t*)(ar + AR_P); float* BA = (float*)(ar + AR_BA); bf16_t* BR = (bf16_t*)(ar + AR_BR); float* KBAR = (float*)(ar + AR_KBAR); bf16_t* VT = (bf16_t*)(ar + AR_VT); \
    bf16_t* QD = (bf16_t*)(ar + AR_QD); bf16_t* MM = (bf16_t*)(ar + AR_KDT); bf16_t* NT = (bf16_t*)(ar + AR_NT); bf16_t* SG = (bf16_t*)(ar + AR_SG); bf16_t* ZB = (bf16_t*)(ar + AR_ZB); unsigned* SELG = (unsigned*)(ar + AR_SELG); int* CNTG = (int*)(ar + AR_CNTG); unsigned char* LISTG = (unsigned char*)(ar + AR_LISTG); bf16_t* OPG = (bf16_t*)(ar + AR_OPG); float* MLG = (float*)(ar + AR_MLG); bf16_t* WN = (bf16_t*)(ar + AR_WN); bf16_t* UT = (bf16_t*)(ar + AR_UT); bf16_t* AQK = (bf16_t*)(ar + AR_AQK); float* GL = (float*)(ar + AR_GL); \
    bf16_t* MG = (bf16_t*)(ar + AR_MERGED); \
    (void)xbg; (void)ssqg; (void)ropeg; (void)Pb; (void)BA; (void)BR; (void)KBAR; (void)VT; (void)QD; (void)MM; (void)NT; (void)SG; (void)ZB; (void)SELG; (void)CNTG; (void)LISTG; (void)OPG; (void)MLG; (void)WN; (void)UT; (void)AQK; (void)GL; (void)MG
#define MPTRS() PTRS(); int* TE = (int*)(ar + AR_TE); float* TW = (float*)(ar + AR_TW); float* RR = (float*)(ar + AR_RR); int* POS = (int*)(ar + AR_POS); int* CNT = (int*)(ar + AR_CNT); \
    bf16_t* XP = (bf16_t*)(ar + AR_XP); float* RP = (float*)(ar + AR_RP); bf16_t* HM = (bf16_t*)(ar + AR_HM); (void)TE; (void)TW; (void)RR; (void)POS; (void)CNT; (void)XP; (void)RP; (void)HM

    if (ACTIVE()) { REPEAT(1) { const int layer = 0; PTRS();
        const __attribute__((address_space(4))) Params* kp = (const __attribute__((address_space(4))) Params*)__builtin_amdgcn_kernarg_segment_ptr(); asm volatile("" : "+s"(kp));
        Params lp;
#pragma unroll
        for (int i = 0; i < 27; ++i) lp.in[i] = kp->in[i];
        lp.out = nullptr; lp.ws = ws; lp.ph_lo = 0; lp.ph_hi = 0; lp.pad0 = 0; lp.pad1 = 0;
        phase_prologue(F, lp); REPBAR(1); } SEAM(); } ++ph;
    for (int layer = 0; layer < 2; ++layer) {
        for (int grp = 0; grp < NGRP; ++grp) {
            if (ACTIVE()) { REPEAT(3) {
                GPTRS();
                pg8::Gemm g{xbg, (const bf16_t*)(lw + LW_WIN), 1024, 1024};
                pg8::SchedPlain S; S.init(NG, 3072, 1024, 1024, 1024, F.G, F.blk);
                pg8::build_rtab(glds, S, ssqg, nullptr, F.tid);
                pg8::EpiScaleBf16 E{Pb, PLD, ssqg, 0, ZB, 512, 10, (const LAS float*)(glds + pg8::RTAB_OFF)};
                pg8::gemm_phase(glds, g, S, E, F.wave);
                ba_tiles(F, xbg, (const bf16_t*)(lw + LW_WBA), ssqg, BA);
                REPBAR(3); }
                SEAM();
            } ++ph;
            if (ACTIVE()) {
                GPTRS();
                REPEAT(4) {
                for (int u = F.blk; u < 1024; u += F.G)
                    prep_dn(F, Pb, BA, sm + SM_CONVW + (size_t)layer * 4 * 1536, sm + SM_ALOG + layer * 8, sm + SM_DTB + layer * 8, QD, MM, NT, WN, UT, AQK, GL, u);
#ifndef DBG_RPOOL
#define DBG_RPOOL 1
#endif
                for (int rpP = 0; rpP < DBG_RPOOL; ++rpP) for (int u = F.blk; u < NG / 64; u += F.G) prep_pool(F, Pb, BR, u);
                REPBAR(4); }
                for (int u = F.blk; u < GB * 32; u += F.G) prep_moba(F, Pb, ropeg, KBAR, VT, u);
                SEAM();
            } ++ph;
            if (ACTIVE()) { REPEAT(18) {
                GPTRS();
                if (F.blk < GB * 8) { if (MK_SINGLE) dn_scan(F, F.blk, MM, NT, SG, 0, SCAN_CUT); }
                else { const int nw = F.G - GB * 8;
                    for (int u = F.blk - GB * 8; u < GB * 4 * 32; u += nw) { const int c = 31 - u / (GB * 4), bh = u % (GB * 4); moba_gate_unit(F, Pb, KBAR, SELG, LISTG, CNTG, bh >> 2, bh & 3, c); } }
                REPBAR(18); }
                SEAM();
            } ++ph;
            if (ACTIVE()) { REPEAT(5) {
                GPTRS();
                if (F.blk < GB * 8) { for (int r2_ = 0; r2_ < ((DBG_REP_CLASS == 16) ? 2 : 1); ++r2_) dn_scan(F, F.blk, MM, NT, SG, MK_SINGLE ? SCAN_CUT : 0, 127, r2_ == 0); }
                else { const int nw = F.G - GB * 8, wq = F.blk - GB * 8;
                    for (int r2_ = 0; r2_ < ((DBG_REP_CLASS == 17) ? 2 : 1); ++r2_)
                    for (int rd = 0; rd * nw < KV_NITEMS; ++rd) { const int i = rd * nw + ((rd & 1) ? nw - 1 - wq : wq); if (i >= KV_NITEMS) continue;
                        int n, part, bh;
                        if (i < 48) { n = 0; part = i >> 4; bh = i & 15; } else if (i < 272) { const int j = i - 48; n = 1 + (j >> 5); part = (j >> 4) & 1; bh = j & 15; } else { const int j = i - 272; n = 8 + (j >> 4); part = 0; bh = j & 15; }
                        moba_kv_unit(F, Pb, VT, SELG, LISTG, CNTG, OPG, MLG, bh >> 2, bh & 3, n, part, n == 0 ? 3 : (n < 8 ? 2 : 1)); } }
                if (layer == 0 && grp == 0) {
                    __syncthreads();
                    pg8::Gemm gk{(const bf16_t*)(ws + WS_MEMN), (const bf16_t*)(ws + WS_LW + LW_WKV), 1024, 1024};
                    pg8::SchedKV Sk; Sk.c = F.blk - GB * 8; Sk.lstride = LW_STRIDE;
                    pg8::EpiScaleBf16 Ek{(bf16_t*)(ws + WS_KVM), 1024, nullptr, 0, nullptr, 0, 1 << 30, nullptr};
                    pg8::gemm_phase(glds, gk, Sk, Ek, F.wave); }
                REPBAR(5); }
                SEAM();
            } ++ph;
            if (ACTIVE()) { REPEAT(6) {
                GPTRS();
                pg8::Gemm g{(const bf16_t*)(ws + WS_X8 + (size_t)grp * NG * 1024), (const bf16_t*)(ws + WS_WG8 + (size_t)layer * 3072 * 1024), 1024, 1024};
                pg8::SchedPlain S; S.init(NG, 3072, 1024, 1024, 1024, F.G, F.blk, 1);
                moba_combine(F, SELG, OPG, MLG, BR);
                dn_out_pass(F, QD, WN, UT, AQK, SG, ZB, sm + SM_DNG + layer * 64, BR);
                pg8::build_rtab(glds, S, ssqg, nullptr, F.tid);
                pg8::EpiScaleBf16 E{Pb, PLD, ssqg, 1, nullptr, 0, 1 << 30, (const LAS float*)(glds + pg8::RTAB_OFF)};
                pg8::gemm_phase<pg8::EpiScaleBf16, pg8::SchedPlain, true>(glds, g, S, E, F.wave);
                REPBAR(6); }
                SEAM();
            } ++ph;
            if (ACTIVE()) { REPEAT(7) {
                GPTRS();
                pg8::Gemm g{BR, (const bf16_t*)(lw + LW_WCAT), 1024, 1024};
                pg8::SchedPlain S; S.init(NG, 1024, 1024, 1024, 1024, F.G, F.blk);
                pg8::EpiMerge E{Pb, MG};
                pg8::gemm_phase(glds, g, S, E, F.wave);
                REPBAR(7); }
                SEAM();
            } ++ph;
            if (ACTIVE()) { for (int rep_ = 0; rep_ < ((DBG_REP_CLASS == 8 && layer == 0) ? 2 : 1); ++rep_) {
                GPTRS();
                pg8::Gemm g{MG, (const bf16_t*)(lw + LW_WOUT), 1024, 1024};
                pg8::SchedPlain S; S.init(NG, 1024, 1024, 1024, 1024, F.G, F.blk);
                pg8::EpiResid E{xb + (size_t)grp * NG * 1024, ssq + (size_t)grp * NG * 16, ws + WS_X8 + (size_t)grp * NG * 1024};
                pg8::gemm_phase(glds, g, S, E, F.wave);
                REPBAR(8); }
                SEAM();
            } ++ph;
        }
        if (ACTIVE()) { REPEAT(9) {
            PTRS();
            pg8::Gemm g{xb, (const bf16_t*)(lw + LW_WQ), 1024, 1024};
            pg8::SchedPlain S; S.init(NTOK, 512, 1024, 1024, 1024, F.G, F.blk);
            pg8::build_rtab(glds, S, ssq, nullptr, F.tid);
            pg8::EpiScaleBf16 E{(bf16_t*)(ar + AR_QX), 512, ssq, 0, nullptr, 0, 1 << 30, (const LAS float*)(glds + pg8::RTAB_OFF)};
            pg8::gemm_phase(glds, g, S, E, F.wave);
            REPBAR(9); }
                SEAM();
        } ++ph;
        if (ACTIVE()) { REPEAT(10) {
            PTRS();
            for (int w = F.blk; w < 256; w += F.G) xattn_wg(F, (const bf16_t*)(ws + WS_KVM) + (size_t)layer * 2048 * 1024, (const bf16_t*)(ar + AR_QX), (bf16_t*)(ar + AR_AO), w);
            REPBAR(10); }
                SEAM();
        } ++ph;
        if (ACTIVE()) {
            PTRS();
            pg8::Gemm g{(const bf16_t*)(ar + AR_AO), (const bf16_t*)(lw + LW_WO), 512, 512};
            pg8::SchedPlain S; S.init(NTOK, 1024, 512, 512, 512, F.G, F.blk);
            pg8::EpiResid E{xb, ssq, ws + WS_X8};
            pg8::gemm_phase(glds, g, S, E, F.wave);
            SEAM();
        } ++ph;
        if (layer == 0) {
            if (ACTIVE()) { REPEAT(11) {
                PTRS();
                pg8::Gemm g{xb, (const bf16_t*)(ws + WS_WGU), 1024, 1024};
                pg8::SchedPlain S; S.init(NTOK, 2 * FF, 1024, 1024, 1024, F.G, F.blk);
                pg8::build_rtab(glds, S, ssq, nullptr, F.tid);
                pg8::EpiSwiglu E{(bf16_t*)(ar + AR_HID), FF, (const LAS float*)(glds + pg8::RTAB_OFF)};
                pg8::gemm_phase(glds, g, S, E, F.wave);
                REPBAR(11); }
                SEAM();
            } ++ph;
            if (ACTIVE()) {
                PTRS();
                pg8::Gemm g{(const bf16_t*)(ar + AR_HID), (const bf16_t*)(ws + WS_WD), FF, FF};
                pg8::SchedPlain S; S.init(NTOK, 1024, FF, FF, FF, F.G, F.blk);
                pg8::EpiResid E{xb, ssq, ws + WS_X8};
                pg8::gemm_phase(glds, g, S, E, F.wave);
                SEAM();
            } ++ph;
        } else {
            if (ACTIVE()) { REPEAT(12) { MPTRS(); moe_route1(F, xb, (const float*)(ws + WS_WR), TE, TW, RR, CNT); REPBAR(12); } SEAM(); } ++ph;
            if (ACTIVE()) { REPEAT(13) { MPTRS(); moe_route2(F, TE, RR, CNT, xb, POS, XP, RP); REPBAR(13); } SEAM(); } ++ph;
            if (ACTIVE()) { REPEAT(14) {
                MPTRS();
                LAS int* MB = (LAS int*)(F.lds + 49152); moe_bases(F, CNT, 0, MB);
                pg8::SchedMoe S;
#pragma unroll
                for (int e = 0; e < 9; ++e) S.pbase[e] = __builtin_amdgcn_readfirstlane(MB[e]);
                S.nN = 2 * EFF / 256; S.nt = 16; S.G = F.G; S.c = F.blk; S.astep = (size_t)256 * 1024 * 2; S.bstep = (size_t)256 * 1024 * 2; S.estep = (size_t)2 * EFF * 1024 * 2;
                __syncthreads();
                pg8::Gemm g{XP, (const bf16_t*)(ws + WS_WMGU), 1024, 1024};
                pg8::build_rtab(glds, S, nullptr, RP, F.tid);
                pg8::EpiSwiglu E{HM, EFF, (const LAS float*)(glds + pg8::RTAB_OFF)};
                pg8::gemm_phase(glds, g, S, E, F.wave);
                REPBAR(14); }
                SEAM();
            } ++ph;
            if (ACTIVE()) { REPEAT(15) {
                MPTRS();
                LAS int* MB = (LAS int*)(F.lds + 49152); moe_bases(F, CNT, 0, MB);
                pg8::SchedMoe S;
#pragma unroll
                for (int e = 0; e < 9; ++e) S.pbase[e] = __builtin_amdgcn_readfirstlane(MB[e]);
                S.nN = 4; S.nt = EFF / 64; S.G = F.G; S.c = F.blk; S.astep = (size_t)256 * EFF * 2; S.bstep = (size_t)256 * EFF * 2; S.estep = (size_t)1024 * EFF * 2;
                __syncthreads();
                pg8::Gemm g{HM, (const bf16_t*)(ws + WS_WMD), EFF, EFF};
                pg8::EpiScaleBf16 E{XP, 1024, nullptr, 0, nullptr, 0, 1 << 30, nullptr};
                pg8::gemm_phase(glds, g, S, E, F.wave);
                REPBAR(15); }
                SEAM();
            } ++ph;
            if (ACTIVE()) { MPTRS(); moe_final(F, xb, xout, XP, POS, TW, sm + SM_FING); SEAM(); } ++ph;
        }
    }
#undef ACTIVE
#undef REPEAT
#undef REPBAR
#undef SEAM
#undef PTRS
#undef GPTRS
#undef MPTRS
}

#ifdef DBG_DUMP_OFF
__global__ void dbg_dump(float* out, const unsigned char* ws) {
    const bf16_t* src = (const bf16_t*)(ws + (size_t)DBG_DUMP_OFF);
    for (size_t i = (size_t)blockIdx.x * blockDim.x + threadIdx.x; i < (size_t)NTOK * 1024; i += (size_t)gridDim.x * blockDim.x) { float v = i < (size_t)DBG_DUMP_N ? bf2f(src[i]) : 0.f; if (!(v == v) || v > 1e30f || v < -1e30f) v = 12345.0f; out[i] = v; }
}
#endif
extern "C" void kernel_launch(void* const* d_in, const int* in_sizes, int n_in, void* d_out, int out_size, void* d_ws, size_t ws_size, hipStream_t stream) {
    static int grid = 0;
    if (grid == 0) {
        if (n_in != 27 || in_sizes[0] != NTOK * DM || out_size != NTOK * DM || ws_size < WS_END) {
            fprintf(stderr, "kernel_launch: unexpected problem (n_in %d, in0 %d, out %d, ws %zu < %zu); nothing launched\n", n_in, n_in > 0 ? in_sizes[0] : -1, out_size, ws_size, (size_t)WS_END); grid = -1; return; }
        int dev = 0, cus = 0;
        if (hipGetDevice(&dev) != hipSuccess || hipDeviceGetAttribute(&cus, hipDeviceAttributeMultiprocessorCount, dev) != hipSuccess) { grid = -1; return; }
        if (hipFuncSetAttribute((const void*)mk_fwd, hipFuncAttributeMaxDynamicSharedMemorySize, LDS_BYTES) != hipSuccess) { fprintf(stderr, "kernel_launch: hipFuncSetAttribute failed\n"); grid = -1; return; }
        int per_cu = 0;
        if (hipOccupancyMaxActiveBlocksPerMultiprocessor(&per_cu, (const void*)mk_fwd, 512, LDS_BYTES) != hipSuccess || per_cu < 1) { fprintf(stderr, "kernel_launch: occupancy query says %d\n", per_cu); }
        (void)hipGetLastError();
        grid = cus > 256 ? 256 : cus;
    }
    if (grid < 0) return;
    (void)hipMemsetAsync((char*)d_ws + WS_CTL, 0, CTL_BYTES, stream);
    Params p{};
    for (int i = 0; i < 27; ++i) p.in[i] = (const float*)d_in[i];
    p.out = (float*)d_out; p.ws = (unsigned char*)d_ws; p.pad0 = 0; p.pad1 = 0;
#if MK_SINGLE
    p.ph_lo = 0; p.ph_hi = NPH;
    hipLaunchKernelGGL(mk_fwd, dim3(grid), dim3(512), LDS_BYTES, stream, p);
#else
#ifndef DBG_NPH
#define DBG_NPH NPH
#endif
    for (int k = 0; k < DBG_NPH; ++k) { p.ph_lo = k; p.ph_hi = k + 1; hipLaunchKernelGGL(mk_fwd, dim3(grid), dim3(512), LDS_BYTES, stream, p); }
#ifdef DBG_DUMP_OFF
    hipLaunchKernelGGL(dbg_dump, dim3(2048), dim3(256), 0, stream, (float*)d_out, (const unsigned char*)d_ws);
#endif
#endif
}
```

```cpp
#include <hip/hip_runtime.h>
#include <cstdio>
#include <cstdint>

#define LAS __attribute__((address_space(3)))
#define DI __device__ __forceinline__
typedef unsigned short bf16_t;
typedef short bf16x8 __attribute__((ext_vector_type(8)));
typedef short s16x4 __attribute__((ext_vector_type(4)));
typedef float f32x4 __attribute__((ext_vector_type(4)));
typedef float f32x2 __attribute__((ext_vector_type(2)));
typedef unsigned u32x4 __attribute__((ext_vector_type(4)));
typedef unsigned u32x2 __attribute__((ext_vector_type(2)));

#ifndef MK_SINGLE
#define MK_SINGLE 1
#endif

constexpr int NTOK = 65536, DM = 1024, SEQ = 8192, NBATCH = 8;
constexpr int NGRP = 2, NG = NTOK / NGRP, GB = NBATCH / NGRP;
constexpr int PLD = 3072;
constexpr int PC_POOL = 0, PC_MQ = 256, PC_MK = 512, PC_MV = 768, PC_DQ = 1024, PC_DK = 1536, PC_DV = 2048, PC_Z = 2560;
constexpr int IN_COLS = 6160;
constexpr int FF = 2816, EFF = 1408, NEXP = 8;
constexpr int MEMLEN = 256;
constexpr float RMS_EPS = 1e-6f;
constexpr int NPH = 1 + 2 * (NGRP * 7 + 3) + 2 + 5;

constexpr size_t MiB = 1u << 20;
constexpr size_t WS_CTL = 0, CTL_BYTES = 1 * MiB;
constexpr size_t LW_WIN = 0, LW_WCAT = LW_WIN + (size_t)6144 * 1024 * 2, LW_WOUT = LW_WCAT + (size_t)1024 * 1024 * 2, LW_WQ = LW_WOUT + (size_t)1024 * 1024 * 2,
                 LW_WKV = LW_WQ + (size_t)512 * 1024 * 2, LW_WO = LW_WKV + (size_t)1024 * 1024 * 2, LW_WBA = LW_WO + (size_t)1024 * 512 * 2, LW_STRIDE = LW_WBA + (size_t)16 * 1024 * 2;
constexpr size_t WS_LW = WS_CTL + CTL_BYTES;
constexpr size_t WS_WGU = WS_LW + 2 * LW_STRIDE;
constexpr size_t WS_WD = WS_WGU + (size_t)2 * FF * 1024 * 2;
constexpr size_t WS_WMGU = WS_WD + (size_t)1024 * FF * 2;
constexpr size_t WS_WMD = WS_WMGU + (size_t)NEXP * 2 * EFF * 1024 * 2;
constexpr size_t WS_WR = WS_WMD + (size_t)NEXP * 1024 * EFF * 2;
constexpr size_t WS_XB = (WS_WR + 8 * 1024 * 4 + MiB - 1) / MiB * MiB;
constexpr size_t WS_SSQ = WS_XB + (size_t)NTOK * 1024 * 2;
constexpr size_t WS_ROPE = WS_SSQ + (size_t)NTOK * 16 * 4;
constexpr size_t WS_MEMN = WS_ROPE + (size_t)NTOK * 16 * 4;
constexpr size_t WS_KVM = WS_MEMN + (size_t)2 * 2048 * 1024 * 2;
constexpr size_t WS_SMALL = WS_KVM + (size_t)2 * 2048 * 1024 * 2;
constexpr int SM_CONVW = 0, SM_ALOG = SM_CONVW + 2 * 4 * 1536, SM_DTB = SM_ALOG + 16, SM_DNG = SM_DTB + 16, SM_FING = SM_DNG + 128, SM_END = SM_FING + 1024;
constexpr size_t WS_X8 = WS_SMALL + 65536;
constexpr size_t WS_WG8 = WS_X8 + (size_t)NTOK * 1024;
constexpr size_t WS_ARENA = WS_WG8 + (size_t)2 * 3072 * 1024;
constexpr size_t AR_P = 0;
constexpr size_t AR_BA = AR_P + (size_t)NG * PLD * 2;
constexpr size_t AR_BR = AR_BA + (size_t)NG * 16 * 4;
constexpr size_t AR_KBAR = AR_BR + (size_t)NG * 1024 * 2;
constexpr size_t AR_VT = AR_KBAR + (size_t)GB * 4 * 32 * 64 * 4;
constexpr int NCH = GB * 128 * 8;
constexpr size_t AR_QD = AR_VT + (size_t)GB * 4 * 64 * SEQ * 2;
constexpr size_t AR_KDT = AR_QD + (size_t)NCH * 8192;
constexpr size_t AR_WN = AR_KDT + (size_t)NCH * 8192;
constexpr size_t AR_UT = AR_WN + (size_t)NCH * 8192;
constexpr size_t AR_AQK = AR_UT + (size_t)NCH * 8192;
constexpr size_t AR_NT = AR_AQK + (size_t)NCH * 8192;
constexpr size_t AR_SG = AR_NT + (size_t)NCH * 8192;
constexpr size_t AR_ZB = AR_SG + (size_t)NCH * 8192;
constexpr size_t AR_GL = AR_ZB + (size_t)NG * 512 * 2;
constexpr size_t AR_SELG = AR_GL + (size_t)NCH * 4 + 65536 - ((size_t)NCH * 4) % 65536;
constexpr size_t AR_CNTG = AR_SELG + (size_t)NG * 4 * 4;
constexpr size_t AR_LISTG = AR_CNTG + (size_t)GB * 4 * 32 * 32 * 4;
constexpr size_t AR_OPG = AR_LISTG + (size_t)GB * 4 * 32 * 32 * 256;
constexpr size_t AR_MLG = AR_OPG + (size_t)NG * 4 * 4 * 64 * 2;
constexpr size_t AR_MERGED = AR_MLG + (size_t)NG * 4 * 4 * 2 * 4;
constexpr size_t AR_MIX_END = AR_MERGED + (size_t)NG * 1024 * 2;
constexpr size_t AR_QX = 0, AR_AO = AR_QX + (size_t)NTOK * 512 * 2, AR_XA_END = AR_AO + (size_t)NTOK * 512 * 2;
constexpr size_t AR_HID = 0, AR_HID_END = (size_t)NTOK * FF * 2;
constexpr int MOE_ROWS = 2 * NTOK + 2048;
constexpr size_t AR_TE = 0, AR_TW = AR_TE + (size_t)NTOK * 8, AR_RR = AR_TW + (size_t)NTOK * 8, AR_POS = AR_RR + (size_t)NTOK * 4, AR_CNT = AR_POS + (size_t)NTOK * 8,
                 AR_XP = AR_CNT + 65536, AR_RP = AR_XP + (size_t)MOE_ROWS * 1024 * 2, AR_HM = AR_RP + (size_t)MOE_ROWS * 4 + 65536 - ((size_t)MOE_ROWS * 4) % 65536,
                 AR_MOE_END = AR_HM + (size_t)MOE_ROWS * EFF * 2;
constexpr size_t cmax(size_t a, size_t b) { return a > b ? a : b; }
constexpr size_t WS_END = WS_ARENA + cmax(cmax(AR_MIX_END, AR_XA_END), cmax(AR_HID_END, AR_MOE_END));
static_assert(AR_XA_END <= AR_MERGED, "xattn buffers must not overlap MERGED");
static_assert(SM_END * 4 <= 65536, "small-vector block");
static_assert(WS_END <= (size_t)1073741824, "workspace map exceeds 1 GiB");

constexpr int LDS_BYTES = 160 * 1024;
constexpr int LDS_MISC = 158 * 1024;

DI float bf2f(unsigned short b) { return __uint_as_float(((unsigned)b) << 16); }
DI unsigned f2bf(float f) { unsigned u = __float_as_uint(f); return (u + 0x7fffu + ((u >> 16) & 1u)) >> 16; }
DI unsigned pk2(float lo, float hi) { return f2bf(lo) | (f2bf(hi) << 16); }
typedef __bf16 bf16v2_t __attribute__((ext_vector_type(2)));
DI unsigned cvt_pk_bf16(float lo, float hi) { bf16v2_t v; v.x = (__bf16)lo; v.y = (__bf16)hi; return __builtin_bit_cast(unsigned, v); }
DI unsigned cvt4_fp8(float a, float b, float c, float d) { unsigned w = 0u; w = __builtin_amdgcn_cvt_pk_fp8_f32(a, b, w, false); w = __builtin_amdgcn_cvt_pk_fp8_f32(c, d, w, true); return w; }
DI float wave_sum(float v) {
#pragma unroll
    for (int o = 1; o < 64; o <<= 1) v += __shfl_xor(v, o);
    return v;
}
DI float fsigmoid(float x) { return __builtin_amdgcn_rcpf(1.0f + __builtin_amdgcn_exp2f(-1.44269504089f * x)); }
DI float row_rstd(const float* ssqp, int row) {
    const f32x4* p = (const f32x4*)(ssqp + (size_t)row * 16);
    const f32x4 a = p[0], b = p[1], c = p[2], d = p[3];
    const float s = (((a.x + a.y) + (a.z + a.w)) + ((b.x + b.y) + (b.z + b.w))) + (((c.x + c.y) + (c.z + c.w)) + ((d.x + d.y) + (d.z + d.w)));
    return rsqrtf(s * (1.0f / 1024.0f) + RMS_EPS);
}
#define LAUNDER_V(x) asm volatile("" : "+v"(x))
#define LDS_WAIT() asm volatile("s_waitcnt lgkmcnt(0)" ::: "memory")
#define VM_WAIT() asm volatile("s_waitcnt vmcnt(0)" ::: "memory")
#define WG_BAR() do { asm volatile("s_waitcnt lgkmcnt(0)" ::: "memory"); __builtin_amdgcn_s_barrier(); asm volatile("" ::: "memory"); } while (0)
#define MFMA16(a, b, c) __builtin_amdgcn_mfma_f32_16x16x32_bf16((a), (b), (c), 0, 0, 0)

#define XB_TMO      128
#define XB_XCNT(j)  (256  + 64 * (j))
#define XB_XSUB(j)  (1280 + 64 * (j))
#define XB_XGEN(j)  (2304 + 64 * (j))
#define XB_TOP      3328
#define XB_TOPGEN   3392
#define XCD_BAR_WORDS 3456
#define XB_SPIN_CAP (1u << 22)

DI unsigned xb_ld(unsigned* p)              { return __hip_atomic_load(p, __ATOMIC_RELAXED, __HIP_MEMORY_SCOPE_AGENT); }
DI unsigned xb_add(unsigned* p, unsigned v) { return __hip_atomic_fetch_add(p, v, __ATOMIC_RELAXED, __HIP_MEMORY_SCOPE_AGENT); }
DI unsigned xb_xcc_id() { return (unsigned)__builtin_amdgcn_s_getreg((3 << 11) | 20) & 0xFu; }
#define XB_SPIN(cond, bar) do { unsigned _sp = 0; while (cond) { __builtin_amdgcn_s_sleep(1); \
    if ((++_sp & 255u) == 0u) { if (xb_ld(&(bar)[XB_TMO])) break; if (_sp > XB_SPIN_CAP) { atomicAdd(&(bar)[XB_TMO], 1u); break; } } } } while (0)

struct XcdBarrier { unsigned* bar; unsigned x; volatile LAS unsigned* st; };

DI XcdBarrier xcd_barrier_post(unsigned* bar, volatile LAS unsigned* st) {
    XcdBarrier b; b.bar = bar; b.x = xb_xcc_id(); b.st = st;
    if (threadIdx.x == 0) (void)xb_add(&bar[XB_XCNT(b.x)], 1u);
    return b;
}
DI void xcd_barrier_complete(unsigned* bar, unsigned x, unsigned& nloc, unsigned& nx) {
    const unsigned G = gridDim.x * gridDim.y * gridDim.z;
    unsigned sum, cnt, mine, sp = 0u;
    for (;;) {
        sum = 0u; cnt = 0u; mine = 0u;
#pragma unroll
        for (unsigned j = 0; j < 16; ++j) { const unsigned c = xb_ld(&bar[XB_XCNT(j)]); sum += c; cnt += (c > 0u) ? 1u : 0u; mine = (j == x) ? c : mine; }
        if (sum == G) break;
        __builtin_amdgcn_s_sleep(1);
        if ((++sp & 255u) == 0u) { if (xb_ld(&bar[XB_TMO])) break; if (sp > XB_SPIN_CAP) { atomicAdd(&bar[XB_TMO], 1u); break; } }
    }
    nloc = mine > 0u ? mine : 1u; nx = cnt > 0u ? cnt : 1u;
}
DI void xcd_barrier(const XcdBarrier& b) {
    asm volatile("s_waitcnt vmcnt(0)" ::: "memory");
    __syncthreads();
    if (threadIdx.x == 0) {
        unsigned* bar = b.bar;
        __builtin_amdgcn_s_waitcnt(0);
        unsigned nloc = b.st[0], nx = b.st[1];
        if (nloc == 0u) { xcd_barrier_complete(bar, b.x, nloc, nx); b.st[0] = nloc; b.st[1] = nx; }
        const unsigned old = xb_add(&bar[XB_XSUB(b.x)], 1u);
        const unsigned gen = old / nloc;
        if (old + 1u == (gen + 1u) * nloc) {
            __builtin_amdgcn_fence(__ATOMIC_RELEASE, "agent");
            asm volatile("s_waitcnt vmcnt(0)" ::: "memory");
            const unsigned og = xb_add(&bar[XB_TOP], 1u);
            const unsigned tg = og / nx;
            if (og + 1u == (tg + 1u) * nx) xb_add(&bar[XB_TOPGEN], 1u);
            else XB_SPIN(xb_ld(&bar[XB_TOPGEN]) == tg, bar);
            __builtin_amdgcn_fence(__ATOMIC_ACQUIRE, "agent");
            xb_add(&bar[XB_XGEN(b.x)], 1u);
            asm volatile("s_waitcnt vmcnt(0)" ::: "memory");
        } else {
            XB_SPIN(xb_ld(&bar[XB_XGEN(b.x)]) == gen, bar);
            __builtin_amdgcn_fence(__ATOMIC_ACQUIRE, "agent");
            asm volatile("s_waitcnt vmcnt(0)" ::: "memory");
        }
    }
    __syncthreads();
}
namespace pg8 {
constexpr int BM = 256, BK = 64, HALF = 128, HTB = HALF * BK * 2, STAGE_BYTES = 8 * HTB, NXCD = 8, WGM = 8;
__host__ __device__ __forceinline__ int lds_byte(int r, int c) { const int st = (r >> 4) * 2 + (c >> 5), rr = r & 15, cc = c & 31, ob = rr * 64 + cc * 2; return st * 1024 + (ob ^ (((ob >> 9) & 1) << 5)); }
__host__ __device__ __forceinline__ void stage_rc(int b, int& R, int& C) { const int st = b / 1024, sb = b % 1024, swz = sb ^ (((sb >> 9) & 1) << 5); R = (st >> 1) * 16 + swz / 64; C = (st & 1) * 32 + (swz % 64) / 2; }
__host__ __device__ __forceinline__ int perm32(int rho) { const int n = rho >> 4, i = rho & 15; return 8 * (i >> 2) + 4 * n + (i & 3); }

struct Unit { int pm, pn, nt, tag, ord; size_t aoff, boff; };
struct Gemm { const bf16_t* A; const bf16_t* Bt; int lda, ldb; };

struct TileOrder {
    int nM, nN, nwg, G, c;
    DI void init(int nM_, int nN_, int G_, int c_) { nM = nM_; nN = nN_; nwg = nM * nN; G = G_; c = c_; }
    DI bool tile(int i, int& pm, int& pn) const {
        const long L = (long)i * G + c; if (L >= nwg) return false;
        int wgid = (int)L; { const int q = nwg / NXCD, r = nwg % NXCD, xcd = wgid % NXCD, off = wgid / NXCD; wgid = (xcd < r ? xcd * (q + 1) : r * (q + 1) + (xcd - r) * q) + off; }
        const int nig = WGM * nN, gid = wgid / nig, fm = gid * WGM, gsz = (nM - fm) < WGM ? (nM - fm) : WGM;
        pm = fm + ((wgid % nig) % gsz); pn = (wgid % nig) / gsz; return true;
    }
};
struct SchedPlain {
    TileOrder T; int nt; size_t astep, bstep;
    DI void init(int M, int N, int K, int lda, int ldb, int G, int c, int esz = 2) { T.init(M / BM, N / BM, G, c); nt = K * esz / (BK * 2); astep = (size_t)BM * lda * esz; bstep = (size_t)BM * ldb * esz; }
    DI bool next(int i, Unit& u) const { if (!T.tile(i, u.pm, u.pn)) return false; u.nt = nt; u.tag = 0; u.ord = i; u.aoff = (size_t)u.pm * astep; u.boff = (size_t)u.pn * bstep; return true; }
};
struct SchedMerge {
    TileOrder T; size_t astep, bstep;
    DI void init(int M, int N, int lda, int ldb, int G, int c) { T.init(M / BM, N / BM, G, c); astep = (size_t)BM * lda * 2; bstep = (size_t)BM * ldb * 2; }
    DI bool next(int i, Unit& u) const {
        const int ti = i / 3, br = i - 3 * ti; if (!T.tile(ti, u.pm, u.pn)) return false;
        const int kofs = br == 0 ? 0 : (br == 1 ? 256 : 512);
        u.nt = br == 2 ? 8 : 4; u.tag = br; u.aoff = (size_t)u.pm * astep + (size_t)kofs * 2; u.boff = (size_t)u.pn * bstep + (size_t)kofs * 2; return true;
    }
};
struct SchedKV {
    int c; size_t lstride;
    DI bool next(int i, Unit& u) const {
        if (i != 0 || c < 0 || c >= 64) return false;
        const int layer = c >> 5, r = c & 31; u.pm = layer * 8 + (r >> 2); u.pn = r & 3; u.nt = 16; u.tag = 0; u.ord = 0;
        u.aoff = (size_t)u.pm * BM * 1024 * 2; u.boff = (size_t)layer * lstride + (size_t)u.pn * BM * 1024 * 2; return true;
    }
};
struct SchedMoe {
    int pbase[9]; int nN, nt, G, c; size_t astep, bstep, estep;
    DI bool next(int i, Unit& u) const {
        const long L = (long)i * G + c; const int tot = pbase[8] * nN; if (L >= tot) return false;
        const int gp = (int)(L / nN), pn = (int)(L - (long)gp * nN);
        int e = 0;
#pragma unroll
        for (int j = 1; j < 8; ++j) e += (gp >= pbase[j]) ? 1 : 0;
        u.pm = gp; u.pn = pn; u.nt = nt; u.tag = e; u.ord = i; u.aoff = (size_t)gp * astep; u.boff = (size_t)e * estep + (size_t)pn * bstep; return true;
    }
};

constexpr int RTAB_OFF = STAGE_BYTES, RTAB_MAX_UNITS = 26;
template <class Sched> DI void build_rtab(LAS unsigned char* lds, const Sched& S, const float* ssqp, const float* rvec, int tid) {
    LAS float* rt = (LAS float*)(lds + RTAB_OFF); Unit u;
    for (int i = tid >> 8; S.next(i, u); i += 2) { if (i >= RTAB_MAX_UNITS) break; const int r = tid & 255, row = u.pm * BM + r; rt[i * 256 + r] = rvec ? rvec[row] : row_rstd(ssqp, row); }
    __syncthreads();
}
struct EpiScaleBf16 { static constexpr bool MID = false;
    bf16_t* O; int ldo; const float* ssqp; int act; bf16_t* O2; int ldo2, pn2; const LAS float* rtab;
    DI void operator()(const f32x4 (&acc)[2][2][4][2], const Unit& u, int wr, int wc, int fr, int fq) const {
        const bool alt = u.pn >= pn2; bf16_t* const Ob = alt ? O2 : O; const int ld = alt ? ldo2 : ldo;
        const int row0 = u.pm * BM + wr * 64 + fr, col0 = (alt ? u.pn - pn2 : u.pn) * BM + wc * 32 + 8 * fq;
#pragma unroll
        for (int ai = 0; ai < 2; ++ai)
#pragma unroll
            for (int m = 0; m < 4; ++m) { const int row = row0 + ai * HALF + m * 16; const float r = ssqp ? rtab[u.ord * 256 + (row & 255)] : 1.0f; bf16_t* rowp = Ob + (size_t)row * ld + col0;
#pragma unroll
                for (int bj = 0; bj < 2; ++bj) { f32x4 v0 = acc[ai][bj][m][0] * r, v1 = acc[ai][bj][m][1] * r;
                    if (act) {
#pragma unroll
                        for (int j = 0; j < 4; ++j) { v0[j] = fsigmoid(v0[j]); v1[j] = fsigmoid(v1[j]); } }
                    u32x4 w; w.x = cvt_pk_bf16(v0[0], v0[1]); w.y = cvt_pk_bf16(v0[2], v0[3]); w.z = cvt_pk_bf16(v1[0], v1[1]); w.w = cvt_pk_bf16(v1[2], v1[3]);
                    *(u32x4*)(rowp + bj * HALF) = w; } }
    }
};
struct EpiResid { static constexpr bool MID = false;
    bf16_t* xb; float* ssqp; unsigned char* x8;
    DI void operator()(const f32x4 (&acc)[2][2][4][2], const Unit& u, int wr, int wc, int fr, int fq) const {
        const int row0 = u.pm * BM + wr * 64 + fr, col0 = u.pn * BM + wc * 32 + 8 * fq;
#pragma unroll
        for (int ai = 0; ai < 2; ++ai)
#pragma unroll
            for (int m = 0; m < 4; ++m) { const int row = row0 + ai * HALF + m * 16; const size_t off = (size_t)row * 1024 + col0; float ss = 0.f;
#pragma unroll
                for (int bj = 0; bj < 2; ++bj) {
                    const u32x4 xo = *(const u32x4*)(xb + off + bj * HALF);
                    f32x4 x0 = (f32x4){__uint_as_float(xo.x << 16), __uint_as_float(xo.x & 0xffff0000u), __uint_as_float(xo.y << 16), __uint_as_float(xo.y & 0xffff0000u)};
                    f32x4 x1 = (f32x4){__uint_as_float(xo.z << 16), __uint_as_float(xo.z & 0xffff0000u), __uint_as_float(xo.w << 16), __uint_as_float(xo.w & 0xffff0000u)};
                    x0 += acc[ai][bj][m][0]; x1 += acc[ai][bj][m][1];
                    u32x4 w; w.x = cvt_pk_bf16(x0[0], x0[1]); w.y = cvt_pk_bf16(x0[2], x0[3]); w.z = cvt_pk_bf16(x1[0], x1[1]); w.w = cvt_pk_bf16(x1[2], x1[3]);
                    *(u32x4*)(xb + off + bj * HALF) = w;
                    { u32x2 w8; w8.x = cvt4_fp8(x0[0], x0[1], x0[2], x0[3]); w8.y = cvt4_fp8(x1[0], x1[1], x1[2], x1[3]); *(u32x2*)(x8 + off + bj * HALF) = w8; }
                    ss += (x0[0] * x0[0] + x0[1] * x0[1]) + (x0[2] * x0[2] + x0[3] * x0[3]) + (x1[0] * x1[0] + x1[1] * x1[1]) + (x1[2] * x1[2] + x1[3] * x1[3]); }
                ss += __shfl_xor(ss, 16); ss += __shfl_xor(ss, 32);
                if (fq == 0) ssqp[(size_t)row * 16 + u.pn * 4 + wc] = ss; }
    }
};
struct EpiSwiglu { static constexpr bool MID = false;
    bf16_t* H; int ldh; const LAS float* rtab;
    DI void operator()(const f32x4 (&acc)[2][2][4][2], const Unit& u, int wr, int wc, int fr, int fq) const {
        const int row0 = u.pm * BM + wr * 64 + fr, col0 = u.pn * HALF + wc * 32 + 8 * fq;
#pragma unroll
        for (int ai = 0; ai < 2; ++ai)
#pragma unroll
            for (int m = 0; m < 4; ++m) { const int row = row0 + ai * HALF + m * 16; const float r = rtab[u.ord * 256 + (row & 255)];
                f32x4 h0, h1;
#pragma unroll
                for (int j = 0; j < 4; ++j) { const float g0 = acc[ai][0][m][0][j] * r, g1 = acc[ai][0][m][1][j] * r;
                    h0[j] = g0 * fsigmoid(g0) * (acc[ai][1][m][0][j] * r); h1[j] = g1 * fsigmoid(g1) * (acc[ai][1][m][1][j] * r); }
                u32x4 w; w.x = cvt_pk_bf16(h0[0], h0[1]); w.y = cvt_pk_bf16(h0[2], h0[3]); w.z = cvt_pk_bf16(h1[0], h1[1]); w.w = cvt_pk_bf16(h1[2], h1[3]);
                *(u32x4*)(H + (size_t)row * ldh + col0) = w; }
    }
};
struct EpiMerge { static constexpr bool MID = true;
    const bf16_t* gates; bf16_t* merged;
    static DI float gclamp(unsigned hi_bits) { return fmaxf(__uint_as_float(hi_bits), 1e-30f); }
    DI void mid(f32x4 (&acc)[2][2][4][2], const Unit& u, int seg, int wr, int wc, int fr, int fq) const {
        int row0 = u.pm * BM + wr * 64 + fr, col0 = u.pn * BM + wc * 32 + 8 * fq; LAUNDER_V(row0); LAUNDER_V(col0);
#pragma unroll
        for (int ai = 0; ai < 2; ++ai)
#pragma unroll
            for (int mp = 0; mp < 2; ++mp) {
                u32x4 ga[2][2], gb[2][2];
#pragma unroll
                for (int mm = 0; mm < 2; ++mm)
#pragma unroll
                    for (int bj = 0; bj < 2; ++bj) { const bf16_t* gp = gates + (size_t)(row0 + ai * HALF + (2 * mp + mm) * 16) * PLD + seg * 1024 + col0 + bj * HALF; ga[mm][bj] = *(const u32x4*)gp; gb[mm][bj] = *(const u32x4*)(gp + 1024); }
                __builtin_amdgcn_sched_barrier(0);
#pragma unroll
                for (int mm = 0; mm < 2; ++mm)
#pragma unroll
                    for (int bj = 0; bj < 2; ++bj) {
#pragma unroll
                        for (int j = 0; j < 4; ++j) { const int m = 2 * mp + mm;
                            const float r_lo = gclamp(ga[mm][bj][j] << 16) * __builtin_amdgcn_rcpf(gclamp(gb[mm][bj][j] << 16)), r_hi = gclamp(ga[mm][bj][j] & 0xffff0000u) * __builtin_amdgcn_rcpf(gclamp(gb[mm][bj][j] & 0xffff0000u));
                            acc[ai][bj][m][j >> 1][(2 * j) & 3] *= r_lo; acc[ai][bj][m][j >> 1][(2 * j + 1) & 3] *= r_hi; }
                        __builtin_amdgcn_sched_barrier(0); }
            }
    }
    DI void operator()(const f32x4 (&acc)[2][2][4][2], const Unit& u, int wr, int wc, int fr, int fq) const {
        const int row0 = u.pm * BM + wr * 64 + fr, col0 = u.pn * BM + wc * 32 + 8 * fq;
#pragma unroll
        for (int ai = 0; ai < 2; ++ai)
#pragma unroll
            for (int m = 0; m < 4; ++m) { const int row = row0 + ai * HALF + m * 16;
#pragma unroll
                for (int bj = 0; bj < 2; ++bj) {
                    const u32x4 gv = *(const u32x4*)(gates + (size_t)row * PLD + 2 * 1024 + col0 + bj * HALF);
                    float v[8];
#pragma unroll
                    for (int j = 0; j < 4; ++j) { v[2 * j] = gclamp(gv[j] << 16); v[2 * j + 1] = gclamp(gv[j] & 0xffff0000u); }
#pragma unroll
                    for (int j = 0; j < 4; ++j) { v[j] *= acc[ai][bj][m][0][j]; v[4 + j] *= acc[ai][bj][m][1][j]; }
                    u32x4 w; w.x = cvt_pk_bf16(v[0], v[1]); w.y = cvt_pk_bf16(v[2], v[3]); w.z = cvt_pk_bf16(v[4], v[5]); w.w = cvt_pk_bf16(v[6], v[7]);
                    *(u32x4*)(merged + (size_t)row * 1024 + col0 + bj * HALF) = w; } }
    }
};

template <class Epi, class Sched, bool F8 = false>
DI void gemm_phase(LAS unsigned char* lds, const Gemm g, const Sched& S, const Epi& E, int wave_id) {
    int tid_ = (int)__builtin_amdgcn_mbcnt_hi(~0u, __builtin_amdgcn_mbcnt_lo(~0u, 0u)) + 64 * wave_id; asm volatile("" : "+v"(tid_));
    const int tid = tid_, wid = __builtin_amdgcn_readfirstlane(tid >> 6), lane = tid & 63, wr = wid >> 2, wc = wid & 3, fr = lane & 15, fq = lane >> 4;
    unsigned voffA[2], voffB[2];
#pragma unroll
    for (int i = 0; i < 2; ++i) { int R, C; stage_rc(tid * 16 + i * 8192, R, C); const int Rb = (R & ~31) + perm32(R & 31);
        voffA[i] = F8 ? (unsigned)(R * g.lda + 2 * C) : (unsigned)(R * g.lda + C) * 2u; voffB[i] = F8 ? (unsigned)(Rb * g.ldb + 2 * C) : (unsigned)(Rb * g.ldb + C) * 2u; }
    const size_t kstep = (size_t)(BK * 2);
    const size_t hstepA = (size_t)HALF * g.lda * (F8 ? 1 : 2), hstepB = (size_t)HALF * g.ldb * (F8 ? 1 : 2);
    const unsigned ldsw = (unsigned)wid * 1024u;
    const int aoff = lds_byte(wr * 64 + fr, fq * 8), boff = lds_byte(wc * 32 + fr, fq * 8);
#define PG8_SA(b, h) (((b) * 2 + (h)) * HTB)
#define PG8_SB(b, h) ((4 + (b) * 2 + (h)) * HTB)
#define PG8_STAGE(bufoff, gbase, voff) do { _Pragma("unroll") for (int _i = 0; _i < 2; ++_i) \
        __builtin_amdgcn_global_load_lds((const unsigned*)((const char*)(gbase) + (voff)[_i]), (LAS unsigned*)(lds + (bufoff) + ldsw + _i * 8192), 16, 0, 0); } while (0)
#define PG8_LDA(dst, b, h) do { _Pragma("unroll") for (int m = 0; m < 4; ++m) { const v4i_t l0_ = *(const LAS v4i_t*)(lds + PG8_SA(b, h) + aoff + m * 2048), l1_ = *(const LAS v4i_t*)(lds + PG8_SA(b, h) + aoff + m * 2048 + 1024); \
        dst[m] = __builtin_shufflevector(l0_, l1_, 0, 1, 2, 3, 4, 5, 6, 7); } } while (0)
#define PG8_LDB(dst, b, h) do { _Pragma("unroll") for (int n = 0; n < 2; ++n) { const v4i_t l0_ = *(const LAS v4i_t*)(lds + PG8_SB(b, h) + boff + n * 2048), l1_ = *(const LAS v4i_t*)(lds + PG8_SB(b, h) + boff + n * 2048 + 1024); \
        dst[n] = __builtin_shufflevector(l0_, l1_, 0, 1, 2, 3, 4, 5, 6, 7); } } while (0)
#define PG8_MMA(ai, bj, At, Bt) do { __builtin_amdgcn_s_setprio(1); _Pragma("unroll") for (int m = 0; m < 4; ++m) _Pragma("unroll") for (int n = 0; n < 2; ++n) { \
        if constexpr (F8) asm volatile("v_mfma_scale_f32_16x16x128_f8f6f4 %0, %1, %2, %0, %3, %4 op_sel_hi:[0,0,0]" : "+v"(acc[ai][bj][m][n]) : "v"(Bt[n]), "v"(At[m]), "v"(f8scale_w), "v"(f8scale_x));   \
        else { const bf16x8 b0_ = __builtin_bit_cast(bf16x8, __builtin_shufflevector(Bt[n], Bt[n], 0, 1, 2, 3)), b1_ = __builtin_bit_cast(bf16x8, __builtin_shufflevector(Bt[n], Bt[n], 4, 5, 6, 7)), \
                            a0_ = __builtin_bit_cast(bf16x8, __builtin_shufflevector(At[m], At[m], 0, 1, 2, 3)), a1_ = __builtin_bit_cast(bf16x8, __builtin_shufflevector(At[m], At[m], 4, 5, 6, 7)); \
            acc[ai][bj][m][n] = __builtin_amdgcn_mfma_f32_16x16x32_bf16(b0_, a0_, acc[ai][bj][m][n], 0, 0, 0); acc[ai][bj][m][n] = __builtin_amdgcn_mfma_f32_16x16x32_bf16(b1_, a1_, acc[ai][bj][m][n], 0, 0, 0); } } \
        __builtin_amdgcn_s_setprio(0); } while (0)
#define PG8_WAIT_V(n) asm volatile("s_waitcnt vmcnt(" #n ")" ::: "memory")
#define PG8_WAIT_L(n) asm volatile("s_waitcnt lgkmcnt(" #n ")" ::: "memory")
#define PG8_BAR __builtin_amdgcn_s_barrier()
#define PG8_SCHED __builtin_amdgcn_sched_barrier(0)
    Unit cur, nxt; int ui = 0;
    if (!S.next(0, cur)) return;
    f32x4 acc[2][2][4][2];
#pragma unroll
    for (int a = 0; a < 2; ++a)
#pragma unroll
        for (int b = 0; b < 2; ++b)
#pragma unroll
            for (int m = 0; m < 4; ++m)
#pragma unroll
                for (int n = 0; n < 2; ++n) acc[a][b][m][n] = (f32x4){0.f, 0.f, 0.f, 0.f};
    typedef int v8i_t __attribute__((ext_vector_type(8))); typedef int v4i_t __attribute__((ext_vector_type(4)));
    const int f8scale_w = 0x7a7a7a7a, f8scale_x = 0x7f7f7f7f;
    v8i_t At[4], B0[2], B1[2];
    const char* cA = (const char*)g.A + cur.aoff; const char* cB = (const char*)g.Bt + cur.boff;
    PG8_STAGE(PG8_SB(0, 0), cB, voffB); PG8_STAGE(PG8_SB(0, 1), cB + hstepB, voffB); PG8_STAGE(PG8_SA(0, 0), cA, voffA); PG8_STAGE(PG8_SA(0, 1), cA + hstepA, voffA);
    if (wr == 1) PG8_BAR;
    PG8_WAIT_V(2); PG8_BAR;
    PG8_STAGE(PG8_SB(1, 0), cB + kstep, voffB); PG8_STAGE(PG8_SA(1, 0), cA + kstep, voffA); PG8_STAGE(PG8_SB(1, 1), cB + hstepB + kstep, voffB);
    PG8_WAIT_V(6); PG8_BAR;
    for (;;) {
        const bool has_next = S.next(ui + 1, nxt);
        const int nt = cur.nt;
        const char* nA = has_next ? (const char*)g.A + nxt.aoff : cA; const char* nB = has_next ? (const char*)g.Bt + nxt.boff : cB;
        for (int t = 0; t < nt; t += 2) {
            if constexpr (Epi::MID) { if (t == 4 || t == 8) { E.mid(acc, cur, t >> 3, wr, wc, fr, fq); } __builtin_amdgcn_sched_barrier(0); }
            const bool last = (t == nt - 2);
            const char* a1 = cA + (size_t)(t + 1) * kstep;
            const char* a2 = last ? nA : cA + (size_t)(t + 2) * kstep; const char* b2 = last ? nB : cB + (size_t)(t + 2) * kstep;
            const char* a3 = a2 + kstep; const char* b3 = b2 + kstep;
            PG8_LDB(B0, 0, 0); PG8_LDB(B1, 0, 1); PG8_SCHED; PG8_LDA(At, 0, 0); PG8_STAGE(PG8_SA(1, 1), a1 + hstepA, voffA);
            PG8_WAIT_V(8); PG8_WAIT_L(0); PG8_BAR; PG8_MMA(0, 0, At, B0); PG8_MMA(0, 1, At, B1); PG8_BAR; PG8_SCHED;
            PG8_LDA(At, 0, 1); PG8_STAGE(PG8_SB(0, 0), b2, voffB); PG8_STAGE(PG8_SB(0, 1), b2 + hstepB, voffB); PG8_STAGE(PG8_SA(0, 0), a2, voffA);
            PG8_WAIT_V(8); PG8_WAIT_L(0); PG8_BAR; PG8_MMA(1, 0, At, B0); PG8_MMA(1, 1, At, B1); PG8_BAR; PG8_SCHED;
            PG8_LDB(B0, 1, 0); PG8_LDB(B1, 1, 1); PG8_SCHED; PG8_LDA(At, 1, 0); PG8_STAGE(PG8_SA(0, 1), a2 + hstepA, voffA);
            PG8_WAIT_V(8); PG8_WAIT_L(0); PG8_BAR; PG8_MMA(0, 0, At, B0); PG8_MMA(0, 1, At, B1); PG8_BAR; PG8_SCHED;
            PG8_LDA(At, 1, 1); PG8_STAGE(PG8_SB(1, 0), b3, voffB); PG8_STAGE(PG8_SB(1, 1), b3 + hstepB, voffB); PG8_STAGE(PG8_SA(1, 0), a3, voffA);
            PG8_WAIT_V(8); PG8_WAIT_L(0); PG8_BAR; PG8_MMA(1, 0, At, B0); PG8_MMA(1, 1, At, B1); PG8_BAR; PG8_SCHED;
        }
        if (wr == 0) PG8_BAR;
        E(acc, cur, wr, wc, fr, fq);
        if (!has_next) break;
#pragma unroll
        for (int a = 0; a < 2; ++a)
#pragma unroll
            for (int b = 0; b < 2; ++b)
#pragma unroll
                for (int m = 0; m < 4; ++m)
#pragma unroll
                    for (int n = 0; n < 2; ++n) acc[a][b][m][n] = (f32x4){0.f, 0.f, 0.f, 0.f};
        cur = nxt; cA = nA; cB = nB; ++ui;
        if (wr == 1) PG8_BAR;
    }
    PG8_WAIT_V(0);
    PG8_BAR;
#undef PG8_SA
#undef PG8_SB
#undef PG8_STAGE
#undef PG8_LDA
#undef PG8_LDB
#undef PG8_MMA
#undef PG8_WAIT_V
#undef PG8_WAIT_L
#undef PG8_BAR
#undef PG8_SCHED
}
}
struct Params { const float* in[27]; float* out; unsigned char* ws; int ph_lo, ph_hi, pad0, pad1; };
enum { I_X = 0, I_MEM, I_POS, I_MIXG, I_WIN, I_POOLW, I_POOLS, I_CONVW, I_ALOG, I_DTB, I_DNG, I_WUPP, I_WUPM, I_WUPD, I_WOUT, I_XAG, I_MEMG, I_XAQ, I_XAKV, I_XAO,
       I_FFNG, I_DGU, I_DD, I_ROUTER, I_MGU, I_MD, I_FING };

struct Frame {
    LAS unsigned char* lds;
    int tid, lane, wave, G, blk;
    unsigned char* ws;
};

struct Job { const float* W; int K, N; bf16_t* WT; int ldt; int mode; int ff; const float* kscale; unsigned char* WT8; };
DI int job_map(int mode, int ff, int n) {
    if (mode == 0) return n;
    if (mode == 1) return n < 2560 ? n : (n < 2576 ? -1 : n - 16);
    if (n < ff) return (n >> 7) * 256 + (n & 127);
    const int m = n - ff; return (m >> 7) * 256 + 128 + (m & 127);
}
DI int job_items(const Job& J) { return (J.K / 64) * ((J.N + 31) / 32); }
DI void transpose_item(const Job& J, LAS float* scr, int item, int lane) {
    const int nblk = (J.N + 31) / 32, kb = item / nblk, nb = item - kb * nblk, k0 = 64 * kb, n0 = 32 * nb;
    const int nn = lane & 31; const bool ok = (n0 + nn) < J.N;
    float tv[32];
#pragma unroll
    for (int i = 0; i < 32; ++i) { const int kk = 2 * i + (lane >> 5); tv[i] = J.W[(size_t)(k0 + kk) * J.N + (ok ? n0 + nn : 0)]; }
#pragma unroll
    for (int i = 0; i < 32; ++i) { const int kk = 2 * i + (lane >> 5); float v = ok ? tv[i] : 0.f; if (J.kscale) v *= J.kscale[k0 + kk]; scr[kk * 33 + nn] = v; }
    LDS_WAIT();
    const int c = lane & 7;
#pragma unroll
    for (int j = 0; j < 4; ++j) { const int n = (lane >> 3) + 8 * j; const int sn = n0 + n; const int drow = sn < J.N ? job_map(J.mode, J.ff, sn) : -1;
        if (drow >= 0) { const LAS float* s = scr + (8 * c) * 33 + n;
            if (J.mode == 1 && drow >= 3072) { u32x2 o;
                o.x = cvt4_fp8(s[0 * 33] * 32.f, s[1 * 33] * 32.f, s[2 * 33] * 32.f, s[3 * 33] * 32.f); o.y = cvt4_fp8(s[4 * 33] * 32.f, s[5 * 33] * 32.f, s[6 * 33] * 32.f, s[7 * 33] * 32.f);
                *(u32x2*)(J.WT8 + (size_t)(drow - 3072) * 1024 + k0 + 8 * c) = o; }
            else { u32x4 o; o.x = pk2(s[0 * 33], s[1 * 33]); o.y = pk2(s[2 * 33], s[3 * 33]); o.z = pk2(s[4 * 33], s[5 * 33]); o.w = pk2(s[6 * 33], s[7 * 33]);
                *(u32x4*)(J.WT + (size_t)drow * J.ldt + k0 + 8 * c) = o; } } }
    LDS_WAIT();
}
constexpr int NJOBS = 2 * 7 + 2 + 16;
DI void get_job(const Frame& F, const Params& P, int j, Job& J) {
    unsigned char* ws = F.ws;
    J.mode = 0; J.ff = 0; J.kscale = nullptr; J.WT8 = nullptr;
    if (j < 14) { const int l = j / 7, t = j - 7 * l; unsigned char* lw = ws + WS_LW + (size_t)l * LW_STRIDE;
        if (t == 0) { J.W = P.in[I_WIN] + (size_t)l * 1024 * IN_COLS; J.K = 1024; J.N = IN_COLS; J.WT = (bf16_t*)(lw + LW_WIN); J.ldt = 1024; J.mode = 1; J.kscale = P.in[I_MIXG] + l * 1024; J.WT8 = ws + WS_WG8 + (size_t)l * 3072 * 1024; }
        else if (t == 1) { J.W = P.in[I_WUPM] + (size_t)l * 256 * 1024; J.K = 256; J.N = 1024; J.WT = (bf16_t*)(lw + LW_WCAT) + 256; J.ldt = 1024; }
        else if (t == 2) { J.W = P.in[I_WUPD] + (size_t)l * 512 * 1024; J.K = 512; J.N = 1024; J.WT = (bf16_t*)(lw + LW_WCAT) + 512; J.ldt = 1024; }
        else if (t == 3) { J.W = P.in[I_WOUT] + (size_t)l * 1024 * 1024; J.K = 1024; J.N = 1024; J.WT = (bf16_t*)(lw + LW_WOUT); J.ldt = 1024; }
        else if (t == 4) { J.W = P.in[I_XAQ] + (size_t)l * 1024 * 512; J.K = 1024; J.N = 512; J.WT = (bf16_t*)(lw + LW_WQ); J.ldt = 1024; J.kscale = P.in[I_XAG] + l * 1024; }
        else if (t == 5) { J.W = P.in[I_XAKV] + (size_t)l * 1024 * 1024; J.K = 1024; J.N = 1024; J.WT = (bf16_t*)(lw + LW_WKV); J.ldt = 1024; }
        else { J.W = P.in[I_XAO] + (size_t)l * 512 * 1024; J.K = 512; J.N = 1024; J.WT = (bf16_t*)(lw + LW_WO); J.ldt = 512; }
    } else if (j == 14) { J.W = P.in[I_DGU]; J.K = 1024; J.N = 2 * FF; J.WT = (bf16_t*)(ws + WS_WGU); J.ldt = 1024; J.mode = 2; J.ff = FF; J.kscale = P.in[I_FFNG]; }
    else if (j == 15) { J.W = P.in[I_DD]; J.K = FF; J.N = 1024; J.WT = (bf16_t*)(ws + WS_WD); J.ldt = FF; }
    else { const int e = (j - 16) >> 1;
        if (((j - 16) & 1) == 0) { J.W = P.in[I_MGU] + (size_t)e * 1024 * 2 * EFF; J.K = 1024; J.N = 2 * EFF; J.WT = (bf16_t*)(ws + WS_WMGU) + (size_t)e * 2 * EFF * 1024; J.ldt = 1024; J.mode = 2; J.ff = EFF; J.kscale = P.in[I_FFNG] + 1024; }
        else { J.W = P.in[I_MD] + (size_t)e * EFF * 1024; J.K = EFF; J.N = 1024; J.WT = (bf16_t*)(ws + WS_WMD) + (size_t)e * 1024 * EFF; J.ldt = EFF; } }
}

DI void phase_prologue(const Frame& F, const Params& P) {
    unsigned char* ws = F.ws;
    const int gw = F.blk * 8 + F.wave, NGW = F.G * 8, lane = F.lane;
    const long gt = (long)F.blk * 512 + F.tid, NGT = (long)F.G * 512;
    { const float* x = P.in[I_X]; bf16_t* xb = (bf16_t*)(ws + WS_XB); float* ssq = (float*)(ws + WS_SSQ); unsigned char* x8 = ws + WS_X8;
      for (int row0 = gw; row0 < NTOK; row0 += 4 * NGW) {
          f32x4 v[4][4];
#pragma unroll
          for (int q = 0; q < 4; ++q) { const int row = row0 + q * NGW; const f32x4* xr = (const f32x4*)(x + (size_t)(row < NTOK ? row : row0) * 1024) + lane;
#pragma unroll
              for (int j = 0; j < 4; ++j) v[q][j] = xr[64 * j]; }
#pragma unroll
          for (int q = 0; q < 4; ++q) { const int row = row0 + q * NGW; if (row < NTOK) { float s = 0.f;
#pragma unroll
              for (int j = 0; j < 4; ++j) s += (v[q][j].x * v[q][j].x + v[q][j].y * v[q][j].y) + (v[q][j].z * v[q][j].z + v[q][j].w * v[q][j].w);
              s = wave_sum(s);
              u32x2* o = (u32x2*)(xb + (size_t)row * 1024) + lane;
#pragma unroll
              for (int j = 0; j < 4; ++j) { u32x2 w; w.x = pk2(v[q][j].x, v[q][j].y); w.y = pk2(v[q][j].z, v[q][j].w); o[64 * j] = w;
                  ((unsigned*)(x8 + (size_t)row * 1024))[lane + 64 * j] = cvt4_fp8(v[q][j].x, v[q][j].y, v[q][j].z, v[q][j].w); }
              if (lane < 16) ssq[(size_t)row * 16 + lane] = lane == 0 ? s : 0.f; } }
      } }
    { const float* mem = P.in[I_MEM]; bf16_t* mn = (bf16_t*)(ws + WS_MEMN);
      for (int row = gw; row < 2048; row += NGW) {
          const f32x4* xr = (const f32x4*)(mem + (size_t)row * 1024) + lane; f32x4 v[4]; float s = 0.f;
#pragma unroll
          for (int j = 0; j < 4; ++j) { v[j] = xr[64 * j]; s += (v[j].x * v[j].x + v[j].y * v[j].y) + (v[j].z * v[j].z + v[j].w * v[j].w); }
          s = wave_sum(s); const float r = rsqrtf(s * (1.0f / 1024.0f) + RMS_EPS);
#pragma unroll
          for (int l = 0; l < 2; ++l) { const f32x4* gr = (const f32x4*)(P.in[I_MEMG] + l * 1024) + lane; u32x2* o = (u32x2*)(mn + ((size_t)l * 2048 + row) * 1024) + lane;
#pragma unroll
              for (int j = 0; j < 4; ++j) { const f32x4 gg = gr[64 * j]; u32x2 w; w.x = pk2(v[j].x * r * gg.x, v[j].y * r * gg.y); w.y = pk2(v[j].z * r * gg.z, v[j].w * r * gg.w); o[64 * j] = w; } }
      } }
    { const int* pos = (const int*)P.in[I_POS]; float* rope = (float*)(ws + WS_ROPE);
      for (long i = gt; i < (long)NTOK * 8; i += NGT) { const int tok = (int)(i >> 3), f = (int)(i & 7);
          const float inv = powf(500000.0f, -(float)f * 2.0f / 16.0f); const float ang = (float)pos[tok] * inv; float sn, cs; sincosf(ang, &sn, &cs);
          rope[(size_t)tok * 16 + f] = cs; rope[(size_t)tok * 16 + 8 + f] = sn; } }
    for (long i = gt; i < 2 * 16 * 1024; i += NGT) { const int l = (int)(i >> 14), j = (int)((i >> 10) & 15), k = (int)(i & 1023);
        const float v = P.in[I_WIN][((size_t)l * 1024 + k) * IN_COLS + 2560 + j] * P.in[I_MIXG][l * 1024 + k];
        ((bf16_t*)(ws + WS_LW + (size_t)l * LW_STRIDE + LW_WBA))[j * 1024 + k] = (bf16_t)f2bf(v); }
    for (long i = gt; i < 8 * 1024; i += NGT) { const int e = (int)(i >> 10), k = (int)(i & 1023); ((float*)(ws + WS_WR))[e * 1024 + k] = P.in[I_ROUTER][k * 8 + e] * P.in[I_FFNG][1024 + k]; }
    for (long i = gt; i < 2L * 256 * 1024; i += NGT) { const int l = (int)(i >> 18), k = (int)((i >> 10) & 255), n = (int)(i & 1023), gi = k >> 6, c = k & 63;
        const float* pw = P.in[I_POOLW] + (((size_t)l * 4 + gi) * 64 + c) * 64; const float* ps = P.in[I_POOLS] + l * 256 + gi * 64; const float* wu = P.in[I_WUPP] + ((size_t)l * 256 + gi * 64) * 1024 + n;
        float s = 0.f;
#pragma unroll 16
        for (int d = 0; d < 64; ++d) s += pw[d] * ps[d] * wu[(size_t)d * 1024];
        ((bf16_t*)(ws + WS_LW + (size_t)l * LW_STRIDE + LW_WCAT))[(size_t)n * 1024 + k] = (bf16_t)f2bf(s); }
    { float* sm = (float*)(ws + WS_SMALL);
      for (long i = gt; i < 2 * 4 * 1536; i += NGT) sm[SM_CONVW + i] = P.in[I_CONVW][i];
      for (long i = gt; i < 16; i += NGT) { sm[SM_ALOG + i] = P.in[I_ALOG][i]; sm[SM_DTB + i] = P.in[I_DTB][i]; }
      for (long i = gt; i < 128; i += NGT) sm[SM_DNG + i] = P.in[I_DNG][i];
      for (long i = gt; i < 1024; i += NGT) sm[SM_FING + i] = P.in[I_FING][i]; }
    { LAS float* scr = (LAS float*)(F.lds + F.wave * 8704);
      int base = 0;
      for (int j = 0; j < NJOBS; ++j) { Job J; get_job(F, P, j, J); const int ni = job_items(J);
          int first = gw - (base % NGW); if (first < 0) first += NGW;
          for (int it = first; it < ni; it += NGW) transpose_item(J, scr, it, lane);
          base += ni; } }
}
DI void ba_tiles(const Frame& F, const bf16_t* xbg, const bf16_t* Wba, const float* ssqg, float* BA) {
    const int lane = F.lane, gw = F.blk * 8 + F.wave, NGW = F.G * 8;
    for (int tile = gw; tile < NG / 16; tile += NGW) {
        const int row0 = tile * 16; f32x4 acc = (f32x4){0.f, 0.f, 0.f, 0.f};
        const bf16_t* ap = xbg + (size_t)(row0 + (lane & 15)) * 1024 + (lane >> 4) * 8; const bf16_t* bp = Wba + (size_t)(lane & 15) * 1024 + (lane >> 4) * 8;
#pragma unroll 8
        for (int ks = 0; ks < 32; ++ks) { const bf16x8 a = *(const bf16x8*)(ap + 32 * ks); const bf16x8 b = *(const bf16x8*)(bp + 32 * ks); acc = MFMA16(a, b, acc); }
#pragma unroll
        for (int i = 0; i < 4; ++i) { const int row = row0 + 4 * (lane >> 4) + i; BA[(size_t)row * 16 + (lane & 15)] = acc[i] * row_rstd(ssqg, row); }
    }
}

template <int W> DI void prep_pool_w(const bf16_t* Pb, bf16_t* BR, int ch, int lr0, int s0) {
    const bf16_t* p = Pb + PC_POOL + ch; float v[32 + W - 1];
#pragma unroll
    for (int i = 0; i < 32 + W - 1; ++i) { const int d = i - (W - 1); const bool ok = s0 + d >= 0; const unsigned short raw = p[(size_t)(ok ? lr0 + d : lr0) * PLD]; v[i] = ok ? bf2f(raw) : 0.f; }
    float sum = 0.f;
#pragma unroll
    for (int i = 0; i < W - 1; ++i) sum += v[i];
#pragma unroll
    for (int t = 0; t < 32; ++t) { const float x = v[t + W - 1]; sum += x; const int s = s0 + t;
        const float o = (s + 1 >= W ? sum * (1.0f / (float)W) : sum / (float)(s + 1)) - x;
        BR[(size_t)(lr0 + t) * 1024 + ch] = (bf16_t)f2bf(o);
        sum -= v[t]; }
}
DI void prep_pool(const Frame& F, const bf16_t* Pb, bf16_t* BR, int unit) {
    int tid_ = F.tid; LAUNDER_V(tid_);
    const int ch = tid_ & 255, half = tid_ >> 8, lr0 = unit * 64 + half * 32, s0 = lr0 & (SEQ - 1), g = F.wave & 3;
    if (g == 0) prep_pool_w<2>(Pb, BR, ch, lr0, s0); else if (g == 1) prep_pool_w<4>(Pb, BR, ch, lr0, s0); else if (g == 2) prep_pool_w<8>(Pb, BR, ch, lr0, s0); else prep_pool_w<16>(Pb, BR, ch, lr0, s0);
}

DI void prep_moba(const Frame& F, bf16_t* Pb, const float* rope, float* KBAR, bf16_t* VT, int unit) {
    int tid_ = F.tid; LAUNDER_V(tid_);
    const int tid = tid_, bl = unit >> 5, j = unit & 31, lr0 = bl * SEQ + j * 256;
    { const int c = tid & 255, rh = tid >> 8, h = c >> 6, d = c & 63; float sum = 0.f;
        LAS float* KS = (LAS float*)F.lds;
        if (d < 16) { const int dp = d < 8 ? d + 8 : d - 8, f = d & 7;
#pragma unroll 8
            for (int r = 128 * rh; r < 128 * rh + 128; ++r) { const size_t lr = (size_t)(lr0 + r); const float v = bf2f(Pb[lr * PLD + PC_MK + c]), vp = bf2f(Pb[lr * PLD + PC_MK + h * 64 + dp]);
                const float cs = rope[lr * 16 + f], sn = rope[lr * 16 + 8 + f]; sum += d < 8 ? v * cs - vp * sn : v * cs + vp * sn; } }
        else {
#pragma unroll 16
            for (int r = 128 * rh; r < 128 * rh + 128; ++r) sum += bf2f(Pb[(size_t)(lr0 + r) * PLD + PC_MK + c]); }
        if (rh == 1) KS[c] = sum;
        __syncthreads();
        if (rh == 0) KBAR[((size_t)(bl * 4 + h) * 32 + j) * 64 + d] = (sum + KS[c]) * (1.0f / 256.0f); }
    __syncthreads();
    { const int r = tid & 255, hp = tid >> 8; const size_t lr = (size_t)(lr0 + r);
      const f32x4 c0 = *(const f32x4*)(rope + lr * 16), c1 = *(const f32x4*)(rope + lr * 16 + 4), s0 = *(const f32x4*)(rope + lr * 16 + 8), s1 = *(const f32x4*)(rope + lr * 16 + 12);
      const float cs[8] = {c0.x, c0.y, c0.z, c0.w, c1.x, c1.y, c1.z, c1.w}, sn[8] = {s0.x, s0.y, s0.z, s0.w, s1.x, s1.y, s1.z, s1.w};
#pragma unroll
      for (int hh = 0; hh < 2; ++hh)
#pragma unroll
          for (int which = 0; which < 2; ++which) { bf16_t* base = Pb + lr * PLD + (which ? PC_MK : PC_MQ) + (2 * hp + hh) * 64;
              const u32x4 a = *(const u32x4*)base, b = *(const u32x4*)(base + 8); float x1[8], x2[8];
#pragma unroll
              for (int q = 0; q < 4; ++q) { x1[2 * q] = __uint_as_float(a[q] << 16); x1[2 * q + 1] = __uint_as_float(a[q] & 0xffff0000u); x2[2 * q] = __uint_as_float(b[q] << 16); x2[2 * q + 1] = __uint_as_float(b[q] & 0xffff0000u); }
              u32x4 oa, ob;
#pragma unroll
              for (int q = 0; q < 4; ++q) { oa[q] = pk2(x1[2 * q] * cs[2 * q] - x2[2 * q] * sn[2 * q], x1[2 * q + 1] * cs[2 * q + 1] - x2[2 * q + 1] * sn[2 * q + 1]);
                                            ob[q] = pk2(x2[2 * q] * cs[2 * q] + x1[2 * q] * sn[2 * q], x2[2 * q + 1] * cs[2 * q + 1] + x1[2 * q + 1] * sn[2 * q + 1]); }
              *(u32x4*)base = oa; *(u32x4*)(base + 8) = ob; } }
    LAS bf16_t* Tt = (LAS bf16_t*)F.lds;
    for (int cc = 0; cc < 4; ++cc) {
        __syncthreads();
#pragma unroll
        for (int i = 0; i < 4; ++i) { const int q = tid + 512 * i, tok = q >> 5, c8 = q & 31; const u32x4 v = *(const u32x4*)(Pb + (size_t)(lr0 + cc * 64 + tok) * PLD + PC_MV + c8 * 8);
#pragma unroll
            for (int e = 0; e < 4; ++e) { Tt[(c8 * 8 + 2 * e) * 72 + tok] = (bf16_t)(v[e] & 0xffffu); Tt[(c8 * 8 + 2 * e + 1) * 72 + tok] = (bf16_t)(v[e] >> 16); } }
        __syncthreads();
#pragma unroll
        for (int i = 0; i < 4; ++i) { const int q = tid + 512 * i, col = q >> 3, t8 = q & 7; const u32x4 v = *(const LAS u32x4*)(Tt + col * 72 + t8 * 8);
            *(u32x4*)(VT + ((size_t)(bl * 256 + col)) * SEQ + j * 256 + cc * 64 + t8 * 8) = v; }
    }
    __syncthreads();
}

constexpr int DN_ROWB = 144;
constexpr int DN_TQ = 0, DN_TK = 9216, DN_TKB = 18432, DN_TVB = 27648, DN_MISC = 36864, DN_PAIR = 38400;
__host__ __device__ constexpr int ap_rowoff(int i) { return i == 0 ? 0 : 4 * (((i - 1) / 4) + 1) * (2 * ((i - 1) / 4) + ((i - 1) % 4)); }

template <int I> DI void subst_load(const LAS float* Ap, const LAS unsigned char* Rt, const LAS float* SCL, int lane, f32x4 (&av)[16], float& Ri) {
    constexpr int off = ap_rowoff(I);
#pragma unroll
    for (int j4 = 0; j4 < I; j4 += 4) av[j4 >> 2] = *(const LAS f32x4*)(Ap + off + j4);
    Ri = bf2f(*(const LAS bf16_t*)(Rt + I * DN_ROWB + lane * 2)) * SCL[I];
}
template <int I> struct Subst2 { static DI void run(float (&x)[64], const LAS float* Ap, const LAS unsigned char* Rt, const LAS float* SCL, int lane, f32x4 (&cur)[16], float Rc, f32x4 (&nxt)[16]) {
    float Rn = 0.f;
    if constexpr (I + 1 < 64) subst_load<I + 1>(Ap, Rt, SCL, lane, nxt, Rn);
    float a0 = Rc, a1 = 0.f, a2 = 0.f, a3 = 0.f;
#pragma unroll
    for (int j4 = 0; j4 < I; j4 += 4) { const f32x4 av = cur[j4 >> 2];
        a0 -= av.x * x[j4];
        if (j4 + 1 < I) a1 -= av.y * x[j4 + 1];
        if (j4 + 2 < I) a2 -= av.z * x[j4 + 2];
        if (j4 + 3 < I) a3 -= av.w * x[j4 + 3]; }
    x[I] = (a0 + a1) + (a2 + a3);
    asm volatile("" : "+v"(x[I])); __builtin_amdgcn_sched_barrier(0);
    if constexpr (I + 1 < 64) Subst2<I + 1>::run(x, Ap, Rt, SCL, lane, nxt, Rn, cur);
} };

DI void conv_w_load(const float* convw, int wcol, float (&w)[4][8]) {
#pragma unroll
    for (int j = 0; j < 4; ++j) { const f32x4 w0 = *(const f32x4*)(convw + j * 1536 + wcol), w1 = *(const f32x4*)(convw + j * 1536 + wcol + 4);
        w[j][0] = w0.x; w[j][1] = w0.y; w[j][2] = w0.z; w[j][3] = w0.w; w[j][4] = w1.x; w[j][5] = w1.y; w[j][6] = w1.z; w[j][7] = w1.w; }
}
DI void conv8(const bf16_t* Pb, const float (&w)[4][8], int lr, int s, int pcol8, float (&a)[8]) {
#pragma unroll
    for (int e = 0; e < 8; ++e) a[e] = 0.f;
    u32x4 xv[4];
#pragma unroll
    for (int j = 0; j < 4; ++j) { const bool valid = (s - 3 + j) >= 0; xv[j] = *(const u32x4*)(Pb + (size_t)(valid ? lr - 3 + j : lr) * PLD + pcol8);
        xv[j].x = valid ? xv[j].x : 0u; xv[j].y = valid ? xv[j].y : 0u; xv[j].z = valid ? xv[j].z : 0u; xv[j].w = valid ? xv[j].w : 0u; }
#pragma unroll
    for (int j = 0; j < 4; ++j) {
        a[0] += w[j][0] * __uint_as_float(xv[j][0] << 16); a[1] += w[j][1] * __uint_as_float(xv[j][0] & 0xffff0000u);
        a[2] += w[j][2] * __uint_as_float(xv[j][1] << 16); a[3] += w[j][3] * __uint_as_float(xv[j][1] & 0xffff0000u);
        a[4] += w[j][4] * __uint_as_float(xv[j][2] << 16); a[5] += w[j][5] * __uint_as_float(xv[j][2] & 0xffff0000u);
        a[6] += w[j][6] * __uint_as_float(xv[j][3] << 16); a[7] += w[j][7] * __uint_as_float(xv[j][3] & 0xffff0000u);
    }
#pragma unroll
    for (int e = 0; e < 8; ++e) a[e] = a[e] * fsigmoid(a[e]);
}
DI float ssq8(const float (&a)[8]) { float ss = 0.f;
#pragma unroll
    for (int e = 0; e < 8; ++e) ss += a[e] * a[e];
    ss += __shfl_xor(ss, 1); ss += __shfl_xor(ss, 2); ss += __shfl_xor(ss, 4); return ss; }
DI u32x4 pack8(const float (&a)[8], float sc) { u32x4 w; w.x = pk2(a[0] * sc, a[1] * sc); w.y = pk2(a[2] * sc, a[3] * sc); w.z = pk2(a[4] * sc, a[5] * sc); w.w = pk2(a[6] * sc, a[7] * sc); return w; }

#ifndef DBG_RA
#define DBG_RA 1
#endif
#ifndef DBG_RB
#define DBG_RB 1
#endif
#ifndef DBG_RC
#define DBG_RC 1
#endif
#ifndef DBG_RD
#define DBG_RD 1
#endif
#ifndef DBG_RB2
#define DBG_RB2 1
#endif
DI void prep_dn(const Frame& F, const bf16_t* Pb, const float* BA, const float* convw, const float* alog, const float* dtb,
                bf16_t* QD, bf16_t* MM, bf16_t* NT, bf16_t* WN, bf16_t* UT, bf16_t* AQK, float* GL, int unit) {
    int lane_ = F.lane; LAUNDER_V(lane_);
    const int lane = lane_, wave = F.wave, pr = wave >> 1, role = wave & 1;
    const int bl = unit >> 8, rem = unit & 255, n = rem >> 1, hq = rem & 1, h = 4 * hq + pr;
    const int lr0 = bl * SEQ + n * 64;
    const int chidx = (bl * 128 + n) * 8 + h;
    LAS unsigned char* L = F.lds + pr * DN_PAIR;
    LAS float* Gs = (LAS float*)(L + DN_MISC); LAS float* EG = Gs + 64; LAS float* EGL = Gs + 128; LAS float* ONES = Gs + 192; LAS float* BETA = Gs + 256 + 64 * role;
    {
        const int lr = lr0 + lane;
        const float braw = BA[(size_t)lr * 16 + h], araw = BA[(size_t)lr * 16 + 8 + h];
        const float beta = fsigmoid(braw);
        const float xa = araw + dtb[h]; const float sp = xa > 20.f ? xa : log1pf(__expf(xa));
        float G = -__expf(alog[h]) * sp;
#pragma unroll
        for (int o = 1; o < 64; o <<= 1) { const float up = __shfl_up(G, o); if (lane >= o) G += up; }
        const float Glast = __shfl(G, 63);
        BETA[lane] = beta;
        if (role == 0) { Gs[lane] = G; EG[lane] = __expf(G); EGL[lane] = __expf(Glast - G); ONES[lane] = 1.0f; if (lane == 0) GL[chidx] = __expf(Glast); }
    }
    LDS_WAIT();
    for (int rpA = 0; rpA < DBG_RA; ++rpA) {
        const int cg = lane & 7, tl = lane >> 3; float w[4][8];
        if (role == 0) {
            conv_w_load(convw, h * 64 + cg * 8, w);
#pragma unroll 4
            for (int ps = 0; ps < 8; ++ps) { const int t = ps * 8 + tl; float a[8]; conv8(Pb, w, lr0 + t, n * 64 + t, PC_DQ + h * 64 + cg * 8, a);
                const float rn = rsqrtf(ssq8(a) + RMS_EPS) * 0.125f;
                *(LAS u32x4*)(L + DN_TQ + t * DN_ROWB + cg * 16) = pack8(a, rn); }
        } else {
            conv_w_load(convw, 512 + h * 64 + cg * 8, w);
#pragma unroll 4
            for (int ps = 0; ps < 8; ++ps) { const int t = ps * 8 + tl; float a[8]; conv8(Pb, w, lr0 + t, n * 64 + t, PC_DK + h * 64 + cg * 8, a);
                const float rn = rsqrtf(ssq8(a) + RMS_EPS);
                *(LAS u32x4*)(L + DN_TK + t * DN_ROWB + cg * 16) = pack8(a, rn); *(LAS u32x4*)(L + DN_TKB + t * DN_ROWB + cg * 16) = pack8(a, rn * BETA[t]); }
        }
        conv_w_load(convw, 1024 + h * 64 + cg * 8, w);
#pragma unroll 4
        for (int ps = 4 * role; ps < 4 * role + 4; ++ps) { const int t = ps * 8 + tl; float a[8]; conv8(Pb, w, lr0 + t, n * 64 + t, PC_DV + h * 64 + cg * 8, a);
            *(LAS u32x4*)(L + DN_TVB + t * DN_ROWB + cg * 16) = pack8(a, BETA[t]); }
    }
    WG_BAR();
    for (int rpB = 0; rpB < DBG_RB; ++rpB) {
        const int fr = lane & 15, fq = lane >> 4;
#pragma unroll
        for (int tt = 0; tt < 8; ++tt) { const int tile = 2 * tt + role, it = tile >> 2, jt = tile & 3;
            f32x4 acc = (f32x4){0.f, 0.f, 0.f, 0.f};
            if (jt <= it) {
#pragma unroll
                for (int ks = 0; ks < 2; ++ks) { const bf16x8 a = *(const LAS bf16x8*)(L + DN_TK + (16 * jt + fr) * DN_ROWB + (fq * 8 + 32 * ks) * 2);
                    const bf16x8 b = *(const LAS bf16x8*)(L + DN_TQ + (16 * it + fr) * DN_ROWB + (fq * 8 + 32 * ks) * 2); acc = MFMA16(a, b, acc); } }
            const int ii = 16 * it + fr; const float Gi = Gs[ii]; float v[4];
#pragma unroll
            for (int r = 0; r < 4; ++r) { const int jj = 16 * jt + 4 * fq + r; v[r] = (jj <= ii) ? acc[r] * __expf(Gi - Gs[jj]) : 0.f; }
            u32x2 w; w.x = pk2(v[0], v[1]); w.y = pk2(v[2], v[3]);
            *(u32x2*)(AQK + (size_t)chidx * 4096 + ii * 64 + 16 * jt + 4 * fq) = w;
        }
#pragma unroll
        for (int i = 0; i < 4; ++i) { const int idx = lane + 64 * role + 128 * i, t = idx >> 3, cg = idx & 7; const u32x4 qv = *(const LAS u32x4*)(L + DN_TQ + t * DN_ROWB + cg * 16); const float eg = EG[t]; u32x4 w;
#pragma unroll
            for (int e = 0; e < 4; ++e) w[e] = pk2(__uint_as_float(qv[e] << 16) * eg, __uint_as_float(qv[e] & 0xffff0000u) * eg);
            *(u32x4*)(QD + (size_t)chidx * 4096 + t * 64 + cg * 8) = w; }
    }
    WG_BAR();
    for (int rpB2 = 0; rpB2 < DBG_RB2; ++rpB2) {
        const int fr = lane & 15, fq = lane >> 4; LAS float* Ap = (LAS float*)(L + DN_TQ);
#pragma unroll
        for (int tt = 0; tt < 5; ++tt) { const int q = 2 * tt + role;
            const int it = q < 1 ? 0 : (q < 3 ? 1 : (q < 6 ? 2 : 3)), jt = q - (it * (it + 1)) / 2;
            f32x4 acc = (f32x4){0.f, 0.f, 0.f, 0.f};
#pragma unroll
            for (int ks = 0; ks < 2; ++ks) { const bf16x8 a = *(const LAS bf16x8*)(L + DN_TKB + (16 * it + fr) * DN_ROWB + (fq * 8 + 32 * ks) * 2);
                const bf16x8 b = *(const LAS bf16x8*)(L + DN_TK + (16 * jt + fr) * DN_ROWB + (fq * 8 + 32 * ks) * 2); acc = MFMA16(a, b, acc); }
            const int jj = 16 * jt + fr; const float Gj = Gs[jj];
#pragma unroll
            for (int r = 0; r < 4; ++r) { const int ii = 16 * it + 4 * fq + r;
                if (jj < ii) { const int m1 = ii - 1, gf = m1 >> 2, rm = m1 & 3; Ap[4 * (gf + 1) * (2 * gf + rm) + jj] = acc[r] * __expf(Gs[ii] - Gj); } }
        }
    }
    u32x4 kdt[4];
#pragma unroll
    for (int i = 0; i < 4; ++i) { const int idx = lane + 64 * role + 128 * i, d = idx >> 3, tc = idx & 7; unsigned short kv[8];
#pragma unroll
        for (int e = 0; e < 8; ++e) kv[e] = *(const LAS bf16_t*)(L + DN_TK + (tc * 8 + e) * DN_ROWB + d * 2);
#pragma unroll
        for (int e = 0; e < 4; ++e) kdt[i][e] = pk2(bf2f(kv[2 * e]) * EGL[tc * 8 + 2 * e], bf2f(kv[2 * e + 1]) * EGL[tc * 8 + 2 * e + 1]); }
    WG_BAR();
#pragma unroll
    for (int i = 0; i < 4; ++i) { const int idx = lane + 64 * role + 128 * i, d = idx >> 3, tc = idx & 7; *(LAS u32x4*)(L + DN_TK + d * DN_ROWB + tc * 16) = kdt[i]; }
    for (int rpC = 0; rpC < DBG_RC; ++rpC) {
        float x[64];
        LAS unsigned char* const RT = L + DN_TVB - role * (DN_TVB - DN_TKB);
        { f32x4 avA[16], avB[16]; float R0; subst_load<0>((const LAS float*)(L + DN_TQ), RT, Gs + 192 - role * 128, lane, avA, R0);
          Subst2<0>::run(x, (const LAS float*)(L + DN_TQ), RT, Gs + 192 - role * 128, lane, avA, R0, avB); }
        { LAS unsigned char* T = RT + lane * DN_ROWB;
#pragma unroll
          for (int cg = 0; cg < 8; ++cg) { u32x4 w; w.x = pk2(x[cg * 8], x[cg * 8 + 1]); w.y = pk2(x[cg * 8 + 2], x[cg * 8 + 3]); w.z = pk2(x[cg * 8 + 4], x[cg * 8 + 5]); w.w = pk2(x[cg * 8 + 6], x[cg * 8 + 7]);
              *(LAS u32x4*)(T + cg * 16) = w; if (role == 0) *((u32x4*)(UT + (size_t)chidx * 4096 + lane * 64) + cg) = w; } }
    }
    WG_BAR();
#pragma unroll
    for (int i = 0; i < 4; ++i) { const int idx = lane + 64 * role + 128 * i, cg = idx >> 6, t = idx & 63; unsigned short wv[8];
#pragma unroll
        for (int e = 0; e < 8; ++e) wv[e] = *(const LAS bf16_t*)(L + DN_TKB + (cg * 8 + e) * DN_ROWB + t * 2);
        u32x4 w;
#pragma unroll
        for (int e = 0; e < 4; ++e) w[e] = ((unsigned)wv[2 * e] | ((unsigned)wv[2 * e + 1] << 16)) ^ 0x80008000u;
        *(u32x4*)(WN + (size_t)chidx * 4096 + t * 64 + cg * 8) = w; }
    for (int rpD = 0; rpD < DBG_RD; ++rpD) {
        const int fr = lane & 15, fq = lane >> 4; const float glast = EG[63];
#pragma unroll
        for (int tt = 0; tt < 8; ++tt) { const int tile = 2 * tt + role, mt = tile >> 2, nt = tile & 3;
            f32x4 acc = (f32x4){0.f, 0.f, 0.f, 0.f};
#pragma unroll
            for (int ks = 0; ks < 2; ++ks) { const bf16x8 a = *(const LAS bf16x8*)(L + DN_TKB + (16 * mt + fr) * DN_ROWB + (fq * 8 + 32 * ks) * 2);
                const bf16x8 b = *(const LAS bf16x8*)(L + DN_TK + (16 * nt + fr) * DN_ROWB + (fq * 8 + 32 * ks) * 2); acc = MFMA16(a, b, acc); }
            { const int dko = 16 * nt + fr, dki0 = 16 * mt + 4 * fq; u32x2 w;
              w.x = pk2((dko == dki0 ? glast : 0.f) - acc[0], (dko == dki0 + 1 ? glast : 0.f) - acc[1]); w.y = pk2((dko == dki0 + 2 ? glast : 0.f) - acc[2], (dko == dki0 + 3 ? glast : 0.f) - acc[3]);
              *(u32x2*)(MM + (size_t)chidx * 4096 + dko * 64 + dki0) = w; }
            acc = (f32x4){0.f, 0.f, 0.f, 0.f};
#pragma unroll
            for (int ks = 0; ks < 2; ++ks) { const bf16x8 a = *(const LAS bf16x8*)(L + DN_TK + (16 * mt + fr) * DN_ROWB + (fq * 8 + 32 * ks) * 2);
                const bf16x8 b = *(const LAS bf16x8*)(L + DN_TVB + (16 * nt + fr) * DN_ROWB + (fq * 8 + 32 * ks) * 2); acc = MFMA16(a, b, acc); }
            { u32x2 w; w.x = pk2(acc[0], acc[1]); w.y = pk2(acc[2], acc[3]); *(u32x2*)(NT + (size_t)chidx * 4096 + (16 * nt + fr) * 64 + 16 * mt + 4 * fq) = w; }
        }
    }
    WG_BAR();
}
constexpr int SC_ROWB = 144;
constexpr int SC_ST = 0, SC_VT = 64 * SC_ROWB, SC_RS = 2 * 64 * SC_ROWB;
DI void dn_scan(const Frame& F, int chain, const bf16_t* MM, const bf16_t* NT, bf16_t* SG, int nb, int ne, bool do_store = true) {
    const int lane = F.lane, wave = F.wave, rt = wave & 3, fr = lane & 15, fq = lane >> 4; const bool worker = wave < 4;
    const int bl = chain >> 3, h = chain & 7;
    LAS unsigned char* L = F.lds;
    if (nb == 0) for (int i = F.tid; i < 64 * SC_ROWB / 4; i += 512) ((LAS unsigned*)L)[i] = 0u;
    const size_t cstride = (size_t)8 * 4096;
    size_t cb = (size_t)((bl * 128 + nb) * 8 + h) * 4096;
    const int aoffs = (16 * rt + fr) * 64 + fq * 8;
    const int coff0 = fr * 64 + 16 * rt + 4 * fq;
    if (worker && nb == 0) {
#pragma unroll
        for (int nt = 0; nt < 4; ++nt) *(u32x2*)(SG + cb + coff0 + 1024 * nt) = (u32x2){0u, 0u}; }
    bf16x8 a[4][2]; u32x2 nc[4][4];
    if (worker) {
#pragma unroll
        for (int j = 0; j < 4; ++j) { const size_t cj = cb + (size_t)(nb + j < 127 ? j : 0) * cstride;
#pragma unroll
            for (int ks = 0; ks < 2; ++ks) a[j][ks] = *(const bf16x8*)(MM + cj + aoffs + 32 * ks);
#pragma unroll
            for (int nt = 0; nt < 4; ++nt) nc[j][nt] = *(const u32x2*)(NT + cj + coff0 + 1024 * nt); } }
    __syncthreads();
#pragma unroll 1
    for (int n0 = nb; n0 < ne; n0 += 16) {
#pragma unroll
        for (int jj = 0; jj < 16; ++jj) { const int j = jj & 3; const int n = n0 + jj;
            if (n < ne) {
                const size_t cbn = cb + cstride;
                if (worker) {
                    LAS unsigned char* SR = L + (n & 1) * 64 * SC_ROWB; LAS unsigned char* SW = L + ((n + 1) & 1) * 64 * SC_ROWB;
#pragma unroll
                    for (int nt = 0; nt < 4; ++nt) {
                        f32x4 acc = (f32x4){__uint_as_float(nc[j][nt].x << 16), __uint_as_float(nc[j][nt].x & 0xffff0000u), __uint_as_float(nc[j][nt].y << 16), __uint_as_float(nc[j][nt].y & 0xffff0000u)};
#pragma unroll
                        for (int ks = 0; ks < 2; ++ks) { const bf16x8 sb = *(const LAS bf16x8*)(SR + (16 * nt + fr) * SC_ROWB + (fq * 8 + 32 * ks) * 2); acc = MFMA16(a[j][ks], sb, acc); }
                        u32x2 w; w.x = cvt_pk_bf16(acc[0], acc[1]); w.y = cvt_pk_bf16(acc[2], acc[3]);
                        *(LAS u32x2*)(SW + (16 * nt + fr) * SC_ROWB + (16 * rt + 4 * fq) * 2) = w;
                        if (do_store) *(u32x2*)(SG + cbn + coff0 + 1024 * nt) = w;
                    }
                    if (n + 4 < 127) { const size_t c4 = cb + 4 * cstride;
#pragma unroll
                        for (int ks = 0; ks < 2; ++ks) a[j][ks] = *(const bf16x8*)(MM + c4 + aoffs + 32 * ks);
#pragma unroll
                        for (int nt = 0; nt < 4; ++nt) nc[j][nt] = *(const u32x2*)(NT + c4 + coff0 + 1024 * nt); }
                }
                WG_BAR();
                cb = cbn;
            }
        }
    }
    __syncthreads();
}

struct OutOps { bf16x8 wn[2], qd[2], aq[2], sb[4][2]; u32x2 uv[4]; unsigned short zv[16]; };
DI void out_load(OutOps& o, int k, int rt, int fr, int fq, const bf16_t* QD, const bf16_t* WN, const bf16_t* UT, const bf16_t* AQK, const bf16_t* SG, const bf16_t* ZB) {
    const size_t cb = (size_t)k * 4096; const int arow = 16 * rt + fr; const int h = k & 7, n = (k >> 3) & 127, bl = k >> 10;
#pragma unroll
    for (int ks = 0; ks < 2; ++ks) { const size_t off = cb + arow * 64 + fq * 8 + 32 * ks;
        o.wn[ks] = *(const bf16x8*)(WN + off); o.qd[ks] = *(const bf16x8*)(QD + off); o.aq[ks] = *(const bf16x8*)(AQK + off); }
#pragma unroll
    for (int nt = 0; nt < 4; ++nt) { o.uv[nt] = *(const u32x2*)(UT + cb + (16 * nt + fr) * 64 + 16 * rt + 4 * fq);
#pragma unroll
        for (int ks = 0; ks < 2; ++ks) o.sb[nt][ks] = *(const bf16x8*)(SG + cb + (16 * nt + fr) * 64 + fq * 8 + 32 * ks); }
    const int lrb = bl * SEQ + n * 64 + 16 * rt + 4 * fq;
#pragma unroll
    for (int r = 0; r < 4; ++r)
#pragma unroll
        for (int nt = 0; nt < 4; ++nt) o.zv[r * 4 + nt] = ZB[(size_t)(lrb + r) * 512 + h * 64 + 16 * nt + fr];
}
DI void dn_out_pass(const Frame& F, const bf16_t* QD, const bf16_t* WN, const bf16_t* UT, const bf16_t* AQK, const bf16_t* SG, const bf16_t* ZB, const float* dng, bf16_t* BR) {
    int lane_ = F.lane; LAUNDER_V(lane_);
    const int lane = lane_, wave = F.wave, rt = wave & 3, half = wave >> 2, fr = lane & 15, fq = lane >> 4;
    LAS unsigned char* L = F.lds;
    float ng[4];
#pragma unroll
    for (int nt = 0; nt < 4; ++nt) ng[nt] = dng[16 * nt + fr];
    int p = F.blk; if (p >= NCH / 2) return;
    OutOps cur, nxt;
    out_load(cur, 2 * p + half, rt, fr, fq, QD, WN, UT, AQK, SG, ZB);
    __syncthreads();
    for (int it = 0; p < NCH / 2; p += F.G, ++it) {
        const int k = 2 * p + half, pn = p + F.G < NCH / 2 ? p + F.G : p;
        out_load(nxt, 2 * pn + half, rt, fr, fq, QD, WN, UT, AQK, SG, ZB);
        const int h = k & 7, n = (k >> 3) & 127, bl = k >> 10;
        LAS unsigned char* VT = L + ((it & 1) * 2 + half) * 64 * SC_ROWB;
        f32x4 vn[4], o[4];
#pragma unroll
        for (int nt = 0; nt < 4; ++nt) { vn[nt] = (f32x4){__uint_as_float(cur.uv[nt].x << 16), __uint_as_float(cur.uv[nt].x & 0xffff0000u), __uint_as_float(cur.uv[nt].y << 16), __uint_as_float(cur.uv[nt].y & 0xffff0000u)};
            o[nt] = (f32x4){0.f, 0.f, 0.f, 0.f};
#pragma unroll
            for (int ks = 0; ks < 2; ++ks) { vn[nt] = MFMA16(cur.wn[ks], cur.sb[nt][ks], vn[nt]); o[nt] = MFMA16(cur.qd[ks], cur.sb[nt][ks], o[nt]); } }
#pragma unroll
        for (int nt = 0; nt < 4; ++nt) { u32x2 w; w.x = cvt_pk_bf16(vn[nt][0], vn[nt][1]); w.y = cvt_pk_bf16(vn[nt][2], vn[nt][3]);
            *(LAS u32x2*)(VT + (16 * nt + fr) * SC_ROWB + (16 * rt + 4 * fq) * 2) = w; }
        WG_BAR();
#pragma unroll
        for (int nt = 0; nt < 4; ++nt)
#pragma unroll
            for (int ks = 0; ks < 2; ++ks) { const bf16x8 vb = *(const LAS bf16x8*)(VT + (16 * nt + fr) * SC_ROWB + (fq * 8 + 32 * ks) * 2); o[nt] = MFMA16(cur.aq[ks], vb, o[nt]); }
        const int lrb = bl * SEQ + n * 64 + 16 * rt + 4 * fq;
#pragma unroll
        for (int r = 0; r < 4; ++r) { float q = (o[0][r] * o[0][r] + o[1][r] * o[1][r]) + (o[2][r] * o[2][r] + o[3][r] * o[3][r]);
            q += __shfl_xor(q, 1); q += __shfl_xor(q, 2); q += __shfl_xor(q, 4); q += __shfl_xor(q, 8);
            const float rs = rsqrtf(q * (1.0f / 64.0f) + RMS_EPS); const size_t lr = (size_t)(lrb + r);
#pragma unroll
            for (int nt = 0; nt < 4; ++nt) { const float z = bf2f(cur.zv[r * 4 + nt]);
                BR[lr * 1024 + 512 + h * 64 + 16 * nt + fr] = (bf16_t)f2bf(o[nt][r] * rs * ng[nt] * (z * fsigmoid(z))); } }
        cur = nxt;
    }
    __syncthreads();
}

constexpr int MG_QS = 0, MG_KB = 36864, MG_SEL = MG_KB + 8192, MG_TOP = MG_SEL + 1024;
DI void moba_gate_unit(const Frame& F, const bf16_t* Pb, const float* KBAR, unsigned* SELG, unsigned char* LISTG, int* CNTG, int bl, int h, int c) {
    int lane_ = F.lane; LAUNDER_V(lane_);
    const int lane = lane_, wave = F.wave, tid = wave * 64 + lane;
    LAS unsigned char* L = F.lds; LAS float* KB = (LAS float*)(L + MG_KB); LAS unsigned* SEL = (LAS unsigned*)(L + MG_SEL);
    const int q0 = bl * SEQ + c * 256, bh = bl * 4 + h;
    __syncthreads();
#pragma unroll
    for (int i = 0; i < 4; ++i) { const int q = tid + 512 * i, r = q >> 3, c8 = q & 7; *(LAS u32x4*)(L + MG_QS + r * 144 + c8 * 16) = *(const u32x4*)(Pb + (size_t)(q0 + r) * PLD + PC_MQ + h * 64 + c8 * 8); }
    for (int i = tid; i < c * 64; i += 512) KB[i] = KBAR[(size_t)bh * 2048 + i];
    __syncthreads();
    {
        const int qi = tid & 255, par = tid >> 8;
        float qv[64];
#pragma unroll
        for (int c8 = 0; c8 < 8; ++c8) { const u32x4 v = *(const LAS u32x4*)(L + MG_QS + qi * 144 + c8 * 16);
#pragma unroll
            for (int e = 0; e < 4; ++e) { qv[c8 * 8 + 2 * e] = __uint_as_float(v[e] << 16); qv[c8 * 8 + 2 * e + 1] = __uint_as_float(v[e] & 0xffff0000u); } }
        float v1 = -INFINITY, v2 = -INFINITY, v3 = -INFINITY; int i1 = -1, i2 = -1, i3 = -1;
        for (int n = par; n < c; n += 2) { float g0 = 0.f, g1 = 0.f, g2 = 0.f, g3 = 0.f;
#pragma unroll
            for (int d4 = 0; d4 < 16; ++d4) { const f32x4 kb = *(const LAS f32x4*)(KB + n * 64 + d4 * 4); g0 += qv[4 * d4] * kb.x; g1 += qv[4 * d4 + 1] * kb.y; g2 += qv[4 * d4 + 2] * kb.z; g3 += qv[4 * d4 + 3] * kb.w; }
            const float g = (g0 + g1) + (g2 + g3);
            if (g > v1) { v3 = v2; i3 = i2; v2 = v1; i2 = i1; v1 = g; i1 = n; } else if (g > v2) { v3 = v2; i3 = i2; v2 = g; i2 = n; } else if (g > v3) { v3 = g; i3 = n; } }
        LAS float* TP = (LAS float*)(L + MG_TOP);
        if (par == 1) { TP[qi * 6 + 0] = v1; TP[qi * 6 + 1] = v2; TP[qi * 6 + 2] = v3; TP[qi * 6 + 3] = __int_as_float(i1); TP[qi * 6 + 4] = __int_as_float(i2); TP[qi * 6 + 5] = __int_as_float(i3); }
        __syncthreads();
        if (par == 0) {
#pragma unroll
            for (int k = 0; k < 3; ++k) { const float g = TP[qi * 6 + k]; const int n = __float_as_int(TP[qi * 6 + 3 + k]);
                if (n >= 0) { const bool b1 = g > v1 || (g == v1 && n < i1), b2 = g > v2 || (g == v2 && n < i2), b3 = g > v3 || (g == v3 && n < i3);
                    if (b1) { v3 = v2; i3 = i2; v2 = v1; i2 = i1; v1 = g; i1 = n; } else if (b2) { v3 = v2; i3 = i2; v2 = g; i2 = n; } else if (b3) { v3 = g; i3 = n; } } }
            const unsigned s4 = (unsigned)(i1 & 255) | ((unsigned)(i2 & 255) << 8) | ((unsigned)(i3 & 255) << 16) | 0xff000000u;
            SEL[qi] = s4; SELG[(size_t)(q0 + qi) * 4 + h] = s4;
        }
    }
    __syncthreads();
    for (int n = wave; n < c; n += 8) { int base = 0; unsigned char* lp = LISTG + ((size_t)(bh * 32 + c) * 32 + n) * 256;
#pragma unroll
        for (int ck = 0; ck < 4; ++ck) { const int q = ck * 64 + lane; const unsigned s4 = SEL[q]; const bool f = (s4 & 255u) == (unsigned)n || ((s4 >> 8) & 255u) == (unsigned)n || ((s4 >> 16) & 255u) == (unsigned)n;
            const unsigned long long bal = __ballot(f); const int pos = base + __popcll(bal & ((1ull << lane) - 1ull)); if (f) lp[pos] = (unsigned char)q; base += __popcll(bal); }
        if (lane == 0) CNTG[(bh * 32 + c) * 32 + n] = base; }
}
constexpr int KV_KL = 0, KV_VL = 36864, KV_PRE = KV_VL + 64 * 528;
DI void kv_tile(const LAS unsigned char* KL, const LAS unsigned char* VL, const bf16x8 (&qf)[2], int nsteps, bool causal, int qloc, int fr, int fq, f32x4 (&O)[4], float& m_out, float& l_out) {
    const float sc2 = 0.125f * 1.44269504089f;
    f32x4 s[16];
    const LAS unsigned char* kr0 = KL + (8 * (fr >> 2) + (fr & 3)) * 144 + fq * 16;
#pragma unroll
    for (int s8 = 0; s8 < 8; ++s8)
#pragma unroll
        for (int j = 0; j < 2; ++j) { f32x4 acc = (f32x4){0.f, 0.f, 0.f, 0.f};
#pragma unroll
            for (int ks = 0; ks < 2; ++ks) { const bf16x8 a = *(const LAS bf16x8*)(kr0 + (32 * s8 + 4 * j) * 144 + 64 * ks); acc = MFMA16(a, qf[ks], acc); }
            s[2 * s8 + j] = (s8 < nsteps) ? acc : (f32x4){-INFINITY, -INFINITY, -INFINITY, -INFINITY}; }
    if (causal) {
#pragma unroll
        for (int t = 0; t < 16; ++t)
#pragma unroll
            for (int r = 0; r < 4; ++r) { const int key = 32 * (t >> 1) + 8 * fq + 4 * (t & 1) + r; s[t][r] = key <= qloc ? s[t][r] : -INFINITY; } }
    float m = -INFINITY;
#pragma unroll
    for (int t = 0; t < 16; ++t) m = fmaxf(m, fmaxf(fmaxf(s[t][0], s[t][1]), fmaxf(s[t][2], s[t][3])));
    m = fmaxf(m, __shfl_xor(m, 16)); m = fmaxf(m, __shfl_xor(m, 32));
    const float mb = -m * sc2; float l = 0.f;
#pragma unroll
    for (int t = 0; t < 16; ++t)
#pragma unroll
        for (int r = 0; r < 4; ++r) { const float p = __builtin_amdgcn_exp2f(fmaf(s[t][r], sc2, mb)); s[t][r] = p; l += p; }
    l += __shfl_xor(l, 16); l += __shfl_xor(l, 32);
#pragma unroll
    for (int dt = 0; dt < 4; ++dt) O[dt] = (f32x4){0.f, 0.f, 0.f, 0.f};
    const LAS unsigned char* vr0 = VL + fr * 528 + fq * 16;
#pragma unroll
    for (int s8 = 0; s8 < 8; ++s8) {
        u32x4 pw; pw.x = cvt_pk_bf16(s[2 * s8][0], s[2 * s8][1]); pw.y = cvt_pk_bf16(s[2 * s8][2], s[2 * s8][3]); pw.z = cvt_pk_bf16(s[2 * s8 + 1][0], s[2 * s8 + 1][1]); pw.w = cvt_pk_bf16(s[2 * s8 + 1][2], s[2 * s8 + 1][3]);
        const bf16x8 pb = __builtin_bit_cast(bf16x8, pw);
#pragma unroll
        for (int dt = 0; dt < 4; ++dt) { const bf16x8 a = *(const LAS bf16x8*)(vr0 + (16 * dt) * 528 + 64 * s8); O[dt] = MFMA16(a, pb, O[dt]); } }
    m_out = m; l_out = l;
}
DI void kv_store(bf16_t* OPG, float* MLG, size_t row, int h, int slot, const f32x4 (&O)[4], float m, float l, int fq) {
    const float inv = 1.0f / l; const size_t base = ((row * 4 + h) * 4 + slot);
#pragma unroll
    for (int dt = 0; dt < 4; ++dt) { u32x2 w; w.x = cvt_pk_bf16(O[dt][0] * inv, O[dt][1] * inv); w.y = cvt_pk_bf16(O[dt][2] * inv, O[dt][3] * inv); *(u32x2*)(OPG + base * 64 + 16 * dt + 4 * fq) = w; }
    if (fq == 0) { MLG[base * 2] = m; MLG[base * 2 + 1] = l; }
}
DI void moba_kv_unit(const Frame& F, const bf16_t* Pb, const bf16_t* VT, const unsigned* SELG, const unsigned char* LISTG, const int* CNTG, bf16_t* OPG, float* MLG, int bl, int h, int n, int part, int nparts) {
    int lane_ = F.lane; LAUNDER_V(lane_);
    const int lane = lane_, wave = F.wave, tid = wave * 64 + lane, fr = lane & 15, fq = lane >> 4;
    LAS unsigned char* L = F.lds; LAS int* PRE = (LAS int*)(L + KV_PRE);
    const int bh = bl * 4 + h;
    const bf16_t* Kg = Pb + (size_t)(bl * SEQ + n * 256) * PLD + PC_MK + h * 64;
    const bf16_t* Vg = VT + (size_t)(bh * 64) * SEQ + n * 256;
    const bf16_t* Qg = Pb + (size_t)(bl * SEQ) * PLD + PC_MQ + h * 64;
    __syncthreads();
#pragma unroll
    for (int i = 0; i < 4; ++i) { const int q = tid + 512 * i, r = q >> 3, c8 = q & 7; *(LAS u32x4*)(L + KV_KL + r * 144 + c8 * 16) = *(const u32x4*)(Kg + (size_t)r * PLD + c8 * 8); }
#pragma unroll
    for (int i = 0; i < 4; ++i) { const int q = tid + 512 * i, d = q >> 5, c16 = q & 31; *(LAS u32x4*)(L + KV_VL + d * 528 + c16 * 16) = *(const u32x4*)(Vg + (size_t)d * SEQ + c16 * 8); }
    if (wave == 0) {
        const int cq = lane; int cnt = (cq > n && cq < 32) ? CNTG[(bh * 32 + cq) * 32 + n] : 0; int inc = cnt;
#pragma unroll
        for (int o = 1; o < 32; o <<= 1) { const int up = __shfl_up(inc, o); if (lane >= o) inc += up; }
        if (lane < 32) PRE[lane] = inc - cnt; if (lane == 31) PRE[32] = inc;
    }
    __syncthreads();
    const int T = PRE[32], nsp = (T + 15) >> 4, ntl = nsp + 16;
    for (int tt = part + nparts * wave; tt < ntl; tt += nparts * 8) {
        f32x4 O[4]; float m, l; bf16x8 qf[2];
        if (tt < nsp) {
            const int e = 16 * tt + fr; const bool valid = e < T; const int ee = valid ? e : 0;
            int cq = 0;
#pragma unroll
            for (int i = 1; i < 32; ++i) cq += (PRE[i] <= ee) ? 1 : 0;
            const int q = LISTG[((size_t)(bh * 32 + cq) * 32 + n) * 256 + (ee - PRE[cq])];
            const int tok = cq * 256 + q; const size_t row = (size_t)(bl * SEQ + tok);
#pragma unroll
            for (int ks = 0; ks < 2; ++ks) qf[ks] = *(const bf16x8*)(Qg + (size_t)tok * PLD + fq * 8 + 32 * ks);
            kv_tile(L + KV_KL, L + KV_VL, qf, 8, false, 0, fr, fq, O, m, l);
            const unsigned s4 = SELG[row * 4 + h]; const int slot = (s4 & 255u) == (unsigned)n ? 0 : (((s4 >> 8) & 255u) == (unsigned)n ? 1 : 2);
            if (valid) kv_store(OPG, MLG, row, h, slot, O, m, l, fq);
        } else {
            const int to = tt - nsp, qloc = 16 * to + fr, tok = n * 256 + qloc; const size_t row = (size_t)(bl * SEQ + tok);
#pragma unroll
            for (int ks = 0; ks < 2; ++ks) qf[ks] = *(const bf16x8*)(Qg + (size_t)tok * PLD + fq * 8 + 32 * ks);
            kv_tile(L + KV_KL, L + KV_VL, qf, (16 * to + 15) / 32 + 1, true, qloc, fr, fq, O, m, l);
            kv_store(OPG, MLG, row, h, 3, O, m, l, fq);
        }
    }
}
DI void moba_combine(const Frame& F, const unsigned* SELG, const bf16_t* OPG, const float* MLG, bf16_t* BR) {
    int lane_ = F.lane; LAUNDER_V(lane_);
    const int lane = lane_, sub = lane & 7, gw = F.blk * 8 + F.wave, NGW = F.G * 8;
    const float sc2 = 0.125f * 1.44269504089f;
    for (int it = gw; it < NG * 4 / 8; it += NGW) { const size_t idx = (size_t)it * 8 + (lane >> 3); const size_t row = idx >> 2; const int h = (int)(idx & 3);
        const unsigned s4 = SELG[idx]; float mk[4], lk[4]; float M = -INFINITY;
#pragma unroll
        for (int k = 0; k < 4; ++k) { const bool ok = (k == 3) || (((s4 >> (8 * k)) & 255u) != 255u); const f32x2 ml = *(const f32x2*)(MLG + (idx * 4 + k) * 2); mk[k] = ok ? ml.x : -INFINITY; lk[k] = ok ? ml.y : 0.f; M = fmaxf(M, mk[k]); }
        float o[8]; float den = 0.f;
#pragma unroll
        for (int e = 0; e < 8; ++e) o[e] = 0.f;
#pragma unroll
        for (int k = 0; k < 4; ++k) { const bool ok = (k == 3) || (((s4 >> (8 * k)) & 255u) != 255u); const float w = ok ? lk[k] * __builtin_amdgcn_exp2f((mk[k] - M) * sc2) : 0.f; den += w;
            u32x4 pv = *(const u32x4*)(OPG + (idx * 4 + k) * 64 + sub * 8);
            if (!ok) pv = (u32x4){0u, 0u, 0u, 0u};
#pragma unroll
            for (int e = 0; e < 4; ++e) { o[2 * e] += w * __uint_as_float(pv[e] << 16); o[2 * e + 1] += w * __uint_as_float(pv[e] & 0xffff0000u); } }
        const float inv = 1.0f / den; u32x4 wv;
#pragma unroll
        for (int e = 0; e < 4; ++e) wv[e] = cvt_pk_bf16(o[2 * e] * inv, o[2 * e + 1] * inv);
        *(u32x4*)(BR + row * 1024 + 256 + h * 64 + sub * 8) = wv; }
}
__host__ __device__ constexpr int kv_parts(int n) { return n == 0 ? 3 : (n < 8 ? 2 : 1); }
__host__ __device__ constexpr int kv_items_before(int n) { int s = 0; for (int i = 0; i < n; ++i) s += kv_parts(i) * GB * 4; return s; }
constexpr int KV_NITEMS = kv_items_before(32);

constexpr int XA_K = 0;
constexpr int XA_VT = 69632;
DI void xattn_wg(const Frame& F, const bf16_t* KVM, const bf16_t* QX, bf16_t* AO, int w) {
    int lane_ = F.lane; LAUNDER_V(lane_);
    const int lane = lane_, wave = F.wave, tid = wave * 64 + lane, fr = lane & 15, fq = lane >> 4;
    const int b = w >> 5, h = (w >> 3) & 3, qpart = w & 7;
    LAS unsigned char* L = F.lds;
    __syncthreads();
#pragma unroll
    for (int i = 0; i < 8; ++i) { const int q = tid + 512 * i, m = q >> 4, c16 = q & 15; *(LAS u32x4*)(L + XA_K + m * 272 + c16 * 16) = *(const u32x4*)(KVM + (size_t)(b * 256 + m) * 1024 + h * 128 + c16 * 8); }
#pragma unroll
    for (int i = 0; i < 8; ++i) { const int q = tid + 512 * i, m = q & 255, c16 = q >> 8; const u32x4 v = *(const u32x4*)(KVM + (size_t)(b * 256 + m) * 1024 + 512 + h * 128 + c16 * 8);
#pragma unroll
        for (int e = 0; e < 4; ++e) { *(LAS bf16_t*)(L + XA_VT + (c16 * 8 + 2 * e) * 528 + m * 2) = (bf16_t)(v[e] & 0xffffu); *(LAS bf16_t*)(L + XA_VT + (c16 * 8 + 2 * e + 1) * 528 + m * 2) = (bf16_t)(v[e] >> 16); } }
    __syncthreads();
    const float sc2 = 0.08838834764831845f * 1.44269504089f;
    for (int rtile = 0; rtile < 8; ++rtile) {
        const size_t tok = (size_t)b * SEQ + qpart * 1024 + wave * 128 + rtile * 16 + fr;
        bf16x8 qf[4];
#pragma unroll
        for (int ks = 0; ks < 4; ++ks) qf[ks] = *(const bf16x8*)(QX + tok * 512 + h * 128 + fq * 8 + 32 * ks);
        f32x4 s[16]; float mx = -INFINITY;
#pragma unroll
        for (int kt = 0; kt < 16; ++kt) { s[kt] = (f32x4){0.f, 0.f, 0.f, 0.f};
#pragma unroll
            for (int ks = 0; ks < 4; ++ks) { const bf16x8 a = *(const LAS bf16x8*)(L + XA_K + (16 * kt + fr) * 272 + (fq * 8 + 32 * ks) * 2); s[kt] = MFMA16(a, qf[ks], s[kt]); }
            mx = fmaxf(mx, fmaxf(fmaxf(s[kt][0], s[kt][1]), fmaxf(s[kt][2], s[kt][3]))); __builtin_amdgcn_sched_barrier(0); }
        mx = fmaxf(mx, __shfl_xor(mx, 16)); mx = fmaxf(mx, __shfl_xor(mx, 32));
        float l = 0.f;
#pragma unroll
        for (int kt = 0; kt < 16; ++kt)
#pragma unroll
            for (int r = 0; r < 4; ++r) { const float p = __builtin_amdgcn_exp2f((s[kt][r] - mx) * sc2); s[kt][r] = p; l += p; }
        l += __shfl_xor(l, 16); l += __shfl_xor(l, 32); const float inv = 1.0f / l;
        f32x4 O[8];
#pragma unroll
        for (int dt = 0; dt < 8; ++dt) O[dt] = (f32x4){0.f, 0.f, 0.f, 0.f};
#pragma unroll
        for (int s8 = 0; s8 < 8; ++s8) {
            u32x4 pw; pw.x = pk2(s[2 * s8][0], s[2 * s8][1]); pw.y = pk2(s[2 * s8][2], s[2 * s8][3]); pw.z = pk2(s[2 * s8 + 1][0], s[2 * s8 + 1][1]); pw.w = pk2(s[2 * s8 + 1][2], s[2 * s8 + 1][3]);
            const bf16x8 pb = __builtin_bit_cast(bf16x8, pw);
#pragma unroll
            for (int dt = 0; dt < 8; ++dt) {
                const u32x2 lo = *(const LAS u32x2*)(L + XA_VT + (16 * dt + fr) * 528 + (32 * s8 + 4 * fq) * 2), hi = *(const LAS u32x2*)(L + XA_VT + (16 * dt + fr) * 528 + (32 * s8 + 16 + 4 * fq) * 2);
                const u32x4 av = (u32x4){lo.x, lo.y, hi.x, hi.y};
                O[dt] = MFMA16(__builtin_bit_cast(bf16x8, av), pb, O[dt]); }
            __builtin_amdgcn_sched_barrier(0);
        }
#pragma unroll
        for (int dt = 0; dt < 8; ++dt) { u32x2 wv; wv.x = pk2(O[dt][0] * inv, O[dt][1] * inv); wv.y = pk2(O[dt][2] * inv, O[dt][3] * inv);
            *(u32x2*)(AO + tok * 512 + h * 128 + 16 * dt + 4 * fq) = wv; }
    }
    __syncthreads();
}
DI void moe_route1(const Frame& F, const bf16_t* x, const float* Wr, int* TE, float* TW, float* RR, int* CNT) {
    const int tid = F.tid, lane = F.lane, wave = F.wave;
    LAS float* WL = (LAS float*)F.lds; LAS int* HC = (LAS int*)(F.lds + 32768);
    __syncthreads();
    for (int i = tid; i < 8 * 1024 / 4; i += 512) ((LAS f32x4*)WL)[i] = ((const f32x4*)Wr)[i];
    for (int tb = F.blk; tb < NTOK / 256; tb += F.G) {
        if (tid < 8) HC[tid] = 0;
        __syncthreads();
        u32x2 vn[4];
        { const u32x2* xr = (const u32x2*)(x + (size_t)(tb * 256 + wave * 32) * 1024) + lane;
#pragma unroll
          for (int j = 0; j < 4; ++j) vn[j] = xr[64 * j]; }
        for (int rr = 0; rr < 32; ++rr) { const int row = tb * 256 + wave * 32 + rr;
            f32x4 v[4]; float ss = 0.f;
#pragma unroll
            for (int j = 0; j < 4; ++j) v[j] = (f32x4){__uint_as_float(vn[j].x << 16), __uint_as_float(vn[j].x & 0xffff0000u), __uint_as_float(vn[j].y << 16), __uint_as_float(vn[j].y & 0xffff0000u)};
            { const u32x2* xr = (const u32x2*)(x + (size_t)(rr + 1 < 32 ? row + 1 : row) * 1024) + lane;
#pragma unroll
              for (int j = 0; j < 4; ++j) vn[j] = xr[64 * j]; }
#pragma unroll
            for (int j = 0; j < 4; ++j) ss += (v[j].x * v[j].x + v[j].y * v[j].y) + (v[j].z * v[j].z + v[j].w * v[j].w);
            ss = wave_sum(ss); const float r = rsqrtf(ss * (1.0f / 1024.0f) + RMS_EPS);
            float lg[8];
#pragma unroll
            for (int e = 0; e < 8; ++e) { float a = 0.f;
#pragma unroll
                for (int j = 0; j < 4; ++j) { const f32x4 w = *(const LAS f32x4*)(WL + e * 1024 + 4 * lane + 256 * j); a += (v[j].x * w.x + v[j].y * w.y) + (v[j].z * w.z + v[j].w * w.w); }
                lg[e] = wave_sum(a) * r; }
            int e0 = 0; float l0 = lg[0];
#pragma unroll
            for (int e = 1; e < 8; ++e) if (lg[e] > l0) { l0 = lg[e]; e0 = e; }
            int e1 = -1; float l1 = -INFINITY;
#pragma unroll
            for (int e = 0; e < 8; ++e) if (e != e0 && lg[e] > l1) { l1 = lg[e]; e1 = e; }
            const float w0 = 1.0f / (1.0f + __expf(l1 - l0));
            if (lane == 0) { TE[2 * (size_t)row] = e0; TE[2 * (size_t)row + 1] = e1; TW[2 * (size_t)row] = w0; TW[2 * (size_t)row + 1] = 1.0f - w0; RR[row] = r;
                __hip_atomic_fetch_add(&HC[e0], 1, __ATOMIC_RELAXED, __HIP_MEMORY_SCOPE_WORKGROUP); __hip_atomic_fetch_add(&HC[e1], 1, __ATOMIC_RELAXED, __HIP_MEMORY_SCOPE_WORKGROUP); }
        }
        __syncthreads();
        if (tid < 8) CNT[tb * 8 + tid] = HC[tid];
        __syncthreads();
    }
}
DI void moe_bases(const Frame& F, const int* CNT, int tb, LAS int* OUT  ) {
    const int tid = F.tid; LAS int* SC = (LAS int*)(F.lds + 40960);
    __syncthreads();
    { const int e = tid & 7, seg = tid >> 3; int all = 0, lt = 0;
#pragma unroll
      for (int q = 0; q < 4; ++q) { const int w = 4 * seg + q; const int c = CNT[w * 8 + e]; all += c; lt += (w < tb) ? c : 0; }
      SC[seg * 8 + e] = all; SC[512 + seg * 8 + e] = lt; }
    __syncthreads();
    if (tid < 8) { int all = 0, lt = 0; for (int s = 0; s < 64; ++s) { all += SC[s * 8 + tid]; lt += SC[512 + s * 8 + tid]; } SC[1024 + tid] = (all + 255) >> 8; OUT[16 + tid] = lt; }
    __syncthreads();
    if (tid == 0) { int b = 0; for (int e = 0; e < 8; ++e) { OUT[e] = b; b += SC[1024 + e]; } OUT[8] = b; }
    __syncthreads();
}
DI void moe_route2(const Frame& F, const int* TE, const float* RR, const int* CNT, const bf16_t* xb, int* POS, bf16_t* XP, float* RP) {
    const int tid = F.tid, lane = F.lane, wave = F.wave;
    LAS int* MB = (LAS int*)(F.lds + 49152);
    LAS int* WT = (LAS int*)(F.lds + 49152 + 256);
    LAS int* PL = (LAS int*)(F.lds + 49152 + 512);
    for (int tb = F.blk; tb < NTOK / 256; tb += F.G) {
        moe_bases(F, CNT, tb, MB);
        int e0 = -1, e1 = -1; const int tok = tb * 256 + tid;
        if (tid < 256) { e0 = TE[2 * (size_t)tok]; e1 = TE[2 * (size_t)tok + 1]; }
        int pw[2] = {0, 0};
#pragma unroll
        for (int e = 0; e < 8; ++e) { const bool f = (e0 == e) || (e1 == e); const unsigned long long bal = __ballot(f);
            const int before = __popcll(bal & ((1ull << lane) - 1ull)); if (lane == 0 && wave < 4) WT[wave * 8 + e] = __popcll(bal);
            if (e0 == e) pw[0] = before; if (e1 == e) pw[1] = before; }
        __syncthreads();
        if (tid < 256) {
#pragma unroll
            for (int sl = 0; sl < 2; ++sl) { const int e = sl ? e1 : e0; int rank = pw[sl]; for (int w2 = 0; w2 < wave; ++w2) rank += WT[w2 * 8 + e];
                const int pos = MB[e] * 256 + MB[16 + e] + rank; PL[2 * tid + sl] = pos; POS[2 * (size_t)tok + sl] = pos; RP[pos] = RR[tok]; } }
        __syncthreads();
        for (int pr0 = wave * 64; pr0 < wave * 64 + 64; pr0 += 8) { u32x4 ra[8], rb[8];
#pragma unroll
            for (int q = 0; q < 8; ++q) { const int t2 = (pr0 + q) >> 1; const u32x4* src = (const u32x4*)(xb + (size_t)(tb * 256 + t2) * 1024); ra[q] = src[lane]; rb[q] = src[lane + 64]; }
#pragma unroll
            for (int q = 0; q < 8; ++q) { const int pos = PL[pr0 + q]; u32x4* dst = (u32x4*)(XP + (size_t)pos * 1024); dst[lane] = ra[q]; dst[lane + 64] = rb[q]; } }
        __syncthreads();
    }
}
DI void moe_final(const Frame& F, const bf16_t* xb, float* out, const bf16_t* Y, const int* POS, const float* TW, const float* fg) {
    const int lane = F.lane, gw = F.blk * 8 + F.wave, NGW = F.G * 8;
    int pn0 = 0, pn1 = 0; float wn0 = 0.f, wn1 = 0.f;
    if (gw < NTOK) { pn0 = POS[2 * (size_t)gw]; pn1 = POS[2 * (size_t)gw + 1]; wn0 = TW[2 * (size_t)gw]; wn1 = TW[2 * (size_t)gw + 1]; }
    for (int row = gw; row < NTOK; row += NGW) {
        const int p0 = pn0, p1 = pn1; const float w0 = wn0, w1 = wn1;
        { const size_t rn = (size_t)(row + NGW < NTOK ? row + NGW : row); pn0 = POS[2 * rn]; pn1 = POS[2 * rn + 1]; wn0 = TW[2 * rn]; wn1 = TW[2 * rn + 1]; }
        f32x4* xr = (f32x4*)(out + (size_t)row * 1024) + lane; const u32x2* xs = (const u32x2*)(xb + (size_t)row * 1024) + lane; const u32x2* y0 = (const u32x2*)(Y + (size_t)p0 * 1024) + lane; const u32x2* y1 = (const u32x2*)(Y + (size_t)p1 * 1024) + lane;
        f32x4 v[4]; float ss = 0.f; u32x2 ya[4], yb[4];
#pragma unroll
        for (int j = 0; j < 4; ++j) { const u32x2 xv = xs[64 * j]; v[j] = (f32x4){__uint_as_float(xv.x << 16), __uint_as_float(xv.x & 0xffff0000u), __uint_as_float(xv.y << 16), __uint_as_float(xv.y & 0xffff0000u)}; ya[j] = y0[64 * j]; yb[j] = y1[64 * j]; }
#pragma unroll
        for (int j = 0; j < 4; ++j) { const u32x2 a = ya[j], b = yb[j];
            v[j].x += w0 * __uint_as_float(a.x << 16) + w1 * __uint_as_float(b.x << 16); v[j].y += w0 * __uint_as_float(a.x & 0xffff0000u) + w1 * __uint_as_float(b.x & 0xffff0000u);
            v[j].z += w0 * __uint_as_float(a.y << 16) + w1 * __uint_as_float(b.y << 16); v[j].w += w0 * __uint_as_float(a.y & 0xffff0000u) + w1 * __uint_as_float(b.y & 0xffff0000u);
            ss += (v[j].x * v[j].x + v[j].y * v[j].y) + (v[j].z * v[j].z + v[j].w * v[j].w); }
        ss = wave_sum(ss); const float r = rsqrtf(ss * (1.0f / 1024.0f) + RMS_EPS);
#pragma unroll
        for (int j = 0; j < 4; ++j) { const f32x4 g = ((const f32x4*)fg)[lane + 64 * j]; xr[64 * j] = (f32x4){v[j].x * r * g.x, v[j].y * r * g.y, v[j].z * r * g.z, v[j].w * r * g.w}; }
    }
}
constexpr int SCAN_CUT = 32;
__global__ void __launch_bounds__(512, 2) mk_fwd(Params prm) {
    extern __shared__ __attribute__((aligned(16))) unsigned char lds_raw[];
    Frame F0;
    F0.lds = (LAS unsigned char*)lds_raw;
    F0.tid = threadIdx.x; F0.lane = F0.tid & 63; F0.wave = __builtin_amdgcn_readfirstlane(F0.tid >> 6); F0.G = gridDim.x; F0.blk = blockIdx.x;
    F0.ws = prm.ws;
    volatile LAS unsigned* MISC = (volatile LAS unsigned*)(F0.lds + LDS_MISC);
    if (F0.tid < 64) MISC[F0.tid] = 0u;
    __syncthreads();
    XcdBarrier bar; bar.bar = (unsigned*)(prm.ws + WS_CTL); bar.x = 0; bar.st = MISC;
#if MK_SINGLE
    bar = xcd_barrier_post((unsigned*)(prm.ws + WS_CTL), MISC);
#endif
    const int lo = prm.ph_lo, hi = prm.ph_hi; int ph = 0;
#ifndef DBG_REP_CLASS
#define DBG_REP_CLASS 0
#endif
#define REPEAT(cls) for (int rep_ = 0; rep_ < ((DBG_REP_CLASS == (cls)) ? 2 : 1); ++rep_)
#define REPBAR(cls) do { if (DBG_REP_CLASS == (cls) && rep_ == 0) xcd_barrier(bar); } while (0)
#define ACTIVE() (ph >= lo && ph < hi)
#define SEAM() do { if (ph + 1 < hi) xcd_barrier(bar); } while (0)
    LAS unsigned char* glds = F0.lds;
#define PTRS() unsigned char* ws = prm.ws; asm volatile("" : "+s"(ws)); Frame F = F0; { int w_ = F0.wave; asm volatile("" : "+s"(w_)); int l_ = (int)__builtin_amdgcn_mbcnt_hi(~0u, __builtin_amdgcn_mbcnt_lo(~0u, 0u)); asm volatile("" : "+v"(l_)); F.wave = w_; F.lane = l_; F.tid = w_ * 64 + l_; } F.ws = ws; unsigned char* ar = ws + WS_ARENA; (void)ar; \
    bf16_t* xb = (bf16_t*)(ws + WS_XB); float* ssq = (float*)(ws + WS_SSQ); const float* rope = (const float*)(ws + WS_ROPE); float* xout = prm.out; (void)xb; (void)ssq; (void)rope; (void)xout; \
    unsigned char* lw = ws + WS_LW + (size_t)layer * LW_STRIDE; (void)lw; const float* sm = (const float*)(ws + WS_SMALL); (void)sm
#define GPTRS() PTRS(); const bf16_t* xbg = xb + (size_t)grp * NG * 1024; const float* ssqg = ssq + (size_t)grp * NG * 16; const float* ropeg = rope + (size_t)grp * NG * 16; \
    bf16_t* Pb = (bf16_t*)(ar + AR_P); float* BA = (float*)(ar + AR_BA); bf16_t* BR = (bf16_t*)(ar + AR_BR); float* KBAR = (float*)(ar + AR_KBAR); bf16_t* VT = (bf16_t*)(ar + AR_VT); \
    bf16_t* QD = (bf16_t*)(ar + AR_QD); bf16_t* MM = (bf16_t*)(ar + AR_KDT); bf16_t* NT = (bf16_t*)(ar + AR_NT); bf16_t* SG = (bf16_t*)(ar + AR_SG); bf16_t* ZB = (bf16_t*)(ar + AR_ZB); unsigned* SELG = (unsigned*)(ar + AR_SELG); int* CNTG = (int*)(ar + AR_CNTG); unsigned char* LISTG = (unsigned char*)(ar + AR_LISTG); bf16_t* OPG = (bf16_t*)(ar + AR_OPG); float* MLG = (float*)(ar + AR_MLG); bf16_t* WN = (bf16_t*)(ar + AR_WN); bf16_t* UT = (bf16_t*)(ar + AR_UT); bf16_t* AQK = (bf16_t*)(ar + AR_AQK); float* GL = (float*)(ar + AR_GL); \
    bf16_t* MG = (bf16_t*)(ar + AR_MERGED); \
    (void)xbg; (void)ssqg; (void)ropeg; (void)Pb; (void)BA; (void)BR; (void)KBAR; (void)VT; (void)QD; (void)MM; (void)NT; (void)SG; (void)ZB; (void)SELG; (void)CNTG; (void)LISTG; (void)OPG; (void)MLG; (void)WN; (void)UT; (void)AQK; (void)GL; (void)MG
#define MPTRS() PTRS(); int* TE = (int*)(ar + AR_TE); float* TW = (float*)(ar + AR_TW); float* RR = (float*)(ar + AR_RR); int* POS = (int*)(ar + AR_POS); int* CNT = (int*)(ar + AR_CNT); \
    bf16_t* XP = (bf16_t*)(ar + AR_XP); float* RP = (float*)(ar + AR_RP); bf16_t* HM = (bf16_t*)(ar + AR_HM); (void)TE; (void)TW; (void)RR; (void)POS; (void)CNT; (void)XP; (void)RP; (void)HM

    if (ACTIVE()) { REPEAT(1) { const int layer = 0; PTRS();
        const __attribute__((address_space(4))) Params* kp = (const __attribute__((address_space(4))) Params*)__builtin_amdgcn_kernarg_segment_ptr(); asm volatile("" : "+s"(kp));
        Params lp;
#pragma unroll
        for (int i = 0; i < 27; ++i) lp.in[i] = kp->in[i];
        lp.out = nullptr; lp.ws = ws; lp.ph_lo = 0; lp.ph_hi = 0; lp.pad0 = 0; lp.pad1 = 0;
        phase_prologue(F, lp); REPBAR(1); } SEAM(); } ++ph;
    for (int layer = 0; layer < 2; ++layer) {
        for (int grp = 0; grp < NGRP; ++grp) {
            if (ACTIVE()) { REPEAT(3) {
                GPTRS();
                pg8::Gemm g{xbg, (const bf16_t*)(lw + LW_WIN), 1024, 1024};
                pg8::SchedPlain S; S.init(NG, 3072, 1024, 1024, 1024, F.G, F.blk);
                pg8::build_rtab(glds, S, ssqg, nullptr, F.tid);
                pg8::EpiScaleBf16 E{Pb, PLD, ssqg, 0, ZB, 512, 10, (const LAS float*)(glds + pg8::RTAB_OFF)};
                pg8::gemm_phase(glds, g, S, E, F.wave);
                ba_tiles(F, xbg, (const bf16_t*)(lw + LW_WBA), ssqg, BA);
                REPBAR(3); }
                SEAM();
            } ++ph;
            if (ACTIVE()) {
                GPTRS();
                REPEAT(4) {
                for (int u = F.blk; u < 1024; u += F.G)
                    prep_dn(F, Pb, BA, sm + SM_CONVW + (size_t)layer * 4 * 1536, sm + SM_ALOG + layer * 8, sm + SM_DTB + layer * 8, QD, MM, NT, WN, UT, AQK, GL, u);
#ifndef DBG_RPOOL
#define DBG_RPOOL 1
#endif
                for (int rpP = 0; rpP < DBG_RPOOL; ++rpP) for (int u = F.blk; u < NG / 64; u += F.G) prep_pool(F, Pb, BR, u);
                REPBAR(4); }
                for (int u = F.blk; u < GB * 32; u += F.G) prep_moba(F, Pb, ropeg, KBAR, VT, u);
                SEAM();
            } ++ph;
            if (ACTIVE()) { REPEAT(18) {
                GPTRS();
                if (F.blk < GB * 8) { if (MK_SINGLE) dn_scan(F, F.blk, MM, NT, SG, 0, SCAN_CUT); }
                else { const int nw = F.G - GB * 8;
                    for (int u = F.blk - GB * 8; u < GB * 4 * 32; u += nw) { const int c = 31 - u / (GB * 4), bh = u % (GB * 4); moba_gate_unit(F, Pb, KBAR, SELG, LISTG, CNTG, bh >> 2, bh & 3, c); } }
                REPBAR(18); }
                SEAM();
            } ++ph;
            if (ACTIVE()) { REPEAT(5) {
                GPTRS();
                if (F.blk < GB * 8) { for (int r2_ = 0; r2_ < ((DBG_REP_CLASS == 16) ? 2 : 1); ++r2_) dn_scan(F, F.blk, MM, NT, SG, MK_SINGLE ? SCAN_CUT : 0, 127, r2_ == 0); }
                else { const int nw = F.G - GB * 8, wq = F.blk - GB * 8;
                    for (int r2_ = 0; r2_ < ((DBG_REP_CLASS == 17) ? 2 : 1); ++r2_)
                    for (int rd = 0; rd * nw < KV_NITEMS; ++rd) { const int i = rd * nw + ((rd & 1) ? nw - 1 - wq : wq); if (i >= KV_NITEMS) continue;
                        int n, part, bh;
                        if (i < 48) { n = 0; part = i >> 4; bh = i & 15; } else if (i < 272) { const int j = i - 48; n = 1 + (j >> 5); part = (j >> 4) & 1; bh = j & 15; } else { const int j = i - 272; n = 8 + (j >> 4); part = 0; bh = j & 15; }
                        moba_kv_unit(F, Pb, VT, SELG, LISTG, CNTG, OPG, MLG, bh >> 2, bh & 3, n, part, n == 0 ? 3 : (n < 8 ? 2 : 1)); } }
                if (layer == 0 && grp == 0) {
                    __syncthreads();
                    pg8::Gemm gk{(const bf16_t*)(ws + WS_MEMN), (const bf16_t*)(ws + WS_LW + LW_WKV), 1024, 1024};
                    pg8::SchedKV Sk; Sk.c = F.blk - GB * 8; Sk.lstride = LW_STRIDE;
                    pg8::EpiScaleBf16 Ek{(bf16_t*)(ws + WS_KVM), 1024, nullptr, 0, nullptr, 0, 1 << 30, nullptr};
                    pg8::gemm_phase(glds, gk, Sk, Ek, F.wave); }
                REPBAR(5); }
                SEAM();
            } ++ph;
            if (ACTIVE()) { REPEAT(6) {
                GPTRS();
                pg8::Gemm g{(const bf16_t*)(ws + WS_X8 + (size_t)grp * NG * 1024), (const bf16_t*)(ws + WS_WG8 + (size_t)layer * 3072 * 1024), 1024, 1024};
                pg8::SchedPlain S; S.init(NG, 3072, 1024, 1024, 1024, F.G, F.blk, 1);
                moba_combine(F, SELG, OPG, MLG, BR);
                dn_out_pass(F, QD, WN, UT, AQK, SG, ZB, sm + SM_DNG + layer * 64, BR);
                pg8::build_rtab(glds, S, ssqg, nullptr, F.tid);
                pg8::EpiScaleBf16 E{Pb, PLD, ssqg, 1, nullptr, 0, 1 << 30, (const LAS float*)(glds + pg8::RTAB_OFF)};
                pg8::gemm_phase<pg8::EpiScaleBf16, pg8::SchedPlain, true>(glds, g, S, E, F.wave);
                REPBAR(6); }
                SEAM();
            } ++ph;
            if (ACTIVE()) { REPEAT(7) {
                GPTRS();
                pg8::Gemm g{BR, (const bf16_t*)(lw + LW_WCAT), 1024, 1024};
                pg8::SchedPlain S; S.init(NG, 1024, 1024, 1024, 1024, F.G, F.blk);
                pg8::EpiMerge E{Pb, MG};
                pg8::gemm_phase(glds, g, S, E, F.wave);
                REPBAR(7); }
                SEAM();
            } ++ph;
            if (ACTIVE()) { for (int rep_ = 0; rep_ < ((DBG_REP_CLASS == 8 && layer == 0) ? 2 : 1); ++rep_) {
                GPTRS();
                pg8::Gemm g{MG, (const bf16_t*)(lw + LW_WOUT), 1024, 1024};
                pg8::SchedPlain S; S.init(NG, 1024, 1024, 1024, 1024, F.G, F.blk);
                pg8::EpiResid E{xb + (size_t)grp * NG * 1024, ssq + (size_t)grp * NG * 16, ws + WS_X8 + (size_t)grp * NG * 1024};
                pg8::gemm_phase(glds, g, S, E, F.wave);
                REPBAR(8); }
                SEAM();
            } ++ph;
        }
        if (ACTIVE()) { REPEAT(9) {
            PTRS();
            pg8::Gemm g{xb, (const bf16_t*)(lw + LW_WQ), 1024, 1024};
            pg8::SchedPlain S; S.init(NTOK, 512, 1024, 1024, 1024, F.G, F.blk);
            pg8::build_rtab(glds, S, ssq, nullptr, F.tid);
            pg8::EpiScaleBf16 E{(bf16_t*)(ar + AR_QX), 512, ssq, 0, nullptr, 0, 1 << 30, (const LAS float*)(glds + pg8::RTAB_OFF)};
            pg8::gemm_phase(glds, g, S, E, F.wave);
            REPBAR(9); }
                SEAM();
        } ++ph;
        if (ACTIVE()) { REPEAT(10) {
            PTRS();
            for (int w = F.blk; w < 256; w += F.G) xattn_wg(F, (const bf16_t*)(ws + WS_KVM) + (size_t)layer * 2048 * 1024, (const bf16_t*)(ar + AR_QX), (bf16_t*)(ar + AR_AO), w);
            REPBAR(10); }
                SEAM();
        } ++ph;
        if (ACTIVE()) {
            PTRS();
            pg8::Gemm g{(const bf16_t*)(ar + AR_AO), (const bf16_t*)(lw + LW_WO), 512, 512};
            pg8::SchedPlain S; S.init(NTOK, 1024, 512, 512, 512, F.G, F.blk);
            pg8::EpiResid E{xb, ssq, ws + WS_X8};
            pg8::gemm_phase(glds, g, S, E, F.wave);
            SEAM();
        } ++ph;
        if (layer == 0) {
            if (ACTIVE()) { REPEAT(11) {
                PTRS();
                pg8::Gemm g{xb, (const bf16_t*)(ws + WS_WGU), 1024, 1024};
                pg8::SchedPlain S; S.init(NTOK, 2 * FF, 1024, 1024, 1024, F.G, F.blk);
                pg8::build_rtab(glds, S, ssq, nullptr, F.tid);
                pg8::EpiSwiglu E{(bf16_t*)(ar + AR_HID), FF, (const LAS float*)(glds + pg8::RTAB_OFF)};
                pg8::gemm_phase(glds, g, S, E, F.wave);
                REPBAR(11); }
                SEAM();
            } ++ph;
            if (ACTIVE()) {
                PTRS();
                pg8::Gemm g{(const bf16_t*)(ar + AR_HID), (const bf16_t*)(ws + WS_WD), FF, FF};
                pg8::SchedPlain S; S.init(NTOK, 1024, FF, FF, FF, F.G, F.blk);
                pg8::EpiResid E{xb, ssq, ws + WS_X8};
                pg8::gemm_phase(glds, g, S, E, F.wave);
                SEAM();
            } ++ph;
        } else {
            if (ACTIVE()) { REPEAT(12) { MPTRS(); moe_route1(F, xb, (const float*)(ws + WS_WR), TE, TW, RR, CNT); REPBAR(12); } SEAM(); } ++ph;
            if (ACTIVE()) { REPEAT(13) { MPTRS(); moe_route2(F, TE, RR, CNT, xb, POS, XP, RP); REPBAR(13); } SEAM(); } ++ph;
            if (ACTIVE()) { REPEAT(14) {
                MPTRS();
                LAS int* MB = (LAS int*)(F.lds + 49152); moe_bases(F, CNT, 0, MB);
                pg8::SchedMoe S;
#pragma unroll
                for (int e = 0; e < 9; ++e) S.pbase[e] = __builtin_amdgcn_readfirstlane(MB[e]);
                S.nN = 2 * EFF / 256; S.nt = 16; S.G = F.G; S.c = F.blk; S.astep = (size_t)256 * 1024 * 2; S.bstep = (size_t)256 * 1024 * 2; S.estep = (size_t)2 * EFF * 1024 * 2;
                __syncthreads();
                pg8::Gemm g{XP, (const bf16_t*)(ws + WS_WMGU), 1024, 1024};
                pg8::build_rtab(glds, S, nullptr, RP, F.tid);
                pg8::EpiSwiglu E{HM, EFF, (const LAS float*)(glds + pg8::RTAB_OFF)};
                pg8::gemm_phase(glds, g, S, E, F.wave);
                REPBAR(14); }
                SEAM();
            } ++ph;
            if (ACTIVE()) { REPEAT(15) {
                MPTRS();
                LAS int* MB = (LAS int*)(F.lds + 49152); moe_bases(F, CNT, 0, MB);
                pg8::SchedMoe S;
#pragma unroll
                for (int e = 0; e < 9; ++e) S.pbase[e] = __builtin_amdgcn_readfirstlane(MB[e]);
                S.nN = 4; S.nt = EFF / 64; S.G = F.G; S.c = F.blk; S.astep = (size_t)256 * EFF * 2; S.bstep = (size_t)256 * EFF * 2; S.estep = (size_t)1024 * EFF * 2;
                __syncthreads();
                pg8::Gemm g{HM, (const bf16_t*)(ws + WS_WMD), EFF, EFF};
                pg8::EpiScaleBf16 E{XP, 1024, nullptr, 0, nullptr, 0, 1 << 30, nullptr};
                pg8::gemm_phase(glds, g, S, E, F.wave);
                REPBAR(15); }
                SEAM();
            } ++ph;
            if (ACTIVE()) { MPTRS(); moe_final(F, xb, xout, XP, POS, TW, sm + SM_FING); SEAM(); } ++ph;
        }
    }
#undef ACTIVE
#undef REPEAT
#undef REPBAR
#undef SEAM
#undef PTRS
#undef GPTRS
#undef MPTRS
}

#ifdef DBG_DUMP_OFF
__global__ void dbg_dump(float* out, const unsigned char* ws) {
    const bf16_t* src = (const bf16_t*)(ws + (size_t)DBG_DUMP_OFF);
    for (size_t i = (size_t)blockIdx.x * blockDim.x + threadIdx.x; i < (size_t)NTOK * 1024; i += (size_t)gridDim.x * blockDim.x) { float v = i < (size_t)DBG_DUMP_N ? bf2f(src[i]) : 0.f; if (!(v == v) || v > 1e30f || v < -1e30f) v = 12345.0f; out[i] = v; }
}
#endif
extern "C" void kernel_launch(void* const* d_in, const int* in_sizes, int n_in, void* d_out, int out_size, void* d_ws, size_t ws_size, hipStream_t stream) {
    static int grid = 0;
    if (grid == 0) {
        if (n_in != 27 || in_sizes[0] != NTOK * DM || out_size != NTOK * DM || ws_size < WS_END) {
            fprintf(stderr, "kernel_launch: unexpected problem (n_in %d, in0 %d, out %d, ws %zu < %zu); nothing launched\n", n_in, n_in > 0 ? in_sizes[0] : -1, out_size, ws_size, (size_t)WS_END); grid = -1; return; }
        int dev = 0, cus = 0;
        if (hipGetDevice(&dev) != hipSuccess || hipDeviceGetAttribute(&cus, hipDeviceAttributeMultiprocessorCount, dev) != hipSuccess) { grid = -1; return; }
        if (hipFuncSetAttribute((const void*)mk_fwd, hipFuncAttributeMaxDynamicSharedMemorySize, LDS_BYTES) != hipSuccess) { fprintf(stderr, "kernel_launch: hipFuncSetAttribute failed\n"); grid = -1; return; }
        int per_cu = 0;
        if (hipOccupancyMaxActiveBlocksPerMultiprocessor(&per_cu, (const void*)mk_fwd, 512, LDS_BYTES) != hipSuccess || per_cu < 1) { fprintf(stderr, "kernel_launch: occupancy query says %d\n", per_cu); }
        (void)hipGetLastError();
        grid = cus > 256 ? 256 : cus;
    }
    if (grid < 0) return;
    (void)hipMemsetAsync((char*)d_ws + WS_CTL, 0, CTL_BYTES, stream);
    Params p{};
    for (int i = 0; i < 27; ++i) p.in[i] = (const float*)d_in[i];
    p.out = (float*)d_out; p.ws = (unsigned char*)d_ws; p.pad0 = 0; p.pad1 = 0;
#if MK_SINGLE
    p.ph_lo = 0; p.ph_hi = NPH;
    hipLaunchKernelGGL(mk_fwd, dim3(grid), dim3(512), LDS_BYTES, stream, p);
#else
#ifndef DBG_NPH
#define DBG_NPH NPH
#endif
    for (int k = 0; k < DBG_NPH; ++k) { p.ph_lo = k; p.ph_hi = k + 1; hipLaunchKernelGGL(mk_fwd, dim3(grid), dim3(512), LDS_BYTES, stream, p); }
#ifdef DBG_DUMP_OFF
    hipLaunchKernelGGL(dbg_dump, dim3(2048), dim3(256), 0, stream, (float*)d_out, (const unsigned char*)d_ws);
#endif
#endif
}
```

```cpp
#include <hip/hip_runtime.h>
#include <cstdio>
#include <cstdint>

#define LAS __attribute__((address_space(3)))
#define DI __device__ __forceinline__
typedef unsigned short bf16_t;
typedef short bf16x8 __attribute__((ext_vector_type(8)));
typedef short s16x4 __attribute__((ext_vector_type(4)));
typedef float f32x4 __attribute__((ext_vector_type(4)));
typedef float f32x2 __attribute__((ext_vector_type(2)));
typedef unsigned u32x4 __attribute__((ext_vector_type(4)));
typedef unsigned u32x2 __attribute__((ext_vector_type(2)));

#ifndef MK_SINGLE
#define MK_SINGLE 1
#endif

constexpr int NTOK = 65536, DM = 1024, SEQ = 8192, NBATCH = 8;
constexpr int NGRP = 2, NG = NTOK / NGRP, GB = NBATCH / NGRP;
constexpr int PLD = 3072;
constexpr int PC_POOL = 0, PC_MQ = 256, PC_MK = 512, PC_MV = 768, PC_DQ = 1024, PC_DK = 1536, PC_DV = 2048, PC_Z = 2560;
constexpr int IN_COLS = 6160;
constexpr int FF = 2816, EFF = 1408, NEXP = 8;
constexpr int MEMLEN = 256;
constexpr float RMS_EPS = 1e-6f;
constexpr int NPH = 1 + 2 * (NGRP * 7 + 3) + 2 + 5;

constexpr size_t MiB = 1u << 20;
constexpr size_t WS_CTL = 0, CTL_BYTES = 1 * MiB;
constexpr size_t LW_WIN = 0, LW_WCAT = LW_WIN + (size_t)6144 * 1024 * 2, LW_WOUT = LW_WCAT + (size_t)1024 * 1024 * 2, LW_WQ = LW_WOUT + (size_t)1024 * 1024 * 2,
                 LW_WKV = LW_WQ + (size_t)512 * 1024 * 2, LW_WO = LW_WKV + (size_t)1024 * 1024 * 2, LW_WBA = LW_WO + (size_t)1024 * 512 * 2, LW_STRIDE = LW_WBA + (size_t)16 * 1024 * 2;
constexpr size_t WS_LW = WS_CTL + CTL_BYTES;
constexpr size_t WS_WGU = WS_LW + 2 * LW_STRIDE;
constexpr size_t WS_WD = WS_WGU + (size_t)2 * FF * 1024 * 2;
constexpr size_t WS_WMGU = WS_WD + (size_t)1024 * FF * 2;
constexpr size_t WS_WMD = WS_WMGU + (size_t)NEXP * 2 * EFF * 1024 * 2;
constexpr size_t WS_WR = WS_WMD + (size_t)NEXP * 1024 * EFF * 2;
constexpr size_t WS_XB = (WS_WR + 8 * 1024 * 4 + MiB - 1) / MiB * MiB;
constexpr size_t WS_SSQ = WS_XB + (size_t)NTOK * 1024 * 2;
constexpr size_t WS_ROPE = WS_SSQ + (size_t)NTOK * 16 * 4;
constexpr size_t WS_MEMN = WS_ROPE + (size_t)NTOK * 16 * 4;
constexpr size_t WS_KVM = WS_MEMN + (size_t)2 * 2048 * 1024 * 2;
constexpr size_t WS_SMALL = WS_KVM + (size_t)2 * 2048 * 1024 * 2;
constexpr int SM_CONVW = 0, SM_ALOG = SM_CONVW + 2 * 4 * 1536, SM_DTB = SM_ALOG + 16, SM_DNG = SM_DTB + 16, SM_FING = SM_DNG + 128, SM_END = SM_FING + 1024;
constexpr size_t WS_X8 = WS_SMALL + 65536;
constexpr size_t WS_WG8 = WS_X8 + (size_t)NTOK * 1024;
constexpr size_t WS_ARENA = WS_WG8 + (size_t)2 * 3072 * 1024;
constexpr size_t AR_P = 0;
constexpr size_t AR_BA = AR_P + (size_t)NG * PLD * 2;
constexpr size_t AR_BR = AR_BA + (size_t)NG * 16 * 4;
constexpr size_t AR_KBAR = AR_BR + (size_t)NG * 1024 * 2;
constexpr size_t AR_VT = AR_KBAR + (size_t)GB * 4 * 32 * 64 * 4;
constexpr int NCH = GB * 128 * 8;
constexpr size_t AR_QD = AR_VT + (size_t)GB * 4 * 64 * SEQ * 2;
constexpr size_t AR_KDT = AR_QD + (size_t)NCH * 8192;
constexpr size_t AR_WN = AR_KDT + (size_t)NCH * 8192;
constexpr size_t AR_UT = AR_WN + (size_t)NCH * 8192;
constexpr size_t AR_AQK = AR_UT + (size_t)NCH * 8192;
constexpr size_t AR_NT = AR_AQK + (size_t)NCH * 8192;
constexpr size_t AR_SG = AR_NT + (size_t)NCH * 8192;
constexpr size_t AR_ZB = AR_SG + (size_t)NCH * 8192;
constexpr size_t AR_GL = AR_ZB + (size_t)NG * 512 * 2;
constexpr size_t AR_SELG = AR_GL + (size_t)NCH * 4 + 65536 - ((size_t)NCH * 4) % 65536;
constexpr size_t AR_CNTG = AR_SELG + (size_t)NG * 4 * 4;
constexpr size_t AR_LISTG = AR_CNTG + (size_t)GB * 4 * 32 * 32 * 4;
constexpr size_t AR_OPG = AR_LISTG + (size_t)GB * 4 * 32 * 32 * 256;
constexpr size_t AR_MLG = AR_OPG + (size_t)NG * 4 * 4 * 64 * 2;
constexpr size_t AR_MERGED = AR_MLG + (size_t)NG * 4 * 4 * 2 * 4;
constexpr size_t AR_MIX_END = AR_MERGED + (size_t)NG * 1024 * 2;
constexpr size_t AR_QX = 0, AR_AO = AR_QX + (size_t)NTOK * 512 * 2, AR_XA_END = AR_AO + (size_t)NTOK * 512 * 2;
constexpr size_t AR_HID = 0, AR_HID_END = (size_t)NTOK * FF * 2;
constexpr int MOE_ROWS = 2 * NTOK + 2048;
constexpr size_t AR_TE = 0, AR_TW = AR_TE + (size_t)NTOK * 8, AR_RR = AR_TW + (size_t)NTOK * 8, AR_POS = AR_RR + (size_t)NTOK * 4, AR_CNT = AR_POS + (size_t)NTOK * 8,
                 AR_XP = AR_CNT + 65536, AR_RP = AR_XP + (size_t)MOE_ROWS * 1024 * 2, AR_HM = AR_RP + (size_t)MOE_ROWS * 4 + 65536 - ((size_t)MOE_ROWS * 4) % 65536,
                 AR_MOE_END = AR_HM + (size_t)MOE_ROWS * EFF * 2;
constexpr size_t cmax(size_t a, size_t b) { return a > b ? a : b; }
constexpr size_t WS_END = WS_ARENA + cmax(cmax(AR_MIX_END, AR_XA_END), cmax(AR_HID_END, AR_MOE_END));
static_assert(AR_XA_END <= AR_MERGED, "xattn buffers must not overlap MERGED");
static_assert(SM_END * 4 <= 65536, "small-vector block");
static_assert(WS_END <= (size_t)1073741824, "workspace map exceeds 1 GiB");

constexpr int LDS_BYTES = 160 * 1024;
constexpr int LDS_MISC = 158 * 1024;

DI float bf2f(unsigned short b) { return __uint_as_float(((unsigned)b) << 16); }
DI unsigned f2bf(float f) { unsigned u = __float_as_uint(f); return (u + 0x7fffu + ((u >> 16) & 1u)) >> 16; }
DI unsigned pk2(float lo, float hi) { return f2bf(lo) | (f2bf(hi) << 16); }
typedef __bf16 bf16v2_t __attribute__((ext_vector_type(2)));
DI unsigned cvt_pk_bf16(float lo, float hi) { bf16v2_t v; v.x = (__bf16)lo; v.y = (__bf16)hi; return __builtin_bit_cast(unsigned, v); }
DI unsigned cvt4_fp8(float a, float b, float c, float d) { unsigned w = 0u; w = __builtin_amdgcn_cvt_pk_fp8_f32(a, b, w, false); w = __builtin_amdgcn_cvt_pk_fp8_f32(c, d, w, true); return w; }
DI float wave_sum(float v) {
#pragma unroll
    for (int o = 1; o < 64; o <<= 1) v += __shfl_xor(v, o);
    return v;
}
DI float fsigmoid(float x) { return __builtin_amdgcn_rcpf(1.0f + __builtin_amdgcn_exp2f(-1.44269504089f * x)); }
DI float row_rstd(const float* ssqp, int row) {
    const f32x4* p = (const f32x4*)(ssqp + (size_t)row * 16);
    const f32x4 a = p[0], b = p[1], c = p[2], d = p[3];
    const float s = (((a.x + a.y) + (a.z + a.w)) + ((b.x + b.y) + (b.z + b.w))) + (((c.x + c.y) + (c.z + c.w)) + ((d.x + d.y) + (d.z + d.w)));
    return rsqrtf(s * (1.0f / 1024.0f) + RMS_EPS);
}
#define LAUNDER_V(x) asm volatile("" : "+v"(x))
#define LDS_WAIT() asm volatile("s_waitcnt lgkmcnt(0)" ::: "memory")
#define VM_WAIT() asm volatile("s_waitcnt vmcnt(0)" ::: "memory")
#define WG_BAR() do { asm volatile("s_waitcnt lgkmcnt(0)" ::: "memory"); __builtin_amdgcn_s_barrier(); asm volatile("" ::: "memory"); } while (0)
#define MFMA16(a, b, c) __builtin_amdgcn_mfma_f32_16x16x32_bf16((a), (b), (c), 0, 0, 0)

#define XB_TMO      128
#define XB_XCNT(j)  (256  + 64 * (j))
#define XB_XSUB(j)  (1280 + 64 * (j))
#define XB_XGEN(j)  (2304 + 64 * (j))
#define XB_TOP      3328
#define XB_TOPGEN   3392
#define XCD_BAR_WORDS 3456
#define XB_SPIN_CAP (1u << 22)

DI unsigned xb_ld(unsigned* p)              { return __hip_atomic_load(p, __ATOMIC_RELAXED, __HIP_MEMORY_SCOPE_AGENT); }
DI unsigned xb_add(unsigned* p, unsigned v) { return __hip_atomic_fetch_add(p, v, __ATOMIC_RELAXED, __HIP_MEMORY_SCOPE_AGENT); }
DI unsigned xb_xcc_id() { return (unsigned)__builtin_amdgcn_s_getreg((3 << 11) | 20) & 0xFu; }
#define XB_SPIN(cond, bar) do { unsigned _sp = 0; while (cond) { __builtin_amdgcn_s_sleep(1); \
    if ((++_sp & 255u) == 0u) { if (xb_ld(&(bar)[XB_TMO])) break; if (_sp > XB_SPIN_CAP) { atomicAdd(&(bar)[XB_TMO], 1u); break; } } } } while (0)

struct XcdBarrier { unsigned* bar; unsigned x; volatile LAS unsigned* st; };

DI XcdBarrier xcd_barrier_post(unsigned* bar, volatile LAS unsigned* st) {
    XcdBarrier b; b.bar = bar; b.x = xb_xcc_id(); b.st = st;
    if (threadIdx.x == 0) (void)xb_add(&bar[XB_XCNT(b.x)], 1u);
    return b;
}
DI void xcd_barrier_complete(unsigned* bar, unsigned x, unsigned& nloc, unsigned& nx) {
    const unsigned G = gridDim.x * gridDim.y * gridDim.z;
    unsigned sum, cnt, mine, sp = 0u;
    for (;;) {
        sum = 0u; cnt = 0u; mine = 0u;
#pragma unroll
        for (unsigned j = 0; j < 16; ++j) { const unsigned c = xb_ld(&bar[XB_XCNT(j)]); sum += c; cnt += (c > 0u) ? 1u : 0u; mine = (j == x) ? c : mine; }
        if (sum == G) break;
        __builtin_amdgcn_s_sleep(1);
        if ((++sp & 255u) == 0u) { if (xb_ld(&bar[XB_TMO])) break; if (sp > XB_SPIN_CAP) { atomicAdd(&bar[XB_TMO], 1u); break; } }
    }
    nloc = mine > 0u ? mine : 1u; nx = cnt > 0u ? cnt : 1u;
}
DI void xcd_barrier(const XcdBarrier& b) {
    asm volatile("s_waitcnt vmcnt(0)" ::: "memory");
    __syncthreads();
    if (threadIdx.x == 0) {
        unsigned* bar = b.bar;
        __builtin_amdgcn_s_waitcnt(0);
        unsigned nloc = b.st[0], nx = b.st[1];
        if (nloc == 0u) { xcd_barrier_complete(bar, b.x, nloc, nx); b.st[0] = nloc; b.st[1] = nx; }
        const unsigned old = xb_add(&bar[XB_XSUB(b.x)], 1u);
        const unsigned gen = old / nloc;
        if (old + 1u == (gen + 1u) * nloc) {
            __builtin_amdgcn_fence(__ATOMIC_RELEASE, "agent");
            asm volatile("s_waitcnt vmcnt(0)" ::: "memory");
            const unsigned og = xb_add(&bar[XB_TOP], 1u);
            const unsigned tg = og / nx;
            if (og + 1u == (tg + 1u) * nx) xb_add(&bar[XB_TOPGEN], 1u);
            else XB_SPIN(xb_ld(&bar[XB_TOPGEN]) == tg, bar);
            __builtin_amdgcn_fence(__ATOMIC_ACQUIRE, "agent");
            xb_add(&bar[XB_XGEN(b.x)], 1u);
            asm volatile("s_waitcnt vmcnt(0)" ::: "memory");
        } else {
            XB_SPIN(xb_ld(&bar[XB_XGEN(b.x)]) == gen, bar);
            __builtin_amdgcn_fence(__ATOMIC_ACQUIRE, "agent");
            asm volatile("s_waitcnt vmcnt(0)" ::: "memory");
        }
    }
    __syncthreads();
}
namespace pg8 {
constexpr int BM = 256, BK = 64, HALF = 128, HTB = HALF * BK * 2, STAGE_BYTES = 8 * HTB, NXCD = 8, WGM = 8;
__host__ __device__ __forceinline__ int lds_byte(int r, int c) { const int st = (r >> 4) * 2 + (c >> 5), rr = r & 15, cc = c & 31, ob = rr * 64 + cc * 2; return st * 1024 + (ob ^ (((ob >> 9) & 1) << 5)); }
__host__ __device__ __forceinline__ void stage_rc(int b, int& R, int& C) { const int st = b / 1024, sb = b % 1024, swz = sb ^ (((sb >> 9) & 1) << 5); R = (st >> 1) * 16 + swz / 64; C = (st & 1) * 32 + (swz % 64) / 2; }
__host__ __device__ __forceinline__ int perm32(int rho) { const int n = rho >> 4, i = rho & 15; return 8 * (i >> 2) + 4 * n + (i & 3); }

struct Unit { int pm, pn, nt, tag, ord; size_t aoff, boff; };
struct Gemm { const bf16_t* A; const bf16_t* Bt; int lda, ldb; };

struct TileOrder {
    int nM, nN, nwg, G, c;
    DI void init(int nM_, int nN_, int G_, int c_) { nM = nM_; nN = nN_; nwg = nM * nN; G = G_; c = c_; }
    DI bool tile(int i, int& pm, int& pn) const {
        const long L = (long)i * G + c; if (L >= nwg) return false;
        int wgid = (int)L; { const int q = nwg / NXCD, r = nwg % NXCD, xcd = wgid % NXCD, off = wgid / NXCD; wgid = (xcd < r ? xcd * (q + 1) : r * (q + 1) + (xcd - r) * q) + off; }
        const int nig = WGM * nN, gid = wgid / nig, fm = gid * WGM, gsz = (nM - fm) < WGM ? (nM - fm) : WGM;
        pm = fm + ((wgid % nig) % gsz); pn = (wgid % nig) / gsz; return true;
    }
};
struct SchedPlain {
    TileOrder T; int nt; size_t astep, bstep;
    DI void init(int M, int N, int K, int lda, int ldb, int G, int c, int esz = 2) { T.init(M / BM, N / BM, G, c); nt = K * esz / (BK * 2); astep = (size_t)BM * lda * esz; bstep = (size_t)BM * ldb * esz; }
    DI bool next(int i, Unit& u) const { if (!T.tile(i, u.pm, u.pn)) return false; u.nt = nt; u.tag = 0; u.ord = i; u.aoff = (size_t)u.pm * astep; u.boff = (size_t)u.pn * bstep; return true; }
};
struct SchedMerge {
    TileOrder T; size_t astep, bstep;
    DI void init(int M, int N, int lda, int ldb, int G, int c) { T.init(M / BM, N / BM, G, c); astep = (size_t)BM * lda * 2; bstep = (size_t)BM * ldb * 2; }
    DI bool next(int i, Unit& u) const {
        const int ti = i / 3, br = i - 3 * ti; if (!T.tile(ti, u.pm, u.pn)) return false;
        const int kofs = br == 0 ? 0 : (br == 1 ? 256 : 512);
        u.nt = br == 2 ? 8 : 4; u.tag = br; u.aoff = (size_t)u.pm * astep + (size_t)kofs * 2; u.boff = (size_t)u.pn * bstep + (size_t)kofs * 2; return true;
    }
};
struct SchedKV {
    int c; size_t lstride;
    DI bool next(int i, Unit& u) const {
        if (i != 0 || c < 0 || c >= 64) return false;
        const int layer = c >> 5, r = c & 31; u.pm = layer * 8 + (r >> 2); u.pn = r & 3; u.nt = 16; u.tag = 0; u.ord = 0;
        u.aoff = (size_t)u.pm * BM * 1024 * 2; u.boff = (size_t)layer * lstride + (size_t)u.pn * BM * 1024 * 2; return true;
    }
};
struct SchedMoe {
    int pbase[9]; int nN, nt, G, c; size_t astep, bstep, estep;
    DI bool next(int i, Unit& u) const {
        const long L = (long)i * G + c; const int tot = pbase[8] * nN; if (L >= tot) return false;
        const int gp = (int)(L / nN), pn = (int)(L - (long)gp * nN);
        int e = 0;
#pragma unroll
        for (int j = 1; j < 8; ++j) e += (gp >= pbase[j]) ? 1 : 0;
        u.pm = gp; u.pn = pn; u.nt = nt; u.tag = e; u.ord = i; u.aoff = (size_t)gp * astep; u.boff = (size_t)e * estep + (size_t)pn * bstep; return true;
    }
};

constexpr int RTAB_OFF = STAGE_BYTES, RTAB_MAX_UNITS = 26;
template <class Sched> DI void build_rtab(LAS unsigned char* lds, const Sched& S, const float* ssqp, const float* rvec, int tid) {
    LAS float* rt = (LAS float*)(lds + RTAB_OFF); Unit u;
    for (int i = tid >> 8; S.next(i, u); i += 2) { if (i >= RTAB_MAX_UNITS) break; const int r = tid & 255, row = u.pm * BM + r; rt[i * 256 + r] = rvec ? rvec[row] : row_rstd(ssqp, row); }
    __syncthreads();
}
struct EpiScaleBf16 { static constexpr bool MID = false;
    bf16_t* O; int ldo; const float* ssqp; int act; bf16_t* O2; int ldo2, pn2; const LAS float* rtab;
    DI void operator()(const f32x4 (&acc)[2][2][4][2], const Unit& u, int wr, int wc, int fr, int fq) const {
        const bool alt = u.pn >= pn2; bf16_t* const Ob = alt ? O2 : O; const int ld = alt ? ldo2 : ldo;
        const int row0 = u.pm * BM + wr * 64 + fr, col0 = (alt ? u.pn - pn2 : u.pn) * BM + wc * 32 + 8 * fq;
#pragma unroll
        for (int ai = 0; ai < 2; ++ai)
#pragma unroll
            for (int m = 0; m < 4; ++m) { const int row = row0 + ai * HALF + m * 16; const float r = ssqp ? rtab[u.ord * 256 + (row & 255)] : 1.0f; bf16_t* rowp = Ob + (size_t)row * ld + col0;
#pragma unroll
                for (int bj = 0; bj < 2; ++bj) { f32x4 v0 = acc[ai][bj][m][0] * r, v1 = acc[ai][bj][m][1] * r;
                    if (act) {
#pragma unroll
                        for (int j = 0; j < 4; ++j) { v0[j] = fsigmoid(v0[j]); v1[j] = fsigmoid(v1[j]); } }
                    u32x4 w; w.x = cvt_pk_bf16(v0[0], v0[1]); w.y = cvt_pk_bf16(v0[2], v0[3]); w.z = cvt_pk_bf16(v1[0], v1[1]); w.w = cvt_pk_bf16(v1[2], v1[3]);
                    *(u32x4*)(rowp + bj * HALF) = w; } }
    }
};
struct EpiResid { static constexpr bool MID = false;
    bf16_t* xb; float* ssqp; unsigned char* x8;
    DI void operator()(const f32x4 (&acc)[2][2][4][2], const Unit& u, int wr, int wc, int fr, int fq) const {
        const int row0 = u.pm * BM + wr * 64 + fr, col0 = u.pn * BM + wc * 32 + 8 * fq;
#pragma unroll
        for (int ai = 0; ai < 2; ++ai)
#pragma unroll
            for (int m = 0; m < 4; ++m) { const int row = row0 + ai * HALF + m * 16; const size_t off = (size_t)row * 1024 + col0; float ss = 0.f;
#pragma unroll
                for (int bj = 0; bj < 2; ++bj) {
                    const u32x4 xo = *(const u32x4*)(xb + off + bj * HALF);
                    f32x4 x0 = (f32x4){__uint_as_float(xo.x << 16), __uint_as_float(xo.x & 0xffff0000u), __uint_as_float(xo.y << 16), __uint_as_float(xo.y & 0xffff0000u)};
                    f32x4 x1 = (f32x4){__uint_as_float(xo.z << 16), __uint_as_float(xo.z & 0xffff0000u), __uint_as_float(xo.w << 16), __uint_as_float(xo.w & 0xffff0000u)};
                    x0 += acc[ai][bj][m][0]; x1 += acc[ai][bj][m][1];
                    u32x4 w; w.x = cvt_pk_bf16(x0[0], x0[1]); w.y = cvt_pk_bf16(x0[2], x0[3]); w.z = cvt_pk_bf16(x1[0], x1[1]); w.w = cvt_pk_bf16(x1[2], x1[3]);
                    *(u32x4*)(xb + off + bj * HALF) = w;
                    { u32x2 w8; w8.x = cvt4_fp8(x0[0], x0[1], x0[2], x0[3]); w8.y = cvt4_fp8(x1[0], x1[1], x1[2], x1[3]); *(u32x2*)(x8 + off + bj * HALF) = w8; }
                    ss += (x0[0] * x0[0] + x0[1] * x0[1]) + (x0[2] * x0[2] + x0[3] * x0[3]) + (x1[0] * x1[0] + x1[1] * x1[1]) + (x1[2] * x1[2] + x1[3] * x1[3]); }
                ss += __shfl_xor(ss, 16); ss += __shfl_xor(ss, 32);
                if (fq == 0) ssqp[(size_t)row * 16 + u.pn * 4 + wc] = ss; }
    }
};
struct EpiSwiglu { static constexpr bool MID = false;
    bf16_t* H; int ldh; const LAS float* rtab;
    DI void operator()(const f32x4 (&acc)[2][2][4][2], const Unit& u, int wr, int wc, int fr, int fq) const {
        const int row0 = u.pm * BM + wr * 64 + fr, col0 = u.pn * HALF + wc * 32 + 8 * fq;
#pragma unroll
        for (int ai = 0; ai < 2; ++ai)
#pragma unroll
            for (int m = 0; m < 4; ++m) { const int row = row0 + ai * HALF + m * 16; const float r = rtab[u.ord * 256 + (row & 255)];
                f32x4 h0, h1;
#pragma unroll
                for (int j = 0; j < 4; ++j) { const float g0 = acc[ai][0][m][0][j] * r, g1 = acc[ai][0][m][1][j] * r;
                    h0[j] = g0 * fsigmoid(g0) * (acc[ai][1][m][0][j] * r); h1[j] = g1 * fsigmoid(g1) * (acc[ai][1][m][1][j] * r); }
                u32x4 w; w.x = cvt_pk_bf16(h0[0], h0[1]); w.y = cvt_pk_bf16(h0[2], h0[3]); w.z = cvt_pk_bf16(h1[0], h1[1]); w.w = cvt_pk_bf16(h1[2], h1[3]);
                *(u32x4*)(H + (size_t)row * ldh + col0) = w; }
    }
};
struct EpiMerge { static constexpr bool MID = true;
    const bf16_t* gates; bf16_t* merged;
    static DI float gclamp(unsigned hi_bits) { return fmaxf(__uint_as_float(hi_bits), 1e-30f); }
    DI void mid(f32x4 (&acc)[2][2][4][2], const Unit& u, int seg, int wr, int wc, int fr, int fq) const {
        int row0 = u.pm * BM + wr * 64 + fr, col0 = u.pn * BM + wc * 32 + 8 * fq; LAUNDER_V(row0); LAUNDER_V(col0);
#pragma unroll
        for (int ai = 0; ai < 2; ++ai)
#pragma unroll
            for (int mp = 0; mp < 2; ++mp) {
                u32x4 ga[2][2], gb[2][2];
#pragma unroll
                for (int mm = 0; mm < 2; ++mm)
#pragma unroll
                    for (int bj = 0; bj < 2; ++bj) { const bf16_t* gp = gates + (size_t)(row0 + ai * HALF + (2 * mp + mm) * 16) * PLD + seg * 1024 + col0 + bj * HALF; ga[mm][bj] = *(const u32x4*)gp; gb[mm][bj] = *(const u32x4*)(gp + 1024); }
                __builtin_amdgcn_sched_barrier(0);
#pragma unroll
                for (int mm = 0; mm < 2; ++mm)
#pragma unroll
                    for (int bj = 0; bj < 2; ++bj) {
#pragma unroll
                        for (int j = 0; j < 4; ++j) { const int m = 2 * mp + mm;
                            const float r_lo = gclamp(ga[mm][bj][j] << 16) * __builtin_amdgcn_rcpf(gclamp(gb[mm][bj][j] << 16)), r_hi = gclamp(ga[mm][bj][j] & 0xffff0000u) * __builtin_amdgcn_rcpf(gclamp(gb[mm][bj][j] & 0xffff0000u));
                            acc[ai][bj][m][j >> 1][(2 * j) & 3] *= r_lo; acc[ai][bj][m][j >> 1][(2 * j + 1) & 3] *= r_hi; }
                        __builtin_amdgcn_sched_barrier(0); }
            }
    }
    DI void operator()(const f32x4 (&acc)[2][2][4][2], const Unit& u, int wr, int wc, int fr, int fq) const {
        const int row0 = u.pm * BM + wr * 64 + fr, col0 = u.pn * BM + wc * 32 + 8 * fq;
#pragma unroll
        for (int ai = 0; ai < 2; ++ai)
#pragma unroll
            for (int m = 0; m < 4; ++m) { const int row = row0 + ai * HALF + m * 16;
#pragma unroll
                for (int bj = 0; bj < 2; ++bj) {
                    const u32x4 gv = *(const u32x4*)(gates + (size_t)row * PLD + 2 * 1024 + col0 + bj * HALF);
                    float v[8];
#pragma unroll
                    for (int j = 0; j < 4; ++j) { v[2 * j] = gclamp(gv[j] << 16); v[2 * j + 1] = gclamp(gv[j] & 0xffff0000u); }
#pragma unroll
                    for (int j = 0; j < 4; ++j) { v[j] *= acc[ai][bj][m][0][j]; v[4 + j] *= acc[ai][bj][m][1][j]; }
                    u32x4 w; w.x = cvt_pk_bf16(v[0], v[1]); w.y = cvt_pk_bf16(v[2], v[3]); w.z = cvt_pk_bf16(v[4], v[5]); w.w = cvt_pk_bf16(v[6], v[7]);
                    *(u32x4*)(merged + (size_t)row * 1024 + col0 + bj * HALF) = w; } }
    }
};

template <class Epi, class Sched, bool F8 = false>
DI void gemm_phase(LAS unsigned char* lds, const Gemm g, const Sched& S, const Epi& E, int wave_id) {
    int tid_ = (int)__builtin_amdgcn_mbcnt_hi(~0u, __builtin_amdgcn_mbcnt_lo(~0u, 0u)) + 64 * wave_id; asm volatile("" : "+v"(tid_));
    const int tid = tid_, wid = __builtin_amdgcn_readfirstlane(tid >> 6), lane = tid & 63, wr = wid >> 2, wc = wid & 3, fr = lane & 15, fq = lane >> 4;
    unsigned voffA[2], voffB[2];
#pragma unroll
    for (int i = 0; i < 2; ++i) { int R, C; stage_rc(tid * 16 + i * 8192, R, C); const int Rb = (R & ~31) + perm32(R & 31);
        voffA[i] = F8 ? (unsigned)(R * g.lda + 2 * C) : (unsigned)(R * g.lda + C) * 2u; voffB[i] = F8 ? (unsigned)(Rb * g.ldb + 2 * C) : (unsigned)(Rb * g.ldb + C) * 2u; }
    const size_t kstep = (size_t)(BK * 2);
    const size_t hstepA = (size_t)HALF * g.lda * (F8 ? 1 : 2), hstepB = (size_t)HALF * g.ldb * (F8 ? 1 : 2);
    const unsigned ldsw = (unsigned)wid * 1024u;
    const int aoff = lds_byte(wr * 64 + fr, fq * 8), boff = lds_byte(wc * 32 + fr, fq * 8);
#define PG8_SA(b, h) (((b) * 2 + (h)) * HTB)
#define PG8_SB(b, h) ((4 + (b) * 2 + (h)) * HTB)
#define PG8_STAGE(bufoff, gbase, voff) do { _Pragma("unroll") for (int _i = 0; _i < 2; ++_i) \
        __builtin_amdgcn_global_load_lds((const unsigned*)((const char*)(gbase) + (voff)[_i]), (LAS unsigned*)(lds + (bufoff) + ldsw + _i * 8192), 16, 0, 0); } while (0)
#define PG8_LDA(dst, b, h) do { _Pragma("unroll") for (int m = 0; m < 4; ++m) { const v4i_t l0_ = *(const LAS v4i_t*)(lds + PG8_SA(b, h) + aoff + m * 2048), l1_ = *(const LAS v4i_t*)(lds + PG8_SA(b, h) + aoff + m * 2048 + 1024); \
        dst[m] = __builtin_shufflevector(l0_, l1_, 0, 1, 2, 3, 4, 5, 6, 7); } } while (0)
#define PG8_LDB(dst, b, h) do { _Pragma("unroll") for (int n = 0; n < 2; ++n) { const v4i_t l0_ = *(const LAS v4i_t*)(lds + PG8_SB(b, h) + boff + n * 2048), l1_ = *(const LAS v4i_t*)(lds + PG8_SB(b, h) + boff + n * 2048 + 1024); \
        dst[n] = __builtin_shufflevector(l0_, l1_, 0, 1, 2, 3, 4, 5, 6, 7); } } while (0)
#define PG8_MMA(ai, bj, At, Bt) do { __builtin_amdgcn_s_setprio(1); _Pragma("unroll") for (int m = 0; m < 4; ++m) _Pragma("unroll") for (int n = 0; n < 2; ++n) { \
        if constexpr (F8) asm volatile("v_mfma_scale_f32_16x16x128_f8f6f4 %0, %1, %2, %0, %3, %4 op_sel_hi:[0,0,0]" : "+v"(acc[ai][bj][m][n]) : "v"(Bt[n]), "v"(At[m]), "v"(f8scale_w), "v"(f8scale_x));   \
        else { const bf16x8 b0_ = __builtin_bit_cast(bf16x8, __builtin_shufflevector(Bt[n], Bt[n], 0, 1, 2, 3)), b1_ = __builtin_bit_cast(bf16x8, __builtin_shufflevector(Bt[n], Bt[n], 4, 5, 6, 7)), \
                            a0_ = __builtin_bit_cast(bf16x8, __builtin_shufflevector(At[m], At[m], 0, 1, 2, 3)), a1_ = __builtin_bit_cast(bf16x8, __builtin_shufflevector(At[m], At[m], 4, 5, 6, 7)); \
            acc[ai][bj][m][n] = __builtin_amdgcn_mfma_f32_16x16x32_bf16(b0_, a0_, acc[ai][bj][m][n], 0, 0, 0); acc[ai][bj][m][n] = __builtin_amdgcn_mfma_f32_16x16x32_bf16(b1_, a1_, acc[ai][bj][m][n], 0, 0, 0); } } \
        __builtin_amdgcn_s_setprio(0); } while (0)
#define PG8_WAIT_V(n) asm volatile("s_waitcnt vmcnt(" #n ")" ::: "memory")
#define PG8_WAIT_L(n) asm volatile("s_waitcnt lgkmcnt(" #n ")" ::: "memory")
#define PG8_BAR __builtin_amdgcn_s_barrier()
#define PG8_SCHED __builtin_amdgcn_sched_barrier(0)
    Unit cur, nxt; int ui = 0;
    if (!S.next(0, cur)) return;
    f32x4 acc[2][2][4][2];
#pragma unroll
    for (int a = 0; a < 2; ++a)
#pragma unroll
        for (int b = 0; b < 2; ++b)
#pragma unroll
            for (int m = 0; m < 4; ++m)
#pragma unroll
                for (int n = 0; n < 2; ++n) acc[a][b][m][n] = (f32x4){0.f, 0.f, 0.f, 0.f};
    typedef int v8i_t __attribute__((ext_vector_type(8))); typedef int v4i_t __attribute__((ext_vector_type(4)));
    const int f8scale_w = 0x7a7a7a7a, f8scale_x = 0x7f7f7f7f;
    v8i_t At[4], B0[2], B1[2];
    const char* cA = (const char*)g.A + cur.aoff; const char* cB = (const char*)g.Bt + cur.boff;
    PG8_STAGE(PG8_SB(0, 0), cB, voffB); PG8_STAGE(PG8_SB(0, 1), cB + hstepB, voffB); PG8_STAGE(PG8_SA(0, 0), cA, voffA); PG8_STAGE(PG8_SA(0, 1), cA + hstepA, voffA);
    if (wr == 1) PG8_BAR;
    PG8_WAIT_V(2); PG8_BAR;
    PG8_STAGE(PG8_SB(1, 0), cB + kstep, voffB); PG8_STAGE(PG8_SA(1, 0), cA + kstep, voffA); PG8_STAGE(PG8_SB(1, 1), cB + hstepB + kstep, voffB);
    PG8_WAIT_V(6); PG8_BAR;
    for (;;) {
        const bool has_next = S.next(ui + 1, nxt);
        const int nt = cur.nt;
        const char* nA = has_next ? (const char*)g.A + nxt.aoff : cA; const char* nB = has_next ? (const char*)g.Bt + nxt.boff : cB;
        for (int t = 0; t < nt; t += 2) {
            if constexpr (Epi::MID) { if (t == 4 || t == 8) { E.mid(acc, cur, t >> 3, wr, wc, fr, fq); } __builtin_amdgcn_sched_barrier(0); }
            const bool last = (t == nt - 2);
            const char* a1 = cA + (size_t)(t + 1) * kstep;
            const char* a2 = last ? nA : cA + (size_t)(t + 2) * kstep; const char* b2 = last ? nB : cB + (size_t)(t + 2) * kstep;
            const char* a3 = a2 + kstep; const char* b3 = b2 + kstep;
            PG8_LDB(B0, 0, 0); PG8_LDB(B1, 0, 1); PG8_SCHED; PG8_LDA(At, 0, 0); PG8_STAGE(PG8_SA(1, 1), a1 + hstepA, voffA);
            PG8_WAIT_V(8); PG8_WAIT_L(0); PG8_BAR; PG8_MMA(0, 0, At, B0); PG8_MMA(0, 1, At, B1); PG8_BAR; PG8_SCHED;
            PG8_LDA(At, 0, 1); PG8_STAGE(PG8_SB(0, 0), b2, voffB); PG8_STAGE(PG8_SB(0, 1), b2 + hstepB, voffB); PG8_STAGE(PG8_SA(0, 0), a2, voffA);
            PG8_WAIT_V(8); PG8_WAIT_L(0); PG8_BAR; PG8_MMA(1, 0, At, B0); PG8_MMA(1, 1, At, B1); PG8_BAR; PG8_SCHED;
            PG8_LDB(B0, 1, 0); PG8_LDB(B1, 1, 1); PG8_SCHED; PG8_LDA(At, 1, 0); PG8_STAGE(PG8_SA(0, 1), a2 + hstepA, voffA);
            PG8_WAIT_V(8); PG8_WAIT_L(0); PG8_BAR; PG8_MMA(0, 0, At, B0); PG8_MMA(0, 1, At, B1); PG8_BAR; PG8_SCHED;
            PG8_LDA(At, 1, 1); PG8_STAGE(PG8_SB(1, 0), b3, voffB); PG8_STAGE(PG8_SB(1, 1), b3 + hstepB, voffB); PG8_STAGE(PG8_SA(1, 0), a3, voffA);
            PG8_WAIT_V(8); PG8_WAIT_L(0); PG8_BAR; PG8_MMA(1, 0, At, B0); PG8_MMA(1, 1, At, B1); PG8_BAR; PG8_SCHED;
        }
        if (wr == 0) PG8_BAR;
        E(acc, cur, wr, wc, fr, fq);
        if (!has_next) break;
#pragma unroll
        for (int a = 0; a < 2; ++a)
#pragma unroll
            for (int b = 0; b < 2; ++b)
#pragma unroll
                for (int m = 0; m < 4; ++m)
#pragma unroll
                    for (int n = 0; n < 2; ++n) acc[a][b][m][n] = (f32x4){0.f, 0.f, 0.f, 0.f};
        cur = nxt; cA = nA; cB = nB; ++ui;
        if (wr == 1) PG8_BAR;
    }
    PG8_WAIT_V(0);
    PG8_BAR;
#undef PG8_SA
#undef PG8_SB
#undef PG8_STAGE
#undef PG8_LDA
#undef PG8_LDB
#undef PG8_MMA
#undef PG8_WAIT_V
#undef PG8_WAIT_L
#undef PG8_BAR
#undef PG8_SCHED
}
}
struct Params { const float* in[27]; float* out; unsigned char* ws; int ph_lo, ph_hi, pad0, pad1; };
enum { I_X = 0, I_MEM, I_POS, I_MIXG, I_WIN, I_POOLW, I_POOLS, I_CONVW, I_ALOG, I_DTB, I_DNG, I_WUPP, I_WUPM, I_WUPD, I_WOUT, I_XAG, I_MEMG, I_XAQ, I_XAKV, I_XAO,
       I_FFNG, I_DGU, I_DD, I_ROUTER, I_MGU, I_MD, I_FING };

struct Frame {
    LAS unsigned char* lds;
    int tid, lane, wave, G, blk;
    unsigned char* ws;
};

struct Job { const float* W; int K, N; bf16_t* WT; int ldt; int mode; int ff; const float* kscale; unsigned char* WT8; };
DI int job_map(int mode, int ff, int n) {
    if (mode == 0) return n;
    if (mode == 1) return n < 2560 ? n : (n < 2576 ? -1 : n - 16);
    if (n < ff) return (n >> 7) * 256 + (n & 127);
    const int m = n - ff; return (m >> 7) * 256 + 128 + (m & 127);
}
DI int job_items(const Job& J) { return (J.K / 64) * ((J.N + 31) / 32); }
DI void transpose_item(const Job& J, LAS float* scr, int item, int lane) {
    const int nblk = (J.N + 31) / 32, kb = item / nblk, nb = item - kb * nblk, k0 = 64 * kb, n0 = 32 * nb;
    const int nn = lane & 31; const bool ok = (n0 + nn) < J.N;
    float tv[32];
#pragma unroll
    for (int i = 0; i < 32; ++i) { const int kk = 2 * i + (lane >> 5); tv[i] = J.W[(size_t)(k0 + kk) * J.N + (ok ? n0 + nn : 0)]; }
#pragma unroll
    for (int i = 0; i < 32; ++i) { const int kk = 2 * i + (lane >> 5); float v = ok ? tv[i] : 0.f; if (J.kscale) v *= J.kscale[k0 + kk]; scr[kk * 33 + nn] = v; }
    LDS_WAIT();
    const int c = lane & 7;
#pragma unroll
    for (int j = 0; j < 4; ++j) { const int n = (lane >> 3) + 8 * j; const int sn = n0 + n; const int drow = sn < J.N ? job_map(J.mode, J.ff, sn) : -1;
        if (drow >= 0) { const LAS float* s = scr + (8 * c) * 33 + n;
            if (J.mode == 1 && drow >= 3072) { u32x2 o;
                o.x = cvt4_fp8(s[0 * 33] * 32.f, s[1 * 33] * 32.f, s[2 * 33] * 32.f, s[3 * 33] * 32.f); o.y = cvt4_fp8(s[4 * 33] * 32.f, s[5 * 33] * 32.f, s[6 * 33] * 32.f, s[7 * 33] * 32.f);
                *(u32x2*)(J.WT8 + (size_t)(drow - 3072) * 1024 + k0 + 8 * c) = o; }
            else { u32x4 o; o.x = pk2(s[0 * 33], s[1 * 33]); o.y = pk2(s[2 * 33], s[3 * 33]); o.z = pk2(s[4 * 33], s[5 * 33]); o.w = pk2(s[6 * 33], s[7 * 33]);
                *(u32x4*)(J.WT + (size_t)drow * J.ldt + k0 + 8 * c) = o; } } }
    LDS_WAIT();
}
constexpr int NJOBS = 2 * 7 + 2 + 16;
DI void get_job(const Frame& F, const Params& P, int j, Job& J) {
    unsigned char* ws = F.ws;
    J.mode = 0; J.ff = 0; J.kscale = nullptr; J.WT8 = nullptr;
    if (j < 14) { const int l = j / 7, t = j - 7 * l; unsigned char* lw = ws + WS_LW + (size_t)l * LW_STRIDE;
        if (t == 0) { J.W = P.in[I_WIN] + (size_t)l * 1024 * IN_COLS; J.K = 1024; J.N = IN_COLS; J.WT = (bf16_t*)(lw + LW_WIN); J.ldt = 1024; J.mode = 1; J.kscale = P.in[I_MIXG] + l * 1024; J.WT8 = ws + WS_WG8 + (size_t)l * 3072 * 1024; }
        else if (t == 1) { J.W = P.in[I_WUPM] + (size_t)l * 256 * 1024; J.K = 256; J.N = 1024; J.WT = (bf16_t*)(lw + LW_WCAT) + 256; J.ldt = 1024; }
        else if (t == 2) { J.W = P.in[I_WUPD] + (size_t)l * 512 * 1024; J.K = 512; J.N = 1024; J.WT = (bf16_t*)(lw + LW_WCAT) + 512; J.ldt = 1024; }
        else if (t == 3) { J.W = P.in[I_WOUT] + (size_t)l * 1024 * 1024; J.K = 1024; J.N = 1024; J.WT = (bf16_t*)(lw + LW_WOUT); J.ldt = 1024; }
        else if (t == 4) { J.W = P.in[I_XAQ] + (size_t)l * 1024 * 512; J.K = 1024; J.N = 512; J.WT = (bf16_t*)(lw + LW_WQ); J.ldt = 1024; J.kscale = P.in[I_XAG] + l * 1024; }
        else if (t == 5) { J.W = P.in[I_XAKV] + (size_t)l * 1024 * 1024; J.K = 1024; J.N = 1024; J.WT = (bf16_t*)(lw + LW_WKV); J.ldt = 1024; }
        else { J.W = P.in[I_XAO] + (size_t)l * 512 * 1024; J.K = 512; J.N = 1024; J.WT = (bf16_t*)(lw + LW_WO); J.ldt = 512; }
    } else if (j == 14) { J.W = P.in[I_DGU]; J.K = 1024; J.N = 2 * FF; J.WT = (bf16_t*)(ws + WS_WGU); J.ldt = 1024; J.mode = 2; J.ff = FF; J.kscale = P.in[I_FFNG]; }
    else if (j == 15) { J.W = P.in[I_DD]; J.K = FF; J.N = 1024; J.WT = (bf16_t*)(ws + WS_WD); J.ldt = FF; }
    else { const int e = (j - 16) >> 1;
        if (((j - 16) & 1) == 0) { J.W = P.in[I_MGU] + (size_t)e * 1024 * 2 * EFF; J.K = 1024; J.N = 2 * EFF; J.WT = (bf16_t*)(ws + WS_WMGU) + (size_t)e * 2 * EFF * 1024; J.ldt = 1024; J.mode = 2; J.ff = EFF; J.kscale = P.in[I_FFNG] + 1024; }
        else { J.W = P.in[I_MD] + (size_t)e * EFF * 1024; J.K = EFF; J.N = 1024; J.WT = (bf16_t*)(ws + WS_WMD) + (size_t)e * 1024 * EFF; J.ldt = EFF; } }
}

DI void phase_prologue(const Frame& F, const Params& P) {
    unsigned char* ws = F.ws;
    const int gw = F.blk * 8 + F.wave, NGW = F.G * 8, lane = F.lane;
    const long gt = (long)F.blk * 512 + F.tid, NGT = (long)F.G * 512;
    { const float* x = P.in[I_X]; bf16_t* xb = (bf16_t*)(ws + WS_XB); float* ssq = (float*)(ws + WS_SSQ); unsigned char* x8 = ws + WS_X8;
      for (int row0 = gw; row0 < NTOK; row0 += 4 * NGW) {
          f32x4 v[4][4];
#pragma unroll
          for (int q = 0; q < 4; ++q) { const int row = row0 + q * NGW; const f32x4* xr = (const f32x4*)(x + (size_t)(row < NTOK ? row : row0) * 1024) + lane;
#pragma unroll
              for (int j = 0; j < 4; ++j) v[q][j] = xr[64 * j]; }
#pragma unroll
          for (int q = 0; q < 4; ++q) { const int row = row0 + q * NGW; if (row < NTOK) { float s = 0.f;
#pragma unroll
              for (int j = 0; j < 4; ++j) s += (v[q][j].x * v[q][j].x + v[q][j].y * v[q][j].y) + (v[q][j].z * v[q][j].z + v[q][j].w * v[q][j].w);
              s = wave_sum(s);
              u32x2* o = (u32x2*)(xb + (size_t)row * 1024) + lane;
#pragma unroll
              for (int j = 0; j < 4; ++j) { u32x2 w; w.x = pk2(v[q][j].x, v[q][j].y); w.y = pk2(v[q][j].z, v[q][j].w); o[64 * j] = w;
                  ((unsigned*)(x8 + (size_t)row * 1024))[lane + 64 * j] = cvt4_fp8(v[q][j].x, v[q][j].y, v[q][j].z, v[q][j].w); }
              if (lane < 16) ssq[(size_t)row * 16 + lane] = lane == 0 ? s : 0.f; } }
      } }
    { const float* mem = P.in[I_MEM]; bf16_t* mn = (bf16_t*)(ws + WS_MEMN);
      for (int row = gw; row < 2048; row += NGW) {
          const f32x4* xr = (const f32x4*)(mem + (size_t)row * 1024) + lane; f32x4 v[4]; float s = 0.f;
#pragma unroll
          for (int j = 0; j < 4; ++j) { v[j] = xr[64 * j]; s += (v[j].x * v[j].x + v[j].y * v[j].y) + (v[j].z * v[j].z + v[j].w * v[j].w); }
          s = wave_sum(s); const float r = rsqrtf(s * (1.0f / 1024.0f) + RMS_EPS);
#pragma unroll
          for (int l = 0; l < 2; ++l) { const f32x4* gr = (const f32x4*)(P.in[I_MEMG] + l * 1024) + lane; u32x2* o = (u32x2*)(mn + ((size_t)l * 2048 + row) * 1024) + lane;
#pragma unroll
              for (int j = 0; j < 4; ++j) { const f32x4 gg = gr[64 * j]; u32x2 w; w.x = pk2(v[j].x * r * gg.x, v[j].y * r * gg.y); w.y = pk2(v[j].z * r * gg.z, v[j].w * r * gg.w); o[64 * j] = w; } }
      } }
    { const int* pos = (const int*)P.in[I_POS]; float* rope = (float*)(ws + WS_ROPE);
      for (long i = gt; i < (long)NTOK * 8; i += NGT) { const int tok = (int)(i >> 3), f = (int)(i & 7);
          const float inv = powf(500000.0f, -(float)f * 2.0f / 16.0f); const float ang = (float)pos[tok] * inv; float sn, cs; sincosf(ang, &sn, &cs);
          rope[(size_t)tok * 16 + f] = cs; rope[(size_t)tok * 16 + 8 + f] = sn; } }
    for (long i = gt; i < 2 * 16 * 1024; i += NGT) { const int l = (int)(i >> 14), j = (int)((i >> 10) & 15), k = (int)(i & 1023);
        const float v = P.in[I_WIN][((size_t)l * 1024 + k) * IN_COLS + 2560 + j] * P.in[I_MIXG][l * 1024 + k];
        ((bf16_t*)(ws + WS_LW + (size_t)l * LW_STRIDE + LW_WBA))[j * 1024 + k] = (bf16_t)f2bf(v); }
    for (long i = gt; i < 8 * 1024; i += NGT) { const int e = (int)(i >> 10), k = (int)(i & 1023); ((float*)(ws + WS_WR))[e * 1024 + k] = P.in[I_ROUTER][k * 8 + e] * P.in[I_FFNG][1024 + k]; }
    for (long i = gt; i < 2L * 256 * 1024; i += NGT) { const int l = (int)(i >> 18), k = (int)((i >> 10) & 255), n = (int)(i & 1023), gi = k >> 6, c = k & 63;
        const float* pw = P.in[I_POOLW] + (((size_t)l * 4 + gi) * 64 + c) * 64; const float* ps = P.in[I_POOLS] + l * 256 + gi * 64; const float* wu = P.in[I_WUPP] + ((size_t)l * 256 + gi * 64) * 1024 + n;
        float s = 0.f;
#pragma unroll 16
        for (int d = 0; d < 64; ++d) s += pw[d] * ps[d] * wu[(size_t)d * 1024];
        ((bf16_t*)(ws + WS_LW + (size_t)l * LW_STRIDE + LW_WCAT))[(size_t)n * 1024 + k] = (bf16_t)f2bf(s); }
    { float* sm = (float*)(ws + WS_SMALL);
      for (long i = gt; i < 2 * 4 * 1536; i += NGT) sm[SM_CONVW + i] = P.in[I_CONVW][i];
      for (long i = gt; i < 16; i += NGT) { sm[SM_ALOG + i] = P.in[I_ALOG][i]; sm[SM_DTB + i] = P.in[I_DTB][i]; }
      for (long i = gt; i < 128; i += NGT) sm[SM_DNG + i] = P.in[I_DNG][i];
      for (long i = gt; i < 1024; i += NGT) sm[SM_FING + i] = P.in[I_FING][i]; }
    { LAS float* scr = (LAS float*)(F.lds + F.wave * 8704);
      int base = 0;
      for (int j = 0; j < NJOBS; ++j) { Job J; get_job(F, P, j, J); const int ni = job_items(J);
          int first = gw - (base % NGW); if (first < 0) first += NGW;
          for (int it = first; it < ni; it += NGW) transpose_item(J, scr, it, lane);
          base += ni; } }
}
DI void ba_tiles(const Frame& F, const bf16_t* xbg, const bf16_t* Wba, const float* ssqg, float* BA) {
    const int lane = F.lane, gw = F.blk * 8 + F.wave, NGW = F.G * 8;
    for (int tile = gw; tile < NG / 16; tile += NGW) {
        const int row0 = tile * 16; f32x4 acc = (f32x4){0.f, 0.f, 0.f, 0.f};
        const bf16_t* ap = xbg + (size_t)(row0 + (lane & 15)) * 1024 + (lane >> 4) * 8; const bf16_t* bp = Wba + (size_t)(lane & 15) * 1024 + (lane >> 4) * 8;
#pragma unroll 8
        for (int ks = 0; ks < 32; ++ks) { const bf16x8 a = *(const bf16x8*)(ap + 32 * ks); const bf16x8 b = *(const bf16x8*)(bp + 32 * ks); acc = MFMA16(a, b, acc); }
#pragma unroll
        for (int i = 0; i < 4; ++i) { const int row = row0 + 4 * (lane >> 4) + i; BA[(size_t)row * 16 + (lane & 15)] = acc[i] * row_rstd(ssqg, row); }
    }
}

template <int W> DI void prep_pool_w(const bf16_t* Pb, bf16_t* BR, int ch, int lr0, int s0) {
    const bf16_t* p = Pb + PC_POOL + ch; float v[32 + W - 1];
#pragma unroll
    for (int i = 0; i < 32 + W - 1; ++i) { const int d = i - (W - 1); const bool ok = s0 + d >= 0; const unsigned short raw = p[(size_t)(ok ? lr0 + d : lr0) * PLD]; v[i] = ok ? bf2f(raw) : 0.f; }
    float sum = 0.f;
#pragma unroll
    for (int i = 0; i < W - 1; ++i) sum += v[i];
#pragma unroll
    for (int t = 0; t < 32; ++t) { const float x = v[t + W - 1]; sum += x; const int s = s0 + t;
        const float o = (s + 1 >= W ? sum * (1.0f / (float)W) : sum / (float)(s + 1)) - x;
        BR[(size_t)(lr0 + t) * 1024 + ch] = (bf16_t)f2bf(o);
        sum -= v[t]; }
}
DI void prep_pool(const Frame& F, const bf16_t* Pb, bf16_t* BR, int unit) {
    int tid_ = F.tid; LAUNDER_V(tid_);
    const int ch = tid_ & 255, half = tid_ >> 8, lr0 = unit * 64 + half * 32, s0 = lr0 & (SEQ - 1), g = F.wave & 3;
    if (g == 0) prep_pool_w<2>(Pb, BR, ch, lr0, s0); else if (g == 1) prep_pool_w<4>(Pb, BR, ch, lr0, s0); else if (g == 2) prep_pool_w<8>(Pb, BR, ch, lr0, s0); else prep_pool_w<16>(Pb, BR, ch, lr0, s0);
}

DI void prep_moba(const Frame& F, bf16_t* Pb, const float* rope, float* KBAR, bf16_t* VT, int unit) {
    int tid_ = F.tid; LAUNDER_V(tid_);
    const int tid = tid_, lane = tid & 63, wave = F.wave;
    const int bl = unit >> 6, j = (unit >> 1) & 31, hp = unit & 1, lr0 = bl * SEQ + j * 256;
    LAS unsigned* Tt = (LAS unsigned*)F.lds; LAS float* KS1 = (LAS float*)(F.lds + 68 * 1024); LAS float* KS2 = KS1 + 128;
    __syncthreads();
    const int r = tid & 255, hh = tid >> 8; const size_t lr = (size_t)(lr0 + r);
    bf16_t* qb = Pb + lr * PLD + PC_MQ + (2 * hp + hh) * 64; bf16_t* kb = Pb + lr * PLD + PC_MK + (2 * hp + hh) * 64;
    const f32x4 c0 = *(const f32x4*)(rope + lr * 16), c1 = *(const f32x4*)(rope + lr * 16 + 4), s0 = *(const f32x4*)(rope + lr * 16 + 8), s1 = *(const f32x4*)(rope + lr * 16 + 12);
    const u32x4 qa = *(const u32x4*)qb, qc = *(const u32x4*)(qb + 8), ka = *(const u32x4*)kb, kc = *(const u32x4*)(kb + 8);
    const int c8 = tid & 15, rg = tid >> 4; const bool plain = (c8 & 7) >= 2;
    u32x4 vv[8], kk[8];
#pragma unroll
    for (int i = 0; i < 8; ++i) vv[i] = *(const u32x4*)(Pb + (size_t)(lr0 + ((tid + 512 * i) >> 4)) * PLD + PC_MV + hp * 128 + c8 * 8);
#pragma unroll
    for (int i = 0; i < 8; ++i) kk[i] = plain ? *(const u32x4*)(Pb + (size_t)(lr0 + rg * 8 + i) * PLD + PC_MK + hp * 128 + c8 * 8) : (u32x4){0u, 0u, 0u, 0u};
    __builtin_amdgcn_sched_barrier(0);
    {
        const float cs[8] = {c0.x, c0.y, c0.z, c0.w, c1.x, c1.y, c1.z, c1.w}, sn[8] = {s0.x, s0.y, s0.z, s0.w, s1.x, s1.y, s1.z, s1.w};
        float q1[8], q2[8], k1[8], k2[8];
#pragma unroll
        for (int q = 0; q < 4; ++q) { q1[2 * q] = __uint_as_float(qa[q] << 16); q1[2 * q + 1] = __uint_as_float(qa[q] & 0xffff0000u); q2[2 * q] = __uint_as_float(qc[q] << 16); q2[2 * q + 1] = __uint_as_float(qc[q] & 0xffff0000u);
                                      k1[2 * q] = __uint_as_float(ka[q] << 16); k1[2 * q + 1] = __uint_as_float(ka[q] & 0xffff0000u); k2[2 * q] = __uint_as_float(kc[q] << 16); k2[2 * q + 1] = __uint_as_float(kc[q] & 0xffff0000u); }
        float ra[8], rb[8]; u32x4 oa, ob;
#pragma unroll
        for (int e = 0; e < 8; ++e) { ra[e] = q1[e] * cs[e] - q2[e] * sn[e]; rb[e] = q2[e] * cs[e] + q1[e] * sn[e]; }
#pragma unroll
        for (int q = 0; q < 4; ++q) { oa[q] = pk2(ra[2 * q], ra[2 * q + 1]); ob[q] = pk2(rb[2 * q], rb[2 * q + 1]); }
        *(u32x4*)qb = oa; *(u32x4*)(qb + 8) = ob;
#pragma unroll
        for (int e = 0; e < 8; ++e) { ra[e] = k1[e] * cs[e] - k2[e] * sn[e]; rb[e] = k2[e] * cs[e] + k1[e] * sn[e]; }
#pragma unroll
        for (int q = 0; q < 4; ++q) { oa[q] = pk2(ra[2 * q], ra[2 * q + 1]); ob[q] = pk2(rb[2 * q], rb[2 * q + 1]); }
        *(u32x4*)kb = oa; *(u32x4*)(kb + 8) = ob;
#pragma unroll
        for (int e = 0; e < 8; ++e) { const float a = wave_sum(ra[e]), b = wave_sum(rb[e]); if (lane == 0) { KS1[wave * 16 + e] = a; KS1[wave * 16 + 8 + e] = b; } }
    }
    {
        float sacc[8];
#pragma unroll
        for (int e = 0; e < 8; ++e) sacc[e] = 0.f;
#pragma unroll
        for (int i = 0; i < 8; ++i)
#pragma unroll
            for (int q = 0; q < 4; ++q) { sacc[2 * q] += __uint_as_float(kk[i][q] << 16); sacc[2 * q + 1] += __uint_as_float(kk[i][q] & 0xffff0000u); }
#pragma unroll
        for (int e = 0; e < 8; ++e) { sacc[e] += __shfl_xor(sacc[e], 16); sacc[e] += __shfl_xor(sacc[e], 32); }
        if (lane < 16) {
#pragma unroll
            for (int e = 0; e < 8; ++e) KS2[wave * 128 + c8 * 8 + e] = sacc[e]; }
    }
#pragma unroll
    for (int i = 0; i < 8; ++i) { const int tok = (tid + 512 * i) >> 4;
#pragma unroll
        for (int e = 0; e < 4; ++e) Tt[tok * 65 + c8 * 4 + e] = vv[i][e]; }
    __syncthreads();
    if (tid < 128) { const int h2 = tid >> 6, d = tid & 63; float sum = 0.f;
        if (d < 16) {
#pragma unroll
            for (int w = 0; w < 4; ++w) sum += KS1[(4 * h2 + w) * 16 + d]; }
        else {
#pragma unroll
            for (int w = 0; w < 8; ++w) sum += KS2[w * 128 + tid]; }
        KBAR[((size_t)(bl * 4 + 2 * hp + h2) * 32 + j) * 64 + d] = sum * (1.0f / 256.0f); }
    const LAS unsigned char* Tb = (const LAS unsigned char*)Tt;
#pragma unroll
    for (int i = 0; i < 8; ++i) { const int o = tid + 512 * i, t8 = o & 7, cl = (o >> 3) & 7, rest = o >> 6, th = rest & 3, cg = rest >> 2, col = cg * 8 + cl, tg = th * 8 + t8;
        unsigned short hv[8];
#pragma unroll
        for (int e = 0; e < 8; ++e) hv[e] = *(const LAS unsigned short*)(Tb + ((tg * 8 + e) * 65 + (col >> 1)) * 4 + (col & 1) * 2);
        u32x4 w;
#pragma unroll
        for (int e = 0; e < 4; ++e) w[e] = (unsigned)hv[2 * e] | ((unsigned)hv[2 * e + 1] << 16);
        *(u32x4*)(VT + ((size_t)(bl * 256 + hp * 128 + col)) * SEQ + j * 256 + tg * 8) = w; }
    __syncthreads();
}

constexpr int DN_ROWB = 144;
constexpr int DN_TQ = 0, DN_TK = 9216, DN_TKB = 18432, DN_TVB = 27648, DN_MISC = 36864, DN_PAIR = 38400;
__host__ __device__ constexpr int ap_rowoff(int i) { return i == 0 ? 0 : 4 * (((i - 1) / 4) + 1) * (2 * ((i - 1) / 4) + ((i - 1) % 4)); }

template <int I> DI void subst_load(const LAS float* Ap, const LAS unsigned char* Rt, const LAS float* SCL, int lane, f32x4 (&av)[16], float& Ri) {
    constexpr int off = ap_rowoff(I);
#pragma unroll
    for (int j4 = 0; j4 < I; j4 += 4) av[j4 >> 2] = *(const LAS f32x4*)(Ap + off + j4);
    Ri = bf2f(*(const LAS bf16_t*)(Rt + I * DN_ROWB + lane * 2)) * SCL[I];
}
template <int I> struct Subst2 { static DI void run(float (&x)[64], const LAS float* Ap, const LAS unsigned char* Rt, const LAS float* SCL, int lane, f32x4 (&cur)[16], float Rc, f32x4 (&nxt)[16]) {
    float Rn = 0.f;
    if constexpr (I + 1 < 64) subst_load<I + 1>(Ap, Rt, SCL, lane, nxt, Rn);
    float a0 = Rc, a1 = 0.f, a2 = 0.f, a3 = 0.f;
#pragma unroll
    for (int j4 = 0; j4 < I; j4 += 4) { const f32x4 av = cur[j4 >> 2];
        a0 -= av.x * x[j4];
        if (j4 + 1 < I) a1 -= av.y * x[j4 + 1];
        if (j4 + 2 < I) a2 -= av.z * x[j4 + 2];
        if (j4 + 3 < I) a3 -= av.w * x[j4 + 3]; }
    x[I] = (a0 + a1) + (a2 + a3);
    asm volatile("" : "+v"(x[I])); __builtin_amdgcn_sched_barrier(0);
    if constexpr (I + 1 < 64) Subst2<I + 1>::run(x, Ap, Rt, SCL, lane, nxt, Rn, cur);
} };

DI void conv_w_load(const float* convw, int wcol, float (&w)[4][8]) {
#pragma unroll
    for (int j = 0; j < 4; ++j) { const f32x4 w0 = *(const f32x4*)(convw + j * 1536 + wcol), w1 = *(const f32x4*)(convw + j * 1536 + wcol + 4);
        w[j][0] = w0.x; w[j][1] = w0.y; w[j][2] = w0.z; w[j][3] = w0.w; w[j][4] = w1.x; w[j][5] = w1.y; w[j][6] = w1.z; w[j][7] = w1.w; }
}
DI void conv8(const bf16_t* Pb, const float (&w)[4][8], int lr, int s, int pcol8, float (&a)[8]) {
#pragma unroll
    for (int e = 0; e < 8; ++e) a[e] = 0.f;
    u32x4 xv[4];
#pragma unroll
    for (int j = 0; j < 4; ++j) { const bool valid = (s - 3 + j) >= 0; xv[j] = *(const u32x4*)(Pb + (size_t)(valid ? lr - 3 + j : lr) * PLD + pcol8);
        xv[j].x = valid ? xv[j].x : 0u; xv[j].y = valid ? xv[j].y : 0u; xv[j].z = valid ? xv[j].z : 0u; xv[j].w = valid ? xv[j].w : 0u; }
#pragma unroll
    for (int j = 0; j < 4; ++j) {
        a[0] += w[j][0] * __uint_as_float(xv[j][0] << 16); a[1] += w[j][1] * __uint_as_float(xv[j][0] & 0xffff0000u);
        a[2] += w[j][2] * __uint_as_float(xv[j][1] << 16); a[3] += w[j][3] * __uint_as_float(xv[j][1] & 0xffff0000u);
        a[4] += w[j][4] * __uint_as_float(xv[j][2] << 16); a[5] += w[j][5] * __uint_as_float(xv[j][2] & 0xffff0000u);
        a[6] += w[j][6] * __uint_as_float(xv[j][3] << 16); a[7] += w[j][7] * __uint_as_float(xv[j][3] & 0xffff0000u);
    }
#pragma unroll
    for (int e = 0; e < 8; ++e) a[e] = a[e] * fsigmoid(a[e]);
}
DI float ssq8(const float (&a)[8]) { float ss = 0.f;
#pragma unroll
    for (int e = 0; e < 8; ++e) ss += a[e] * a[e];
    ss += __shfl_xor(ss, 1); ss += __shfl_xor(ss, 2); ss += __shfl_xor(ss, 4); return ss; }
DI u32x4 pack8(const float (&a)[8], float sc) { u32x4 w; w.x = pk2(a[0] * sc, a[1] * sc); w.y = pk2(a[2] * sc, a[3] * sc); w.z = pk2(a[4] * sc, a[5] * sc); w.w = pk2(a[6] * sc, a[7] * sc); return w; }

#ifndef DBG_RA
#define DBG_RA 1
#endif
#ifndef DBG_RB
#define DBG_RB 1
#endif
#ifndef DBG_RC
#define DBG_RC 1
#endif
#ifndef DBG_RD
#define DBG_RD 1
#endif
#ifndef DBG_RB2
#define DBG_RB2 1
#endif
DI void prep_dn(const Frame& F, const bf16_t* Pb, const float* BA, const float* convw, const float* alog, const float* dtb,
                bf16_t* QD, bf16_t* MM, bf16_t* NT, bf16_t* WN, bf16_t* UT, bf16_t* AQK, float* GL, int unit) {
    int lane_ = F.lane; LAUNDER_V(lane_);
    const int lane = lane_, wave = F.wave, pr = wave >> 1, role = wave & 1;
    const int bl = unit >> 8, rem = unit & 255, n = rem >> 1, hq = rem & 1, h = 4 * hq + pr;
    const int lr0 = bl * SEQ + n * 64;
    const int chidx = (bl * 128 + n) * 8 + h;
    LAS unsigned char* L = F.lds + pr * DN_PAIR;
    LAS float* Gs = (LAS float*)(L + DN_MISC); LAS float* EG = Gs + 64; LAS float* EGL = Gs + 128; LAS float* ONES = Gs + 192; LAS float* BETA = Gs + 256 + 64 * role;
    {
        const int lr = lr0 + lane;
        const float braw = BA[(size_t)lr * 16 + h], araw = BA[(size_t)lr * 16 + 8 + h];
        const float beta = fsigmoid(braw);
        const float xa = araw + dtb[h]; const float sp = xa > 20.f ? xa : log1pf(__expf(xa));
        float G = -__expf(alog[h]) * sp;
#pragma unroll
        for (int o = 1; o < 64; o <<= 1) { const float up = __shfl_up(G, o); if (lane >= o) G += up; }
        const float Glast = __shfl(G, 63);
        BETA[lane] = beta;
        if (role == 0) { Gs[lane] = G; EG[lane] = __expf(G); EGL[lane] = __expf(Glast - G); ONES[lane] = 1.0f; if (lane == 0) GL[chidx] = __expf(Glast); }
    }
    LDS_WAIT();
    for (int rpA = 0; rpA < DBG_RA; ++rpA) {
        const int cg = lane & 7, tl = lane >> 3; float w[4][8];
        if (role == 0) {
            conv_w_load(convw, h * 64 + cg * 8, w);
#pragma unroll 4
            for (int ps = 0; ps < 8; ++ps) { const int t = ps * 8 + tl; float a[8]; conv8(Pb, w, lr0 + t, n * 64 + t, PC_DQ + h * 64 + cg * 8, a);
                const float rn = rsqrtf(ssq8(a) + RMS_EPS) * 0.125f;
                *(LAS u32x4*)(L + DN_TQ + t * DN_ROWB + cg * 16) = pack8(a, rn); }
        } else {
            conv_w_load(convw, 512 + h * 64 + cg * 8, w);
#pragma unroll 4
            for (int ps = 0; ps < 8; ++ps) { const int t = ps * 8 + tl; float a[8]; conv8(Pb, w, lr0 + t, n * 64 + t, PC_DK + h * 64 + cg * 8, a);
                const float rn = rsqrtf(ssq8(a) + RMS_EPS);
                *(LAS u32x4*)(L + DN_TK + t * DN_ROWB + cg * 16) = pack8(a, rn); *(LAS u32x4*)(L + DN_TKB + t * DN_ROWB + cg * 16) = pack8(a, rn * BETA[t]); }
        }
        conv_w_load(convw, 1024 + h * 64 + cg * 8, w);
#pragma unroll 4
        for (int ps = 4 * role; ps < 4 * role + 4; ++ps) { const int t = ps * 8 + tl; float a[8]; conv8(Pb, w, lr0 + t, n * 64 + t, PC_DV + h * 64 + cg * 8, a);
            *(LAS u32x4*)(L + DN_TVB + t * DN_ROWB + cg * 16) = pack8(a, BETA[t]); }
    }
    WG_BAR();
    for (int rpB = 0; rpB < DBG_RB; ++rpB) {
        const int fr = lane & 15, fq = lane >> 4;
#pragma unroll
        for (int tt = 0; tt < 8; ++tt) { const int tile = 2 * tt + role, it = tile >> 2, jt = tile & 3;
            f32x4 acc = (f32x4){0.f, 0.f, 0.f, 0.f};
            if (jt <= it) {
#pragma unroll
                for (int ks = 0; ks < 2; ++ks) { const bf16x8 a = *(const LAS bf16x8*)(L + DN_TK + (16 * jt + fr) * DN_ROWB + (fq * 8 + 32 * ks) * 2);
                    const bf16x8 b = *(const LAS bf16x8*)(L + DN_TQ + (16 * it + fr) * DN_ROWB + (fq * 8 + 32 * ks) * 2); acc = MFMA16(a, b, acc); } }
            const int ii = 16 * it + fr; const float Gi = Gs[ii]; float v[4];
#pragma unroll
            for (int r = 0; r < 4; ++r) { const int jj = 16 * jt + 4 * fq + r; v[r] = (jj <= ii) ? acc[r] * __expf(Gi - Gs[jj]) : 0.f; }
            u32x2 w; w.x = pk2(v[0], v[1]); w.y = pk2(v[2], v[3]);
            *(u32x2*)(AQK + (size_t)chidx * 4096 + ii * 64 + 16 * jt + 4 * fq) = w;
        }
#pragma unroll
        for (int i = 0; i < 4; ++i) { const int idx = lane + 64 * role + 128 * i, t = idx >> 3, cg = idx & 7; const u32x4 qv = *(const LAS u32x4*)(L + DN_TQ + t * DN_ROWB + cg * 16); const float eg = EG[t]; u32x4 w;
#pragma unroll
            for (int e = 0; e < 4; ++e) w[e] = pk2(__uint_as_float(qv[e] << 16) * eg, __uint_as_float(qv[e] & 0xffff0000u) * eg);
            *(u32x4*)(QD + (size_t)chidx * 4096 + t * 64 + cg * 8) = w; }
    }
    WG_BAR();
    for (int rpB2 = 0; rpB2 < DBG_RB2; ++rpB2) {
        const int fr = lane & 15, fq = lane >> 4; LAS float* Ap = (LAS float*)(L + DN_TQ);
#pragma unroll
        for (int tt = 0; tt < 5; ++tt) { const int q = 2 * tt + role;
            const int it = q < 1 ? 0 : (q < 3 ? 1 : (q < 6 ? 2 : 3)), jt = q - (it * (it + 1)) / 2;
            f32x4 acc = (f32x4){0.f, 0.f, 0.f, 0.f};
#pragma unroll
            for (int ks = 0; ks < 2; ++ks) { const bf16x8 a = *(const LAS bf16x8*)(L + DN_TKB + (16 * it + fr) * DN_ROWB + (fq * 8 + 32 * ks) * 2);
                const bf16x8 b = *(const LAS bf16x8*)(L + DN_TK + (16 * jt + fr) * DN_ROWB + (fq * 8 + 32 * ks) * 2); acc = MFMA16(a, b, acc); }
            const int jj = 16 * jt + fr; const float Gj = Gs[jj];
#pragma unroll
            for (int r = 0; r < 4; ++r) { const int ii = 16 * it + 4 * fq + r;
                if (jj < ii) { const int m1 = ii - 1, gf = m1 >> 2, rm = m1 & 3; Ap[4 * (gf + 1) * (2 * gf + rm) + jj] = acc[r] * __expf(Gs[ii] - Gj); } }
        }
    }
    u32x4 kdt[4];
#pragma unroll
    for (int i = 0; i < 4; ++i) { const int idx = lane + 64 * role + 128 * i, d = idx >> 3, tc = idx & 7; unsigned short kv[8];
#pragma unroll
        for (int e = 0; e < 8; ++e) kv[e] = *(const LAS bf16_t*)(L + DN_TK + (tc * 8 + e) * DN_ROWB + d * 2);
#pragma unroll
        for (int e = 0; e < 4; ++e) kdt[i][e] = pk2(bf2f(kv[2 * e]) * EGL[tc * 8 + 2 * e], bf2f(kv[2 * e + 1]) * EGL[tc * 8 + 2 * e + 1]); }
    WG_BAR();
#pragma unroll
    for (int i = 0; i < 4; ++i) { const int idx = lane + 64 * role + 128 * i, d = idx >> 3, tc = idx & 7; *(LAS u32x4*)(L + DN_TK + d * DN_ROWB + tc * 16) = kdt[i]; }
    for (int rpC = 0; rpC < DBG_RC; ++rpC) {
        float x[64];
        LAS unsigned char* const RT = L + DN_TVB - role * (DN_TVB - DN_TKB);
        { f32x4 avA[16], avB[16]; float R0; subst_load<0>((const LAS float*)(L + DN_TQ), RT, Gs + 192 - role * 128, lane, avA, R0);
          Subst2<0>::run(x, (const LAS float*)(L + DN_TQ), RT, Gs + 192 - role * 128, lane, avA, R0, avB); }
        { LAS unsigned char* T = RT + lane * DN_ROWB;
#pragma unroll
          for (int cg = 0; cg < 8; ++cg) { u32x4 w; w.x = pk2(x[cg * 8], x[cg * 8 + 1]); w.y = pk2(x[cg * 8 + 2], x[cg * 8 + 3]); w.z = pk2(x[cg * 8 + 4], x[cg * 8 + 5]); w.w = pk2(x[cg * 8 + 6], x[cg * 8 + 7]);
              *(LAS u32x4*)(T + cg * 16) = w; if (role == 0) *((u32x4*)(UT + (size_t)chidx * 4096 + lane * 64) + cg) = w; } }
    }
    WG_BAR();
#pragma unroll
    for (int i = 0; i < 4; ++i) { const int idx = lane + 64 * role + 128 * i, cg = idx >> 6, t = idx & 63; unsigned short wv[8];
#pragma unroll
        for (int e = 0; e < 8; ++e) wv[e] = *(const LAS bf16_t*)(L + DN_TKB + (cg * 8 + e) * DN_ROWB + t * 2);
        u32x4 w;
#pragma unroll
        for (int e = 0; e < 4; ++e) w[e] = ((unsigned)wv[2 * e] | ((unsigned)wv[2 * e + 1] << 16)) ^ 0x80008000u;
        *(u32x4*)(WN + (size_t)chidx * 4096 + t * 64 + cg * 8) = w; }
    for (int rpD = 0; rpD < DBG_RD; ++rpD) {
        const int fr = lane & 15, fq = lane >> 4; const float glast = EG[63];
#pragma unroll
        for (int tt = 0; tt < 8; ++tt) { const int tile = 2 * tt + role, mt = tile >> 2, nt = tile & 3;
            f32x4 acc = (f32x4){0.f, 0.f, 0.f, 0.f};
#pragma unroll
            for (int ks = 0; ks < 2; ++ks) { const bf16x8 a = *(const LAS bf16x8*)(L + DN_TKB + (16 * mt + fr) * DN_ROWB + (fq * 8 + 32 * ks) * 2);
                const bf16x8 b = *(const LAS bf16x8*)(L + DN_TK + (16 * nt + fr) * DN_ROWB + (fq * 8 + 32 * ks) * 2); acc = MFMA16(a, b, acc); }
            { const int dko = 16 * nt + fr, dki0 = 16 * mt + 4 * fq; u32x2 w;
              w.x = pk2((dko == dki0 ? glast : 0.f) - acc[0], (dko == dki0 + 1 ? glast : 0.f) - acc[1]); w.y = pk2((dko == dki0 + 2 ? glast : 0.f) - acc[2], (dko == dki0 + 3 ? glast : 0.f) - acc[3]);
              *(u32x2*)(MM + (size_t)chidx * 4096 + dko * 64 + dki0) = w; }
            acc = (f32x4){0.f, 0.f, 0.f, 0.f};
#pragma unroll
            for (int ks = 0; ks < 2; ++ks) { const bf16x8 a = *(const LAS bf16x8*)(L + DN_TK + (16 * mt + fr) * DN_ROWB + (fq * 8 + 32 * ks) * 2);
                const bf16x8 b = *(const LAS bf16x8*)(L + DN_TVB + (16 * nt + fr) * DN_ROWB + (fq * 8 + 32 * ks) * 2); acc = MFMA16(a, b, acc); }
            { u32x2 w; w.x = pk2(acc[0], acc[1]); w.y = pk2(acc[2], acc[3]); *(u32x2*)(NT + (size_t)chidx * 4096 + (16 * nt + fr) * 64 + 16 * mt + 4 * fq) = w; }
        }
    }
    WG_BAR();
}
constexpr int SC_ROWB = 144;
constexpr int SC_ST = 0, SC_VT = 64 * SC_ROWB, SC_RS = 2 * 64 * SC_ROWB;
DI void dn_scan(const Frame& F, int chain, const bf16_t* MM, const bf16_t* NT, bf16_t* SG, int nb, int ne, bool do_store = true) {
    const int lane = F.lane, wave = F.wave, rt = wave & 3, fr = lane & 15, fq = lane >> 4; const bool worker = wave < 4;
    const int bl = chain >> 3, h = chain & 7;
    LAS unsigned char* L = F.lds;
    if (nb == 0) for (int i = F.tid; i < 64 * SC_ROWB / 4; i += 512) ((LAS unsigned*)L)[i] = 0u;
    const size_t cstride = (size_t)8 * 4096;
    size_t cb = (size_t)((bl * 128 + nb) * 8 + h) * 4096;
    const int aoffs = (16 * rt + fr) * 64 + fq * 8;
    const int coff0 = fr * 64 + 16 * rt + 4 * fq;
    if (worker && nb == 0) {
#pragma unroll
        for (int nt = 0; nt < 4; ++nt) *(u32x2*)(SG + cb + coff0 + 1024 * nt) = (u32x2){0u, 0u}; }
    bf16x8 a[4][2]; u32x2 nc[4][4];
    if (worker) {
#pragma unroll
        for (int j = 0; j < 4; ++j) { const size_t cj = cb + (size_t)(nb + j < 127 ? j : 0) * cstride;
#pragma unroll
            for (int ks = 0; ks < 2; ++ks) a[j][ks] = *(const bf16x8*)(MM + cj + aoffs + 32 * ks);
#pragma unroll
            for (int nt = 0; nt < 4; ++nt) nc[j][nt] = *(const u32x2*)(NT + cj + coff0 + 1024 * nt); } }
    __syncthreads();
#pragma unroll 1
    for (int n0 = nb; n0 < ne; n0 += 16) {
#pragma unroll
        for (int jj = 0; jj < 16; ++jj) { const int j = jj & 3; const int n = n0 + jj;
            if (n < ne) {
                const size_t cbn = cb + cstride;
                if (worker) {
                    LAS unsigned char* SR = L + (n & 1) * 64 * SC_ROWB; LAS unsigned char* SW = L + ((n + 1) & 1) * 64 * SC_ROWB;
#pragma unroll
                    for (int nt = 0; nt < 4; ++nt) {
                        f32x4 acc = (f32x4){__uint_as_float(nc[j][nt].x << 16), __uint_as_float(nc[j][nt].x & 0xffff0000u), __uint_as_float(nc[j][nt].y << 16), __uint_as_float(nc[j][nt].y & 0xffff0000u)};
#pragma unroll
                        for (int ks = 0; ks < 2; ++ks) { const bf16x8 sb = *(const LAS bf16x8*)(SR + (16 * nt + fr) * SC_ROWB + (fq * 8 + 32 * ks) * 2); acc = MFMA16(a[j][ks], sb, acc); }
                        u32x2 w; w.x = cvt_pk_bf16(acc[0], acc[1]); w.y = cvt_pk_bf16(acc[2], acc[3]);
                        *(LAS u32x2*)(SW + (16 * nt + fr) * SC_ROWB + (16 * rt + 4 * fq) * 2) = w;
                        if (do_store) *(u32x2*)(SG + cbn + coff0 + 1024 * nt) = w;
                    }
                    if (n + 4 < 127) { const size_t c4 = cb + 4 * cstride;
#pragma unroll
                        for (int ks = 0; ks < 2; ++ks) a[j][ks] = *(const bf16x8*)(MM + c4 + aoffs + 32 * ks);
#pragma unroll
                        for (int nt = 0; nt < 4; ++nt) nc[j][nt] = *(const u32x2*)(NT + c4 + coff0 + 1024 * nt); }
                }
                WG_BAR();
                cb = cbn;
            }
        }
    }
    __syncthreads();
}

struct OutOps { bf16x8 wn[2], qd[2], aq[2], sb[4][2]; u32x2 uv[4]; unsigned short zv[16]; };
DI void out_load(OutOps& o, int k, int rt, int fr, int fq, const bf16_t* QD, const bf16_t* WN, const bf16_t* UT, const bf16_t* AQK, const bf16_t* SG, const bf16_t* ZB) {
    const size_t cb = (size_t)k * 4096; const int arow = 16 * rt + fr; const int h = k & 7, n = (k >> 3) & 127, bl = k >> 10;
#pragma unroll
    for (int ks = 0; ks < 2; ++ks) { const size_t off = cb + arow * 64 + fq * 8 + 32 * ks;
        o.wn[ks] = *(const bf16x8*)(WN + off); o.qd[ks] = *(const bf16x8*)(QD + off); o.aq[ks] = *(const bf16x8*)(AQK + off); }
#pragma unroll
    for (int nt = 0; nt < 4; ++nt) { o.uv[nt] = *(const u32x2*)(UT + cb + (16 * nt + fr) * 64 + 16 * rt + 4 * fq);
#pragma unroll
        for (int ks = 0; ks < 2; ++ks) o.sb[nt][ks] = *(const bf16x8*)(SG + cb + (16 * nt + fr) * 64 + fq * 8 + 32 * ks); }
    const int lrb = bl * SEQ + n * 64 + 16 * rt + 4 * fq;
#pragma unroll
    for (int r = 0; r < 4; ++r)
#pragma unroll
        for (int nt = 0; nt < 4; ++nt) o.zv[r * 4 + nt] = ZB[(size_t)(lrb + r) * 512 + h * 64 + 16 * nt + fr];
}
DI void dn_out_pass(const Frame& F, const bf16_t* QD, const bf16_t* WN, const bf16_t* UT, const bf16_t* AQK, const bf16_t* SG, const bf16_t* ZB, const float* dng, bf16_t* BR) {
    int lane_ = F.lane; LAUNDER_V(lane_);
    const int lane = lane_, wave = F.wave, rt = wave & 3, half = wave >> 2, fr = lane & 15, fq = lane >> 4;
    LAS unsigned char* L = F.lds;
    float ng[4];
#pragma unroll
    for (int nt = 0; nt < 4; ++nt) ng[nt] = dng[16 * nt + fr];
    int p = F.blk; if (p >= NCH / 2) return;
    OutOps cur, nxt;
    out_load(cur, 2 * p + half, rt, fr, fq, QD, WN, UT, AQK, SG, ZB);
    __syncthreads();
    for (int it = 0; p < NCH / 2; p += F.G, ++it) {
        const int k = 2 * p + half, pn = p + F.G < NCH / 2 ? p + F.G : p;
        out_load(nxt, 2 * pn + half, rt, fr, fq, QD, WN, UT, AQK, SG, ZB);
        const int h = k & 7, n = (k >> 3) & 127, bl = k >> 10;
        LAS unsigned char* VT = L + ((it & 1) * 2 + half) * 64 * SC_ROWB;
        f32x4 vn[4], o[4];
#pragma unroll
        for (int nt = 0; nt < 4; ++nt) { vn[nt] = (f32x4){__uint_as_float(cur.uv[nt].x << 16), __uint_as_float(cur.uv[nt].x & 0xffff0000u), __uint_as_float(cur.uv[nt].y << 16), __uint_as_float(cur.uv[nt].y & 0xffff0000u)};
            o[nt] = (f32x4){0.f, 0.f, 0.f, 0.f};
#pragma unroll
            for (int ks = 0; ks < 2; ++ks) { vn[nt] = MFMA16(cur.wn[ks], cur.sb[nt][ks], vn[nt]); o[nt] = MFMA16(cur.qd[ks], cur.sb[nt][ks], o[nt]); } }
#pragma unroll
        for (int nt = 0; nt < 4; ++nt) { u32x2 w; w.x = cvt_pk_bf16(vn[nt][0], vn[nt][1]); w.y = cvt_pk_bf16(vn[nt][2], vn[nt][3]);
            *(LAS u32x2*)(VT + (16 * nt + fr) * SC_ROWB + (16 * rt + 4 * fq) * 2) = w; }
        WG_BAR();
#pragma unroll
        for (int nt = 0; nt < 4; ++nt)
#pragma unroll
            for (int ks = 0; ks < 2; ++ks) { const bf16x8 vb = *(const LAS bf16x8*)(VT + (16 * nt + fr) * SC_ROWB + (fq * 8 + 32 * ks) * 2); o[nt] = MFMA16(cur.aq[ks], vb, o[nt]); }
        const int lrb = bl * SEQ + n * 64 + 16 * rt + 4 * fq;
#pragma unroll
        for (int r = 0; r < 4; ++r) { float q = (o[0][r] * o[0][r] + o[1][r] * o[1][r]) + (o[2][r] * o[2][r] + o[3][r] * o[3][r]);
            q += __shfl_xor(q, 1); q += __shfl_xor(q, 2); q += __shfl_xor(q, 4); q += __shfl_xor(q, 8);
            const float rs = rsqrtf(q * (1.0f / 64.0f) + RMS_EPS); const size_t lr = (size_t)(lrb + r);
#pragma unroll
            for (int nt = 0; nt < 4; ++nt) { const float z = bf2f(cur.zv[r * 4 + nt]);
                BR[lr * 1024 + 512 + h * 64 + 16 * nt + fr] = (bf16_t)f2bf(o[nt][r] * rs * ng[nt] * (z * fsigmoid(z))); } }
        cur = nxt;
    }
    __syncthreads();
}

constexpr int MG_QS = 0, MG_KB = 36864, MG_SEL = MG_KB + 8192, MG_TOP = MG_SEL + 1024;
DI void moba_gate_unit(const Frame& F, const bf16_t* Pb, const float* KBAR, unsigned* SELG, unsigned char* LISTG, int* CNTG, int bl, int h, int c) {
    int lane_ = F.lane; LAUNDER_V(lane_);
    const int lane = lane_, wave = F.wave, tid = wave * 64 + lane;
    LAS unsigned char* L = F.lds; LAS float* KB = (LAS float*)(L + MG_KB); LAS unsigned* SEL = (LAS unsigned*)(L + MG_SEL);
    const int q0 = bl * SEQ + c * 256, bh = bl * 4 + h;
    __syncthreads();
#pragma unroll
    for (int i = 0; i < 4; ++i) { const int q = tid + 512 * i, r = q >> 3, c8 = q & 7; *(LAS u32x4*)(L + MG_QS + r * 144 + c8 * 16) = *(const u32x4*)(Pb + (size_t)(q0 + r) * PLD + PC_MQ + h * 64 + c8 * 8); }
    for (int i = tid; i < c * 64; i += 512) KB[i] = KBAR[(size_t)bh * 2048 + i];
    __syncthreads();
    {
        const int qi = tid & 255, par = tid >> 8;
        float qv[64];
#pragma unroll
        for (int c8 = 0; c8 < 8; ++c8) { const u32x4 v = *(const LAS u32x4*)(L + MG_QS + qi * 144 + c8 * 16);
#pragma unroll
            for (int e = 0; e < 4; ++e) { qv[c8 * 8 + 2 * e] = __uint_as_float(v[e] << 16); qv[c8 * 8 + 2 * e + 1] = __uint_as_float(v[e] & 0xffff0000u); } }
        float v1 = -INFINITY, v2 = -INFINITY, v3 = -INFINITY; int i1 = -1, i2 = -1, i3 = -1;
        for (int n = par; n < c; n += 2) { float g0 = 0.f, g1 = 0.f, g2 = 0.f, g3 = 0.f;
#pragma unroll
            for (int d4 = 0; d4 < 16; ++d4) { const f32x4 kb = *(const LAS f32x4*)(KB + n * 64 + d4 * 4); g0 += qv[4 * d4] * kb.x; g1 += qv[4 * d4 + 1] * kb.y; g2 += qv[4 * d4 + 2] * kb.z; g3 += qv[4 * d4 + 3] * kb.w; }
            const float g = (g0 + g1) + (g2 + g3);
            if (g > v1) { v3 = v2; i3 = i2; v2 = v1; i2 = i1; v1 = g; i1 = n; } else if (g > v2) { v3 = v2; i3 = i2; v2 = g; i2 = n; } else if (g > v3) { v3 = g; i3 = n; } }
        LAS float* TP = (LAS float*)(L + MG_TOP);
        if (par == 1) { TP[qi * 6 + 0] = v1; TP[qi * 6 + 1] = v2; TP[qi * 6 + 2] = v3; TP[qi * 6 + 3] = __int_as_float(i1); TP[qi * 6 + 4] = __int_as_float(i2); TP[qi * 6 + 5] = __int_as_float(i3); }
        __syncthreads();
        if (par == 0) {
#pragma unroll
            for (int k = 0; k < 3; ++k) { const float g = TP[qi * 6 + k]; const int n = __float_as_int(TP[qi * 6 + 3 + k]);
                if (n >= 0) { const bool b1 = g > v1 || (g == v1 && n < i1), b2 = g > v2 || (g == v2 && n < i2), b3 = g > v3 || (g == v3 && n < i3);
                    if (b1) { v3 = v2; i3 = i2; v2 = v1; i2 = i1; v1 = g; i1 = n; } else if (b2) { v3 = v2; i3 = i2; v2 = g; i2 = n; } else if (b3) { v3 = g; i3 = n; } } }
            const unsigned s4 = (unsigned)(i1 & 255) | ((unsigned)(i2 & 255) << 8) | ((unsigned)(i3 & 255) << 16) | 0xff000000u;
            SEL[qi] = s4; SELG[(size_t)(q0 + qi) * 4 + h] = s4;
        }
    }
    __syncthreads();
    for (int n = wave; n < c; n += 8) { int base = 0; unsigned char* lp = LISTG + ((size_t)(bh * 32 + c) * 32 + n) * 256;
#pragma unroll
        for (int ck = 0; ck < 4; ++ck) { const int q = ck * 64 + lane; const unsigned s4 = SEL[q]; const bool f = (s4 & 255u) == (unsigned)n || ((s4 >> 8) & 255u) == (unsigned)n || ((s4 >> 16) & 255u) == (unsigned)n;
            const unsigned long long bal = __ballot(f); const int pos = base + __popcll(bal & ((1ull << lane) - 1ull)); if (f) lp[pos] = (unsigned char)q; base += __popcll(bal); }
        if (lane == 0) CNTG[(bh * 32 + c) * 32 + n] = base; }
}
constexpr int KV_KL = 0, KV_VL = 36864, KV_PRE = KV_VL + 64 * 528;
DI void kv_tile(const LAS unsigned char* KL, const LAS unsigned char* VL, const bf16x8 (&qf)[2], int nsteps, bool causal, int qloc, int fr, int fq, f32x4 (&O)[4], float& m_out, float& l_out) {
    const float sc2 = 0.125f * 1.44269504089f;
    f32x4 s[16];
    const LAS unsigned char* kr0 = KL + (8 * (fr >> 2) + (fr & 3)) * 144 + fq * 16;
#pragma unroll
    for (int s8 = 0; s8 < 8; ++s8)
#pragma unroll
        for (int j = 0; j < 2; ++j) { f32x4 acc = (f32x4){0.f, 0.f, 0.f, 0.f};
#pragma unroll
            for (int ks = 0; ks < 2; ++ks) { const bf16x8 a = *(const LAS bf16x8*)(kr0 + (32 * s8 + 4 * j) * 144 + 64 * ks); acc = MFMA16(a, qf[ks], acc); }
            s[2 * s8 + j] = (s8 < nsteps) ? acc : (f32x4){-INFINITY, -INFINITY, -INFINITY, -INFINITY}; }
    if (causal) {
#pragma unroll
        for (int t = 0; t < 16; ++t)
#pragma unroll
            for (int r = 0; r < 4; ++r) { const int key = 32 * (t >> 1) + 8 * fq + 4 * (t & 1) + r; s[t][r] = key <= qloc ? s[t][r] : -INFINITY; } }
    float m = -INFINITY;
#pragma unroll
    for (int t = 0; t < 16; ++t) m = fmaxf(m, fmaxf(fmaxf(s[t][0], s[t][1]), fmaxf(s[t][2], s[t][3])));
    m = fmaxf(m, __shfl_xor(m, 16)); m = fmaxf(m, __shfl_xor(m, 32));
    const float mb = -m * sc2; float l = 0.f;
#pragma unroll
    for (int t = 0; t < 16; ++t)
#pragma unroll
        for (int r = 0; r < 4; ++r) { const float p = __builtin_amdgcn_exp2f(fmaf(s[t][r], sc2, mb)); s[t][r] = p; l += p; }
    l += __shfl_xor(l, 16); l += __shfl_xor(l, 32);
#pragma unroll
    for (int dt = 0; dt < 4; ++dt) O[dt] = (f32x4){0.f, 0.f, 0.f, 0.f};
    const LAS unsigned char* vr0 = VL + fr * 528 + fq * 16;
#pragma unroll
    for (int s8 = 0; s8 < 8; ++s8) {
        u32x4 pw; pw.x = cvt_pk_bf16(s[2 * s8][0], s[2 * s8][1]); pw.y = cvt_pk_bf16(s[2 * s8][2], s[2 * s8][3]); pw.z = cvt_pk_bf16(s[2 * s8 + 1][0], s[2 * s8 + 1][1]); pw.w = cvt_pk_bf16(s[2 * s8 + 1][2], s[2 * s8 + 1][3]);
        const bf16x8 pb = __builtin_bit_cast(bf16x8, pw);
#pragma unroll
        for (int dt = 0; dt < 4; ++dt) { const bf16x8 a = *(const LAS bf16x8*)(vr0 + (16 * dt) * 528 + 64 * s8); O[dt] = MFMA16(a, pb, O[dt]); } }
    m_out = m; l_out = l;
}
DI void kv_store(bf16_t* OPG, float* MLG, size_t row, int h, int slot, const f32x4 (&O)[4], float m, float l, int fq) {
    const float inv = 1.0f / l; const size_t base = ((row * 4 + h) * 4 + slot);
#pragma unroll
    for (int dt = 0; dt < 4; ++dt) { u32x2 w; w.x = cvt_pk_bf16(O[dt][0] * inv, O[dt][1] * inv); w.y = cvt_pk_bf16(O[dt][2] * inv, O[dt][3] * inv); *(u32x2*)(OPG + base * 64 + 16 * dt + 4 * fq) = w; }
    if (fq == 0) { MLG[base * 2] = m; MLG[base * 2 + 1] = l; }
}
DI void moba_kv_unit(const Frame& F, const bf16_t* Pb, const bf16_t* VT, const unsigned* SELG, const unsigned char* LISTG, const int* CNTG, bf16_t* OPG, float* MLG, int bl, int h, int n, int part, int nparts) {
    int lane_ = F.lane; LAUNDER_V(lane_);
    const int lane = lane_, wave = F.wave, tid = wave * 64 + lane, fr = lane & 15, fq = lane >> 4;
    LAS unsigned char* L = F.lds; LAS int* PRE = (LAS int*)(L + KV_PRE);
    const int bh = bl * 4 + h;
    const bf16_t* Kg = Pb + (size_t)(bl * SEQ + n * 256) * PLD + PC_MK + h * 64;
    const bf16_t* Vg = VT + (size_t)(bh * 64) * SEQ + n * 256;
    const bf16_t* Qg = Pb + (size_t)(bl * SEQ) * PLD + PC_MQ + h * 64;
    __syncthreads();
#pragma unroll
    for (int i = 0; i < 4; ++i) { const int q = tid + 512 * i, r = q >> 3, c8 = q & 7; *(LAS u32x4*)(L + KV_KL + r * 144 + c8 * 16) = *(const u32x4*)(Kg + (size_t)r * PLD + c8 * 8); }
#pragma unroll
    for (int i = 0; i < 4; ++i) { const int q = tid + 512 * i, d = q >> 5, c16 = q & 31; *(LAS u32x4*)(L + KV_VL + d * 528 + c16 * 16) = *(const u32x4*)(Vg + (size_t)d * SEQ + c16 * 8); }
    if (wave == 0) {
        const int cq = lane; int cnt = (cq > n && cq < 32) ? CNTG[(bh * 32 + cq) * 32 + n] : 0; int inc = cnt;
#pragma unroll
        for (int o = 1; o < 32; o <<= 1) { const int up = __shfl_up(inc, o); if (lane >= o) inc += up; }
        if (lane < 32) PRE[lane] = inc - cnt; if (lane == 31) PRE[32] = inc;
    }
    __syncthreads();
    const int T = PRE[32], nsp = (T + 15) >> 4, ntl = nsp + 16;
    for (int tt = part + nparts * wave; tt < ntl; tt += nparts * 8) {
        f32x4 O[4]; float m, l; bf16x8 qf[2];
        if (tt < nsp) {
            const int e = 16 * tt + fr; const bool valid = e < T; const int ee = valid ? e : 0;
            int cq = 0;
#pragma unroll
            for (int i = 1; i < 32; ++i) cq += (PRE[i] <= ee) ? 1 : 0;
            const int q = LISTG[((size_t)(bh * 32 + cq) * 32 + n) * 256 + (ee - PRE[cq])];
            const int tok = cq * 256 + q; const size_t row = (size_t)(bl * SEQ + tok);
#pragma unroll
            for (int ks = 0; ks < 2; ++ks) qf[ks] = *(const bf16x8*)(Qg + (size_t)tok * PLD + fq * 8 + 32 * ks);
            kv_tile(L + KV_KL, L + KV_VL, qf, 8, false, 0, fr, fq, O, m, l);
            const unsigned s4 = SELG[row * 4 + h]; const int slot = (s4 & 255u) == (unsigned)n ? 0 : (((s4 >> 8) & 255u) == (unsigned)n ? 1 : 2);
            if (valid) kv_store(OPG, MLG, row, h, slot, O, m, l, fq);
        } else {
            const int to = tt - nsp, qloc = 16 * to + fr, tok = n * 256 + qloc; const size_t row = (size_t)(bl * SEQ + tok);
#pragma unroll
            for (int ks = 0; ks < 2; ++ks) qf[ks] = *(const bf16x8*)(Qg + (size_t)tok * PLD + fq * 8 + 32 * ks);
            kv_tile(L + KV_KL, L + KV_VL, qf, (16 * to + 15) / 32 + 1, true, qloc, fr, fq, O, m, l);
            kv_store(OPG, MLG, row, h, 3, O, m, l, fq);
        }
    }
}
DI void moba_combine(const Frame& F, const unsigned* SELG, const bf16_t* OPG, const float* MLG, bf16_t* BR) {
    int lane_ = F.lane; LAUNDER_V(lane_);
    const int lane = lane_, sub = lane & 7, gw = F.blk * 8 + F.wave, NGW = F.G * 8;
    const float sc2 = 0.125f * 1.44269504089f;
    for (int it = gw; it < NG * 4 / 8; it += NGW) { const size_t idx = (size_t)it * 8 + (lane >> 3); const size_t row = idx >> 2; const int h = (int)(idx & 3);
        const unsigned s4 = SELG[idx]; float mk[4], lk[4]; float M = -INFINITY;
#pragma unroll
        for (int k = 0; k < 4; ++k) { const bool ok = (k == 3) || (((s4 >> (8 * k)) & 255u) != 255u); const f32x2 ml = *(const f32x2*)(MLG + (idx * 4 + k) * 2); mk[k] = ok ? ml.x : -INFINITY; lk[k] = ok ? ml.y : 0.f; M = fmaxf(M, mk[k]); }
        float o[8]; float den = 0.f;
#pragma unroll
        for (int e = 0; e < 8; ++e) o[e] = 0.f;
#pragma unroll
        for (int k = 0; k < 4; ++k) { const bool ok = (k == 3) || (((s4 >> (8 * k)) & 255u) != 255u); const float w = ok ? lk[k] * __builtin_amdgcn_exp2f((mk[k] - M) * sc2) : 0.f; den += w;
            u32x4 pv = *(const u32x4*)(OPG + (idx * 4 + k) * 64 + sub * 8);
            if (!ok) pv = (u32x4){0u, 0u, 0u, 0u};
#pragma unroll
            for (int e = 0; e < 4; ++e) { o[2 * e] += w * __uint_as_float(pv[e] << 16); o[2 * e + 1] += w * __uint_as_float(pv[e] & 0xffff0000u); } }
        const float inv = 1.0f / den; u32x4 wv;
#pragma unroll
        for (int e = 0; e < 4; ++e) wv[e] = cvt_pk_bf16(o[2 * e] * inv, o[2 * e + 1] * inv);
        *(u32x4*)(BR + row * 1024 + 256 + h * 64 + sub * 8) = wv; }
}
__host__ __device__ constexpr int kv_parts(int n) { return n == 0 ? 3 : (n < 8 ? 2 : 1); }
__host__ __device__ constexpr int kv_items_before(int n) { int s = 0; for (int i = 0; i < n; ++i) s += kv_parts(i) * GB * 4; return s; }
constexpr int KV_NITEMS = kv_items_before(32);

constexpr int XA_K = 0;
constexpr int XA_VT = 69632;
DI void xattn_wg(const Frame& F, const bf16_t* KVM, const bf16_t* QX, bf16_t* AO, int w) {
    int lane_ = F.lane; LAUNDER_V(lane_);
    const int lane = lane_, wave = F.wave, tid = wave * 64 + lane, fr = lane & 15, fq = lane >> 4;
    const int b = w >> 5, h = (w >> 3) & 3, qpart = w & 7;
    LAS unsigned char* L = F.lds;
    __syncthreads();
#pragma unroll
    for (int i = 0; i < 8; ++i) { const int q = tid + 512 * i, m = q >> 4, c16 = q & 15; *(LAS u32x4*)(L + XA_K + m * 272 + c16 * 16) = *(const u32x4*)(KVM + (size_t)(b * 256 + m) * 1024 + h * 128 + c16 * 8); }
#pragma unroll
    for (int i = 0; i < 8; ++i) { const int q = tid + 512 * i, m = q & 255, c16 = q >> 8; const u32x4 v = *(const u32x4*)(KVM + (size_t)(b * 256 + m) * 1024 + 512 + h * 128 + c16 * 8);
#pragma unroll
        for (int e = 0; e < 4; ++e) { *(LAS bf16_t*)(L + XA_VT + (c16 * 8 + 2 * e) * 528 + m * 2) = (bf16_t)(v[e] & 0xffffu); *(LAS bf16_t*)(L + XA_VT + (c16 * 8 + 2 * e + 1) * 528 + m * 2) = (bf16_t)(v[e] >> 16); } }
    __syncthreads();
    const float sc2 = 0.08838834764831845f * 1.44269504089f;
    for (int rtile = 0; rtile < 8; ++rtile) {
        const size_t tok = (size_t)b * SEQ + qpart * 1024 + wave * 128 + rtile * 16 + fr;
        bf16x8 qf[4];
#pragma unroll
        for (int ks = 0; ks < 4; ++ks) qf[ks] = *(const bf16x8*)(QX + tok * 512 + h * 128 + fq * 8 + 32 * ks);
        f32x4 s[16]; float mx = -INFINITY;
#pragma unroll
        for (int kt = 0; kt < 16; ++kt) { s[kt] = (f32x4){0.f, 0.f, 0.f, 0.f};
#pragma unroll
            for (int ks = 0; ks < 4; ++ks) { const bf16x8 a = *(const LAS bf16x8*)(L + XA_K + (16 * kt + fr) * 272 + (fq * 8 + 32 * ks) * 2); s[kt] = MFMA16(a, qf[ks], s[kt]); }
            mx = fmaxf(mx, fmaxf(fmaxf(s[kt][0], s[kt][1]), fmaxf(s[kt][2], s[kt][3]))); __builtin_amdgcn_sched_barrier(0); }
        mx = fmaxf(mx, __shfl_xor(mx, 16)); mx = fmaxf(mx, __shfl_xor(mx, 32));
        float l = 0.f;
#pragma unroll
        for (int kt = 0; kt < 16; ++kt)
#pragma unroll
            for (int r = 0; r < 4; ++r) { const float p = __builtin_amdgcn_exp2f((s[kt][r] - mx) * sc2); s[kt][r] = p; l += p; }
        l += __shfl_xor(l, 16); l += __shfl_xor(l, 32); const float inv = 1.0f / l;
        f32x4 O[8];
#pragma unroll
        for (int dt = 0; dt < 8; ++dt) O[dt] = (f32x4){0.f, 0.f, 0.f, 0.f};
#pragma unroll
        for (int s8 = 0; s8 < 8; ++s8) {
            u32x4 pw; pw.x = pk2(s[2 * s8][0], s[2 * s8][1]); pw.y = pk2(s[2 * s8][2], s[2 * s8][3]); pw.z = pk2(s[2 * s8 + 1][0], s[2 * s8 + 1][1]); pw.w = pk2(s[2 * s8 + 1][2], s[2 * s8 + 1][3]);
            const bf16x8 pb = __builtin_bit_cast(bf16x8, pw);
#pragma unroll
            for (int dt = 0; dt < 8; ++dt) {
                const u32x2 lo = *(const LAS u32x2*)(L + XA_VT + (16 * dt + fr) * 528 + (32 * s8 + 4 * fq) * 2), hi = *(const LAS u32x2*)(L + XA_VT + (16 * dt + fr) * 528 + (32 * s8 + 16 + 4 * fq) * 2);
                const u32x4 av = (u32x4){lo.x, lo.y, hi.x, hi.y};
                O[dt] = MFMA16(__builtin_bit_cast(bf16x8, av), pb, O[dt]); }
            __builtin_amdgcn_sched_barrier(0);
        }
#pragma unroll
        for (int dt = 0; dt < 8; ++dt) { u32x2 wv; wv.x = pk2(O[dt][0] * inv, O[dt][1] * inv); wv.y = pk2(O[dt][2] * inv, O[dt][3] * inv);
            *(u32x2*)(AO + tok * 512 + h * 128 + 16 * dt + 4 * fq) = wv; }
    }
    __syncthreads();
}
DI void moe_route1(const Frame& F, const bf16_t* x, const float* Wr, int* TE, float* TW, float* RR, int* CNT) {
    const int tid = F.tid, lane = F.lane, wave = F.wave;
    LAS float* WL = (LAS float*)F.lds; LAS int* HC = (LAS int*)(F.lds + 32768);
    __syncthreads();
    for (int i = tid; i < 8 * 1024 / 4; i += 512) ((LAS f32x4*)WL)[i] = ((const f32x4*)Wr)[i];
    for (int tb = F.blk; tb < NTOK / 256; tb += F.G) {
        if (tid < 8) HC[tid] = 0;
        __syncthreads();
        u32x2 vn[4];
        { const u32x2* xr = (const u32x2*)(x + (size_t)(tb * 256 + wave * 32) * 1024) + lane;
#pragma unroll
          for (int j = 0; j < 4; ++j) vn[j] = xr[64 * j]; }
        for (int rr = 0; rr < 32; ++rr) { const int row = tb * 256 + wave * 32 + rr;
            f32x4 v[4]; float ss = 0.f;
#pragma unroll
            for (int j = 0; j < 4; ++j) v[j] = (f32x4){__uint_as_float(vn[j].x << 16), __uint_as_float(vn[j].x & 0xffff0000u), __uint_as_float(vn[j].y << 16), __uint_as_float(vn[j].y & 0xffff0000u)};
            { const u32x2* xr = (const u32x2*)(x + (size_t)(rr + 1 < 32 ? row + 1 : row) * 1024) + lane;
#pragma unroll
              for (int j = 0; j < 4; ++j) vn[j] = xr[64 * j]; }
#pragma unroll
            for (int j = 0; j < 4; ++j) ss += (v[j].x * v[j].x + v[j].y * v[j].y) + (v[j].z * v[j].z + v[j].w * v[j].w);
            ss = wave_sum(ss); const float r = rsqrtf(ss * (1.0f / 1024.0f) + RMS_EPS);
            float lg[8];
#pragma unroll
            for (int e = 0; e < 8; ++e) { float a = 0.f;
#pragma unroll
                for (int j = 0; j < 4; ++j) { const f32x4 w = *(const LAS f32x4*)(WL + e * 1024 + 4 * lane + 256 * j); a += (v[j].x * w.x + v[j].y * w.y) + (v[j].z * w.z + v[j].w * w.w); }
                lg[e] = wave_sum(a) * r; }
            int e0 = 0; float l0 = lg[0];
#pragma unroll
            for (int e = 1; e < 8; ++e) if (lg[e] > l0) { l0 = lg[e]; e0 = e; }
            int e1 = -1; float l1 = -INFINITY;
#pragma unroll
            for (int e = 0; e < 8; ++e) if (e != e0 && lg[e] > l1) { l1 = lg[e]; e1 = e; }
            const float w0 = 1.0f / (1.0f + __expf(l1 - l0));
            if (lane == 0) { TE[2 * (size_t)row] = e0; TE[2 * (size_t)row + 1] = e1; TW[2 * (size_t)row] = w0; TW[2 * (size_t)row + 1] = 1.0f - w0; RR[row] = r;
                __hip_atomic_fetch_add(&HC[e0], 1, __ATOMIC_RELAXED, __HIP_MEMORY_SCOPE_WORKGROUP); __hip_atomic_fetch_add(&HC[e1], 1, __ATOMIC_RELAXED, __HIP_MEMORY_SCOPE_WORKGROUP); }
        }
        __syncthreads();
        if (tid < 8) CNT[tb * 8 + tid] = HC[tid];
        __syncthreads();
    }
}
DI void moe_bases(const Frame& F, const int* CNT, int tb, LAS int* OUT  ) {
    const int tid = F.tid; LAS int* SC = (LAS int*)(F.lds + 40960);
    __syncthreads();
    { const int e = tid & 7, seg = tid >> 3; int all = 0, lt = 0;
#pragma unroll
      for (int q = 0; q < 4; ++q) { const int w = 4 * seg + q; const int c = CNT[w * 8 + e]; all += c; lt += (w < tb) ? c : 0; }
      SC[seg * 8 + e] = all; SC[512 + seg * 8 + e] = lt; }
    __syncthreads();
    if (tid < 8) { int all = 0, lt = 0; for (int s = 0; s < 64; ++s) { all += SC[s * 8 + tid]; lt += SC[512 + s * 8 + tid]; } SC[1024 + tid] = (all + 255) >> 8; OUT[16 + tid] = lt; }
    __syncthreads();
    if (tid == 0) { int b = 0; for (int e = 0; e < 8; ++e) { OUT[e] = b; b += SC[1024 + e]; } OUT[8] = b; }
    __syncthreads();
}
DI void moe_route2(const Frame& F, const int* TE, const float* RR, const int* CNT, const bf16_t* xb, int* POS, bf16_t* XP, float* RP) {
    const int tid = F.tid, lane = F.lane, wave = F.wave;
    LAS int* MB = (LAS int*)(F.lds + 49152);
    LAS int* WT = (LAS int*)(F.lds + 49152 + 256);
    LAS int* PL = (LAS int*)(F.lds + 49152 + 512);
    for (int tb = F.blk; tb < NTOK / 256; tb += F.G) {
        moe_bases(F, CNT, tb, MB);
        int e0 = -1, e1 = -1; const int tok = tb * 256 + tid;
        if (tid < 256) { e0 = TE[2 * (size_t)tok]; e1 = TE[2 * (size_t)tok + 1]; }
        int pw[2] = {0, 0};
#pragma unroll
        for (int e = 0; e < 8; ++e) { const bool f = (e0 == e) || (e1 == e); const unsigned long long bal = __ballot(f);
            const int before = __popcll(bal & ((1ull << lane) - 1ull)); if (lane == 0 && wave < 4) WT[wave * 8 + e] = __popcll(bal);
            if (e0 == e) pw[0] = before; if (e1 == e) pw[1] = before; }
        __syncthreads();
        if (tid < 256) {
#pragma unroll
            for (int sl = 0; sl < 2; ++sl) { const int e = sl ? e1 : e0; int rank = pw[sl]; for (int w2 = 0; w2 < wave; ++w2) rank += WT[w2 * 8 + e];
                const int pos = MB[e] * 256 + MB[16 + e] + rank; PL[2 * tid + sl] = pos; POS[2 * (size_t)tok + sl] = pos; RP[pos] = RR[tok]; } }
        __syncthreads();
        for (int pr0 = wave * 64; pr0 < wave * 64 + 64; pr0 += 8) { u32x4 ra[8], rb[8];
#pragma unroll
            for (int q = 0; q < 8; ++q) { const int t2 = (pr0 + q) >> 1; const u32x4* src = (const u32x4*)(xb + (size_t)(tb * 256 + t2) * 1024); ra[q] = src[lane]; rb[q] = src[lane + 64]; }
#pragma unroll
            for (int q = 0; q < 8; ++q) { const int pos = PL[pr0 + q]; u32x4* dst = (u32x4*)(XP + (size_t)pos * 1024); dst[lane] = ra[q]; dst[lane + 64] = rb[q]; } }
        __syncthreads();
    }
}
DI void moe_final(const Frame& F, const bf16_t* xb, float* out, const bf16_t* Y, const int* POS, const float* TW, const float* fg) {
    const int lane = F.lane, gw = F.blk * 8 + F.wave, NGW = F.G * 8;
    int pn0 = 0, pn1 = 0; float wn0 = 0.f, wn1 = 0.f;
    if (gw < NTOK) { pn0 = POS[2 * (size_t)gw]; pn1 = POS[2 * (size_t)gw + 1]; wn0 = TW[2 * (size_t)gw]; wn1 = TW[2 * (size_t)gw + 1]; }
    for (int row = gw; row < NTOK; row += NGW) {
        const int p0 = pn0, p1 = pn1; const float w0 = wn0, w1 = wn1;
        { const size_t rn = (size_t)(row + NGW < NTOK ? row + NGW : row); pn0 = POS[2 * rn]; pn1 = POS[2 * rn + 1]; wn0 = TW[2 * rn]; wn1 = TW[2 * rn + 1]; }
        f32x4* xr = (f32x4*)(out + (size_t)row * 1024) + lane; const u32x2* xs = (const u32x2*)(xb + (size_t)row * 1024) + lane; const u32x2* y0 = (const u32x2*)(Y + (size_t)p0 * 1024) + lane; const u32x2* y1 = (const u32x2*)(Y + (size_t)p1 * 1024) + lane;
        f32x4 v[4]; float ss = 0.f; u32x2 ya[4], yb[4];
#pragma unroll
        for (int j = 0; j < 4; ++j) { const u32x2 xv = xs[64 * j]; v[j] = (f32x4){__uint_as_float(xv.x << 16), __uint_as_float(xv.x & 0xffff0000u), __uint_as_float(xv.y << 16), __uint_as_float(xv.y & 0xffff0000u)}; ya[j] = y0[64 * j]; yb[j] = y1[64 * j]; }
#pragma unroll
        for (int j = 0; j < 4; ++j) { const u32x2 a = ya[j], b = yb[j];
            v[j].x += w0 * __uint_as_float(a.x << 16) + w1 * __uint_as_float(b.x << 16); v[j].y += w0 * __uint_as_float(a.x & 0xffff0000u) + w1 * __uint_as_float(b.x & 0xffff0000u);
            v[j].z += w0 * __uint_as_float(a.y << 16) + w1 * __uint_as_float(b.y << 16); v[j].w += w0 * __uint_as_float(a.y & 0xffff0000u) + w1 * __uint_as_float(b.y & 0xffff0000u);
            ss += (v[j].x * v[j].x + v[j].y * v[j].y) + (v[j].z * v[j].z + v[j].w * v[j].w); }
        ss = wave_sum(ss); const float r = rsqrtf(ss * (1.0f / 1024.0f) + RMS_EPS);
#pragma unroll
        for (int j = 0; j < 4; ++j) { const f32x4 g = ((const f32x4*)fg)[lane + 64 * j]; xr[64 * j] = (f32x4){v[j].x * r * g.x, v[j].y * r * g.y, v[j].z * r * g.z, v[j].w * r * g.w}; }
    }
}
constexpr int SCAN_CUT = 32;
__global__ void __launch_bounds__(512, 2) mk_fwd(Params prm) {
    extern __shared__ __attribute__((aligned(16))) unsigned char lds_raw[];
    Frame F0;
    F0.lds = (LAS unsigned char*)lds_raw;
    F0.tid = threadIdx.x; F0.lane = F0.tid & 63; F0.wave = __builtin_amdgcn_readfirstlane(F0.tid >> 6); F0.G = gridDim.x; F0.blk = blockIdx.x;
    F0.ws = prm.ws;
    volatile LAS unsigned* MISC = (volatile LAS unsigned*)(F0.lds + LDS_MISC);
    if (F0.tid < 64) MISC[F0.tid] = 0u;
    __syncthreads();
    XcdBarrier bar; bar.bar = (unsigned*)(prm.ws + WS_CTL); bar.x = 0; bar.st = MISC;
#if MK_SINGLE
    bar = xcd_barrier_post((unsigned*)(prm.ws + WS_CTL), MISC);
#endif
    const int lo = prm.ph_lo, hi = prm.ph_hi; int ph = 0;
#ifndef DBG_REP_CLASS
#define DBG_REP_CLASS 0
#endif
#define REPEAT(cls) for (int rep_ = 0; rep_ < ((DBG_REP_CLASS == (cls)) ? 2 : 1); ++rep_)
#define REPBAR(cls) do { if (DBG_REP_CLASS == (cls) && rep_ == 0) xcd_barrier(bar); } while (0)
#define ACTIVE() (ph >= lo && ph < hi)
#define SEAM() do { if (ph + 1 < hi) xcd_barrier(bar); } while (0)
    LAS unsigned char* glds = F0.lds;
#define PTRS() unsigned char* ws = prm.ws; asm volatile("" : "+s"(ws)); Frame F = F0; { int w_ = F0.wave; asm volatile("" : "+s"(w_)); int l_ = (int)__builtin_amdgcn_mbcnt_hi(~0u, __builtin_amdgcn_mbcnt_lo(~0u, 0u)); asm volatile("" : "+v"(l_)); F.wave = w_; F.lane = l_; F.tid = w_ * 64 + l_; } F.ws = ws; unsigned char* ar = ws + WS_ARENA; (void)ar; \
    bf16_t* xb = (bf16_t*)(ws + WS_XB); float* ssq = (float*)(ws + WS_SSQ); const float* rope = (const float*)(ws + WS_ROPE); float* xout = prm.out; (void)xb; (void)ssq; (void)rope; (void)xout; \
    unsigned char* lw = ws + WS_LW + (size_t)layer * LW_STRIDE; (void)lw; const float* sm = (const float*)(ws + WS_SMALL); (void)sm
#define GPTRS() PTRS(); const bf16_t* xbg = xb + (size_t)grp * NG * 1024; const float* ssqg = ssq + (size_t)grp * NG * 16; const float* ropeg = rope + (size_t)grp * NG * 16; \
    bf16_t* Pb = (bf16_t*)(ar + AR_P); float* BA = (float*)(ar + AR_BA); bf16_t* BR = (bf16_t*)(ar + AR_BR); float* KBAR = (float*)(ar + AR_KBAR); bf16_t* VT = (bf16_t*)(ar + AR_VT); \
    bf16_t* QD = (bf16_t*)(ar + AR_QD); bf16_t* MM = (bf16_t*)(ar + AR_KDT); bf16_t* NT = (bf16_t*)(ar + AR_NT); bf16_t* SG = (bf16_t*)(ar + AR_SG); bf16_t* ZB = (bf16_t*)(ar + AR_ZB); unsigned* SELG = (unsigned*)(ar + AR_SELG); int* CNTG = (int*)(ar + AR_CNTG); unsigned char* LISTG = (unsigned char*)(ar + AR_LISTG); bf16_t* OPG = (bf16_t*)(ar + AR_OPG); float* MLG = (float*)(ar + AR_MLG); bf16_t* WN = (bf16_t*)(ar + AR_WN); bf16_t* UT = (bf16_t*)(ar + AR_UT); bf16_t* AQK = (bf16_t*)(ar + AR_AQK); float* GL = (float*)(ar + AR_GL); \
    bf16_t* MG = (bf16_t*)(ar + AR_MERGED); \
    (void)xbg; (void)ssqg; (void)ropeg; (void)Pb; (void)BA; (void)BR; (void)KBAR; (void)VT; (void)QD; (void)MM; (void)NT; (void)SG; (void)ZB; (void)SELG; (void)CNTG; (void)LISTG; (void)OPG; (void)MLG; (void)WN; (void)UT; (void)AQK; (void)GL; (void)MG
#define MPTRS() PTRS(); int* TE = (int*)(ar + AR_TE); float* TW = (float*)(ar + AR_TW); float* RR = (float*)(ar + AR_RR); int* POS = (int*)(ar + AR_POS); int* CNT = (int*)(ar + AR_CNT); \
    bf16_t* XP = (bf16_t*)(ar + AR_XP); float* RP = (float*)(ar + AR_RP); bf16_t* HM = (bf16_t*)(ar + AR_HM); (void)TE; (void)TW; (void)RR; (void)POS; (void)CNT; (void)XP; (void)RP; (void)HM

    if (ACTIVE()) { REPEAT(1) { const int layer = 0; PTRS();
        const __attribute__((address_space(4))) Params* kp = (const __attribute__((address_space(4))) Params*)__builtin_amdgcn_kernarg_segment_ptr(); asm volatile("" : "+s"(kp));
        Params lp;
#pragma unroll
        for (int i = 0; i < 27; ++i) lp.in[i] = kp->in[i];
        lp.out = nullptr; lp.ws = ws; lp.ph_lo = 0; lp.ph_hi = 0; lp.pad0 = 0; lp.pad1 = 0;
        phase_prologue(F, lp); REPBAR(1); } SEAM(); } ++ph;
    for (int layer = 0; layer < 2; ++layer) {
        for (int grp = 0; grp < NGRP; ++grp) {
            if (ACTIVE()) { REPEAT(3) {
                GPTRS();
                pg8::Gemm g{xbg, (const bf16_t*)(lw + LW_WIN), 1024, 1024};
                pg8::SchedPlain S; S.init(NG, 3072, 1024, 1024, 1024, F.G, F.blk);
                pg8::build_rtab(glds, S, ssqg, nullptr, F.tid);
                pg8::EpiScaleBf16 E{Pb, PLD, ssqg, 0, ZB, 512, 10, (const LAS float*)(glds + pg8::RTAB_OFF)};
                pg8::gemm_phase(glds, g, S, E, F.wave);
                ba_tiles(F, xbg, (const bf16_t*)(lw + LW_WBA), ssqg, BA);
                REPBAR(3); }
                SEAM();
            } ++ph;
            if (ACTIVE()) {
                GPTRS();
                REPEAT(4) {
                for (int u = F.blk; u < 1024; u += F.G)
                    prep_dn(F, Pb, BA, sm + SM_CONVW + (size_t)layer * 4 * 1536, sm + SM_ALOG + layer * 8, sm + SM_DTB + layer * 8, QD, MM, NT, WN, UT, AQK, GL, u);
#ifndef DBG_RPOOL
#define DBG_RPOOL 1
#endif
                for (int rpP = 0; rpP < DBG_RPOOL; ++rpP) for (int u = F.blk; u < NG / 64; u += F.G) prep_pool(F, Pb, BR, u);
                REPBAR(4); }
#ifndef DBG_RMOBA
#define DBG_RMOBA 1
#endif
                for (int rpM = 0; rpM < DBG_RMOBA; ++rpM) for (int u = F.blk; u < GB * 64; u += F.G) prep_moba(F, Pb, ropeg, KBAR, VT, u);
                SEAM();
            } ++ph;
            if (ACTIVE()) { REPEAT(18) {
                GPTRS();
                if (F.blk < GB * 8) { if (MK_SINGLE) dn_scan(F, F.blk, MM, NT, SG, 0, SCAN_CUT); }
                else { const int nw = F.G - GB * 8;
                    for (int u = F.blk - GB * 8; u < GB * 4 * 32; u += nw) { const int c = 31 - u / (GB * 4), bh = u % (GB * 4); moba_gate_unit(F, Pb, KBAR, SELG, LISTG, CNTG, bh >> 2, bh & 3, c); } }
                REPBAR(18); }
                SEAM();
            } ++ph;
            if (ACTIVE()) { REPEAT(5) {
                GPTRS();
                if (F.blk < GB * 8) { for (int r2_ = 0; r2_ < ((DBG_REP_CLASS == 16) ? 2 : 1); ++r2_) dn_scan(F, F.blk, MM, NT, SG, MK_SINGLE ? SCAN_CUT : 0, 127, r2_ == 0); }
                else { const int nw = F.G - GB * 8, wq = F.blk - GB * 8;
                    for (int r2_ = 0; r2_ < ((DBG_REP_CLASS == 17) ? 2 : 1); ++r2_)
                    for (int rd = 0; rd * nw < KV_NITEMS; ++rd) { const int i = rd * nw + ((rd & 1) ? nw - 1 - wq : wq); if (i >= KV_NITEMS) continue;
                        int n, part, bh;
                        if (i < 48) { n = 0; part = i >> 4; bh = i & 15; } else if (i < 272) { const int j = i - 48; n = 1 + (j >> 5); part = (j >> 4) & 1; bh = j & 15; } else { const int j = i - 272; n = 8 + (j >> 4); part = 0; bh = j & 15; }
                        moba_kv_unit(F, Pb, VT, SELG, LISTG, CNTG, OPG, MLG, bh >> 2, bh & 3, n, part, n == 0 ? 3 : (n < 8 ? 2 : 1)); } }
                if (layer == 0 && grp == 0) {
                    __syncthreads();
                    pg8::Gemm gk{(const bf16_t*)(ws + WS_MEMN), (const bf16_t*)(ws + WS_LW + LW_WKV), 1024, 1024};
                    pg8::SchedKV Sk; Sk.c = F.blk - GB * 8; Sk.lstride = LW_STRIDE;
                    pg8::EpiScaleBf16 Ek{(bf16_t*)(ws + WS_KVM), 1024, nullptr, 0, nullptr, 0, 1 << 30, nullptr};
                    pg8::gemm_phase(glds, gk, Sk, Ek, F.wave); }
                REPBAR(5); }
                SEAM();
            } ++ph;
            if (ACTIVE()) { REPEAT(6) {
                GPTRS();
                pg8::Gemm g{(const bf16_t*)(ws + WS_X8 + (size_t)grp * NG * 1024), (const bf16_t*)(ws + WS_WG8 + (size_t)layer * 3072 * 1024), 1024, 1024};
                pg8::SchedPlain S; S.init(NG, 3072, 1024, 1024, 1024, F.G, F.blk, 1);
                moba_combine(F, SELG, OPG, MLG, BR);
                dn_out_pass(F, QD, WN, UT, AQK, SG, ZB, sm + SM_DNG + layer * 64, BR);
                pg8::build_rtab(glds, S, ssqg, nullptr, F.tid);
                pg8::EpiScaleBf16 E{Pb, PLD, ssqg, 1, nullptr, 0, 1 << 30, (const LAS float*)(glds + pg8::RTAB_OFF)};
                pg8::gemm_phase<pg8::EpiScaleBf16, pg8::SchedPlain, true>(glds, g, S, E, F.wave);
                REPBAR(6); }
                SEAM();
            } ++ph;
            if (ACTIVE()) { REPEAT(7) {
                GPTRS();
                pg8::Gemm g{BR, (const bf16_t*)(lw + LW_WCAT), 1024, 1024};
                pg8::SchedPlain S; S.init(NG, 1024, 1024, 1024, 1024, F.G, F.blk);
                pg8::EpiMerge E{Pb, MG};
                pg8::gemm_phase(glds, g, S, E, F.wave);
                REPBAR(7); }
                SEAM();
            } ++ph;
            if (ACTIVE()) { for (int rep_ = 0; rep_ < ((DBG_REP_CLASS == 8 && layer == 0) ? 2 : 1); ++rep_) {
                GPTRS();
                pg8::Gemm g{MG, (const bf16_t*)(lw + LW_WOUT), 1024, 1024};
                pg8::SchedPlain S; S.init(NG, 1024, 1024, 1024, 1024, F.G, F.blk);
                pg8::EpiResid E{xb + (size_t)grp * NG * 1024, ssq + (size_t)grp * NG * 16, ws + WS_X8 + (size_t)grp * NG * 1024};
                pg8::gemm_phase(glds, g, S, E, F.wave);
                REPBAR(8); }
                SEAM();
            } ++ph;
        }
        if (ACTIVE()) { REPEAT(9) {
            PTRS();
            pg8::Gemm g{xb, (const bf16_t*)(lw + LW_WQ), 1024, 1024};
            pg8::SchedPlain S; S.init(NTOK, 512, 1024, 1024, 1024, F.G, F.blk);
            pg8::build_rtab(glds, S, ssq, nullptr, F.tid);
            pg8::EpiScaleBf16 E{(bf16_t*)(ar + AR_QX), 512, ssq, 0, nullptr, 0, 1 << 30, (const LAS float*)(glds + pg8::RTAB_OFF)};
            pg8::gemm_phase(glds, g, S, E, F.wave);
            REPBAR(9); }
                SEAM();
        } ++ph;
        if (ACTIVE()) { REPEAT(10) {
            PTRS();
            for (int w = F.blk; w < 256; w += F.G) xattn_wg(F, (const bf16_t*)(ws + WS_KVM) + (size_t)layer * 2048 * 1024, (const bf16_t*)(ar + AR_QX), (bf16_t*)(ar + AR_AO), w);
            REPBAR(10); }
                SEAM();
        } ++ph;
        if (ACTIVE()) {
            PTRS();
            pg8::Gemm g{(const bf16_t*)(ar + AR_AO), (const bf16_t*)(lw + LW_WO), 512, 512};
            pg8::SchedPlain S; S.init(NTOK, 1024, 512, 512, 512, F.G, F.blk);
            pg8::EpiResid E{xb, ssq, ws + WS_X8};
            pg8::gemm_phase(glds, g, S, E, F.wave);
            SEAM();
        } ++ph;
        if (layer == 0) {
            if (ACTIVE()) { REPEAT(11) {
                PTRS();
                pg8::Gemm g{xb, (const bf16_t*)(ws + WS_WGU), 1024, 1024};
                pg8::SchedPlain S; S.init(NTOK, 2 * FF, 1024, 1024, 1024, F.G, F.blk);
                pg8::build_rtab(glds, S, ssq, nullptr, F.tid);
                pg8::EpiSwiglu E{(bf16_t*)(ar + AR_HID), FF, (const LAS float*)(glds + pg8::RTAB_OFF)};
                pg8::gemm_phase(glds, g, S, E, F.wave);
                REPBAR(11); }
                SEAM();
            } ++ph;
            if (ACTIVE()) {
                PTRS();
                pg8::Gemm g{(const bf16_t*)(ar + AR_HID), (const bf16_t*)(ws + WS_WD), FF, FF};
                pg8::SchedPlain S; S.init(NTOK, 1024, FF, FF, FF, F.G, F.blk);
                pg8::EpiResid E{xb, ssq, ws + WS_X8};
                pg8::gemm_phase(glds, g, S, E, F.wave);
                SEAM();
            } ++ph;
        } else {
            if (ACTIVE()) { REPEAT(12) { MPTRS(); moe_route1(F, xb, (const float*)(ws + WS_WR), TE, TW, RR, CNT); REPBAR(12); } SEAM(); } ++ph;
            if (ACTIVE()) { REPEAT(13) { MPTRS(); moe_route2(F, TE, RR, CNT, xb, POS, XP, RP); REPBAR(13); } SEAM(); } ++ph;
            if (ACTIVE()) { REPEAT(14) {
                MPTRS();
                LAS int* MB = (LAS int*)(F.lds + 49152); moe_bases(F, CNT, 0, MB);
                pg8::SchedMoe S;
#pragma unroll
                for (int e = 0; e < 9; ++e) S.pbase[e] = __builtin_amdgcn_readfirstlane(MB[e]);
                S.nN = 2 * EFF / 256; S.nt = 16; S.G = F.G; S.c = F.blk; S.astep = (size_t)256 * 1024 * 2; S.bstep = (size_t)256 * 1024 * 2; S.estep = (size_t)2 * EFF * 1024 * 2;
                __syncthreads();
                pg8::Gemm g{XP, (const bf16_t*)(ws + WS_WMGU), 1024, 1024};
                pg8::build_rtab(glds, S, nullptr, RP, F.tid);
                pg8::EpiSwiglu E{HM, EFF, (const LAS float*)(glds + pg8::RTAB_OFF)};
                pg8::gemm_phase(glds, g, S, E, F.wave);
                REPBAR(14); }
                SEAM();
            } ++ph;
            if (ACTIVE()) { REPEAT(15) {
                MPTRS();
                LAS int* MB = (LAS int*)(F.lds + 49152); moe_bases(F, CNT, 0, MB);
                pg8::SchedMoe S;
#pragma unroll
                for (int e = 0; e < 9; ++e) S.pbase[e] = __builtin_amdgcn_readfirstlane(MB[e]);
                S.nN = 4; S.nt = EFF / 64; S.G = F.G; S.c = F.blk; S.astep = (size_t)256 * EFF * 2; S.bstep = (size_t)256 * EFF * 2; S.estep = (size_t)1024 * EFF * 2;
                __syncthreads();
                pg8::Gemm g{HM, (const bf16_t*)(ws + WS_WMD), EFF, EFF};
                pg8::EpiScaleBf16 E{XP, 1024, nullptr, 0, nullptr, 0, 1 << 30, nullptr};
                pg8::gemm_phase(glds, g, S, E, F.wave);
                REPBAR(15); }
                SEAM();
            } ++ph;
            if (ACTIVE()) { MPTRS(); moe_final(F, xb, xout, XP, POS, TW, sm + SM_FING); SEAM(); } ++ph;
        }
    }
#undef ACTIVE
#undef REPEAT
#undef REPBAR
#undef SEAM
#undef PTRS
#undef GPTRS
#undef MPTRS
}

#ifdef DBG_DUMP_OFF
__global__ void dbg_dump(float* out, const unsigned char* ws) {
    const bf16_t* src = (const bf16_t*)(ws + (size_t)DBG_DUMP_OFF);
    for (size_t i = (size_t)blockIdx.x * blockDim.x + threadIdx.x; i < (size_t)NTOK * 1024; i += (size_t)gridDim.x * blockDim.x) { float v = i < (size_t)DBG_DUMP_N ? bf2f(src[i]) : 0.f; if (!(v == v) || v > 1e30f || v < -1e30f) v = 12345.0f; out[i] = v; }
}
#endif
extern "C" void kernel_launch(void* const* d_in, const int* in_sizes, int n_in, void* d_out, int out_size, void* d_ws, size_t ws_size, hipStream_t stream) {
    static int grid = 0;
    if (grid == 0) {
        if (n_in != 27 || in_sizes[0] != NTOK * DM || out_size != NTOK * DM || ws_size < WS_END) {
            fprintf(stderr, "kernel_launch: unexpected problem (n_in %d, in0 %d, out %d, ws %zu < %zu); nothing launched\n", n_in, n_in > 0 ? in_sizes[0] : -1, out_size, ws_size, (size_t)WS_END); grid = -1; return; }
        int dev = 0, cus = 0;
        if (hipGetDevice(&dev) != hipSuccess || hipDeviceGetAttribute(&cus, hipDeviceAttributeMultiprocessorCount, dev) != hipSuccess) { grid = -1; return; }
        if (hipFuncSetAttribute((const void*)mk_fwd, hipFuncAttributeMaxDynamicSharedMemorySize, LDS_BYTES) != hipSuccess) { fprintf(stderr, "kernel_launch: hipFuncSetAttribute failed\n"); grid = -1; return; }
        int per_cu = 0;
        if (hipOccupancyMaxActiveBlocksPerMultiprocessor(&per_cu, (const void*)mk_fwd, 512, LDS_BYTES) != hipSuccess || per_cu < 1) { fprintf(stderr, "kernel_launch: occupancy query says %d\n", per_cu); }
        (void)hipGetLastError();
        grid = cus > 256 ? 256 : cus;
    }
    if (grid < 0) return;
    (void)hipMemsetAsync((char*)d_ws + WS_CTL, 0, CTL_BYTES, stream);
    Params p{};
    for (int i = 0; i < 27; ++i) p.in[i] = (const float*)d_in[i];
    p.out = (float*)d_out; p.ws = (unsigned char*)d_ws; p.pad0 = 0; p.pad1 = 0;
#if MK_SINGLE
    p.ph_lo = 0; p.ph_hi = NPH;
    hipLaunchKernelGGL(mk_fwd, dim3(grid), dim3(512), LDS_BYTES, stream, p);
#else
#ifndef DBG_NPH
#define DBG_NPH NPH
#endif
    for (int k = 0; k < DBG_NPH; ++k) { p.ph_lo = k; p.ph_hi = k + 1; hipLaunchKernelGGL(mk_fwd, dim3(grid), dim3(512), LDS_BYTES, stream, p); }
#ifdef DBG_DUMP_OFF
    hipLaunchKernelGGL(dbg_dump, dim3(2048), dim3(256), 0, stream, (float*)d_out, (const unsigned char*)d_ws);
#endif
#endif
}
```

```cpp
#include <hip/hip_runtime.h>
#include <cstdio>
#include <cstdint>

#define LAS __attribute__((address_space(3)))
#define DI __device__ __forceinline__
typedef unsigned short bf16_t;
typedef short bf16x8 __attribute__((ext_vector_type(8)));
typedef short s16x4 __attribute__((ext_vector_type(4)));
typedef float f32x4 __attribute__((ext_vector_type(4)));
typedef float f32x2 __attribute__((ext_vector_type(2)));
typedef unsigned u32x4 __attribute__((ext_vector_type(4)));
typedef unsigned u32x2 __attribute__((ext_vector_type(2)));

#ifndef MK_SINGLE
#define MK_SINGLE 1
#endif

constexpr int NTOK = 65536, DM = 1024, SEQ = 8192, NBATCH = 8;
constexpr int NGRP = 2, NG = NTOK / NGRP, GB = NBATCH / NGRP;
constexpr int PLD = 3072;
constexpr int PC_POOL = 0, PC_MQ = 256, PC_MK = 512, PC_MV = 768, PC_DQ = 1024, PC_DK = 1536, PC_DV = 2048, PC_Z = 2560;
constexpr int IN_COLS = 6160;
constexpr int FF = 2816, EFF = 1408, NEXP = 8;
constexpr int MEMLEN = 256;
constexpr float RMS_EPS = 1e-6f;
constexpr int NPH = 1 + 2 * (NGRP * 7 + 3) + 2 + 5;

constexpr size_t MiB = 1u << 20;
constexpr size_t WS_CTL = 0, CTL_BYTES = 1 * MiB;
constexpr size_t LW_WIN = 0, LW_WCAT = LW_WIN + (size_t)6144 * 1024 * 2, LW_WOUT = LW_WCAT + (size_t)1024 * 1024 * 2, LW_WQ = LW_WOUT + (size_t)1024 * 1024 * 2,
                 LW_WKV = LW_WQ + (size_t)512 * 1024 * 2, LW_WO = LW_WKV + (size_t)1024 * 1024 * 2, LW_WBA = LW_WO + (size_t)1024 * 512 * 2, LW_STRIDE = LW_WBA + (size_t)16 * 1024 * 2;
constexpr size_t WS_LW = WS_CTL + CTL_BYTES;
constexpr size_t WS_WGU = WS_LW + 2 * LW_STRIDE;
constexpr size_t WS_WD = WS_WGU + (size_t)2 * FF * 1024 * 2;
constexpr size_t WS_WMGU = WS_WD + (size_t)1024 * FF * 2;
constexpr size_t WS_WMD = WS_WMGU + (size_t)NEXP * 2 * EFF * 1024 * 2;
constexpr size_t WS_WR = WS_WMD + (size_t)NEXP * 1024 * EFF * 2;
constexpr size_t WS_XB = (WS_WR + 8 * 1024 * 4 + MiB - 1) / MiB * MiB;
constexpr size_t WS_SSQ = WS_XB + (size_t)NTOK * 1024 * 2;
constexpr size_t WS_ROPE = WS_SSQ + (size_t)NTOK * 16 * 4;
constexpr size_t WS_MEMN = WS_ROPE + (size_t)NTOK * 16 * 4;
constexpr size_t WS_KVM = WS_MEMN + (size_t)2 * 2048 * 1024 * 2;
constexpr size_t WS_SMALL = WS_KVM + (size_t)2 * 2048 * 1024 * 2;
constexpr int SM_CONVW = 0, SM_ALOG = SM_CONVW + 2 * 4 * 1536, SM_DTB = SM_ALOG + 16, SM_DNG = SM_DTB + 16, SM_FING = SM_DNG + 128, SM_END = SM_FING + 1024;
constexpr size_t WS_X8 = WS_SMALL + 65536;
constexpr size_t WS_WG8 = WS_X8 + (size_t)NTOK * 1024;
constexpr size_t WS_ARENA = WS_WG8 + (size_t)2 * 3072 * 1024;
constexpr size_t AR_P = 0;
constexpr size_t AR_BA = AR_P + (size_t)NG * PLD * 2;
constexpr size_t AR_BR = AR_BA + (size_t)NG * 16 * 4;
constexpr size_t AR_KBAR = AR_BR + (size_t)NG * 1024 * 2;
constexpr size_t AR_VT = AR_KBAR + (size_t)GB * 4 * 32 * 64 * 4;
constexpr int NCH = GB * 128 * 8;
constexpr size_t AR_QD = AR_VT + (size_t)GB * 4 * 64 * SEQ * 2;
constexpr size_t AR_KDT = AR_QD + (size_t)NCH * 8192;
constexpr size_t AR_WN = AR_KDT + (size_t)NCH * 8192;
constexpr size_t AR_UT = AR_WN + (size_t)NCH * 8192;
constexpr size_t AR_AQK = AR_UT + (size_t)NCH * 8192;
constexpr size_t AR_NT = AR_AQK + (size_t)NCH * 8192;
constexpr size_t AR_SG = AR_NT + (size_t)NCH * 8192;
constexpr size_t AR_ZB = AR_SG + (size_t)NCH * 8192;
constexpr size_t AR_GL = AR_ZB + (size_t)NG * 512 * 2;
constexpr size_t AR_SELG = AR_GL + (size_t)NCH * 4 + 65536 - ((size_t)NCH * 4) % 65536;
constexpr size_t AR_CNTG = AR_SELG + (size_t)NG * 4 * 4;
constexpr size_t AR_LISTG = AR_CNTG + (size_t)GB * 4 * 32 * 32 * 4;
constexpr size_t AR_OPG = AR_LISTG + (size_t)GB * 4 * 32 * 32 * 256;
constexpr size_t AR_MLG = AR_OPG + (size_t)NG * 4 * 4 * 64 * 2;
constexpr size_t AR_MERGED = AR_MLG + (size_t)NG * 4 * 4 * 2 * 4;
constexpr size_t AR_MIX_END = AR_MERGED + (size_t)NG * 1024 * 2;
constexpr size_t AR_QX = 0, AR_AO = AR_QX + (size_t)NTOK * 512 * 2, AR_XA_END = AR_AO + (size_t)NTOK * 512 * 2;
constexpr size_t AR_HID = 0, AR_HID_END = (size_t)NTOK * FF * 2;
constexpr int MOE_ROWS = 2 * NTOK + 2048;
constexpr size_t AR_TE = 0, AR_TW = AR_TE + (size_t)NTOK * 8, AR_RR = AR_TW + (size_t)NTOK * 8, AR_POS = AR_RR + (size_t)NTOK * 4, AR_CNT = AR_POS + (size_t)NTOK * 8,
                 AR_XP = AR_CNT + 65536, AR_RP = AR_XP + (size_t)MOE_ROWS * 1024 * 2, AR_HM = AR_RP + (size_t)MOE_ROWS * 4 + 65536 - ((size_t)MOE_ROWS * 4) % 65536,
                 AR_MOE_END = AR_HM + (size_t)MOE_ROWS * EFF * 2;
constexpr size_t cmax(size_t a, size_t b) { return a > b ? a : b; }
constexpr size_t WS_END = WS_ARENA + cmax(cmax(AR_MIX_END, AR_XA_END), cmax(AR_HID_END, AR_MOE_END));
static_assert(AR_XA_END <= AR_MERGED, "xattn buffers must not overlap MERGED");
static_assert(SM_END * 4 <= 65536, "small-vector block");
static_assert(WS_END <= (size_t)1073741824, "workspace map exceeds 1 GiB");

constexpr int LDS_BYTES = 160 * 1024;
constexpr int LDS_MISC = 158 * 1024;

DI float bf2f(unsigned short b) { return __uint_as_float(((unsigned)b) << 16); }
DI unsigned f2bf(float f) { unsigned u = __float_as_uint(f); return (u + 0x7fffu + ((u >> 16) & 1u)) >> 16; }
DI unsigned pk2(float lo, float hi) { return f2bf(lo) | (f2bf(hi) << 16); }
typedef __bf16 bf16v2_t __attribute__((ext_vector_type(2)));
DI unsigned cvt_pk_bf16(float lo, float hi) { bf16v2_t v; v.x = (__bf16)lo; v.y = (__bf16)hi; return __builtin_bit_cast(unsigned, v); }
DI unsigned cvt4_fp8(float a, float b, float c, float d) { unsigned w = 0u; w = __builtin_amdgcn_cvt_pk_fp8_f32(a, b, w, false); w = __builtin_amdgcn_cvt_pk_fp8_f32(c, d, w, true); return w; }
DI float wave_sum(float v) {
#pragma unroll
    for (int o = 1; o < 64; o <<= 1) v += __shfl_xor(v, o);
    return v;
}
DI float fsigmoid(float x) { return __builtin_amdgcn_rcpf(1.0f + __builtin_amdgcn_exp2f(-1.44269504089f * x)); }
DI float row_rstd(const float* ssqp, int row) {
    const f32x4* p = (const f32x4*)(ssqp + (size_t)row * 16);
    const f32x4 a = p[0], b = p[1], c = p[2], d = p[3];
    const float s = (((a.x + a.y) + (a.z + a.w)) + ((b.x + b.y) + (b.z + b.w))) + (((c.x + c.y) + (c.z + c.w)) + ((d.x + d.y) + (d.z + d.w)));
    return rsqrtf(s * (1.0f / 1024.0f) + RMS_EPS);
}
#define LAUNDER_V(x) asm volatile("" : "+v"(x))
#define LDS_WAIT() asm volatile("s_waitcnt lgkmcnt(0)" ::: "memory")
#define VM_WAIT() asm volatile("s_waitcnt vmcnt(0)" ::: "memory")
#define WG_BAR() do { asm volatile("s_waitcnt lgkmcnt(0)" ::: "memory"); __builtin_amdgcn_s_barrier(); asm volatile("" ::: "memory"); } while (0)
#define MFMA16(a, b, c) __builtin_amdgcn_mfma_f32_16x16x32_bf16((a), (b), (c), 0, 0, 0)

#define XB_TMO      128
#define XB_XCNT(j)  (256  + 64 * (j))
#define XB_XSUB(j)  (1280 + 64 * (j))
#define XB_XGEN(j)  (2304 + 64 * (j))
#define XB_TOP      3328
#define XB_TOPGEN   3392
#define XCD_BAR_WORDS 3456
#define XB_SPIN_CAP (1u << 22)

DI unsigned xb_ld(unsigned* p)              { return __hip_atomic_load(p, __ATOMIC_RELAXED, __HIP_MEMORY_SCOPE_AGENT); }
DI unsigned xb_add(unsigned* p, unsigned v) { return __hip_atomic_fetch_add(p, v, __ATOMIC_RELAXED, __HIP_MEMORY_SCOPE_AGENT); }
DI unsigned xb_xcc_id() { return (unsigned)__builtin_amdgcn_s_getreg((3 << 11) | 20) & 0xFu; }
#define XB_SPIN(cond, bar) do { unsigned _sp = 0; while (cond) { __builtin_amdgcn_s_sleep(1); \
    if ((++_sp & 255u) == 0u) { if (xb_ld(&(bar)[XB_TMO])) break; if (_sp > XB_SPIN_CAP) { atomicAdd(&(bar)[XB_TMO], 1u); break; } } } } while (0)

struct XcdBarrier { unsigned* bar; unsigned x; volatile LAS unsigned* st; };

DI XcdBarrier xcd_barrier_post(unsigned* bar, volatile LAS unsigned* st) {
    XcdBarrier b; b.bar = bar; b.x = xb_xcc_id(); b.st = st;
    if (threadIdx.x == 0) (void)xb_add(&bar[XB_XCNT(b.x)], 1u);
    return b;
}
DI void xcd_barrier_complete(unsigned* bar, unsigned x, unsigned& nloc, unsigned& nx) {
    const unsigned G = gridDim.x * gridDim.y * gridDim.z;
    unsigned sum, cnt, mine, sp = 0u;
    for (;;) {
        sum = 0u; cnt = 0u; mine = 0u;
#pragma unroll
        for (unsigned j = 0; j < 16; ++j) { const unsigned c = xb_ld(&bar[XB_XCNT(j)]); sum += c; cnt += (c > 0u) ? 1u : 0u; mine = (j == x) ? c : mine; }
        if (sum == G) break;
        __builtin_amdgcn_s_sleep(1);
        if ((++sp & 255u) == 0u) { if (xb_ld(&bar[XB_TMO])) break; if (sp > XB_SPIN_CAP) { atomicAdd(&bar[XB_TMO], 1u); break; } }
    }
    nloc = mine > 0u ? mine : 1u; nx = cnt > 0u ? cnt : 1u;
}
DI void xcd_barrier(const XcdBarrier& b) {
    asm volatile("s_waitcnt vmcnt(0)" ::: "memory");
    __syncthreads();
    if (threadIdx.x == 0) {
        unsigned* bar = b.bar;
        __builtin_amdgcn_s_waitcnt(0);
        unsigned nloc = b.st[0], nx = b.st[1];
        if (nloc == 0u) { xcd_barrier_complete(bar, b.x, nloc, nx); b.st[0] = nloc; b.st[1] = nx; }
        const unsigned old = xb_add(&bar[XB_XSUB(b.x)], 1u);
        const unsigned gen = old / nloc;
        if (old + 1u == (gen + 1u) * nloc) {
            __builtin_amdgcn_fence(__ATOMIC_RELEASE, "agent");
            asm volatile("s_waitcnt vmcnt(0)" ::: "memory");
            const unsigned og = xb_add(&bar[XB_TOP], 1u);
            const unsigned tg = og / nx;
            if (og + 1u == (tg + 1u) * nx) xb_add(&bar[XB_TOPGEN], 1u);
            else XB_SPIN(xb_ld(&bar[XB_TOPGEN]) == tg, bar);
            __builtin_amdgcn_fence(__ATOMIC_ACQUIRE, "agent");
            xb_add(&bar[XB_XGEN(b.x)], 1u);
            asm volatile("s_waitcnt vmcnt(0)" ::: "memory");
        } else {
            XB_SPIN(xb_ld(&bar[XB_XGEN(b.x)]) == gen, bar);
            __builtin_amdgcn_fence(__ATOMIC_ACQUIRE, "agent");
            asm volatile("s_waitcnt vmcnt(0)" ::: "memory");
        }
    }
    __syncthreads();
}
namespace pg8 {
constexpr int BM = 256, BK = 64, HALF = 128, HTB = HALF * BK * 2, STAGE_BYTES = 8 * HTB, NXCD = 8, WGM = 8;
__host__ __device__ __forceinline__ int lds_byte(int r, int c) { const int st = (r >> 4) * 2 + (c >> 5), rr = r & 15, cc = c & 31, ob = rr * 64 + cc * 2; return st * 1024 + (ob ^ (((ob >> 9) & 1) << 5)); }
__host__ __device__ __forceinline__ void stage_rc(int b, int& R, int& C) { const int st = b / 1024, sb = b % 1024, swz = sb ^ (((sb >> 9) & 1) << 5); R = (st >> 1) * 16 + swz / 64; C = (st & 1) * 32 + (swz % 64) / 2; }
__host__ __device__ __forceinline__ int perm32(int rho) { const int n = rho >> 4, i = rho & 15; return 8 * (i >> 2) + 4 * n + (i & 3); }

struct Unit { int pm, pn, nt, tag, ord; size_t aoff, boff; };
struct Gemm { const bf16_t* A; const bf16_t* Bt; int lda, ldb; };

struct TileOrder {
    int nM, nN, nwg, G, c;
    DI void init(int nM_, int nN_, int G_, int c_) { nM = nM_; nN = nN_; nwg = nM * nN; G = G_; c = c_; }
    DI bool tile(int i, int& pm, int& pn) const {
        const long L = (long)i * G + c; if (L >= nwg) return false;
        int wgid = (int)L; { const int q = nwg / NXCD, r = nwg % NXCD, xcd = wgid % NXCD, off = wgid / NXCD; wgid = (xcd < r ? xcd * (q + 1) : r * (q + 1) + (xcd - r) * q) + off; }
        const int nig = WGM * nN, gid = wgid / nig, fm = gid * WGM, gsz = (nM - fm) < WGM ? (nM - fm) : WGM;
        pm = fm + ((wgid % nig) % gsz); pn = (wgid % nig) / gsz; return true;
    }
};
struct SchedPlain {
    TileOrder T; int nt; size_t astep, bstep;
    DI void init(int M, int N, int K, int lda, int ldb, int G, int c, int esz = 2) { T.init(M / BM, N / BM, G, c); nt = K * esz / (BK * 2); astep = (size_t)BM * lda * esz; bstep = (size_t)BM * ldb * esz; }
    DI bool next(int i, Unit& u) const { if (!T.tile(i, u.pm, u.pn)) return false; u.nt = nt; u.tag = 0; u.ord = i; u.aoff = (size_t)u.pm * astep; u.boff = (size_t)u.pn * bstep; return true; }
};
struct SchedMerge {
    TileOrder T; size_t astep, bstep;
    DI void init(int M, int N, int lda, int ldb, int G, int c) { T.init(M / BM, N / BM, G, c); astep = (size_t)BM * lda * 2; bstep = (size_t)BM * ldb * 2; }
    DI bool next(int i, Unit& u) const {
        const int ti = i / 3, br = i - 3 * ti; if (!T.tile(ti, u.pm, u.pn)) return false;
        const int kofs = br == 0 ? 0 : (br == 1 ? 256 : 512);
        u.nt = br == 2 ? 8 : 4; u.tag = br; u.aoff = (size_t)u.pm * astep + (size_t)kofs * 2; u.boff = (size_t)u.pn * bstep + (size_t)kofs * 2; return true;
    }
};
struct SchedKV {
    int c; size_t lstride;
    DI bool next(int i, Unit& u) const {
        if (i != 0 || c < 0 || c >= 64) return false;
        const int layer = c >> 5, r = c & 31; u.pm = layer * 8 + (r >> 2); u.pn = r & 3; u.nt = 16; u.tag = 0; u.ord = 0;
        u.aoff = (size_t)u.pm * BM * 1024 * 2; u.boff = (size_t)layer * lstride + (size_t)u.pn * BM * 1024 * 2; return true;
    }
};
struct SchedMoe {
    int pbase[9]; int nN, nt, G, c; size_t astep, bstep, estep;
    DI bool next(int i, Unit& u) const {
        const long L = (long)i * G + c; const int nM = pbase[8], nwg = nM * nN; if (L >= nwg) return false;
        int wgid = (int)L; { const int q = nwg / NXCD, r = nwg % NXCD, xcd = wgid % NXCD, off = wgid / NXCD; wgid = (xcd < r ? xcd * (q + 1) : r * (q + 1) + (xcd - r) * q) + off; }
        const int nig = WGM * nN, gid = wgid / nig, fm = gid * WGM, gsz = (nM - fm) < WGM ? (nM - fm) : WGM;
        const int gp = fm + ((wgid % nig) % gsz), pn = (wgid % nig) / gsz;
        int e = 0;
#pragma unroll
        for (int j = 1; j < 8; ++j) e += (gp >= pbase[j]) ? 1 : 0;
        u.pm = gp; u.pn = pn; u.nt = nt; u.tag = e; u.ord = i; u.aoff = (size_t)gp * astep; u.boff = (size_t)e * estep + (size_t)pn * bstep; return true;
    }
};

constexpr int RTAB_OFF = STAGE_BYTES, RTAB_MAX_UNITS = 26;
template <class Sched> DI void build_rtab(LAS unsigned char* lds, const Sched& S, const float* ssqp, const float* rvec, int tid) {
    LAS float* rt = (LAS float*)(lds + RTAB_OFF); Unit u;
    for (int i = tid >> 8; S.next(i, u); i += 2) { if (i >= RTAB_MAX_UNITS) break; const int r = tid & 255, row = u.pm * BM + r; rt[i * 256 + r] = rvec ? rvec[row] : row_rstd(ssqp, row); }
    __syncthreads();
}
struct EpiScaleBf16 { static constexpr bool MID = false;
    bf16_t* O; int ldo; const float* ssqp; int act; bf16_t* O2; int ldo2, pn2; const LAS float* rtab;
    DI void operator()(const f32x4 (&acc)[2][2][4][2], const Unit& u, int wr, int wc, int fr, int fq) const {
        const bool alt = u.pn >= pn2; bf16_t* const Ob = alt ? O2 : O; const int ld = alt ? ldo2 : ldo;
        const int row0 = u.pm * BM + wr * 64 + fr, col0 = (alt ? u.pn - pn2 : u.pn) * BM + wc * 32 + 8 * fq;
#pragma unroll
        for (int ai = 0; ai < 2; ++ai)
#pragma unroll
            for (int m = 0; m < 4; ++m) { const int row = row0 + ai * HALF + m * 16; const float r = ssqp ? rtab[u.ord * 256 + (row & 255)] : 1.0f; bf16_t* rowp = Ob + (size_t)row * ld + col0;
#pragma unroll
                for (int bj = 0; bj < 2; ++bj) { f32x4 v0 = acc[ai][bj][m][0] * r, v1 = acc[ai][bj][m][1] * r;
                    if (act) {
#pragma unroll
                        for (int j = 0; j < 4; ++j) { v0[j] = fsigmoid(v0[j]); v1[j] = fsigmoid(v1[j]); } }
                    u32x4 w; w.x = cvt_pk_bf16(v0[0], v0[1]); w.y = cvt_pk_bf16(v0[2], v0[3]); w.z = cvt_pk_bf16(v1[0], v1[1]); w.w = cvt_pk_bf16(v1[2], v1[3]);
                    *(u32x4*)(rowp + bj * HALF) = w; } }
    }
};
struct EpiResid { static constexpr bool MID = false;
    bf16_t* xb; float* ssqp; unsigned char* x8;
    DI void operator()(const f32x4 (&acc)[2][2][4][2], const Unit& u, int wr, int wc, int fr, int fq) const {
        const int row0 = u.pm * BM + wr * 64 + fr, col0 = u.pn * BM + wc * 32 + 8 * fq;
#pragma unroll
        for (int ai = 0; ai < 2; ++ai)
#pragma unroll
            for (int m = 0; m < 4; ++m) { const int row = row0 + ai * HALF + m * 16; const size_t off = (size_t)row * 1024 + col0; float ss = 0.f;
#pragma unroll
                for (int bj = 0; bj < 2; ++bj) {
                    const u32x4 xo = *(const u32x4*)(xb + off + bj * HALF);
                    f32x4 x0 = (f32x4){__uint_as_float(xo.x << 16), __uint_as_float(xo.x & 0xffff0000u), __uint_as_float(xo.y << 16), __uint_as_float(xo.y & 0xffff0000u)};
                    f32x4 x1 = (f32x4){__uint_as_float(xo.z << 16), __uint_as_float(xo.z & 0xffff0000u), __uint_as_float(xo.w << 16), __uint_as_float(xo.w & 0xffff0000u)};
                    x0 += acc[ai][bj][m][0]; x1 += acc[ai][bj][m][1];
                    u32x4 w; w.x = cvt_pk_bf16(x0[0], x0[1]); w.y = cvt_pk_bf16(x0[2], x0[3]); w.z = cvt_pk_bf16(x1[0], x1[1]); w.w = cvt_pk_bf16(x1[2], x1[3]);
                    *(u32x4*)(xb + off + bj * HALF) = w;
                    { u32x2 w8; w8.x = cvt4_fp8(x0[0], x0[1], x0[2], x0[3]); w8.y = cvt4_fp8(x1[0], x1[1], x1[2], x1[3]); *(u32x2*)(x8 + off + bj * HALF) = w8; }
                    ss += (x0[0] * x0[0] + x0[1] * x0[1]) + (x0[2] * x0[2] + x0[3] * x0[3]) + (x1[0] * x1[0] + x1[1] * x1[1]) + (x1[2] * x1[2] + x1[3] * x1[3]); }
                ss += __shfl_xor(ss, 16); ss += __shfl_xor(ss, 32);
                if (fq == 0) ssqp[(size_t)row * 16 + u.pn * 4 + wc] = ss; }
    }
};
struct EpiSwiglu { static constexpr bool MID = false;
    bf16_t* H; int ldh; const LAS float* rtab;
    DI void operator()(const f32x4 (&acc)[2][2][4][2], const Unit& u, int wr, int wc, int fr, int fq) const {
        const int row0 = u.pm * BM + wr * 64 + fr, col0 = u.pn * HALF + wc * 32 + 8 * fq;
#pragma unroll
        for (int ai = 0; ai < 2; ++ai)
#pragma unroll
            for (int m = 0; m < 4; ++m) { const int row = row0 + ai * HALF + m * 16; const float r = rtab[u.ord * 256 + (row & 255)];
                f32x4 h0, h1;
#pragma unroll
                for (int j = 0; j < 4; ++j) { const float g0 = acc[ai][0][m][0][j] * r, g1 = acc[ai][0][m][1][j] * r;
                    h0[j] = g0 * fsigmoid(g0) * (acc[ai][1][m][0][j] * r); h1[j] = g1 * fsigmoid(g1) * (acc[ai][1][m][1][j] * r); }
                u32x4 w; w.x = cvt_pk_bf16(h0[0], h0[1]); w.y = cvt_pk_bf16(h0[2], h0[3]); w.z = cvt_pk_bf16(h1[0], h1[1]); w.w = cvt_pk_bf16(h1[2], h1[3]);
                *(u32x4*)(H + (size_t)row * ldh + col0) = w; }
    }
};
struct EpiMerge { static constexpr bool MID = true;
    const bf16_t* gates; bf16_t* merged;
    static DI float gclamp(unsigned hi_bits) { return fmaxf(__uint_as_float(hi_bits), 1e-30f); }
    DI void mid(f32x4 (&acc)[2][2][4][2], const Unit& u, int seg, int wr, int wc, int fr, int fq) const {
        int row0 = u.pm * BM + wr * 64 + fr, col0 = u.pn * BM + wc * 32 + 8 * fq; LAUNDER_V(row0); LAUNDER_V(col0);
#pragma unroll
        for (int ai = 0; ai < 2; ++ai)
#pragma unroll
            for (int mp = 0; mp < 2; ++mp) {
                u32x4 ga[2][2], gb[2][2];
#pragma unroll
                for (int mm = 0; mm < 2; ++mm)
#pragma unroll
                    for (int bj = 0; bj < 2; ++bj) { const bf16_t* gp = gates + (size_t)(row0 + ai * HALF + (2 * mp + mm) * 16) * PLD + seg * 1024 + col0 + bj * HALF; ga[mm][bj] = *(const u32x4*)gp; gb[mm][bj] = *(const u32x4*)(gp + 1024); }
                __builtin_amdgcn_sched_barrier(0);
#pragma unroll
                for (int mm = 0; mm < 2; ++mm)
#pragma unroll
                    for (int bj = 0; bj < 2; ++bj) {
#pragma unroll
                        for (int j = 0; j < 4; ++j) { const int m = 2 * mp + mm;
                            const float r_lo = gclamp(ga[mm][bj][j] << 16) * __builtin_amdgcn_rcpf(gclamp(gb[mm][bj][j] << 16)), r_hi = gclamp(ga[mm][bj][j] & 0xffff0000u) * __builtin_amdgcn_rcpf(gclamp(gb[mm][bj][j] & 0xffff0000u));
                            acc[ai][bj][m][j >> 1][(2 * j) & 3] *= r_lo; acc[ai][bj][m][j >> 1][(2 * j + 1) & 3] *= r_hi; }
                        __builtin_amdgcn_sched_barrier(0); }
            }
    }
    DI void operator()(const f32x4 (&acc)[2][2][4][2], const Unit& u, int wr, int wc, int fr, int fq) const {
        const int row0 = u.pm * BM + wr * 64 + fr, col0 = u.pn * BM + wc * 32 + 8 * fq;
#pragma unroll
        for (int ai = 0; ai < 2; ++ai)
#pragma unroll
            for (int m = 0; m < 4; ++m) { const int row = row0 + ai * HALF + m * 16;
#pragma unroll
                for (int bj = 0; bj < 2; ++bj) {
                    const u32x4 gv = *(const u32x4*)(gates + (size_t)row * PLD + 2 * 1024 + col0 + bj * HALF);
                    float v[8];
#pragma unroll
                    for (int j = 0; j < 4; ++j) { v[2 * j] = gclamp(gv[j] << 16); v[2 * j + 1] = gclamp(gv[j] & 0xffff0000u); }
#pragma unroll
                    for (int j = 0; j < 4; ++j) { v[j] *= acc[ai][bj][m][0][j]; v[4 + j] *= acc[ai][bj][m][1][j]; }
                    u32x4 w; w.x = cvt_pk_bf16(v[0], v[1]); w.y = cvt_pk_bf16(v[2], v[3]); w.z = cvt_pk_bf16(v[4], v[5]); w.w = cvt_pk_bf16(v[6], v[7]);
                    *(u32x4*)(merged + (size_t)row * 1024 + col0 + bj * HALF) = w; } }
    }
};

template <class Epi, class Sched, bool F8 = false>
DI void gemm_phase(LAS unsigned char* lds, const Gemm g, const Sched& S, const Epi& E, int wave_id) {
    int tid_ = (int)__builtin_amdgcn_mbcnt_hi(~0u, __builtin_amdgcn_mbcnt_lo(~0u, 0u)) + 64 * wave_id; asm volatile("" : "+v"(tid_));
    const int tid = tid_, wid = __builtin_amdgcn_readfirstlane(tid >> 6), lane = tid & 63, wr = wid >> 2, wc = wid & 3, fr = lane & 15, fq = lane >> 4;
    unsigned voffA[2], voffB[2];
#pragma unroll
    for (int i = 0; i < 2; ++i) { int R, C; stage_rc(tid * 16 + i * 8192, R, C); const int Rb = (R & ~31) + perm32(R & 31);
        voffA[i] = F8 ? (unsigned)(R * g.lda + 2 * C) : (unsigned)(R * g.lda + C) * 2u; voffB[i] = F8 ? (unsigned)(Rb * g.ldb + 2 * C) : (unsigned)(Rb * g.ldb + C) * 2u; }
    const size_t kstep = (size_t)(BK * 2);
    const size_t hstepA = (size_t)HALF * g.lda * (F8 ? 1 : 2), hstepB = (size_t)HALF * g.ldb * (F8 ? 1 : 2);
    const unsigned ldsw = (unsigned)wid * 1024u;
    const int aoff = lds_byte(wr * 64 + fr, fq * 8), boff = lds_byte(wc * 32 + fr, fq * 8);
#define PG8_SA(b, h) (((b) * 2 + (h)) * HTB)
#define PG8_SB(b, h) ((4 + (b) * 2 + (h)) * HTB)
#define PG8_STAGE(bufoff, gbase, voff) do { _Pragma("unroll") for (int _i = 0; _i < 2; ++_i) \
        __builtin_amdgcn_global_load_lds((const unsigned*)((const char*)(gbase) + (voff)[_i]), (LAS unsigned*)(lds + (bufoff) + ldsw + _i * 8192), 16, 0, 0); } while (0)
#define PG8_LDA(dst, b, h) do { _Pragma("unroll") for (int m = 0; m < 4; ++m) { const v4i_t l0_ = *(const LAS v4i_t*)(lds + PG8_SA(b, h) + aoff + m * 2048), l1_ = *(const LAS v4i_t*)(lds + PG8_SA(b, h) + aoff + m * 2048 + 1024); \
        dst[m] = __builtin_shufflevector(l0_, l1_, 0, 1, 2, 3, 4, 5, 6, 7); } } while (0)
#define PG8_LDB(dst, b, h) do { _Pragma("unroll") for (int n = 0; n < 2; ++n) { const v4i_t l0_ = *(const LAS v4i_t*)(lds + PG8_SB(b, h) + boff + n * 2048), l1_ = *(const LAS v4i_t*)(lds + PG8_SB(b, h) + boff + n * 2048 + 1024); \
        dst[n] = __builtin_shufflevector(l0_, l1_, 0, 1, 2, 3, 4, 5, 6, 7); } } while (0)
#define PG8_MMA(ai, bj, At, Bt) do { __builtin_amdgcn_s_setprio(1); _Pragma("unroll") for (int m = 0; m < 4; ++m) _Pragma("unroll") for (int n = 0; n < 2; ++n) { \
        if constexpr (F8) asm volatile("v_mfma_scale_f32_16x16x128_f8f6f4 %0, %1, %2, %0, %3, %4 op_sel_hi:[0,0,0]" : "+v"(acc[ai][bj][m][n]) : "v"(Bt[n]), "v"(At[m]), "v"(f8scale_w), "v"(f8scale_x));   \
        else { const bf16x8 b0_ = __builtin_bit_cast(bf16x8, __builtin_shufflevector(Bt[n], Bt[n], 0, 1, 2, 3)), b1_ = __builtin_bit_cast(bf16x8, __builtin_shufflevector(Bt[n], Bt[n], 4, 5, 6, 7)), \
                            a0_ = __builtin_bit_cast(bf16x8, __builtin_shufflevector(At[m], At[m], 0, 1, 2, 3)), a1_ = __builtin_bit_cast(bf16x8, __builtin_shufflevector(At[m], At[m], 4, 5, 6, 7)); \
            acc[ai][bj][m][n] = __builtin_amdgcn_mfma_f32_16x16x32_bf16(b0_, a0_, acc[ai][bj][m][n], 0, 0, 0); acc[ai][bj][m][n] = __builtin_amdgcn_mfma_f32_16x16x32_bf16(b1_, a1_, acc[ai][bj][m][n], 0, 0, 0); } } \
        __builtin_amdgcn_s_setprio(0); } while (0)
#define PG8_WAIT_V(n) asm volatile("s_waitcnt vmcnt(" #n ")" ::: "memory")
#define PG8_WAIT_L(n) asm volatile("s_waitcnt lgkmcnt(" #n ")" ::: "memory")
#define PG8_BAR __builtin_amdgcn_s_barrier()
#define PG8_SCHED __builtin_amdgcn_sched_barrier(0)
    Unit cur, nxt; int ui = 0;
    if (!S.next(0, cur)) return;
    f32x4 acc[2][2][4][2];
#pragma unroll
    for (int a = 0; a < 2; ++a)
#pragma unroll
        for (int b = 0; b < 2; ++b)
#pragma unroll
            for (int m = 0; m < 4; ++m)
#pragma unroll
                for (int n = 0; n < 2; ++n) acc[a][b][m][n] = (f32x4){0.f, 0.f, 0.f, 0.f};
    typedef int v8i_t __attribute__((ext_vector_type(8))); typedef int v4i_t __attribute__((ext_vector_type(4)));
    const int f8scale_w = 0x7a7a7a7a, f8scale_x = 0x7f7f7f7f;
    v8i_t At[4], B0[2], B1[2];
    const char* cA = (const char*)g.A + cur.aoff; const char* cB = (const char*)g.Bt + cur.boff;
    PG8_STAGE(PG8_SB(0, 0), cB, voffB); PG8_STAGE(PG8_SB(0, 1), cB + hstepB, voffB); PG8_STAGE(PG8_SA(0, 0), cA, voffA); PG8_STAGE(PG8_SA(0, 1), cA + hstepA, voffA);
    if (wr == 1) PG8_BAR;
    PG8_WAIT_V(2); PG8_BAR;
    PG8_STAGE(PG8_SB(1, 0), cB + kstep, voffB); PG8_STAGE(PG8_SA(1, 0), cA + kstep, voffA); PG8_STAGE(PG8_SB(1, 1), cB + hstepB + kstep, voffB);
    PG8_WAIT_V(6); PG8_BAR;
    for (;;) {
        const bool has_next = S.next(ui + 1, nxt);
        const int nt = cur.nt;
        const char* nA = has_next ? (const char*)g.A + nxt.aoff : cA; const char* nB = has_next ? (const char*)g.Bt + nxt.boff : cB;
        for (int t = 0; t < nt; t += 2) {
            if constexpr (Epi::MID) { if (t == 4 || t == 8) { E.mid(acc, cur, t >> 3, wr, wc, fr, fq); } __builtin_amdgcn_sched_barrier(0); }
            const bool last = (t == nt - 2);
            const char* a1 = cA + (size_t)(t + 1) * kstep;
            const char* a2 = last ? nA : cA + (size_t)(t + 2) * kstep; const char* b2 = last ? nB : cB + (size_t)(t + 2) * kstep;
            const char* a3 = a2 + kstep; const char* b3 = b2 + kstep;
            PG8_LDB(B0, 0, 0); PG8_LDB(B1, 0, 1); PG8_SCHED; PG8_LDA(At, 0, 0); PG8_STAGE(PG8_SA(1, 1), a1 + hstepA, voffA);
            PG8_WAIT_V(8); PG8_WAIT_L(0); PG8_BAR; PG8_MMA(0, 0, At, B0); PG8_MMA(0, 1, At, B1); PG8_BAR; PG8_SCHED;
            PG8_LDA(At, 0, 1); PG8_STAGE(PG8_SB(0, 0), b2, voffB); PG8_STAGE(PG8_SB(0, 1), b2 + hstepB, voffB); PG8_STAGE(PG8_SA(0, 0), a2, voffA);
            PG8_WAIT_V(8); PG8_WAIT_L(0); PG8_BAR; PG8_MMA(1, 0, At, B0); PG8_MMA(1, 1, At, B1); PG8_BAR; PG8_SCHED;
            PG8_LDB(B0, 1, 0); PG8_LDB(B1, 1, 1); PG8_SCHED; PG8_LDA(At, 1, 0); PG8_STAGE(PG8_SA(0, 1), a2 + hstepA, voffA);
            PG8_WAIT_V(8); PG8_WAIT_L(0); PG8_BAR; PG8_MMA(0, 0, At, B0); PG8_MMA(0, 1, At, B1); PG8_BAR; PG8_SCHED;
            PG8_LDA(At, 1, 1); PG8_STAGE(PG8_SB(1, 0), b3, voffB); PG8_STAGE(PG8_SB(1, 1), b3 + hstepB, voffB); PG8_STAGE(PG8_SA(1, 0), a3, voffA);
            PG8_WAIT_V(8); PG8_WAIT_L(0); PG8_BAR; PG8_MMA(1, 0, At, B0); PG8_MMA(1, 1, At, B1); PG8_BAR; PG8_SCHED;
        }
        if (wr == 0) PG8_BAR;
        E(acc, cur, wr, wc, fr, fq);
        if (!has_next) break;
#pragma unroll
        for (int a = 0; a < 2; ++a)
#pragma unroll
            for (int b = 0; b < 2; ++b)
#pragma unroll
                for (int m = 0; m < 4; ++m)
#pragma unroll
                    for (int n = 0; n < 2; ++n) acc[a][b][m][n] = (f32x4){0.f, 0.f, 0.f, 0.f};
        cur = nxt; cA = nA; cB = nB; ++ui;
        if (wr == 1) PG8_BAR;
    }
    PG8_WAIT_V(0);
    PG8_BAR;
#undef PG8_SA
#undef PG8_SB
#undef PG8_STAGE
#undef PG8_LDA
#undef PG8_LDB
#undef PG8_MMA
#undef PG8_WAIT_V
#undef PG8_WAIT_L
#undef PG8_BAR
#undef PG8_SCHED
}
}
struct Params { const float* in[27]; float* out; unsigned char* ws; int ph_lo, ph_hi, pad0, pad1; };
enum { I_X = 0, I_MEM, I_POS, I_MIXG, I_WIN, I_POOLW, I_POOLS, I_CONVW, I_ALOG, I_DTB, I_DNG, I_WUPP, I_WUPM, I_WUPD, I_WOUT, I_XAG, I_MEMG, I_XAQ, I_XAKV, I_XAO,
       I_FFNG, I_DGU, I_DD, I_ROUTER, I_MGU, I_MD, I_FING };

struct Frame {
    LAS unsigned char* lds;
    int tid, lane, wave, G, blk;
    unsigned char* ws;
};

struct Job { const float* W; int K, N; bf16_t* WT; int ldt; int mode; int ff; const float* kscale; unsigned char* WT8; };
DI int job_map(int mode, int ff, int n) {
    if (mode == 0) return n;
    if (mode == 1) return n < 2560 ? n : (n < 2576 ? -1 : n - 16);
    if (n < ff) return (n >> 7) * 256 + (n & 127);
    const int m = n - ff; return (m >> 7) * 256 + 128 + (m & 127);
}
DI int job_items(const Job& J) { return (J.K / 64) * ((J.N + 31) / 32); }
DI void transpose_item(const Job& J, LAS float* scr, int item, int lane) {
    const int nblk = (J.N + 31) / 32, kb = item / nblk, nb = item - kb * nblk, k0 = 64 * kb, n0 = 32 * nb;
    const int nn = lane & 31; const bool ok = (n0 + nn) < J.N;
    float tv[32];
#pragma unroll
    for (int i = 0; i < 32; ++i) { const int kk = 2 * i + (lane >> 5); tv[i] = J.W[(size_t)(k0 + kk) * J.N + (ok ? n0 + nn : 0)]; }
#pragma unroll
    for (int i = 0; i < 32; ++i) { const int kk = 2 * i + (lane >> 5); float v = ok ? tv[i] : 0.f; if (J.kscale) v *= J.kscale[k0 + kk]; scr[kk * 33 + nn] = v; }
    LDS_WAIT();
    const int c = lane & 7;
#pragma unroll
    for (int j = 0; j < 4; ++j) { const int n = (lane >> 3) + 8 * j; const int sn = n0 + n; const int drow = sn < J.N ? job_map(J.mode, J.ff, sn) : -1;
        if (drow >= 0) { const LAS float* s = scr + (8 * c) * 33 + n;
            if (J.mode == 1 && drow >= 3072) { u32x2 o;
                o.x = cvt4_fp8(s[0 * 33] * 32.f, s[1 * 33] * 32.f, s[2 * 33] * 32.f, s[3 * 33] * 32.f); o.y = cvt4_fp8(s[4 * 33] * 32.f, s[5 * 33] * 32.f, s[6 * 33] * 32.f, s[7 * 33] * 32.f);
                *(u32x2*)(J.WT8 + (size_t)(drow - 3072) * 1024 + k0 + 8 * c) = o; }
            else { u32x4 o; o.x = pk2(s[0 * 33], s[1 * 33]); o.y = pk2(s[2 * 33], s[3 * 33]); o.z = pk2(s[4 * 33], s[5 * 33]); o.w = pk2(s[6 * 33], s[7 * 33]);
                *(u32x4*)(J.WT + (size_t)drow * J.ldt + k0 + 8 * c) = o; } } }
    LDS_WAIT();
}
constexpr int NJOBS = 2 * 7 + 2 + 16;
DI void get_job(const Frame& F, const Params& P, int j, Job& J) {
    unsigned char* ws = F.ws;
    J.mode = 0; J.ff = 0; J.kscale = nullptr; J.WT8 = nullptr;
    if (j < 14) { const int l = j / 7, t = j - 7 * l; unsigned char* lw = ws + WS_LW + (size_t)l * LW_STRIDE;
        if (t == 0) { J.W = P.in[I_WIN] + (size_t)l * 1024 * IN_COLS; J.K = 1024; J.N = IN_COLS; J.WT = (bf16_t*)(lw + LW_WIN); J.ldt = 1024; J.mode = 1; J.kscale = P.in[I_MIXG] + l * 1024; J.WT8 = ws + WS_WG8 + (size_t)l * 3072 * 1024; }
        else if (t == 1) { J.W = P.in[I_WUPM] + (size_t)l * 256 * 1024; J.K = 256; J.N = 1024; J.WT = (bf16_t*)(lw + LW_WCAT) + 256; J.ldt = 1024; }
        else if (t == 2) { J.W = P.in[I_WUPD] + (size_t)l * 512 * 1024; J.K = 512; J.N = 1024; J.WT = (bf16_t*)(lw + LW_WCAT) + 512; J.ldt = 1024; }
        else if (t == 3) { J.W = P.in[I_WOUT] + (size_t)l * 1024 * 1024; J.K = 1024; J.N = 1024; J.WT = (bf16_t*)(lw + LW_WOUT); J.ldt = 1024; }
        else if (t == 4) { J.W = P.in[I_XAQ] + (size_t)l * 1024 * 512; J.K = 1024; J.N = 512; J.WT = (bf16_t*)(lw + LW_WQ); J.ldt = 1024; J.kscale = P.in[I_XAG] + l * 1024; }
        else if (t == 5) { J.W = P.in[I_XAKV] + (size_t)l * 1024 * 1024; J.K = 1024; J.N = 1024; J.WT = (bf16_t*)(lw + LW_WKV); J.ldt = 1024; }
        else { J.W = P.in[I_XAO] + (size_t)l * 512 * 1024; J.K = 512; J.N = 1024; J.WT = (bf16_t*)(lw + LW_WO); J.ldt = 512; }
    } else if (j == 14) { J.W = P.in[I_DGU]; J.K = 1024; J.N = 2 * FF; J.WT = (bf16_t*)(ws + WS_WGU); J.ldt = 1024; J.mode = 2; J.ff = FF; J.kscale = P.in[I_FFNG]; }
    else if (j == 15) { J.W = P.in[I_DD]; J.K = FF; J.N = 1024; J.WT = (bf16_t*)(ws + WS_WD); J.ldt = FF; }
    else { const int e = (j - 16) >> 1;
        if (((j - 16) & 1) == 0) { J.W = P.in[I_MGU] + (size_t)e * 1024 * 2 * EFF; J.K = 1024; J.N = 2 * EFF; J.WT = (bf16_t*)(ws + WS_WMGU) + (size_t)e * 2 * EFF * 1024; J.ldt = 1024; J.mode = 2; J.ff = EFF; J.kscale = P.in[I_FFNG] + 1024; }
        else { J.W = P.in[I_MD] + (size_t)e * EFF * 1024; J.K = EFF; J.N = 1024; J.WT = (bf16_t*)(ws + WS_WMD) + (size_t)e * 1024 * EFF; J.ldt = EFF; } }
}

DI void phase_prologue(const Frame& F, const Params& P) {
    unsigned char* ws = F.ws;
    const int gw = F.blk * 8 + F.wave, NGW = F.G * 8, lane = F.lane;
    const long gt = (long)F.blk * 512 + F.tid, NGT = (long)F.G * 512;
    { const float* x = P.in[I_X]; bf16_t* xb = (bf16_t*)(ws + WS_XB); float* ssq = (float*)(ws + WS_SSQ); unsigned char* x8 = ws + WS_X8;
      for (int row0 = gw; row0 < NTOK; row0 += 4 * NGW) {
          f32x4 v[4][4];
#pragma unroll
          for (int q = 0; q < 4; ++q) { const int row = row0 + q * NGW; const f32x4* xr = (const f32x4*)(x + (size_t)(row < NTOK ? row : row0) * 1024) + lane;
#pragma unroll
              for (int j = 0; j < 4; ++j) v[q][j] = xr[64 * j]; }
#pragma unroll
          for (int q = 0; q < 4; ++q) { const int row = row0 + q * NGW; if (row < NTOK) { float s = 0.f;
#pragma unroll
              for (int j = 0; j < 4; ++j) s += (v[q][j].x * v[q][j].x + v[q][j].y * v[q][j].y) + (v[q][j].z * v[q][j].z + v[q][j].w * v[q][j].w);
              s = wave_sum(s);
              u32x2* o = (u32x2*)(xb + (size_t)row * 1024) + lane;
#pragma unroll
              for (int j = 0; j < 4; ++j) { u32x2 w; w.x = pk2(v[q][j].x, v[q][j].y); w.y = pk2(v[q][j].z, v[q][j].w); o[64 * j] = w;
                  ((unsigned*)(x8 + (size_t)row * 1024))[lane + 64 * j] = cvt4_fp8(v[q][j].x, v[q][j].y, v[q][j].z, v[q][j].w); }
              if (lane < 16) ssq[(size_t)row * 16 + lane] = lane == 0 ? s : 0.f; } }
      } }
    { const float* mem = P.in[I_MEM]; bf16_t* mn = (bf16_t*)(ws + WS_MEMN);
      for (int row = gw; row < 2048; row += NGW) {
          const f32x4* xr = (const f32x4*)(mem + (size_t)row * 1024) + lane; f32x4 v[4]; float s = 0.f;
#pragma unroll
          for (int j = 0; j < 4; ++j) { v[j] = xr[64 * j]; s += (v[j].x * v[j].x + v[j].y * v[j].y) + (v[j].z * v[j].z + v[j].w * v[j].w); }
          s = wave_sum(s); const float r = rsqrtf(s * (1.0f / 1024.0f) + RMS_EPS);
#pragma unroll
          for (int l = 0; l < 2; ++l) { const f32x4* gr = (const f32x4*)(P.in[I_MEMG] + l * 1024) + lane; u32x2* o = (u32x2*)(mn + ((size_t)l * 2048 + row) * 1024) + lane;
#pragma unroll
              for (int j = 0; j < 4; ++j) { const f32x4 gg = gr[64 * j]; u32x2 w; w.x = pk2(v[j].x * r * gg.x, v[j].y * r * gg.y); w.y = pk2(v[j].z * r * gg.z, v[j].w * r * gg.w); o[64 * j] = w; } }
      } }
    { const int* pos = (const int*)P.in[I_POS]; float* rope = (float*)(ws + WS_ROPE);
      for (long i = gt; i < (long)NTOK * 8; i += NGT) { const int tok = (int)(i >> 3), f = (int)(i & 7);
          const float inv = powf(500000.0f, -(float)f * 2.0f / 16.0f); const float ang = (float)pos[tok] * inv; float sn, cs; sincosf(ang, &sn, &cs);
          rope[(size_t)tok * 16 + f] = cs; rope[(size_t)tok * 16 + 8 + f] = sn; } }
    for (long i = gt; i < 2 * 16 * 1024; i += NGT) { const int l = (int)(i >> 14), j = (int)((i >> 10) & 15), k = (int)(i & 1023);
        const float v = P.in[I_WIN][((size_t)l * 1024 + k) * IN_COLS + 2560 + j] * P.in[I_MIXG][l * 1024 + k];
        ((bf16_t*)(ws + WS_LW + (size_t)l * LW_STRIDE + LW_WBA))[j * 1024 + k] = (bf16_t)f2bf(v); }
    for (long i = gt; i < 8 * 1024; i += NGT) { const int e = (int)(i >> 10), k = (int)(i & 1023); ((float*)(ws + WS_WR))[e * 1024 + k] = P.in[I_ROUTER][k * 8 + e] * P.in[I_FFNG][1024 + k]; }
    for (long i = gt; i < 2L * 256 * 1024; i += NGT) { const int l = (int)(i >> 18), k = (int)((i >> 10) & 255), n = (int)(i & 1023), gi = k >> 6, c = k & 63;
        const float* pw = P.in[I_POOLW] + (((size_t)l * 4 + gi) * 64 + c) * 64; const float* ps = P.in[I_POOLS] + l * 256 + gi * 64; const float* wu = P.in[I_WUPP] + ((size_t)l * 256 + gi * 64) * 1024 + n;
        float s = 0.f;
#pragma unroll 16
        for (int d = 0; d < 64; ++d) s += pw[d] * ps[d] * wu[(size_t)d * 1024];
        ((bf16_t*)(ws + WS_LW + (size_t)l * LW_STRIDE + LW_WCAT))[(size_t)n * 1024 + k] = (bf16_t)f2bf(s); }
    { float* sm = (float*)(ws + WS_SMALL);
      for (long i = gt; i < 2 * 4 * 1536; i += NGT) sm[SM_CONVW + i] = P.in[I_CONVW][i];
      for (long i = gt; i < 16; i += NGT) { sm[SM_ALOG + i] = P.in[I_ALOG][i]; sm[SM_DTB + i] = P.in[I_DTB][i]; }
      for (long i = gt; i < 128; i += NGT) sm[SM_DNG + i] = P.in[I_DNG][i];
      for (long i = gt; i < 1024; i += NGT) sm[SM_FING + i] = P.in[I_FING][i]; }
    { LAS float* scr = (LAS float*)(F.lds + F.wave * 8704);
      int base = 0;
      for (int j = 0; j < NJOBS; ++j) { Job J; get_job(F, P, j, J); const int ni = job_items(J);
          int first = gw - (base % NGW); if (first < 0) first += NGW;
          for (int it = first; it < ni; it += NGW) transpose_item(J, scr, it, lane);
          base += ni; } }
}
DI void ba_tiles(const Frame& F, const bf16_t* xbg, const bf16_t* Wba, const float* ssqg, float* BA) {
    const int lane = F.lane, gw = F.blk * 8 + F.wave, NGW = F.G * 8;
    for (int tile = gw; tile < NG / 16; tile += NGW) {
        const int row0 = tile * 16; f32x4 acc = (f32x4){0.f, 0.f, 0.f, 0.f};
        const bf16_t* ap = xbg + (size_t)(row0 + (lane & 15)) * 1024 + (lane >> 4) * 8; const bf16_t* bp = Wba + (size_t)(lane & 15) * 1024 + (lane >> 4) * 8;
#pragma unroll 8
        for (int ks = 0; ks < 32; ++ks) { const bf16x8 a = *(const bf16x8*)(ap + 32 * ks); const bf16x8 b = *(const bf16x8*)(bp + 32 * ks); acc = MFMA16(a, b, acc); }
#pragma unroll
        for (int i = 0; i < 4; ++i) { const int row = row0 + 4 * (lane >> 4) + i; BA[(size_t)row * 16 + (lane & 15)] = acc[i] * row_rstd(ssqg, row); }
    }
}

template <int W> DI void prep_pool_w(const bf16_t* Pb, bf16_t* BR, int ch, int lr0, int s0) {
    const bf16_t* p = Pb + PC_POOL + ch; float v[32 + W - 1];
#pragma unroll
    for (int i = 0; i < 32 + W - 1; ++i) { const int d = i - (W - 1); const bool ok = s0 + d >= 0; const unsigned short raw = p[(size_t)(ok ? lr0 + d : lr0) * PLD]; v[i] = ok ? bf2f(raw) : 0.f; }
    float sum = 0.f;
#pragma unroll
    for (int i = 0; i < W - 1; ++i) sum += v[i];
#pragma unroll
    for (int t = 0; t < 32; ++t) { const float x = v[t + W - 1]; sum += x; const int s = s0 + t;
        const float o = (s + 1 >= W ? sum * (1.0f / (float)W) : sum / (float)(s + 1)) - x;
        BR[(size_t)(lr0 + t) * 1024 + ch] = (bf16_t)f2bf(o);
        sum -= v[t]; }
}
DI void prep_pool(const Frame& F, const bf16_t* Pb, bf16_t* BR, int unit) {
    int tid_ = F.tid; LAUNDER_V(tid_);
    const int ch = tid_ & 255, half = tid_ >> 8, lr0 = unit * 64 + half * 32, s0 = lr0 & (SEQ - 1), g = F.wave & 3;
    if (g == 0) prep_pool_w<2>(Pb, BR, ch, lr0, s0); else if (g == 1) prep_pool_w<4>(Pb, BR, ch, lr0, s0); else if (g == 2) prep_pool_w<8>(Pb, BR, ch, lr0, s0); else prep_pool_w<16>(Pb, BR, ch, lr0, s0);
}

DI void prep_moba(const Frame& F, bf16_t* Pb, const float* rope, float* KBAR, bf16_t* VT, int unit) {
    int tid_ = F.tid; LAUNDER_V(tid_);
    const int tid = tid_, lane = tid & 63, wave = F.wave;
    const int bl = unit >> 6, j = (unit >> 1) & 31, hp = unit & 1, lr0 = bl * SEQ + j * 256;
    LAS unsigned* Tt = (LAS unsigned*)F.lds; LAS float* KS1 = (LAS float*)(F.lds + 68 * 1024); LAS float* KS2 = KS1 + 128;
    __syncthreads();
    const int r = tid & 255, hh = tid >> 8; const size_t lr = (size_t)(lr0 + r);
    bf16_t* qb = Pb + lr * PLD + PC_MQ + (2 * hp + hh) * 64; bf16_t* kb = Pb + lr * PLD + PC_MK + (2 * hp + hh) * 64;
    const f32x4 c0 = *(const f32x4*)(rope + lr * 16), c1 = *(const f32x4*)(rope + lr * 16 + 4), s0 = *(const f32x4*)(rope + lr * 16 + 8), s1 = *(const f32x4*)(rope + lr * 16 + 12);
    const u32x4 qa = *(const u32x4*)qb, qc = *(const u32x4*)(qb + 8), ka = *(const u32x4*)kb, kc = *(const u32x4*)(kb + 8);
    const int c8 = tid & 15, rg = tid >> 4; const bool plain = (c8 & 7) >= 2;
    u32x4 vv[8], kk[8];
#pragma unroll
    for (int i = 0; i < 8; ++i) vv[i] = *(const u32x4*)(Pb + (size_t)(lr0 + ((tid + 512 * i) >> 4)) * PLD + PC_MV + hp * 128 + c8 * 8);
#pragma unroll
    for (int i = 0; i < 8; ++i) kk[i] = plain ? *(const u32x4*)(Pb + (size_t)(lr0 + rg * 8 + i) * PLD + PC_MK + hp * 128 + c8 * 8) : (u32x4){0u, 0u, 0u, 0u};
    __builtin_amdgcn_sched_barrier(0);
    {
        const float cs[8] = {c0.x, c0.y, c0.z, c0.w, c1.x, c1.y, c1.z, c1.w}, sn[8] = {s0.x, s0.y, s0.z, s0.w, s1.x, s1.y, s1.z, s1.w};
        float q1[8], q2[8], k1[8], k2[8];
#pragma unroll
        for (int q = 0; q < 4; ++q) { q1[2 * q] = __uint_as_float(qa[q] << 16); q1[2 * q + 1] = __uint_as_float(qa[q] & 0xffff0000u); q2[2 * q] = __uint_as_float(qc[q] << 16); q2[2 * q + 1] = __uint_as_float(qc[q] & 0xffff0000u);
                                      k1[2 * q] = __uint_as_float(ka[q] << 16); k1[2 * q + 1] = __uint_as_float(ka[q] & 0xffff0000u); k2[2 * q] = __uint_as_float(kc[q] << 16); k2[2 * q + 1] = __uint_as_float(kc[q] & 0xffff0000u); }
        float ra[8], rb[8]; u32x4 oa, ob;
#pragma unroll
        for (int e = 0; e < 8; ++e) { ra[e] = q1[e] * cs[e] - q2[e] * sn[e]; rb[e] = q2[e] * cs[e] + q1[e] * sn[e]; }
#pragma unroll
        for (int q = 0; q < 4; ++q) { oa[q] = pk2(ra[2 * q], ra[2 * q + 1]); ob[q] = pk2(rb[2 * q], rb[2 * q + 1]); }
        *(u32x4*)qb = oa; *(u32x4*)(qb + 8) = ob;
#pragma unroll
        for (int e = 0; e < 8; ++e) { ra[e] = k1[e] * cs[e] - k2[e] * sn[e]; rb[e] = k2[e] * cs[e] + k1[e] * sn[e]; }
#pragma unroll
        for (int q = 0; q < 4; ++q) { oa[q] = pk2(ra[2 * q], ra[2 * q + 1]); ob[q] = pk2(rb[2 * q], rb[2 * q + 1]); }
        *(u32x4*)kb = oa; *(u32x4*)(kb + 8) = ob;
#pragma unroll
        for (int e = 0; e < 8; ++e) { const float a = wave_sum(ra[e]), b = wave_sum(rb[e]); if (lane == 0) { KS1[wave * 16 + e] = a; KS1[wave * 16 + 8 + e] = b; } }
    }
    {
        float sacc[8];
#pragma unroll
        for (int e = 0; e < 8; ++e) sacc[e] = 0.f;
#pragma unroll
        for (int i = 0; i < 8; ++i)
#pragma unroll
            for (int q = 0; q < 4; ++q) { sacc[2 * q] += __uint_as_float(kk[i][q] << 16); sacc[2 * q + 1] += __uint_as_float(kk[i][q] & 0xffff0000u); }
#pragma unroll
        for (int e = 0; e < 8; ++e) { sacc[e] += __shfl_xor(sacc[e], 16); sacc[e] += __shfl_xor(sacc[e], 32); }
        if (lane < 16) {
#pragma unroll
            for (int e = 0; e < 8; ++e) KS2[wave * 128 + c8 * 8 + e] = sacc[e]; }
    }
#pragma unroll
    for (int i = 0; i < 8; ++i) { const int tok = (tid + 512 * i) >> 4;
#pragma unroll
        for (int e = 0; e < 4; ++e) Tt[tok * 65 + c8 * 4 + e] = vv[i][e]; }
    __syncthreads();
    if (tid < 128) { const int h2 = tid >> 6, d = tid & 63; float sum = 0.f;
        if (d < 16) {
#pragma unroll
            for (int w = 0; w < 4; ++w) sum += KS1[(4 * h2 + w) * 16 + d]; }
        else {
#pragma unroll
            for (int w = 0; w < 8; ++w) sum += KS2[w * 128 + tid]; }
        KBAR[((size_t)(bl * 4 + 2 * hp + h2) * 32 + j) * 64 + d] = sum * (1.0f / 256.0f); }
    const LAS unsigned char* Tb = (const LAS unsigned char*)Tt;
#pragma unroll
    for (int i = 0; i < 8; ++i) { const int o = tid + 512 * i, t8 = o & 7, cl = (o >> 3) & 7, rest = o >> 6, th = rest & 3, cg = rest >> 2, col = cg * 8 + cl, tg = th * 8 + t8;
        unsigned short hv[8];
#pragma unroll
        for (int e = 0; e < 8; ++e) hv[e] = *(const LAS unsigned short*)(Tb + ((tg * 8 + e) * 65 + (col >> 1)) * 4 + (col & 1) * 2);
        u32x4 w;
#pragma unroll
        for (int e = 0; e < 4; ++e) w[e] = (unsigned)hv[2 * e] | ((unsigned)hv[2 * e + 1] << 16);
        *(u32x4*)(VT + ((size_t)(bl * 256 + hp * 128 + col)) * SEQ + j * 256 + tg * 8) = w; }
    __syncthreads();
}

constexpr int DN_ROWB = 144;
constexpr int DN_TQ = 0, DN_TK = 9216, DN_TKB = 18432, DN_TVB = 27648, DN_MISC = 36864, DN_PAIR = 38400;
__host__ __device__ constexpr int ap_rowoff(int i) { return i == 0 ? 0 : 4 * (((i - 1) / 4) + 1) * (2 * ((i - 1) / 4) + ((i - 1) % 4)); }

template <int I> DI void subst_load(const LAS float* Ap, const LAS unsigned char* Rt, const LAS float* SCL, int lane, f32x4 (&av)[16], float& Ri) {
    constexpr int off = ap_rowoff(I);
#pragma unroll
    for (int j4 = 0; j4 < I; j4 += 4) av[j4 >> 2] = *(const LAS f32x4*)(Ap + off + j4);
    Ri = bf2f(*(const LAS bf16_t*)(Rt + I * DN_ROWB + lane * 2)) * SCL[I];
}
template <int I> struct Subst2 { static DI void run(float (&x)[64], const LAS float* Ap, const LAS unsigned char* Rt, const LAS float* SCL, int lane, f32x4 (&cur)[16], float Rc, f32x4 (&nxt)[16]) {
    float Rn = 0.f;
    if constexpr (I + 1 < 64) subst_load<I + 1>(Ap, Rt, SCL, lane, nxt, Rn);
    float a0 = Rc, a1 = 0.f, a2 = 0.f, a3 = 0.f;
#pragma unroll
    for (int j4 = 0; j4 < I; j4 += 4) { const f32x4 av = cur[j4 >> 2];
        a0 -= av.x * x[j4];
        if (j4 + 1 < I) a1 -= av.y * x[j4 + 1];
        if (j4 + 2 < I) a2 -= av.z * x[j4 + 2];
        if (j4 + 3 < I) a3 -= av.w * x[j4 + 3]; }
    x[I] = (a0 + a1) + (a2 + a3);
    asm volatile("" : "+v"(x[I])); __builtin_amdgcn_sched_barrier(0);
    if constexpr (I + 1 < 64) Subst2<I + 1>::run(x, Ap, Rt, SCL, lane, nxt, Rn, cur);
} };

DI void conv_w_load(const float* convw, int wcol, float (&w)[4][8]) {
#pragma unroll
    for (int j = 0; j < 4; ++j) { const f32x4 w0 = *(const f32x4*)(convw + j * 1536 + wcol), w1 = *(const f32x4*)(convw + j * 1536 + wcol + 4);
        w[j][0] = w0.x; w[j][1] = w0.y; w[j][2] = w0.z; w[j][3] = w0.w; w[j][4] = w1.x; w[j][5] = w1.y; w[j][6] = w1.z; w[j][7] = w1.w; }
}
DI void conv8(const bf16_t* Pb, const float (&w)[4][8], int lr, int s, int pcol8, float (&a)[8]) {
#pragma unroll
    for (int e = 0; e < 8; ++e) a[e] = 0.f;
    u32x4 xv[4];
#pragma unroll
    for (int j = 0; j < 4; ++j) { const bool valid = (s - 3 + j) >= 0; xv[j] = *(const u32x4*)(Pb + (size_t)(valid ? lr - 3 + j : lr) * PLD + pcol8);
        xv[j].x = valid ? xv[j].x : 0u; xv[j].y = valid ? xv[j].y : 0u; xv[j].z = valid ? xv[j].z : 0u; xv[j].w = valid ? xv[j].w : 0u; }
#pragma unroll
    for (int j = 0; j < 4; ++j) {
        a[0] += w[j][0] * __uint_as_float(xv[j][0] << 16); a[1] += w[j][1] * __uint_as_float(xv[j][0] & 0xffff0000u);
        a[2] += w[j][2] * __uint_as_float(xv[j][1] << 16); a[3] += w[j][3] * __uint_as_float(xv[j][1] & 0xffff0000u);
        a[4] += w[j][4] * __uint_as_float(xv[j][2] << 16); a[5] += w[j][5] * __uint_as_float(xv[j][2] & 0xffff0000u);
        a[6] += w[j][6] * __uint_as_float(xv[j][3] << 16); a[7] += w[j][7] * __uint_as_float(xv[j][3] & 0xffff0000u);
    }
#pragma unroll
    for (int e = 0; e < 8; ++e) a[e] = a[e] * fsigmoid(a[e]);
}
DI float ssq8(const float (&a)[8]) { float ss = 0.f;
#pragma unroll
    for (int e = 0; e < 8; ++e) ss += a[e] * a[e];
    ss += __shfl_xor(ss, 1); ss += __shfl_xor(ss, 2); ss += __shfl_xor(ss, 4); return ss; }
DI u32x4 pack8(const float (&a)[8], float sc) { u32x4 w; w.x = pk2(a[0] * sc, a[1] * sc); w.y = pk2(a[2] * sc, a[3] * sc); w.z = pk2(a[4] * sc, a[5] * sc); w.w = pk2(a[6] * sc, a[7] * sc); return w; }

#ifndef DBG_RA
#define DBG_RA 1
#endif
#ifndef DBG_RB
#define DBG_RB 1
#endif
#ifndef DBG_RC
#define DBG_RC 1
#endif
#ifndef DBG_RD
#define DBG_RD 1
#endif
#ifndef DBG_RB2
#define DBG_RB2 1
#endif
DI void prep_dn(const Frame& F, const bf16_t* Pb, const float* BA, const float* convw, const float* alog, const float* dtb,
                bf16_t* QD, bf16_t* MM, bf16_t* NT, bf16_t* WN, bf16_t* UT, bf16_t* AQK, float* GL, int unit) {
    int lane_ = F.lane; LAUNDER_V(lane_);
    const int lane = lane_, wave = F.wave, pr = wave >> 1, role = wave & 1;
    const int bl = unit >> 8, rem = unit & 255, n = rem >> 1, hq = rem & 1, h = 4 * hq + pr;
    const int lr0 = bl * SEQ + n * 64;
    const int chidx = (bl * 128 + n) * 8 + h;
    LAS unsigned char* L = F.lds + pr * DN_PAIR;
    LAS float* Gs = (LAS float*)(L + DN_MISC); LAS float* EG = Gs + 64; LAS float* EGL = Gs + 128; LAS float* ONES = Gs + 192; LAS float* BETA = Gs + 256 + 64 * role;
    {
        const int lr = lr0 + lane;
        const float braw = BA[(size_t)lr * 16 + h], araw = BA[(size_t)lr * 16 + 8 + h];
        const float beta = fsigmoid(braw);
        const float xa = araw + dtb[h]; const float sp = xa > 20.f ? xa : log1pf(__expf(xa));
        float G = -__expf(alog[h]) * sp;
#pragma unroll
        for (int o = 1; o < 64; o <<= 1) { const float up = __shfl_up(G, o); if (lane >= o) G += up; }
        const float Glast = __shfl(G, 63);
        BETA[lane] = beta;
        if (role == 0) { Gs[lane] = G; EG[lane] = __expf(G); EGL[lane] = __expf(Glast - G); ONES[lane] = 1.0f; if (lane == 0) GL[chidx] = __expf(Glast); }
    }
    LDS_WAIT();
    for (int rpA = 0; rpA < DBG_RA; ++rpA) {
        const int cg = lane & 7, tl = lane >> 3; float w[4][8];
        if (role == 0) {
            conv_w_load(convw, h * 64 + cg * 8, w);
#pragma unroll 4
            for (int ps = 0; ps < 8; ++ps) { const int t = ps * 8 + tl; float a[8]; conv8(Pb, w, lr0 + t, n * 64 + t, PC_DQ + h * 64 + cg * 8, a);
                const float rn = rsqrtf(ssq8(a) + RMS_EPS) * 0.125f;
                *(LAS u32x4*)(L + DN_TQ + t * DN_ROWB + cg * 16) = pack8(a, rn); }
        } else {
            conv_w_load(convw, 512 + h * 64 + cg * 8, w);
#pragma unroll 4
            for (int ps = 0; ps < 8; ++ps) { const int t = ps * 8 + tl; float a[8]; conv8(Pb, w, lr0 + t, n * 64 + t, PC_DK + h * 64 + cg * 8, a);
                const float rn = rsqrtf(ssq8(a) + RMS_EPS);
                *(LAS u32x4*)(L + DN_TK + t * DN_ROWB + cg * 16) = pack8(a, rn); *(LAS u32x4*)(L + DN_TKB + t * DN_ROWB + cg * 16) = pack8(a, rn * BETA[t]); }
        }
        conv_w_load(convw, 1024 + h * 64 + cg * 8, w);
#pragma unroll 4
        for (int ps = 4 * role; ps < 4 * role + 4; ++ps) { const int t = ps * 8 + tl; float a[8]; conv8(Pb, w, lr0 + t, n * 64 + t, PC_DV + h * 64 + cg * 8, a);
            *(LAS u32x4*)(L + DN_TVB + t * DN_ROWB + cg * 16) = pack8(a, BETA[t]); }
    }
    WG_BAR();
    for (int rpB = 0; rpB < DBG_RB; ++rpB) {
        const int fr = lane & 15, fq = lane >> 4;
#pragma unroll
        for (int tt = 0; tt < 8; ++tt) { const int tile = 2 * tt + role, it = tile >> 2, jt = tile & 3;
            f32x4 acc = (f32x4){0.f, 0.f, 0.f, 0.f};
            if (jt <= it) {
#pragma unroll
                for (int ks = 0; ks < 2; ++ks) { const bf16x8 a = *(const LAS bf16x8*)(L + DN_TK + (16 * jt + fr) * DN_ROWB + (fq * 8 + 32 * ks) * 2);
                    const bf16x8 b = *(const LAS bf16x8*)(L + DN_TQ + (16 * it + fr) * DN_ROWB + (fq * 8 + 32 * ks) * 2); acc = MFMA16(a, b, acc); } }
            const int ii = 16 * it + fr; const float Gi = Gs[ii]; float v[4];
#pragma unroll
            for (int r = 0; r < 4; ++r) { const int jj = 16 * jt + 4 * fq + r; v[r] = (jj <= ii) ? acc[r] * __expf(Gi - Gs[jj]) : 0.f; }
            u32x2 w; w.x = pk2(v[0], v[1]); w.y = pk2(v[2], v[3]);
            *(u32x2*)(AQK + (size_t)chidx * 4096 + ii * 64 + 16 * jt + 4 * fq) = w;
        }
#pragma unroll
        for (int i = 0; i < 4; ++i) { const int idx = lane + 64 * role + 128 * i, t = idx >> 3, cg = idx & 7; const u32x4 qv = *(const LAS u32x4*)(L + DN_TQ + t * DN_ROWB + cg * 16); const float eg = EG[t]; u32x4 w;
#pragma unroll
            for (int e = 0; e < 4; ++e) w[e] = pk2(__uint_as_float(qv[e] << 16) * eg, __uint_as_float(qv[e] & 0xffff0000u) * eg);
            *(u32x4*)(QD + (size_t)chidx * 4096 + t * 64 + cg * 8) = w; }
    }
    WG_BAR();
    for (int rpB2 = 0; rpB2 < DBG_RB2; ++rpB2) {
        const int fr = lane & 15, fq = lane >> 4; LAS float* Ap = (LAS float*)(L + DN_TQ);
#pragma unroll
        for (int tt = 0; tt < 5; ++tt) { const int q = 2 * tt + role;
            const int it = q < 1 ? 0 : (q < 3 ? 1 : (q < 6 ? 2 : 3)), jt = q - (it * (it + 1)) / 2;
            f32x4 acc = (f32x4){0.f, 0.f, 0.f, 0.f};
#pragma unroll
            for (int ks = 0; ks < 2; ++ks) { const bf16x8 a = *(const LAS bf16x8*)(L + DN_TKB + (16 * it + fr) * DN_ROWB + (fq * 8 + 32 * ks) * 2);
                const bf16x8 b = *(const LAS bf16x8*)(L + DN_TK + (16 * jt + fr) * DN_ROWB + (fq * 8 + 32 * ks) * 2); acc = MFMA16(a, b, acc); }
            const int jj = 16 * jt + fr; const float Gj = Gs[jj];
#pragma unroll
            for (int r = 0; r < 4; ++r) { const int ii = 16 * it + 4 * fq + r;
                if (jj < ii) { const int m1 = ii - 1, gf = m1 >> 2, rm = m1 & 3; Ap[4 * (gf + 1) * (2 * gf + rm) + jj] = acc[r] * __expf(Gs[ii] - Gj); } }
        }
    }
    u32x4 kdt[4];
#pragma unroll
    for (int i = 0; i < 4; ++i) { const int idx = lane + 64 * role + 128 * i, d = idx >> 3, tc = idx & 7; unsigned short kv[8];
#pragma unroll
        for (int e = 0; e < 8; ++e) kv[e] = *(const LAS bf16_t*)(L + DN_TK + (tc * 8 + e) * DN_ROWB + d * 2);
#pragma unroll
        for (int e = 0; e < 4; ++e) kdt[i][e] = pk2(bf2f(kv[2 * e]) * EGL[tc * 8 + 2 * e], bf2f(kv[2 * e + 1]) * EGL[tc * 8 + 2 * e + 1]); }
    WG_BAR();
#pragma unroll
    for (int i = 0; i < 4; ++i) { const int idx = lane + 64 * role + 128 * i, d = idx >> 3, tc = idx & 7; *(LAS u32x4*)(L + DN_TK + d * DN_ROWB + tc * 16) = kdt[i]; }
    for (int rpC = 0; rpC < DBG_RC; ++rpC) {
        float x[64];
        LAS unsigned char* const RT = L + DN_TVB - role * (DN_TVB - DN_TKB);
        { f32x4 avA[16], avB[16]; float R0; subst_load<0>((const LAS float*)(L + DN_TQ), RT, Gs + 192 - role * 128, lane, avA, R0);
          Subst2<0>::run(x, (const LAS float*)(L + DN_TQ), RT, Gs + 192 - role * 128, lane, avA, R0, avB); }
        { LAS unsigned char* T = RT + lane * DN_ROWB;
#pragma unroll
          for (int cg = 0; cg < 8; ++cg) { u32x4 w; w.x = pk2(x[cg * 8], x[cg * 8 + 1]); w.y = pk2(x[cg * 8 + 2], x[cg * 8 + 3]); w.z = pk2(x[cg * 8 + 4], x[cg * 8 + 5]); w.w = pk2(x[cg * 8 + 6], x[cg * 8 + 7]);
              *(LAS u32x4*)(T + cg * 16) = w; if (role == 0) *((u32x4*)(UT + (size_t)chidx * 4096 + lane * 64) + cg) = w; } }
    }
    WG_BAR();
#pragma unroll
    for (int i = 0; i < 4; ++i) { const int idx = lane + 64 * role + 128 * i, cg = idx >> 6, t = idx & 63; unsigned short wv[8];
#pragma unroll
        for (int e = 0; e < 8; ++e) wv[e] = *(const LAS bf16_t*)(L + DN_TKB + (cg * 8 + e) * DN_ROWB + t * 2);
        u32x4 w;
#pragma unroll
        for (int e = 0; e < 4; ++e) w[e] = ((unsigned)wv[2 * e] | ((unsigned)wv[2 * e + 1] << 16)) ^ 0x80008000u;
        *(u32x4*)(WN + (size_t)chidx * 4096 + t * 64 + cg * 8) = w; }
    for (int rpD = 0; rpD < DBG_RD; ++rpD) {
        const int fr = lane & 15, fq = lane >> 4; const float glast = EG[63];
#pragma unroll
        for (int tt = 0; tt < 8; ++tt) { const int tile = 2 * tt + role, mt = tile >> 2, nt = tile & 3;
            f32x4 acc = (f32x4){0.f, 0.f, 0.f, 0.f};
#pragma unroll
            for (int ks = 0; ks < 2; ++ks) { const bf16x8 a = *(const LAS bf16x8*)(L + DN_TKB + (16 * mt + fr) * DN_ROWB + (fq * 8 + 32 * ks) * 2);
                const bf16x8 b = *(const LAS bf16x8*)(L + DN_TK + (16 * nt + fr) * DN_ROWB + (fq * 8 + 32 * ks) * 2); acc = MFMA16(a, b, acc); }
            { const int dko = 16 * nt + fr, dki0 = 16 * mt + 4 * fq; u32x2 w;
              w.x = pk2((dko == dki0 ? glast : 0.f) - acc[0], (dko == dki0 + 1 ? glast : 0.f) - acc[1]); w.y = pk2((dko == dki0 + 2 ? glast : 0.f) - acc[2], (dko == dki0 + 3 ? glast : 0.f) - acc[3]);
              *(u32x2*)(MM + (size_t)chidx * 4096 + dko * 64 + dki0) = w; }
            acc = (f32x4){0.f, 0.f, 0.f, 0.f};
#pragma unroll
            for (int ks = 0; ks < 2; ++ks) { const bf16x8 a = *(const LAS bf16x8*)(L + DN_TK + (16 * mt + fr) * DN_ROWB + (fq * 8 + 32 * ks) * 2);
                const bf16x8 b = *(const LAS bf16x8*)(L + DN_TVB + (16 * nt + fr) * DN_ROWB + (fq * 8 + 32 * ks) * 2); acc = MFMA16(a, b, acc); }
            { u32x2 w; w.x = pk2(acc[0], acc[1]); w.y = pk2(acc[2], acc[3]); *(u32x2*)(NT + (size_t)chidx * 4096 + (16 * nt + fr) * 64 + 16 * mt + 4 * fq) = w; }
        }
    }
    WG_BAR();
}
constexpr int SC_ROWB = 144;
constexpr int SC_ST = 0, SC_VT = 64 * SC_ROWB, SC_RS = 2 * 64 * SC_ROWB;
DI void dn_scan(const Frame& F, int chain, const bf16_t* MM, const bf16_t* NT, bf16_t* SG, int nb, int ne, bool do_store = true) {
    const int lane = F.lane, wave = F.wave, rt = wave & 3, fr = lane & 15, fq = lane >> 4; const bool worker = wave < 4;
    const int bl = chain >> 3, h = chain & 7;
    LAS unsigned char* L = F.lds;
    if (nb == 0) for (int i = F.tid; i < 64 * SC_ROWB / 4; i += 512) ((LAS unsigned*)L)[i] = 0u;
    const size_t cstride = (size_t)8 * 4096;
    size_t cb = (size_t)((bl * 128 + nb) * 8 + h) * 4096;
    const int aoffs = (16 * rt + fr) * 64 + fq * 8;
    const int coff0 = fr * 64 + 16 * rt + 4 * fq;
    if (worker && nb == 0) {
#pragma unroll
        for (int nt = 0; nt < 4; ++nt) *(u32x2*)(SG + cb + coff0 + 1024 * nt) = (u32x2){0u, 0u}; }
    bf16x8 a[4][2]; u32x2 nc[4][4];
    if (worker) {
#pragma unroll
        for (int j = 0; j < 4; ++j) { const size_t cj = cb + (size_t)(nb + j < 127 ? j : 0) * cstride;
#pragma unroll
            for (int ks = 0; ks < 2; ++ks) a[j][ks] = *(const bf16x8*)(MM + cj + aoffs + 32 * ks);
#pragma unroll
            for (int nt = 0; nt < 4; ++nt) nc[j][nt] = *(const u32x2*)(NT + cj + coff0 + 1024 * nt); } }
    __syncthreads();
#pragma unroll 1
    for (int n0 = nb; n0 < ne; n0 += 16) {
#pragma unroll
        for (int jj = 0; jj < 16; ++jj) { const int j = jj & 3; const int n = n0 + jj;
            if (n < ne) {
                const size_t cbn = cb + cstride;
                if (worker) {
                    LAS unsigned char* SR = L + (n & 1) * 64 * SC_ROWB; LAS unsigned char* SW = L + ((n + 1) & 1) * 64 * SC_ROWB;
#pragma unroll
                    for (int nt = 0; nt < 4; ++nt) {
                        f32x4 acc = (f32x4){__uint_as_float(nc[j][nt].x << 16), __uint_as_float(nc[j][nt].x & 0xffff0000u), __uint_as_float(nc[j][nt].y << 16), __uint_as_float(nc[j][nt].y & 0xffff0000u)};
#pragma unroll
                        for (int ks = 0; ks < 2; ++ks) { const bf16x8 sb = *(const LAS bf16x8*)(SR + (16 * nt + fr) * SC_ROWB + (fq * 8 + 32 * ks) * 2); acc = MFMA16(a[j][ks], sb, acc); }
                        u32x2 w; w.x = cvt_pk_bf16(acc[0], acc[1]); w.y = cvt_pk_bf16(acc[2], acc[3]);
                        *(LAS u32x2*)(SW + (16 * nt + fr) * SC_ROWB + (16 * rt + 4 * fq) * 2) = w;
                        if (do_store) *(u32x2*)(SG + cbn + coff0 + 1024 * nt) = w;
                    }
                    if (n + 4 < 127) { const size_t c4 = cb + 4 * cstride;
#pragma unroll
                        for (int ks = 0; ks < 2; ++ks) a[j][ks] = *(const bf16x8*)(MM + c4 + aoffs + 32 * ks);
#pragma unroll
                        for (int nt = 0; nt < 4; ++nt) nc[j][nt] = *(const u32x2*)(NT + c4 + coff0 + 1024 * nt); }
                }
                WG_BAR();
                cb = cbn;
            }
        }
    }
    __syncthreads();
}

struct OutOps { bf16x8 wn[2], qd[2], aq[2], sb[4][2]; u32x2 uv[4]; unsigned short zv[16]; };
DI void out_load(OutOps& o, int k, int rt, int fr, int fq, const bf16_t* QD, const bf16_t* WN, const bf16_t* UT, const bf16_t* AQK, const bf16_t* SG, const bf16_t* ZB) {
    const size_t cb = (size_t)k * 4096; const int arow = 16 * rt + fr; const int h = k & 7, n = (k >> 3) & 127, bl = k >> 10;
#pragma unroll
    for (int ks = 0; ks < 2; ++ks) { const size_t off = cb + arow * 64 + fq * 8 + 32 * ks;
        o.wn[ks] = *(const bf16x8*)(WN + off); o.qd[ks] = *(const bf16x8*)(QD + off); o.aq[ks] = *(const bf16x8*)(AQK + off); }
#pragma unroll
    for (int nt = 0; nt < 4; ++nt) { o.uv[nt] = *(const u32x2*)(UT + cb + (16 * nt + fr) * 64 + 16 * rt + 4 * fq);
#pragma unroll
        for (int ks = 0; ks < 2; ++ks) o.sb[nt][ks] = *(const bf16x8*)(SG + cb + (16 * nt + fr) * 64 + fq * 8 + 32 * ks); }
    const int lrb = bl * SEQ + n * 64 + 16 * rt + 4 * fq;
#pragma unroll
    for (int r = 0; r < 4; ++r)
#pragma unroll
        for (int nt = 0; nt < 4; ++nt) o.zv[r * 4 + nt] = ZB[(size_t)(lrb + r) * 512 + h * 64 + 16 * nt + fr];
}
DI void dn_out_pass(const Frame& F, const bf16_t* QD, const bf16_t* WN, const bf16_t* UT, const bf16_t* AQK, const bf16_t* SG, const bf16_t* ZB, const float* dng, bf16_t* BR) {
    int lane_ = F.lane; LAUNDER_V(lane_);
    const int lane = lane_, wave = F.wave, rt = wave & 3, half = wave >> 2, fr = lane & 15, fq = lane >> 4;
    LAS unsigned char* L = F.lds;
    float ng[4];
#pragma unroll
    for (int nt = 0; nt < 4; ++nt) ng[nt] = dng[16 * nt + fr];
    int p = F.blk; if (p >= NCH / 2) return;
    OutOps cur, nxt;
    out_load(cur, 2 * p + half, rt, fr, fq, QD, WN, UT, AQK, SG, ZB);
    __syncthreads();
    for (int it = 0; p < NCH / 2; p += F.G, ++it) {
        const int k = 2 * p + half, pn = p + F.G < NCH / 2 ? p + F.G : p;
        out_load(nxt, 2 * pn + half, rt, fr, fq, QD, WN, UT, AQK, SG, ZB);
        const int h = k & 7, n = (k >> 3) & 127, bl = k >> 10;
        LAS unsigned char* VT = L + ((it & 1) * 2 + half) * 64 * SC_ROWB;
        f32x4 vn[4], o[4];
#pragma unroll
        for (int nt = 0; nt < 4; ++nt) { vn[nt] = (f32x4){__uint_as_float(cur.uv[nt].x << 16), __uint_as_float(cur.uv[nt].x & 0xffff0000u), __uint_as_float(cur.uv[nt].y << 16), __uint_as_float(cur.uv[nt].y & 0xffff0000u)};
            o[nt] = (f32x4){0.f, 0.f, 0.f, 0.f};
#pragma unroll
            for (int ks = 0; ks < 2; ++ks) { vn[nt] = MFMA16(cur.wn[ks], cur.sb[nt][ks], vn[nt]); o[nt] = MFMA16(cur.qd[ks], cur.sb[nt][ks], o[nt]); } }
#pragma unroll
        for (int nt = 0; nt < 4; ++nt) { u32x2 w; w.x = cvt_pk_bf16(vn[nt][0], vn[nt][1]); w.y = cvt_pk_bf16(vn[nt][2], vn[nt][3]);
            *(LAS u32x2*)(VT + (16 * nt + fr) * SC_ROWB + (16 * rt + 4 * fq) * 2) = w; }
        WG_BAR();
#pragma unroll
        for (int nt = 0; nt < 4; ++nt)
#pragma unroll
            for (int ks = 0; ks < 2; ++ks) { const bf16x8 vb = *(const LAS bf16x8*)(VT + (16 * nt + fr) * SC_ROWB + (fq * 8 + 32 * ks) * 2); o[nt] = MFMA16(cur.aq[ks], vb, o[nt]); }
        const int lrb = bl * SEQ + n * 64 + 16 * rt + 4 * fq;
#pragma unroll
        for (int r = 0; r < 4; ++r) { float q = (o[0][r] * o[0][r] + o[1][r] * o[1][r]) + (o[2][r] * o[2][r] + o[3][r] * o[3][r]);
            q += __shfl_xor(q, 1); q += __shfl_xor(q, 2); q += __shfl_xor(q, 4); q += __shfl_xor(q, 8);
            const float rs = rsqrtf(q * (1.0f / 64.0f) + RMS_EPS); const size_t lr = (size_t)(lrb + r);
#pragma unroll
            for (int nt = 0; nt < 4; ++nt) { const float z = bf2f(cur.zv[r * 4 + nt]);
                BR[lr * 1024 + 512 + h * 64 + 16 * nt + fr] = (bf16_t)f2bf(o[nt][r] * rs * ng[nt] * (z * fsigmoid(z))); } }
        cur = nxt;
    }
    __syncthreads();
}

constexpr int MG_QS = 0, MG_KB = 36864, MG_SEL = MG_KB + 8192, MG_TOP = MG_SEL + 1024;
DI void moba_gate_unit(const Frame& F, const bf16_t* Pb, const float* KBAR, unsigned* SELG, unsigned char* LISTG, int* CNTG, int bl, int h, int c) {
    int lane_ = F.lane; LAUNDER_V(lane_);
    const int lane = lane_, wave = F.wave, tid = wave * 64 + lane;
    LAS unsigned char* L = F.lds; LAS float* KB = (LAS float*)(L + MG_KB); LAS unsigned* SEL = (LAS unsigned*)(L + MG_SEL);
    const int q0 = bl * SEQ + c * 256, bh = bl * 4 + h;
    __syncthreads();
#pragma unroll
    for (int i = 0; i < 4; ++i) { const int q = tid + 512 * i, r = q >> 3, c8 = q & 7; *(LAS u32x4*)(L + MG_QS + r * 144 + c8 * 16) = *(const u32x4*)(Pb + (size_t)(q0 + r) * PLD + PC_MQ + h * 64 + c8 * 8); }
    for (int i = tid; i < c * 64; i += 512) KB[i] = KBAR[(size_t)bh * 2048 + i];
    __syncthreads();
    {
        const int qi = tid & 255, par = tid >> 8;
        float qv[64];
#pragma unroll
        for (int c8 = 0; c8 < 8; ++c8) { const u32x4 v = *(const LAS u32x4*)(L + MG_QS + qi * 144 + c8 * 16);
#pragma unroll
            for (int e = 0; e < 4; ++e) { qv[c8 * 8 + 2 * e] = __uint_as_float(v[e] << 16); qv[c8 * 8 + 2 * e + 1] = __uint_as_float(v[e] & 0xffff0000u); } }
        float v1 = -INFINITY, v2 = -INFINITY, v3 = -INFINITY; int i1 = -1, i2 = -1, i3 = -1;
        for (int n = par; n < c; n += 2) { float g0 = 0.f, g1 = 0.f, g2 = 0.f, g3 = 0.f;
#pragma unroll
            for (int d4 = 0; d4 < 16; ++d4) { const f32x4 kb = *(const LAS f32x4*)(KB + n * 64 + d4 * 4); g0 += qv[4 * d4] * kb.x; g1 += qv[4 * d4 + 1] * kb.y; g2 += qv[4 * d4 + 2] * kb.z; g3 += qv[4 * d4 + 3] * kb.w; }
            const float g = (g0 + g1) + (g2 + g3);
            if (g > v1) { v3 = v2; i3 = i2; v2 = v1; i2 = i1; v1 = g; i1 = n; } else if (g > v2) { v3 = v2; i3 = i2; v2 = g; i2 = n; } else if (g > v3) { v3 = g; i3 = n; } }
        LAS float* TP = (LAS float*)(L + MG_TOP);
        if (par == 1) { TP[qi * 6 + 0] = v1; TP[qi * 6 + 1] = v2; TP[qi * 6 + 2] = v3; TP[qi * 6 + 3] = __int_as_float(i1); TP[qi * 6 + 4] = __int_as_float(i2); TP[qi * 6 + 5] = __int_as_float(i3); }
        __syncthreads();
        if (par == 0) {
#pragma unroll
            for (int k = 0; k < 3; ++k) { const float g = TP[qi * 6 + k]; const int n = __float_as_int(TP[qi * 6 + 3 + k]);
                if (n >= 0) { const bool b1 = g > v1 || (g == v1 && n < i1), b2 = g > v2 || (g == v2 && n < i2), b3 = g > v3 || (g == v3 && n < i3);
                    if (b1) { v3 = v2; i3 = i2; v2 = v1; i2 = i1; v1 = g; i1 = n; } else if (b2) { v3 = v2; i3 = i2; v2 = g; i2 = n; } else if (b3) { v3 = g; i3 = n; } } }
            const unsigned s4 = (unsigned)(i1 & 255) | ((unsigned)(i2 & 255) << 8) | ((unsigned)(i3 & 255) << 16) | 0xff000000u;
            SEL[qi] = s4; SELG[(size_t)(q0 + qi) * 4 + h] = s4;
        }
    }
    __syncthreads();
    for (int n = wave; n < c; n += 8) { int base = 0; unsigned char* lp = LISTG + ((size_t)(bh * 32 + c) * 32 + n) * 256;
#pragma unroll
        for (int ck = 0; ck < 4; ++ck) { const int q = ck * 64 + lane; const unsigned s4 = SEL[q]; const bool f = (s4 & 255u) == (unsigned)n || ((s4 >> 8) & 255u) == (unsigned)n || ((s4 >> 16) & 255u) == (unsigned)n;
            const unsigned long long bal = __ballot(f); const int pos = base + __popcll(bal & ((1ull << lane) - 1ull)); if (f) lp[pos] = (unsigned char)q; base += __popcll(bal); }
        if (lane == 0) CNTG[(bh * 32 + c) * 32 + n] = base; }
}
constexpr int KV_KL = 0, KV_VL = 36864, KV_PRE = KV_VL + 64 * 528;
DI void kv_tile(const LAS unsigned char* KL, const LAS unsigned char* VL, const bf16x8 (&qf)[2], int nsteps, bool causal, int qloc, int fr, int fq, f32x4 (&O)[4], float& m_out, float& l_out) {
    const float sc2 = 0.125f * 1.44269504089f;
    f32x4 s[16];
    const LAS unsigned char* kr0 = KL + (8 * (fr >> 2) + (fr & 3)) * 144 + fq * 16;
#pragma unroll
    for (int s8 = 0; s8 < 8; ++s8)
#pragma unroll
        for (int j = 0; j < 2; ++j) { f32x4 acc = (f32x4){0.f, 0.f, 0.f, 0.f};
#pragma unroll
            for (int ks = 0; ks < 2; ++ks) { const bf16x8 a = *(const LAS bf16x8*)(kr0 + (32 * s8 + 4 * j) * 144 + 64 * ks); acc = MFMA16(a, qf[ks], acc); }
            s[2 * s8 + j] = (s8 < nsteps) ? acc : (f32x4){-INFINITY, -INFINITY, -INFINITY, -INFINITY}; }
    if (causal) {
#pragma unroll
        for (int t = 0; t < 16; ++t)
#pragma unroll
            for (int r = 0; r < 4; ++r) { const int key = 32 * (t >> 1) + 8 * fq + 4 * (t & 1) + r; s[t][r] = key <= qloc ? s[t][r] : -INFINITY; } }
    float m = -INFINITY;
#pragma unroll
    for (int t = 0; t < 16; ++t) m = fmaxf(m, fmaxf(fmaxf(s[t][0], s[t][1]), fmaxf(s[t][2], s[t][3])));
    m = fmaxf(m, __shfl_xor(m, 16)); m = fmaxf(m, __shfl_xor(m, 32));
    const float mb = -m * sc2; float l = 0.f;
#pragma unroll
    for (int t = 0; t < 16; ++t)
#pragma unroll
        for (int r = 0; r < 4; ++r) { const float p = __builtin_amdgcn_exp2f(fmaf(s[t][r], sc2, mb)); s[t][r] = p; l += p; }
    l += __shfl_xor(l, 16); l += __shfl_xor(l, 32);
#pragma unroll
    for (int dt = 0; dt < 4; ++dt) O[dt] = (f32x4){0.f, 0.f, 0.f, 0.f};
    const LAS unsigned char* vr0 = VL + fr * 528 + fq * 16;
#pragma unroll
    for (int s8 = 0; s8 < 8; ++s8) {
        u32x4 pw; pw.x = cvt_pk_bf16(s[2 * s8][0], s[2 * s8][1]); pw.y = cvt_pk_bf16(s[2 * s8][2], s[2 * s8][3]); pw.z = cvt_pk_bf16(s[2 * s8 + 1][0], s[2 * s8 + 1][1]); pw.w = cvt_pk_bf16(s[2 * s8 + 1][2], s[2 * s8 + 1][3]);
        const bf16x8 pb = __builtin_bit_cast(bf16x8, pw);
#pragma unroll
        for (int dt = 0; dt < 4; ++dt) { const bf16x8 a = *(const LAS bf16x8*)(vr0 + (16 * dt) * 528 + 64 * s8); O[dt] = MFMA16(a, pb, O[dt]); } }
    m_out = m; l_out = l;
}
DI void kv_store(bf16_t* OPG, float* MLG, size_t row, int h, int slot, const f32x4 (&O)[4], float m, float l, int fq) {
    const float inv = 1.0f / l; const size_t base = ((row * 4 + h) * 4 + slot);
#pragma unroll
    for (int dt = 0; dt < 4; ++dt) { u32x2 w; w.x = cvt_pk_bf16(O[dt][0] * inv, O[dt][1] * inv); w.y = cvt_pk_bf16(O[dt][2] * inv, O[dt][3] * inv); *(u32x2*)(OPG + base * 64 + 16 * dt + 4 * fq) = w; }
    if (fq == 0) { MLG[base * 2] = m; MLG[base * 2 + 1] = l; }
}
DI void moba_kv_unit(const Frame& F, const bf16_t* Pb, const bf16_t* VT, const unsigned* SELG, const unsigned char* LISTG, const int* CNTG, bf16_t* OPG, float* MLG, int bl, int h, int n, int part, int nparts) {
    int lane_ = F.lane; LAUNDER_V(lane_);
    const int lane = lane_, wave = F.wave, tid = wave * 64 + lane, fr = lane & 15, fq = lane >> 4;
    LAS unsigned char* L = F.lds; LAS int* PRE = (LAS int*)(L + KV_PRE);
    const int bh = bl * 4 + h;
    const bf16_t* Kg = Pb + (size_t)(bl * SEQ + n * 256) * PLD + PC_MK + h * 64;
    const bf16_t* Vg = VT + (size_t)(bh * 64) * SEQ + n * 256;
    const bf16_t* Qg = Pb + (size_t)(bl * SEQ) * PLD + PC_MQ + h * 64;
    __syncthreads();
#pragma unroll
    for (int i = 0; i < 4; ++i) { const int q = tid + 512 * i, r = q >> 3, c8 = q & 7; *(LAS u32x4*)(L + KV_KL + r * 144 + c8 * 16) = *(const u32x4*)(Kg + (size_t)r * PLD + c8 * 8); }
#pragma unroll
    for (int i = 0; i < 4; ++i) { const int q = tid + 512 * i, d = q >> 5, c16 = q & 31; *(LAS u32x4*)(L + KV_VL + d * 528 + c16 * 16) = *(const u32x4*)(Vg + (size_t)d * SEQ + c16 * 8); }
    if (wave == 0) {
        const int cq = lane; int cnt = (cq > n && cq < 32) ? CNTG[(bh * 32 + cq) * 32 + n] : 0; int inc = cnt;
#pragma unroll
        for (int o = 1; o < 32; o <<= 1) { const int up = __shfl_up(inc, o); if (lane >= o) inc += up; }
        if (lane < 32) PRE[lane] = inc - cnt; if (lane == 31) PRE[32] = inc;
    }
    __syncthreads();
    const int T = PRE[32], nsp = (T + 15) >> 4, ntl = nsp + 16;
    for (int tt = part + nparts * wave; tt < ntl; tt += nparts * 8) {
        f32x4 O[4]; float m, l; bf16x8 qf[2];
        if (tt < nsp) {
            const int e = 16 * tt + fr; const bool valid = e < T; const int ee = valid ? e : 0;
            int cq = 0;
#pragma unroll
            for (int i = 1; i < 32; ++i) cq += (PRE[i] <= ee) ? 1 : 0;
            const int q = LISTG[((size_t)(bh * 32 + cq) * 32 + n) * 256 + (ee - PRE[cq])];
            const int tok = cq * 256 + q; const size_t row = (size_t)(bl * SEQ + tok);
#pragma unroll
            for (int ks = 0; ks < 2; ++ks) qf[ks] = *(const bf16x8*)(Qg + (size_t)tok * PLD + fq * 8 + 32 * ks);
            kv_tile(L + KV_KL, L + KV_VL, qf, 8, false, 0, fr, fq, O, m, l);
            const unsigned s4 = SELG[row * 4 + h]; const int slot = (s4 & 255u) == (unsigned)n ? 0 : (((s4 >> 8) & 255u) == (unsigned)n ? 1 : 2);
            if (valid) kv_store(OPG, MLG, row, h, slot, O, m, l, fq);
        } else {
            const int to = tt - nsp, qloc = 16 * to + fr, tok = n * 256 + qloc; const size_t row = (size_t)(bl * SEQ + tok);
#pragma unroll
            for (int ks = 0; ks < 2; ++ks) qf[ks] = *(const bf16x8*)(Qg + (size_t)tok * PLD + fq * 8 + 32 * ks);
            kv_tile(L + KV_KL, L + KV_VL, qf, (16 * to + 15) / 32 + 1, true, qloc, fr, fq, O, m, l);
            kv_store(OPG, MLG, row, h, 3, O, m, l, fq);
        }
    }
}
DI void moba_combine(const Frame& F, const unsigned* SELG, const bf16_t* OPG, const float* MLG, bf16_t* BR) {
    int lane_ = F.lane; LAUNDER_V(lane_);
    const int lane = lane_, sub = lane & 7, gw = F.blk * 8 + F.wave, NGW = F.G * 8;
    const float sc2 = 0.125f * 1.44269504089f;
    for (int it = gw; it < NG * 4 / 8; it += NGW) { const size_t idx = (size_t)it * 8 + (lane >> 3); const size_t row = idx >> 2; const int h = (int)(idx & 3);
        const unsigned s4 = SELG[idx]; float mk[4], lk[4]; float M = -INFINITY;
#pragma unroll
        for (int k = 0; k < 4; ++k) { const bool ok = (k == 3) || (((s4 >> (8 * k)) & 255u) != 255u); const f32x2 ml = *(const f32x2*)(MLG + (idx * 4 + k) * 2); mk[k] = ok ? ml.x : -INFINITY; lk[k] = ok ? ml.y : 0.f; M = fmaxf(M, mk[k]); }
        float o[8]; float den = 0.f;
#pragma unroll
        for (int e = 0; e < 8; ++e) o[e] = 0.f;
#pragma unroll
        for (int k = 0; k < 4; ++k) { const bool ok = (k == 3) || (((s4 >> (8 * k)) & 255u) != 255u); const float w = ok ? lk[k] * __builtin_amdgcn_exp2f((mk[k] - M) * sc2) : 0.f; den += w;
            u32x4 pv = *(const u32x4*)(OPG + (idx * 4 + k) * 64 + sub * 8);
            if (!ok) pv = (u32x4){0u, 0u, 0u, 0u};
#pragma unroll
            for (int e = 0; e < 4; ++e) { o[2 * e] += w * __uint_as_float(pv[e] << 16); o[2 * e + 1] += w * __uint_as_float(pv[e] & 0xffff0000u); } }
        const float inv = 1.0f / den; u32x4 wv;
#pragma unroll
        for (int e = 0; e < 4; ++e) wv[e] = cvt_pk_bf16(o[2 * e] * inv, o[2 * e + 1] * inv);
        *(u32x4*)(BR + row * 1024 + 256 + h * 64 + sub * 8) = wv; }
}
__host__ __device__ constexpr int kv_parts(int n) { return n == 0 ? 3 : (n < 8 ? 2 : 1); }
__host__ __device__ constexpr int kv_items_before(int n) { int s = 0; for (int i = 0; i < n; ++i) s += kv_parts(i) * GB * 4; return s; }
constexpr int KV_NITEMS = kv_items_before(32);

constexpr int XA_K = 0;
constexpr int XA_VT = 69632;
DI void xattn_wg(const Frame& F, const bf16_t* KVM, const bf16_t* QX, bf16_t* AO, int w) {
    int lane_ = F.lane; LAUNDER_V(lane_);
    const int lane = lane_, wave = F.wave, tid = wave * 64 + lane, fr = lane & 15, fq = lane >> 4;
    const int b = w >> 5, h = (w >> 3) & 3, qpart = w & 7;
    LAS unsigned char* L = F.lds;
    __syncthreads();
#pragma unroll
    for (int i = 0; i < 8; ++i) { const int q = tid + 512 * i, m = q >> 4, c16 = q & 15; *(LAS u32x4*)(L + XA_K + m * 272 + c16 * 16) = *(const u32x4*)(KVM + (size_t)(b * 256 + m) * 1024 + h * 128 + c16 * 8); }
#pragma unroll
    for (int i = 0; i < 8; ++i) { const int q = tid + 512 * i, m = q & 255, c16 = q >> 8; const u32x4 v = *(const u32x4*)(KVM + (size_t)(b * 256 + m) * 1024 + 512 + h * 128 + c16 * 8);
#pragma unroll
        for (int e = 0; e < 4; ++e) { *(LAS bf16_t*)(L + XA_VT + (c16 * 8 + 2 * e) * 528 + m * 2) = (bf16_t)(v[e] & 0xffffu); *(LAS bf16_t*)(L + XA_VT + (c16 * 8 + 2 * e + 1) * 528 + m * 2) = (bf16_t)(v[e] >> 16); } }
    __syncthreads();
    const float sc2 = 0.08838834764831845f * 1.44269504089f;
    for (int rtile = 0; rtile < 8; ++rtile) {
        const size_t tok = (size_t)b * SEQ + qpart * 1024 + wave * 128 + rtile * 16 + fr;
        bf16x8 qf[4];
#pragma unroll
        for (int ks = 0; ks < 4; ++ks) qf[ks] = *(const bf16x8*)(QX + tok * 512 + h * 128 + fq * 8 + 32 * ks);
        f32x4 s[16]; float mx = -INFINITY;
#pragma unroll
        for (int kt = 0; kt < 16; ++kt) { s[kt] = (f32x4){0.f, 0.f, 0.f, 0.f};
#pragma unroll
            for (int ks = 0; ks < 4; ++ks) { const bf16x8 a = *(const LAS bf16x8*)(L + XA_K + (16 * kt + fr) * 272 + (fq * 8 + 32 * ks) * 2); s[kt] = MFMA16(a, qf[ks], s[kt]); }
            mx = fmaxf(mx, fmaxf(fmaxf(s[kt][0], s[kt][1]), fmaxf(s[kt][2], s[kt][3]))); __builtin_amdgcn_sched_barrier(0); }
        mx = fmaxf(mx, __shfl_xor(mx, 16)); mx = fmaxf(mx, __shfl_xor(mx, 32));
        float l = 0.f;
#pragma unroll
        for (int kt = 0; kt < 16; ++kt)
#pragma unroll
            for (int r = 0; r < 4; ++r) { const float p = __builtin_amdgcn_exp2f((s[kt][r] - mx) * sc2); s[kt][r] = p; l += p; }
        l += __shfl_xor(l, 16); l += __shfl_xor(l, 32); const float inv = 1.0f / l;
        f32x4 O[8];
#pragma unroll
        for (int dt = 0; dt < 8; ++dt) O[dt] = (f32x4){0.f, 0.f, 0.f, 0.f};
#pragma unroll
        for (int s8 = 0; s8 < 8; ++s8) {
            u32x4 pw; pw.x = pk2(s[2 * s8][0], s[2 * s8][1]); pw.y = pk2(s[2 * s8][2], s[2 * s8][3]); pw.z = pk2(s[2 * s8 + 1][0], s[2 * s8 + 1][1]); pw.w = pk2(s[2 * s8 + 1][2], s[2 * s8 + 1][3]);
            const bf16x8 pb = __builtin_bit_cast(bf16x8, pw);
#pragma unroll
            for (int dt = 0; dt < 8; ++dt) {
                const u32x2 lo = *(const LAS u32x2*)(L + XA_VT + (16 * dt + fr) * 528 + (32 * s8 + 4 * fq) * 2), hi = *(const LAS u32x2*)(L + XA_VT + (16 * dt + fr) * 528 + (32 * s8 + 16 + 4 * fq) * 2);
                const u32x4 av = (u32x4){lo.x, lo.y, hi.x, hi.y};
                O[dt] = MFMA16(__builtin_bit_cast(bf16x8, av), pb, O[dt]); }
            __builtin_amdgcn_sched_barrier(0);
        }
#pragma unroll
        for (int dt = 0; dt < 8; ++dt) { u32x2 wv; wv.x = pk2(O[dt][0] * inv, O[dt][1] * inv); wv.y = pk2(O[dt][2] * inv, O[dt][3] * inv);
            *(u32x2*)(AO + tok * 512 + h * 128 + 16 * dt + 4 * fq) = wv; }
    }
    __syncthreads();
}
DI void moe_route1(const Frame& F, const bf16_t* x, const float* Wr, int* TE, float* TW, float* RR, int* CNT) {
    const int tid = F.tid, lane = F.lane, wave = F.wave;
    LAS float* WL = (LAS float*)F.lds; LAS int* HC = (LAS int*)(F.lds + 32768);
    __syncthreads();
    for (int i = tid; i < 8 * 1024 / 4; i += 512) ((LAS f32x4*)WL)[i] = ((const f32x4*)Wr)[i];
    for (int tb = F.blk; tb < NTOK / 256; tb += F.G) {
        if (tid < 8) HC[tid] = 0;
        __syncthreads();
        u32x2 vn[4];
        { const u32x2* xr = (const u32x2*)(x + (size_t)(tb * 256 + wave * 32) * 1024) + lane;
#pragma unroll
          for (int j = 0; j < 4; ++j) vn[j] = xr[64 * j]; }
        for (int rr = 0; rr < 32; ++rr) { const int row = tb * 256 + wave * 32 + rr;
            f32x4 v[4]; float ss = 0.f;
#pragma unroll
            for (int j = 0; j < 4; ++j) v[j] = (f32x4){__uint_as_float(vn[j].x << 16), __uint_as_float(vn[j].x & 0xffff0000u), __uint_as_float(vn[j].y << 16), __uint_as_float(vn[j].y & 0xffff0000u)};
            { const u32x2* xr = (const u32x2*)(x + (size_t)(rr + 1 < 32 ? row + 1 : row) * 1024) + lane;
#pragma unroll
              for (int j = 0; j < 4; ++j) vn[j] = xr[64 * j]; }
#pragma unroll
            for (int j = 0; j < 4; ++j) ss += (v[j].x * v[j].x + v[j].y * v[j].y) + (v[j].z * v[j].z + v[j].w * v[j].w);
            ss = wave_sum(ss); const float r = rsqrtf(ss * (1.0f / 1024.0f) + RMS_EPS);
            float lg[8];
#pragma unroll
            for (int e = 0; e < 8; ++e) { float a = 0.f;
#pragma unroll
                for (int j = 0; j < 4; ++j) { const f32x4 w = *(const LAS f32x4*)(WL + e * 1024 + 4 * lane + 256 * j); a += (v[j].x * w.x + v[j].y * w.y) + (v[j].z * w.z + v[j].w * w.w); }
                lg[e] = wave_sum(a) * r; }
            int e0 = 0; float l0 = lg[0];
#pragma unroll
            for (int e = 1; e < 8; ++e) if (lg[e] > l0) { l0 = lg[e]; e0 = e; }
            int e1 = -1; float l1 = -INFINITY;
#pragma unroll
            for (int e = 0; e < 8; ++e) if (e != e0 && lg[e] > l1) { l1 = lg[e]; e1 = e; }
            const float w0 = 1.0f / (1.0f + __expf(l1 - l0));
            if (lane == 0) { TE[2 * (size_t)row] = e0; TE[2 * (size_t)row + 1] = e1; TW[2 * (size_t)row] = w0; TW[2 * (size_t)row + 1] = 1.0f - w0; RR[row] = r;
                __hip_atomic_fetch_add(&HC[e0], 1, __ATOMIC_RELAXED, __HIP_MEMORY_SCOPE_WORKGROUP); __hip_atomic_fetch_add(&HC[e1], 1, __ATOMIC_RELAXED, __HIP_MEMORY_SCOPE_WORKGROUP); }
        }
        __syncthreads();
        if (tid < 8) CNT[tb * 8 + tid] = HC[tid];
        __syncthreads();
    }
}
DI void moe_bases(const Frame& F, const int* CNT, int tb, LAS int* OUT  ) {
    const int tid = F.tid; LAS int* SC = (LAS int*)(F.lds + 40960);
    __syncthreads();
    { const int e = tid & 7, seg = tid >> 3; int all = 0, lt = 0;
#pragma unroll
      for (int q = 0; q < 4; ++q) { const int w = 4 * seg + q; const int c = CNT[w * 8 + e]; all += c; lt += (w < tb) ? c : 0; }
      SC[seg * 8 + e] = all; SC[512 + seg * 8 + e] = lt; }
    __syncthreads();
    if (tid < 8) { int all = 0, lt = 0; for (int s = 0; s < 64; ++s) { all += SC[s * 8 + tid]; lt += SC[512 + s * 8 + tid]; } SC[1024 + tid] = (all + 255) >> 8; OUT[16 + tid] = lt; }
    __syncthreads();
    if (tid == 0) { int b = 0; for (int e = 0; e < 8; ++e) { OUT[e] = b; b += SC[1024 + e]; } OUT[8] = b; }
    __syncthreads();
}
DI void moe_route2(const Frame& F, const int* TE, const float* RR, const int* CNT, const bf16_t* xb, int* POS, bf16_t* XP, float* RP) {
    const int tid = F.tid, lane = F.lane, wave = F.wave;
    LAS int* MB = (LAS int*)(F.lds + 49152);
    LAS int* WT = (LAS int*)(F.lds + 49152 + 256);
    LAS int* PL = (LAS int*)(F.lds + 49152 + 512);
    for (int tb = F.blk; tb < NTOK / 256; tb += F.G) {
        moe_bases(F, CNT, tb, MB);
        int e0 = -1, e1 = -1; const int tok = tb * 256 + tid;
        if (tid < 256) { e0 = TE[2 * (size_t)tok]; e1 = TE[2 * (size_t)tok + 1]; }
        int pw[2] = {0, 0};
#pragma unroll
        for (int e = 0; e < 8; ++e) { const bool f = (e0 == e) || (e1 == e); const unsigned long long bal = __ballot(f);
            const int before = __popcll(bal & ((1ull << lane) - 1ull)); if (lane == 0 && wave < 4) WT[wave * 8 + e] = __popcll(bal);
            if (e0 == e) pw[0] = before; if (e1 == e) pw[1] = before; }
        __syncthreads();
        if (tid < 256) {
#pragma unroll
            for (int sl = 0; sl < 2; ++sl) { const int e = sl ? e1 : e0; int rank = pw[sl]; for (int w2 = 0; w2 < wave; ++w2) rank += WT[w2 * 8 + e];
                const int pos = MB[e] * 256 + MB[16 + e] + rank; PL[2 * tid + sl] = pos; POS[2 * (size_t)tok + sl] = pos; RP[pos] = RR[tok]; } }
        __syncthreads();
        for (int pr0 = wave * 64; pr0 < wave * 64 + 64; pr0 += 8) { u32x4 ra[8], rb[8];
#pragma unroll
            for (int q = 0; q < 8; ++q) { const int t2 = (pr0 + q) >> 1; const u32x4* src = (const u32x4*)(xb + (size_t)(tb * 256 + t2) * 1024); ra[q] = src[lane]; rb[q] = src[lane + 64]; }
#pragma unroll
            for (int q = 0; q < 8; ++q) { const int pos = PL[pr0 + q]; u32x4* dst = (u32x4*)(XP + (size_t)pos * 1024); dst[lane] = ra[q]; dst[lane + 64] = rb[q]; } }
        __syncthreads();
    }
}
DI void moe_final(const Frame& F, const bf16_t* xb, float* out, const bf16_t* Y, const int* POS, const float* TW, const float* fg) {
    const int lane = F.lane, gw = F.blk * 8 + F.wave, NGW = F.G * 8;
    int pn0 = 0, pn1 = 0; float wn0 = 0.f, wn1 = 0.f;
    if (gw < NTOK) { pn0 = POS[2 * (size_t)gw]; pn1 = POS[2 * (size_t)gw + 1]; wn0 = TW[2 * (size_t)gw]; wn1 = TW[2 * (size_t)gw + 1]; }
    for (int row = gw; row < NTOK; row += NGW) {
        const int p0 = pn0, p1 = pn1; const float w0 = wn0, w1 = wn1;
        { const size_t rn = (size_t)(row + NGW < NTOK ? row + NGW : row); pn0 = POS[2 * rn]; pn1 = POS[2 * rn + 1]; wn0 = TW[2 * rn]; wn1 = TW[2 * rn + 1]; }
        f32x4* xr = (f32x4*)(out + (size_t)row * 1024) + lane; const u32x2* xs = (const u32x2*)(xb + (size_t)row * 1024) + lane; const u32x2* y0 = (const u32x2*)(Y + (size_t)p0 * 1024) + lane; const u32x2* y1 = (const u32x2*)(Y + (size_t)p1 * 1024) + lane;
        f32x4 v[4]; float ss = 0.f; u32x2 ya[4], yb[4];
#pragma unroll
        for (int j = 0; j < 4; ++j) { const u32x2 xv = xs[64 * j]; v[j] = (f32x4){__uint_as_float(xv.x << 16), __uint_as_float(xv.x & 0xffff0000u), __uint_as_float(xv.y << 16), __uint_as_float(xv.y & 0xffff0000u)}; ya[j] = y0[64 * j]; yb[j] = y1[64 * j]; }
#pragma unroll
        for (int j = 0; j < 4; ++j) { const u32x2 a = ya[j], b = yb[j];
            v[j].x += w0 * __uint_as_float(a.x << 16) + w1 * __uint_as_float(b.x << 16); v[j].y += w0 * __uint_as_float(a.x & 0xffff0000u) + w1 * __uint_as_float(b.x & 0xffff0000u);
            v[j].z += w0 * __uint_as_float(a.y << 16) + w1 * __uint_as_float(b.y << 16); v[j].w += w0 * __uint_as_float(a.y & 0xffff0000u) + w1 * __uint_as_float(b.y & 0xffff0000u);
            ss += (v[j].x * v[j].x + v[j].y * v[j].y) + (v[j].z * v[j].z + v[j].w * v[j].w); }
        ss = wave_sum(ss); const float r = rsqrtf(ss * (1.0f / 1024.0f) + RMS_EPS);
#pragma unroll
        for (int j = 0; j < 4; ++j) { const f32x4 g = ((const f32x4*)fg)[lane + 64 * j]; xr[64 * j] = (f32x4){v[j].x * r * g.x, v[j].y * r * g.y, v[j].z * r * g.z, v[j].w * r * g.w}; }
    }
}
constexpr int SCAN_CUT = 32;
__global__ void __launch_bounds__(512, 2) mk_fwd(Params prm) {
    extern __shared__ __attribute__((aligned(16))) unsigned char lds_raw[];
    Frame F0;
    F0.lds = (LAS unsigned char*)lds_raw;
    F0.tid = threadIdx.x; F0.lane = F0.tid & 63; F0.wave = __builtin_amdgcn_readfirstlane(F0.tid >> 6); F0.G = gridDim.x; F0.blk = blockIdx.x;
    F0.ws = prm.ws;
    volatile LAS unsigned* MISC = (volatile LAS unsigned*)(F0.lds + LDS_MISC);
    if (F0.tid < 64) MISC[F0.tid] = 0u;
    __syncthreads();
    XcdBarrier bar; bar.bar = (unsigned*)(prm.ws + WS_CTL); bar.x = 0; bar.st = MISC;
#if MK_SINGLE
    bar = xcd_barrier_post((unsigned*)(prm.ws + WS_CTL), MISC);
#endif
    const int lo = prm.ph_lo, hi = prm.ph_hi; int ph = 0;
#ifndef DBG_REP_CLASS
#define DBG_REP_CLASS 0
#endif
#ifndef DBG_RBA
#define DBG_RBA 1
#endif
#ifndef DBG_RCMB
#define DBG_RCMB 1
#endif
#ifndef DBG_ROUT
#define DBG_ROUT 1
#endif
#ifndef DBG_RFIN
#define DBG_RFIN 1
#endif
#define REPEAT(cls) for (int rep_ = 0; rep_ < ((DBG_REP_CLASS == (cls)) ? 2 : 1); ++rep_)
#define REPBAR(cls) do { if (DBG_REP_CLASS == (cls) && rep_ == 0) xcd_barrier(bar); } while (0)
#define ACTIVE() (ph >= lo && ph < hi)
#define SEAM() do { if (ph + 1 < hi) xcd_barrier(bar); } while (0)
    LAS unsigned char* glds = F0.lds;
#define PTRS() unsigned char* ws = prm.ws; asm volatile("" : "+s"(ws)); Frame F = F0; { int w_ = F0.wave; asm volatile("" : "+s"(w_)); int l_ = (int)__builtin_amdgcn_mbcnt_hi(~0u, __builtin_amdgcn_mbcnt_lo(~0u, 0u)); asm volatile("" : "+v"(l_)); F.wave = w_; F.lane = l_; F.tid = w_ * 64 + l_; } F.ws = ws; unsigned char* ar = ws + WS_ARENA; (void)ar; \
    bf16_t* xb = (bf16_t*)(ws + WS_XB); float* ssq = (float*)(ws + WS_SSQ); const float* rope = (const float*)(ws + WS_ROPE); float* xout = prm.out; (void)xb; (void)ssq; (void)rope; (void)xout; \
    unsigned char* lw = ws + WS_LW + (size_t)layer * LW_STRIDE; (void)lw; const float* sm = (const float*)(ws + WS_SMALL); (void)sm
#define GPTRS() PTRS(); const bf16_t* xbg = xb + (size_t)grp * NG * 1024; const float* ssqg = ssq + (size_t)grp * NG * 16; const float* ropeg = rope + (size_t)grp * NG * 16; \
    bf16_t* Pb = (bf16_t*)(ar + AR_P); float* BA = (float*)(ar + AR_BA); bf16_t* BR = (bf16_t*)(ar + AR_BR); float* KBAR = (float*)(ar + AR_KBAR); bf16_t* VT = (bf16_t*)(ar + AR_VT); \
    bf16_t* QD = (bf16_t*)(ar + AR_QD); bf16_t* MM = (bf16_t*)(ar + AR_KDT); bf16_t* NT = (bf16_t*)(ar + AR_NT); bf16_t* SG = (bf16_t*)(ar + AR_SG); bf16_t* ZB = (bf16_t*)(ar + AR_ZB); unsigned* SELG = (unsigned*)(ar + AR_SELG); int* CNTG = (int*)(ar + AR_CNTG); unsigned char* LISTG = (unsigned char*)(ar + AR_LISTG); bf16_t* OPG = (bf16_t*)(ar + AR_OPG); float* MLG = (float*)(ar + AR_MLG); bf16_t* WN = (bf16_t*)(ar + AR_WN); bf16_t* UT = (bf16_t*)(ar + AR_UT); bf16_t* AQK = (bf16_t*)(ar + AR_AQK); float* GL = (float*)(ar + AR_GL); \
    bf16_t* MG = (bf16_t*)(ar + AR_MERGED); \
    (void)xbg; (void)ssqg; (void)ropeg; (void)Pb; (void)BA; (void)BR; (void)KBAR; (void)VT; (void)QD; (void)MM; (void)NT; (void)SG; (void)ZB; (void)SELG; (void)CNTG; (void)LISTG; (void)OPG; (void)MLG; (void)WN; (void)UT; (void)AQK; (void)GL; (void)MG
#define MPTRS() PTRS(); int* TE = (int*)(ar + AR_TE); float* TW = (float*)(ar + AR_TW); float* RR = (float*)(ar + AR_RR); int* POS = (int*)(ar + AR_POS); int* CNT = (int*)(ar + AR_CNT); \
    bf16_t* XP = (bf16_t*)(ar + AR_XP); float* RP = (float*)(ar + AR_RP); bf16_t* HM = (bf16_t*)(ar + AR_HM); (void)TE; (void)TW; (void)RR; (void)POS; (void)CNT; (void)XP; (void)RP; (void)HM

    if (ACTIVE()) { REPEAT(1) { const int layer = 0; PTRS();
        const __attribute__((address_space(4))) Params* kp = (const __attribute__((address_space(4))) Params*)__builtin_amdgcn_kernarg_segment_ptr(); asm volatile("" : "+s"(kp));
        Params lp;
#pragma unroll
        for (int i = 0; i < 27; ++i) lp.in[i] = kp->in[i];
        lp.out = nullptr; lp.ws = ws; lp.ph_lo = 0; lp.ph_hi = 0; lp.pad0 = 0; lp.pad1 = 0;
        phase_prologue(F, lp); REPBAR(1); } SEAM(); } ++ph;
    for (int layer = 0; layer < 2; ++layer) {
        for (int grp = 0; grp < NGRP; ++grp) {
            if (ACTIVE()) { REPEAT(3) {
                GPTRS();
                pg8::Gemm g{xbg, (const bf16_t*)(lw + LW_WIN), 1024, 1024};
                pg8::SchedPlain S; S.init(NG, 3072, 1024, 1024, 1024, F.G, F.blk);
                pg8::build_rtab(glds, S, ssqg, nullptr, F.tid);
                pg8::EpiScaleBf16 E{Pb, PLD, ssqg, 0, ZB, 512, 10, (const LAS float*)(glds + pg8::RTAB_OFF)};
                pg8::gemm_phase(glds, g, S, E, F.wave);
                for (int rq_ = 0; rq_ < DBG_RBA; ++rq_) ba_tiles(F, xbg, (const bf16_t*)(lw + LW_WBA), ssqg, BA);
                REPBAR(3); }
                SEAM();
            } ++ph;
            if (ACTIVE()) {
                GPTRS();
                REPEAT(4) {
                for (int u = F.blk; u < 1024; u += F.G)
                    prep_dn(F, Pb, BA, sm + SM_CONVW + (size_t)layer * 4 * 1536, sm + SM_ALOG + layer * 8, sm + SM_DTB + layer * 8, QD, MM, NT, WN, UT, AQK, GL, u);
#ifndef DBG_RPOOL
#define DBG_RPOOL 1
#endif
                for (int rpP = 0; rpP < DBG_RPOOL; ++rpP) for (int u = F.blk; u < NG / 64; u += F.G) prep_pool(F, Pb, BR, u);
                REPBAR(4); }
#ifndef DBG_RMOBA
#define DBG_RMOBA 1
#endif
                for (int rpM = 0; rpM < DBG_RMOBA; ++rpM) for (int u = F.blk; u < GB * 64; u += F.G) prep_moba(F, Pb, ropeg, KBAR, VT, u);
                SEAM();
            } ++ph;
            if (ACTIVE()) { REPEAT(18) {
                GPTRS();
                if (F.blk < GB * 8) { if (MK_SINGLE) dn_scan(F, F.blk, MM, NT, SG, 0, SCAN_CUT); }
                else { const int nw = F.G - GB * 8;
                    for (int u = F.blk - GB * 8; u < GB * 4 * 32; u += nw) { const int c = 31 - u / (GB * 4), bh = u % (GB * 4); moba_gate_unit(F, Pb, KBAR, SELG, LISTG, CNTG, bh >> 2, bh & 3, c); } }
                REPBAR(18); }
                SEAM();
            } ++ph;
            if (ACTIVE()) { REPEAT(5) {
                GPTRS();
                if (F.blk < GB * 8) { for (int r2_ = 0; r2_ < ((DBG_REP_CLASS == 16) ? 2 : 1); ++r2_) dn_scan(F, F.blk, MM, NT, SG, MK_SINGLE ? SCAN_CUT : 0, 127, r2_ == 0); }
                else { const int nw = F.G - GB * 8, wq = F.blk - GB * 8;
                    for (int r2_ = 0; r2_ < ((DBG_REP_CLASS == 17) ? 2 : 1); ++r2_)
                    for (int rd = 0; rd * nw < KV_NITEMS; ++rd) { const int i = rd * nw + ((rd & 1) ? nw - 1 - wq : wq); if (i >= KV_NITEMS) continue;
                        int n, part, bh;
                        if (i < 48) { n = 0; part = i >> 4; bh = i & 15; } else if (i < 272) { const int j = i - 48; n = 1 + (j >> 5); part = (j >> 4) & 1; bh = j & 15; } else { const int j = i - 272; n = 8 + (j >> 4); part = 0; bh = j & 15; }
                        moba_kv_unit(F, Pb, VT, SELG, LISTG, CNTG, OPG, MLG, bh >> 2, bh & 3, n, part, n == 0 ? 3 : (n < 8 ? 2 : 1)); } }
                if (layer == 0 && grp == 0) {
                    __syncthreads();
                    pg8::Gemm gk{(const bf16_t*)(ws + WS_MEMN), (const bf16_t*)(ws + WS_LW + LW_WKV), 1024, 1024};
                    pg8::SchedKV Sk; Sk.c = F.blk - GB * 8; Sk.lstride = LW_STRIDE;
                    pg8::EpiScaleBf16 Ek{(bf16_t*)(ws + WS_KVM), 1024, nullptr, 0, nullptr, 0, 1 << 30, nullptr};
                    pg8::gemm_phase(glds, gk, Sk, Ek, F.wave); }
                REPBAR(5); }
                SEAM();
            } ++ph;
            if (ACTIVE()) { REPEAT(6) {
                GPTRS();
                pg8::Gemm g{(const bf16_t*)(ws + WS_X8 + (size_t)grp * NG * 1024), (const bf16_t*)(ws + WS_WG8 + (size_t)layer * 3072 * 1024), 1024, 1024};
                pg8::SchedPlain S; S.init(NG, 3072, 1024, 1024, 1024, F.G, F.blk, 1);
                for (int rq_ = 0; rq_ < DBG_RCMB; ++rq_) moba_combine(F, SELG, OPG, MLG, BR);
                for (int rq_ = 0; rq_ < DBG_ROUT; ++rq_) dn_out_pass(F, QD, WN, UT, AQK, SG, ZB, sm + SM_DNG + layer * 64, BR);
                pg8::build_rtab(glds, S, ssqg, nullptr, F.tid);
                pg8::EpiScaleBf16 E{Pb, PLD, ssqg, 1, nullptr, 0, 1 << 30, (const LAS float*)(glds + pg8::RTAB_OFF)};
                pg8::gemm_phase<pg8::EpiScaleBf16, pg8::SchedPlain, true>(glds, g, S, E, F.wave);
                REPBAR(6); }
                SEAM();
            } ++ph;
            if (ACTIVE()) { REPEAT(7) {
                GPTRS();
                pg8::Gemm g{BR, (const bf16_t*)(lw + LW_WCAT), 1024, 1024};
                pg8::SchedPlain S; S.init(NG, 1024, 1024, 1024, 1024, F.G, F.blk);
                pg8::EpiMerge E{Pb, MG};
                pg8::gemm_phase(glds, g, S, E, F.wave);
                REPBAR(7); }
                SEAM();
            } ++ph;
            if (ACTIVE()) { for (int rep_ = 0; rep_ < ((DBG_REP_CLASS == 8 && layer == 0) ? 2 : 1); ++rep_) {
                GPTRS();
                pg8::Gemm g{MG, (const bf16_t*)(lw + LW_WOUT), 1024, 1024};
                pg8::SchedPlain S; S.init(NG, 1024, 1024, 1024, 1024, F.G, F.blk);
                pg8::EpiResid E{xb + (size_t)grp * NG * 1024, ssq + (size_t)grp * NG * 16, ws + WS_X8 + (size_t)grp * NG * 1024};
                pg8::gemm_phase(glds, g, S, E, F.wave);
                REPBAR(8); }
                SEAM();
            } ++ph;
        }
        if (ACTIVE()) { REPEAT(9) {
            PTRS();
            pg8::Gemm g{xb, (const bf16_t*)(lw + LW_WQ), 1024, 1024};
            pg8::SchedPlain S; S.init(NTOK, 512, 1024, 1024, 1024, F.G, F.blk);
            pg8::build_rtab(glds, S, ssq, nullptr, F.tid);
            pg8::EpiScaleBf16 E{(bf16_t*)(ar + AR_QX), 512, ssq, 0, nullptr, 0, 1 << 30, (const LAS float*)(glds + pg8::RTAB_OFF)};
            pg8::gemm_phase(glds, g, S, E, F.wave);
            REPBAR(9); }
                SEAM();
        } ++ph;
        if (ACTIVE()) { REPEAT(10) {
            PTRS();
            for (int w = F.blk; w < 256; w += F.G) xattn_wg(F, (const bf16_t*)(ws + WS_KVM) + (size_t)layer * 2048 * 1024, (const bf16_t*)(ar + AR_QX), (bf16_t*)(ar + AR_AO), w);
            REPBAR(10); }
                SEAM();
        } ++ph;
        if (ACTIVE()) {
            PTRS();
            pg8::Gemm g{(const bf16_t*)(ar + AR_AO), (const bf16_t*)(lw + LW_WO), 512, 512};
            pg8::SchedPlain S; S.init(NTOK, 1024, 512, 512, 512, F.G, F.blk);
            pg8::EpiResid E{xb, ssq, ws + WS_X8};
            pg8::gemm_phase(glds, g, S, E, F.wave);
            SEAM();
        } ++ph;
        if (layer == 0) {
            if (ACTIVE()) { REPEAT(11) {
                PTRS();
                pg8::Gemm g{xb, (const bf16_t*)(ws + WS_WGU), 1024, 1024};
                pg8::SchedPlain S; S.init(NTOK, 2 * FF, 1024, 1024, 1024, F.G, F.blk);
                pg8::build_rtab(glds, S, ssq, nullptr, F.tid);
                pg8::EpiSwiglu E{(bf16_t*)(ar + AR_HID), FF, (const LAS float*)(glds + pg8::RTAB_OFF)};
                pg8::gemm_phase(glds, g, S, E, F.wave);
                REPBAR(11); }
                SEAM();
            } ++ph;
            if (ACTIVE()) {
                PTRS();
                pg8::Gemm g{(const bf16_t*)(ar + AR_HID), (const bf16_t*)(ws + WS_WD), FF, FF};
                pg8::SchedPlain S; S.init(NTOK, 1024, FF, FF, FF, F.G, F.blk);
                pg8::EpiResid E{xb, ssq, ws + WS_X8};
                pg8::gemm_phase(glds, g, S, E, F.wave);
                SEAM();
            } ++ph;
        } else {
            if (ACTIVE()) { REPEAT(12) { MPTRS(); moe_route1(F, xb, (const float*)(ws + WS_WR), TE, TW, RR, CNT); REPBAR(12); } SEAM(); } ++ph;
            if (ACTIVE()) { REPEAT(13) { MPTRS(); moe_route2(F, TE, RR, CNT, xb, POS, XP, RP); REPBAR(13); } SEAM(); } ++ph;
            if (ACTIVE()) { REPEAT(14) {
                MPTRS();
                LAS int* MB = (LAS int*)(F.lds + 49152); moe_bases(F, CNT, 0, MB);
                pg8::SchedMoe S;
#pragma unroll
                for (int e = 0; e < 9; ++e) S.pbase[e] = __builtin_amdgcn_readfirstlane(MB[e]);
                S.nN = 2 * EFF / 256; S.nt = 16; S.G = F.G; S.c = F.blk; S.astep = (size_t)256 * 1024 * 2; S.bstep = (size_t)256 * 1024 * 2; S.estep = (size_t)2 * EFF * 1024 * 2;
                __syncthreads();
                pg8::Gemm g{XP, (const bf16_t*)(ws + WS_WMGU), 1024, 1024};
                pg8::build_rtab(glds, S, nullptr, RP, F.tid);
                pg8::EpiSwiglu E{HM, EFF, (const LAS float*)(glds + pg8::RTAB_OFF)};
                pg8::gemm_phase(glds, g, S, E, F.wave);
                REPBAR(14); }
                SEAM();
            } ++ph;
            if (ACTIVE()) { REPEAT(15) {
                MPTRS();
                LAS int* MB = (LAS int*)(F.lds + 49152); moe_bases(F, CNT, 0, MB);
                pg8::SchedMoe S;
#pragma unroll
                for (int e = 0; e < 9; ++e) S.pbase[e] = __builtin_amdgcn_readfirstlane(MB[e]);
                S.nN = 4; S.nt = EFF / 64; S.G = F.G; S.c = F.blk; S.astep = (size_t)256 * EFF * 2; S.bstep = (size_t)256 * EFF * 2; S.estep = (size_t)1024 * EFF * 2;
                __syncthreads();
                pg8::Gemm g{HM, (const bf16_t*)(ws + WS_WMD), EFF, EFF};
                pg8::EpiScaleBf16 E{XP, 1024, nullptr, 0, nullptr, 0, 1 << 30, nullptr};
                pg8::gemm_phase(glds, g, S, E, F.wave);
                REPBAR(15); }
                SEAM();
            } ++ph;
            if (ACTIVE()) { MPTRS(); for (int rq_ = 0; rq_ < DBG_RFIN; ++rq_) moe_final(F, xb, xout, XP, POS, TW, sm + SM_FING); SEAM(); } ++ph;
        }
    }
#undef ACTIVE
#undef REPEAT
#undef REPBAR
#undef SEAM
#undef PTRS
#undef GPTRS
#undef MPTRS
}

#ifdef DBG_DUMP_OFF
__global__ void dbg_dump(float* out, const unsigned char* ws) {
    const bf16_t* src = (const bf16_t*)(ws + (size_t)DBG_DUMP_OFF);
    for (size_t i = (size_t)blockIdx.x * blockDim.x + threadIdx.x; i < (size_t)NTOK * 1024; i += (size_t)gridDim.x * blockDim.x) { float v = i < (size_t)DBG_DUMP_N ? bf2f(src[i]) : 0.f; if (!(v == v) || v > 1e30f || v < -1e30f) v = 12345.0f; out[i] = v; }
}
#endif
extern "C" void kernel_launch(void* const* d_in, const int* in_sizes, int n_in, void* d_out, int out_size, void* d_ws, size_t ws_size, hipStream_t stream) {
    static int grid = 0;
    if (grid == 0) {
        if (n_in != 27 || in_sizes[0] != NTOK * DM || out_size != NTOK * DM || ws_size < WS_END) {
            fprintf(stderr, "kernel_launch: unexpected problem (n_in %d, in0 %d, out %d, ws %zu < %zu); nothing launched\n", n_in, n_in > 0 ? in_sizes[0] : -1, out_size, ws_size, (size_t)WS_END); grid = -1; return; }
        int dev = 0, cus = 0;
        if (hipGetDevice(&dev) != hipSuccess || hipDeviceGetAttribute(&cus, hipDeviceAttributeMultiprocessorCount, dev) != hipSuccess) { grid = -1; return; }
        if (hipFuncSetAttribute((const void*)mk_fwd, hipFuncAttributeMaxDynamicSharedMemorySize, LDS_BYTES) != hipSuccess) { fprintf(stderr, "kernel_launch: hipFuncSetAttribute failed\n"); grid = -1; return; }
        int per_cu = 0;
        if (hipOccupancyMaxActiveBlocksPerMultiprocessor(&per_cu, (const void*)mk_fwd, 512, LDS_BYTES) != hipSuccess || per_cu < 1) { fprintf(stderr, "kernel_launch: occupancy query says %d\n", per_cu); }
        (void)hipGetLastError();
        grid = cus > 256 ? 256 : cus;
    }
    if (grid < 0) return;
    (void)hipMemsetAsync((char*)d_ws + WS_CTL, 0, CTL_BYTES, stream);
    Params p{};
    for (int i = 0; i < 27; ++i) p.in[i] = (const float*)d_in[i];
    p.out = (float*)d_out; p.ws = (unsigned char*)d_ws; p.pad0 = 0; p.pad1 = 0;
#if MK_SINGLE
    p.ph_lo = 0; p.ph_hi = NPH;
    hipLaunchKernelGGL(mk_fwd, dim3(grid), dim3(512), LDS_BYTES, stream, p);
#else
#ifndef DBG_NPH
#define DBG_NPH NPH
#endif
    for (int k = 0; k < DBG_NPH; ++k) { p.ph_lo = k; p.ph_hi = k + 1; hipLaunchKernelGGL(mk_fwd, dim3(grid), dim3(512), LDS_BYTES, stream, p); }
#ifdef DBG_DUMP_OFF
    hipLaunchKernelGGL(dbg_dump, dim3(2048), dim3(256), 0, stream, (float*)d_out, (const unsigned char*)d_ws);
#endif
#endif
}
```

```cpp
#include <hip/hip_runtime.h>
#include <cstdio>
#include <cstdint>

#define LAS __attribute__((address_space(3)))
#define DI __device__ __forceinline__
typedef unsigned short bf16_t;
typedef short bf16x8 __attribute__((ext_vector_type(8)));
typedef short s16x4 __attribute__((ext_vector_type(4)));
typedef float f32x4 __attribute__((ext_vector_type(4)));
typedef float f32x2 __attribute__((ext_vector_type(2)));
typedef unsigned u32x4 __attribute__((ext_vector_type(4)));
typedef unsigned u32x2 __attribute__((ext_vector_type(2)));

#ifndef MK_SINGLE
#define MK_SINGLE 1
#endif

constexpr int NTOK = 65536, DM = 1024, SEQ = 8192, NBATCH = 8;
constexpr int NGRP = 2, NG = NTOK / NGRP, GB = NBATCH / NGRP;
constexpr int PLD = 3072;
constexpr int PC_POOL = 0, PC_MQ = 256, PC_MK = 512, PC_MV = 768, PC_DQ = 1024, PC_DK = 1536, PC_DV = 2048, PC_Z = 2560;
constexpr int IN_COLS = 6160;
constexpr int FF = 2816, EFF = 1408, NEXP = 8;
constexpr int MEMLEN = 256;
constexpr float RMS_EPS = 1e-6f;
constexpr int NPH = 1 + 2 * (NGRP * 7 + 3) + 2 + 5;

constexpr size_t MiB = 1u << 20;
constexpr size_t WS_CTL = 0, CTL_BYTES = 1 * MiB;
constexpr size_t LW_WIN = 0, LW_WCAT = LW_WIN + (size_t)6144 * 1024 * 2, LW_WOUT = LW_WCAT + (size_t)1024 * 1024 * 2, LW_WQ = LW_WOUT + (size_t)1024 * 1024 * 2,
                 LW_WKV = LW_WQ + (size_t)512 * 1024 * 2, LW_WO = LW_WKV + (size_t)1024 * 1024 * 2, LW_WBA = LW_WO + (size_t)1024 * 512 * 2, LW_STRIDE = LW_WBA + (size_t)16 * 1024 * 2;
constexpr size_t WS_LW = WS_CTL + CTL_BYTES;
constexpr size_t WS_WGU = WS_LW + 2 * LW_STRIDE;
constexpr size_t WS_WD = WS_WGU + (size_t)2 * FF * 1024 * 2;
constexpr size_t WS_WMGU = WS_WD + (size_t)1024 * FF * 2;
constexpr size_t WS_WMD = WS_WMGU + (size_t)NEXP * 2 * EFF * 1024 * 2;
constexpr size_t WS_WR = WS_WMD + (size_t)NEXP * 1024 * EFF * 2;
constexpr size_t WS_XB = (WS_WR + 8 * 1024 * 4 + MiB - 1) / MiB * MiB;
constexpr size_t WS_SSQ = WS_XB + (size_t)NTOK * 1024 * 2;
constexpr size_t WS_ROPE = WS_SSQ + (size_t)NTOK * 16 * 4;
constexpr size_t WS_MEMN = WS_ROPE + (size_t)NTOK * 16 * 4;
constexpr size_t WS_KVM = WS_MEMN + (size_t)2 * 2048 * 1024 * 2;
constexpr size_t WS_SMALL = WS_KVM + (size_t)2 * 2048 * 1024 * 2;
constexpr int SM_CONVW = 0, SM_ALOG = SM_CONVW + 2 * 4 * 1536, SM_DTB = SM_ALOG + 16, SM_DNG = SM_DTB + 16, SM_FING = SM_DNG + 128, SM_END = SM_FING + 1024;
constexpr size_t WS_X8 = WS_SMALL + 65536;
constexpr size_t WS_WG8 = WS_X8 + (size_t)NTOK * 1024;
constexpr size_t WS_ARENA = WS_WG8 + (size_t)2 * 3072 * 1024;
constexpr size_t AR_P = 0;
constexpr size_t AR_BA = AR_P + (size_t)NG * PLD * 2;
constexpr size_t AR_BR = AR_BA + (size_t)NG * 16 * 4;
constexpr size_t AR_KBAR = AR_BR + (size_t)NG * 1024 * 2;
constexpr size_t AR_VT = AR_KBAR + (size_t)GB * 4 * 32 * 64 * 4;
constexpr int NCH = GB * 128 * 8;
constexpr size_t AR_QD = AR_VT + (size_t)GB * 4 * 64 * SEQ * 2;
constexpr size_t AR_KDT = AR_QD + (size_t)NCH * 8192;
constexpr size_t AR_WN = AR_KDT + (size_t)NCH * 8192;
constexpr size_t AR_UT = AR_WN + (size_t)NCH * 8192;
constexpr size_t AR_AQK = AR_UT + (size_t)NCH * 8192;
constexpr size_t AR_NT = AR_AQK + (size_t)NCH * 8192;
constexpr size_t AR_SG = AR_NT + (size_t)NCH * 8192;
constexpr size_t AR_ZB = AR_SG + (size_t)NCH * 8192;
constexpr size_t AR_GL = AR_ZB + (size_t)NG * 512 * 2;
constexpr size_t AR_SELG = AR_GL + (size_t)NCH * 4 + 65536 - ((size_t)NCH * 4) % 65536;
constexpr size_t AR_CNTG = AR_SELG + (size_t)NG * 4 * 4;
constexpr size_t AR_LISTG = AR_CNTG + (size_t)GB * 4 * 32 * 32 * 4;
constexpr size_t AR_OPG = AR_LISTG + (size_t)GB * 4 * 32 * 32 * 256;
constexpr size_t AR_MLG = AR_OPG + (size_t)NG * 4 * 4 * 64 * 2;
constexpr size_t AR_MERGED = AR_MLG + (size_t)NG * 4 * 4 * 2 * 4;
constexpr size_t AR_MIX_END = AR_MERGED + (size_t)NG * 1024 * 2;
constexpr size_t AR_QX = 0, AR_AO = AR_QX + (size_t)NTOK * 512 * 2, AR_XA_END = AR_AO + (size_t)NTOK * 512 * 2;
constexpr size_t AR_HID = 0, AR_HID_END = (size_t)NTOK * FF * 2;
constexpr int MOE_ROWS = 2 * NTOK + 2048;
constexpr size_t AR_TE = 0, AR_TW = AR_TE + (size_t)NTOK * 8, AR_RR = AR_TW + (size_t)NTOK * 8, AR_POS = AR_RR + (size_t)NTOK * 4, AR_CNT = AR_POS + (size_t)NTOK * 8,
                 AR_XP = AR_CNT + 65536, AR_RP = AR_XP + (size_t)MOE_ROWS * 1024 * 2, AR_HM = AR_RP + (size_t)MOE_ROWS * 4 + 65536 - ((size_t)MOE_ROWS * 4) % 65536,
                 AR_MOE_END = AR_HM + (size_t)MOE_ROWS * EFF * 2;
constexpr size_t cmax(size_t a, size_t b) { return a > b ? a : b; }
constexpr size_t WS_END = WS_ARENA + cmax(cmax(AR_MIX_END, AR_XA_END), cmax(AR_HID_END, AR_MOE_END));
static_assert(AR_XA_END <= AR_MERGED, "xattn buffers must not overlap MERGED");
static_assert(SM_END * 4 <= 65536, "small-vector block");
static_assert(WS_END <= (size_t)1073741824, "workspace map exceeds 1 GiB");

constexpr int LDS_BYTES = 160 * 1024;
constexpr int LDS_MISC = 158 * 1024;

DI float bf2f(unsigned short b) { return __uint_as_float(((unsigned)b) << 16); }
typedef __bf16 bf16v2_t __attribute__((ext_vector_type(2)));
DI unsigned cvt_pk_bf16(float lo, float hi) { bf16v2_t v; v.x = (__bf16)lo; v.y = (__bf16)hi; return __builtin_bit_cast(unsigned, v); }
DI unsigned f2bf(float f) { return (unsigned)__builtin_bit_cast(unsigned short, (__bf16)f); }
DI unsigned pk2(float lo, float hi) { return cvt_pk_bf16(lo, hi); }
DI unsigned cvt4_fp8(float a, float b, float c, float d) { unsigned w = 0u; w = __builtin_amdgcn_cvt_pk_fp8_f32(a, b, w, false); w = __builtin_amdgcn_cvt_pk_fp8_f32(c, d, w, true); return w; }
DI float wave_sum(float v) {
#pragma unroll
    for (int o = 1; o < 64; o <<= 1) v += __shfl_xor(v, o);
    return v;
}
DI float fsigmoid(float x) { return __builtin_amdgcn_rcpf(1.0f + __builtin_amdgcn_exp2f(-1.44269504089f * x)); }
DI float row_rstd(const float* ssqp, int row) {
    const f32x4* p = (const f32x4*)(ssqp + (size_t)row * 16);
    const f32x4 a = p[0], b = p[1], c = p[2], d = p[3];
    const float s = (((a.x + a.y) + (a.z + a.w)) + ((b.x + b.y) + (b.z + b.w))) + (((c.x + c.y) + (c.z + c.w)) + ((d.x + d.y) + (d.z + d.w)));
    return rsqrtf(s * (1.0f / 1024.0f) + RMS_EPS);
}
#define LAUNDER_V(x) asm volatile("" : "+v"(x))
#define LDS_WAIT() asm volatile("s_waitcnt lgkmcnt(0)" ::: "memory")
#define VM_WAIT() asm volatile("s_waitcnt vmcnt(0)" ::: "memory")
#define WG_BAR() do { asm volatile("s_waitcnt lgkmcnt(0)" ::: "memory"); __builtin_amdgcn_s_barrier(); asm volatile("" ::: "memory"); } while (0)
#define MFMA16(a, b, c) __builtin_amdgcn_mfma_f32_16x16x32_bf16((a), (b), (c), 0, 0, 0)

#define XB_TMO      128
#define XB_XCNT(j)  (256  + 64 * (j))
#define XB_XSUB(j)  (1280 + 64 * (j))
#define XB_XGEN(j)  (2304 + 64 * (j))
#define XB_TOP      3328
#define XB_TOPGEN   3392
#define XCD_BAR_WORDS 3456
#define XB_SPIN_CAP (1u << 22)

DI unsigned xb_ld(unsigned* p)              { return __hip_atomic_load(p, __ATOMIC_RELAXED, __HIP_MEMORY_SCOPE_AGENT); }
DI unsigned xb_add(unsigned* p, unsigned v) { return __hip_atomic_fetch_add(p, v, __ATOMIC_RELAXED, __HIP_MEMORY_SCOPE_AGENT); }
DI unsigned xb_xcc_id() { return (unsigned)__builtin_amdgcn_s_getreg((3 << 11) | 20) & 0xFu; }
#define XB_SPIN(cond, bar) do { unsigned _sp = 0; while (cond) { __builtin_amdgcn_s_sleep(1); \
    if ((++_sp & 255u) == 0u) { if (xb_ld(&(bar)[XB_TMO])) break; if (_sp > XB_SPIN_CAP) { atomicAdd(&(bar)[XB_TMO], 1u); break; } } } } while (0)

struct XcdBarrier { unsigned* bar; unsigned x; volatile LAS unsigned* st; };

DI XcdBarrier xcd_barrier_post(unsigned* bar, volatile LAS unsigned* st) {
    XcdBarrier b; b.bar = bar; b.x = xb_xcc_id(); b.st = st;
    if (threadIdx.x == 0) (void)xb_add(&bar[XB_XCNT(b.x)], 1u);
    return b;
}
DI void xcd_barrier_complete(unsigned* bar, unsigned x, unsigned& nloc, unsigned& nx) {
    const unsigned G = gridDim.x * gridDim.y * gridDim.z;
    unsigned sum, cnt, mine, sp = 0u;
    for (;;) {
        sum = 0u; cnt = 0u; mine = 0u;
#pragma unroll
        for (unsigned j = 0; j < 16; ++j) { const unsigned c = xb_ld(&bar[XB_XCNT(j)]); sum += c; cnt += (c > 0u) ? 1u : 0u; mine = (j == x) ? c : mine; }
        if (sum == G) break;
        __builtin_amdgcn_s_sleep(1);
        if ((++sp & 255u) == 0u) { if (xb_ld(&bar[XB_TMO])) break; if (sp > XB_SPIN_CAP) { atomicAdd(&bar[XB_TMO], 1u); break; } }
    }
    nloc = mine > 0u ? mine : 1u; nx = cnt > 0u ? cnt : 1u;
}
DI void xcd_barrier(const XcdBarrier& b) {
    asm volatile("s_waitcnt vmcnt(0)" ::: "memory");
    __syncthreads();
    if (threadIdx.x == 0) {
        unsigned* bar = b.bar;
        __builtin_amdgcn_s_waitcnt(0);
        unsigned nloc = b.st[0], nx = b.st[1];
        if (nloc == 0u) { xcd_barrier_complete(bar, b.x, nloc, nx); b.st[0] = nloc; b.st[1] = nx; }
        const unsigned old = xb_add(&bar[XB_XSUB(b.x)], 1u);
        const unsigned gen = old / nloc;
        if (old + 1u == (gen + 1u) * nloc) {
            __builtin_amdgcn_fence(__ATOMIC_RELEASE, "agent");
            asm volatile("s_waitcnt vmcnt(0)" ::: "memory");
            const unsigned og = xb_add(&bar[XB_TOP], 1u);
            const unsigned tg = og / nx;
            if (og + 1u == (tg + 1u) * nx) xb_add(&bar[XB_TOPGEN], 1u);
            else XB_SPIN(xb_ld(&bar[XB_TOPGEN]) == tg, bar);
            __builtin_amdgcn_fence(__ATOMIC_ACQUIRE, "agent");
            xb_add(&bar[XB_XGEN(b.x)], 1u);
            asm volatile("s_waitcnt vmcnt(0)" ::: "memory");
        } else {
            XB_SPIN(xb_ld(&bar[XB_XGEN(b.x)]) == gen, bar);
            __builtin_amdgcn_fence(__ATOMIC_ACQUIRE, "agent");
            asm volatile("s_waitcnt vmcnt(0)" ::: "memory");
        }
    }
    __syncthreads();
}
namespace pg8 {
constexpr int BM = 256, BK = 64, HALF = 128, HTB = HALF * BK * 2, STAGE_BYTES = 8 * HTB, NXCD = 8, WGM = 8;
__host__ __device__ __forceinline__ int lds_byte(int r, int c) { const int st = (r >> 4) * 2 + (c >> 5), rr = r & 15, cc = c & 31, ob = rr * 64 + cc * 2; return st * 1024 + (ob ^ (((ob >> 9) & 1) << 5)); }
__host__ __device__ __forceinline__ void stage_rc(int b, int& R, int& C) { const int st = b / 1024, sb = b % 1024, swz = sb ^ (((sb >> 9) & 1) << 5); R = (st >> 1) * 16 + swz / 64; C = (st & 1) * 32 + (swz % 64) / 2; }
__host__ __device__ __forceinline__ int perm32(int rho) { const int n = rho >> 4, i = rho & 15; return 8 * (i >> 2) + 4 * n + (i & 3); }

struct Unit { int pm, pn, nt, tag, ord; size_t aoff, boff; };
struct Gemm { const bf16_t* A; const bf16_t* Bt; int lda, ldb; };

struct TileOrder {
    int nM, nN, nwg, G, c;
    DI void init(int nM_, int nN_, int G_, int c_) { nM = nM_; nN = nN_; nwg = nM * nN; G = G_; c = c_; }
    DI bool tile(int i, int& pm, int& pn) const {
        const long L = (long)i * G + c; if (L >= nwg) return false;
        int wgid = (int)L; { const int q = nwg / NXCD, r = nwg % NXCD, xcd = wgid % NXCD, off = wgid / NXCD; wgid = (xcd < r ? xcd * (q + 1) : r * (q + 1) + (xcd - r) * q) + off; }
        const int nig = WGM * nN, gid = wgid / nig, fm = gid * WGM, gsz = (nM - fm) < WGM ? (nM - fm) : WGM;
        pm = fm + ((wgid % nig) % gsz); pn = (wgid % nig) / gsz; return true;
    }
};
struct SchedPlain {
    TileOrder T; int nt; size_t astep, bstep;
    DI void init(int M, int N, int K, int lda, int ldb, int G, int c, int esz = 2) { T.init(M / BM, N / BM, G, c); nt = K * esz / (BK * 2); astep = (size_t)BM * lda * esz; bstep = (size_t)BM * ldb * esz; }
    DI bool next(int i, Unit& u) const { if (!T.tile(i, u.pm, u.pn)) return false; u.nt = nt; u.tag = 0; u.ord = i; u.aoff = (size_t)u.pm * astep; u.boff = (size_t)u.pn * bstep; return true; }
};
struct SchedMerge {
    TileOrder T; size_t astep, bstep;
    DI void init(int M, int N, int lda, int ldb, int G, int c) { T.init(M / BM, N / BM, G, c); astep = (size_t)BM * lda * 2; bstep = (size_t)BM * ldb * 2; }
    DI bool next(int i, Unit& u) const {
        const int ti = i / 3, br = i - 3 * ti; if (!T.tile(ti, u.pm, u.pn)) return false;
        const int kofs = br == 0 ? 0 : (br == 1 ? 256 : 512);
        u.nt = br == 2 ? 8 : 4; u.tag = br; u.aoff = (size_t)u.pm * astep + (size_t)kofs * 2; u.boff = (size_t)u.pn * bstep + (size_t)kofs * 2; return true;
    }
};
struct SchedKV {
    int c; size_t lstride;
    DI bool next(int i, Unit& u) const {
        if (i != 0 || c < 0 || c >= 64) return false;
        const int layer = c >> 5, r = c & 31; u.pm = layer * 8 + (r >> 2); u.pn = r & 3; u.nt = 16; u.tag = 0; u.ord = 0;
        u.aoff = (size_t)u.pm * BM * 1024 * 2; u.boff = (size_t)layer * lstride + (size_t)u.pn * BM * 1024 * 2; return true;
    }
};
struct SchedMoe {
    int pbase[9]; int nN, nt, G, c; size_t astep, bstep, estep;
    DI bool next(int i, Unit& u) const {
        const long L = (long)i * G + c; const int nM = pbase[8], nwg = nM * nN; if (L >= nwg) return false;
        int wgid = (int)L; { const int q = nwg / NXCD, r = nwg % NXCD, xcd = wgid % NXCD, off = wgid / NXCD; wgid = (xcd < r ? xcd * (q + 1) : r * (q + 1) + (xcd - r) * q) + off; }
        const int nig = WGM * nN, gid = wgid / nig, fm = gid * WGM, gsz = (nM - fm) < WGM ? (nM - fm) : WGM;
        const int gp = fm + ((wgid % nig) % gsz), pn = (wgid % nig) / gsz;
        int e = 0;
#pragma unroll
        for (int j = 1; j < 8; ++j) e += (gp >= pbase[j]) ? 1 : 0;
        u.pm = gp; u.pn = pn; u.nt = nt; u.tag = e; u.ord = i; u.aoff = (size_t)gp * astep; u.boff = (size_t)e * estep + (size_t)pn * bstep; return true;
    }
};

constexpr int RTAB_OFF = STAGE_BYTES, RTAB_MAX_UNITS = 26;
template <class Sched> DI void build_rtab(LAS unsigned char* lds, const Sched& S, const float* ssqp, const float* rvec, int tid) {
    LAS float* rt = (LAS float*)(lds + RTAB_OFF); Unit u;
    for (int i = tid >> 8; S.next(i, u); i += 2) { if (i >= RTAB_MAX_UNITS) break; const int r = tid & 255, row = u.pm * BM + r; rt[i * 256 + r] = rvec ? rvec[row] : row_rstd(ssqp, row); }
    __syncthreads();
}
struct EpiScaleBf16 { static constexpr bool MID = false;
    bf16_t* O; int ldo; const float* ssqp; int act; bf16_t* O2; int ldo2, pn2; const LAS float* rtab;
    DI void operator()(const f32x4 (&acc)[2][2][4][2], const Unit& u, int wr, int wc, int fr, int fq) const {
        const bool alt = u.pn >= pn2; bf16_t* const Ob = alt ? O2 : O; const int ld = alt ? ldo2 : ldo;
        const int row0 = u.pm * BM + wr * 64 + fr, col0 = (alt ? u.pn - pn2 : u.pn) * BM + wc * 32 + 8 * fq;
#pragma unroll
        for (int ai = 0; ai < 2; ++ai)
#pragma unroll
            for (int m = 0; m < 4; ++m) { const int row = row0 + ai * HALF + m * 16; const float r = ssqp ? rtab[u.ord * 256 + (row & 255)] : 1.0f; bf16_t* rowp = Ob + (size_t)row * ld + col0;
#pragma unroll
                for (int bj = 0; bj < 2; ++bj) { f32x4 v0 = acc[ai][bj][m][0] * r, v1 = acc[ai][bj][m][1] * r;
                    if (act) {
#pragma unroll
                        for (int j = 0; j < 4; ++j) { v0[j] = fsigmoid(v0[j]); v1[j] = fsigmoid(v1[j]); } }
                    u32x4 w; w.x = cvt_pk_bf16(v0[0], v0[1]); w.y = cvt_pk_bf16(v0[2], v0[3]); w.z = cvt_pk_bf16(v1[0], v1[1]); w.w = cvt_pk_bf16(v1[2], v1[3]);
                    *(u32x4*)(rowp + bj * HALF) = w; } }
    }
};
struct EpiResid { static constexpr bool MID = false;
    bf16_t* xb; float* ssqp; unsigned char* x8;
    DI void operator()(const f32x4 (&acc)[2][2][4][2], const Unit& u, int wr, int wc, int fr, int fq) const {
        const int row0 = u.pm * BM + wr * 64 + fr, col0 = u.pn * BM + wc * 32 + 8 * fq;
#pragma unroll
        for (int ai = 0; ai < 2; ++ai)
#pragma unroll
            for (int m = 0; m < 4; ++m) { const int row = row0 + ai * HALF + m * 16; const size_t off = (size_t)row * 1024 + col0; float ss = 0.f;
#pragma unroll
                for (int bj = 0; bj < 2; ++bj) {
                    const u32x4 xo = *(const u32x4*)(xb + off + bj * HALF);
                    f32x4 x0 = (f32x4){__uint_as_float(xo.x << 16), __uint_as_float(xo.x & 0xffff0000u), __uint_as_float(xo.y << 16), __uint_as_float(xo.y & 0xffff0000u)};
                    f32x4 x1 = (f32x4){__uint_as_float(xo.z << 16), __uint_as_float(xo.z & 0xffff0000u), __uint_as_float(xo.w << 16), __uint_as_float(xo.w & 0xffff0000u)};
                    x0 += acc[ai][bj][m][0]; x1 += acc[ai][bj][m][1];
                    u32x4 w; w.x = cvt_pk_bf16(x0[0], x0[1]); w.y = cvt_pk_bf16(x0[2], x0[3]); w.z = cvt_pk_bf16(x1[0], x1[1]); w.w = cvt_pk_bf16(x1[2], x1[3]);
                    *(u32x4*)(xb + off + bj * HALF) = w;
                    { u32x2 w8; w8.x = cvt4_fp8(x0[0], x0[1], x0[2], x0[3]); w8.y = cvt4_fp8(x1[0], x1[1], x1[2], x1[3]); *(u32x2*)(x8 + off + bj * HALF) = w8; }
                    ss += (x0[0] * x0[0] + x0[1] * x0[1]) + (x0[2] * x0[2] + x0[3] * x0[3]) + (x1[0] * x1[0] + x1[1] * x1[1]) + (x1[2] * x1[2] + x1[3] * x1[3]); }
                ss += __shfl_xor(ss, 16); ss += __shfl_xor(ss, 32);
                if (fq == 0) ssqp[(size_t)row * 16 + u.pn * 4 + wc] = ss; }
    }
};
struct EpiSwiglu { static constexpr bool MID = false;
    bf16_t* H; int ldh; const LAS float* rtab;
    DI void operator()(const f32x4 (&acc)[2][2][4][2], const Unit& u, int wr, int wc, int fr, int fq) const {
        const int row0 = u.pm * BM + wr * 64 + fr, col0 = u.pn * HALF + wc * 32 + 8 * fq;
#pragma unroll
        for (int ai = 0; ai < 2; ++ai)
#pragma unroll
            for (int m = 0; m < 4; ++m) { const int row = row0 + ai * HALF + m * 16; const float r = rtab[u.ord * 256 + (row & 255)];
                f32x4 h0, h1;
#pragma unroll
                for (int j = 0; j < 4; ++j) { const float g0 = acc[ai][0][m][0][j] * r, g1 = acc[ai][0][m][1][j] * r;
                    h0[j] = g0 * fsigmoid(g0) * (acc[ai][1][m][0][j] * r); h1[j] = g1 * fsigmoid(g1) * (acc[ai][1][m][1][j] * r); }
                u32x4 w; w.x = cvt_pk_bf16(h0[0], h0[1]); w.y = cvt_pk_bf16(h0[2], h0[3]); w.z = cvt_pk_bf16(h1[0], h1[1]); w.w = cvt_pk_bf16(h1[2], h1[3]);
                *(u32x4*)(H + (size_t)row * ldh + col0) = w; }
    }
};
struct EpiMerge { static constexpr bool MID = true;
    const bf16_t* gates; bf16_t* merged;
    static DI float gclamp(unsigned hi_bits) { return fmaxf(__uint_as_float(hi_bits), 1e-30f); }
    DI void mid(f32x4 (&acc)[2][2][4][2], const Unit& u, int seg, int wr, int wc, int fr, int fq) const {
        int row0 = u.pm * BM + wr * 64 + fr, col0 = u.pn * BM + wc * 32 + 8 * fq; LAUNDER_V(row0); LAUNDER_V(col0);
#pragma unroll
        for (int ai = 0; ai < 2; ++ai)
#pragma unroll
            for (int mp = 0; mp < 2; ++mp) {
                u32x4 ga[2][2], gb[2][2];
#pragma unroll
                for (int mm = 0; mm < 2; ++mm)
#pragma unroll
                    for (int bj = 0; bj < 2; ++bj) { const bf16_t* gp = gates + (size_t)(row0 + ai * HALF + (2 * mp + mm) * 16) * PLD + seg * 1024 + col0 + bj * HALF; ga[mm][bj] = *(const u32x4*)gp; gb[mm][bj] = *(const u32x4*)(gp + 1024); }
                __builtin_amdgcn_sched_barrier(0);
#pragma unroll
                for (int mm = 0; mm < 2; ++mm)
#pragma unroll
                    for (int bj = 0; bj < 2; ++bj) {
#pragma unroll
                        for (int j = 0; j < 4; ++j) { const int m = 2 * mp + mm;
                            const float r_lo = gclamp(ga[mm][bj][j] << 16) * __builtin_amdgcn_rcpf(gclamp(gb[mm][bj][j] << 16)), r_hi = gclamp(ga[mm][bj][j] & 0xffff0000u) * __builtin_amdgcn_rcpf(gclamp(gb[mm][bj][j] & 0xffff0000u));
                            acc[ai][bj][m][j >> 1][(2 * j) & 3] *= r_lo; acc[ai][bj][m][j >> 1][(2 * j + 1) & 3] *= r_hi; }
                        __builtin_amdgcn_sched_barrier(0); }
            }
    }
    DI void operator()(const f32x4 (&acc)[2][2][4][2], const Unit& u, int wr, int wc, int fr, int fq) const {
        const int row0 = u.pm * BM + wr * 64 + fr, col0 = u.pn * BM + wc * 32 + 8 * fq;
#pragma unroll
        for (int ai = 0; ai < 2; ++ai)
#pragma unroll
            for (int m = 0; m < 4; ++m) { const int row = row0 + ai * HALF + m * 16;
#pragma unroll
                for (int bj = 0; bj < 2; ++bj) {
                    const u32x4 gv = *(const u32x4*)(gates + (size_t)row * PLD + 2 * 1024 + col0 + bj * HALF);
                    float v[8];
#pragma unroll
                    for (int j = 0; j < 4; ++j) { v[2 * j] = gclamp(gv[j] << 16); v[2 * j + 1] = gclamp(gv[j] & 0xffff0000u); }
#pragma unroll
                    for (int j = 0; j < 4; ++j) { v[j] *= acc[ai][bj][m][0][j]; v[4 + j] *= acc[ai][bj][m][1][j]; }
                    u32x4 w; w.x = cvt_pk_bf16(v[0], v[1]); w.y = cvt_pk_bf16(v[2], v[3]); w.z = cvt_pk_bf16(v[4], v[5]); w.w = cvt_pk_bf16(v[6], v[7]);
                    *(u32x4*)(merged + (size_t)row * 1024 + col0 + bj * HALF) = w; } }
    }
};

template <class Epi, class Sched, bool F8 = false>
DI void gemm_phase(LAS unsigned char* lds, const Gemm g, const Sched& S, const Epi& E, int wave_id) {
    int tid_ = (int)__builtin_amdgcn_mbcnt_hi(~0u, __builtin_amdgcn_mbcnt_lo(~0u, 0u)) + 64 * wave_id; asm volatile("" : "+v"(tid_));
    const int tid = tid_, wid = __builtin_amdgcn_readfirstlane(tid >> 6), lane = tid & 63, wr = wid >> 2, wc = wid & 3, fr = lane & 15, fq = lane >> 4;
    unsigned voffA[2], voffB[2];
#pragma unroll
    for (int i = 0; i < 2; ++i) { int R, C; stage_rc(tid * 16 + i * 8192, R, C); const int Rb = (R & ~31) + perm32(R & 31);
        voffA[i] = F8 ? (unsigned)(R * g.lda + 2 * C) : (unsigned)(R * g.lda + C) * 2u; voffB[i] = F8 ? (unsigned)(Rb * g.ldb + 2 * C) : (unsigned)(Rb * g.ldb + C) * 2u; }
    const size_t kstep = (size_t)(BK * 2);
    const size_t hstepA = (size_t)HALF * g.lda * (F8 ? 1 : 2), hstepB = (size_t)HALF * g.ldb * (F8 ? 1 : 2);
    const unsigned ldsw = (unsigned)wid * 1024u;
    const int aoff = lds_byte(wr * 64 + fr, fq * 8), boff = lds_byte(wc * 32 + fr, fq * 8);
#define PG8_SA(b, h) (((b) * 2 + (h)) * HTB)
#define PG8_SB(b, h) ((4 + (b) * 2 + (h)) * HTB)
#define PG8_STAGE(bufoff, gbase, voff) do { _Pragma("unroll") for (int _i = 0; _i < 2; ++_i) \
        __builtin_amdgcn_global_load_lds((const unsigned*)((const char*)(gbase) + (voff)[_i]), (LAS unsigned*)(lds + (bufoff) + ldsw + _i * 8192), 16, 0, 0); } while (0)
#define PG8_LDA(dst, b, h) do { _Pragma("unroll") for (int m = 0; m < 4; ++m) { const v4i_t l0_ = *(const LAS v4i_t*)(lds + PG8_SA(b, h) + aoff + m * 2048), l1_ = *(const LAS v4i_t*)(lds + PG8_SA(b, h) + aoff + m * 2048 + 1024); \
        dst[m] = __builtin_shufflevector(l0_, l1_, 0, 1, 2, 3, 4, 5, 6, 7); } } while (0)
#define PG8_LDB(dst, b, h) do { _Pragma("unroll") for (int n = 0; n < 2; ++n) { const v4i_t l0_ = *(const LAS v4i_t*)(lds + PG8_SB(b, h) + boff + n * 2048), l1_ = *(const LAS v4i_t*)(lds + PG8_SB(b, h) + boff + n * 2048 + 1024); \
        dst[n] = __builtin_shufflevector(l0_, l1_, 0, 1, 2, 3, 4, 5, 6, 7); } } while (0)
#define PG8_MMA(ai, bj, At, Bt) do { __builtin_amdgcn_s_setprio(1); _Pragma("unroll") for (int m = 0; m < 4; ++m) _Pragma("unroll") for (int n = 0; n < 2; ++n) { \
        if constexpr (F8) asm volatile("v_mfma_scale_f32_16x16x128_f8f6f4 %0, %1, %2, %0, %3, %4 op_sel_hi:[0,0,0]" : "+v"(acc[ai][bj][m][n]) : "v"(Bt[n]), "v"(At[m]), "v"(f8scale_w), "v"(f8scale_x));   \
        else { const bf16x8 b0_ = __builtin_bit_cast(bf16x8, __builtin_shufflevector(Bt[n], Bt[n], 0, 1, 2, 3)), b1_ = __builtin_bit_cast(bf16x8, __builtin_shufflevector(Bt[n], Bt[n], 4, 5, 6, 7)), \
                            a0_ = __builtin_bit_cast(bf16x8, __builtin_shufflevector(At[m], At[m], 0, 1, 2, 3)), a1_ = __builtin_bit_cast(bf16x8, __builtin_shufflevector(At[m], At[m], 4, 5, 6, 7)); \
            acc[ai][bj][m][n] = __builtin_amdgcn_mfma_f32_16x16x32_bf16(b0_, a0_, acc[ai][bj][m][n], 0, 0, 0); acc[ai][bj][m][n] = __builtin_amdgcn_mfma_f32_16x16x32_bf16(b1_, a1_, acc[ai][bj][m][n], 0, 0, 0); } } \
        __builtin_amdgcn_s_setprio(0); } while (0)
#define PG8_WAIT_V(n) asm volatile("s_waitcnt vmcnt(" #n ")" ::: "memory")
#define PG8_WAIT_L(n) asm volatile("s_waitcnt lgkmcnt(" #n ")" ::: "memory")
#define PG8_BAR __builtin_amdgcn_s_barrier()
#define PG8_SCHED __builtin_amdgcn_sched_barrier(0)
    Unit cur, nxt; int ui = 0;
    if (!S.next(0, cur)) return;
    f32x4 acc[2][2][4][2];
#pragma unroll
    for (int a = 0; a < 2; ++a)
#pragma unroll
        for (int b = 0; b < 2; ++b)
#pragma unroll
            for (int m = 0; m < 4; ++m)
#pragma unroll
                for (int n = 0; n < 2; ++n) acc[a][b][m][n] = (f32x4){0.f, 0.f, 0.f, 0.f};
    typedef int v8i_t __attribute__((ext_vector_type(8))); typedef int v4i_t __attribute__((ext_vector_type(4)));
    const int f8scale_w = 0x7a7a7a7a, f8scale_x = 0x7f7f7f7f;
    v8i_t At[4], B0[2], B1[2];
    const char* cA = (const char*)g.A + cur.aoff; const char* cB = (const char*)g.Bt + cur.boff;
    PG8_STAGE(PG8_SB(0, 0), cB, voffB); PG8_STAGE(PG8_SB(0, 1), cB + hstepB, voffB); PG8_STAGE(PG8_SA(0, 0), cA, voffA); PG8_STAGE(PG8_SA(0, 1), cA + hstepA, voffA);
    if (wr == 1) PG8_BAR;
    PG8_WAIT_V(2); PG8_BAR;
    PG8_STAGE(PG8_SB(1, 0), cB + kstep, voffB); PG8_STAGE(PG8_SA(1, 0), cA + kstep, voffA); PG8_STAGE(PG8_SB(1, 1), cB + hstepB + kstep, voffB);
    PG8_WAIT_V(6); PG8_BAR;
    for (;;) {
        const bool has_next = S.next(ui + 1, nxt);
        const int nt = cur.nt;
        const char* nA = has_next ? (const char*)g.A + nxt.aoff : cA; const char* nB = has_next ? (const char*)g.Bt + nxt.boff : cB;
        for (int t = 0; t < nt; t += 2) {
            if constexpr (Epi::MID) { if (t == 4 || t == 8) { E.mid(acc, cur, t >> 3, wr, wc, fr, fq); } __builtin_amdgcn_sched_barrier(0); }
            const bool last = (t == nt - 2);
            const char* a1 = cA + (size_t)(t + 1) * kstep;
            const char* a2 = last ? nA : cA + (size_t)(t + 2) * kstep; const char* b2 = last ? nB : cB + (size_t)(t + 2) * kstep;
            const char* a3 = a2 + kstep; const char* b3 = b2 + kstep;
            PG8_LDB(B0, 0, 0); PG8_LDB(B1, 0, 1); PG8_SCHED; PG8_LDA(At, 0, 0); PG8_STAGE(PG8_SA(1, 1), a1 + hstepA, voffA);
            PG8_WAIT_V(8); PG8_WAIT_L(0); PG8_BAR; PG8_MMA(0, 0, At, B0); PG8_MMA(0, 1, At, B1); PG8_BAR; PG8_SCHED;
            PG8_LDA(At, 0, 1); PG8_STAGE(PG8_SB(0, 0), b2, voffB); PG8_STAGE(PG8_SB(0, 1), b2 + hstepB, voffB); PG8_STAGE(PG8_SA(0, 0), a2, voffA);
            PG8_WAIT_V(8); PG8_WAIT_L(0); PG8_BAR; PG8_MMA(1, 0, At, B0); PG8_MMA(1, 1, At, B1); PG8_BAR; PG8_SCHED;
            PG8_LDB(B0, 1, 0); PG8_LDB(B1, 1, 1); PG8_SCHED; PG8_LDA(At, 1, 0); PG8_STAGE(PG8_SA(0, 1), a2 + hstepA, voffA);
            PG8_WAIT_V(8); PG8_WAIT_L(0); PG8_BAR; PG8_MMA(0, 0, At, B0); PG8_MMA(0, 1, At, B1); PG8_BAR; PG8_SCHED;
            PG8_LDA(At, 1, 1); PG8_STAGE(PG8_SB(1, 0), b3, voffB); PG8_STAGE(PG8_SB(1, 1), b3 + hstepB, voffB); PG8_STAGE(PG8_SA(1, 0), a3, voffA);
            PG8_WAIT_V(8); PG8_WAIT_L(0); PG8_BAR; PG8_MMA(1, 0, At, B0); PG8_MMA(1, 1, At, B1); PG8_BAR; PG8_SCHED;
        }
        if (wr == 0) PG8_BAR;
        E(acc, cur, wr, wc, fr, fq);
        if (!has_next) break;
#pragma unroll
        for (int a = 0; a < 2; ++a)
#pragma unroll
            for (int b = 0; b < 2; ++b)
#pragma unroll
                for (int m = 0; m < 4; ++m)
#pragma unroll
                    for (int n = 0; n < 2; ++n) acc[a][b][m][n] = (f32x4){0.f, 0.f, 0.f, 0.f};
        cur = nxt; cA = nA; cB = nB; ++ui;
        if (wr == 1) PG8_BAR;
    }
    PG8_WAIT_V(0);
    PG8_BAR;
#undef PG8_SA
#undef PG8_SB
#undef PG8_STAGE
#undef PG8_LDA
#undef PG8_LDB
#undef PG8_MMA
#undef PG8_WAIT_V
#undef PG8_WAIT_L
#undef PG8_BAR
#undef PG8_SCHED
}
}
struct Params { const float* in[27]; float* out; unsigned char* ws; int ph_lo, ph_hi, pad0, pad1; };
enum { I_X = 0, I_MEM, I_POS, I_MIXG, I_WIN, I_POOLW, I_POOLS, I_CONVW, I_ALOG, I_DTB, I_DNG, I_WUPP, I_WUPM, I_WUPD, I_WOUT, I_XAG, I_MEMG, I_XAQ, I_XAKV, I_XAO,
       I_FFNG, I_DGU, I_DD, I_ROUTER, I_MGU, I_MD, I_FING };

struct Frame {
    LAS unsigned char* lds;
    int tid, lane, wave, G, blk;
    unsigned char* ws;
};

struct Job { const float* W; int K, N; bf16_t* WT; int ldt; int mode; int ff; const float* kscale; unsigned char* WT8; };
DI int job_map(int mode, int ff, int n) {
    if (mode == 0) return n;
    if (mode == 1) return n < 2560 ? n : (n < 2576 ? -1 : n - 16);
    if (n < ff) return (n >> 7) * 256 + (n & 127);
    const int m = n - ff; return (m >> 7) * 256 + 128 + (m & 127);
}
DI int job_items(const Job& J) { return (J.K / 64) * ((J.N + 31) / 32); }
DI void transpose_item(const Job& J, LAS float* scr, int item, int lane) {
    const int nblk = (J.N + 31) / 32, kb = item / nblk, nb = item - kb * nblk, k0 = 64 * kb, n0 = 32 * nb;
    const int nn = lane & 31; const bool ok = (n0 + nn) < J.N;
    float tv[32];
#pragma unroll
    for (int i = 0; i < 32; ++i) { const int kk = 2 * i + (lane >> 5); tv[i] = J.W[(size_t)(k0 + kk) * J.N + (ok ? n0 + nn : 0)]; }
#pragma unroll
    for (int i = 0; i < 32; ++i) { const int kk = 2 * i + (lane >> 5); float v = ok ? tv[i] : 0.f; if (J.kscale) v *= J.kscale[k0 + kk]; scr[kk * 33 + nn] = v; }
    LDS_WAIT();
    const int c = lane & 7;
#pragma unroll
    for (int j = 0; j < 4; ++j) { const int n = (lane >> 3) + 8 * j; const int sn = n0 + n; const int drow = sn < J.N ? job_map(J.mode, J.ff, sn) : -1;
        if (drow >= 0) { const LAS float* s = scr + (8 * c) * 33 + n;
            if (J.mode == 1 && drow >= 3072) { u32x2 o;
                o.x = cvt4_fp8(s[0 * 33] * 32.f, s[1 * 33] * 32.f, s[2 * 33] * 32.f, s[3 * 33] * 32.f); o.y = cvt4_fp8(s[4 * 33] * 32.f, s[5 * 33] * 32.f, s[6 * 33] * 32.f, s[7 * 33] * 32.f);
                *(u32x2*)(J.WT8 + (size_t)(drow - 3072) * 1024 + k0 + 8 * c) = o; }
            else { u32x4 o; o.x = pk2(s[0 * 33], s[1 * 33]); o.y = pk2(s[2 * 33], s[3 * 33]); o.z = pk2(s[4 * 33], s[5 * 33]); o.w = pk2(s[6 * 33], s[7 * 33]);
                *(u32x4*)(J.WT + (size_t)drow * J.ldt + k0 + 8 * c) = o; } } }
    LDS_WAIT();
}
constexpr int NJOBS = 2 * 7 + 2 + 16;
DI void get_job(const Frame& F, const Params& P, int j, Job& J) {
    unsigned char* ws = F.ws;
    J.mode = 0; J.ff = 0; J.kscale = nullptr; J.WT8 = nullptr;
    if (j < 14) { const int l = j / 7, t = j - 7 * l; unsigned char* lw = ws + WS_LW + (size_t)l * LW_STRIDE;
        if (t == 0) { J.W = P.in[I_WIN] + (size_t)l * 1024 * IN_COLS; J.K = 1024; J.N = IN_COLS; J.WT = (bf16_t*)(lw + LW_WIN); J.ldt = 1024; J.mode = 1; J.kscale = P.in[I_MIXG] + l * 1024; J.WT8 = ws + WS_WG8 + (size_t)l * 3072 * 1024; }
        else if (t == 1) { J.W = P.in[I_WUPM] + (size_t)l * 256 * 1024; J.K = 256; J.N = 1024; J.WT = (bf16_t*)(lw + LW_WCAT) + 256; J.ldt = 1024; }
        else if (t == 2) { J.W = P.in[I_WUPD] + (size_t)l * 512 * 1024; J.K = 512; J.N = 1024; J.WT = (bf16_t*)(lw + LW_WCAT) + 512; J.ldt = 1024; }
        else if (t == 3) { J.W = P.in[I_WOUT] + (size_t)l * 1024 * 1024; J.K = 1024; J.N = 1024; J.WT = (bf16_t*)(lw + LW_WOUT); J.ldt = 1024; }
        else if (t == 4) { J.W = P.in[I_XAQ] + (size_t)l * 1024 * 512; J.K = 1024; J.N = 512; J.WT = (bf16_t*)(lw + LW_WQ); J.ldt = 1024; J.kscale = P.in[I_XAG] + l * 1024; }
        else if (t == 5) { J.W = P.in[I_XAKV] + (size_t)l * 1024 * 1024; J.K = 1024; J.N = 1024; J.WT = (bf16_t*)(lw + LW_WKV); J.ldt = 1024; }
        else { J.W = P.in[I_XAO] + (size_t)l * 512 * 1024; J.K = 512; J.N = 1024; J.WT = (bf16_t*)(lw + LW_WO); J.ldt = 512; }
    } else if (j == 14) { J.W = P.in[I_DGU]; J.K = 1024; J.N = 2 * FF; J.WT = (bf16_t*)(ws + WS_WGU); J.ldt = 1024; J.mode = 2; J.ff = FF; J.kscale = P.in[I_FFNG]; }
    else if (j == 15) { J.W = P.in[I_DD]; J.K = FF; J.N = 1024; J.WT = (bf16_t*)(ws + WS_WD); J.ldt = FF; }
    else { const int e = (j - 16) >> 1;
        if (((j - 16) & 1) == 0) { J.W = P.in[I_MGU] + (size_t)e * 1024 * 2 * EFF; J.K = 1024; J.N = 2 * EFF; J.WT = (bf16_t*)(ws + WS_WMGU) + (size_t)e * 2 * EFF * 1024; J.ldt = 1024; J.mode = 2; J.ff = EFF; J.kscale = P.in[I_FFNG] + 1024; }
        else { J.W = P.in[I_MD] + (size_t)e * EFF * 1024; J.K = EFF; J.N = 1024; J.WT = (bf16_t*)(ws + WS_WMD) + (size_t)e * 1024 * EFF; J.ldt = EFF; } }
}

DI void phase_prologue(const Frame& F, const Params& P) {
    unsigned char* ws = F.ws;
    const int gw = F.blk * 8 + F.wave, NGW = F.G * 8, lane = F.lane;
    const long gt = (long)F.blk * 512 + F.tid, NGT = (long)F.G * 512;
    { const float* x = P.in[I_X]; bf16_t* xb = (bf16_t*)(ws + WS_XB); float* ssq = (float*)(ws + WS_SSQ); unsigned char* x8 = ws + WS_X8;
      for (int row0 = gw; row0 < NTOK; row0 += 4 * NGW) {
          f32x4 v[4][4];
#pragma unroll
          for (int q = 0; q < 4; ++q) { const int row = row0 + q * NGW; const f32x4* xr = (const f32x4*)(x + (size_t)(row < NTOK ? row : row0) * 1024) + lane;
#pragma unroll
              for (int j = 0; j < 4; ++j) v[q][j] = xr[64 * j]; }
#pragma unroll
          for (int q = 0; q < 4; ++q) { const int row = row0 + q * NGW; if (row < NTOK) { float s = 0.f;
#pragma unroll
              for (int j = 0; j < 4; ++j) s += (v[q][j].x * v[q][j].x + v[q][j].y * v[q][j].y) + (v[q][j].z * v[q][j].z + v[q][j].w * v[q][j].w);
              s = wave_sum(s);
              u32x2* o = (u32x2*)(xb + (size_t)row * 1024) + lane;
#pragma unroll
              for (int j = 0; j < 4; ++j) { u32x2 w; w.x = pk2(v[q][j].x, v[q][j].y); w.y = pk2(v[q][j].z, v[q][j].w); o[64 * j] = w;
                  ((unsigned*)(x8 + (size_t)row * 1024))[lane + 64 * j] = cvt4_fp8(v[q][j].x, v[q][j].y, v[q][j].z, v[q][j].w); }
              if (lane < 16) ssq[(size_t)row * 16 + lane] = lane == 0 ? s : 0.f; } }
      } }
    { const float* mem = P.in[I_MEM]; bf16_t* mn = (bf16_t*)(ws + WS_MEMN);
      for (int row = gw; row < 2048; row += NGW) {
          const f32x4* xr = (const f32x4*)(mem + (size_t)row * 1024) + lane; f32x4 v[4]; float s = 0.f;
#pragma unroll
          for (int j = 0; j < 4; ++j) { v[j] = xr[64 * j]; s += (v[j].x * v[j].x + v[j].y * v[j].y) + (v[j].z * v[j].z + v[j].w * v[j].w); }
          s = wave_sum(s); const float r = rsqrtf(s * (1.0f / 1024.0f) + RMS_EPS);
#pragma unroll
          for (int l = 0; l < 2; ++l) { const f32x4* gr = (const f32x4*)(P.in[I_MEMG] + l * 1024) + lane; u32x2* o = (u32x2*)(mn + ((size_t)l * 2048 + row) * 1024) + lane;
#pragma unroll
              for (int j = 0; j < 4; ++j) { const f32x4 gg = gr[64 * j]; u32x2 w; w.x = pk2(v[j].x * r * gg.x, v[j].y * r * gg.y); w.y = pk2(v[j].z * r * gg.z, v[j].w * r * gg.w); o[64 * j] = w; } }
      } }
    { const int* pos = (const int*)P.in[I_POS]; float* rope = (float*)(ws + WS_ROPE);
      for (long i = gt; i < (long)NTOK * 8; i += NGT) { const int tok = (int)(i >> 3), f = (int)(i & 7);
          const float inv = powf(500000.0f, -(float)f * 2.0f / 16.0f); const float ang = (float)pos[tok] * inv; float sn, cs; sincosf(ang, &sn, &cs);
          rope[(size_t)tok * 16 + f] = cs; rope[(size_t)tok * 16 + 8 + f] = sn; } }
    for (long i = gt; i < 2 * 16 * 1024; i += NGT) { const int l = (int)(i >> 14), j = (int)((i >> 10) & 15), k = (int)(i & 1023);
        const float v = P.in[I_WIN][((size_t)l * 1024 + k) * IN_COLS + 2560 + j] * P.in[I_MIXG][l * 1024 + k];
        ((bf16_t*)(ws + WS_LW + (size_t)l * LW_STRIDE + LW_WBA))[j * 1024 + k] = (bf16_t)f2bf(v); }
    for (long i = gt; i < 8 * 1024; i += NGT) { const int e = (int)(i >> 10), k = (int)(i & 1023); ((float*)(ws + WS_WR))[e * 1024 + k] = P.in[I_ROUTER][k * 8 + e] * P.in[I_FFNG][1024 + k]; }
    for (long i = gt; i < 2L * 256 * 1024; i += NGT) { const int l = (int)(i >> 18), k = (int)((i >> 10) & 255), n = (int)(i & 1023), gi = k >> 6, c = k & 63;
        const float* pw = P.in[I_POOLW] + (((size_t)l * 4 + gi) * 64 + c) * 64; const float* ps = P.in[I_POOLS] + l * 256 + gi * 64; const float* wu = P.in[I_WUPP] + ((size_t)l * 256 + gi * 64) * 1024 + n;
        float s = 0.f;
#pragma unroll 16
        for (int d = 0; d < 64; ++d) s += pw[d] * ps[d] * wu[(size_t)d * 1024];
        ((bf16_t*)(ws + WS_LW + (size_t)l * LW_STRIDE + LW_WCAT))[(size_t)n * 1024 + k] = (bf16_t)f2bf(s); }
    { float* sm = (float*)(ws + WS_SMALL);
      for (long i = gt; i < 2 * 4 * 1536; i += NGT) sm[SM_CONVW + i] = P.in[I_CONVW][i];
      for (long i = gt; i < 16; i += NGT) { sm[SM_ALOG + i] = P.in[I_ALOG][i]; sm[SM_DTB + i] = P.in[I_DTB][i]; }
      for (long i = gt; i < 128; i += NGT) sm[SM_DNG + i] = P.in[I_DNG][i];
      for (long i = gt; i < 1024; i += NGT) sm[SM_FING + i] = P.in[I_FING][i]; }
    { LAS float* scr = (LAS float*)(F.lds + F.wave * 8704);
      int base = 0;
      for (int j = 0; j < NJOBS; ++j) { Job J; get_job(F, P, j, J); const int ni = job_items(J);
          int first = gw - (base % NGW); if (first < 0) first += NGW;
          for (int it = first; it < ni; it += NGW) transpose_item(J, scr, it, lane);
          base += ni; } }
}
DI void ba_tiles(const Frame& F, const bf16_t* xbg, const bf16_t* Wba, const float* ssqg, float* BA) {
    const int lane = F.lane, gw = F.blk * 8 + F.wave, NGW = F.G * 8;
    for (int tile = gw; tile < NG / 16; tile += NGW) {
        const int row0 = tile * 16; f32x4 acc = (f32x4){0.f, 0.f, 0.f, 0.f};
        const bf16_t* ap = xbg + (size_t)(row0 + (lane & 15)) * 1024 + (lane >> 4) * 8; const bf16_t* bp = Wba + (size_t)(lane & 15) * 1024 + (lane >> 4) * 8;
#pragma unroll 8
        for (int ks = 0; ks < 32; ++ks) { const bf16x8 a = *(const bf16x8*)(ap + 32 * ks); const bf16x8 b = *(const bf16x8*)(bp + 32 * ks); acc = MFMA16(a, b, acc); }
#pragma unroll
        for (int i = 0; i < 4; ++i) { const int row = row0 + 4 * (lane >> 4) + i; BA[(size_t)row * 16 + (lane & 15)] = acc[i] * row_rstd(ssqg, row); }
    }
}

template <int W> DI void prep_pool_w(const bf16_t* Pb, bf16_t* BR, int ch, int lr0, int s0) {
    const bf16_t* p = Pb + PC_POOL + ch; float v[32 + W - 1];
#pragma unroll
    for (int i = 0; i < 32 + W - 1; ++i) { const int d = i - (W - 1); const bool ok = s0 + d >= 0; const unsigned short raw = p[(size_t)(ok ? lr0 + d : lr0) * PLD]; v[i] = ok ? bf2f(raw) : 0.f; }
    float sum = 0.f;
#pragma unroll
    for (int i = 0; i < W - 1; ++i) sum += v[i];
#pragma unroll
    for (int t = 0; t < 32; ++t) { const float x = v[t + W - 1]; sum += x; const int s = s0 + t;
        const float o = (s + 1 >= W ? sum * (1.0f / (float)W) : sum / (float)(s + 1)) - x;
        BR[(size_t)(lr0 + t) * 1024 + ch] = (bf16_t)f2bf(o);
        sum -= v[t]; }
}
DI void prep_pool(const Frame& F, const bf16_t* Pb, bf16_t* BR, int unit) {
    int tid_ = F.tid; LAUNDER_V(tid_);
    const int ch = tid_ & 255, half = tid_ >> 8, lr0 = unit * 64 + half * 32, s0 = lr0 & (SEQ - 1), g = F.wave & 3;
    if (g == 0) prep_pool_w<2>(Pb, BR, ch, lr0, s0); else if (g == 1) prep_pool_w<4>(Pb, BR, ch, lr0, s0); else if (g == 2) prep_pool_w<8>(Pb, BR, ch, lr0, s0); else prep_pool_w<16>(Pb, BR, ch, lr0, s0);
}

DI void prep_moba(const Frame& F, bf16_t* Pb, const float* rope, float* KBAR, bf16_t* VT, int unit) {
    int tid_ = F.tid; LAUNDER_V(tid_);
    const int tid = tid_, lane = tid & 63, wave = F.wave;
    const int bl = unit >> 6, j = (unit >> 1) & 31, hp = unit & 1, lr0 = bl * SEQ + j * 256;
    LAS unsigned* Tt = (LAS unsigned*)F.lds; LAS float* KS1 = (LAS float*)(F.lds + 68 * 1024); LAS float* KS2 = KS1 + 128;
    __syncthreads();
    const int r = tid & 255, hh = tid >> 8; const size_t lr = (size_t)(lr0 + r);
    bf16_t* qb = Pb + lr * PLD + PC_MQ + (2 * hp + hh) * 64; bf16_t* kb = Pb + lr * PLD + PC_MK + (2 * hp + hh) * 64;
    const f32x4 c0 = *(const f32x4*)(rope + lr * 16), c1 = *(const f32x4*)(rope + lr * 16 + 4), s0 = *(const f32x4*)(rope + lr * 16 + 8), s1 = *(const f32x4*)(rope + lr * 16 + 12);
    const u32x4 qa = *(const u32x4*)qb, qc = *(const u32x4*)(qb + 8), ka = *(const u32x4*)kb, kc = *(const u32x4*)(kb + 8);
    const int c8 = tid & 15, rg = tid >> 4; const bool plain = (c8 & 7) >= 2;
    u32x4 vv[8], kk[8];
#pragma unroll
    for (int i = 0; i < 8; ++i) vv[i] = *(const u32x4*)(Pb + (size_t)(lr0 + ((tid + 512 * i) >> 4)) * PLD + PC_MV + hp * 128 + c8 * 8);
#pragma unroll
    for (int i = 0; i < 8; ++i) kk[i] = plain ? *(const u32x4*)(Pb + (size_t)(lr0 + rg * 8 + i) * PLD + PC_MK + hp * 128 + c8 * 8) : (u32x4){0u, 0u, 0u, 0u};
    __builtin_amdgcn_sched_barrier(0);
    {
        const float cs[8] = {c0.x, c0.y, c0.z, c0.w, c1.x, c1.y, c1.z, c1.w}, sn[8] = {s0.x, s0.y, s0.z, s0.w, s1.x, s1.y, s1.z, s1.w};
        float q1[8], q2[8], k1[8], k2[8];
#pragma unroll
        for (int q = 0; q < 4; ++q) { q1[2 * q] = __uint_as_float(qa[q] << 16); q1[2 * q + 1] = __uint_as_float(qa[q] & 0xffff0000u); q2[2 * q] = __uint_as_float(qc[q] << 16); q2[2 * q + 1] = __uint_as_float(qc[q] & 0xffff0000u);
                                      k1[2 * q] = __uint_as_float(ka[q] << 16); k1[2 * q + 1] = __uint_as_float(ka[q] & 0xffff0000u); k2[2 * q] = __uint_as_float(kc[q] << 16); k2[2 * q + 1] = __uint_as_float(kc[q] & 0xffff0000u); }
        float ra[8], rb[8]; u32x4 oa, ob;
#pragma unroll
        for (int e = 0; e < 8; ++e) { ra[e] = q1[e] * cs[e] - q2[e] * sn[e]; rb[e] = q2[e] * cs[e] + q1[e] * sn[e]; }
#pragma unroll
        for (int q = 0; q < 4; ++q) { oa[q] = pk2(ra[2 * q], ra[2 * q + 1]); ob[q] = pk2(rb[2 * q], rb[2 * q + 1]); }
        *(u32x4*)qb = oa; *(u32x4*)(qb + 8) = ob;
#pragma unroll
        for (int e = 0; e < 8; ++e) { ra[e] = k1[e] * cs[e] - k2[e] * sn[e]; rb[e] = k2[e] * cs[e] + k1[e] * sn[e]; }
#pragma unroll
        for (int q = 0; q < 4; ++q) { oa[q] = pk2(ra[2 * q], ra[2 * q + 1]); ob[q] = pk2(rb[2 * q], rb[2 * q + 1]); }
        *(u32x4*)kb = oa; *(u32x4*)(kb + 8) = ob;
#pragma unroll
        for (int e = 0; e < 8; ++e) { const float a = wave_sum(ra[e]), b = wave_sum(rb[e]); if (lane == 0) { KS1[wave * 16 + e] = a; KS1[wave * 16 + 8 + e] = b; } }
    }
    {
        float sacc[8];
#pragma unroll
        for (int e = 0; e < 8; ++e) sacc[e] = 0.f;
#pragma unroll
        for (int i = 0; i < 8; ++i)
#pragma unroll
            for (int q = 0; q < 4; ++q) { sacc[2 * q] += __uint_as_float(kk[i][q] << 16); sacc[2 * q + 1] += __uint_as_float(kk[i][q] & 0xffff0000u); }
#pragma unroll
        for (int e = 0; e < 8; ++e) { sacc[e] += __shfl_xor(sacc[e], 16); sacc[e] += __shfl_xor(sacc[e], 32); }
        if (lane < 16) {
#pragma unroll
            for (int e = 0; e < 8; ++e) KS2[wave * 128 + c8 * 8 + e] = sacc[e]; }
    }
#pragma unroll
    for (int i = 0; i < 8; ++i) { const int tok = (tid + 512 * i) >> 4;
#pragma unroll
        for (int e = 0; e < 4; ++e) Tt[tok * 65 + c8 * 4 + e] = vv[i][e]; }
    __syncthreads();
    if (tid < 128) { const int h2 = tid >> 6, d = tid & 63; float sum = 0.f;
        if (d < 16) {
#pragma unroll
            for (int w = 0; w < 4; ++w) sum += KS1[(4 * h2 + w) * 16 + d]; }
        else {
#pragma unroll
            for (int w = 0; w < 8; ++w) sum += KS2[w * 128 + tid]; }
        KBAR[((size_t)(bl * 4 + 2 * hp + h2) * 32 + j) * 64 + d] = sum * (1.0f / 256.0f); }
    const LAS unsigned char* Tb = (const LAS unsigned char*)Tt;
#pragma unroll
    for (int i = 0; i < 8; ++i) { const int o = tid + 512 * i, t8 = o & 7, cl = (o >> 3) & 7, rest = o >> 6, th = rest & 3, cg = rest >> 2, col = cg * 8 + cl, tg = th * 8 + t8;
        unsigned short hv[8];
#pragma unroll
        for (int e = 0; e < 8; ++e) hv[e] = *(const LAS unsigned short*)(Tb + ((tg * 8 + e) * 65 + (col >> 1)) * 4 + (col & 1) * 2);
        u32x4 w;
#pragma unroll
        for (int e = 0; e < 4; ++e) w[e] = (unsigned)hv[2 * e] | ((unsigned)hv[2 * e + 1] << 16);
        *(u32x4*)(VT + ((size_t)(bl * 256 + hp * 128 + col)) * SEQ + j * 256 + tg * 8) = w; }
    __syncthreads();
}

constexpr int DN_ROWB = 144;
constexpr int DN_TQ = 0, DN_TK = 9216, DN_TKB = 18432, DN_TVB = 27648, DN_MISC = 36864, DN_PAIR = 38400;
__host__ __device__ constexpr int ap_rowoff(int i) { return i == 0 ? 0 : 4 * (((i - 1) / 4) + 1) * (2 * ((i - 1) / 4) + ((i - 1) % 4)); }

template <int I> DI void subst_load(const LAS float* Ap, const LAS unsigned char* Rt, const LAS float* SCL, int lane, f32x4 (&av)[16], float& Ri) {
    constexpr int off = ap_rowoff(I);
#pragma unroll
    for (int j4 = 0; j4 < I; j4 += 4) av[j4 >> 2] = *(const LAS f32x4*)(Ap + off + j4);
    Ri = bf2f(*(const LAS bf16_t*)(Rt + I * DN_ROWB + lane * 2)) * SCL[I];
}
template <int I> struct Subst2 { static DI void run(float (&x)[64], const LAS float* Ap, const LAS unsigned char* Rt, const LAS float* SCL, int lane, f32x4 (&cur)[16], float Rc, f32x4 (&nxt)[16]) {
    float Rn = 0.f;
    if constexpr (I + 1 < 64) subst_load<I + 1>(Ap, Rt, SCL, lane, nxt, Rn);
    float a0 = Rc, a1 = 0.f, a2 = 0.f, a3 = 0.f;
#pragma unroll
    for (int j4 = 0; j4 < I; j4 += 4) { const f32x4 av = cur[j4 >> 2];
        a0 -= av.x * x[j4];
        if (j4 + 1 < I) a1 -= av.y * x[j4 + 1];
        if (j4 + 2 < I) a2 -= av.z * x[j4 + 2];
        if (j4 + 3 < I) a3 -= av.w * x[j4 + 3]; }
    x[I] = (a0 + a1) + (a2 + a3);
    asm volatile("" : "+v"(x[I])); __builtin_amdgcn_sched_barrier(0);
    if constexpr (I + 1 < 64) Subst2<I + 1>::run(x, Ap, Rt, SCL, lane, nxt, Rn, cur);
} };

DI void conv_w_load(const float* convw, int wcol, float (&w)[4][8]) {
#pragma unroll
    for (int j = 0; j < 4; ++j) { const f32x4 w0 = *(const f32x4*)(convw + j * 1536 + wcol), w1 = *(const f32x4*)(convw + j * 1536 + wcol + 4);
        w[j][0] = w0.x; w[j][1] = w0.y; w[j][2] = w0.z; w[j][3] = w0.w; w[j][4] = w1.x; w[j][5] = w1.y; w[j][6] = w1.z; w[j][7] = w1.w; }
}
DI void conv8(const bf16_t* Pb, const float (&w)[4][8], int lr, int s, int pcol8, float (&a)[8]) {
#pragma unroll
    for (int e = 0; e < 8; ++e) a[e] = 0.f;
    u32x4 xv[4];
#pragma unroll
    for (int j = 0; j < 4; ++j) { const bool valid = (s - 3 + j) >= 0; xv[j] = *(const u32x4*)(Pb + (size_t)(valid ? lr - 3 + j : lr) * PLD + pcol8);
        xv[j].x = valid ? xv[j].x : 0u; xv[j].y = valid ? xv[j].y : 0u; xv[j].z = valid ? xv[j].z : 0u; xv[j].w = valid ? xv[j].w : 0u; }
#pragma unroll
    for (int j = 0; j < 4; ++j) {
        a[0] += w[j][0] * __uint_as_float(xv[j][0] << 16); a[1] += w[j][1] * __uint_as_float(xv[j][0] & 0xffff0000u);
        a[2] += w[j][2] * __uint_as_float(xv[j][1] << 16); a[3] += w[j][3] * __uint_as_float(xv[j][1] & 0xffff0000u);
        a[4] += w[j][4] * __uint_as_float(xv[j][2] << 16); a[5] += w[j][5] * __uint_as_float(xv[j][2] & 0xffff0000u);
        a[6] += w[j][6] * __uint_as_float(xv[j][3] << 16); a[7] += w[j][7] * __uint_as_float(xv[j][3] & 0xffff0000u);
    }
#pragma unroll
    for (int e = 0; e < 8; ++e) a[e] = a[e] * fsigmoid(a[e]);
}
DI float ssq8(const float (&a)[8]) { float ss = 0.f;
#pragma unroll
    for (int e = 0; e < 8; ++e) ss += a[e] * a[e];
    ss += __shfl_xor(ss, 1); ss += __shfl_xor(ss, 2); ss += __shfl_xor(ss, 4); return ss; }
DI u32x4 pack8(const float (&a)[8], float sc) { u32x4 w; w.x = pk2(a[0] * sc, a[1] * sc); w.y = pk2(a[2] * sc, a[3] * sc); w.z = pk2(a[4] * sc, a[5] * sc); w.w = pk2(a[6] * sc, a[7] * sc); return w; }

#ifndef DBG_RA
#define DBG_RA 1
#endif
#ifndef DBG_RB
#define DBG_RB 1
#endif
#ifndef DBG_RC
#define DBG_RC 1
#endif
#ifndef DBG_RD
#define DBG_RD 1
#endif
#ifndef DBG_RB2
#define DBG_RB2 1
#endif
constexpr int DN_PCNT = 4 * DN_PAIR;
DI void pair_bar(LAS unsigned* cnt, unsigned& gen, int lane) {
    asm volatile("s_waitcnt lgkmcnt(0)" ::: "memory");
    gen += 2u;
    if (lane == 0) __hip_atomic_fetch_add(cnt, 1u, __ATOMIC_RELAXED, __HIP_MEMORY_SCOPE_WORKGROUP);
    for (;;) { const unsigned v = __builtin_amdgcn_readfirstlane(__hip_atomic_load(cnt, __ATOMIC_RELAXED, __HIP_MEMORY_SCOPE_WORKGROUP)); if (v >= gen) break; __builtin_amdgcn_s_sleep(1); }
    asm volatile("" ::: "memory");
}
DI void prep_dn(const Frame& F, const bf16_t* Pb, const float* BA, const float* convw, const float* alog, const float* dtb,
                bf16_t* QD, bf16_t* MM, bf16_t* NT, bf16_t* WN, bf16_t* UT, bf16_t* AQK, float* GL, int unit, unsigned& pgen) {
    int lane_ = F.lane; LAUNDER_V(lane_);
    const int lane = lane_, wave = F.wave, pr = wave >> 1, role = wave & 1;
    const int bl = unit >> 8, rem = unit & 255, n = rem >> 1, hq = rem & 1, h = 4 * hq + pr;
    const int lr0 = bl * SEQ + n * 64;
    const int chidx = (bl * 128 + n) * 8 + h;
    LAS unsigned char* L = F.lds + pr * DN_PAIR;
    LAS unsigned* const pcnt = (LAS unsigned*)(F.lds + DN_PCNT) + pr * 16;
#define PAIR_BAR() pair_bar(pcnt, pgen, lane)
    LAS float* Gs = (LAS float*)(L + DN_MISC); LAS float* EG = Gs + 64; LAS float* EGL = Gs + 128; LAS float* ONES = Gs + 192; LAS float* BETA = Gs + 256 + 64 * role;
    {
        const int lr = lr0 + lane;
        const float braw = BA[(size_t)lr * 16 + h], araw = BA[(size_t)lr * 16 + 8 + h];
        const float beta = fsigmoid(braw);
        const float xa = araw + dtb[h]; const float sp = xa > 20.f ? xa : log1pf(__expf(xa));
        float G = -__expf(alog[h]) * sp;
#pragma unroll
        for (int o = 1; o < 64; o <<= 1) { const float up = __shfl_up(G, o); if (lane >= o) G += up; }
        const float Glast = __shfl(G, 63);
        BETA[lane] = beta;
        if (role == 0) { Gs[lane] = G; EG[lane] = __expf(G); EGL[lane] = __expf(Glast - G); ONES[lane] = 1.0f; if (lane == 0) GL[chidx] = __expf(Glast); }
    }
    LDS_WAIT();
    for (int rpA = 0; rpA < DBG_RA; ++rpA) {
        const int cg = lane & 7, tl = lane >> 3; float w[4][8];
        if (role == 0) {
            conv_w_load(convw, h * 64 + cg * 8, w);
#pragma unroll 4
            for (int ps = 0; ps < 8; ++ps) { const int t = ps * 8 + tl; float a[8]; conv8(Pb, w, lr0 + t, n * 64 + t, PC_DQ + h * 64 + cg * 8, a);
                const float rn = rsqrtf(ssq8(a) + RMS_EPS) * 0.125f;
                *(LAS u32x4*)(L + DN_TQ + t * DN_ROWB + cg * 16) = pack8(a, rn); }
        } else {
            conv_w_load(convw, 512 + h * 64 + cg * 8, w);
#pragma unroll 4
            for (int ps = 0; ps < 8; ++ps) { const int t = ps * 8 + tl; float a[8]; conv8(Pb, w, lr0 + t, n * 64 + t, PC_DK + h * 64 + cg * 8, a);
                const float rn = rsqrtf(ssq8(a) + RMS_EPS);
                *(LAS u32x4*)(L + DN_TK + t * DN_ROWB + cg * 16) = pack8(a, rn); *(LAS u32x4*)(L + DN_TKB + t * DN_ROWB + cg * 16) = pack8(a, rn * BETA[t]); }
        }
        conv_w_load(convw, 1024 + h * 64 + cg * 8, w);
#pragma unroll 4
        for (int ps = 4 * role; ps < 4 * role + 4; ++ps) { const int t = ps * 8 + tl; float a[8]; conv8(Pb, w, lr0 + t, n * 64 + t, PC_DV + h * 64 + cg * 8, a);
            *(LAS u32x4*)(L + DN_TVB + t * DN_ROWB + cg * 16) = pack8(a, BETA[t]); }
    }
    PAIR_BAR();
    for (int rpB = 0; rpB < DBG_RB; ++rpB) {
        const int fr = lane & 15, fq = lane >> 4;
#pragma unroll
        for (int tt = 0; tt < 8; ++tt) { const int tile = 2 * tt + role, it = tile >> 2, jt = tile & 3;
            f32x4 acc = (f32x4){0.f, 0.f, 0.f, 0.f};
            if (jt <= it) {
#pragma unroll
                for (int ks = 0; ks < 2; ++ks) { const bf16x8 a = *(const LAS bf16x8*)(L + DN_TK + (16 * jt + fr) * DN_ROWB + (fq * 8 + 32 * ks) * 2);
                    const bf16x8 b = *(const LAS bf16x8*)(L + DN_TQ + (16 * it + fr) * DN_ROWB + (fq * 8 + 32 * ks) * 2); acc = MFMA16(a, b, acc); } }
            const int ii = 16 * it + fr; const float Gi = Gs[ii]; float v[4];
#pragma unroll
            for (int r = 0; r < 4; ++r) { const int jj = 16 * jt + 4 * fq + r; v[r] = (jj <= ii) ? acc[r] * __expf(Gi - Gs[jj]) : 0.f; }
            u32x2 w; w.x = pk2(v[0], v[1]); w.y = pk2(v[2], v[3]);
            *(u32x2*)(AQK + (size_t)chidx * 4096 + ii * 64 + 16 * jt + 4 * fq) = w;
        }
#pragma unroll
        for (int i = 0; i < 4; ++i) { const int idx = lane + 64 * role + 128 * i, t = idx >> 3, cg = idx & 7; const u32x4 qv = *(const LAS u32x4*)(L + DN_TQ + t * DN_ROWB + cg * 16); const float eg = EG[t]; u32x4 w;
#pragma unroll
            for (int e = 0; e < 4; ++e) w[e] = pk2(__uint_as_float(qv[e] << 16) * eg, __uint_as_float(qv[e] & 0xffff0000u) * eg);
            *(u32x4*)(QD + (size_t)chidx * 4096 + t * 64 + cg * 8) = w; }
    }
    PAIR_BAR();
    for (int rpB2 = 0; rpB2 < DBG_RB2; ++rpB2) {
        const int fr = lane & 15, fq = lane >> 4; LAS float* Ap = (LAS float*)(L + DN_TQ);
#pragma unroll
        for (int tt = 0; tt < 5; ++tt) { const int q = 2 * tt + role;
            const int it = q < 1 ? 0 : (q < 3 ? 1 : (q < 6 ? 2 : 3)), jt = q - (it * (it + 1)) / 2;
            f32x4 acc = (f32x4){0.f, 0.f, 0.f, 0.f};
#pragma unroll
            for (int ks = 0; ks < 2; ++ks) { const bf16x8 a = *(const LAS bf16x8*)(L + DN_TKB + (16 * it + fr) * DN_ROWB + (fq * 8 + 32 * ks) * 2);
                const bf16x8 b = *(const LAS bf16x8*)(L + DN_TK + (16 * jt + fr) * DN_ROWB + (fq * 8 + 32 * ks) * 2); acc = MFMA16(a, b, acc); }
            const int jj = 16 * jt + fr; const float Gj = Gs[jj];
#pragma unroll
            for (int r = 0; r < 4; ++r) { const int ii = 16 * it + 4 * fq + r;
                if (jj < ii) { const int m1 = ii - 1, gf = m1 >> 2, rm = m1 & 3; Ap[4 * (gf + 1) * (2 * gf + rm) + jj] = acc[r] * __expf(Gs[ii] - Gj); } }
        }
    }
    u32x4 kdt[4];
#pragma unroll
    for (int i = 0; i < 4; ++i) { const int idx = lane + 64 * role + 128 * i, d = idx >> 3, tc = idx & 7; unsigned short kv[8];
#pragma unroll
        for (int e = 0; e < 8; ++e) kv[e] = *(const LAS bf16_t*)(L + DN_TK + (tc * 8 + e) * DN_ROWB + d * 2);
#pragma unroll
        for (int e = 0; e < 4; ++e) kdt[i][e] = pk2(bf2f(kv[2 * e]) * EGL[tc * 8 + 2 * e], bf2f(kv[2 * e + 1]) * EGL[tc * 8 + 2 * e + 1]); }
    PAIR_BAR();
#pragma unroll
    for (int i = 0; i < 4; ++i) { const int idx = lane + 64 * role + 128 * i, d = idx >> 3, tc = idx & 7; *(LAS u32x4*)(L + DN_TK + d * DN_ROWB + tc * 16) = kdt[i]; }
    for (int rpC = 0; rpC < DBG_RC; ++rpC) {
        float x[64];
        LAS unsigned char* const RT = L + DN_TVB - role * (DN_TVB - DN_TKB);
        { f32x4 avA[16], avB[16]; float R0; subst_load<0>((const LAS float*)(L + DN_TQ), RT, Gs + 192 - role * 128, lane, avA, R0);
          Subst2<0>::run(x, (const LAS float*)(L + DN_TQ), RT, Gs + 192 - role * 128, lane, avA, R0, avB); }
        { LAS unsigned char* T = RT + lane * DN_ROWB;
#pragma unroll
          for (int cg = 0; cg < 8; ++cg) { u32x4 w; w.x = pk2(x[cg * 8], x[cg * 8 + 1]); w.y = pk2(x[cg * 8 + 2], x[cg * 8 + 3]); w.z = pk2(x[cg * 8 + 4], x[cg * 8 + 5]); w.w = pk2(x[cg * 8 + 6], x[cg * 8 + 7]);
              *(LAS u32x4*)(T + cg * 16) = w; if (role == 0) *((u32x4*)(UT + (size_t)chidx * 4096 + lane * 64) + cg) = w; } }
    }
    PAIR_BAR();
#pragma unroll
    for (int i = 0; i < 4; ++i) { const int idx = lane + 64 * role + 128 * i, cg = idx >> 6, t = idx & 63; unsigned short wv[8];
#pragma unroll
        for (int e = 0; e < 8; ++e) wv[e] = *(const LAS bf16_t*)(L + DN_TKB + (cg * 8 + e) * DN_ROWB + t * 2);
        u32x4 w;
#pragma unroll
        for (int e = 0; e < 4; ++e) w[e] = ((unsigned)wv[2 * e] | ((unsigned)wv[2 * e + 1] << 16)) ^ 0x80008000u;
        *(u32x4*)(WN + (size_t)chidx * 4096 + t * 64 + cg * 8) = w; }
    for (int rpD = 0; rpD < DBG_RD; ++rpD) {
        const int fr = lane & 15, fq = lane >> 4; const float glast = EG[63];
#pragma unroll
        for (int tt = 0; tt < 8; ++tt) { const int tile = 2 * tt + role, mt = tile >> 2, nt = tile & 3;
            f32x4 acc = (f32x4){0.f, 0.f, 0.f, 0.f};
#pragma unroll
            for (int ks = 0; ks < 2; ++ks) { const bf16x8 a = *(const LAS bf16x8*)(L + DN_TKB + (16 * mt + fr) * DN_ROWB + (fq * 8 + 32 * ks) * 2);
                const bf16x8 b = *(const LAS bf16x8*)(L + DN_TK + (16 * nt + fr) * DN_ROWB + (fq * 8 + 32 * ks) * 2); acc = MFMA16(a, b, acc); }
            { const int dko = 16 * nt + fr, dki0 = 16 * mt + 4 * fq; u32x2 w;
              w.x = pk2((dko == dki0 ? glast : 0.f) - acc[0], (dko == dki0 + 1 ? glast : 0.f) - acc[1]); w.y = pk2((dko == dki0 + 2 ? glast : 0.f) - acc[2], (dko == dki0 + 3 ? glast : 0.f) - acc[3]);
              *(u32x2*)(MM + (size_t)chidx * 4096 + dko * 64 + dki0) = w; }
            acc = (f32x4){0.f, 0.f, 0.f, 0.f};
#pragma unroll
            for (int ks = 0; ks < 2; ++ks) { const bf16x8 a = *(const LAS bf16x8*)(L + DN_TK + (16 * mt + fr) * DN_ROWB + (fq * 8 + 32 * ks) * 2);
                const bf16x8 b = *(const LAS bf16x8*)(L + DN_TVB + (16 * nt + fr) * DN_ROWB + (fq * 8 + 32 * ks) * 2); acc = MFMA16(a, b, acc); }
            { u32x2 w; w.x = pk2(acc[0], acc[1]); w.y = pk2(acc[2], acc[3]); *(u32x2*)(NT + (size_t)chidx * 4096 + (16 * nt + fr) * 64 + 16 * mt + 4 * fq) = w; }
        }
    }
    PAIR_BAR();
}
#undef PAIR_BAR
constexpr int SC_ROWB = 144;
constexpr int SC_ST = 0, SC_VT = 64 * SC_ROWB, SC_RS = 2 * 64 * SC_ROWB;
DI void dn_scan(const Frame& F, int chain, const bf16_t* MM, const bf16_t* NT, bf16_t* SG, int nb, int ne, bool do_store = true) {
    const int lane = F.lane, wave = F.wave, rt = wave & 3, fr = lane & 15, fq = lane >> 4; const bool worker = wave < 4;
    const int bl = chain >> 3, h = chain & 7;
    LAS unsigned char* L = F.lds;
    if (nb == 0) for (int i = F.tid; i < 64 * SC_ROWB / 4; i += 512) ((LAS unsigned*)L)[i] = 0u;
    const size_t cstride = (size_t)8 * 4096;
    size_t cb = (size_t)((bl * 128 + nb) * 8 + h) * 4096;
    const int aoffs = (16 * rt + fr) * 64 + fq * 8;
    const int coff0 = fr * 64 + 16 * rt + 4 * fq;
    if (worker && nb == 0) {
#pragma unroll
        for (int nt = 0; nt < 4; ++nt) *(u32x2*)(SG + cb + coff0 + 1024 * nt) = (u32x2){0u, 0u}; }
    bf16x8 a[4][2]; u32x2 nc[4][4];
    if (worker) {
#pragma unroll
        for (int j = 0; j < 4; ++j) { const size_t cj = cb + (size_t)(nb + j < 127 ? j : 0) * cstride;
#pragma unroll
            for (int ks = 0; ks < 2; ++ks) a[j][ks] = *(const bf16x8*)(MM + cj + aoffs + 32 * ks);
#pragma unroll
            for (int nt = 0; nt < 4; ++nt) nc[j][nt] = *(const u32x2*)(NT + cj + coff0 + 1024 * nt); } }
    __syncthreads();
#pragma unroll 1
    for (int n0 = nb; n0 < ne; n0 += 16) {
#pragma unroll
        for (int jj = 0; jj < 16; ++jj) { const int j = jj & 3; const int n = n0 + jj;
            if (n < ne) {
                const size_t cbn = cb + cstride;
                if (worker) {
                    LAS unsigned char* SR = L + (n & 1) * 64 * SC_ROWB; LAS unsigned char* SW = L + ((n + 1) & 1) * 64 * SC_ROWB;
#pragma unroll
                    for (int nt = 0; nt < 4; ++nt) {
                        f32x4 acc = (f32x4){__uint_as_float(nc[j][nt].x << 16), __uint_as_float(nc[j][nt].x & 0xffff0000u), __uint_as_float(nc[j][nt].y << 16), __uint_as_float(nc[j][nt].y & 0xffff0000u)};
#pragma unroll
                        for (int ks = 0; ks < 2; ++ks) { const bf16x8 sb = *(const LAS bf16x8*)(SR + (16 * nt + fr) * SC_ROWB + (fq * 8 + 32 * ks) * 2); acc = MFMA16(a[j][ks], sb, acc); }
                        u32x2 w; w.x = cvt_pk_bf16(acc[0], acc[1]); w.y = cvt_pk_bf16(acc[2], acc[3]);
                        *(LAS u32x2*)(SW + (16 * nt + fr) * SC_ROWB + (16 * rt + 4 * fq) * 2) = w;
                        if (do_store) *(u32x2*)(SG + cbn + coff0 + 1024 * nt) = w;
                    }
                    if (n + 4 < 127) { const size_t c4 = cb + 4 * cstride;
#pragma unroll
                        for (int ks = 0; ks < 2; ++ks) a[j][ks] = *(const bf16x8*)(MM + c4 + aoffs + 32 * ks);
#pragma unroll
                        for (int nt = 0; nt < 4; ++nt) nc[j][nt] = *(const u32x2*)(NT + c4 + coff0 + 1024 * nt); }
                }
                WG_BAR();
                cb = cbn;
            }
        }
    }
    __syncthreads();
}

struct OutOps { bf16x8 wn[2], qd[2], aq[2], sb[4][2]; u32x2 uv[4]; unsigned short zv[16]; };
DI void out_load(OutOps& o, int k, int rt, int fr, int fq, const bf16_t* QD, const bf16_t* WN, const bf16_t* UT, const bf16_t* AQK, const bf16_t* SG, const bf16_t* ZB) {
    const size_t cb = (size_t)k * 4096; const int arow = 16 * rt + fr; const int h = k & 7, n = (k >> 3) & 127, bl = k >> 10;
#pragma unroll
    for (int ks = 0; ks < 2; ++ks) { const size_t off = cb + arow * 64 + fq * 8 + 32 * ks;
        o.wn[ks] = *(const bf16x8*)(WN + off); o.qd[ks] = *(const bf16x8*)(QD + off); o.aq[ks] = *(const bf16x8*)(AQK + off); }
#pragma unroll
    for (int nt = 0; nt < 4; ++nt) { o.uv[nt] = *(const u32x2*)(UT + cb + (16 * nt + fr) * 64 + 16 * rt + 4 * fq);
#pragma unroll
        for (int ks = 0; ks < 2; ++ks) o.sb[nt][ks] = *(const bf16x8*)(SG + cb + (16 * nt + fr) * 64 + fq * 8 + 32 * ks); }
    const int lrb = bl * SEQ + n * 64 + 16 * rt + 4 * fq;
#pragma unroll
    for (int r = 0; r < 4; ++r)
#pragma unroll
        for (int nt = 0; nt < 4; ++nt) o.zv[r * 4 + nt] = ZB[(size_t)(lrb + r) * 512 + h * 64 + 16 * nt + fr];
}
DI void dn_out_pass(const Frame& F, const bf16_t* QD, const bf16_t* WN, const bf16_t* UT, const bf16_t* AQK, const bf16_t* SG, const bf16_t* ZB, const float* dng, bf16_t* BR) {
    int lane_ = F.lane; LAUNDER_V(lane_);
    const int lane = lane_, wave = F.wave, rt = wave & 3, half = wave >> 2, fr = lane & 15, fq = lane >> 4;
    LAS unsigned char* L = F.lds;
    float ng[4];
#pragma unroll
    for (int nt = 0; nt < 4; ++nt) ng[nt] = dng[16 * nt + fr];
    int p = F.blk; if (p >= NCH / 2) return;
    OutOps cur, nxt;
    out_load(cur, 2 * p + half, rt, fr, fq, QD, WN, UT, AQK, SG, ZB);
    __syncthreads();
    for (int it = 0; p < NCH / 2; p += F.G, ++it) {
        const int k = 2 * p + half, pn = p + F.G < NCH / 2 ? p + F.G : p;
        out_load(nxt, 2 * pn + half, rt, fr, fq, QD, WN, UT, AQK, SG, ZB);
        const int h = k & 7, n = (k >> 3) & 127, bl = k >> 10;
        LAS unsigned char* VT = L + ((it & 1) * 2 + half) * 64 * SC_ROWB;
        f32x4 vn[4], o[4];
#pragma unroll
        for (int nt = 0; nt < 4; ++nt) { vn[nt] = (f32x4){__uint_as_float(cur.uv[nt].x << 16), __uint_as_float(cur.uv[nt].x & 0xffff0000u), __uint_as_float(cur.uv[nt].y << 16), __uint_as_float(cur.uv[nt].y & 0xffff0000u)};
            o[nt] = (f32x4){0.f, 0.f, 0.f, 0.f};
#pragma unroll
            for (int ks = 0; ks < 2; ++ks) { vn[nt] = MFMA16(cur.wn[ks], cur.sb[nt][ks], vn[nt]); o[nt] = MFMA16(cur.qd[ks], cur.sb[nt][ks], o[nt]); } }
#pragma unroll
        for (int nt = 0; nt < 4; ++nt) { u32x2 w; w.x = cvt_pk_bf16(vn[nt][0], vn[nt][1]); w.y = cvt_pk_bf16(vn[nt][2], vn[nt][3]);
            *(LAS u32x2*)(VT + (16 * nt + fr) * SC_ROWB + (16 * rt + 4 * fq) * 2) = w; }
        WG_BAR();
#pragma unroll
        for (int nt = 0; nt < 4; ++nt)
#pragma unroll
            for (int ks = 0; ks < 2; ++ks) { const bf16x8 vb = *(const LAS bf16x8*)(VT + (16 * nt + fr) * SC_ROWB + (fq * 8 + 32 * ks) * 2); o[nt] = MFMA16(cur.aq[ks], vb, o[nt]); }
        const int lrb = bl * SEQ + n * 64 + 16 * rt + 4 * fq;
#pragma unroll
        for (int r = 0; r < 4; ++r) { float q = (o[0][r] * o[0][r] + o[1][r] * o[1][r]) + (o[2][r] * o[2][r] + o[3][r] * o[3][r]);
            q += __shfl_xor(q, 1); q += __shfl_xor(q, 2); q += __shfl_xor(q, 4); q += __shfl_xor(q, 8);
            const float rs = rsqrtf(q * (1.0f / 64.0f) + RMS_EPS); const size_t lr = (size_t)(lrb + r);
#pragma unroll
            for (int nt = 0; nt < 4; ++nt) { const float z = bf2f(cur.zv[r * 4 + nt]);
                BR[lr * 1024 + 512 + h * 64 + 16 * nt + fr] = (bf16_t)f2bf(o[nt][r] * rs * ng[nt] * (z * fsigmoid(z))); } }
        cur = nxt;
    }
    __syncthreads();
}

constexpr int MG_QS = 0, MG_KB = 36864, MG_SEL = MG_KB + 8192, MG_TOP = MG_SEL + 1024;
DI void moba_gate_unit(const Frame& F, const bf16_t* Pb, const float* KBAR, unsigned* SELG, unsigned char* LISTG, int* CNTG, int bl, int h, int c) {
    int lane_ = F.lane; LAUNDER_V(lane_);
    const int lane = lane_, wave = F.wave, tid = wave * 64 + lane;
    LAS unsigned char* L = F.lds; LAS float* KB = (LAS float*)(L + MG_KB); LAS unsigned* SEL = (LAS unsigned*)(L + MG_SEL);
    const int q0 = bl * SEQ + c * 256, bh = bl * 4 + h;
    __syncthreads();
    {
        u32x4 qv4[4]; float kbv[4];
#pragma unroll
        for (int i = 0; i < 4; ++i) { const int q = tid + 512 * i, r = q >> 3, c8 = q & 7; qv4[i] = *(const u32x4*)(Pb + (size_t)(q0 + r) * PLD + PC_MQ + h * 64 + c8 * 8); }
#pragma unroll
        for (int i = 0; i < 4; ++i) { const int idx = tid + 512 * i; kbv[i] = idx < c * 64 ? KBAR[(size_t)bh * 2048 + idx] : 0.f; }
        __builtin_amdgcn_sched_barrier(0);
#pragma unroll
        for (int i = 0; i < 4; ++i) { const int q = tid + 512 * i, r = q >> 3, c8 = q & 7; *(LAS u32x4*)(L + MG_QS + r * 144 + c8 * 16) = qv4[i]; }
#pragma unroll
        for (int i = 0; i < 4; ++i) { const int idx = tid + 512 * i; if (idx < c * 64) KB[idx] = kbv[i]; } }
    __syncthreads();
    {
        const int qi = tid & 255, par = tid >> 8;
        float qv[64];
#pragma unroll
        for (int c8 = 0; c8 < 8; ++c8) { const u32x4 v = *(const LAS u32x4*)(L + MG_QS + qi * 144 + c8 * 16);
#pragma unroll
            for (int e = 0; e < 4; ++e) { qv[c8 * 8 + 2 * e] = __uint_as_float(v[e] << 16); qv[c8 * 8 + 2 * e + 1] = __uint_as_float(v[e] & 0xffff0000u); } }
        float v1 = -INFINITY, v2 = -INFINITY, v3 = -INFINITY; int i1 = -1, i2 = -1, i3 = -1;
        for (int n = par; n < c; n += 2) { float g0 = 0.f, g1 = 0.f, g2 = 0.f, g3 = 0.f;
#pragma unroll
            for (int d4 = 0; d4 < 16; ++d4) { const f32x4 kb = *(const LAS f32x4*)(KB + n * 64 + d4 * 4); g0 += qv[4 * d4] * kb.x; g1 += qv[4 * d4 + 1] * kb.y; g2 += qv[4 * d4 + 2] * kb.z; g3 += qv[4 * d4 + 3] * kb.w; }
            const float g = (g0 + g1) + (g2 + g3);
            if (g > v1) { v3 = v2; i3 = i2; v2 = v1; i2 = i1; v1 = g; i1 = n; } else if (g > v2) { v3 = v2; i3 = i2; v2 = g; i2 = n; } else if (g > v3) { v3 = g; i3 = n; } }
        LAS float* TP = (LAS float*)(L + MG_TOP);
        if (par == 1) { TP[qi * 6 + 0] = v1; TP[qi * 6 + 1] = v2; TP[qi * 6 + 2] = v3; TP[qi * 6 + 3] = __int_as_float(i1); TP[qi * 6 + 4] = __int_as_float(i2); TP[qi * 6 + 5] = __int_as_float(i3); }
        __syncthreads();
        if (par == 0) {
#pragma unroll
            for (int k = 0; k < 3; ++k) { const float g = TP[qi * 6 + k]; const int n = __float_as_int(TP[qi * 6 + 3 + k]);
                if (n >= 0) { const bool b1 = g > v1 || (g == v1 && n < i1), b2 = g > v2 || (g == v2 && n < i2), b3 = g > v3 || (g == v3 && n < i3);
                    if (b1) { v3 = v2; i3 = i2; v2 = v1; i2 = i1; v1 = g; i1 = n; } else if (b2) { v3 = v2; i3 = i2; v2 = g; i2 = n; } else if (b3) { v3 = g; i3 = n; } } }
            const unsigned s4 = (unsigned)(i1 & 255) | ((unsigned)(i2 & 255) << 8) | ((unsigned)(i3 & 255) << 16) | 0xff000000u;
            SEL[qi] = s4; SELG[(size_t)(q0 + qi) * 4 + h] = s4;
        }
    }
    __syncthreads();
    for (int n = wave; n < c; n += 8) { int base = 0; unsigned char* lp = LISTG + ((size_t)(bh * 32 + c) * 32 + n) * 256;
#pragma unroll
        for (int ck = 0; ck < 4; ++ck) { const int q = ck * 64 + lane; const unsigned s4 = SEL[q]; const bool f = (s4 & 255u) == (unsigned)n || ((s4 >> 8) & 255u) == (unsigned)n || ((s4 >> 16) & 255u) == (unsigned)n;
            const unsigned long long bal = __ballot(f); const int pos = base + __popcll(bal & ((1ull << lane) - 1ull)); if (f) lp[pos] = (unsigned char)q; base += __popcll(bal); }
        if (lane == 0) CNTG[(bh * 32 + c) * 32 + n] = base; }
}
constexpr int KV_KL = 0, KV_VL = 36864, KV_PRE = KV_VL + 64 * 528;
DI void kv_tile(const LAS unsigned char* KL, const LAS unsigned char* VL, const bf16x8 (&qf)[2], int nsteps, bool causal, int qloc, int fr, int fq, f32x4 (&O)[4], float& m_out, float& l_out) {
    const float sc2 = 0.125f * 1.44269504089f;
    f32x4 s[16];
    const LAS unsigned char* kr0 = KL + (8 * (fr >> 2) + (fr & 3)) * 144 + fq * 16;
#pragma unroll
    for (int s8 = 0; s8 < 8; ++s8)
#pragma unroll
        for (int j = 0; j < 2; ++j) { f32x4 acc = (f32x4){0.f, 0.f, 0.f, 0.f};
#pragma unroll
            for (int ks = 0; ks < 2; ++ks) { const bf16x8 a = *(const LAS bf16x8*)(kr0 + (32 * s8 + 4 * j) * 144 + 64 * ks); acc = MFMA16(a, qf[ks], acc); }
            s[2 * s8 + j] = (s8 < nsteps) ? acc : (f32x4){-INFINITY, -INFINITY, -INFINITY, -INFINITY}; }
    if (causal) {
#pragma unroll
        for (int t = 0; t < 16; ++t)
#pragma unroll
            for (int r = 0; r < 4; ++r) { const int key = 32 * (t >> 1) + 8 * fq + 4 * (t & 1) + r; s[t][r] = key <= qloc ? s[t][r] : -INFINITY; } }
    float m = -INFINITY;
#pragma unroll
    for (int t = 0; t < 16; ++t) m = fmaxf(m, fmaxf(fmaxf(s[t][0], s[t][1]), fmaxf(s[t][2], s[t][3])));
    m = fmaxf(m, __shfl_xor(m, 16)); m = fmaxf(m, __shfl_xor(m, 32));
    const float mb = -m * sc2; float l = 0.f;
#pragma unroll
    for (int t = 0; t < 16; ++t)
#pragma unroll
        for (int r = 0; r < 4; ++r) { const float p = __builtin_amdgcn_exp2f(fmaf(s[t][r], sc2, mb)); s[t][r] = p; l += p; }
    l += __shfl_xor(l, 16); l += __shfl_xor(l, 32);
#pragma unroll
    for (int dt = 0; dt < 4; ++dt) O[dt] = (f32x4){0.f, 0.f, 0.f, 0.f};
    const LAS unsigned char* vr0 = VL + fr * 528 + fq * 16;
#pragma unroll
    for (int s8 = 0; s8 < 8; ++s8) {
        u32x4 pw; pw.x = cvt_pk_bf16(s[2 * s8][0], s[2 * s8][1]); pw.y = cvt_pk_bf16(s[2 * s8][2], s[2 * s8][3]); pw.z = cvt_pk_bf16(s[2 * s8 + 1][0], s[2 * s8 + 1][1]); pw.w = cvt_pk_bf16(s[2 * s8 + 1][2], s[2 * s8 + 1][3]);
        const bf16x8 pb = __builtin_bit_cast(bf16x8, pw);
#pragma unroll
        for (int dt = 0; dt < 4; ++dt) { const bf16x8 a = *(const LAS bf16x8*)(vr0 + (16 * dt) * 528 + 64 * s8); O[dt] = MFMA16(a, pb, O[dt]); } }
    m_out = m; l_out = l;
}
DI void kv_store(bf16_t* OPG, float* MLG, size_t row, int h, int slot, const f32x4 (&O)[4], float m, float l, int fq) {
    const float inv = 1.0f / l; const size_t base = ((row * 4 + h) * 4 + slot);
#pragma unroll
    for (int dt = 0; dt < 4; ++dt) { u32x2 w; w.x = cvt_pk_bf16(O[dt][0] * inv, O[dt][1] * inv); w.y = cvt_pk_bf16(O[dt][2] * inv, O[dt][3] * inv); *(u32x2*)(OPG + base * 64 + 16 * dt + 4 * fq) = w; }
    if (fq == 0) { MLG[base * 2] = m; MLG[base * 2 + 1] = l; }
}
DI void moba_kv_unit(const Frame& F, const bf16_t* Pb, const bf16_t* VT, const unsigned* SELG, const unsigned char* LISTG, const int* CNTG, bf16_t* OPG, float* MLG, int bl, int h, int n, int part, int nparts) {
    int lane_ = F.lane; LAUNDER_V(lane_);
    const int lane = lane_, wave = F.wave, tid = wave * 64 + lane, fr = lane & 15, fq = lane >> 4;
    LAS unsigned char* L = F.lds; LAS int* PRE = (LAS int*)(L + KV_PRE);
    const int bh = bl * 4 + h;
    const bf16_t* Kg = Pb + (size_t)(bl * SEQ + n * 256) * PLD + PC_MK + h * 64;
    const bf16_t* Vg = VT + (size_t)(bh * 64) * SEQ + n * 256;
    const bf16_t* Qg = Pb + (size_t)(bl * SEQ) * PLD + PC_MQ + h * 64;
    __syncthreads();
#pragma unroll
    for (int i = 0; i < 4; ++i) { const int q = tid + 512 * i, r = q >> 3, c8 = q & 7; *(LAS u32x4*)(L + KV_KL + r * 144 + c8 * 16) = *(const u32x4*)(Kg + (size_t)r * PLD + c8 * 8); }
#pragma unroll
    for (int i = 0; i < 4; ++i) { const int q = tid + 512 * i, d = q >> 5, c16 = q & 31; *(LAS u32x4*)(L + KV_VL + d * 528 + c16 * 16) = *(const u32x4*)(Vg + (size_t)d * SEQ + c16 * 8); }
    if (wave == 0) {
        const int cq = lane; int cnt = (cq > n && cq < 32) ? CNTG[(bh * 32 + cq) * 32 + n] : 0; int inc = cnt;
#pragma unroll
        for (int o = 1; o < 32; o <<= 1) { const int up = __shfl_up(inc, o); if (lane >= o) inc += up; }
        if (lane < 32) PRE[lane] = inc - cnt; if (lane == 31) PRE[32] = inc;
    }
    __syncthreads();
    const int T = PRE[32], nsp = (T + 15) >> 4, ntl = nsp + 16;
    for (int tt = part + nparts * wave; tt < ntl; tt += nparts * 8) {
        f32x4 O[4]; float m, l; bf16x8 qf[2];
        if (tt < nsp) {
            const int e = 16 * tt + fr; const bool valid = e < T; const int ee = valid ? e : 0;
            int cq = 0;
#pragma unroll
            for (int i = 1; i < 32; ++i) cq += (PRE[i] <= ee) ? 1 : 0;
            const int q = LISTG[((size_t)(bh * 32 + cq) * 32 + n) * 256 + (ee - PRE[cq])];
            const int tok = cq * 256 + q; const size_t row = (size_t)(bl * SEQ + tok);
#pragma unroll
            for (int ks = 0; ks < 2; ++ks) qf[ks] = *(const bf16x8*)(Qg + (size_t)tok * PLD + fq * 8 + 32 * ks);
            kv_tile(L + KV_KL, L + KV_VL, qf, 8, false, 0, fr, fq, O, m, l);
            const unsigned s4 = SELG[row * 4 + h]; const int slot = (s4 & 255u) == (unsigned)n ? 0 : (((s4 >> 8) & 255u) == (unsigned)n ? 1 : 2);
            if (valid) kv_store(OPG, MLG, row, h, slot, O, m, l, fq);
        } else {
            const int to = tt - nsp, qloc = 16 * to + fr, tok = n * 256 + qloc; const size_t row = (size_t)(bl * SEQ + tok);
#pragma unroll
            for (int ks = 0; ks < 2; ++ks) qf[ks] = *(const bf16x8*)(Qg + (size_t)tok * PLD + fq * 8 + 32 * ks);
            kv_tile(L + KV_KL, L + KV_VL, qf, (16 * to + 15) / 32 + 1, true, qloc, fr, fq, O, m, l);
            kv_store(OPG, MLG, row, h, 3, O, m, l, fq);
        }
    }
}
DI void moba_combine(const Frame& F, const unsigned* SELG, const bf16_t* OPG, const float* MLG, bf16_t* BR) {
    int lane_ = F.lane; LAUNDER_V(lane_);
    const int lane = lane_, sub = lane & 7, gw = F.blk * 8 + F.wave, NGW = F.G * 8;
    const float sc2 = 0.125f * 1.44269504089f;
    for (int it = gw; it < NG * 4 / 8; it += NGW) { const size_t idx = (size_t)it * 8 + (lane >> 3); const size_t row = idx >> 2; const int h = (int)(idx & 3);
        const unsigned s4 = SELG[idx]; float mk[4], lk[4]; float M = -INFINITY;
#pragma unroll
        for (int k = 0; k < 4; ++k) { const bool ok = (k == 3) || (((s4 >> (8 * k)) & 255u) != 255u); const f32x2 ml = *(const f32x2*)(MLG + (idx * 4 + k) * 2); mk[k] = ok ? ml.x : -INFINITY; lk[k] = ok ? ml.y : 0.f; M = fmaxf(M, mk[k]); }
        float o[8]; float den = 0.f;
#pragma unroll
        for (int e = 0; e < 8; ++e) o[e] = 0.f;
#pragma unroll
        for (int k = 0; k < 4; ++k) { const bool ok = (k == 3) || (((s4 >> (8 * k)) & 255u) != 255u); const float w = ok ? lk[k] * __builtin_amdgcn_exp2f((mk[k] - M) * sc2) : 0.f; den += w;
            u32x4 pv = *(const u32x4*)(OPG + (idx * 4 + k) * 64 + sub * 8);
            if (!ok) pv = (u32x4){0u, 0u, 0u, 0u};
#pragma unroll
            for (int e = 0; e < 4; ++e) { o[2 * e] += w * __uint_as_float(pv[e] << 16); o[2 * e + 1] += w * __uint_as_float(pv[e] & 0xffff0000u); } }
        const float inv = 1.0f / den; u32x4 wv;
#pragma unroll
        for (int e = 0; e < 4; ++e) wv[e] = cvt_pk_bf16(o[2 * e] * inv, o[2 * e + 1] * inv);
        *(u32x4*)(BR + row * 1024 + 256 + h * 64 + sub * 8) = wv; }
}
__host__ __device__ constexpr int kv_parts(int n) { return n == 0 ? 3 : (n < 8 ? 2 : 1); }
__host__ __device__ constexpr int kv_items_before(int n) { int s = 0; for (int i = 0; i < n; ++i) s += kv_parts(i) * GB * 4; return s; }
constexpr int KV_NITEMS = kv_items_before(32);

constexpr int XA_K = 0;
constexpr int XA_VT = 69632;
DI void xattn_wg(const Frame& F, const bf16_t* KVM, const bf16_t* QX, bf16_t* AO, int w) {
    int lane_ = F.lane; LAUNDER_V(lane_);
    const int lane = lane_, wave = F.wave, tid = wave * 64 + lane, fr = lane & 15, fq = lane >> 4;
    const int b = w >> 5, h = (w >> 3) & 3, qpart = w & 7;
    LAS unsigned char* L = F.lds;
    __syncthreads();
#pragma unroll
    for (int i = 0; i < 8; ++i) { const int q = tid + 512 * i, m = q >> 4, c16 = q & 15; *(LAS u32x4*)(L + XA_K + m * 272 + c16 * 16) = *(const u32x4*)(KVM + (size_t)(b * 256 + m) * 1024 + h * 128 + c16 * 8); }
#pragma unroll
    for (int i = 0; i < 8; ++i) { const int q = tid + 512 * i, m = q & 255, c16 = q >> 8; const u32x4 v = *(const u32x4*)(KVM + (size_t)(b * 256 + m) * 1024 + 512 + h * 128 + c16 * 8);
#pragma unroll
        for (int e = 0; e < 4; ++e) { *(LAS bf16_t*)(L + XA_VT + (c16 * 8 + 2 * e) * 528 + m * 2) = (bf16_t)(v[e] & 0xffffu); *(LAS bf16_t*)(L + XA_VT + (c16 * 8 + 2 * e + 1) * 528 + m * 2) = (bf16_t)(v[e] >> 16); } }
    __syncthreads();
    const float sc2 = 0.08838834764831845f * 1.44269504089f;
    for (int rtile = 0; rtile < 8; ++rtile) {
        const size_t tok = (size_t)b * SEQ + qpart * 1024 + wave * 128 + rtile * 16 + fr;
        bf16x8 qf[4];
#pragma unroll
        for (int ks = 0; ks < 4; ++ks) qf[ks] = *(const bf16x8*)(QX + tok * 512 + h * 128 + fq * 8 + 32 * ks);
        f32x4 s[16]; float mx = -INFINITY;
#pragma unroll
        for (int kt = 0; kt < 16; ++kt) { s[kt] = (f32x4){0.f, 0.f, 0.f, 0.f};
#pragma unroll
            for (int ks = 0; ks < 4; ++ks) { const bf16x8 a = *(const LAS bf16x8*)(L + XA_K + (16 * kt + fr) * 272 + (fq * 8 + 32 * ks) * 2); s[kt] = MFMA16(a, qf[ks], s[kt]); }
            mx = fmaxf(mx, fmaxf(fmaxf(s[kt][0], s[kt][1]), fmaxf(s[kt][2], s[kt][3]))); __builtin_amdgcn_sched_barrier(0); }
        mx = fmaxf(mx, __shfl_xor(mx, 16)); mx = fmaxf(mx, __shfl_xor(mx, 32));
        float l = 0.f;
#pragma unroll
        for (int kt = 0; kt < 16; ++kt)
#pragma unroll
            for (int r = 0; r < 4; ++r) { const float p = __builtin_amdgcn_exp2f((s[kt][r] - mx) * sc2); s[kt][r] = p; l += p; }
        l += __shfl_xor(l, 16); l += __shfl_xor(l, 32); const float inv = 1.0f / l;
        f32x4 O[8];
#pragma unroll
        for (int dt = 0; dt < 8; ++dt) O[dt] = (f32x4){0.f, 0.f, 0.f, 0.f};
#pragma unroll
        for (int s8 = 0; s8 < 8; ++s8) {
            u32x4 pw; pw.x = pk2(s[2 * s8][0], s[2 * s8][1]); pw.y = pk2(s[2 * s8][2], s[2 * s8][3]); pw.z = pk2(s[2 * s8 + 1][0], s[2 * s8 + 1][1]); pw.w = pk2(s[2 * s8 + 1][2], s[2 * s8 + 1][3]);
            const bf16x8 pb = __builtin_bit_cast(bf16x8, pw);
#pragma unroll
            for (int dt = 0; dt < 8; ++dt) {
                const u32x2 lo = *(const LAS u32x2*)(L + XA_VT + (16 * dt + fr) * 528 + (32 * s8 + 4 * fq) * 2), hi = *(const LAS u32x2*)(L + XA_VT + (16 * dt + fr) * 528 + (32 * s8 + 16 + 4 * fq) * 2);
                const u32x4 av = (u32x4){lo.x, lo.y, hi.x, hi.y};
                O[dt] = MFMA16(__builtin_bit_cast(bf16x8, av), pb, O[dt]); }
            __builtin_amdgcn_sched_barrier(0);
        }
#pragma unroll
        for (int dt = 0; dt < 8; ++dt) { u32x2 wv; wv.x = pk2(O[dt][0] * inv, O[dt][1] * inv); wv.y = pk2(O[dt][2] * inv, O[dt][3] * inv);
            *(u32x2*)(AO + tok * 512 + h * 128 + 16 * dt + 4 * fq) = wv; }
    }
    __syncthreads();
}
DI void moe_route1(const Frame& F, const bf16_t* x, const float* Wr, const float* ssqp, int* TE, float* TW, float* RR, int* CNT) {
    int lane_ = F.lane; LAUNDER_V(lane_);
    const int lane = lane_, wave = F.wave, tid = wave * 64 + lane;
    constexpr int WP = 2064;
    LAS float* LG = (LAS float*)(F.lds + 16 * WP) + wave * 16 * 17;
    LAS int* HC = (LAS int*)(F.lds + 16 * WP + 8 * 16 * 17 * 4);
    __syncthreads();
    { const int e = tid >> 6, k0 = (tid & 63) * 16; f32x4 w[4];
#pragma unroll
      for (int i = 0; i < 4; ++i) w[i] = *(const f32x4*)(Wr + (size_t)e * 1024 + k0 + 4 * i);
      unsigned hi[8], lo[8];
#pragma unroll
      for (int i = 0; i < 4; ++i)
#pragma unroll
          for (int j = 0; j < 2; ++j) { const float a = w[i][2 * j], b = w[i][2 * j + 1]; const unsigned ha = f2bf(a), hb = f2bf(b);
              hi[2 * i + j] = ha | (hb << 16); lo[2 * i + j] = pk2(a - __uint_as_float(ha << 16), b - __uint_as_float(hb << 16)); }
      *(LAS u32x4*)(F.lds + e * WP + k0 * 2) = (u32x4){hi[0], hi[1], hi[2], hi[3]}; *(LAS u32x4*)(F.lds + e * WP + k0 * 2 + 16) = (u32x4){hi[4], hi[5], hi[6], hi[7]};
      *(LAS u32x4*)(F.lds + (8 + e) * WP + k0 * 2) = (u32x4){lo[0], lo[1], lo[2], lo[3]}; *(LAS u32x4*)(F.lds + (8 + e) * WP + k0 * 2 + 16) = (u32x4){lo[4], lo[5], lo[6], lo[7]}; }
    for (int tb = F.blk; tb < NTOK / 256; tb += F.G) {
        if (tid < 8) HC[tid] = 0;
        __syncthreads();
        for (int tt = 0; tt < 2; ++tt) {
            const int row0 = tb * 256 + wave * 32 + tt * 16; f32x4 acc = (f32x4){0.f, 0.f, 0.f, 0.f};
            const bf16_t* ap = x + (size_t)(row0 + (lane & 15)) * 1024 + (lane >> 4) * 8; const LAS unsigned char* bp = F.lds + (lane & 15) * WP + (lane >> 4) * 16;
            bf16x8 a[32];
#pragma unroll
            for (int ks = 0; ks < 32; ++ks) a[ks] = *(const bf16x8*)(ap + 32 * ks);
            float rs[4];
#pragma unroll
            for (int i = 0; i < 4; ++i) rs[i] = row_rstd(ssqp, row0 + 4 * (lane >> 4) + i);
            __builtin_amdgcn_sched_barrier(0);
#pragma unroll
            for (int ks = 0; ks < 32; ++ks) { const bf16x8 b = *(const LAS bf16x8*)(bp + 64 * ks); acc = MFMA16(a[ks], b, acc); }
#pragma unroll
            for (int i = 0; i < 4; ++i) LG[(4 * (lane >> 4) + i) * 17 + (lane & 15)] = acc[i] * rs[i];
            LDS_WAIT();
            if (lane < 16) { const int row = row0 + lane; float lg[8];
#pragma unroll
                for (int e = 0; e < 8; ++e) lg[e] = LG[lane * 17 + e] + LG[lane * 17 + 8 + e];
                int e0 = 0; float l0 = lg[0];
#pragma unroll
                for (int e = 1; e < 8; ++e) if (lg[e] > l0) { l0 = lg[e]; e0 = e; }
                int e1 = -1; float l1 = -INFINITY;
#pragma unroll
                for (int e = 0; e < 8; ++e) if (e != e0 && lg[e] > l1) { l1 = lg[e]; e1 = e; }
                const float w0 = 1.0f / (1.0f + __expf(l1 - l0));
                TE[2 * (size_t)row] = e0; TE[2 * (size_t)row + 1] = e1; TW[2 * (size_t)row] = w0; TW[2 * (size_t)row + 1] = 1.0f - w0; RR[row] = row_rstd(ssqp, row);
                __hip_atomic_fetch_add(&HC[e0], 1, __ATOMIC_RELAXED, __HIP_MEMORY_SCOPE_WORKGROUP); __hip_atomic_fetch_add(&HC[e1], 1, __ATOMIC_RELAXED, __HIP_MEMORY_SCOPE_WORKGROUP); }
            LDS_WAIT();
        }
        __syncthreads();
        if (tid < 8) CNT[tb * 8 + tid] = HC[tid];
        __syncthreads();
    }
}
DI void moe_bases(const Frame& F, const int* CNT, int tb, LAS int* OUT  ) {
    const int tid = F.tid; LAS int* SC = (LAS int*)(F.lds + 40960);
    __syncthreads();
    { const int e = tid & 7, seg = tid >> 3; int all = 0, lt = 0;
#pragma unroll
      for (int q = 0; q < 4; ++q) { const int w = 4 * seg + q; const int c = CNT[w * 8 + e]; all += c; lt += (w < tb) ? c : 0; }
      SC[seg * 8 + e] = all; SC[512 + seg * 8 + e] = lt; }
    __syncthreads();
    if (tid < 8) { int all = 0, lt = 0; for (int s = 0; s < 64; ++s) { all += SC[s * 8 + tid]; lt += SC[512 + s * 8 + tid]; } SC[1024 + tid] = (all + 255) >> 8; OUT[16 + tid] = lt; }
    __syncthreads();
    if (tid == 0) { int b = 0; for (int e = 0; e < 8; ++e) { OUT[e] = b; b += SC[1024 + e]; } OUT[8] = b; }
    __syncthreads();
}
DI void moe_route2(const Frame& F, const int* TE, const float* RR, const int* CNT, const bf16_t* xb, int* POS, bf16_t* XP, float* RP) {
    const int tid = F.tid, lane = F.lane, wave = F.wave;
    LAS int* MB = (LAS int*)(F.lds + 49152);
    LAS int* WT = (LAS int*)(F.lds + 49152 + 256);
    LAS int* PL = (LAS int*)(F.lds + 49152 + 512);
    for (int tb = F.blk; tb < NTOK / 256; tb += F.G) {
        moe_bases(F, CNT, tb, MB);
        int e0 = -1, e1 = -1; const int tok = tb * 256 + tid;
        if (tid < 256) { e0 = TE[2 * (size_t)tok]; e1 = TE[2 * (size_t)tok + 1]; }
        int pw[2] = {0, 0};
#pragma unroll
        for (int e = 0; e < 8; ++e) { const bool f = (e0 == e) || (e1 == e); const unsigned long long bal = __ballot(f);
            const int before = __popcll(bal & ((1ull << lane) - 1ull)); if (lane == 0 && wave < 4) WT[wave * 8 + e] = __popcll(bal);
            if (e0 == e) pw[0] = before; if (e1 == e) pw[1] = before; }
        __syncthreads();
        if (tid < 256) {
#pragma unroll
            for (int sl = 0; sl < 2; ++sl) { const int e = sl ? e1 : e0; int rank = pw[sl]; for (int w2 = 0; w2 < wave; ++w2) rank += WT[w2 * 8 + e];
                const int pos = MB[e] * 256 + MB[16 + e] + rank; PL[2 * tid + sl] = pos; POS[2 * (size_t)tok + sl] = pos; RP[pos] = RR[tok]; } }
        __syncthreads();
        for (int pr0 = wave * 64; pr0 < wave * 64 + 64; pr0 += 8) { u32x4 ra[8], rb[8];
#pragma unroll
            for (int q = 0; q < 8; ++q) { const int t2 = (pr0 + q) >> 1; const u32x4* src = (const u32x4*)(xb + (size_t)(tb * 256 + t2) * 1024); ra[q] = src[lane]; rb[q] = src[lane + 64]; }
#pragma unroll
            for (int q = 0; q < 8; ++q) { const int pos = PL[pr0 + q]; u32x4* dst = (u32x4*)(XP + (size_t)pos * 1024); dst[lane] = ra[q]; dst[lane + 64] = rb[q]; } }
        __syncthreads();
    }
}
DI void moe_final(const Frame& F, const bf16_t* xb, float* out, const bf16_t* Y, const int* POS, const float* TW, const float* fg) {
    const int lane = F.lane, gw = F.blk * 8 + F.wave, NGW = F.G * 8;
    int pn0 = 0, pn1 = 0; float wn0 = 0.f, wn1 = 0.f;
    if (gw < NTOK) { pn0 = POS[2 * (size_t)gw]; pn1 = POS[2 * (size_t)gw + 1]; wn0 = TW[2 * (size_t)gw]; wn1 = TW[2 * (size_t)gw + 1]; }
    for (int row = gw; row < NTOK; row += NGW) {
        const int p0 = pn0, p1 = pn1; const float w0 = wn0, w1 = wn1;
        { const size_t rn = (size_t)(row + NGW < NTOK ? row + NGW : row); pn0 = POS[2 * rn]; pn1 = POS[2 * rn + 1]; wn0 = TW[2 * rn]; wn1 = TW[2 * rn + 1]; }
        f32x4* xr = (f32x4*)(out + (size_t)row * 1024) + lane; const u32x2* xs = (const u32x2*)(xb + (size_t)row * 1024) + lane; const u32x2* y0 = (const u32x2*)(Y + (size_t)p0 * 1024) + lane; const u32x2* y1 = (const u32x2*)(Y + (size_t)p1 * 1024) + lane;
        f32x4 v[4]; float ss = 0.f; u32x2 ya[4], yb[4];
#pragma unroll
        for (int j = 0; j < 4; ++j) { const u32x2 xv = xs[64 * j]; v[j] = (f32x4){__uint_as_float(xv.x << 16), __uint_as_float(xv.x & 0xffff0000u), __uint_as_float(xv.y << 16), __uint_as_float(xv.y & 0xffff0000u)}; ya[j] = y0[64 * j]; yb[j] = y1[64 * j]; }
#pragma unroll
        for (int j = 0; j < 4; ++j) { const u32x2 a = ya[j], b = yb[j];
            v[j].x += w0 * __uint_as_float(a.x << 16) + w1 * __uint_as_float(b.x << 16); v[j].y += w0 * __uint_as_float(a.x & 0xffff0000u) + w1 * __uint_as_float(b.x & 0xffff0000u);
            v[j].z += w0 * __uint_as_float(a.y << 16) + w1 * __uint_as_float(b.y << 16); v[j].w += w0 * __uint_as_float(a.y & 0xffff0000u) + w1 * __uint_as_float(b.y & 0xffff0000u);
            ss += (v[j].x * v[j].x + v[j].y * v[j].y) + (v[j].z * v[j].z + v[j].w * v[j].w); }
        ss = wave_sum(ss); const float r = rsqrtf(ss * (1.0f / 1024.0f) + RMS_EPS);
#pragma unroll
        for (int j = 0; j < 4; ++j) { const f32x4 g = ((const f32x4*)fg)[lane + 64 * j]; xr[64 * j] = (f32x4){v[j].x * r * g.x, v[j].y * r * g.y, v[j].z * r * g.z, v[j].w * r * g.w}; }
    }
}
constexpr int SCAN_CUT = 32;
__global__ void __launch_bounds__(512, 2) mk_fwd(Params prm) {
    extern __shared__ __attribute__((aligned(16))) unsigned char lds_raw[];
    Frame F0;
    F0.lds = (LAS unsigned char*)lds_raw;
    F0.tid = threadIdx.x; F0.lane = F0.tid & 63; F0.wave = __builtin_amdgcn_readfirstlane(F0.tid >> 6); F0.G = gridDim.x; F0.blk = blockIdx.x;
    F0.ws = prm.ws;
    volatile LAS unsigned* MISC = (volatile LAS unsigned*)(F0.lds + LDS_MISC);
    if (F0.tid < 64) MISC[F0.tid] = 0u;
    __syncthreads();
    XcdBarrier bar; bar.bar = (unsigned*)(prm.ws + WS_CTL); bar.x = 0; bar.st = MISC;
#if MK_SINGLE
    bar = xcd_barrier_post((unsigned*)(prm.ws + WS_CTL), MISC);
#endif
    const int lo = prm.ph_lo, hi = prm.ph_hi; int ph = 0;
#ifndef DBG_REP_CLASS
#define DBG_REP_CLASS 0
#endif
#ifndef DBG_RBA
#define DBG_RBA 1
#endif
#ifndef DBG_RCMB
#define DBG_RCMB 1
#endif
#ifndef DBG_ROUT
#define DBG_ROUT 1
#endif
#ifndef DBG_RFIN
#define DBG_RFIN 1
#endif
#define REPEAT(cls) for (int rep_ = 0; rep_ < ((DBG_REP_CLASS == (cls)) ? 2 : 1); ++rep_)
#define REPBAR(cls) do { if (DBG_REP_CLASS == (cls) && rep_ == 0) xcd_barrier(bar); } while (0)
#define ACTIVE() (ph >= lo && ph < hi)
#define SEAM() do { if (ph + 1 < hi) xcd_barrier(bar); } while (0)
    LAS unsigned char* glds = F0.lds;
#define PTRS() unsigned char* ws = prm.ws; asm volatile("" : "+s"(ws)); Frame F = F0; { int w_ = F0.wave; asm volatile("" : "+s"(w_)); int l_ = (int)__builtin_amdgcn_mbcnt_hi(~0u, __builtin_amdgcn_mbcnt_lo(~0u, 0u)); asm volatile("" : "+v"(l_)); F.wave = w_; F.lane = l_; F.tid = w_ * 64 + l_; } F.ws = ws; unsigned char* ar = ws + WS_ARENA; (void)ar; \
    bf16_t* xb = (bf16_t*)(ws + WS_XB); float* ssq = (float*)(ws + WS_SSQ); const float* rope = (const float*)(ws + WS_ROPE); float* xout = prm.out; (void)xb; (void)ssq; (void)rope; (void)xout; \
    unsigned char* lw = ws + WS_LW + (size_t)layer * LW_STRIDE; (void)lw; const float* sm = (const float*)(ws + WS_SMALL); (void)sm
#define GPTRS() PTRS(); const bf16_t* xbg = xb + (size_t)grp * NG * 1024; const float* ssqg = ssq + (size_t)grp * NG * 16; const float* ropeg = rope + (size_t)grp * NG * 16; \
    bf16_t* Pb = (bf16_t*)(ar + AR_P); float* BA = (float*)(ar + AR_BA); bf16_t* BR = (bf16_t*)(ar + AR_BR); float* KBAR = (float*)(ar + AR_KBAR); bf16_t* VT = (bf16_t*)(ar + AR_VT); \
    bf16_t* QD = (bf16_t*)(ar + AR_QD); bf16_t* MM = (bf16_t*)(ar + AR_KDT); bf16_t* NT = (bf16_t*)(ar + AR_NT); bf16_t* SG = (bf16_t*)(ar + AR_SG); bf16_t* ZB = (bf16_t*)(ar + AR_ZB); unsigned* SELG = (unsigned*)(ar + AR_SELG); int* CNTG = (int*)(ar + AR_CNTG); unsigned char* LISTG = (unsigned char*)(ar + AR_LISTG); bf16_t* OPG = (bf16_t*)(ar + AR_OPG); float* MLG = (float*)(ar + AR_MLG); bf16_t* WN = (bf16_t*)(ar + AR_WN); bf16_t* UT = (bf16_t*)(ar + AR_UT); bf16_t* AQK = (bf16_t*)(ar + AR_AQK); float* GL = (float*)(ar + AR_GL); \
    bf16_t* MG = (bf16_t*)(ar + AR_MERGED); \
    (void)xbg; (void)ssqg; (void)ropeg; (void)Pb; (void)BA; (void)BR; (void)KBAR; (void)VT; (void)QD; (void)MM; (void)NT; (void)SG; (void)ZB; (void)SELG; (void)CNTG; (void)LISTG; (void)OPG; (void)MLG; (void)WN; (void)UT; (void)AQK; (void)GL; (void)MG
#define MPTRS() PTRS(); int* TE = (int*)(ar + AR_TE); float* TW = (float*)(ar + AR_TW); float* RR = (float*)(ar + AR_RR); int* POS = (int*)(ar + AR_POS); int* CNT = (int*)(ar + AR_CNT); \
    bf16_t* XP = (bf16_t*)(ar + AR_XP); float* RP = (float*)(ar + AR_RP); bf16_t* HM = (bf16_t*)(ar + AR_HM); (void)TE; (void)TW; (void)RR; (void)POS; (void)CNT; (void)XP; (void)RP; (void)HM

    if (ACTIVE()) { REPEAT(1) { const int layer = 0; PTRS();
        const __attribute__((address_space(4))) Params* kp = (const __attribute__((address_space(4))) Params*)__builtin_amdgcn_kernarg_segment_ptr(); asm volatile("" : "+s"(kp));
        Params lp;
#pragma unroll
        for (int i = 0; i < 27; ++i) lp.in[i] = kp->in[i];
        lp.out = nullptr; lp.ws = ws; lp.ph_lo = 0; lp.ph_hi = 0; lp.pad0 = 0; lp.pad1 = 0;
        phase_prologue(F, lp); REPBAR(1); } SEAM(); } ++ph;
    for (int layer = 0; layer < 2; ++layer) {
        for (int grp = 0; grp < NGRP; ++grp) {
            if (ACTIVE()) { REPEAT(3) {
                GPTRS();
                pg8::Gemm g{xbg, (const bf16_t*)(lw + LW_WIN), 1024, 1024};
                pg8::SchedPlain S; S.init(NG, 3072, 1024, 1024, 1024, F.G, F.blk);
                pg8::build_rtab(glds, S, ssqg, nullptr, F.tid);
                pg8::EpiScaleBf16 E{Pb, PLD, ssqg, 0, ZB, 512, 10, (const LAS float*)(glds + pg8::RTAB_OFF)};
                pg8::gemm_phase(glds, g, S, E, F.wave);
                for (int rq_ = 0; rq_ < DBG_RBA; ++rq_) ba_tiles(F, xbg, (const bf16_t*)(lw + LW_WBA), ssqg, BA);
                REPBAR(3); }
                SEAM();
            } ++ph;
            if (ACTIVE()) {
                GPTRS();
                REPEAT(4) {
                __syncthreads();
                if (F.tid < 64) ((LAS unsigned*)(F.lds + DN_PCNT))[F.tid] = 0u;
                __syncthreads();
                { unsigned pgen = 0u;
#ifdef DBG_STAGGER
                if (F.wave >= 4) { for (int z_ = 0; z_ < DBG_STAGGER; ++z_) __builtin_amdgcn_s_sleep(127); }
#endif
                for (int u = F.blk; u < 1024; u += F.G)
                    prep_dn(F, Pb, BA, sm + SM_CONVW + (size_t)layer * 4 * 1536, sm + SM_ALOG + layer * 8, sm + SM_DTB + layer * 8, QD, MM, NT, WN, UT, AQK, GL, u, pgen); }
                __syncthreads();
#ifndef DBG_RPOOL
#define DBG_RPOOL 1
#endif
                for (int rpP = 0; rpP < DBG_RPOOL; ++rpP) for (int u = F.blk; u < NG / 64; u += F.G) prep_pool(F, Pb, BR, u);
                REPBAR(4); }
#ifndef DBG_RMOBA
#define DBG_RMOBA 1
#endif
                for (int rpM = 0; rpM < DBG_RMOBA; ++rpM) for (int u = F.blk; u < GB * 64; u += F.G) prep_moba(F, Pb, ropeg, KBAR, VT, u);
                SEAM();
            } ++ph;
            if (ACTIVE()) { REPEAT(18) {
                GPTRS();
                if (F.blk < GB * 8) { if (MK_SINGLE) dn_scan(F, F.blk, MM, NT, SG, 0, SCAN_CUT); }
                else { const int nw = F.G - GB * 8;
                    for (int u = F.blk - GB * 8; u < GB * 4 * 32; u += nw) { const int c = 31 - u / (GB * 4), bh = u % (GB * 4); moba_gate_unit(F, Pb, KBAR, SELG, LISTG, CNTG, bh >> 2, bh & 3, c); } }
                REPBAR(18); }
                SEAM();
            } ++ph;
            if (ACTIVE()) { REPEAT(5) {
                GPTRS();
                if (F.blk < GB * 8) { for (int r2_ = 0; r2_ < ((DBG_REP_CLASS == 16) ? 2 : 1); ++r2_) dn_scan(F, F.blk, MM, NT, SG, MK_SINGLE ? SCAN_CUT : 0, 127, r2_ == 0); }
                else { const int nw = F.G - GB * 8, wq = F.blk - GB * 8;
                    for (int r2_ = 0; r2_ < ((DBG_REP_CLASS == 17) ? 2 : 1); ++r2_)
                    for (int rd = 0; rd * nw < KV_NITEMS; ++rd) { const int i = rd * nw + ((rd & 1) ? nw - 1 - wq : wq); if (i >= KV_NITEMS) continue;
                        int n, part, bh;
                        if (i < 48) { n = 0; part = i >> 4; bh = i & 15; } else if (i < 272) { const int j = i - 48; n = 1 + (j >> 5); part = (j >> 4) & 1; bh = j & 15; } else { const int j = i - 272; n = 8 + (j >> 4); part = 0; bh = j & 15; }
                        moba_kv_unit(F, Pb, VT, SELG, LISTG, CNTG, OPG, MLG, bh >> 2, bh & 3, n, part, n == 0 ? 3 : (n < 8 ? 2 : 1)); } }
                if (layer == 0 && grp == 0) {
                    __syncthreads();
                    pg8::Gemm gk{(const bf16_t*)(ws + WS_MEMN), (const bf16_t*)(ws + WS_LW + LW_WKV), 1024, 1024};
                    pg8::SchedKV Sk; Sk.c = F.blk - GB * 8; Sk.lstride = LW_STRIDE;
                    pg8::EpiScaleBf16 Ek{(bf16_t*)(ws + WS_KVM), 1024, nullptr, 0, nullptr, 0, 1 << 30, nullptr};
                    pg8::gemm_phase(glds, gk, Sk, Ek, F.wave); }
                REPBAR(5); }
                SEAM();
            } ++ph;
            if (ACTIVE()) { REPEAT(6) {
                GPTRS();
                pg8::Gemm g{(const bf16_t*)(ws + WS_X8 + (size_t)grp * NG * 1024), (const bf16_t*)(ws + WS_WG8 + (size_t)layer * 3072 * 1024), 1024, 1024};
                pg8::SchedPlain S; S.init(NG, 3072, 1024, 1024, 1024, F.G, F.blk, 1);
                for (int rq_ = 0; rq_ < DBG_RCMB; ++rq_) moba_combine(F, SELG, OPG, MLG, BR);
                for (int rq_ = 0; rq_ < DBG_ROUT; ++rq_) dn_out_pass(F, QD, WN, UT, AQK, SG, ZB, sm + SM_DNG + layer * 64, BR);
                pg8::build_rtab(glds, S, ssqg, nullptr, F.tid);
                pg8::EpiScaleBf16 E{Pb, PLD, ssqg, 1, nullptr, 0, 1 << 30, (const LAS float*)(glds + pg8::RTAB_OFF)};
                pg8::gemm_phase<pg8::EpiScaleBf16, pg8::SchedPlain, true>(glds, g, S, E, F.wave);
                REPBAR(6); }
                SEAM();
            } ++ph;
            if (ACTIVE()) { REPEAT(7) {
                GPTRS();
                pg8::Gemm g{BR, (const bf16_t*)(lw + LW_WCAT), 1024, 1024};
                pg8::SchedPlain S; S.init(NG, 1024, 1024, 1024, 1024, F.G, F.blk);
                pg8::EpiMerge E{Pb, MG};
                pg8::gemm_phase(glds, g, S, E, F.wave);
                REPBAR(7); }
                SEAM();
            } ++ph;
            if (ACTIVE()) { for (int rep_ = 0; rep_ < ((DBG_REP_CLASS == 8 && layer == 0) ? 2 : 1); ++rep_) {
                GPTRS();
                pg8::Gemm g{MG, (const bf16_t*)(lw + LW_WOUT), 1024, 1024};
                pg8::SchedPlain S; S.init(NG, 1024, 1024, 1024, 1024, F.G, F.blk);
                pg8::EpiResid E{xb + (size_t)grp * NG * 1024, ssq + (size_t)grp * NG * 16, ws + WS_X8 + (size_t)grp * NG * 1024};
                pg8::gemm_phase(glds, g, S, E, F.wave);
                REPBAR(8); }
                SEAM();
            } ++ph;
        }
        if (ACTIVE()) { REPEAT(9) {
            PTRS();
            pg8::Gemm g{xb, (const bf16_t*)(lw + LW_WQ), 1024, 1024};
            pg8::SchedPlain S; S.init(NTOK, 512, 1024, 1024, 1024, F.G, F.blk);
            pg8::build_rtab(glds, S, ssq, nullptr, F.tid);
            pg8::EpiScaleBf16 E{(bf16_t*)(ar + AR_QX), 512, ssq, 0, nullptr, 0, 1 << 30, (const LAS float*)(glds + pg8::RTAB_OFF)};
            pg8::gemm_phase(glds, g, S, E, F.wave);
            REPBAR(9); }
                SEAM();
        } ++ph;
        if (ACTIVE()) { REPEAT(10) {
            PTRS();
            for (int w = F.blk; w < 256; w += F.G) xattn_wg(F, (const bf16_t*)(ws + WS_KVM) + (size_t)layer * 2048 * 1024, (const bf16_t*)(ar + AR_QX), (bf16_t*)(ar + AR_AO), w);
            REPBAR(10); }
                SEAM();
        } ++ph;
        if (ACTIVE()) {
            PTRS();
            pg8::Gemm g{(const bf16_t*)(ar + AR_AO), (const bf16_t*)(lw + LW_WO), 512, 512};
            pg8::SchedPlain S; S.init(NTOK, 1024, 512, 512, 512, F.G, F.blk);
            pg8::EpiResid E{xb, ssq, ws + WS_X8};
            pg8::gemm_phase(glds, g, S, E, F.wave);
            SEAM();
        } ++ph;
        if (layer == 0) {
            if (ACTIVE()) { REPEAT(11) {
                PTRS();
                pg8::Gemm g{xb, (const bf16_t*)(ws + WS_WGU), 1024, 1024};
                pg8::SchedPlain S; S.init(NTOK, 2 * FF, 1024, 1024, 1024, F.G, F.blk);
                pg8::build_rtab(glds, S, ssq, nullptr, F.tid);
                pg8::EpiSwiglu E{(bf16_t*)(ar + AR_HID), FF, (const LAS float*)(glds + pg8::RTAB_OFF)};
                pg8::gemm_phase(glds, g, S, E, F.wave);
                REPBAR(11); }
                SEAM();
            } ++ph;
            if (ACTIVE()) {
                PTRS();
                pg8::Gemm g{(const bf16_t*)(ar + AR_HID), (const bf16_t*)(ws + WS_WD), FF, FF};
                pg8::SchedPlain S; S.init(NTOK, 1024, FF, FF, FF, F.G, F.blk);
                pg8::EpiResid E{xb, ssq, ws + WS_X8};
                pg8::gemm_phase(glds, g, S, E, F.wave);
                SEAM();
            } ++ph;
        } else {
            if (ACTIVE()) { REPEAT(12) { MPTRS(); moe_route1(F, xb, (const float*)(ws + WS_WR), ssq, TE, TW, RR, CNT); REPBAR(12); } SEAM(); } ++ph;
            if (ACTIVE()) { REPEAT(13) { MPTRS(); moe_route2(F, TE, RR, CNT, xb, POS, XP, RP); REPBAR(13); } SEAM(); } ++ph;
            if (ACTIVE()) { REPEAT(14) {
                MPTRS();
                LAS int* MB = (LAS int*)(F.lds + 49152); moe_bases(F, CNT, 0, MB);
                pg8::SchedMoe S;
#pragma unroll
                for (int e = 0; e < 9; ++e) S.pbase[e] = __builtin_amdgcn_readfirstlane(MB[e]);
                S.nN = 2 * EFF / 256; S.nt = 16; S.G = F.G; S.c = F.blk; S.astep = (size_t)256 * 1024 * 2; S.bstep = (size_t)256 * 1024 * 2; S.estep = (size_t)2 * EFF * 1024 * 2;
                __syncthreads();
                pg8::Gemm g{XP, (const bf16_t*)(ws + WS_WMGU), 1024, 1024};
                pg8::build_rtab(glds, S, nullptr, RP, F.tid);
                pg8::EpiSwiglu E{HM, EFF, (const LAS float*)(glds + pg8::RTAB_OFF)};
                pg8::gemm_phase(glds, g, S, E, F.wave);
                REPBAR(14); }
                SEAM();
            } ++ph;
            if (ACTIVE()) { REPEAT(15) {
                MPTRS();
                LAS int* MB = (LAS int*)(F.lds + 49152); moe_bases(F, CNT, 0, MB);
                pg8::SchedMoe S;
#pragma unroll
                for (int e = 0; e < 9; ++e) S.pbase[e] = __builtin_amdgcn_readfirstlane(MB[e]);
                S.nN = 4; S.nt = EFF / 64; S.G = F.G; S.c = F.blk; S.astep = (size_t)256 * EFF * 2; S.bstep = (size_t)256 * EFF * 2; S.estep = (size_t)1024 * EFF * 2;
                __syncthreads();
                pg8::Gemm g{HM, (const bf16_t*)(ws + WS_WMD), EFF, EFF};
                pg8::EpiScaleBf16 E{XP, 1024, nullptr, 0, nullptr, 0, 1 << 30, nullptr};
                pg8::gemm_phase(glds, g, S, E, F.wave);
                REPBAR(15); }
                SEAM();
            } ++ph;
            if (ACTIVE()) { MPTRS(); for (int rq_ = 0; rq_ < DBG_RFIN; ++rq_) moe_final(F, xb, xout, XP, POS, TW, sm + SM_FING); SEAM(); } ++ph;
        }
    }
#undef ACTIVE
#undef REPEAT
#undef REPBAR
#undef SEAM
#undef PTRS
#undef GPTRS
#undef MPTRS
}

#ifdef DBG_DUMP_OFF
__global__ void dbg_dump(float* out, const unsigned char* ws) {
    const bf16_t* src = (const bf16_t*)(ws + (size_t)DBG_DUMP_OFF);
    for (size_t i = (size_t)blockIdx.x * blockDim.x + threadIdx.x; i < (size_t)NTOK * 1024; i += (size_t)gridDim.x * blockDim.x) { float v = i < (size_t)DBG_DUMP_N ? bf2f(src[i]) : 0.f; if (!(v == v) || v > 1e30f || v < -1e30f) v = 12345.0f; out[i] = v; }
}
#endif
extern "C" void kernel_launch(void* const* d_in, const int* in_sizes, int n_in, void* d_out, int out_size, void* d_ws, size_t ws_size, hipStream_t stream) {
    static int grid = 0;
    if (grid == 0) {
        if (n_in != 27 || in_sizes[0] != NTOK * DM || out_size != NTOK * DM || ws_size < WS_END) {
            fprintf(stderr, "kernel_launch: unexpected problem (n_in %d, in0 %d, out %d, ws %zu < %zu); nothing launched\n", n_in, n_in > 0 ? in_sizes[0] : -1, out_size, ws_size, (size_t)WS_END); grid = -1; return; }
        int dev = 0, cus = 0;
        if (hipGetDevice(&dev) != hipSuccess || hipDeviceGetAttribute(&cus, hipDeviceAttributeMultiprocessorCount, dev) != hipSuccess) { grid = -1; return; }
        if (hipFuncSetAttribute((const void*)mk_fwd, hipFuncAttributeMaxDynamicSharedMemorySize, LDS_BYTES) != hipSuccess) { fprintf(stderr, "kernel_launch: hipFuncSetAttribute failed\n"); grid = -1; return; }
        int per_cu = 0;
        if (hipOccupancyMaxActiveBlocksPerMultiprocessor(&per_cu, (const void*)mk_fwd, 512, LDS_BYTES) != hipSuccess || per_cu < 1) { fprintf(stderr, "kernel_launch: occupancy query says %d\n", per_cu); }
        (void)hipGetLastError();
        grid = cus > 256 ? 256 : cus;
    }
    if (grid < 0) return;
    (void)hipMemsetAsync((char*)d_ws + WS_CTL, 0, CTL_BYTES, stream);
    Params p{};
    for (int i = 0; i < 27; ++i) p.in[i] = (const float*)d_in[i];
    p.out = (float*)d_out; p.ws = (unsigned char*)d_ws; p.pad0 = 0; p.pad1 = 0;
#if MK_SINGLE
    p.ph_lo = 0; p.ph_hi = NPH;
    hipLaunchKernelGGL(mk_fwd, dim3(grid), dim3(512), LDS_BYTES, stream, p);
#else
#ifndef DBG_NPH
#define DBG_NPH NPH
#endif
    for (int k = 0; k < DBG_NPH; ++k) { p.ph_lo = k; p.ph_hi = k + 1; hipLaunchKernelGGL(mk_fwd, dim3(grid), dim3(512), LDS_BYTES, stream, p); }
#ifdef DBG_DUMP_OFF
    hipLaunchKernelGGL(dbg_dump, dim3(2048), dim3(256), 0, stream, (float*)d_out, (const unsigned char*)d_ws);
#endif
#endif
}
```

```cpp
#include <hip/hip_runtime.h>
#include <cstdio>
#include <cstdint>

#define LAS __attribute__((address_space(3)))
#define DI __device__ __forceinline__
typedef unsigned short bf16_t;
typedef short bf16x8 __attribute__((ext_vector_type(8)));
typedef short s16x4 __attribute__((ext_vector_type(4)));
typedef float f32x4 __attribute__((ext_vector_type(4)));
typedef float f32x2 __attribute__((ext_vector_type(2)));
typedef unsigned u32x4 __attribute__((ext_vector_type(4)));
typedef unsigned u32x2 __attribute__((ext_vector_type(2)));

#ifndef MK_SINGLE
#define MK_SINGLE 1
#endif

constexpr int NTOK = 65536, DM = 1024, SEQ = 8192, NBATCH = 8;
constexpr int NGRP = 2, NG = NTOK / NGRP, GB = NBATCH / NGRP;
constexpr int PLD = 3072;
constexpr int PC_POOL = 0, PC_MQ = 256, PC_MK = 512, PC_MV = 768, PC_DQ = 1024, PC_DK = 1536, PC_DV = 2048, PC_Z = 2560;
constexpr int IN_COLS = 6160;
constexpr int FF = 2816, EFF = 1408, NEXP = 8;
constexpr int MEMLEN = 256;
constexpr float RMS_EPS = 1e-6f;
constexpr int NPH = 1 + 2 * (NGRP * 7 + 3) + 2 + 5;

constexpr size_t MiB = 1u << 20;
constexpr size_t WS_CTL = 0, CTL_BYTES = 1 * MiB;
constexpr size_t LW_WIN = 0, LW_WCAT = LW_WIN + (size_t)6144 * 1024 * 2, LW_WOUT = LW_WCAT + (size_t)1024 * 1024 * 2, LW_WQ = LW_WOUT + (size_t)1024 * 1024 * 2,
                 LW_WKV = LW_WQ + (size_t)512 * 1024 * 2, LW_WO = LW_WKV + (size_t)1024 * 1024 * 2, LW_WBA = LW_WO + (size_t)1024 * 512 * 2, LW_STRIDE = LW_WBA + (size_t)16 * 1024 * 2;
constexpr size_t WS_LW = WS_CTL + CTL_BYTES;
constexpr size_t WS_WGU = WS_LW + 2 * LW_STRIDE;
constexpr size_t WS_WD = WS_WGU + (size_t)2 * FF * 1024 * 2;
constexpr size_t WS_WMGU = WS_WD + (size_t)1024 * FF * 2;
constexpr size_t WS_WMD = WS_WMGU + (size_t)NEXP * 2 * EFF * 1024 * 2;
constexpr size_t WS_WR = WS_WMD + (size_t)NEXP * 1024 * EFF * 2;
constexpr size_t WS_XB = (WS_WR + 8 * 1024 * 4 + MiB - 1) / MiB * MiB;
constexpr size_t WS_SSQ = WS_XB + (size_t)NTOK * 1024 * 2;
constexpr size_t WS_ROPE = WS_SSQ + (size_t)NTOK * 16 * 4;
constexpr size_t WS_MEMN = WS_ROPE + (size_t)NTOK * 16 * 4;
constexpr size_t WS_KVM = WS_MEMN + (size_t)2 * 2048 * 1024 * 2;
constexpr size_t WS_SMALL = WS_KVM + (size_t)2 * 2048 * 1024 * 2;
constexpr int SM_CONVW = 0, SM_ALOG = SM_CONVW + 2 * 4 * 1536, SM_DTB = SM_ALOG + 16, SM_DNG = SM_DTB + 16, SM_FING = SM_DNG + 128, SM_END = SM_FING + 1024;
constexpr size_t WS_X8 = WS_SMALL + 65536;
constexpr size_t WS_WG8 = WS_X8 + (size_t)NTOK * 1024;
constexpr size_t WS_ARENA = WS_WG8 + (size_t)2 * 3072 * 1024;
constexpr size_t AR_P = 0;
constexpr size_t AR_BA = AR_P + (size_t)NG * PLD * 2;
constexpr size_t AR_BR = AR_BA + (size_t)NG * 16 * 4;
constexpr size_t AR_KBAR = AR_BR + (size_t)NG * 1024 * 2;
constexpr size_t AR_VT = AR_KBAR + (size_t)GB * 4 * 32 * 64 * 4;
constexpr int NCH = GB * 128 * 8;
constexpr size_t AR_QD = AR_VT + (size_t)GB * 4 * 64 * SEQ * 2;
constexpr size_t AR_KDT = AR_QD + (size_t)NCH * 8192;
constexpr size_t AR_WN = AR_KDT + (size_t)NCH * 8192;
constexpr size_t AR_UT = AR_WN + (size_t)NCH * 8192;
constexpr size_t AR_AQK = AR_UT + (size_t)NCH * 8192;
constexpr size_t AR_NT = AR_AQK + (size_t)NCH * 8192;
constexpr size_t AR_SG = AR_NT + (size_t)NCH * 8192;
constexpr size_t AR_ZB = AR_SG + (size_t)NCH * 8192;
constexpr size_t AR_GL = AR_ZB + (size_t)NG * 512 * 2;
constexpr size_t AR_SELG = AR_GL + (size_t)NCH * 4 + 65536 - ((size_t)NCH * 4) % 65536;
constexpr size_t AR_CNTG = AR_SELG + (size_t)NG * 4 * 4;
constexpr size_t AR_LISTG = AR_CNTG + (size_t)GB * 4 * 32 * 32 * 4;
constexpr size_t AR_OPG = AR_LISTG + (size_t)GB * 4 * 32 * 32 * 256;
constexpr size_t AR_MLG = AR_OPG + (size_t)NG * 4 * 4 * 64 * 2;
constexpr size_t AR_MERGED = AR_MLG + (size_t)NG * 4 * 4 * 2 * 4;
constexpr size_t AR_MIX_END = AR_MERGED + (size_t)NG * 1024 * 2;
constexpr size_t AR_QX = 0, AR_AO = AR_QX + (size_t)NTOK * 512 * 2, AR_XA_END = AR_AO + (size_t)NTOK * 512 * 2;
constexpr size_t AR_HID = 0, AR_HID_END = (size_t)NTOK * FF * 2;
constexpr int MOE_ROWS = 2 * NTOK + 2048;
constexpr size_t AR_TE = 0, AR_TW = AR_TE + (size_t)NTOK * 8, AR_RR = AR_TW + (size_t)NTOK * 8, AR_POS = AR_RR + (size_t)NTOK * 4, AR_CNT = AR_POS + (size_t)NTOK * 8,
                 AR_XP = AR_CNT + 65536, AR_RP = AR_XP + (size_t)MOE_ROWS * 1024 * 2, AR_HM = AR_RP + (size_t)MOE_ROWS * 4 + 65536 - ((size_t)MOE_ROWS * 4) % 65536,
                 AR_MOE_END = AR_HM + (size_t)MOE_ROWS * EFF * 2;
constexpr size_t cmax(size_t a, size_t b) { return a > b ? a : b; }
constexpr size_t WS_END = WS_ARENA + cmax(cmax(AR_MIX_END, AR_XA_END), cmax(AR_HID_END, AR_MOE_END));
static_assert(AR_XA_END <= AR_MERGED, "xattn buffers must not overlap MERGED");
static_assert(SM_END * 4 <= 65536, "small-vector block");
static_assert(WS_END <= (size_t)1073741824, "workspace map exceeds 1 GiB");

constexpr int LDS_BYTES = 160 * 1024;
constexpr int LDS_MISC = 158 * 1024;

DI float bf2f(unsigned short b) { return __uint_as_float(((unsigned)b) << 16); }
typedef __bf16 bf16v2_t __attribute__((ext_vector_type(2)));
DI unsigned cvt_pk_bf16(float lo, float hi) { bf16v2_t v; v.x = (__bf16)lo; v.y = (__bf16)hi; return __builtin_bit_cast(unsigned, v); }
DI unsigned f2bf(float f) { return (unsigned)__builtin_bit_cast(unsigned short, (__bf16)f); }
DI unsigned pk2(float lo, float hi) { return cvt_pk_bf16(lo, hi); }
DI unsigned cvt4_fp8(float a, float b, float c, float d) { unsigned w = 0u; w = __builtin_amdgcn_cvt_pk_fp8_f32(a, b, w, false); w = __builtin_amdgcn_cvt_pk_fp8_f32(c, d, w, true); return w; }
DI float wave_sum(float v) {
#pragma unroll
    for (int o = 1; o < 64; o <<= 1) v += __shfl_xor(v, o);
    return v;
}
DI float fsigmoid(float x) { return __builtin_amdgcn_rcpf(1.0f + __builtin_amdgcn_exp2f(-1.44269504089f * x)); }
DI float row_rstd(const float* ssqp, int row) {
    const f32x4* p = (const f32x4*)(ssqp + (size_t)row * 16);
    const f32x4 a = p[0], b = p[1], c = p[2], d = p[3];
    const float s = (((a.x + a.y) + (a.z + a.w)) + ((b.x + b.y) + (b.z + b.w))) + (((c.x + c.y) + (c.z + c.w)) + ((d.x + d.y) + (d.z + d.w)));
    return rsqrtf(s * (1.0f / 1024.0f) + RMS_EPS);
}
#define LAUNDER_V(x) asm volatile("" : "+v"(x))
#define LDS_WAIT() asm volatile("s_waitcnt lgkmcnt(0)" ::: "memory")
#define VM_WAIT() asm volatile("s_waitcnt vmcnt(0)" ::: "memory")
#define WG_BAR() do { asm volatile("s_waitcnt lgkmcnt(0)" ::: "memory"); __builtin_amdgcn_s_barrier(); asm volatile("" ::: "memory"); } while (0)
#define MFMA16(a, b, c) __builtin_amdgcn_mfma_f32_16x16x32_bf16((a), (b), (c), 0, 0, 0)

#define XB_TMO      128
#define XB_XCNT(j)  (256  + 64 * (j))
#define XB_XSUB(j)  (1280 + 64 * (j))
#define XB_XGEN(j)  (2304 + 64 * (j))
#define XB_TOP      3328
#define XB_TOPGEN   3392
#define XCD_BAR_WORDS 3456
#define XB_SPIN_CAP (1u << 22)

DI unsigned xb_ld(unsigned* p)              { return __hip_atomic_load(p, __ATOMIC_RELAXED, __HIP_MEMORY_SCOPE_AGENT); }
DI unsigned xb_add(unsigned* p, unsigned v) { return __hip_atomic_fetch_add(p, v, __ATOMIC_RELAXED, __HIP_MEMORY_SCOPE_AGENT); }
DI unsigned xb_xcc_id() { return (unsigned)__builtin_amdgcn_s_getreg((3 << 11) | 20) & 0xFu; }
#define XB_SPIN(cond, bar) do { unsigned _sp = 0; while (cond) { __builtin_amdgcn_s_sleep(1); \
    if ((++_sp & 255u) == 0u) { if (xb_ld(&(bar)[XB_TMO])) break; if (_sp > XB_SPIN_CAP) { atomicAdd(&(bar)[XB_TMO], 1u); break; } } } } while (0)

struct XcdBarrier { unsigned* bar; unsigned x; volatile LAS unsigned* st; };

DI XcdBarrier xcd_barrier_post(unsigned* bar, volatile LAS unsigned* st) {
    XcdBarrier b; b.bar = bar; b.x = xb_xcc_id(); b.st = st;
    if (threadIdx.x == 0) (void)xb_add(&bar[XB_XCNT(b.x)], 1u);
    return b;
}
DI void xcd_barrier_complete(unsigned* bar, unsigned x, unsigned& nloc, unsigned& nx) {
    const unsigned G = gridDim.x * gridDim.y * gridDim.z;
    unsigned sum, cnt, mine, sp = 0u;
    for (;;) {
        sum = 0u; cnt = 0u; mine = 0u;
#pragma unroll
        for (unsigned j = 0; j < 16; ++j) { const unsigned c = xb_ld(&bar[XB_XCNT(j)]); sum += c; cnt += (c > 0u) ? 1u : 0u; mine = (j == x) ? c : mine; }
        if (sum == G) break;
        __builtin_amdgcn_s_sleep(1);
        if ((++sp & 255u) == 0u) { if (xb_ld(&bar[XB_TMO])) break; if (sp > XB_SPIN_CAP) { atomicAdd(&bar[XB_TMO], 1u); break; } }
    }
    nloc = mine > 0u ? mine : 1u; nx = cnt > 0u ? cnt : 1u;
}
DI void xcd_barrier(const XcdBarrier& b) {
    asm volatile("s_waitcnt vmcnt(0)" ::: "memory");
    __syncthreads();
    if (threadIdx.x == 0) {
        unsigned* bar = b.bar;
        __builtin_amdgcn_s_waitcnt(0);
        unsigned nloc = b.st[0], nx = b.st[1];
        if (nloc == 0u) { xcd_barrier_complete(bar, b.x, nloc, nx); b.st[0] = nloc; b.st[1] = nx; }
        const unsigned old = xb_add(&bar[XB_XSUB(b.x)], 1u);
        const unsigned gen = old / nloc;
        if (old + 1u == (gen + 1u) * nloc) {
            __builtin_amdgcn_fence(__ATOMIC_RELEASE, "agent");
            asm volatile("s_waitcnt vmcnt(0)" ::: "memory");
            const unsigned og = xb_add(&bar[XB_TOP], 1u);
            const unsigned tg = og / nx;
            if (og + 1u == (tg + 1u) * nx) xb_add(&bar[XB_TOPGEN], 1u);
            else XB_SPIN(xb_ld(&bar[XB_TOPGEN]) == tg, bar);
            __builtin_amdgcn_fence(__ATOMIC_ACQUIRE, "agent");
            xb_add(&bar[XB_XGEN(b.x)], 1u);
            asm volatile("s_waitcnt vmcnt(0)" ::: "memory");
        } else {
            XB_SPIN(xb_ld(&bar[XB_XGEN(b.x)]) == gen, bar);
            __builtin_amdgcn_fence(__ATOMIC_ACQUIRE, "agent");
            asm volatile("s_waitcnt vmcnt(0)" ::: "memory");
        }
    }
    __syncthreads();
}
namespace pg8 {
constexpr int BM = 256, BK = 64, HALF = 128, HTB = HALF * BK * 2, STAGE_BYTES = 8 * HTB, NXCD = 8, WGM = 8;
__host__ __device__ __forceinline__ int lds_byte(int r, int c) { const int st = (r >> 4) * 2 + (c >> 5), rr = r & 15, cc = c & 31, ob = rr * 64 + cc * 2; return st * 1024 + (ob ^ (((ob >> 9) & 1) << 5)); }
__host__ __device__ __forceinline__ void stage_rc(int b, int& R, int& C) { const int st = b / 1024, sb = b % 1024, swz = sb ^ (((sb >> 9) & 1) << 5); R = (st >> 1) * 16 + swz / 64; C = (st & 1) * 32 + (swz % 64) / 2; }
__host__ __device__ __forceinline__ int perm32(int rho) { const int n = rho >> 4, i = rho & 15; return 8 * (i >> 2) + 4 * n + (i & 3); }

struct Unit { int pm, pn, nt, tag, ord; size_t aoff, boff; };
struct Gemm { const bf16_t* A; const bf16_t* Bt; int lda, ldb; };

struct TileOrder {
    int nM, nN, nwg, G, c;
    DI void init(int nM_, int nN_, int G_, int c_) { nM = nM_; nN = nN_; nwg = nM * nN; G = G_; c = c_; }
    DI bool tile(int i, int& pm, int& pn) const {
        const long L = (long)i * G + c; if (L >= nwg) return false;
        int wgid = (int)L; { const int q = nwg / NXCD, r = nwg % NXCD, xcd = wgid % NXCD, off = wgid / NXCD; wgid = (xcd < r ? xcd * (q + 1) : r * (q + 1) + (xcd - r) * q) + off; }
        const int nig = WGM * nN, gid = wgid / nig, fm = gid * WGM, gsz = (nM - fm) < WGM ? (nM - fm) : WGM;
        pm = fm + ((wgid % nig) % gsz); pn = (wgid % nig) / gsz; return true;
    }
};
struct SchedPlain {
    TileOrder T; int nt; size_t astep, bstep;
    DI void init(int M, int N, int K, int lda, int ldb, int G, int c, int esz = 2) { T.init(M / BM, N / BM, G, c); nt = K * esz / (BK * 2); astep = (size_t)BM * lda * esz; bstep = (size_t)BM * ldb * esz; }
    DI bool next(int i, Unit& u) const { if (!T.tile(i, u.pm, u.pn)) return false; u.nt = nt; u.tag = 0; u.ord = i; u.aoff = (size_t)u.pm * astep; u.boff = (size_t)u.pn * bstep; return true; }
};
struct SchedMerge {
    TileOrder T; size_t astep, bstep;
    DI void init(int M, int N, int lda, int ldb, int G, int c) { T.init(M / BM, N / BM, G, c); astep = (size_t)BM * lda * 2; bstep = (size_t)BM * ldb * 2; }
    DI bool next(int i, Unit& u) const {
        const int ti = i / 3, br = i - 3 * ti; if (!T.tile(ti, u.pm, u.pn)) return false;
        const int kofs = br == 0 ? 0 : (br == 1 ? 256 : 512);
        u.nt = br == 2 ? 8 : 4; u.tag = br; u.aoff = (size_t)u.pm * astep + (size_t)kofs * 2; u.boff = (size_t)u.pn * bstep + (size_t)kofs * 2; return true;
    }
};
struct SchedKV {
    int c; size_t lstride;
    DI bool next(int i, Unit& u) const {
        if (i != 0 || c < 0 || c >= 64) return false;
        const int layer = c >> 5, r = c & 31; u.pm = layer * 8 + (r >> 2); u.pn = r & 3; u.nt = 16; u.tag = 0; u.ord = 0;
        u.aoff = (size_t)u.pm * BM * 1024 * 2; u.boff = (size_t)layer * lstride + (size_t)u.pn * BM * 1024 * 2; return true;
    }
};
struct SchedMoe {
    int pbase[9]; int nN, nt, G, c; size_t astep, bstep, estep;
    DI bool next(int i, Unit& u) const {
        const long L = (long)i * G + c; const int nM = pbase[8], nwg = nM * nN; if (L >= nwg) return false;
        int wgid = (int)L; { const int q = nwg / NXCD, r = nwg % NXCD, xcd = wgid % NXCD, off = wgid / NXCD; wgid = (xcd < r ? xcd * (q + 1) : r * (q + 1) + (xcd - r) * q) + off; }
        const int nig = WGM * nN, gid = wgid / nig, fm = gid * WGM, gsz = (nM - fm) < WGM ? (nM - fm) : WGM;
        const int gp = fm + ((wgid % nig) % gsz), pn = (wgid % nig) / gsz;
        int e = 0;
#pragma unroll
        for (int j = 1; j < 8; ++j) e += (gp >= pbase[j]) ? 1 : 0;
        u.pm = gp; u.pn = pn; u.nt = nt; u.tag = e; u.ord = i; u.aoff = (size_t)gp * astep; u.boff = (size_t)e * estep + (size_t)pn * bstep; return true;
    }
};

constexpr int RTAB_OFF = STAGE_BYTES, RTAB_MAX_UNITS = 26;
template <class Sched> DI void build_rtab(LAS unsigned char* lds, const Sched& S, const float* ssqp, const float* rvec, int tid) {
    LAS float* rt = (LAS float*)(lds + RTAB_OFF); Unit u;
    for (int i = tid >> 8; S.next(i, u); i += 2) { if (i >= RTAB_MAX_UNITS) break; const int r = tid & 255, row = u.pm * BM + r; rt[i * 256 + r] = rvec ? rvec[row] : row_rstd(ssqp, row); }
    __syncthreads();
}
struct EpiScaleBf16 { static constexpr bool MID = false;
    bf16_t* O; int ldo; const float* ssqp; int act; bf16_t* O2; int ldo2, pn2; const LAS float* rtab;
    DI void operator()(const f32x4 (&acc)[2][2][4][2], const Unit& u, int wr, int wc, int fr, int fq) const {
        const bool alt = u.pn >= pn2; bf16_t* const Ob = alt ? O2 : O; const int ld = alt ? ldo2 : ldo;
        const int row0 = u.pm * BM + wr * 64 + fr, col0 = (alt ? u.pn - pn2 : u.pn) * BM + wc * 32 + 8 * fq;
#pragma unroll
        for (int ai = 0; ai < 2; ++ai)
#pragma unroll
            for (int m = 0; m < 4; ++m) { const int row = row0 + ai * HALF + m * 16; const float r = ssqp ? rtab[u.ord * 256 + (row & 255)] : 1.0f; bf16_t* rowp = Ob + (size_t)row * ld + col0;
#pragma unroll
                for (int bj = 0; bj < 2; ++bj) { f32x4 v0 = acc[ai][bj][m][0] * r, v1 = acc[ai][bj][m][1] * r;
                    if (act) {
#pragma unroll
                        for (int j = 0; j < 4; ++j) { v0[j] = fsigmoid(v0[j]); v1[j] = fsigmoid(v1[j]); } }
                    u32x4 w; w.x = cvt_pk_bf16(v0[0], v0[1]); w.y = cvt_pk_bf16(v0[2], v0[3]); w.z = cvt_pk_bf16(v1[0], v1[1]); w.w = cvt_pk_bf16(v1[2], v1[3]);
                    *(u32x4*)(rowp + bj * HALF) = w; } }
    }
};
struct EpiResid { static constexpr bool MID = false;
    bf16_t* xb; float* ssqp; unsigned char* x8;
    DI void operator()(const f32x4 (&acc)[2][2][4][2], const Unit& u, int wr, int wc, int fr, int fq) const {
        const int row0 = u.pm * BM + wr * 64 + fr, col0 = u.pn * BM + wc * 32 + 8 * fq;
#pragma unroll
        for (int ai = 0; ai < 2; ++ai)
#pragma unroll
            for (int m = 0; m < 4; ++m) { const int row = row0 + ai * HALF + m * 16; const size_t off = (size_t)row * 1024 + col0; float ss = 0.f;
#pragma unroll
                for (int bj = 0; bj < 2; ++bj) {
                    const u32x4 xo = *(const u32x4*)(xb + off + bj * HALF);
                    f32x4 x0 = (f32x4){__uint_as_float(xo.x << 16), __uint_as_float(xo.x & 0xffff0000u), __uint_as_float(xo.y << 16), __uint_as_float(xo.y & 0xffff0000u)};
                    f32x4 x1 = (f32x4){__uint_as_float(xo.z << 16), __uint_as_float(xo.z & 0xffff0000u), __uint_as_float(xo.w << 16), __uint_as_float(xo.w & 0xffff0000u)};
                    x0 += acc[ai][bj][m][0]; x1 += acc[ai][bj][m][1];
                    u32x4 w; w.x = cvt_pk_bf16(x0[0], x0[1]); w.y = cvt_pk_bf16(x0[2], x0[3]); w.z = cvt_pk_bf16(x1[0], x1[1]); w.w = cvt_pk_bf16(x1[2], x1[3]);
                    *(u32x4*)(xb + off + bj * HALF) = w;
                    { u32x2 w8; w8.x = cvt4_fp8(x0[0], x0[1], x0[2], x0[3]); w8.y = cvt4_fp8(x1[0], x1[1], x1[2], x1[3]); *(u32x2*)(x8 + off + bj * HALF) = w8; }
                    ss += (x0[0] * x0[0] + x0[1] * x0[1]) + (x0[2] * x0[2] + x0[3] * x0[3]) + (x1[0] * x1[0] + x1[1] * x1[1]) + (x1[2] * x1[2] + x1[3] * x1[3]); }
                ss += __shfl_xor(ss, 16); ss += __shfl_xor(ss, 32);
                if (fq == 0) ssqp[(size_t)row * 16 + u.pn * 4 + wc] = ss; }
    }
};
struct EpiSwiglu { static constexpr bool MID = false;
    bf16_t* H; int ldh; const LAS float* rtab;
    DI void operator()(const f32x4 (&acc)[2][2][4][2], const Unit& u, int wr, int wc, int fr, int fq) const {
        const int row0 = u.pm * BM + wr * 64 + fr, col0 = u.pn * HALF + wc * 32 + 8 * fq;
#pragma unroll
        for (int ai = 0; ai < 2; ++ai)
#pragma unroll
            for (int m = 0; m < 4; ++m) { const int row = row0 + ai * HALF + m * 16; const float r = rtab[u.ord * 256 + (row & 255)];
                f32x4 h0, h1;
#pragma unroll
                for (int j = 0; j < 4; ++j) { const float g0 = acc[ai][0][m][0][j] * r, g1 = acc[ai][0][m][1][j] * r;
                    h0[j] = g0 * fsigmoid(g0) * (acc[ai][1][m][0][j] * r); h1[j] = g1 * fsigmoid(g1) * (acc[ai][1][m][1][j] * r); }
                u32x4 w; w.x = cvt_pk_bf16(h0[0], h0[1]); w.y = cvt_pk_bf16(h0[2], h0[3]); w.z = cvt_pk_bf16(h1[0], h1[1]); w.w = cvt_pk_bf16(h1[2], h1[3]);
                *(u32x4*)(H + (size_t)row * ldh + col0) = w; }
    }
};
struct EpiMerge { static constexpr bool MID = true;
    const bf16_t* gates; bf16_t* merged;
    static DI float gclamp(unsigned hi_bits) { return fmaxf(__uint_as_float(hi_bits), 1e-30f); }
    DI void mid(f32x4 (&acc)[2][2][4][2], const Unit& u, int seg, int wr, int wc, int fr, int fq) const {
        int row0 = u.pm * BM + wr * 64 + fr, col0 = u.pn * BM + wc * 32 + 8 * fq; LAUNDER_V(row0); LAUNDER_V(col0);
#pragma unroll
        for (int ai = 0; ai < 2; ++ai)
#pragma unroll
            for (int mp = 0; mp < 2; ++mp) {
                u32x4 ga[2][2], gb[2][2];
#pragma unroll
                for (int mm = 0; mm < 2; ++mm)
#pragma unroll
                    for (int bj = 0; bj < 2; ++bj) { const bf16_t* gp = gates + (size_t)(row0 + ai * HALF + (2 * mp + mm) * 16) * PLD + seg * 1024 + col0 + bj * HALF; ga[mm][bj] = *(const u32x4*)gp; gb[mm][bj] = *(const u32x4*)(gp + 1024); }
                __builtin_amdgcn_sched_barrier(0);
#pragma unroll
                for (int mm = 0; mm < 2; ++mm)
#pragma unroll
                    for (int bj = 0; bj < 2; ++bj) {
#pragma unroll
                        for (int j = 0; j < 4; ++j) { const int m = 2 * mp + mm;
                            const float r_lo = gclamp(ga[mm][bj][j] << 16) * __builtin_amdgcn_rcpf(gclamp(gb[mm][bj][j] << 16)), r_hi = gclamp(ga[mm][bj][j] & 0xffff0000u) * __builtin_amdgcn_rcpf(gclamp(gb[mm][bj][j] & 0xffff0000u));
                            acc[ai][bj][m][j >> 1][(2 * j) & 3] *= r_lo; acc[ai][bj][m][j >> 1][(2 * j + 1) & 3] *= r_hi; }
                        __builtin_amdgcn_sched_barrier(0); }
            }
    }
    DI void operator()(const f32x4 (&acc)[2][2][4][2], const Unit& u, int wr, int wc, int fr, int fq) const {
        const int row0 = u.pm * BM + wr * 64 + fr, col0 = u.pn * BM + wc * 32 + 8 * fq;
#pragma unroll
        for (int ai = 0; ai < 2; ++ai)
#pragma unroll
            for (int m = 0; m < 4; ++m) { const int row = row0 + ai * HALF + m * 16;
#pragma unroll
                for (int bj = 0; bj < 2; ++bj) {
                    const u32x4 gv = *(const u32x4*)(gates + (size_t)row * PLD + 2 * 1024 + col0 + bj * HALF);
                    float v[8];
#pragma unroll
                    for (int j = 0; j < 4; ++j) { v[2 * j] = gclamp(gv[j] << 16); v[2 * j + 1] = gclamp(gv[j] & 0xffff0000u); }
#pragma unroll
                    for (int j = 0; j < 4; ++j) { v[j] *= acc[ai][bj][m][0][j]; v[4 + j] *= acc[ai][bj][m][1][j]; }
                    u32x4 w; w.x = cvt_pk_bf16(v[0], v[1]); w.y = cvt_pk_bf16(v[2], v[3]); w.z = cvt_pk_bf16(v[4], v[5]); w.w = cvt_pk_bf16(v[6], v[7]);
                    *(u32x4*)(merged + (size_t)row * 1024 + col0 + bj * HALF) = w; } }
    }
};

template <class Epi, class Sched, bool F8 = false>
DI void gemm_phase(LAS unsigned char* lds, const Gemm g, const Sched& S, const Epi& E, int wave_id) {
    int tid_ = (int)__builtin_amdgcn_mbcnt_hi(~0u, __builtin_amdgcn_mbcnt_lo(~0u, 0u)) + 64 * wave_id; asm volatile("" : "+v"(tid_));
    const int tid = tid_, wid = __builtin_amdgcn_readfirstlane(tid >> 6), lane = tid & 63, wr = wid >> 2, wc = wid & 3, fr = lane & 15, fq = lane >> 4;
    unsigned voffA[2], voffB[2];
#pragma unroll
    for (int i = 0; i < 2; ++i) { int R, C; stage_rc(tid * 16 + i * 8192, R, C); const int Rb = (R & ~31) + perm32(R & 31);
        voffA[i] = F8 ? (unsigned)(R * g.lda + 2 * C) : (unsigned)(R * g.lda + C) * 2u; voffB[i] = F8 ? (unsigned)(Rb * g.ldb + 2 * C) : (unsigned)(Rb * g.ldb + C) * 2u; }
    const size_t kstep = (size_t)(BK * 2);
    const size_t hstepA = (size_t)HALF * g.lda * (F8 ? 1 : 2), hstepB = (size_t)HALF * g.ldb * (F8 ? 1 : 2);
    const unsigned ldsw = (unsigned)wid * 1024u;
    const int aoff = lds_byte(wr * 64 + fr, fq * 8), boff = lds_byte(wc * 32 + fr, fq * 8);
#define PG8_SA(b, h) (((b) * 2 + (h)) * HTB)
#define PG8_SB(b, h) ((4 + (b) * 2 + (h)) * HTB)
#define PG8_STAGE(bufoff, gbase, voff) do { _Pragma("unroll") for (int _i = 0; _i < 2; ++_i) \
        __builtin_amdgcn_global_load_lds((const unsigned*)((const char*)(gbase) + (voff)[_i]), (LAS unsigned*)(lds + (bufoff) + ldsw + _i * 8192), 16, 0, 0); } while (0)
#define PG8_LDA(dst, b, h) do { _Pragma("unroll") for (int m = 0; m < 4; ++m) { const v4i_t l0_ = *(const LAS v4i_t*)(lds + PG8_SA(b, h) + aoff + m * 2048), l1_ = *(const LAS v4i_t*)(lds + PG8_SA(b, h) + aoff + m * 2048 + 1024); \
        dst[m] = __builtin_shufflevector(l0_, l1_, 0, 1, 2, 3, 4, 5, 6, 7); } } while (0)
#define PG8_LDB(dst, b, h) do { _Pragma("unroll") for (int n = 0; n < 2; ++n) { const v4i_t l0_ = *(const LAS v4i_t*)(lds + PG8_SB(b, h) + boff + n * 2048), l1_ = *(const LAS v4i_t*)(lds + PG8_SB(b, h) + boff + n * 2048 + 1024); \
        dst[n] = __builtin_shufflevector(l0_, l1_, 0, 1, 2, 3, 4, 5, 6, 7); } } while (0)
#define PG8_MMA(ai, bj, At, Bt) do { __builtin_amdgcn_s_setprio(1); _Pragma("unroll") for (int m = 0; m < 4; ++m) _Pragma("unroll") for (int n = 0; n < 2; ++n) { \
        if constexpr (F8) asm volatile("v_mfma_scale_f32_16x16x128_f8f6f4 %0, %1, %2, %0, %3, %4 op_sel_hi:[0,0,0]" : "+v"(acc[ai][bj][m][n]) : "v"(Bt[n]), "v"(At[m]), "v"(f8scale_w), "v"(f8scale_x));   \
        else { const bf16x8 b0_ = __builtin_bit_cast(bf16x8, __builtin_shufflevector(Bt[n], Bt[n], 0, 1, 2, 3)), b1_ = __builtin_bit_cast(bf16x8, __builtin_shufflevector(Bt[n], Bt[n], 4, 5, 6, 7)), \
                            a0_ = __builtin_bit_cast(bf16x8, __builtin_shufflevector(At[m], At[m], 0, 1, 2, 3)), a1_ = __builtin_bit_cast(bf16x8, __builtin_shufflevector(At[m], At[m], 4, 5, 6, 7)); \
            acc[ai][bj][m][n] = __builtin_amdgcn_mfma_f32_16x16x32_bf16(b0_, a0_, acc[ai][bj][m][n], 0, 0, 0); acc[ai][bj][m][n] = __builtin_amdgcn_mfma_f32_16x16x32_bf16(b1_, a1_, acc[ai][bj][m][n], 0, 0, 0); } } \
        __builtin_amdgcn_s_setprio(0); } while (0)
#define PG8_WAIT_V(n) asm volatile("s_waitcnt vmcnt(" #n ")" ::: "memory")
#define PG8_WAIT_L(n) asm volatile("s_waitcnt lgkmcnt(" #n ")" ::: "memory")
#define PG8_BAR __builtin_amdgcn_s_barrier()
#define PG8_SCHED __builtin_amdgcn_sched_barrier(0)
    Unit cur, nxt; int ui = 0;
    if (!S.next(0, cur)) return;
    f32x4 acc[2][2][4][2];
#pragma unroll
    for (int a = 0; a < 2; ++a)
#pragma unroll
        for (int b = 0; b < 2; ++b)
#pragma unroll
            for (int m = 0; m < 4; ++m)
#pragma unroll
                for (int n = 0; n < 2; ++n) acc[a][b][m][n] = (f32x4){0.f, 0.f, 0.f, 0.f};
    typedef int v8i_t __attribute__((ext_vector_type(8))); typedef int v4i_t __attribute__((ext_vector_type(4)));
    const int f8scale_w = 0x7a7a7a7a, f8scale_x = 0x7f7f7f7f;
    v8i_t At[4], B0[2], B1[2];
    const char* cA = (const char*)g.A + cur.aoff; const char* cB = (const char*)g.Bt + cur.boff;
    PG8_STAGE(PG8_SB(0, 0), cB, voffB); PG8_STAGE(PG8_SB(0, 1), cB + hstepB, voffB); PG8_STAGE(PG8_SA(0, 0), cA, voffA); PG8_STAGE(PG8_SA(0, 1), cA + hstepA, voffA);
    if (wr == 1) PG8_BAR;
    PG8_WAIT_V(2); PG8_BAR;
    PG8_STAGE(PG8_SB(1, 0), cB + kstep, voffB); PG8_STAGE(PG8_SA(1, 0), cA + kstep, voffA); PG8_STAGE(PG8_SB(1, 1), cB + hstepB + kstep, voffB);
    PG8_WAIT_V(6); PG8_BAR;
    for (;;) {
        const bool has_next = S.next(ui + 1, nxt);
        const int nt = cur.nt;
        const char* nA = has_next ? (const char*)g.A + nxt.aoff : cA; const char* nB = has_next ? (const char*)g.Bt + nxt.boff : cB;
        for (int t = 0; t < nt; t += 2) {
            if constexpr (Epi::MID) { if (t == 4 || t == 8) { E.mid(acc, cur, t >> 3, wr, wc, fr, fq); } __builtin_amdgcn_sched_barrier(0); }
            const bool last = (t == nt - 2);
            const char* a1 = cA + (size_t)(t + 1) * kstep;
            const char* a2 = last ? nA : cA + (size_t)(t + 2) * kstep; const char* b2 = last ? nB : cB + (size_t)(t + 2) * kstep;
            const char* a3 = a2 + kstep; const char* b3 = b2 + kstep;
            PG8_LDB(B0, 0, 0); PG8_LDB(B1, 0, 1); PG8_SCHED; PG8_LDA(At, 0, 0); PG8_STAGE(PG8_SA(1, 1), a1 + hstepA, voffA);
            PG8_WAIT_V(8); PG8_WAIT_L(0); PG8_BAR; PG8_MMA(0, 0, At, B0); PG8_MMA(0, 1, At, B1); PG8_BAR; PG8_SCHED;
            PG8_LDA(At, 0, 1); PG8_STAGE(PG8_SB(0, 0), b2, voffB); PG8_STAGE(PG8_SB(0, 1), b2 + hstepB, voffB); PG8_STAGE(PG8_SA(0, 0), a2, voffA);
            PG8_WAIT_V(8); PG8_WAIT_L(0); PG8_BAR; PG8_MMA(1, 0, At, B0); PG8_MMA(1, 1, At, B1); PG8_BAR; PG8_SCHED;
            PG8_LDB(B0, 1, 0); PG8_LDB(B1, 1, 1); PG8_SCHED; PG8_LDA(At, 1, 0); PG8_STAGE(PG8_SA(0, 1), a2 + hstepA, voffA);
            PG8_WAIT_V(8); PG8_WAIT_L(0); PG8_BAR; PG8_MMA(0, 0, At, B0); PG8_MMA(0, 1, At, B1); PG8_BAR; PG8_SCHED;
            PG8_LDA(At, 1, 1); PG8_STAGE(PG8_SB(1, 0), b3, voffB); PG8_STAGE(PG8_SB(1, 1), b3 + hstepB, voffB); PG8_STAGE(PG8_SA(1, 0), a3, voffA);
            PG8_WAIT_V(8); PG8_WAIT_L(0); PG8_BAR; PG8_MMA(1, 0, At, B0); PG8_MMA(1, 1, At, B1); PG8_BAR; PG8_SCHED;
        }
        if (wr == 0) PG8_BAR;
        E(acc, cur, wr, wc, fr, fq);
        if (!has_next) break;
#pragma unroll
        for (int a = 0; a < 2; ++a)
#pragma unroll
            for (int b = 0; b < 2; ++b)
#pragma unroll
                for (int m = 0; m < 4; ++m)
#pragma unroll
                    for (int n = 0; n < 2; ++n) acc[a][b][m][n] = (f32x4){0.f, 0.f, 0.f, 0.f};
        cur = nxt; cA = nA; cB = nB; ++ui;
        if (wr == 1) PG8_BAR;
    }
    PG8_WAIT_V(0);
    PG8_BAR;
#undef PG8_SA
#undef PG8_SB
#undef PG8_STAGE
#undef PG8_LDA
#undef PG8_LDB
#undef PG8_MMA
#undef PG8_WAIT_V
#undef PG8_WAIT_L
#undef PG8_BAR
#undef PG8_SCHED
}
}
struct Params { const float* in[27]; float* out; unsigned char* ws; int ph_lo, ph_hi, pad0, pad1; };
enum { I_X = 0, I_MEM, I_POS, I_MIXG, I_WIN, I_POOLW, I_POOLS, I_CONVW, I_ALOG, I_DTB, I_DNG, I_WUPP, I_WUPM, I_WUPD, I_WOUT, I_XAG, I_MEMG, I_XAQ, I_XAKV, I_XAO,
       I_FFNG, I_DGU, I_DD, I_ROUTER, I_MGU, I_MD, I_FING };

struct Frame {
    LAS unsigned char* lds;
    int tid, lane, wave, G, blk;
    unsigned char* ws;
};

struct Job { const float* W; int K, N; bf16_t* WT; int ldt; int mode; int ff; const float* kscale; unsigned char* WT8; };
DI int job_map(int mode, int ff, int n) {
    if (mode == 0) return n;
    if (mode == 1) return n < 2560 ? n : (n < 2576 ? -1 : n - 16);
    if (n < ff) return (n >> 7) * 256 + (n & 127);
    const int m = n - ff; return (m >> 7) * 256 + 128 + (m & 127);
}
DI int job_items(const Job& J) { return (J.K / 64) * ((J.N + 31) / 32); }
DI void transpose_item(const Job& J, LAS float* scr, int item, int lane) {
    const int nblk = (J.N + 31) / 32, kb = item / nblk, nb = item - kb * nblk, k0 = 64 * kb, n0 = 32 * nb;
    const int nn = lane & 31; const bool ok = (n0 + nn) < J.N;
    float tv[32];
#pragma unroll
    for (int i = 0; i < 32; ++i) { const int kk = 2 * i + (lane >> 5); tv[i] = J.W[(size_t)(k0 + kk) * J.N + (ok ? n0 + nn : 0)]; }
#pragma unroll
    for (int i = 0; i < 32; ++i) { const int kk = 2 * i + (lane >> 5); float v = ok ? tv[i] : 0.f; if (J.kscale) v *= J.kscale[k0 + kk]; scr[kk * 33 + nn] = v; }
    LDS_WAIT();
    const int c = lane & 7;
#pragma unroll
    for (int j = 0; j < 4; ++j) { const int n = (lane >> 3) + 8 * j; const int sn = n0 + n; const int drow = sn < J.N ? job_map(J.mode, J.ff, sn) : -1;
        if (drow >= 0) { const LAS float* s = scr + (8 * c) * 33 + n;
            if (J.mode == 1 && drow >= 3072) { u32x2 o;
                o.x = cvt4_fp8(s[0 * 33] * 32.f, s[1 * 33] * 32.f, s[2 * 33] * 32.f, s[3 * 33] * 32.f); o.y = cvt4_fp8(s[4 * 33] * 32.f, s[5 * 33] * 32.f, s[6 * 33] * 32.f, s[7 * 33] * 32.f);
                *(u32x2*)(J.WT8 + (size_t)(drow - 3072) * 1024 + k0 + 8 * c) = o; }
            else { u32x4 o; o.x = pk2(s[0 * 33], s[1 * 33]); o.y = pk2(s[2 * 33], s[3 * 33]); o.z = pk2(s[4 * 33], s[5 * 33]); o.w = pk2(s[6 * 33], s[7 * 33]);
                *(u32x4*)(J.WT + (size_t)drow * J.ldt + k0 + 8 * c) = o; } } }
    LDS_WAIT();
}
constexpr int NJOBS = 2 * 7 + 2 + 16;
DI void get_job(const Frame& F, const Params& P, int j, Job& J) {
    unsigned char* ws = F.ws;
    J.mode = 0; J.ff = 0; J.kscale = nullptr; J.WT8 = nullptr;
    if (j < 14) { const int l = j / 7, t = j - 7 * l; unsigned char* lw = ws + WS_LW + (size_t)l * LW_STRIDE;
        if (t == 0) { J.W = P.in[I_WIN] + (size_t)l * 1024 * IN_COLS; J.K = 1024; J.N = IN_COLS; J.WT = (bf16_t*)(lw + LW_WIN); J.ldt = 1024; J.mode = 1; J.kscale = P.in[I_MIXG] + l * 1024; J.WT8 = ws + WS_WG8 + (size_t)l * 3072 * 1024; }
        else if (t == 1) { J.W = P.in[I_WUPM] + (size_t)l * 256 * 1024; J.K = 256; J.N = 1024; J.WT = (bf16_t*)(lw + LW_WCAT) + 256; J.ldt = 1024; }
        else if (t == 2) { J.W = P.in[I_WUPD] + (size_t)l * 512 * 1024; J.K = 512; J.N = 1024; J.WT = (bf16_t*)(lw + LW_WCAT) + 512; J.ldt = 1024; }
        else if (t == 3) { J.W = P.in[I_WOUT] + (size_t)l * 1024 * 1024; J.K = 1024; J.N = 1024; J.WT = (bf16_t*)(lw + LW_WOUT); J.ldt = 1024; }
        else if (t == 4) { J.W = P.in[I_XAQ] + (size_t)l * 1024 * 512; J.K = 1024; J.N = 512; J.WT = (bf16_t*)(lw + LW_WQ); J.ldt = 1024; J.kscale = P.in[I_XAG] + l * 1024; }
        else if (t == 5) { J.W = P.in[I_XAKV] + (size_t)l * 1024 * 1024; J.K = 1024; J.N = 1024; J.WT = (bf16_t*)(lw + LW_WKV); J.ldt = 1024; }
        else { J.W = P.in[I_XAO] + (size_t)l * 512 * 1024; J.K = 512; J.N = 1024; J.WT = (bf16_t*)(lw + LW_WO); J.ldt = 512; }
    } else if (j == 14) { J.W = P.in[I_DGU]; J.K = 1024; J.N = 2 * FF; J.WT = (bf16_t*)(ws + WS_WGU); J.ldt = 1024; J.mode = 2; J.ff = FF; J.kscale = P.in[I_FFNG]; }
    else if (j == 15) { J.W = P.in[I_DD]; J.K = FF; J.N = 1024; J.WT = (bf16_t*)(ws + WS_WD); J.ldt = FF; }
    else { const int e = (j - 16) >> 1;
        if (((j - 16) & 1) == 0) { J.W = P.in[I_MGU] + (size_t)e * 1024 * 2 * EFF; J.K = 1024; J.N = 2 * EFF; J.WT = (bf16_t*)(ws + WS_WMGU) + (size_t)e * 2 * EFF * 1024; J.ldt = 1024; J.mode = 2; J.ff = EFF; J.kscale = P.in[I_FFNG] + 1024; }
        else { J.W = P.in[I_MD] + (size_t)e * EFF * 1024; J.K = EFF; J.N = 1024; J.WT = (bf16_t*)(ws + WS_WMD) + (size_t)e * 1024 * EFF; J.ldt = EFF; } }
}

DI void phase_prologue(const Frame& F, const Params& P) {
    unsigned char* ws = F.ws;
    const int gw = F.blk * 8 + F.wave, NGW = F.G * 8, lane = F.lane;
    const long gt = (long)F.blk * 512 + F.tid, NGT = (long)F.G * 512;
    { const float* x = P.in[I_X]; bf16_t* xb = (bf16_t*)(ws + WS_XB); float* ssq = (float*)(ws + WS_SSQ); unsigned char* x8 = ws + WS_X8;
      for (int row0 = gw; row0 < NTOK; row0 += 4 * NGW) {
          f32x4 v[4][4];
#pragma unroll
          for (int q = 0; q < 4; ++q) { const int row = row0 + q * NGW; const f32x4* xr = (const f32x4*)(x + (size_t)(row < NTOK ? row : row0) * 1024) + lane;
#pragma unroll
              for (int j = 0; j < 4; ++j) v[q][j] = xr[64 * j]; }
#pragma unroll
          for (int q = 0; q < 4; ++q) { const int row = row0 + q * NGW; if (row < NTOK) { float s = 0.f;
#pragma unroll
              for (int j = 0; j < 4; ++j) s += (v[q][j].x * v[q][j].x + v[q][j].y * v[q][j].y) + (v[q][j].z * v[q][j].z + v[q][j].w * v[q][j].w);
              s = wave_sum(s);
              u32x2* o = (u32x2*)(xb + (size_t)row * 1024) + lane;
#pragma unroll
              for (int j = 0; j < 4; ++j) { u32x2 w; w.x = pk2(v[q][j].x, v[q][j].y); w.y = pk2(v[q][j].z, v[q][j].w); o[64 * j] = w;
                  ((unsigned*)(x8 + (size_t)row * 1024))[lane + 64 * j] = cvt4_fp8(v[q][j].x, v[q][j].y, v[q][j].z, v[q][j].w); }
              if (lane < 16) ssq[(size_t)row * 16 + lane] = lane == 0 ? s : 0.f; } }
      } }
    { const float* mem = P.in[I_MEM]; bf16_t* mn = (bf16_t*)(ws + WS_MEMN);
      for (int row = gw; row < 2048; row += NGW) {
          const f32x4* xr = (const f32x4*)(mem + (size_t)row * 1024) + lane; f32x4 v[4]; float s = 0.f;
#pragma unroll
          for (int j = 0; j < 4; ++j) { v[j] = xr[64 * j]; s += (v[j].x * v[j].x + v[j].y * v[j].y) + (v[j].z * v[j].z + v[j].w * v[j].w); }
          s = wave_sum(s); const float r = rsqrtf(s * (1.0f / 1024.0f) + RMS_EPS);
#pragma unroll
          for (int l = 0; l < 2; ++l) { const f32x4* gr = (const f32x4*)(P.in[I_MEMG] + l * 1024) + lane; u32x2* o = (u32x2*)(mn + ((size_t)l * 2048 + row) * 1024) + lane;
#pragma unroll
              for (int j = 0; j < 4; ++j) { const f32x4 gg = gr[64 * j]; u32x2 w; w.x = pk2(v[j].x * r * gg.x, v[j].y * r * gg.y); w.y = pk2(v[j].z * r * gg.z, v[j].w * r * gg.w); o[64 * j] = w; } }
      } }
    { const int* pos = (const int*)P.in[I_POS]; float* rope = (float*)(ws + WS_ROPE);
      for (long i = gt; i < (long)NTOK * 8; i += NGT) { const int tok = (int)(i >> 3), f = (int)(i & 7);
          const float inv = powf(500000.0f, -(float)f * 2.0f / 16.0f); const float ang = (float)pos[tok] * inv; float sn, cs; sincosf(ang, &sn, &cs);
          rope[(size_t)tok * 16 + f] = cs; rope[(size_t)tok * 16 + 8 + f] = sn; } }
    for (long i = gt; i < 2 * 16 * 1024; i += NGT) { const int l = (int)(i >> 14), j = (int)((i >> 10) & 15), k = (int)(i & 1023);
        const float v = P.in[I_WIN][((size_t)l * 1024 + k) * IN_COLS + 2560 + j] * P.in[I_MIXG][l * 1024 + k];
        ((bf16_t*)(ws + WS_LW + (size_t)l * LW_STRIDE + LW_WBA))[j * 1024 + k] = (bf16_t)f2bf(v); }
    for (long i = gt; i < 8 * 1024; i += NGT) { const int e = (int)(i >> 10), k = (int)(i & 1023); ((float*)(ws + WS_WR))[e * 1024 + k] = P.in[I_ROUTER][k * 8 + e] * P.in[I_FFNG][1024 + k]; }
    for (long i = gt; i < 2L * 256 * 1024; i += NGT) { const int l = (int)(i >> 18), k = (int)((i >> 10) & 255), n = (int)(i & 1023), gi = k >> 6, c = k & 63;
        const float* pw = P.in[I_POOLW] + (((size_t)l * 4 + gi) * 64 + c) * 64; const float* ps = P.in[I_POOLS] + l * 256 + gi * 64; const float* wu = P.in[I_WUPP] + ((size_t)l * 256 + gi * 64) * 1024 + n;
        float s = 0.f;
#pragma unroll 16
        for (int d = 0; d < 64; ++d) s += pw[d] * ps[d] * wu[(size_t)d * 1024];
        ((bf16_t*)(ws + WS_LW + (size_t)l * LW_STRIDE + LW_WCAT))[(size_t)n * 1024 + k] = (bf16_t)f2bf(s); }
    { float* sm = (float*)(ws + WS_SMALL);
      for (long i = gt; i < 2 * 4 * 1536; i += NGT) sm[SM_CONVW + i] = P.in[I_CONVW][i];
      for (long i = gt; i < 16; i += NGT) { sm[SM_ALOG + i] = P.in[I_ALOG][i]; sm[SM_DTB + i] = P.in[I_DTB][i]; }
      for (long i = gt; i < 128; i += NGT) sm[SM_DNG + i] = P.in[I_DNG][i];
      for (long i = gt; i < 1024; i += NGT) sm[SM_FING + i] = P.in[I_FING][i]; }
    { LAS float* scr = (LAS float*)(F.lds + F.wave * 8704);
      int base = 0;
      for (int j = 0; j < NJOBS; ++j) { Job J; get_job(F, P, j, J); const int ni = job_items(J);
          int first = gw - (base % NGW); if (first < 0) first += NGW;
          for (int it = first; it < ni; it += NGW) transpose_item(J, scr, it, lane);
          base += ni; } }
}
DI void ba_tiles(const Frame& F, const bf16_t* xbg, const bf16_t* Wba, const float* ssqg, float* BA) {
    const int lane = F.lane, gw = F.blk * 8 + F.wave, NGW = F.G * 8;
    for (int tile = gw; tile < NG / 16; tile += NGW) {
        const int row0 = tile * 16; f32x4 acc = (f32x4){0.f, 0.f, 0.f, 0.f};
        const bf16_t* ap = xbg + (size_t)(row0 + (lane & 15)) * 1024 + (lane >> 4) * 8; const bf16_t* bp = Wba + (size_t)(lane & 15) * 1024 + (lane >> 4) * 8;
#pragma unroll 8
        for (int ks = 0; ks < 32; ++ks) { const bf16x8 a = *(const bf16x8*)(ap + 32 * ks); const bf16x8 b = *(const bf16x8*)(bp + 32 * ks); acc = MFMA16(a, b, acc); }
#pragma unroll
        for (int i = 0; i < 4; ++i) { const int row = row0 + 4 * (lane >> 4) + i; BA[(size_t)row * 16 + (lane & 15)] = acc[i] * row_rstd(ssqg, row); }
    }
}

template <int W> DI void prep_pool_w(const bf16_t* Pb, bf16_t* BR, int g, int lane, int lr0, int s0) {
    const int cg = lane & 7, tb = lane >> 3, ch = g * 64 + cg * 8, lr = lr0 + tb * 8, s = s0 + tb * 8;
    const bf16_t* p = Pb + PC_POOL + ch; u32x4 rv[8 + W - 1];
#pragma unroll
    for (int i = 0; i < 8 + W - 1; ++i) { const int d = i - (W - 1); const bool ok = s + d >= 0; rv[i] = *(const u32x4*)(p + (size_t)(ok ? lr + d : lr) * PLD); if (!ok) rv[i] = (u32x4){0u, 0u, 0u, 0u}; }
    f32x2 sum[4];
#pragma unroll
    for (int q = 0; q < 4; ++q) sum[q] = (f32x2){0.f, 0.f};
#pragma unroll
    for (int i = 0; i < W - 1; ++i)
#pragma unroll
        for (int q = 0; q < 4; ++q) sum[q] += (f32x2){__uint_as_float(rv[i][q] << 16), __uint_as_float(rv[i][q] & 0xffff0000u)};
#pragma unroll
    for (int t = 0; t < 8; ++t) { const int st = s + t; const float inv = st + 1 >= W ? (1.0f / (float)W) : 1.0f / (float)(st + 1); u32x4 w;
#pragma unroll
        for (int q = 0; q < 4; ++q) { const f32x2 x = (f32x2){__uint_as_float(rv[t + W - 1][q] << 16), __uint_as_float(rv[t + W - 1][q] & 0xffff0000u)}; sum[q] += x;
            const f32x2 o = sum[q] * inv - x; w[q] = pk2(o.x, o.y);
            sum[q] -= (f32x2){__uint_as_float(rv[t][q] << 16), __uint_as_float(rv[t][q] & 0xffff0000u)}; }
        *(u32x4*)(BR + (size_t)(lr + t) * 1024 + ch) = w; }
}
DI void prep_pool(const Frame& F, const bf16_t* Pb, bf16_t* BR, int unit2) {
    int lane_ = F.lane; LAUNDER_V(lane_);
    const int lane = lane_, g = F.wave & 3, lr0 = (unit2 * 2 + (F.wave >> 2)) * 64, s0 = lr0 & (SEQ - 1);
    if (g == 0) prep_pool_w<2>(Pb, BR, g, lane, lr0, s0); else if (g == 1) prep_pool_w<4>(Pb, BR, g, lane, lr0, s0); else if (g == 2) prep_pool_w<8>(Pb, BR, g, lane, lr0, s0); else prep_pool_w<16>(Pb, BR, g, lane, lr0, s0);
}

DI void prep_moba(const Frame& F, bf16_t* Pb, const float* rope, float* KBAR, bf16_t* VT, int unit) {
    int tid_ = F.tid; LAUNDER_V(tid_);
    const int tid = tid_, lane = tid & 63, wave = F.wave;
    const int bl = unit >> 6, j = (unit >> 1) & 31, hp = unit & 1, lr0 = bl * SEQ + j * 256;
    LAS unsigned* Tt = (LAS unsigned*)F.lds; LAS float* KS1 = (LAS float*)(F.lds + 68 * 1024); LAS float* KS2 = KS1 + 128;
    __syncthreads();
    const int r = tid & 255, hh = tid >> 8; const size_t lr = (size_t)(lr0 + r);
    bf16_t* qb = Pb + lr * PLD + PC_MQ + (2 * hp + hh) * 64; bf16_t* kb = Pb + lr * PLD + PC_MK + (2 * hp + hh) * 64;
    const f32x4 c0 = *(const f32x4*)(rope + lr * 16), c1 = *(const f32x4*)(rope + lr * 16 + 4), s0 = *(const f32x4*)(rope + lr * 16 + 8), s1 = *(const f32x4*)(rope + lr * 16 + 12);
    const u32x4 qa = *(const u32x4*)qb, qc = *(const u32x4*)(qb + 8), ka = *(const u32x4*)kb, kc = *(const u32x4*)(kb + 8);
    const int c8 = tid & 15, rg = tid >> 4; const bool plain = (c8 & 7) >= 2;
    u32x4 vv[8], kk[8];
#pragma unroll
    for (int i = 0; i < 8; ++i) vv[i] = *(const u32x4*)(Pb + (size_t)(lr0 + ((tid + 512 * i) >> 4)) * PLD + PC_MV + hp * 128 + c8 * 8);
#pragma unroll
    for (int i = 0; i < 8; ++i) kk[i] = plain ? *(const u32x4*)(Pb + (size_t)(lr0 + rg * 8 + i) * PLD + PC_MK + hp * 128 + c8 * 8) : (u32x4){0u, 0u, 0u, 0u};
    __builtin_amdgcn_sched_barrier(0);
    {
        const float cs[8] = {c0.x, c0.y, c0.z, c0.w, c1.x, c1.y, c1.z, c1.w}, sn[8] = {s0.x, s0.y, s0.z, s0.w, s1.x, s1.y, s1.z, s1.w};
        float q1[8], q2[8], k1[8], k2[8];
#pragma unroll
        for (int q = 0; q < 4; ++q) { q1[2 * q] = __uint_as_float(qa[q] << 16); q1[2 * q + 1] = __uint_as_float(qa[q] & 0xffff0000u); q2[2 * q] = __uint_as_float(qc[q] << 16); q2[2 * q + 1] = __uint_as_float(qc[q] & 0xffff0000u);
                                      k1[2 * q] = __uint_as_float(ka[q] << 16); k1[2 * q + 1] = __uint_as_float(ka[q] & 0xffff0000u); k2[2 * q] = __uint_as_float(kc[q] << 16); k2[2 * q + 1] = __uint_as_float(kc[q] & 0xffff0000u); }
        float ra[8], rb[8]; u32x4 oa, ob;
#pragma unroll
        for (int e = 0; e < 8; ++e) { ra[e] = q1[e] * cs[e] - q2[e] * sn[e]; rb[e] = q2[e] * cs[e] + q1[e] * sn[e]; }
#pragma unroll
        for (int q = 0; q < 4; ++q) { oa[q] = pk2(ra[2 * q], ra[2 * q + 1]); ob[q] = pk2(rb[2 * q], rb[2 * q + 1]); }
        *(u32x4*)qb = oa; *(u32x4*)(qb + 8) = ob;
#pragma unroll
        for (int e = 0; e < 8; ++e) { ra[e] = k1[e] * cs[e] - k2[e] * sn[e]; rb[e] = k2[e] * cs[e] + k1[e] * sn[e]; }
#pragma unroll
        for (int q = 0; q < 4; ++q) { oa[q] = pk2(ra[2 * q], ra[2 * q + 1]); ob[q] = pk2(rb[2 * q], rb[2 * q + 1]); }
        *(u32x4*)kb = oa; *(u32x4*)(kb + 8) = ob;
#pragma unroll
        for (int e = 0; e < 8; ++e) { const float a = wave_sum(ra[e]), b = wave_sum(rb[e]); if (lane == 0) { KS1[wave * 16 + e] = a; KS1[wave * 16 + 8 + e] = b; } }
    }
    {
        float sacc[8];
#pragma unroll
        for (int e = 0; e < 8; ++e) sacc[e] = 0.f;
#pragma unroll
        for (int i = 0; i < 8; ++i)
#pragma unroll
            for (int q = 0; q < 4; ++q) { sacc[2 * q] += __uint_as_float(kk[i][q] << 16); sacc[2 * q + 1] += __uint_as_float(kk[i][q] & 0xffff0000u); }
#pragma unroll
        for (int e = 0; e < 8; ++e) { sacc[e] += __shfl_xor(sacc[e], 16); sacc[e] += __shfl_xor(sacc[e], 32); }
        if (lane < 16) {
#pragma unroll
            for (int e = 0; e < 8; ++e) KS2[wave * 128 + c8 * 8 + e] = sacc[e]; }
    }
#pragma unroll
    for (int i = 0; i < 8; ++i) { const int tok = (tid + 512 * i) >> 4;
#pragma unroll
        for (int e = 0; e < 4; ++e) Tt[tok * 65 + c8 * 4 + e] = vv[i][e]; }
    __syncthreads();
    if (tid < 128) { const int h2 = tid >> 6, d = tid & 63; float sum = 0.f;
        if (d < 16) {
#pragma unroll
            for (int w = 0; w < 4; ++w) sum += KS1[(4 * h2 + w) * 16 + d]; }
        else {
#pragma unroll
            for (int w = 0; w < 8; ++w) sum += KS2[w * 128 + tid]; }
        KBAR[((size_t)(bl * 4 + 2 * hp + h2) * 32 + j) * 64 + d] = sum * (1.0f / 256.0f); }
    const LAS unsigned char* Tb = (const LAS unsigned char*)Tt;
#pragma unroll
    for (int i = 0; i < 8; ++i) { const int o = tid + 512 * i, t8 = o & 7, cl = (o >> 3) & 7, rest = o >> 6, th = rest & 3, cg = rest >> 2, col = cg * 8 + cl, tg = th * 8 + t8;
        unsigned short hv[8];
#pragma unroll
        for (int e = 0; e < 8; ++e) hv[e] = *(const LAS unsigned short*)(Tb + ((tg * 8 + e) * 65 + (col >> 1)) * 4 + (col & 1) * 2);
        u32x4 w;
#pragma unroll
        for (int e = 0; e < 4; ++e) w[e] = (unsigned)hv[2 * e] | ((unsigned)hv[2 * e + 1] << 16);
        *(u32x4*)(VT + ((size_t)(bl * 256 + hp * 128 + col)) * SEQ + j * 256 + tg * 8) = w; }
    __syncthreads();
}

constexpr int DN_ROWB = 144;
constexpr int DN_TQ = 0, DN_TK = 9216, DN_TKB = 18432, DN_TVB = 27648, DN_MISC = 36864, DN_PAIR = 38400;
__host__ __device__ constexpr int ap_rowoff(int i) { return i == 0 ? 0 : 4 * (((i - 1) / 4) + 1) * (2 * ((i - 1) / 4) + ((i - 1) % 4)); }

template <int I> DI void subst_load(const LAS float* Ap, const LAS unsigned char* Rt, const LAS float* SCL, int lane, f32x4 (&av)[16], float& Ri) {
    constexpr int off = ap_rowoff(I);
#pragma unroll
    for (int j4 = 0; j4 < I; j4 += 4) av[j4 >> 2] = *(const LAS f32x4*)(Ap + off + j4);
    Ri = bf2f(*(const LAS bf16_t*)(Rt + I * DN_ROWB + lane * 2)) * SCL[I];
}
template <int I> struct Subst2 { static DI void run(f32x2 (&x)[32], const LAS float* Ap, const LAS unsigned char* Rt, const LAS float* SCL, int lane, f32x4 (&cur)[16], float Rc, f32x4 (&nxt)[16]) {
    float Rn = 0.f;
    if constexpr (I + 1 < 64) subst_load<I + 1>(Ap, Rt, SCL, lane, nxt, Rn);
    f32x2 a01 = (f32x2){Rc, 0.f}, a23 = (f32x2){0.f, 0.f};
#pragma unroll
    for (int j4 = 0; j4 < I; j4 += 4) { const f32x4 av = cur[j4 >> 2];
        a01 -= (f32x2){av.x, av.y} * x[j4 >> 1];
        if (j4 + 2 < I) a23 -= (f32x2){av.z, av.w} * x[(j4 >> 1) + 1]; }
    const f32x2 sm = a01 + a23; float xi = sm.x + sm.y;
    asm volatile("" : "+v"(xi)); __builtin_amdgcn_sched_barrier(0);
    if constexpr (I & 1) x[I >> 1].y = xi; else x[I >> 1].x = xi;
    if constexpr (I + 1 < 64) Subst2<I + 1>::run(x, Ap, Rt, SCL, lane, nxt, Rn, cur);
} };

DI void conv_w_load(const float* convw, int wcol, f32x2 (&w)[4][4]) {
#pragma unroll
    for (int j = 0; j < 4; ++j) { const f32x4 w0 = *(const f32x4*)(convw + j * 1536 + wcol), w1 = *(const f32x4*)(convw + j * 1536 + wcol + 4);
        w[j][0] = (f32x2){w0.x, w0.y}; w[j][1] = (f32x2){w0.z, w0.w}; w[j][2] = (f32x2){w1.x, w1.y}; w[j][3] = (f32x2){w1.z, w1.w}; }
}
DI void conv8(const bf16_t* Pb, const f32x2 (&w)[4][4], int lr, int s, int pcol8, bool edge, f32x2 (&a)[4]) {
    u32x4 xv[4];
#pragma unroll
    for (int j = 0; j < 4; ++j) { const bool valid = !edge || (s - 3 + j) >= 0; xv[j] = *(const u32x4*)(Pb + (size_t)(valid ? lr - 3 + j : lr) * PLD + pcol8); }
    if (edge) {
#pragma unroll
        for (int j = 0; j < 3; ++j) { const bool valid = (s - 3 + j) >= 0; xv[j].x = valid ? xv[j].x : 0u; xv[j].y = valid ? xv[j].y : 0u; xv[j].z = valid ? xv[j].z : 0u; xv[j].w = valid ? xv[j].w : 0u; } }
#pragma unroll
    for (int q = 0; q < 4; ++q) a[q] = (f32x2){0.f, 0.f};
#pragma unroll
    for (int j = 0; j < 4; ++j)
#pragma unroll
        for (int q = 0; q < 4; ++q) a[q] += w[j][q] * (f32x2){__uint_as_float(xv[j][q] << 16), __uint_as_float(xv[j][q] & 0xffff0000u)};
#pragma unroll
    for (int q = 0; q < 4; ++q) { const f32x2 t = a[q] * -1.44269504089f; f32x2 e = (f32x2){__builtin_amdgcn_exp2f(t.x), __builtin_amdgcn_exp2f(t.y)}; e += 1.0f;
        a[q] *= (f32x2){__builtin_amdgcn_rcpf(e.x), __builtin_amdgcn_rcpf(e.y)}; }
}
DI float ssq8(const f32x2 (&a)[4]) { f32x2 s2 = a[0] * a[0];
#pragma unroll
    for (int q = 1; q < 4; ++q) s2 += a[q] * a[q];
    float ss = s2.x + s2.y;
    ss += __shfl_xor(ss, 1); ss += __shfl_xor(ss, 2); ss += __shfl_xor(ss, 4); return ss; }
DI u32x4 pack8(const f32x2 (&a)[4], float sc) { u32x4 w;
#pragma unroll
    for (int q = 0; q < 4; ++q) { const f32x2 t = a[q] * sc; w[q] = pk2(t.x, t.y); }
    return w; }

#ifndef DBG_RA
#define DBG_RA 1
#endif
#ifndef DBG_RB
#define DBG_RB 1
#endif
#ifndef DBG_RC
#define DBG_RC 1
#endif
#ifndef DBG_RD
#define DBG_RD 1
#endif
#ifndef DBG_RB2
#define DBG_RB2 1
#endif
constexpr int DN_PCNT = 4 * DN_PAIR;
DI void pair_bar(LAS unsigned* cnt, unsigned& gen, int lane) {
    asm volatile("s_waitcnt lgkmcnt(0)" ::: "memory");
    gen += 2u;
    if (lane == 0) __hip_atomic_fetch_add(cnt, 1u, __ATOMIC_RELAXED, __HIP_MEMORY_SCOPE_WORKGROUP);
    for (;;) { const unsigned v = __builtin_amdgcn_readfirstlane(__hip_atomic_load(cnt, __ATOMIC_RELAXED, __HIP_MEMORY_SCOPE_WORKGROUP)); if (v >= gen) break; __builtin_amdgcn_s_sleep(1); }
    asm volatile("" ::: "memory");
}
DI void prep_dn(const Frame& F, const bf16_t* Pb, const float* BA, const float* convw, const float* alog, const float* dtb,
                bf16_t* QD, bf16_t* MM, bf16_t* NT, bf16_t* WN, bf16_t* UT, bf16_t* AQK, float* GL, int unit, unsigned& pgen) {
    int lane_ = F.lane; LAUNDER_V(lane_);
    const int lane = lane_, wave = F.wave, pr = wave >> 1, role = wave & 1;
    const int bl = unit >> 8, rem = unit & 255, n = rem >> 1, hq = rem & 1, h = 4 * hq + pr;
    const int lr0 = bl * SEQ + n * 64;
    const int chidx = (bl * 128 + n) * 8 + h;
    LAS unsigned char* L = F.lds + pr * DN_PAIR;
    LAS unsigned* const pcnt = (LAS unsigned*)(F.lds + DN_PCNT) + pr * 16;
#define PAIR_BAR() pair_bar(pcnt, pgen, lane)
    LAS float* Gs = (LAS float*)(L + DN_MISC); LAS float* EG = Gs + 64; LAS float* EGL = Gs + 128; LAS float* ONES = Gs + 192; LAS float* BETA = Gs + 256 + 64 * role;
    {
        const int lr = lr0 + lane;
        const float braw = BA[(size_t)lr * 16 + h], araw = BA[(size_t)lr * 16 + 8 + h];
        const float beta = fsigmoid(braw);
        const float xa = araw + dtb[h]; const float sp = xa > 20.f ? xa : log1pf(__expf(xa));
        float G = -__expf(alog[h]) * sp;
#pragma unroll
        for (int o = 1; o < 64; o <<= 1) { const float up = __shfl_up(G, o); if (lane >= o) G += up; }
        const float Glast = __shfl(G, 63);
        BETA[lane] = beta;
        if (role == 0) { Gs[lane] = G; EG[lane] = __expf(G); EGL[lane] = __expf(Glast - G); ONES[lane] = 1.0f; if (lane == 0) GL[chidx] = __expf(Glast); }
    }
    LDS_WAIT();
    for (int rpA = 0; rpA < DBG_RA; ++rpA) {
        const int cg = lane & 7, tl = lane >> 3; f32x2 w[4][4]; const bool edge = (n == 0);
        if (role == 0) {
            conv_w_load(convw, h * 64 + cg * 8, w);
#pragma unroll 4
            for (int ps = 0; ps < 8; ++ps) { const int t = ps * 8 + tl; f32x2 a[4]; conv8(Pb, w, lr0 + t, n * 64 + t, PC_DQ + h * 64 + cg * 8, edge, a);
                const float rn = rsqrtf(ssq8(a) + RMS_EPS) * 0.125f;
                *(LAS u32x4*)(L + DN_TQ + t * DN_ROWB + cg * 16) = pack8(a, rn); }
        } else {
            conv_w_load(convw, 512 + h * 64 + cg * 8, w);
#pragma unroll 4
            for (int ps = 0; ps < 8; ++ps) { const int t = ps * 8 + tl; f32x2 a[4]; conv8(Pb, w, lr0 + t, n * 64 + t, PC_DK + h * 64 + cg * 8, edge, a);
                const float rn = rsqrtf(ssq8(a) + RMS_EPS);
                *(LAS u32x4*)(L + DN_TK + t * DN_ROWB + cg * 16) = pack8(a, rn); *(LAS u32x4*)(L + DN_TKB + t * DN_ROWB + cg * 16) = pack8(a, rn * BETA[t]); }
        }
        conv_w_load(convw, 1024 + h * 64 + cg * 8, w);
#pragma unroll 4
        for (int ps = 4 * role; ps < 4 * role + 4; ++ps) { const int t = ps * 8 + tl; f32x2 a[4]; conv8(Pb, w, lr0 + t, n * 64 + t, PC_DV + h * 64 + cg * 8, edge, a);
            *(LAS u32x4*)(L + DN_TVB + t * DN_ROWB + cg * 16) = pack8(a, BETA[t]); }
    }
    PAIR_BAR();
    for (int rpB = 0; rpB < DBG_RB; ++rpB) {
        const int fr = lane & 15, fq = lane >> 4;
#pragma unroll
        for (int tt = 0; tt < 8; ++tt) { const int tile = 2 * tt + role, it = tile >> 2, jt = tile & 3;
            f32x4 acc = (f32x4){0.f, 0.f, 0.f, 0.f};
            if (jt <= it) {
#pragma unroll
                for (int ks = 0; ks < 2; ++ks) { const bf16x8 a = *(const LAS bf16x8*)(L + DN_TK + (16 * jt + fr) * DN_ROWB + (fq * 8 + 32 * ks) * 2);
                    const bf16x8 b = *(const LAS bf16x8*)(L + DN_TQ + (16 * it + fr) * DN_ROWB + (fq * 8 + 32 * ks) * 2); acc = MFMA16(a, b, acc); } }
            const int ii = 16 * it + fr; const float Gi = Gs[ii]; float v[4];
#pragma unroll
            for (int r = 0; r < 4; ++r) { const int jj = 16 * jt + 4 * fq + r; v[r] = (jj <= ii) ? acc[r] * __expf(Gi - Gs[jj]) : 0.f; }
            u32x2 w; w.x = pk2(v[0], v[1]); w.y = pk2(v[2], v[3]);
            *(u32x2*)(AQK + (size_t)chidx * 4096 + ii * 64 + 16 * jt + 4 * fq) = w;
        }
#pragma unroll
        for (int i = 0; i < 4; ++i) { const int idx = lane + 64 * role + 128 * i, t = idx >> 3, cg = idx & 7; const u32x4 qv = *(const LAS u32x4*)(L + DN_TQ + t * DN_ROWB + cg * 16); const float eg = EG[t]; u32x4 w;
#pragma unroll
            for (int e = 0; e < 4; ++e) w[e] = pk2(__uint_as_float(qv[e] << 16) * eg, __uint_as_float(qv[e] & 0xffff0000u) * eg);
            *(u32x4*)(QD + (size_t)chidx * 4096 + t * 64 + cg * 8) = w; }
    }
    PAIR_BAR();
    for (int rpB2 = 0; rpB2 < DBG_RB2; ++rpB2) {
        const int fr = lane & 15, fq = lane >> 4; LAS float* Ap = (LAS float*)(L + DN_TQ);
#pragma unroll
        for (int tt = 0; tt < 5; ++tt) { const int q = 2 * tt + role;
            const int it = q < 1 ? 0 : (q < 3 ? 1 : (q < 6 ? 2 : 3)), jt = q - (it * (it + 1)) / 2;
            f32x4 acc = (f32x4){0.f, 0.f, 0.f, 0.f};
#pragma unroll
            for (int ks = 0; ks < 2; ++ks) { const bf16x8 a = *(const LAS bf16x8*)(L + DN_TKB + (16 * it + fr) * DN_ROWB + (fq * 8 + 32 * ks) * 2);
                const bf16x8 b = *(const LAS bf16x8*)(L + DN_TK + (16 * jt + fr) * DN_ROWB + (fq * 8 + 32 * ks) * 2); acc = MFMA16(a, b, acc); }
            const int jj = 16 * jt + fr; const float Gj = Gs[jj];
#pragma unroll
            for (int r = 0; r < 4; ++r) { const int ii = 16 * it + 4 * fq + r;
                if (jj < ((ii + 3) & ~3) && ii > 0) { const int m1 = ii - 1, gf = m1 >> 2, rm = m1 & 3; Ap[4 * (gf + 1) * (2 * gf + rm) + jj] = jj < ii ? acc[r] * __expf(Gs[ii] - Gj) : 0.f; } }
        }
    }
    u32x4 kdt[4];
#pragma unroll
    for (int i = 0; i < 4; ++i) { const int idx = lane + 64 * role + 128 * i, d = idx >> 3, tc = idx & 7; unsigned short kv[8];
#pragma unroll
        for (int e = 0; e < 8; ++e) kv[e] = *(const LAS bf16_t*)(L + DN_TK + (tc * 8 + e) * DN_ROWB + d * 2);
#pragma unroll
        for (int e = 0; e < 4; ++e) kdt[i][e] = pk2(bf2f(kv[2 * e]) * EGL[tc * 8 + 2 * e], bf2f(kv[2 * e + 1]) * EGL[tc * 8 + 2 * e + 1]); }
    PAIR_BAR();
#pragma unroll
    for (int i = 0; i < 4; ++i) { const int idx = lane + 64 * role + 128 * i, d = idx >> 3, tc = idx & 7; *(LAS u32x4*)(L + DN_TK + d * DN_ROWB + tc * 16) = kdt[i]; }
    for (int rpC = 0; rpC < DBG_RC; ++rpC) {
        f32x2 x[32];
#pragma unroll
        for (int i = 0; i < 32; ++i) x[i] = (f32x2){0.f, 0.f};
        LAS unsigned char* const RT = L + DN_TVB - role * (DN_TVB - DN_TKB);
        { f32x4 avA[16], avB[16]; float R0; subst_load<0>((const LAS float*)(L + DN_TQ), RT, Gs + 192 - role * 128, lane, avA, R0);
          Subst2<0>::run(x, (const LAS float*)(L + DN_TQ), RT, Gs + 192 - role * 128, lane, avA, R0, avB); }
        { LAS unsigned char* T = RT + lane * DN_ROWB;
#pragma unroll
          for (int cg = 0; cg < 8; ++cg) { u32x4 w; w.x = pk2(x[cg * 4].x, x[cg * 4].y); w.y = pk2(x[cg * 4 + 1].x, x[cg * 4 + 1].y); w.z = pk2(x[cg * 4 + 2].x, x[cg * 4 + 2].y); w.w = pk2(x[cg * 4 + 3].x, x[cg * 4 + 3].y);
              *(LAS u32x4*)(T + cg * 16) = w; if (role == 0) *((u32x4*)(UT + (size_t)chidx * 4096 + lane * 64) + cg) = w; } }
    }
    PAIR_BAR();
#pragma unroll
    for (int i = 0; i < 4; ++i) { const int idx = lane + 64 * role + 128 * i, cg = idx >> 6, t = idx & 63; unsigned short wv[8];
#pragma unroll
        for (int e = 0; e < 8; ++e) wv[e] = *(const LAS bf16_t*)(L + DN_TKB + (cg * 8 + e) * DN_ROWB + t * 2);
        u32x4 w;
#pragma unroll
        for (int e = 0; e < 4; ++e) w[e] = ((unsigned)wv[2 * e] | ((unsigned)wv[2 * e + 1] << 16)) ^ 0x80008000u;
        *(u32x4*)(WN + (size_t)chidx * 4096 + t * 64 + cg * 8) = w; }
    for (int rpD = 0; rpD < DBG_RD; ++rpD) {
        const int fr = lane & 15, fq = lane >> 4; const float glast = EG[63];
#pragma unroll
        for (int tt = 0; tt < 8; ++tt) { const int tile = 2 * tt + role, mt = tile >> 2, nt = tile & 3;
            f32x4 acc = (f32x4){0.f, 0.f, 0.f, 0.f};
#pragma unroll
            for (int ks = 0; ks < 2; ++ks) { const bf16x8 a = *(const LAS bf16x8*)(L + DN_TKB + (16 * mt + fr) * DN_ROWB + (fq * 8 + 32 * ks) * 2);
                const bf16x8 b = *(const LAS bf16x8*)(L + DN_TK + (16 * nt + fr) * DN_ROWB + (fq * 8 + 32 * ks) * 2); acc = MFMA16(a, b, acc); }
            { const int dko = 16 * nt + fr, dki0 = 16 * mt + 4 * fq; u32x2 w;
              w.x = pk2((dko == dki0 ? glast : 0.f) - acc[0], (dko == dki0 + 1 ? glast : 0.f) - acc[1]); w.y = pk2((dko == dki0 + 2 ? glast : 0.f) - acc[2], (dko == dki0 + 3 ? glast : 0.f) - acc[3]);
              *(u32x2*)(MM + (size_t)chidx * 4096 + dko * 64 + dki0) = w; }
            acc = (f32x4){0.f, 0.f, 0.f, 0.f};
#pragma unroll
            for (int ks = 0; ks < 2; ++ks) { const bf16x8 a = *(const LAS bf16x8*)(L + DN_TK + (16 * mt + fr) * DN_ROWB + (fq * 8 + 32 * ks) * 2);
                const bf16x8 b = *(const LAS bf16x8*)(L + DN_TVB + (16 * nt + fr) * DN_ROWB + (fq * 8 + 32 * ks) * 2); acc = MFMA16(a, b, acc); }
            { u32x2 w; w.x = pk2(acc[0], acc[1]); w.y = pk2(acc[2], acc[3]); *(u32x2*)(NT + (size_t)chidx * 4096 + (16 * nt + fr) * 64 + 16 * mt + 4 * fq) = w; }
        }
    }
    PAIR_BAR();
}
#undef PAIR_BAR
constexpr int SC_ROWB = 144;
constexpr int SC_ST = 0, SC_VT = 64 * SC_ROWB, SC_RS = 2 * 64 * SC_ROWB;
DI void dn_scan(const Frame& F, int chain, const bf16_t* MM, const bf16_t* NT, bf16_t* SG, int nb, int ne, bool do_store = true) {
    const int lane = F.lane, wave = F.wave, rt = wave & 3, fr = lane & 15, fq = lane >> 4; const bool worker = wave < 4;
    const int bl = chain >> 3, h = chain & 7;
    LAS unsigned char* L = F.lds;
    if (nb == 0) for (int i = F.tid; i < 64 * SC_ROWB / 4; i += 512) ((LAS unsigned*)L)[i] = 0u;
    const size_t cstride = (size_t)8 * 4096;
    size_t cb = (size_t)((bl * 128 + nb) * 8 + h) * 4096;
    const int aoffs = (16 * rt + fr) * 64 + fq * 8;
    const int coff0 = fr * 64 + 16 * rt + 4 * fq;
    if (worker && nb == 0) {
#pragma unroll
        for (int nt = 0; nt < 4; ++nt) *(u32x2*)(SG + cb + coff0 + 1024 * nt) = (u32x2){0u, 0u}; }
    bf16x8 a[4][2]; u32x2 nc[4][4];
    if (worker) {
#pragma unroll
        for (int j = 0; j < 4; ++j) { const size_t cj = cb + (size_t)(nb + j < 127 ? j : 0) * cstride;
#pragma unroll
            for (int ks = 0; ks < 2; ++ks) a[j][ks] = *(const bf16x8*)(MM + cj + aoffs + 32 * ks);
#pragma unroll
            for (int nt = 0; nt < 4; ++nt) nc[j][nt] = *(const u32x2*)(NT + cj + coff0 + 1024 * nt); } }
    __syncthreads();
#pragma unroll 1
    for (int n0 = nb; n0 < ne; n0 += 16) {
#pragma unroll
        for (int jj = 0; jj < 16; ++jj) { const int j = jj & 3; const int n = n0 + jj;
            if (n < ne) {
                const size_t cbn = cb + cstride;
                if (worker) {
                    LAS unsigned char* SR = L + (n & 1) * 64 * SC_ROWB; LAS unsigned char* SW = L + ((n + 1) & 1) * 64 * SC_ROWB;
#pragma unroll
                    for (int nt = 0; nt < 4; ++nt) {
                        f32x4 acc = (f32x4){__uint_as_float(nc[j][nt].x << 16), __uint_as_float(nc[j][nt].x & 0xffff0000u), __uint_as_float(nc[j][nt].y << 16), __uint_as_float(nc[j][nt].y & 0xffff0000u)};
#pragma unroll
                        for (int ks = 0; ks < 2; ++ks) { const bf16x8 sb = *(const LAS bf16x8*)(SR + (16 * nt + fr) * SC_ROWB + (fq * 8 + 32 * ks) * 2); acc = MFMA16(a[j][ks], sb, acc); }
                        u32x2 w; w.x = cvt_pk_bf16(acc[0], acc[1]); w.y = cvt_pk_bf16(acc[2], acc[3]);
                        *(LAS u32x2*)(SW + (16 * nt + fr) * SC_ROWB + (16 * rt + 4 * fq) * 2) = w;
                        if (do_store) *(u32x2*)(SG + cbn + coff0 + 1024 * nt) = w;
                    }
                    if (n + 4 < 127) { const size_t c4 = cb + 4 * cstride;
#pragma unroll
                        for (int ks = 0; ks < 2; ++ks) a[j][ks] = *(const bf16x8*)(MM + c4 + aoffs + 32 * ks);
#pragma unroll
                        for (int nt = 0; nt < 4; ++nt) nc[j][nt] = *(const u32x2*)(NT + c4 + coff0 + 1024 * nt); }
                }
                WG_BAR();
                cb = cbn;
            }
        }
    }
    __syncthreads();
}

struct OutOps { bf16x8 wn[2], qd[2], aq[2], sb[4][2]; u32x2 uv[4]; unsigned short zv[16]; };
DI void out_load(OutOps& o, int k, int rt, int fr, int fq, const bf16_t* QD, const bf16_t* WN, const bf16_t* UT, const bf16_t* AQK, const bf16_t* SG, const bf16_t* ZB) {
    const size_t cb = (size_t)k * 4096; const int arow = 16 * rt + fr; const int h = k & 7, n = (k >> 3) & 127, bl = k >> 10;
#pragma unroll
    for (int ks = 0; ks < 2; ++ks) { const size_t off = cb + arow * 64 + fq * 8 + 32 * ks;
        o.wn[ks] = *(const bf16x8*)(WN + off); o.qd[ks] = *(const bf16x8*)(QD + off); o.aq[ks] = *(const bf16x8*)(AQK + off); }
#pragma unroll
    for (int nt = 0; nt < 4; ++nt) { o.uv[nt] = *(const u32x2*)(UT + cb + (16 * nt + fr) * 64 + 16 * rt + 4 * fq);
#pragma unroll
        for (int ks = 0; ks < 2; ++ks) o.sb[nt][ks] = *(const bf16x8*)(SG + cb + (16 * nt + fr) * 64 + fq * 8 + 32 * ks); }
    const int lrb = bl * SEQ + n * 64 + 16 * rt + 4 * fq;
#pragma unroll
    for (int r = 0; r < 4; ++r)
#pragma unroll
        for (int nt = 0; nt < 4; ++nt) o.zv[r * 4 + nt] = ZB[(size_t)(lrb + r) * 512 + h * 64 + 16 * nt + fr];
}
DI void dn_out_pass(const Frame& F, const bf16_t* QD, const bf16_t* WN, const bf16_t* UT, const bf16_t* AQK, const bf16_t* SG, const bf16_t* ZB, const float* dng, bf16_t* BR) {
    int lane_ = F.lane; LAUNDER_V(lane_);
    const int lane = lane_, wave = F.wave, rt = wave & 3, half = wave >> 2, fr = lane & 15, fq = lane >> 4;
    LAS unsigned char* L = F.lds;
    float ng[4];
#pragma unroll
    for (int nt = 0; nt < 4; ++nt) ng[nt] = dng[16 * nt + fr];
    int p = F.blk; if (p >= NCH / 2) return;
    OutOps cur, nxt;
    out_load(cur, 2 * p + half, rt, fr, fq, QD, WN, UT, AQK, SG, ZB);
    __syncthreads();
    for (int it = 0; p < NCH / 2; p += F.G, ++it) {
        const int k = 2 * p + half, pn = p + F.G < NCH / 2 ? p + F.G : p;
        out_load(nxt, 2 * pn + half, rt, fr, fq, QD, WN, UT, AQK, SG, ZB);
        const int h = k & 7, n = (k >> 3) & 127, bl = k >> 10;
        LAS unsigned char* VT = L + ((it & 1) * 2 + half) * 64 * SC_ROWB;
        f32x4 vn[4], o[4];
#pragma unroll
        for (int nt = 0; nt < 4; ++nt) { vn[nt] = (f32x4){__uint_as_float(cur.uv[nt].x << 16), __uint_as_float(cur.uv[nt].x & 0xffff0000u), __uint_as_float(cur.uv[nt].y << 16), __uint_as_float(cur.uv[nt].y & 0xffff0000u)};
            o[nt] = (f32x4){0.f, 0.f, 0.f, 0.f};
#pragma unroll
            for (int ks = 0; ks < 2; ++ks) { vn[nt] = MFMA16(cur.wn[ks], cur.sb[nt][ks], vn[nt]); o[nt] = MFMA16(cur.qd[ks], cur.sb[nt][ks], o[nt]); } }
#pragma unroll
        for (int nt = 0; nt < 4; ++nt) { u32x2 w; w.x = cvt_pk_bf16(vn[nt][0], vn[nt][1]); w.y = cvt_pk_bf16(vn[nt][2], vn[nt][3]);
            *(LAS u32x2*)(VT + (16 * nt + fr) * SC_ROWB + (16 * rt + 4 * fq) * 2) = w; }
        WG_BAR();
#pragma unroll
        for (int nt = 0; nt < 4; ++nt)
#pragma unroll
            for (int ks = 0; ks < 2; ++ks) { const bf16x8 vb = *(const LAS bf16x8*)(VT + (16 * nt + fr) * SC_ROWB + (fq * 8 + 32 * ks) * 2); o[nt] = MFMA16(cur.aq[ks], vb, o[nt]); }
        const int lrb = bl * SEQ + n * 64 + 16 * rt + 4 * fq;
#pragma unroll
        for (int r = 0; r < 4; ++r) { float q = (o[0][r] * o[0][r] + o[1][r] * o[1][r]) + (o[2][r] * o[2][r] + o[3][r] * o[3][r]);
            q += __shfl_xor(q, 1); q += __shfl_xor(q, 2); q += __shfl_xor(q, 4); q += __shfl_xor(q, 8);
            const float rs = rsqrtf(q * (1.0f / 64.0f) + RMS_EPS); const size_t lr = (size_t)(lrb + r);
#pragma unroll
            for (int nt = 0; nt < 4; ++nt) { const float z = bf2f(cur.zv[r * 4 + nt]);
                BR[lr * 1024 + 512 + h * 64 + 16 * nt + fr] = (bf16_t)f2bf(o[nt][r] * rs * ng[nt] * (z * fsigmoid(z))); } }
        cur = nxt;
    }
    __syncthreads();
}

constexpr int MG_QS = 0, MG_KB = 36864, MG_SEL = MG_KB + 8192, MG_TOP = MG_SEL + 1024;
DI void moba_gate_unit(const Frame& F, const bf16_t* Pb, const float* KBAR, unsigned* SELG, unsigned char* LISTG, int* CNTG, int bl, int h, int c) {
    int lane_ = F.lane; LAUNDER_V(lane_);
    const int lane = lane_, wave = F.wave, tid = wave * 64 + lane;
    LAS unsigned char* L = F.lds; LAS float* KB = (LAS float*)(L + MG_KB); LAS unsigned* SEL = (LAS unsigned*)(L + MG_SEL);
    const int q0 = bl * SEQ + c * 256, bh = bl * 4 + h;
    __syncthreads();
    {
        u32x4 qv4[4]; float kbv[4];
#pragma unroll
        for (int i = 0; i < 4; ++i) { const int q = tid + 512 * i, r = q >> 3, c8 = q & 7; qv4[i] = *(const u32x4*)(Pb + (size_t)(q0 + r) * PLD + PC_MQ + h * 64 + c8 * 8); }
#pragma unroll
        for (int i = 0; i < 4; ++i) { const int idx = tid + 512 * i; kbv[i] = idx < c * 64 ? KBAR[(size_t)bh * 2048 + idx] : 0.f; }
        __builtin_amdgcn_sched_barrier(0);
#pragma unroll
        for (int i = 0; i < 4; ++i) { const int q = tid + 512 * i, r = q >> 3, c8 = q & 7; *(LAS u32x4*)(L + MG_QS + r * 144 + c8 * 16) = qv4[i]; }
#pragma unroll
        for (int i = 0; i < 4; ++i) { const int idx = tid + 512 * i; if (idx < c * 64) KB[idx] = kbv[i]; } }
    __syncthreads();
    {
        const int qi = tid & 255, par = tid >> 8;
        float qv[64];
#pragma unroll
        for (int c8 = 0; c8 < 8; ++c8) { const u32x4 v = *(const LAS u32x4*)(L + MG_QS + qi * 144 + c8 * 16);
#pragma unroll
            for (int e = 0; e < 4; ++e) { qv[c8 * 8 + 2 * e] = __uint_as_float(v[e] << 16); qv[c8 * 8 + 2 * e + 1] = __uint_as_float(v[e] & 0xffff0000u); } }
        float v1 = -INFINITY, v2 = -INFINITY, v3 = -INFINITY; int i1 = -1, i2 = -1, i3 = -1;
        for (int n = par; n < c; n += 2) { float g0 = 0.f, g1 = 0.f, g2 = 0.f, g3 = 0.f;
#pragma unroll
            for (int d4 = 0; d4 < 16; ++d4) { const f32x4 kb = *(const LAS f32x4*)(KB + n * 64 + d4 * 4); g0 += qv[4 * d4] * kb.x; g1 += qv[4 * d4 + 1] * kb.y; g2 += qv[4 * d4 + 2] * kb.z; g3 += qv[4 * d4 + 3] * kb.w; }
            const float g = (g0 + g1) + (g2 + g3);
            if (g > v1) { v3 = v2; i3 = i2; v2 = v1; i2 = i1; v1 = g; i1 = n; } else if (g > v2) { v3 = v2; i3 = i2; v2 = g; i2 = n; } else if (g > v3) { v3 = g; i3 = n; } }
        LAS float* TP = (LAS float*)(L + MG_TOP);
        if (par == 1) { TP[qi * 6 + 0] = v1; TP[qi * 6 + 1] = v2; TP[qi * 6 + 2] = v3; TP[qi * 6 + 3] = __int_as_float(i1); TP[qi * 6 + 4] = __int_as_float(i2); TP[qi * 6 + 5] = __int_as_float(i3); }
        __syncthreads();
        if (par == 0) {
#pragma unroll
            for (int k = 0; k < 3; ++k) { const float g = TP[qi * 6 + k]; const int n = __float_as_int(TP[qi * 6 + 3 + k]);
                if (n >= 0) { const bool b1 = g > v1 || (g == v1 && n < i1), b2 = g > v2 || (g == v2 && n < i2), b3 = g > v3 || (g == v3 && n < i3);
                    if (b1) { v3 = v2; i3 = i2; v2 = v1; i2 = i1; v1 = g; i1 = n; } else if (b2) { v3 = v2; i3 = i2; v2 = g; i2 = n; } else if (b3) { v3 = g; i3 = n; } } }
            const unsigned s4 = (unsigned)(i1 & 255) | ((unsigned)(i2 & 255) << 8) | ((unsigned)(i3 & 255) << 16) | 0xff000000u;
            SEL[qi] = s4; SELG[(size_t)(q0 + qi) * 4 + h] = s4;
        }
    }
    __syncthreads();
    for (int n = wave; n < c; n += 8) { int base = 0; unsigned char* lp = LISTG + ((size_t)(bh * 32 + c) * 32 + n) * 256;
#pragma unroll
        for (int ck = 0; ck < 4; ++ck) { const int q = ck * 64 + lane; const unsigned s4 = SEL[q]; const bool f = (s4 & 255u) == (unsigned)n || ((s4 >> 8) & 255u) == (unsigned)n || ((s4 >> 16) & 255u) == (unsigned)n;
            const unsigned long long bal = __ballot(f); const int pos = base + __popcll(bal & ((1ull << lane) - 1ull)); if (f) lp[pos] = (unsigned char)q; base += __popcll(bal); }
        if (lane == 0) CNTG[(bh * 32 + c) * 32 + n] = base; }
}
constexpr int KV_KL = 0, KV_VL = 36864, KV_PRE = KV_VL + 64 * 528;
DI void kv_tile(const LAS unsigned char* KL, const LAS unsigned char* VL, const bf16x8 (&qf)[2], int nsteps, bool causal, int qloc, int fr, int fq, f32x4 (&O)[4], float& m_out, float& l_out) {
    const float sc2 = 0.125f * 1.44269504089f;
    f32x4 s[16];
    const LAS unsigned char* kr0 = KL + (8 * (fr >> 2) + (fr & 3)) * 144 + fq * 16;
#pragma unroll
    for (int s8 = 0; s8 < 8; ++s8)
#pragma unroll
        for (int j = 0; j < 2; ++j) { f32x4 acc = (f32x4){0.f, 0.f, 0.f, 0.f};
#pragma unroll
            for (int ks = 0; ks < 2; ++ks) { const bf16x8 a = *(const LAS bf16x8*)(kr0 + (32 * s8 + 4 * j) * 144 + 64 * ks); acc = MFMA16(a, qf[ks], acc); }
            s[2 * s8 + j] = (s8 < nsteps) ? acc : (f32x4){-INFINITY, -INFINITY, -INFINITY, -INFINITY}; }
    if (causal) {
#pragma unroll
        for (int t = 0; t < 16; ++t)
#pragma unroll
            for (int r = 0; r < 4; ++r) { const int key = 32 * (t >> 1) + 8 * fq + 4 * (t & 1) + r; s[t][r] = key <= qloc ? s[t][r] : -INFINITY; } }
    float m = -INFINITY;
#pragma unroll
    for (int t = 0; t < 16; ++t) m = fmaxf(m, fmaxf(fmaxf(s[t][0], s[t][1]), fmaxf(s[t][2], s[t][3])));
    m = fmaxf(m, __shfl_xor(m, 16)); m = fmaxf(m, __shfl_xor(m, 32));
    const float mb = -m * sc2; float l = 0.f;
#pragma unroll
    for (int t = 0; t < 16; ++t)
#pragma unroll
        for (int r = 0; r < 4; ++r) { const float p = __builtin_amdgcn_exp2f(fmaf(s[t][r], sc2, mb)); s[t][r] = p; l += p; }
    l += __shfl_xor(l, 16); l += __shfl_xor(l, 32);
#pragma unroll
    for (int dt = 0; dt < 4; ++dt) O[dt] = (f32x4){0.f, 0.f, 0.f, 0.f};
    const LAS unsigned char* vr0 = VL + fr * 528 + fq * 16;
#pragma unroll
    for (int s8 = 0; s8 < 8; ++s8) {
        u32x4 pw; pw.x = cvt_pk_bf16(s[2 * s8][0], s[2 * s8][1]); pw.y = cvt_pk_bf16(s[2 * s8][2], s[2 * s8][3]); pw.z = cvt_pk_bf16(s[2 * s8 + 1][0], s[2 * s8 + 1][1]); pw.w = cvt_pk_bf16(s[2 * s8 + 1][2], s[2 * s8 + 1][3]);
        const bf16x8 pb = __builtin_bit_cast(bf16x8, pw);
#pragma unroll
        for (int dt = 0; dt < 4; ++dt) { const bf16x8 a = *(const LAS bf16x8*)(vr0 + (16 * dt) * 528 + 64 * s8); O[dt] = MFMA16(a, pb, O[dt]); } }
    m_out = m; l_out = l;
}
DI void kv_store(bf16_t* OPG, float* MLG, size_t row, int h, int slot, const f32x4 (&O)[4], float m, float l, int fq) {
    const float inv = 1.0f / l; const size_t base = ((row * 4 + h) * 4 + slot);
#pragma unroll
    for (int dt = 0; dt < 4; ++dt) { u32x2 w; w.x = cvt_pk_bf16(O[dt][0] * inv, O[dt][1] * inv); w.y = cvt_pk_bf16(O[dt][2] * inv, O[dt][3] * inv); *(u32x2*)(OPG + base * 64 + 16 * dt + 4 * fq) = w; }
    if (fq == 0) { MLG[base * 2] = m; MLG[base * 2 + 1] = l; }
}
DI void moba_kv_unit(const Frame& F, const bf16_t* Pb, const bf16_t* VT, const unsigned* SELG, const unsigned char* LISTG, const int* CNTG, bf16_t* OPG, float* MLG, int bl, int h, int n, int part, int nparts) {
    int lane_ = F.lane; LAUNDER_V(lane_);
    const int lane = lane_, wave = F.wave, tid = wave * 64 + lane, fr = lane & 15, fq = lane >> 4;
    LAS unsigned char* L = F.lds; LAS int* PRE = (LAS int*)(L + KV_PRE);
    const int bh = bl * 4 + h;
    const bf16_t* Kg = Pb + (size_t)(bl * SEQ + n * 256) * PLD + PC_MK + h * 64;
    const bf16_t* Vg = VT + (size_t)(bh * 64) * SEQ + n * 256;
    const bf16_t* Qg = Pb + (size_t)(bl * SEQ) * PLD + PC_MQ + h * 64;
    __syncthreads();
#pragma unroll
    for (int i = 0; i < 4; ++i) { const int q = tid + 512 * i, r = q >> 3, c8 = q & 7; *(LAS u32x4*)(L + KV_KL + r * 144 + c8 * 16) = *(const u32x4*)(Kg + (size_t)r * PLD + c8 * 8); }
#pragma unroll
    for (int i = 0; i < 4; ++i) { const int q = tid + 512 * i, d = q >> 5, c16 = q & 31; *(LAS u32x4*)(L + KV_VL + d * 528 + c16 * 16) = *(const u32x4*)(Vg + (size_t)d * SEQ + c16 * 8); }
    if (wave == 0) {
        const int cq = lane; int cnt = (cq > n && cq < 32) ? CNTG[(bh * 32 + cq) * 32 + n] : 0; int inc = cnt;
#pragma unroll
        for (int o = 1; o < 32; o <<= 1) { const int up = __shfl_up(inc, o); if (lane >= o) inc += up; }
        if (lane < 32) PRE[lane] = inc - cnt; if (lane == 31) PRE[32] = inc;
    }
    __syncthreads();
    const int T = PRE[32], nsp = (T + 15) >> 4, ntl = nsp + 16;
    for (int tt = part + nparts * wave; tt < ntl; tt += nparts * 8) {
        f32x4 O[4]; float m, l; bf16x8 qf[2];
        if (tt < nsp) {
            const int e = 16 * tt + fr; const bool valid = e < T; const int ee = valid ? e : 0;
            int cq = 0;
#pragma unroll
            for (int i = 1; i < 32; ++i) cq += (PRE[i] <= ee) ? 1 : 0;
            const int q = LISTG[((size_t)(bh * 32 + cq) * 32 + n) * 256 + (ee - PRE[cq])];
            const int tok = cq * 256 + q; const size_t row = (size_t)(bl * SEQ + tok);
#pragma unroll
            for (int ks = 0; ks < 2; ++ks) qf[ks] = *(const bf16x8*)(Qg + (size_t)tok * PLD + fq * 8 + 32 * ks);
            kv_tile(L + KV_KL, L + KV_VL, qf, 8, false, 0, fr, fq, O, m, l);
            const unsigned s4 = SELG[row * 4 + h]; const int slot = (s4 & 255u) == (unsigned)n ? 0 : (((s4 >> 8) & 255u) == (unsigned)n ? 1 : 2);
            if (valid) kv_store(OPG, MLG, row, h, slot, O, m, l, fq);
        } else {
            const int to = tt - nsp, qloc = 16 * to + fr, tok = n * 256 + qloc; const size_t row = (size_t)(bl * SEQ + tok);
#pragma unroll
            for (int ks = 0; ks < 2; ++ks) qf[ks] = *(const bf16x8*)(Qg + (size_t)tok * PLD + fq * 8 + 32 * ks);
            kv_tile(L + KV_KL, L + KV_VL, qf, (16 * to + 15) / 32 + 1, true, qloc, fr, fq, O, m, l);
            kv_store(OPG, MLG, row, h, 3, O, m, l, fq);
        }
    }
}
DI void moba_combine(const Frame& F, const unsigned* SELG, const bf16_t* OPG, const float* MLG, bf16_t* BR) {
    int lane_ = F.lane; LAUNDER_V(lane_);
    const int lane = lane_, sub = lane & 7, gw = F.blk * 8 + F.wave, NGW = F.G * 8;
    const float sc2 = 0.125f * 1.44269504089f;
    for (int it = gw; it < NG * 4 / 8; it += NGW) { const size_t idx = (size_t)it * 8 + (lane >> 3); const size_t row = idx >> 2; const int h = (int)(idx & 3);
        const unsigned s4 = SELG[idx]; float mk[4], lk[4]; float M = -INFINITY;
#pragma unroll
        for (int k = 0; k < 4; ++k) { const bool ok = (k == 3) || (((s4 >> (8 * k)) & 255u) != 255u); const f32x2 ml = *(const f32x2*)(MLG + (idx * 4 + k) * 2); mk[k] = ok ? ml.x : -INFINITY; lk[k] = ok ? ml.y : 0.f; M = fmaxf(M, mk[k]); }
        float o[8]; float den = 0.f;
#pragma unroll
        for (int e = 0; e < 8; ++e) o[e] = 0.f;
#pragma unroll
        for (int k = 0; k < 4; ++k) { const bool ok = (k == 3) || (((s4 >> (8 * k)) & 255u) != 255u); const float w = ok ? lk[k] * __builtin_amdgcn_exp2f((mk[k] - M) * sc2) : 0.f; den += w;
            u32x4 pv = *(const u32x4*)(OPG + (idx * 4 + k) * 64 + sub * 8);
            if (!ok) pv = (u32x4){0u, 0u, 0u, 0u};
#pragma unroll
            for (int e = 0; e < 4; ++e) { o[2 * e] += w * __uint_as_float(pv[e] << 16); o[2 * e + 1] += w * __uint_as_float(pv[e] & 0xffff0000u); } }
        const float inv = 1.0f / den; u32x4 wv;
#pragma unroll
        for (int e = 0; e < 4; ++e) wv[e] = cvt_pk_bf16(o[2 * e] * inv, o[2 * e + 1] * inv);
        *(u32x4*)(BR + row * 1024 + 256 + h * 64 + sub * 8) = wv; }
}
__host__ __device__ constexpr int kv_parts(int n) { return n == 0 ? 3 : (n < 8 ? 2 : 1); }
__host__ __device__ constexpr int kv_items_before(int n) { int s = 0; for (int i = 0; i < n; ++i) s += kv_parts(i) * GB * 4; return s; }
constexpr int KV_NITEMS = kv_items_before(32);

constexpr int XA_K = 0;
constexpr int XA_VT = 69632;
DI void xattn_wg(const Frame& F, const bf16_t* KVM, const bf16_t* QX, bf16_t* AO, int w) {
    int lane_ = F.lane; LAUNDER_V(lane_);
    const int lane = lane_, wave = F.wave, tid = wave * 64 + lane, fr = lane & 15, fq = lane >> 4;
    const int b = w >> 5, h = (w >> 3) & 3, qpart = w & 7;
    LAS unsigned char* L = F.lds;
    __syncthreads();
#pragma unroll
    for (int i = 0; i < 8; ++i) { const int q = tid + 512 * i, m = q >> 4, c16 = q & 15; *(LAS u32x4*)(L + XA_K + m * 272 + c16 * 16) = *(const u32x4*)(KVM + (size_t)(b * 256 + m) * 1024 + h * 128 + c16 * 8); }
#pragma unroll
    for (int i = 0; i < 8; ++i) { const int q = tid + 512 * i, m = q & 255, c16 = q >> 8; const u32x4 v = *(const u32x4*)(KVM + (size_t)(b * 256 + m) * 1024 + 512 + h * 128 + c16 * 8);
#pragma unroll
        for (int e = 0; e < 4; ++e) { *(LAS bf16_t*)(L + XA_VT + (c16 * 8 + 2 * e) * 528 + m * 2) = (bf16_t)(v[e] & 0xffffu); *(LAS bf16_t*)(L + XA_VT + (c16 * 8 + 2 * e + 1) * 528 + m * 2) = (bf16_t)(v[e] >> 16); } }
    __syncthreads();
    const float sc2 = 0.08838834764831845f * 1.44269504089f;
    for (int rtile = 0; rtile < 8; ++rtile) {
        const size_t tok = (size_t)b * SEQ + qpart * 1024 + wave * 128 + rtile * 16 + fr;
        bf16x8 qf[4];
#pragma unroll
        for (int ks = 0; ks < 4; ++ks) qf[ks] = *(const bf16x8*)(QX + tok * 512 + h * 128 + fq * 8 + 32 * ks);
        f32x4 s[16]; float mx = -INFINITY;
#pragma unroll
        for (int kt = 0; kt < 16; ++kt) { s[kt] = (f32x4){0.f, 0.f, 0.f, 0.f};
#pragma unroll
            for (int ks = 0; ks < 4; ++ks) { const bf16x8 a = *(const LAS bf16x8*)(L + XA_K + (16 * kt + fr) * 272 + (fq * 8 + 32 * ks) * 2); s[kt] = MFMA16(a, qf[ks], s[kt]); }
            mx = fmaxf(mx, fmaxf(fmaxf(s[kt][0], s[kt][1]), fmaxf(s[kt][2], s[kt][3]))); __builtin_amdgcn_sched_barrier(0); }
        mx = fmaxf(mx, __shfl_xor(mx, 16)); mx = fmaxf(mx, __shfl_xor(mx, 32));
        float l = 0.f;
#pragma unroll
        for (int kt = 0; kt < 16; ++kt)
#pragma unroll
            for (int r = 0; r < 4; ++r) { const float p = __builtin_amdgcn_exp2f((s[kt][r] - mx) * sc2); s[kt][r] = p; l += p; }
        l += __shfl_xor(l, 16); l += __shfl_xor(l, 32); const float inv = 1.0f / l;
        f32x4 O[8];
#pragma unroll
        for (int dt = 0; dt < 8; ++dt) O[dt] = (f32x4){0.f, 0.f, 0.f, 0.f};
#pragma unroll
        for (int s8 = 0; s8 < 8; ++s8) {
            u32x4 pw; pw.x = pk2(s[2 * s8][0], s[2 * s8][1]); pw.y = pk2(s[2 * s8][2], s[2 * s8][3]); pw.z = pk2(s[2 * s8 + 1][0], s[2 * s8 + 1][1]); pw.w = pk2(s[2 * s8 + 1][2], s[2 * s8 + 1][3]);
            const bf16x8 pb = __builtin_bit_cast(bf16x8, pw);
#pragma unroll
            for (int dt = 0; dt < 8; ++dt) {
                const u32x2 lo = *(const LAS u32x2*)(L + XA_VT + (16 * dt + fr) * 528 + (32 * s8 + 4 * fq) * 2), hi = *(const LAS u32x2*)(L + XA_VT + (16 * dt + fr) * 528 + (32 * s8 + 16 + 4 * fq) * 2);
                const u32x4 av = (u32x4){lo.x, lo.y, hi.x, hi.y};
                O[dt] = MFMA16(__builtin_bit_cast(bf16x8, av), pb, O[dt]); }
            __builtin_amdgcn_sched_barrier(0);
        }
#pragma unroll
        for (int dt = 0; dt < 8; ++dt) { u32x2 wv; wv.x = pk2(O[dt][0] * inv, O[dt][1] * inv); wv.y = pk2(O[dt][2] * inv, O[dt][3] * inv);
            *(u32x2*)(AO + tok * 512 + h * 128 + 16 * dt + 4 * fq) = wv; }
    }
    __syncthreads();
}
DI void moe_route1(const Frame& F, const bf16_t* x, const float* Wr, const float* ssqp, int* TE, float* TW, float* RR, int* CNT) {
    int lane_ = F.lane; LAUNDER_V(lane_);
    const int lane = lane_, wave = F.wave, tid = wave * 64 + lane;
    constexpr int WP = 2064;
    LAS float* LG = (LAS float*)(F.lds + 16 * WP) + wave * 16 * 17;
    LAS int* HC = (LAS int*)(F.lds + 16 * WP + 8 * 16 * 17 * 4);
    __syncthreads();
    { const int e = tid >> 6, k0 = (tid & 63) * 16; f32x4 w[4];
#pragma unroll
      for (int i = 0; i < 4; ++i) w[i] = *(const f32x4*)(Wr + (size_t)e * 1024 + k0 + 4 * i);
      unsigned hi[8], lo[8];
#pragma unroll
      for (int i = 0; i < 4; ++i)
#pragma unroll
          for (int j = 0; j < 2; ++j) { const float a = w[i][2 * j], b = w[i][2 * j + 1]; const unsigned ha = f2bf(a), hb = f2bf(b);
              hi[2 * i + j] = ha | (hb << 16); lo[2 * i + j] = pk2(a - __uint_as_float(ha << 16), b - __uint_as_float(hb << 16)); }
      *(LAS u32x4*)(F.lds + e * WP + k0 * 2) = (u32x4){hi[0], hi[1], hi[2], hi[3]}; *(LAS u32x4*)(F.lds + e * WP + k0 * 2 + 16) = (u32x4){hi[4], hi[5], hi[6], hi[7]};
      *(LAS u32x4*)(F.lds + (8 + e) * WP + k0 * 2) = (u32x4){lo[0], lo[1], lo[2], lo[3]}; *(LAS u32x4*)(F.lds + (8 + e) * WP + k0 * 2 + 16) = (u32x4){lo[4], lo[5], lo[6], lo[7]}; }
    for (int tb = F.blk; tb < NTOK / 256; tb += F.G) {
        if (tid < 8) HC[tid] = 0;
        __syncthreads();
        for (int tt = 0; tt < 2; ++tt) {
            const int row0 = tb * 256 + wave * 32 + tt * 16; f32x4 acc = (f32x4){0.f, 0.f, 0.f, 0.f};
            const bf16_t* ap = x + (size_t)(row0 + (lane & 15)) * 1024 + (lane >> 4) * 8; const LAS unsigned char* bp = F.lds + (lane & 15) * WP + (lane >> 4) * 16;
            bf16x8 a[32];
#pragma unroll
            for (int ks = 0; ks < 32; ++ks) a[ks] = *(const bf16x8*)(ap + 32 * ks);
            float rs[4];
#pragma unroll
            for (int i = 0; i < 4; ++i) rs[i] = row_rstd(ssqp, row0 + 4 * (lane >> 4) + i);
            __builtin_amdgcn_sched_barrier(0);
#pragma unroll
            for (int ks = 0; ks < 32; ++ks) { const bf16x8 b = *(const LAS bf16x8*)(bp + 64 * ks); acc = MFMA16(a[ks], b, acc); }
#pragma unroll
            for (int i = 0; i < 4; ++i) LG[(4 * (lane >> 4) + i) * 17 + (lane & 15)] = acc[i] * rs[i];
            LDS_WAIT();
            if (lane < 16) { const int row = row0 + lane; float lg[8];
#pragma unroll
                for (int e = 0; e < 8; ++e) lg[e] = LG[lane * 17 + e] + LG[lane * 17 + 8 + e];
                int e0 = 0; float l0 = lg[0];
#pragma unroll
                for (int e = 1; e < 8; ++e) if (lg[e] > l0) { l0 = lg[e]; e0 = e; }
                int e1 = -1; float l1 = -INFINITY;
#pragma unroll
                for (int e = 0; e < 8; ++e) if (e != e0 && lg[e] > l1) { l1 = lg[e]; e1 = e; }
                const float w0 = 1.0f / (1.0f + __expf(l1 - l0));
                TE[2 * (size_t)row] = e0; TE[2 * (size_t)row + 1] = e1; TW[2 * (size_t)row] = w0; TW[2 * (size_t)row + 1] = 1.0f - w0; RR[row] = row_rstd(ssqp, row);
                __hip_atomic_fetch_add(&HC[e0], 1, __ATOMIC_RELAXED, __HIP_MEMORY_SCOPE_WORKGROUP); __hip_atomic_fetch_add(&HC[e1], 1, __ATOMIC_RELAXED, __HIP_MEMORY_SCOPE_WORKGROUP); }
            LDS_WAIT();
        }
        __syncthreads();
        if (tid < 8) CNT[tb * 8 + tid] = HC[tid];
        __syncthreads();
    }
}
DI void moe_bases(const Frame& F, const int* CNT, int tb, LAS int* OUT  ) {
    const int tid = F.tid; LAS int* SC = (LAS int*)(F.lds + 40960);
    __syncthreads();
    { const int e = tid & 7, seg = tid >> 3; int all = 0, lt = 0;
#pragma unroll
      for (int q = 0; q < 4; ++q) { const int w = 4 * seg + q; const int c = CNT[w * 8 + e]; all += c; lt += (w < tb) ? c : 0; }
      SC[seg * 8 + e] = all; SC[512 + seg * 8 + e] = lt; }
    __syncthreads();
    if (tid < 8) { int all = 0, lt = 0; for (int s = 0; s < 64; ++s) { all += SC[s * 8 + tid]; lt += SC[512 + s * 8 + tid]; } SC[1024 + tid] = (all + 255) >> 8; OUT[16 + tid] = lt; }
    __syncthreads();
    if (tid == 0) { int b = 0; for (int e = 0; e < 8; ++e) { OUT[e] = b; b += SC[1024 + e]; } OUT[8] = b; }
    __syncthreads();
}
DI void moe_route2(const Frame& F, const int* TE, const float* RR, const int* CNT, const bf16_t* xb, int* POS, bf16_t* XP, float* RP) {
    const int tid = F.tid, lane = F.lane, wave = F.wave;
    LAS int* MB = (LAS int*)(F.lds + 49152);
    LAS int* WT = (LAS int*)(F.lds + 49152 + 256);
    LAS int* PL = (LAS int*)(F.lds + 49152 + 512);
    for (int tb = F.blk; tb < NTOK / 256; tb += F.G) {
        moe_bases(F, CNT, tb, MB);
        int e0 = -1, e1 = -1; const int tok = tb * 256 + tid;
        if (tid < 256) { e0 = TE[2 * (size_t)tok]; e1 = TE[2 * (size_t)tok + 1]; }
        int pw[2] = {0, 0};
#pragma unroll
        for (int e = 0; e < 8; ++e) { const bool f = (e0 == e) || (e1 == e); const unsigned long long bal = __ballot(f);
            const int before = __popcll(bal & ((1ull << lane) - 1ull)); if (lane == 0 && wave < 4) WT[wave * 8 + e] = __popcll(bal);
            if (e0 == e) pw[0] = before; if (e1 == e) pw[1] = before; }
        __syncthreads();
        if (tid < 256) {
#pragma unroll
            for (int sl = 0; sl < 2; ++sl) { const int e = sl ? e1 : e0; int rank = pw[sl]; for (int w2 = 0; w2 < wave; ++w2) rank += WT[w2 * 8 + e];
                const int pos = MB[e] * 256 + MB[16 + e] + rank; PL[2 * tid + sl] = pos; POS[2 * (size_t)tok + sl] = pos; RP[pos] = RR[tok]; } }
        __syncthreads();
        for (int pr0 = wave * 64; pr0 < wave * 64 + 64; pr0 += 8) { u32x4 ra[8], rb[8];
#pragma unroll
            for (int q = 0; q < 8; ++q) { const int t2 = (pr0 + q) >> 1; const u32x4* src = (const u32x4*)(xb + (size_t)(tb * 256 + t2) * 1024); ra[q] = src[lane]; rb[q] = src[lane + 64]; }
#pragma unroll
            for (int q = 0; q < 8; ++q) { const int pos = PL[pr0 + q]; u32x4* dst = (u32x4*)(XP + (size_t)pos * 1024); dst[lane] = ra[q]; dst[lane + 64] = rb[q]; } }
        __syncthreads();
    }
}
DI void moe_final(const Frame& F, const bf16_t* xb, float* out, const bf16_t* Y, const int* POS, const float* TW, const float* fg) {
    const int lane = F.lane, gw = F.blk * 8 + F.wave, NGW = F.G * 8;
    int pn0 = 0, pn1 = 0; float wn0 = 0.f, wn1 = 0.f;
    if (gw < NTOK) { pn0 = POS[2 * (size_t)gw]; pn1 = POS[2 * (size_t)gw + 1]; wn0 = TW[2 * (size_t)gw]; wn1 = TW[2 * (size_t)gw + 1]; }
    for (int row = gw; row < NTOK; row += NGW) {
        const int p0 = pn0, p1 = pn1; const float w0 = wn0, w1 = wn1;
        { const size_t rn = (size_t)(row + NGW < NTOK ? row + NGW : row); pn0 = POS[2 * rn]; pn1 = POS[2 * rn + 1]; wn0 = TW[2 * rn]; wn1 = TW[2 * rn + 1]; }
        f32x4* xr = (f32x4*)(out + (size_t)row * 1024) + lane; const u32x2* xs = (const u32x2*)(xb + (size_t)row * 1024) + lane; const u32x2* y0 = (const u32x2*)(Y + (size_t)p0 * 1024) + lane; const u32x2* y1 = (const u32x2*)(Y + (size_t)p1 * 1024) + lane;
        f32x4 v[4]; float ss = 0.f; u32x2 ya[4], yb[4];
#pragma unroll
        for (int j = 0; j < 4; ++j) { const u32x2 xv = xs[64 * j]; v[j] = (f32x4){__uint_as_float(xv.x << 16), __uint_as_float(xv.x & 0xffff0000u), __uint_as_float(xv.y << 16), __uint_as_float(xv.y & 0xffff0000u)}; ya[j] = y0[64 * j]; yb[j] = y1[64 * j]; }
#pragma unroll
        for (int j = 0; j < 4; ++j) { const u32x2 a = ya[j], b = yb[j];
            v[j].x += w0 * __uint_as_float(a.x << 16) + w1 * __uint_as_float(b.x << 16); v[j].y += w0 * __uint_as_float(a.x & 0xffff0000u) + w1 * __uint_as_float(b.x & 0xffff0000u);
            v[j].z += w0 * __uint_as_float(a.y << 16) + w1 * __uint_as_float(b.y << 16); v[j].w += w0 * __uint_as_float(a.y & 0xffff0000u) + w1 * __uint_as_float(b.y & 0xffff0000u);
            ss += (v[j].x * v[j].x + v[j].y * v[j].y) + (v[j].z * v[j].z + v[j].w * v[j].w); }
        ss = wave_sum(ss); const float r = rsqrtf(ss * (1.0f / 1024.0f) + RMS_EPS);
#pragma unroll
        for (int j = 0; j < 4; ++j) { const f32x4 g = ((const f32x4*)fg)[lane + 64 * j]; xr[64 * j] = (f32x4){v[j].x * r * g.x, v[j].y * r * g.y, v[j].z * r * g.z, v[j].w * r * g.w}; }
    }
}
constexpr int SCAN_CUT = 32;
__global__ void __launch_bounds__(512, 2) mk_fwd(Params prm) {
    extern __shared__ __attribute__((aligned(16))) unsigned char lds_raw[];
    Frame F0;
    F0.lds = (LAS unsigned char*)lds_raw;
    F0.tid = threadIdx.x; F0.lane = F0.tid & 63; F0.wave = __builtin_amdgcn_readfirstlane(F0.tid >> 6); F0.G = gridDim.x; F0.blk = blockIdx.x;
    F0.ws = prm.ws;
    volatile LAS unsigned* MISC = (volatile LAS unsigned*)(F0.lds + LDS_MISC);
    if (F0.tid < 64) MISC[F0.tid] = 0u;
    __syncthreads();
    XcdBarrier bar; bar.bar = (unsigned*)(prm.ws + WS_CTL); bar.x = 0; bar.st = MISC;
#if MK_SINGLE
    bar = xcd_barrier_post((unsigned*)(prm.ws + WS_CTL), MISC);
#endif
    const int lo = prm.ph_lo, hi = prm.ph_hi; int ph = 0;
#ifndef DBG_REP_CLASS
#define DBG_REP_CLASS 0
#endif
#ifndef DBG_RBA
#define DBG_RBA 1
#endif
#ifndef DBG_RCMB
#define DBG_RCMB 1
#endif
#ifndef DBG_ROUT
#define DBG_ROUT 1
#endif
#ifndef DBG_RFIN
#define DBG_RFIN 1
#endif
#define REPEAT(cls) for (int rep_ = 0; rep_ < ((DBG_REP_CLASS == (cls)) ? 2 : 1); ++rep_)
#define REPBAR(cls) do { if (DBG_REP_CLASS == (cls) && rep_ == 0) xcd_barrier(bar); } while (0)
#define ACTIVE() (ph >= lo && ph < hi)
#define SEAM() do { if (ph + 1 < hi) xcd_barrier(bar); } while (0)
    LAS unsigned char* glds = F0.lds;
#define PTRS() unsigned char* ws = prm.ws; asm volatile("" : "+s"(ws)); Frame F = F0; { int w_ = F0.wave; asm volatile("" : "+s"(w_)); int l_ = (int)__builtin_amdgcn_mbcnt_hi(~0u, __builtin_amdgcn_mbcnt_lo(~0u, 0u)); asm volatile("" : "+v"(l_)); F.wave = w_; F.lane = l_; F.tid = w_ * 64 + l_; } F.ws = ws; unsigned char* ar = ws + WS_ARENA; (void)ar; \
    bf16_t* xb = (bf16_t*)(ws + WS_XB); float* ssq = (float*)(ws + WS_SSQ); const float* rope = (const float*)(ws + WS_ROPE); float* xout = prm.out; (void)xb; (void)ssq; (void)rope; (void)xout; \
    unsigned char* lw = ws + WS_LW + (size_t)layer * LW_STRIDE; (void)lw; const float* sm = (const float*)(ws + WS_SMALL); (void)sm
#define GPTRS() PTRS(); const bf16_t* xbg = xb + (size_t)grp * NG * 1024; const float* ssqg = ssq + (size_t)grp * NG * 16; const float* ropeg = rope + (size_t)grp * NG * 16; \
    bf16_t* Pb = (bf16_t*)(ar + AR_P); float* BA = (float*)(ar + AR_BA); bf16_t* BR = (bf16_t*)(ar + AR_BR); float* KBAR = (float*)(ar + AR_KBAR); bf16_t* VT = (bf16_t*)(ar + AR_VT); \
    bf16_t* QD = (bf16_t*)(ar + AR_QD); bf16_t* MM = (bf16_t*)(ar + AR_KDT); bf16_t* NT = (bf16_t*)(ar + AR_NT); bf16_t* SG = (bf16_t*)(ar + AR_SG); bf16_t* ZB = (bf16_t*)(ar + AR_ZB); unsigned* SELG = (unsigned*)(ar + AR_SELG); int* CNTG = (int*)(ar + AR_CNTG); unsigned char* LISTG = (unsigned char*)(ar + AR_LISTG); bf16_t* OPG = (bf16_t*)(ar + AR_OPG); float* MLG = (float*)(ar + AR_MLG); bf16_t* WN = (bf16_t*)(ar + AR_WN); bf16_t* UT = (bf16_t*)(ar + AR_UT); bf16_t* AQK = (bf16_t*)(ar + AR_AQK); float* GL = (float*)(ar + AR_GL); \
    bf16_t* MG = (bf16_t*)(ar + AR_MERGED); \
    (void)xbg; (void)ssqg; (void)ropeg; (void)Pb; (void)BA; (void)BR; (void)KBAR; (void)VT; (void)QD; (void)MM; (void)NT; (void)SG; (void)ZB; (void)SELG; (void)CNTG; (void)LISTG; (void)OPG; (void)MLG; (void)WN; (void)UT; (void)AQK; (void)GL; (void)MG
#define MPTRS() PTRS(); int* TE = (int*)(ar + AR_TE); float* TW = (float*)(ar + AR_TW); float* RR = (float*)(ar + AR_RR); int* POS = (int*)(ar + AR_POS); int* CNT = (int*)(ar + AR_CNT); \
    bf16_t* XP = (bf16_t*)(ar + AR_XP); float* RP = (float*)(ar + AR_RP); bf16_t* HM = (bf16_t*)(ar + AR_HM); (void)TE; (void)TW; (void)RR; (void)POS; (void)CNT; (void)XP; (void)RP; (void)HM

    if (ACTIVE()) { REPEAT(1) { const int layer = 0; PTRS();
        const __attribute__((address_space(4))) Params* kp = (const __attribute__((address_space(4))) Params*)__builtin_amdgcn_kernarg_segment_ptr(); asm volatile("" : "+s"(kp));
        Params lp;
#pragma unroll
        for (int i = 0; i < 27; ++i) lp.in[i] = kp->in[i];
        lp.out = nullptr; lp.ws = ws; lp.ph_lo = 0; lp.ph_hi = 0; lp.pad0 = 0; lp.pad1 = 0;
        phase_prologue(F, lp); REPBAR(1); } SEAM(); } ++ph;
    for (int layer = 0; layer < 2; ++layer) {
        for (int grp = 0; grp < NGRP; ++grp) {
            if (ACTIVE()) { REPEAT(3) {
                GPTRS();
                pg8::Gemm g{xbg, (const bf16_t*)(lw + LW_WIN), 1024, 1024};
                pg8::SchedPlain S; S.init(NG, 3072, 1024, 1024, 1024, F.G, F.blk);
                pg8::build_rtab(glds, S, ssqg, nullptr, F.tid);
                pg8::EpiScaleBf16 E{Pb, PLD, ssqg, 0, ZB, 512, 10, (const LAS float*)(glds + pg8::RTAB_OFF)};
                pg8::gemm_phase(glds, g, S, E, F.wave);
                for (int rq_ = 0; rq_ < DBG_RBA; ++rq_) ba_tiles(F, xbg, (const bf16_t*)(lw + LW_WBA), ssqg, BA);
                REPBAR(3); }
                SEAM();
            } ++ph;
            if (ACTIVE()) {
                GPTRS();
                REPEAT(4) {
                __syncthreads();
                if (F.tid < 64) ((LAS unsigned*)(F.lds + DN_PCNT))[F.tid] = 0u;
                __syncthreads();
                { unsigned pgen = 0u;
#ifdef DBG_STAGGER
                if (F.wave >= 4) { for (int z_ = 0; z_ < DBG_STAGGER; ++z_) __builtin_amdgcn_s_sleep(127); }
#endif
                for (int u = F.blk; u < 1024; u += F.G)
                    prep_dn(F, Pb, BA, sm + SM_CONVW + (size_t)layer * 4 * 1536, sm + SM_ALOG + layer * 8, sm + SM_DTB + layer * 8, QD, MM, NT, WN, UT, AQK, GL, u, pgen); }
                __syncthreads();
#ifndef DBG_RPOOL
#define DBG_RPOOL 1
#endif
                for (int rpP = 0; rpP < DBG_RPOOL; ++rpP) for (int u = F.blk; u < NG / 128; u += F.G) prep_pool(F, Pb, BR, u);
                REPBAR(4); }
#ifndef DBG_RMOBA
#define DBG_RMOBA 1
#endif
                for (int rpM = 0; rpM < DBG_RMOBA; ++rpM) for (int u = F.blk; u < GB * 64; u += F.G) prep_moba(F, Pb, ropeg, KBAR, VT, u);
                SEAM();
            } ++ph;
            if (ACTIVE()) { REPEAT(18) {
                GPTRS();
                if (F.blk < GB * 8) { if (MK_SINGLE) dn_scan(F, F.blk, MM, NT, SG, 0, SCAN_CUT); }
                else { const int nw = F.G - GB * 8;
                    for (int u = F.blk - GB * 8; u < GB * 4 * 32; u += nw) { const int c = 31 - u / (GB * 4), bh = u % (GB * 4); moba_gate_unit(F, Pb, KBAR, SELG, LISTG, CNTG, bh >> 2, bh & 3, c); } }
                REPBAR(18); }
                SEAM();
            } ++ph;
            if (ACTIVE()) { REPEAT(5) {
                GPTRS();
                if (F.blk < GB * 8) { for (int r2_ = 0; r2_ < ((DBG_REP_CLASS == 16) ? 2 : 1); ++r2_) dn_scan(F, F.blk, MM, NT, SG, MK_SINGLE ? SCAN_CUT : 0, 127, r2_ == 0); }
                else { const int nw = F.G - GB * 8, wq = F.blk - GB * 8;
                    for (int r2_ = 0; r2_ < ((DBG_REP_CLASS == 17) ? 2 : 1); ++r2_)
                    for (int rd = 0; rd * nw < KV_NITEMS; ++rd) { const int i = rd * nw + ((rd & 1) ? nw - 1 - wq : wq); if (i >= KV_NITEMS) continue;
                        int n, part, bh;
                        if (i < 48) { n = 0; part = i >> 4; bh = i & 15; } else if (i < 272) { const int j = i - 48; n = 1 + (j >> 5); part = (j >> 4) & 1; bh = j & 15; } else { const int j = i - 272; n = 8 + (j >> 4); part = 0; bh = j & 15; }
                        moba_kv_unit(F, Pb, VT, SELG, LISTG, CNTG, OPG, MLG, bh >> 2, bh & 3, n, part, n == 0 ? 3 : (n < 8 ? 2 : 1)); } }
                if (layer == 0 && grp == 0) {
                    __syncthreads();
                    pg8::Gemm gk{(const bf16_t*)(ws + WS_MEMN), (const bf16_t*)(ws + WS_LW + LW_WKV), 1024, 1024};
                    pg8::SchedKV Sk; Sk.c = F.blk - GB * 8; Sk.lstride = LW_STRIDE;
                    pg8::EpiScaleBf16 Ek{(bf16_t*)(ws + WS_KVM), 1024, nullptr, 0, nullptr, 0, 1 << 30, nullptr};
                    pg8::gemm_phase(glds, gk, Sk, Ek, F.wave); }
                REPBAR(5); }
                SEAM();
            } ++ph;
            if (ACTIVE()) { REPEAT(6) {
                GPTRS();
                pg8::Gemm g{(const bf16_t*)(ws + WS_X8 + (size_t)grp * NG * 1024), (const bf16_t*)(ws + WS_WG8 + (size_t)layer * 3072 * 1024), 1024, 1024};
                pg8::SchedPlain S; S.init(NG, 3072, 1024, 1024, 1024, F.G, F.blk, 1);
                for (int rq_ = 0; rq_ < DBG_RCMB; ++rq_) moba_combine(F, SELG, OPG, MLG, BR);
                for (int rq_ = 0; rq_ < DBG_ROUT; ++rq_) dn_out_pass(F, QD, WN, UT, AQK, SG, ZB, sm + SM_DNG + layer * 64, BR);
                pg8::build_rtab(glds, S, ssqg, nullptr, F.tid);
                pg8::EpiScaleBf16 E{Pb, PLD, ssqg, 1, nullptr, 0, 1 << 30, (const LAS float*)(glds + pg8::RTAB_OFF)};
                pg8::gemm_phase<pg8::EpiScaleBf16, pg8::SchedPlain, true>(glds, g, S, E, F.wave);
                REPBAR(6); }
                SEAM();
            } ++ph;
            if (ACTIVE()) { REPEAT(7) {
                GPTRS();
                pg8::Gemm g{BR, (const bf16_t*)(lw + LW_WCAT), 1024, 1024};
                pg8::SchedPlain S; S.init(NG, 1024, 1024, 1024, 1024, F.G, F.blk);
                pg8::EpiMerge E{Pb, MG};
                pg8::gemm_phase(glds, g, S, E, F.wave);
                REPBAR(7); }
                SEAM();
            } ++ph;
            if (ACTIVE()) { for (int rep_ = 0; rep_ < ((DBG_REP_CLASS == 8 && layer == 0) ? 2 : 1); ++rep_) {
                GPTRS();
                pg8::Gemm g{MG, (const bf16_t*)(lw + LW_WOUT), 1024, 1024};
                pg8::SchedPlain S; S.init(NG, 1024, 1024, 1024, 1024, F.G, F.blk);
                pg8::EpiResid E{xb + (size_t)grp * NG * 1024, ssq + (size_t)grp * NG * 16, ws + WS_X8 + (size_t)grp * NG * 1024};
                pg8::gemm_phase(glds, g, S, E, F.wave);
                REPBAR(8); }
                SEAM();
            } ++ph;
        }
        if (ACTIVE()) { REPEAT(9) {
            PTRS();
            pg8::Gemm g{xb, (const bf16_t*)(lw + LW_WQ), 1024, 1024};
            pg8::SchedPlain S; S.init(NTOK, 512, 1024, 1024, 1024, F.G, F.blk);
            pg8::build_rtab(glds, S, ssq, nullptr, F.tid);
            pg8::EpiScaleBf16 E{(bf16_t*)(ar + AR_QX), 512, ssq, 0, nullptr, 0, 1 << 30, (const LAS float*)(glds + pg8::RTAB_OFF)};
            pg8::gemm_phase(glds, g, S, E, F.wave);
            REPBAR(9); }
                SEAM();
        } ++ph;
        if (ACTIVE()) { REPEAT(10) {
            PTRS();
            for (int w = F.blk; w < 256; w += F.G) xattn_wg(F, (const bf16_t*)(ws + WS_KVM) + (size_t)layer * 2048 * 1024, (const bf16_t*)(ar + AR_QX), (bf16_t*)(ar + AR_AO), w);
            REPBAR(10); }
                SEAM();
        } ++ph;
        if (ACTIVE()) {
            PTRS();
            pg8::Gemm g{(const bf16_t*)(ar + AR_AO), (const bf16_t*)(lw + LW_WO), 512, 512};
            pg8::SchedPlain S; S.init(NTOK, 1024, 512, 512, 512, F.G, F.blk);
            pg8::EpiResid E{xb, ssq, ws + WS_X8};
            pg8::gemm_phase(glds, g, S, E, F.wave);
            SEAM();
        } ++ph;
        if (layer == 0) {
            if (ACTIVE()) { REPEAT(11) {
                PTRS();
                pg8::Gemm g{xb, (const bf16_t*)(ws + WS_WGU), 1024, 1024};
                pg8::SchedPlain S; S.init(NTOK, 2 * FF, 1024, 1024, 1024, F.G, F.blk);
                pg8::build_rtab(glds, S, ssq, nullptr, F.tid);
                pg8::EpiSwiglu E{(bf16_t*)(ar + AR_HID), FF, (const LAS float*)(glds + pg8::RTAB_OFF)};
                pg8::gemm_phase(glds, g, S, E, F.wave);
                REPBAR(11); }
                SEAM();
            } ++ph;
            if (ACTIVE()) {
                PTRS();
                pg8::Gemm g{(const bf16_t*)(ar + AR_HID), (const bf16_t*)(ws + WS_WD), FF, FF};
                pg8::SchedPlain S; S.init(NTOK, 1024, FF, FF, FF, F.G, F.blk);
                pg8::EpiResid E{xb, ssq, ws + WS_X8};
                pg8::gemm_phase(glds, g, S, E, F.wave);
                SEAM();
            } ++ph;
        } else {
            if (ACTIVE()) { REPEAT(12) { MPTRS(); moe_route1(F, xb, (const float*)(ws + WS_WR), ssq, TE, TW, RR, CNT); REPBAR(12); } SEAM(); } ++ph;
            if (ACTIVE()) { REPEAT(13) { MPTRS(); moe_route2(F, TE, RR, CNT, xb, POS, XP, RP); REPBAR(13); } SEAM(); } ++ph;
            if (ACTIVE()) { REPEAT(14) {
                MPTRS();
                LAS int* MB = (LAS int*)(F.lds + 49152); moe_bases(F, CNT, 0, MB);
                pg8::SchedMoe S;
#pragma unroll
                for (int e = 0; e < 9; ++e) S.pbase[e] = __builtin_amdgcn_readfirstlane(MB[e]);
                S.nN = 2 * EFF / 256; S.nt = 16; S.G = F.G; S.c = F.blk; S.astep = (size_t)256 * 1024 * 2; S.bstep = (size_t)256 * 1024 * 2; S.estep = (size_t)2 * EFF * 1024 * 2;
                __syncthreads();
                pg8::Gemm g{XP, (const bf16_t*)(ws + WS_WMGU), 1024, 1024};
                pg8::build_rtab(glds, S, nullptr, RP, F.tid);
                pg8::EpiSwiglu E{HM, EFF, (const LAS float*)(glds + pg8::RTAB_OFF)};
                pg8::gemm_phase(glds, g, S, E, F.wave);
                REPBAR(14); }
                SEAM();
            } ++ph;
            if (ACTIVE()) { REPEAT(15) {
                MPTRS();
                LAS int* MB = (LAS int*)(F.lds + 49152); moe_bases(F, CNT, 0, MB);
                pg8::SchedMoe S;
#pragma unroll
                for (int e = 0; e < 9; ++e) S.pbase[e] = __builtin_amdgcn_readfirstlane(MB[e]);
                S.nN = 4; S.nt = EFF / 64; S.G = F.G; S.c = F.blk; S.astep = (size_t)256 * EFF * 2; S.bstep = (size_t)256 * EFF * 2; S.estep = (size_t)1024 * EFF * 2;
                __syncthreads();
                pg8::Gemm g{HM, (const bf16_t*)(ws + WS_WMD), EFF, EFF};
                pg8::EpiScaleBf16 E{XP, 1024, nullptr, 0, nullptr, 0, 1 << 30, nullptr};
                pg8::gemm_phase(glds, g, S, E, F.wave);
                REPBAR(15); }
                SEAM();
            } ++ph;
            if (ACTIVE()) { MPTRS(); for (int rq_ = 0; rq_ < DBG_RFIN; ++rq_) moe_final(F, xb, xout, XP, POS, TW, sm + SM_FING); SEAM(); } ++ph;
        }
    }
#undef ACTIVE
#undef REPEAT
#undef REPBAR
#undef SEAM
#undef PTRS
#undef GPTRS
#undef MPTRS
}

#ifdef DBG_DUMP_OFF
__global__ void dbg_dump(float* out, const unsigned char* ws) {
    const bf16_t* src = (const bf16_t*)(ws + (size_t)DBG_DUMP_OFF);
    for (size_t i = (size_t)blockIdx.x * blockDim.x + threadIdx.x; i < (size_t)NTOK * 1024; i += (size_t)gridDim.x * blockDim.x) { float v = i < (size_t)DBG_DUMP_N ? bf2f(src[i]) : 0.f; if (!(v == v) || v > 1e30f || v < -1e30f) v = 12345.0f; out[i] = v; }
}
#endif
extern "C" void kernel_launch(void* const* d_in, const int* in_sizes, int n_in, void* d_out, int out_size, void* d_ws, size_t ws_size, hipStream_t stream) {
    static int grid = 0;
    if (grid == 0) {
        if (n_in != 27 || in_sizes[0] != NTOK * DM || out_size != NTOK * DM || ws_size < WS_END) {
            fprintf(stderr, "kernel_launch: unexpected problem (n_in %d, in0 %d, out %d, ws %zu < %zu); nothing launched\n", n_in, n_in > 0 ? in_sizes[0] : -1, out_size, ws_size, (size_t)WS_END); grid = -1; return; }
        int dev = 0, cus = 0;
        if (hipGetDevice(&dev) != hipSuccess || hipDeviceGetAttribute(&cus, hipDeviceAttributeMultiprocessorCount, dev) != hipSuccess) { grid = -1; return; }
        if (hipFuncSetAttribute((const void*)mk_fwd, hipFuncAttributeMaxDynamicSharedMemorySize, LDS_BYTES) != hipSuccess) { fprintf(stderr, "kernel_launch: hipFuncSetAttribute failed\n"); grid = -1; return; }
        int per_cu = 0;
        if (hipOccupancyMaxActiveBlocksPerMultiprocessor(&per_cu, (const void*)mk_fwd, 512, LDS_BYTES) != hipSuccess || per_cu < 1) { fprintf(stderr, "kernel_launch: occupancy query says %d\n", per_cu); }
        (void)hipGetLastError();
        grid = cus > 256 ? 256 : cus;
    }
    if (grid < 0) return;
    (void)hipMemsetAsync((char*)d_ws + WS_CTL, 0, CTL_BYTES, stream);
    Params p{};
    for (int i = 0; i < 27; ++i) p.in[i] = (const float*)d_in[i];
    p.out = (float*)d_out; p.ws = (unsigned char*)d_ws; p.pad0 = 0; p.pad1 = 0;
#if MK_SINGLE
    p.ph_lo = 0; p.ph_hi = NPH;
    hipLaunchKernelGGL(mk_fwd, dim3(grid), dim3(512), LDS_BYTES, stream, p);
#else
#ifndef DBG_NPH
#define DBG_NPH NPH
#endif
    for (int k = 0; k < DBG_NPH; ++k) { p.ph_lo = k; p.ph_hi = k + 1; hipLaunchKernelGGL(mk_fwd, dim3(grid), dim3(512), LDS_BYTES, stream, p); }
#ifdef DBG_DUMP_OFF
    hipLaunchKernelGGL(dbg_dump, dim3(2048), dim3(256), 0, stream, (float*)d_out, (const unsigned char*)d_ws);
#endif
#endif
}
```

```cpp
#include <hip/hip_runtime.h>
#include <cstdio>
#include <cstdint>

#define LAS __attribute__((address_space(3)))
#define DI __device__ __forceinline__
typedef unsigned short bf16_t;
typedef short bf16x8 __attribute__((ext_vector_type(8)));
typedef short s16x4 __attribute__((ext_vector_type(4)));
typedef float f32x4 __attribute__((ext_vector_type(4)));
typedef float f32x2 __attribute__((ext_vector_type(2)));
typedef unsigned u32x4 __attribute__((ext_vector_type(4)));
typedef unsigned u32x2 __attribute__((ext_vector_type(2)));

#ifndef MK_SINGLE
#define MK_SINGLE 1
#endif

constexpr int NTOK = 65536, DM = 1024, SEQ = 8192, NBATCH = 8;
constexpr int NGRP = 2, NG = NTOK / NGRP, GB = NBATCH / NGRP;
constexpr int PLD = 3072;
constexpr int PC_POOL = 0, PC_MQ = 256, PC_MK = 512, PC_MV = 768, PC_DQ = 1024, PC_DK = 1536, PC_DV = 2048, PC_Z = 2560;
constexpr int IN_COLS = 6160;
constexpr int FF = 2816, EFF = 1408, NEXP = 8;
constexpr int MEMLEN = 256;
constexpr float RMS_EPS = 1e-6f;
constexpr int NPH = 1 + 2 * (NGRP * 5 + 2 + 3) + 2 + 5;

constexpr size_t MiB = 1u << 20;
constexpr size_t WS_CTL = 0, CTL_BYTES = 1 * MiB;
constexpr size_t LW_WIN = 0, LW_WCAT = LW_WIN + (size_t)6144 * 1024 * 2, LW_WOUT = LW_WCAT + (size_t)1024 * 1024 * 2, LW_WQ = LW_WOUT + (size_t)1024 * 1024 * 2,
                 LW_WKV = LW_WQ + (size_t)512 * 1024 * 2, LW_WO = LW_WKV + (size_t)1024 * 1024 * 2, LW_WBA = LW_WO + (size_t)1024 * 512 * 2, LW_STRIDE = LW_WBA + (size_t)16 * 1024 * 2;
constexpr size_t WS_LW = WS_CTL + CTL_BYTES;
constexpr size_t WS_WGU = WS_LW + 2 * LW_STRIDE;
constexpr size_t WS_WD = WS_WGU + (size_t)2 * FF * 1024 * 2;
constexpr size_t WS_WMGU = WS_WD + (size_t)1024 * FF * 2;
constexpr size_t WS_WMD = WS_WMGU + (size_t)NEXP * 2 * EFF * 1024 * 2;
constexpr size_t WS_WR = WS_WMD + (size_t)NEXP * 1024 * EFF * 2;
constexpr size_t WS_XB = (WS_WR + 8 * 1024 * 4 + MiB - 1) / MiB * MiB;
constexpr size_t WS_SSQ = WS_XB + (size_t)NTOK * 1024 * 2;
constexpr size_t WS_ROPE = WS_SSQ + (size_t)NTOK * 16 * 4;
constexpr size_t WS_MEMN = WS_ROPE + (size_t)NTOK * 16 * 4;
constexpr size_t WS_KVM = WS_MEMN + (size_t)2 * 2048 * 1024 * 2;
constexpr size_t WS_SMALL = WS_KVM + (size_t)2 * 2048 * 1024 * 2;
constexpr int SM_CONVW = 0, SM_ALOG = SM_CONVW + 2 * 4 * 1536, SM_DTB = SM_ALOG + 16, SM_DNG = SM_DTB + 16, SM_FING = SM_DNG + 128, SM_END = SM_FING + 1024;
constexpr size_t WS_X8 = WS_SMALL + 65536;
constexpr size_t WS_WG8 = WS_X8 + (size_t)NTOK * 1024;
constexpr size_t WS_ARENA = WS_WG8 + (size_t)2 * 3072 * 1024;
constexpr size_t AR_P = 0;
constexpr size_t AR_BA = AR_P + (size_t)NG * PLD * 2;
constexpr size_t AR_BR = AR_BA + (size_t)NG * 16 * 4;
constexpr size_t AR_KBAR = AR_BR + (size_t)NG * 1024 * 2;
constexpr size_t AR_VT = AR_KBAR + (size_t)GB * 4 * 32 * 64 * 4;
constexpr int NCH = GB * 128 * 8;
constexpr size_t AR_QD = AR_VT + (size_t)GB * 4 * 64 * SEQ * 2;
constexpr size_t AR_KDT = AR_QD + (size_t)NCH * 8192;
constexpr size_t AR_WN = AR_KDT + (size_t)NCH * 8192;
constexpr size_t AR_UT = AR_WN + (size_t)NCH * 8192;
constexpr size_t AR_AQK = AR_UT + (size_t)NCH * 8192;
constexpr size_t AR_NT = AR_AQK + (size_t)NCH * 8192;
constexpr size_t AR_SG = AR_NT + (size_t)NCH * 8192;
constexpr size_t AR_ZB = AR_SG + (size_t)NCH * 8192;
constexpr size_t AR_GL = AR_ZB + (size_t)NG * 512 * 2;
constexpr size_t AR_SELG = AR_GL + (size_t)NCH * 4 + 65536 - ((size_t)NCH * 4) % 65536;
constexpr size_t AR_CNTG = AR_SELG + (size_t)NG * 4 * 4;
constexpr size_t AR_LISTG = AR_CNTG + (size_t)GB * 4 * 32 * 32 * 4;
constexpr size_t AR_OPG = AR_LISTG + (size_t)GB * 4 * 32 * 32 * 256;
constexpr size_t AR_MLG = AR_OPG + (size_t)NG * 4 * 4 * 64 * 2;
constexpr size_t AR_MERGED = AR_MLG + (size_t)NG * 4 * 4 * 2 * 4;
constexpr size_t AR_MG2 = AR_QD;
constexpr size_t AR_MIX_END = AR_MERGED + (size_t)NG * 1024 * 2;
constexpr size_t AR_QX = 0, AR_AO = AR_QX + (size_t)NTOK * 512 * 2, AR_XA_END = AR_AO + (size_t)NTOK * 512 * 2;
constexpr size_t AR_HID = 0, AR_HID_END = (size_t)NTOK * FF * 2;
constexpr int MOE_ROWS = 2 * NTOK + 2048;
constexpr size_t AR_TE = 0, AR_TW = AR_TE + (size_t)NTOK * 8, AR_RR = AR_TW + (size_t)NTOK * 8, AR_POS = AR_RR + (size_t)NTOK * 4, AR_CNT = AR_POS + (size_t)NTOK * 8,
                 AR_XP = AR_CNT + 65536, AR_RP = AR_XP + (size_t)MOE_ROWS * 1024 * 2, AR_HM = AR_RP + (size_t)MOE_ROWS * 4 + 65536 - ((size_t)MOE_ROWS * 4) % 65536,
                 AR_MOE_END = AR_HM + (size_t)MOE_ROWS * EFF * 2;
constexpr size_t cmax(size_t a, size_t b) { return a > b ? a : b; }
constexpr size_t WS_END = WS_ARENA + cmax(cmax(AR_MIX_END, AR_XA_END), cmax(AR_HID_END, AR_MOE_END));
static_assert(AR_XA_END <= AR_MERGED, "xattn buffers must not overlap MERGED");
static_assert(AR_MG2 + (size_t)NTOK * 1024 * 2 <= AR_ZB, "MG2 must fit in the dead DeltaNet chunk buffers");
static_assert((size_t)NG * 1024 * 2 + (size_t)NG * PLD * 2 == (size_t)NTOK * 1024 * 4, "group 0 parks its branch outputs + gates in the (not yet written) output buffer");
static_assert(SM_END * 4 <= 65536, "small-vector block");
static_assert(WS_END <= (size_t)1073741824, "workspace map exceeds 1 GiB");

constexpr int LDS_BYTES = 160 * 1024;
constexpr int LDS_MISC = 158 * 1024;

DI float bf2f(unsigned short b) { return __uint_as_float(((unsigned)b) << 16); }
typedef __bf16 bf16v2_t __attribute__((ext_vector_type(2)));
DI unsigned cvt_pk_bf16(float lo, float hi) { bf16v2_t v; v.x = (__bf16)lo; v.y = (__bf16)hi; return __builtin_bit_cast(unsigned, v); }
DI unsigned f2bf(float f) { return (unsigned)__builtin_bit_cast(unsigned short, (__bf16)f); }
DI unsigned pk2(float lo, float hi) { return cvt_pk_bf16(lo, hi); }
DI unsigned cvt4_fp8(float a, float b, float c, float d) { unsigned w = 0u; w = __builtin_amdgcn_cvt_pk_fp8_f32(a, b, w, false); w = __builtin_amdgcn_cvt_pk_fp8_f32(c, d, w, true); return w; }
DI float wave_sum(float v) {
#pragma unroll
    for (int o = 1; o < 64; o <<= 1) v += __shfl_xor(v, o);
    return v;
}
DI float fsigmoid(float x) { return __builtin_amdgcn_rcpf(1.0f + __builtin_amdgcn_exp2f(-1.44269504089f * x)); }
DI float row_rstd(const float* ssqp, int row) {
    const f32x4* p = (const f32x4*)(ssqp + (size_t)row * 16);
    const f32x4 a = p[0], b = p[1], c = p[2], d = p[3];
    const float s = (((a.x + a.y) + (a.z + a.w)) + ((b.x + b.y) + (b.z + b.w))) + (((c.x + c.y) + (c.z + c.w)) + ((d.x + d.y) + (d.z + d.w)));
    return rsqrtf(s * (1.0f / 1024.0f) + RMS_EPS);
}
#define LAUNDER_V(x) asm volatile("" : "+v"(x))
#define LDS_WAIT() asm volatile("s_waitcnt lgkmcnt(0)" ::: "memory")
#define VM_WAIT() asm volatile("s_waitcnt vmcnt(0)" ::: "memory")
#define WG_BAR() do { asm volatile("s_waitcnt lgkmcnt(0)" ::: "memory"); __builtin_amdgcn_s_barrier(); asm volatile("" ::: "memory"); } while (0)
#define MFMA16(a, b, c) __builtin_amdgcn_mfma_f32_16x16x32_bf16((a), (b), (c), 0, 0, 0)

#define XB_TMO      128
#define XB_XCNT(j)  (256  + 64 * (j))
#define XB_XSUB(j)  (1280 + 64 * (j))
#define XB_XGEN(j)  (2304 + 64 * (j))
#define XB_TOP      3328
#define XB_TOPGEN   3392
#define XCD_BAR_WORDS 3456
#define XB_SPIN_CAP (1u << 22)

DI unsigned xb_ld(unsigned* p)              { return __hip_atomic_load(p, __ATOMIC_RELAXED, __HIP_MEMORY_SCOPE_AGENT); }
DI unsigned xb_add(unsigned* p, unsigned v) { return __hip_atomic_fetch_add(p, v, __ATOMIC_RELAXED, __HIP_MEMORY_SCOPE_AGENT); }
DI unsigned xb_xcc_id() { return (unsigned)__builtin_amdgcn_s_getreg((3 << 11) | 20) & 0xFu; }
#define XB_SPIN(cond, bar) do { unsigned _sp = 0; while (cond) { __builtin_amdgcn_s_sleep(1); \
    if ((++_sp & 255u) == 0u) { if (xb_ld(&(bar)[XB_TMO])) break; if (_sp > XB_SPIN_CAP) { atomicAdd(&(bar)[XB_TMO], 1u); break; } } } } while (0)

struct XcdBarrier { unsigned* bar; unsigned x; volatile LAS unsigned* st; };

DI XcdBarrier xcd_barrier_post(unsigned* bar, volatile LAS unsigned* st) {
    XcdBarrier b; b.bar = bar; b.x = xb_xcc_id(); b.st = st;
    if (threadIdx.x == 0) (void)xb_add(&bar[XB_XCNT(b.x)], 1u);
    return b;
}
DI void xcd_barrier_complete(unsigned* bar, unsigned x, unsigned& nloc, unsigned& nx) {
    const unsigned G = gridDim.x * gridDim.y * gridDim.z;
    unsigned sum, cnt, mine, sp = 0u;
    for (;;) {
        sum = 0u; cnt = 0u; mine = 0u;
#pragma unroll
        for (unsigned j = 0; j < 16; ++j) { const unsigned c = xb_ld(&bar[XB_XCNT(j)]); sum += c; cnt += (c > 0u) ? 1u : 0u; mine = (j == x) ? c : mine; }
        if (sum == G) break;
        __builtin_amdgcn_s_sleep(1);
        if ((++sp & 255u) == 0u) { if (xb_ld(&bar[XB_TMO])) break; if (sp > XB_SPIN_CAP) { atomicAdd(&bar[XB_TMO], 1u); break; } }
    }
    nloc = mine > 0u ? mine : 1u; nx = cnt > 0u ? cnt : 1u;
}
DI void xcd_barrier(const XcdBarrier& b) {
    asm volatile("s_waitcnt vmcnt(0)" ::: "memory");
    __syncthreads();
    if (threadIdx.x == 0) {
        unsigned* bar = b.bar;
        __builtin_amdgcn_s_waitcnt(0);
        unsigned nloc = b.st[0], nx = b.st[1];
        if (nloc == 0u) { xcd_barrier_complete(bar, b.x, nloc, nx); b.st[0] = nloc; b.st[1] = nx; }
        const unsigned old = xb_add(&bar[XB_XSUB(b.x)], 1u);
        const unsigned gen = old / nloc;
        if (old + 1u == (gen + 1u) * nloc) {
            __builtin_amdgcn_fence(__ATOMIC_RELEASE, "agent");
            asm volatile("s_waitcnt vmcnt(0)" ::: "memory");
            const unsigned og = xb_add(&bar[XB_TOP], 1u);
            const unsigned tg = og / nx;
            if (og + 1u == (tg + 1u) * nx) xb_add(&bar[XB_TOPGEN], 1u);
            else XB_SPIN(xb_ld(&bar[XB_TOPGEN]) == tg, bar);
            __builtin_amdgcn_fence(__ATOMIC_ACQUIRE, "agent");
            xb_add(&bar[XB_XGEN(b.x)], 1u);
            asm volatile("s_waitcnt vmcnt(0)" ::: "memory");
        } else {
            XB_SPIN(xb_ld(&bar[XB_XGEN(b.x)]) == gen, bar);
            __builtin_amdgcn_fence(__ATOMIC_ACQUIRE, "agent");
            asm volatile("s_waitcnt vmcnt(0)" ::: "memory");
        }
    }
    __syncthreads();
}
namespace pg8 {
constexpr int BM = 256, BK = 64, HALF = 128, HTB = HALF * BK * 2, STAGE_BYTES = 8 * HTB, NXCD = 8, WGM = 8;
__host__ __device__ __forceinline__ int lds_byte(int r, int c) { const int st = (r >> 4) * 2 + (c >> 5), rr = r & 15, cc = c & 31, ob = rr * 64 + cc * 2; return st * 1024 + (ob ^ (((ob >> 9) & 1) << 5)); }
__host__ __device__ __forceinline__ void stage_rc(int b, int& R, int& C) { const int st = b / 1024, sb = b % 1024, swz = sb ^ (((sb >> 9) & 1) << 5); R = (st >> 1) * 16 + swz / 64; C = (st & 1) * 32 + (swz % 64) / 2; }
__host__ __device__ __forceinline__ int perm32(int rho) { const int n = rho >> 4, i = rho & 15; return 8 * (i >> 2) + 4 * n + (i & 3); }

struct Unit { int pm, pn, nt, tag, ord; size_t aoff, boff; };
struct Gemm { const bf16_t* A; const bf16_t* Bt; int lda, ldb; };

struct TileOrder {
    int nM, nN, nwg, G, c;
    DI void init(int nM_, int nN_, int G_, int c_) { nM = nM_; nN = nN_; nwg = nM * nN; G = G_; c = c_; }
    DI bool tile(int i, int& pm, int& pn) const {
        const long L = (long)i * G + c; if (L >= nwg) return false;
        int wgid = (int)L; { const int q = nwg / NXCD, r = nwg % NXCD, xcd = wgid % NXCD, off = wgid / NXCD; wgid = (xcd < r ? xcd * (q + 1) : r * (q + 1) + (xcd - r) * q) + off; }
        const int nig = WGM * nN, gid = wgid / nig, fm = gid * WGM, gsz = (nM - fm) < WGM ? (nM - fm) : WGM;
        pm = fm + ((wgid % nig) % gsz); pn = (wgid % nig) / gsz; return true;
    }
};
struct SchedPlain {
    TileOrder T; int nt; size_t astep, bstep; int gapm = 1 << 30; size_t agap = 0;
    DI void init(int M, int N, int K, int lda, int ldb, int G, int c, int esz = 2) { T.init(M / BM, N / BM, G, c); nt = K * esz / (BK * 2); astep = (size_t)BM * lda * esz; bstep = (size_t)BM * ldb * esz; }
    DI bool next(int i, Unit& u) const { if (!T.tile(i, u.pm, u.pn)) return false; u.nt = nt; u.tag = 0; u.ord = i; u.aoff = (size_t)u.pm * astep + (u.pm >= gapm ? agap : (size_t)0); u.boff = (size_t)u.pn * bstep; return true; }
};
struct SchedMerge {
    TileOrder T; size_t astep, bstep;
    DI void init(int M, int N, int lda, int ldb, int G, int c) { T.init(M / BM, N / BM, G, c); astep = (size_t)BM * lda * 2; bstep = (size_t)BM * ldb * 2; }
    DI bool next(int i, Unit& u) const {
        const int ti = i / 3, br = i - 3 * ti; if (!T.tile(ti, u.pm, u.pn)) return false;
        const int kofs = br == 0 ? 0 : (br == 1 ? 256 : 512);
        u.nt = br == 2 ? 8 : 4; u.tag = br; u.aoff = (size_t)u.pm * astep + (size_t)kofs * 2; u.boff = (size_t)u.pn * bstep + (size_t)kofs * 2; return true;
    }
};
struct SchedKV {
    int c; size_t lstride;
    DI bool next(int i, Unit& u) const {
        if (i != 0 || c < 0 || c >= 64) return false;
        const int layer = c >> 5, r = c & 31; u.pm = layer * 8 + (r >> 2); u.pn = r & 3; u.nt = 16; u.tag = 0; u.ord = 0;
        u.aoff = (size_t)u.pm * BM * 1024 * 2; u.boff = (size_t)layer * lstride + (size_t)u.pn * BM * 1024 * 2; return true;
    }
};
struct SchedMoe {
    int pbase[9]; int nN, nt, G, c; size_t astep, bstep, estep;
    DI bool next(int i, Unit& u) const {
        const long L = (long)i * G + c; const int nM = pbase[8], nwg = nM * nN; if (L >= nwg) return false;
        int wgid = (int)L; { const int q = nwg / NXCD, r = nwg % NXCD, xcd = wgid % NXCD, off = wgid / NXCD; wgid = (xcd < r ? xcd * (q + 1) : r * (q + 1) + (xcd - r) * q) + off; }
        const int nig = WGM * nN, gid = wgid / nig, fm = gid * WGM, gsz = (nM - fm) < WGM ? (nM - fm) : WGM;
        const int gp = fm + ((wgid % nig) % gsz), pn = (wgid % nig) / gsz;
        int e = 0;
#pragma unroll
        for (int j = 1; j < 8; ++j) e += (gp >= pbase[j]) ? 1 : 0;
        u.pm = gp; u.pn = pn; u.nt = nt; u.tag = e; u.ord = i; u.aoff = (size_t)gp * astep; u.boff = (size_t)e * estep + (size_t)pn * bstep; return true;
    }
};

constexpr int RTAB_OFF = STAGE_BYTES, RTAB_MAX_UNITS = 26;
template <class Sched> DI void build_rtab(LAS unsigned char* lds, const Sched& S, const float* ssqp, const float* rvec, int tid) {
    LAS float* rt = (LAS float*)(lds + RTAB_OFF); Unit u;
    for (int i = tid >> 8; S.next(i, u); i += 2) { if (i >= RTAB_MAX_UNITS) break; const int r = tid & 255, row = u.pm * BM + r; rt[i * 256 + r] = rvec ? rvec[row] : row_rstd(ssqp, row); }
    __syncthreads();
}
struct EpiScaleBf16 { static constexpr bool MID = false;
    bf16_t* O; int ldo; const float* ssqp; int act; bf16_t* O2; int ldo2, pn2; const LAS float* rtab;
    DI void operator()(const f32x4 (&acc)[2][2][4][2], const Unit& u, int wr, int wc, int fr, int fq) const {
        const bool alt = u.pn >= pn2; bf16_t* const Ob = alt ? O2 : O; const int ld = alt ? ldo2 : ldo;
        const int row0 = u.pm * BM + wr * 64 + fr, col0 = (alt ? u.pn - pn2 : u.pn) * BM + wc * 32 + 8 * fq;
#pragma unroll
        for (int ai = 0; ai < 2; ++ai)
#pragma unroll
            for (int m = 0; m < 4; ++m) { const int row = row0 + ai * HALF + m * 16; const float r = ssqp ? rtab[u.ord * 256 + (row & 255)] : 1.0f; bf16_t* rowp = Ob + (size_t)row * ld + col0;
#pragma unroll
                for (int bj = 0; bj < 2; ++bj) { f32x4 v0 = acc[ai][bj][m][0] * r, v1 = acc[ai][bj][m][1] * r;
                    if (act) {
#pragma unroll
                        for (int j = 0; j < 4; ++j) { v0[j] = fminf(1.0f + __builtin_amdgcn_exp2f(-1.44269504089f * v0[j]), 1e30f); v1[j] = fminf(1.0f + __builtin_amdgcn_exp2f(-1.44269504089f * v1[j]), 1e30f); } }
                    u32x4 w; w.x = cvt_pk_bf16(v0[0], v0[1]); w.y = cvt_pk_bf16(v0[2], v0[3]); w.z = cvt_pk_bf16(v1[0], v1[1]); w.w = cvt_pk_bf16(v1[2], v1[3]);
                    if (act) *(u32x4*)(O + (size_t)(u.pm * 12 + u.pn) * 65536 + (size_t)((((wr * 4 + wc) * 1024 + ai * 512 + m * 128 + bj * 64 + fq * 16 + fr)) * 8)) = w;
                    else *(u32x4*)(rowp + bj * HALF) = w; } }
    }
};
struct EpiResid { static constexpr bool MID = false;
    bf16_t* xb; float* ssqp; unsigned char* x8;
    DI void operator()(const f32x4 (&acc)[2][2][4][2], const Unit& u, int wr, int wc, int fr, int fq) const {
        const int row0 = u.pm * BM + wr * 64 + fr, col0 = u.pn * BM + wc * 32 + 8 * fq;
#pragma unroll
        for (int ai = 0; ai < 2; ++ai)
#pragma unroll
            for (int m = 0; m < 4; ++m) { const int row = row0 + ai * HALF + m * 16; const size_t off = (size_t)row * 1024 + col0; float ss = 0.f;
#pragma unroll
                for (int bj = 0; bj < 2; ++bj) {
                    const u32x4 xo = *(const u32x4*)(xb + off + bj * HALF);
                    f32x4 x0 = (f32x4){__uint_as_float(xo.x << 16), __uint_as_float(xo.x & 0xffff0000u), __uint_as_float(xo.y << 16), __uint_as_float(xo.y & 0xffff0000u)};
                    f32x4 x1 = (f32x4){__uint_as_float(xo.z << 16), __uint_as_float(xo.z & 0xffff0000u), __uint_as_float(xo.w << 16), __uint_as_float(xo.w & 0xffff0000u)};
                    x0 += acc[ai][bj][m][0]; x1 += acc[ai][bj][m][1];
                    u32x4 w; w.x = cvt_pk_bf16(x0[0], x0[1]); w.y = cvt_pk_bf16(x0[2], x0[3]); w.z = cvt_pk_bf16(x1[0], x1[1]); w.w = cvt_pk_bf16(x1[2], x1[3]);
                    *(u32x4*)(xb + off + bj * HALF) = w;
                    if (x8) { u32x2 w8; w8.x = cvt4_fp8(x0[0], x0[1], x0[2], x0[3]); w8.y = cvt4_fp8(x1[0], x1[1], x1[2], x1[3]); *(u32x2*)(x8 + off + bj * HALF) = w8; }
                    ss += (x0[0] * x0[0] + x0[1] * x0[1]) + (x0[2] * x0[2] + x0[3] * x0[3]) + (x1[0] * x1[0] + x1[1] * x1[1]) + (x1[2] * x1[2] + x1[3] * x1[3]); }
                ss += __shfl_xor(ss, 16); ss += __shfl_xor(ss, 32);
                if (fq == 0) ssqp[(size_t)row * 16 + u.pn * 4 + wc] = ss; }
    }
};
struct EpiSwiglu { static constexpr bool MID = false;
    bf16_t* H; int ldh; const LAS float* rtab;
    DI void operator()(const f32x4 (&acc)[2][2][4][2], const Unit& u, int wr, int wc, int fr, int fq) const {
        const int row0 = u.pm * BM + wr * 64 + fr, col0 = u.pn * HALF + wc * 32 + 8 * fq;
#pragma unroll
        for (int ai = 0; ai < 2; ++ai)
#pragma unroll
            for (int m = 0; m < 4; ++m) { const int row = row0 + ai * HALF + m * 16; const float r = rtab[u.ord * 256 + (row & 255)];
                f32x4 h0, h1;
#pragma unroll
                for (int j = 0; j < 4; ++j) { const float g0 = acc[ai][0][m][0][j] * r, g1 = acc[ai][0][m][1][j] * r;
                    h0[j] = g0 * fsigmoid(g0) * (acc[ai][1][m][0][j] * r); h1[j] = g1 * fsigmoid(g1) * (acc[ai][1][m][1][j] * r); }
                u32x4 w; w.x = cvt_pk_bf16(h0[0], h0[1]); w.y = cvt_pk_bf16(h0[2], h0[3]); w.z = cvt_pk_bf16(h1[0], h1[1]); w.w = cvt_pk_bf16(h1[2], h1[3]);
                *(u32x4*)(H + (size_t)row * ldh + col0) = w; }
    }
};
struct EpiMerge { static constexpr bool MID = true;
    const bf16_t* gates; bf16_t* merged; const bf16_t* gates1 = nullptr; int gapm = 1 << 30;
    DI const bf16_t* gtile(const Unit& u, int g) const { return u.pm >= gapm ? gates1 + (size_t)((u.pm - gapm) * 12 + g * 4 + u.pn) * 65536 : gates + (size_t)(u.pm * 12 + g * 4 + u.pn) * 65536; }
    static DI float gclamp(unsigned hi_bits) { return fmaxf(__uint_as_float(hi_bits), 1e-30f); }
    DI void mid(f32x4 (&acc)[2][2][4][2], const Unit& u, int seg, int wr, int wc, int fr, int fq) const {
        int lb = ((wr * 4 + wc) * 1024 + fq * 16 + fr) * 8; LAUNDER_V(lb); const bf16_t* const gb_ = gtile(u, seg) + lb;
#pragma unroll
        for (int ai = 0; ai < 2; ++ai)
#pragma unroll
            for (int mp = 0; mp < 2; ++mp) {
                u32x4 ga[2][2], gb[2][2];
#pragma unroll
                for (int mm = 0; mm < 2; ++mm)
#pragma unroll
                    for (int bj = 0; bj < 2; ++bj) { const bf16_t* gp = gb_ + (ai * 512 + (2 * mp + mm) * 128 + bj * 64) * 8; ga[mm][bj] = *(const u32x4*)gp; gb[mm][bj] = *(const u32x4*)(gp + 4 * 65536); }
                __builtin_amdgcn_sched_barrier(0);
#pragma unroll
                for (int mm = 0; mm < 2; ++mm)
#pragma unroll
                    for (int bj = 0; bj < 2; ++bj) {
#pragma unroll
                        for (int j = 0; j < 4; ++j) { const int m = 2 * mp + mm;
                            const float r_lo = __uint_as_float(gb[mm][bj][j] << 16) * __builtin_amdgcn_rcpf(__uint_as_float(ga[mm][bj][j] << 16)), r_hi = __uint_as_float(gb[mm][bj][j] & 0xffff0000u) * __builtin_amdgcn_rcpf(__uint_as_float(ga[mm][bj][j] & 0xffff0000u));
                            acc[ai][bj][m][j >> 1][(2 * j) & 3] *= r_lo; acc[ai][bj][m][j >> 1][(2 * j + 1) & 3] *= r_hi; }
                        __builtin_amdgcn_sched_barrier(0); }
            }
    }
    DI void operator()(const f32x4 (&acc)[2][2][4][2], const Unit& u, int wr, int wc, int fr, int fq) const {
        const int row0 = u.pm * BM + wr * 64 + fr, col0 = u.pn * BM + wc * 32 + 8 * fq;
#pragma unroll
        for (int ai = 0; ai < 2; ++ai)
#pragma unroll
            for (int m = 0; m < 4; ++m) { const int row = row0 + ai * HALF + m * 16;
#pragma unroll
                for (int bj = 0; bj < 2; ++bj) {
                    const u32x4 gv = *(const u32x4*)(gtile(u, 2) + (((wr * 4 + wc) * 1024 + ai * 512 + m * 128 + bj * 64 + fq * 16 + fr)) * 8);
                    float v[8];
#pragma unroll
                    for (int j = 0; j < 4; ++j) { v[2 * j] = __builtin_amdgcn_rcpf(__uint_as_float(gv[j] << 16)); v[2 * j + 1] = __builtin_amdgcn_rcpf(__uint_as_float(gv[j] & 0xffff0000u)); }
#pragma unroll
                    for (int j = 0; j < 4; ++j) { v[j] *= acc[ai][bj][m][0][j]; v[4 + j] *= acc[ai][bj][m][1][j]; }
                    u32x4 w; w.x = cvt_pk_bf16(v[0], v[1]); w.y = cvt_pk_bf16(v[2], v[3]); w.z = cvt_pk_bf16(v[4], v[5]); w.w = cvt_pk_bf16(v[6], v[7]);
                    *(u32x4*)(merged + (size_t)row * 1024 + col0 + bj * HALF) = w; } }
    }
};

template <class Epi, class Sched, bool F8 = false>
DI void gemm_phase(LAS unsigned char* lds, const Gemm g, const Sched& S, const Epi& E, int wave_id) {
    int tid_ = (int)__builtin_amdgcn_mbcnt_hi(~0u, __builtin_amdgcn_mbcnt_lo(~0u, 0u)) + 64 * wave_id; asm volatile("" : "+v"(tid_));
    const int tid = tid_, wid = __builtin_amdgcn_readfirstlane(tid >> 6), lane = tid & 63, wr = wid >> 2, wc = wid & 3, fr = lane & 15, fq = lane >> 4;
    unsigned voffA[2], voffB[2];
#pragma unroll
    for (int i = 0; i < 2; ++i) { int R, C; stage_rc(tid * 16 + i * 8192, R, C); const int Rb = (R & ~31) + perm32(R & 31);
        voffA[i] = F8 ? (unsigned)(R * g.lda + 2 * C) : (unsigned)(R * g.lda + C) * 2u; voffB[i] = F8 ? (unsigned)(Rb * g.ldb + 2 * C) : (unsigned)(Rb * g.ldb + C) * 2u; }
    const size_t kstep = (size_t)(BK * 2);
    const size_t hstepA = (size_t)HALF * g.lda * (F8 ? 1 : 2), hstepB = (size_t)HALF * g.ldb * (F8 ? 1 : 2);
    const unsigned ldsw = (unsigned)wid * 1024u;
    const int aoff = lds_byte(wr * 64 + fr, fq * 8), boff = lds_byte(wc * 32 + fr, fq * 8);
#define PG8_SA(b, h) (((b) * 2 + (h)) * HTB)
#define PG8_SB(b, h) ((4 + (b) * 2 + (h)) * HTB)
#define PG8_STAGE(bufoff, gbase, voff) do { _Pragma("unroll") for (int _i = 0; _i < 2; ++_i) \
        __builtin_amdgcn_global_load_lds((const unsigned*)((const char*)(gbase) + (voff)[_i]), (LAS unsigned*)(lds + (bufoff) + ldsw + _i * 8192), 16, 0, 0); } while (0)
#define PG8_LDA(dst, b, h) do { _Pragma("unroll") for (int m = 0; m < 4; ++m) { const v4i_t l0_ = *(const LAS v4i_t*)(lds + PG8_SA(b, h) + aoff + m * 2048), l1_ = *(const LAS v4i_t*)(lds + PG8_SA(b, h) + aoff + m * 2048 + 1024); \
        dst[m] = __builtin_shufflevector(l0_, l1_, 0, 1, 2, 3, 4, 5, 6, 7); } } while (0)
#define PG8_LDB(dst, b, h) do { _Pragma("unroll") for (int n = 0; n < 2; ++n) { const v4i_t l0_ = *(const LAS v4i_t*)(lds + PG8_SB(b, h) + boff + n * 2048), l1_ = *(const LAS v4i_t*)(lds + PG8_SB(b, h) + boff + n * 2048 + 1024); \
        dst[n] = __builtin_shufflevector(l0_, l1_, 0, 1, 2, 3, 4, 5, 6, 7); } } while (0)
#define PG8_MMA(ai, bj, At, Bt) do { __builtin_amdgcn_s_setprio(1); _Pragma("unroll") for (int m = 0; m < 4; ++m) _Pragma("unroll") for (int n = 0; n < 2; ++n) { \
        if constexpr (F8) asm volatile("v_mfma_scale_f32_16x16x128_f8f6f4 %0, %1, %2, %0, %3, %4 op_sel_hi:[0,0,0]" : "+v"(acc[ai][bj][m][n]) : "v"(Bt[n]), "v"(At[m]), "v"(f8scale_w), "v"(f8scale_x));   \
        else { const bf16x8 b0_ = __builtin_bit_cast(bf16x8, __builtin_shufflevector(Bt[n], Bt[n], 0, 1, 2, 3)), b1_ = __builtin_bit_cast(bf16x8, __builtin_shufflevector(Bt[n], Bt[n], 4, 5, 6, 7)), \
                            a0_ = __builtin_bit_cast(bf16x8, __builtin_shufflevector(At[m], At[m], 0, 1, 2, 3)), a1_ = __builtin_bit_cast(bf16x8, __builtin_shufflevector(At[m], At[m], 4, 5, 6, 7)); \
            acc[ai][bj][m][n] = __builtin_amdgcn_mfma_f32_16x16x32_bf16(b0_, a0_, acc[ai][bj][m][n], 0, 0, 0); acc[ai][bj][m][n] = __builtin_amdgcn_mfma_f32_16x16x32_bf16(b1_, a1_, acc[ai][bj][m][n], 0, 0, 0); } } \
        __builtin_amdgcn_s_setprio(0); } while (0)
#define PG8_WAIT_V(n) asm volatile("s_waitcnt vmcnt(" #n ")" ::: "memory")
#define PG8_WAIT_L(n) asm volatile("s_waitcnt lgkmcnt(" #n ")" ::: "memory")
#define PG8_BAR __builtin_amdgcn_s_barrier()
#define PG8_SCHED __builtin_amdgcn_sched_barrier(0)
    Unit cur, nxt; int ui = 0;
    if (!S.next(0, cur)) return;
    f32x4 acc[2][2][4][2];
#pragma unroll
    for (int a = 0; a < 2; ++a)
#pragma unroll
        for (int b = 0; b < 2; ++b)
#pragma unroll
            for (int m = 0; m < 4; ++m)
#pragma unroll
                for (int n = 0; n < 2; ++n) acc[a][b][m][n] = (f32x4){0.f, 0.f, 0.f, 0.f};
    typedef int v8i_t __attribute__((ext_vector_type(8))); typedef int v4i_t __attribute__((ext_vector_type(4)));
    const int f8scale_w = 0x7a7a7a7a, f8scale_x = 0x7f7f7f7f;
    v8i_t At[4], B0[2], B1[2];
    const char* cA = (const char*)g.A + cur.aoff; const char* cB = (const char*)g.Bt + cur.boff;
    PG8_STAGE(PG8_SB(0, 0), cB, voffB); PG8_STAGE(PG8_SB(0, 1), cB + hstepB, voffB); PG8_STAGE(PG8_SA(0, 0), cA, voffA); PG8_STAGE(PG8_SA(0, 1), cA + hstepA, voffA);
    if (wr == 1) PG8_BAR;
    PG8_WAIT_V(2); PG8_BAR;
    PG8_STAGE(PG8_SB(1, 0), cB + kstep, voffB); PG8_STAGE(PG8_SA(1, 0), cA + kstep, voffA); PG8_STAGE(PG8_SB(1, 1), cB + hstepB + kstep, voffB);
    PG8_WAIT_V(6); PG8_BAR;
    for (;;) {
        const bool has_next = S.next(ui + 1, nxt);
        const int nt = cur.nt;
        const char* nA = has_next ? (const char*)g.A + nxt.aoff : cA; const char* nB = has_next ? (const char*)g.Bt + nxt.boff : cB;
        for (int t = 0; t < nt; t += 2) {
            if constexpr (Epi::MID) { if (t == 4 || t == 8) { E.mid(acc, cur, t >> 3, wr, wc, fr, fq); } __builtin_amdgcn_sched_barrier(0); }
            const bool last = (t == nt - 2);
            const char* a1 = cA + (size_t)(t + 1) * kstep;
            const char* a2 = last ? nA : cA + (size_t)(t + 2) * kstep; const char* b2 = last ? nB : cB + (size_t)(t + 2) * kstep;
            const char* a3 = a2 + kstep; const char* b3 = b2 + kstep;
            PG8_LDB(B0, 0, 0); PG8_LDB(B1, 0, 1); PG8_SCHED; PG8_LDA(At, 0, 0); PG8_STAGE(PG8_SA(1, 1), a1 + hstepA, voffA);
            PG8_WAIT_V(8); PG8_WAIT_L(0); PG8_BAR; PG8_MMA(0, 0, At, B0); PG8_MMA(0, 1, At, B1); PG8_BAR; PG8_SCHED;
            PG8_LDA(At, 0, 1); PG8_STAGE(PG8_SB(0, 0), b2, voffB); PG8_STAGE(PG8_SB(0, 1), b2 + hstepB, voffB); PG8_STAGE(PG8_SA(0, 0), a2, voffA);
            PG8_WAIT_V(8); PG8_WAIT_L(0); PG8_BAR; PG8_MMA(1, 0, At, B0); PG8_MMA(1, 1, At, B1); PG8_BAR; PG8_SCHED;
            PG8_LDB(B0, 1, 0); PG8_LDB(B1, 1, 1); PG8_SCHED; PG8_LDA(At, 1, 0); PG8_STAGE(PG8_SA(0, 1), a2 + hstepA, voffA);
            PG8_WAIT_V(8); PG8_WAIT_L(0); PG8_BAR; PG8_MMA(0, 0, At, B0); PG8_MMA(0, 1, At, B1); PG8_BAR; PG8_SCHED;
            PG8_LDA(At, 1, 1); PG8_STAGE(PG8_SB(1, 0), b3, voffB); PG8_STAGE(PG8_SB(1, 1), b3 + hstepB, voffB); PG8_STAGE(PG8_SA(1, 0), a3, voffA);
            PG8_WAIT_V(8); PG8_WAIT_L(0); PG8_BAR; PG8_MMA(1, 0, At, B0); PG8_MMA(1, 1, At, B1); PG8_BAR; PG8_SCHED;
        }
        if (wr == 0) PG8_BAR;
        E(acc, cur, wr, wc, fr, fq);
        if (!has_next) break;
#pragma unroll
        for (int a = 0; a < 2; ++a)
#pragma unroll
            for (int b = 0; b < 2; ++b)
#pragma unroll
                for (int m = 0; m < 4; ++m)
#pragma unroll
                    for (int n = 0; n < 2; ++n) acc[a][b][m][n] = (f32x4){0.f, 0.f, 0.f, 0.f};
        cur = nxt; cA = nA; cB = nB; ++ui;
        if (wr == 1) PG8_BAR;
    }
    PG8_WAIT_V(0);
    PG8_BAR;
#undef PG8_SA
#undef PG8_SB
#undef PG8_STAGE
#undef PG8_LDA
#undef PG8_LDB
#undef PG8_MMA
#undef PG8_WAIT_V
#undef PG8_WAIT_L
#undef PG8_BAR
#undef PG8_SCHED
}
}
struct Params { const float* in[27]; float* out; unsigned char* ws; int ph_lo, ph_hi, pad0, pad1; };
enum { I_X = 0, I_MEM, I_POS, I_MIXG, I_WIN, I_POOLW, I_POOLS, I_CONVW, I_ALOG, I_DTB, I_DNG, I_WUPP, I_WUPM, I_WUPD, I_WOUT, I_XAG, I_MEMG, I_XAQ, I_XAKV, I_XAO,
       I_FFNG, I_DGU, I_DD, I_ROUTER, I_MGU, I_MD, I_FING };

struct Frame {
    LAS unsigned char* lds;
    int tid, lane, wave, G, blk;
    unsigned char* ws;
};

#ifndef FFN1_F8
#define FFN1_F8 1
#endif
#ifndef INPROJ_F8
#define INPROJ_F8 0
#endif
struct Job { const float* W; int K, N; bf16_t* WT; int ldt; int mode; int ff; const float* kscale; unsigned char* WT8; };
DI int job_map(int mode, int ff, int n) {
    if (mode == 0) return n;
    if (mode == 1) return n < 2560 ? n : (n < 2576 ? -1 : n - 16);
    if (n < ff) return (n >> 7) * 256 + (n & 127);
    const int m = n - ff; return (m >> 7) * 256 + 128 + (m & 127);
}
DI int job_items(const Job& J) { return (J.K / 64) * ((J.N + 31) / 32); }
DI void transpose_item(const Job& J, LAS float* scr, int item, int lane) {
    const int nblk = (J.N + 31) / 32, kb = item / nblk, nb = item - kb * nblk, k0 = 64 * kb, n0 = 32 * nb;
    const int n4 = (lane & 7) * 4, kr = lane >> 3; const bool ok = (n0 + n4) < J.N;
    f32x4 tv[8];
#pragma unroll
    for (int i = 0; i < 8; ++i) { const int kk = 8 * i + kr; tv[i] = *(const f32x4*)(J.W + (size_t)(k0 + kk) * J.N + (ok ? n0 + n4 : 0)); }
#pragma unroll
    for (int i = 0; i < 8; ++i) { const int kk = 8 * i + kr; f32x4 v = ok ? tv[i] : (f32x4){0.f, 0.f, 0.f, 0.f}; if (J.kscale) v *= J.kscale[k0 + kk];
        scr[kk * 33 + n4] = v.x; scr[kk * 33 + n4 + 1] = v.y; scr[kk * 33 + n4 + 2] = v.z; scr[kk * 33 + n4 + 3] = v.w; }
    LDS_WAIT();
    const int c = lane & 7;
#pragma unroll
    for (int j = 0; j < 4; ++j) { const int n = (lane >> 3) + 8 * j; const int sn = n0 + n; const int drow = sn < J.N ? job_map(J.mode, J.ff, sn) : -1;
        if (drow >= 0) { const LAS float* s = scr + (8 * c) * 33 + n;
            if ((J.mode == 1 && (INPROJ_F8 || drow >= 3072)) || J.mode == 3) { u32x2 o;
                o.x = cvt4_fp8(s[0 * 33] * 32.f, s[1 * 33] * 32.f, s[2 * 33] * 32.f, s[3 * 33] * 32.f); o.y = cvt4_fp8(s[4 * 33] * 32.f, s[5 * 33] * 32.f, s[6 * 33] * 32.f, s[7 * 33] * 32.f);
                unsigned char* dst8 = J.mode == 3 ? J.WT8 + (size_t)drow * 1024 : (drow >= 3072 ? J.WT8 + (size_t)(drow - 3072) * 1024 : (unsigned char*)J.WT + (size_t)drow * 1024);
                *(u32x2*)(dst8 + k0 + 8 * c) = o; }
            else { u32x4 o; o.x = pk2(s[0 * 33], s[1 * 33]); o.y = pk2(s[2 * 33], s[3 * 33]); o.z = pk2(s[4 * 33], s[5 * 33]); o.w = pk2(s[6 * 33], s[7 * 33]);
                *(u32x4*)(J.WT + (size_t)drow * J.ldt + k0 + 8 * c) = o; } } }
    LDS_WAIT();
}
constexpr int NJOBS = 2 * 7 + 2 + 16;
DI void get_job(const Frame& F, const Params& P, int j, Job& J) {
    unsigned char* ws = F.ws;
    J.mode = 0; J.ff = 0; J.kscale = nullptr; J.WT8 = nullptr;
    if (j < 14) { const int l = j / 7, t = j - 7 * l; unsigned char* lw = ws + WS_LW + (size_t)l * LW_STRIDE;
        if (t == 0) { J.W = P.in[I_WIN] + (size_t)l * 1024 * IN_COLS; J.K = 1024; J.N = IN_COLS; J.WT = (bf16_t*)(lw + LW_WIN); J.ldt = 1024; J.mode = 1; J.kscale = P.in[I_MIXG] + l * 1024; J.WT8 = ws + WS_WG8 + (size_t)l * 3072 * 1024; }
        else if (t == 1) { J.W = P.in[I_WUPM] + (size_t)l * 256 * 1024; J.K = 256; J.N = 1024; J.WT = (bf16_t*)(lw + LW_WCAT) + 256; J.ldt = 1024; }
        else if (t == 2) { J.W = P.in[I_WUPD] + (size_t)l * 512 * 1024; J.K = 512; J.N = 1024; J.WT = (bf16_t*)(lw + LW_WCAT) + 512; J.ldt = 1024; }
        else if (t == 3) { J.W = P.in[I_WOUT] + (size_t)l * 1024 * 1024; J.K = 1024; J.N = 1024; J.WT = (bf16_t*)(lw + LW_WOUT); J.ldt = 1024; }
        else if (t == 4) { J.W = P.in[I_XAQ] + (size_t)l * 1024 * 512; J.K = 1024; J.N = 512; J.WT = (bf16_t*)(lw + LW_WQ); J.ldt = 1024; J.kscale = P.in[I_XAG] + l * 1024; }
        else if (t == 5) { J.W = P.in[I_XAKV] + (size_t)l * 1024 * 1024; J.K = 1024; J.N = 1024; J.WT = (bf16_t*)(lw + LW_WKV); J.ldt = 1024; }
        else { J.W = P.in[I_XAO] + (size_t)l * 512 * 1024; J.K = 512; J.N = 1024; J.WT = (bf16_t*)(lw + LW_WO); J.ldt = 512; }
    } else if (j == 14) { J.W = P.in[I_DGU]; J.K = 1024; J.N = 2 * FF; J.WT = (bf16_t*)(ws + WS_WGU); J.ldt = 1024; J.mode = FFN1_F8 ? 3 : 2; J.ff = FF; J.kscale = P.in[I_FFNG]; J.WT8 = ws + WS_WGU; }
    else if (j == 15) { J.W = P.in[I_DD]; J.K = FF; J.N = 1024; J.WT = (bf16_t*)(ws + WS_WD); J.ldt = FF; }
    else { const int e = (j - 16) >> 1;
        if (((j - 16) & 1) == 0) { J.W = P.in[I_MGU] + (size_t)e * 1024 * 2 * EFF; J.K = 1024; J.N = 2 * EFF; J.WT = (bf16_t*)(ws + WS_WMGU) + (size_t)e * 2 * EFF * 1024; J.ldt = 1024; J.mode = 2; J.ff = EFF; J.kscale = P.in[I_FFNG] + 1024; }
        else { J.W = P.in[I_MD] + (size_t)e * EFF * 1024; J.K = EFF; J.N = 1024; J.WT = (bf16_t*)(ws + WS_WMD) + (size_t)e * 1024 * EFF; J.ldt = EFF; } }
}

DI void phase_prologue(const Frame& F, const Params& P) {
    unsigned char* ws = F.ws;
    const int gw = F.blk * 8 + F.wave, NGW = F.G * 8, lane = F.lane;
    const long gt = (long)F.blk * 512 + F.tid, NGT = (long)F.G * 512;
    { const float* x = P.in[I_X]; bf16_t* xb = (bf16_t*)(ws + WS_XB); float* ssq = (float*)(ws + WS_SSQ); unsigned char* x8 = ws + WS_X8;
      for (int row0 = gw; row0 < NTOK; row0 += 4 * NGW) {
          f32x4 v[4][4];
#pragma unroll
          for (int q = 0; q < 4; ++q) { const int row = row0 + q * NGW; const f32x4* xr = (const f32x4*)(x + (size_t)(row < NTOK ? row : row0) * 1024) + lane;
#pragma unroll
              for (int j = 0; j < 4; ++j) v[q][j] = xr[64 * j]; }
#pragma unroll
          for (int q = 0; q < 4; ++q) { const int row = row0 + q * NGW; if (row < NTOK) { float s = 0.f;
#pragma unroll
              for (int j = 0; j < 4; ++j) s += (v[q][j].x * v[q][j].x + v[q][j].y * v[q][j].y) + (v[q][j].z * v[q][j].z + v[q][j].w * v[q][j].w);
              s = wave_sum(s);
              u32x2* o = (u32x2*)(xb + (size_t)row * 1024) + lane;
#pragma unroll
              for (int j = 0; j < 4; ++j) { u32x2 w; w.x = pk2(v[q][j].x, v[q][j].y); w.y = pk2(v[q][j].z, v[q][j].w); o[64 * j] = w;
                  ((unsigned*)(x8 + (size_t)row * 1024))[lane + 64 * j] = cvt4_fp8(v[q][j].x, v[q][j].y, v[q][j].z, v[q][j].w); }
              if (lane < 16) ssq[(size_t)row * 16 + lane] = lane == 0 ? s : 0.f; } }
      } }
    { const float* mem = P.in[I_MEM]; bf16_t* mn = (bf16_t*)(ws + WS_MEMN);
      for (int row = gw; row < 2048; row += NGW) {
          const f32x4* xr = (const f32x4*)(mem + (size_t)row * 1024) + lane; f32x4 v[4]; float s = 0.f;
#pragma unroll
          for (int j = 0; j < 4; ++j) { v[j] = xr[64 * j]; s += (v[j].x * v[j].x + v[j].y * v[j].y) + (v[j].z * v[j].z + v[j].w * v[j].w); }
          s = wave_sum(s); const float r = rsqrtf(s * (1.0f / 1024.0f) + RMS_EPS);
#pragma unroll
          for (int l = 0; l < 2; ++l) { const f32x4* gr = (const f32x4*)(P.in[I_MEMG] + l * 1024) + lane; u32x2* o = (u32x2*)(mn + ((size_t)l * 2048 + row) * 1024) + lane;
#pragma unroll
              for (int j = 0; j < 4; ++j) { const f32x4 gg = gr[64 * j]; u32x2 w; w.x = pk2(v[j].x * r * gg.x, v[j].y * r * gg.y); w.y = pk2(v[j].z * r * gg.z, v[j].w * r * gg.w); o[64 * j] = w; } }
      } }
    { const int* pos = (const int*)P.in[I_POS]; float* rope = (float*)(ws + WS_ROPE);
      for (long i = gt; i < (long)NTOK * 8; i += NGT) { const int tok = (int)(i >> 3), f = (int)(i & 7);
          const float inv = powf(500000.0f, -(float)f * 2.0f / 16.0f); const float ang = (float)pos[tok] * inv; float sn, cs; sincosf(ang, &sn, &cs);
          rope[(size_t)tok * 16 + f] = cs; rope[(size_t)tok * 16 + 8 + f] = sn; } }
    for (long i = gt; i < 2 * 16 * 1024; i += NGT) { const int l = (int)(i >> 14), j = (int)((i >> 10) & 15), k = (int)(i & 1023);
        const float v = P.in[I_WIN][((size_t)l * 1024 + k) * IN_COLS + 2560 + j] * P.in[I_MIXG][l * 1024 + k];
        ((bf16_t*)(ws + WS_LW + (size_t)l * LW_STRIDE + LW_WBA))[j * 1024 + k] = (bf16_t)f2bf(v); }
    for (long i = gt; i < 8 * 1024; i += NGT) { const int e = (int)(i >> 10), k = (int)(i & 1023); ((float*)(ws + WS_WR))[e * 1024 + k] = P.in[I_ROUTER][k * 8 + e] * P.in[I_FFNG][1024 + k]; }
    for (long i = gt; i < 2L * 256 * 1024; i += NGT) { const int l = (int)(i >> 18), k = (int)((i >> 10) & 255), n = (int)(i & 1023), gi = k >> 6, c = k & 63;
        const float* pw = P.in[I_POOLW] + (((size_t)l * 4 + gi) * 64 + c) * 64; const float* ps = P.in[I_POOLS] + l * 256 + gi * 64; const float* wu = P.in[I_WUPP] + ((size_t)l * 256 + gi * 64) * 1024 + n;
        float s = 0.f;
#pragma unroll 16
        for (int d = 0; d < 64; ++d) s += pw[d] * ps[d] * wu[(size_t)d * 1024];
        ((bf16_t*)(ws + WS_LW + (size_t)l * LW_STRIDE + LW_WCAT))[(size_t)n * 1024 + k] = (bf16_t)f2bf(s); }
    { float* sm = (float*)(ws + WS_SMALL);
      for (long i = gt; i < 2 * 4 * 1536; i += NGT) sm[SM_CONVW + i] = P.in[I_CONVW][i];
      for (long i = gt; i < 16; i += NGT) { sm[SM_ALOG + i] = P.in[I_ALOG][i]; sm[SM_DTB + i] = P.in[I_DTB][i]; }
      for (long i = gt; i < 128; i += NGT) sm[SM_DNG + i] = P.in[I_DNG][i];
      for (long i = gt; i < 1024; i += NGT) sm[SM_FING + i] = P.in[I_FING][i]; }
    { LAS float* scr = (LAS float*)(F.lds + F.wave * 8704);
      int base = 0;
      for (int j = 0; j < NJOBS; ++j) { Job J; get_job(F, P, j, J); const int ni = job_items(J);
          int first = gw - (base % NGW); if (first < 0) first += NGW;
          for (int it = first; it < ni; it += NGW) transpose_item(J, scr, it, lane);
          base += ni; } }
}
DI void ba_tiles(const Frame& F, const bf16_t* xbg, const bf16_t* Wba, const float* ssqg, float* BA) {
    const int lane = F.lane, gw = F.blk * 8 + F.wave, NGW = F.G * 8;
    for (int tile = gw; tile < NG / 16; tile += NGW) {
        const int row0 = tile * 16; f32x4 acc = (f32x4){0.f, 0.f, 0.f, 0.f};
        const bf16_t* ap = xbg + (size_t)(row0 + (lane & 15)) * 1024 + (lane >> 4) * 8; const bf16_t* bp = Wba + (size_t)(lane & 15) * 1024 + (lane >> 4) * 8;
#pragma unroll 8
        for (int ks = 0; ks < 32; ++ks) { const bf16x8 a = *(const bf16x8*)(ap + 32 * ks); const bf16x8 b = *(const bf16x8*)(bp + 32 * ks); acc = MFMA16(a, b, acc); }
#pragma unroll
        for (int i = 0; i < 4; ++i) { const int row = row0 + 4 * (lane >> 4) + i; BA[(size_t)row * 16 + (lane & 15)] = acc[i] * row_rstd(ssqg, row); }
    }
}

template <int W> DI void prep_pool_w(const bf16_t* Pb, bf16_t* BR, int g, int lane, int lr0, int s0) {
    const int cg = lane & 7, tb = lane >> 3, ch = g * 64 + cg * 8, lr = lr0 + tb * 8, s = s0 + tb * 8;
    const bf16_t* p = Pb + PC_POOL + ch; u32x4 rv[8 + W - 1];
#pragma unroll
    for (int i = 0; i < 8 + W - 1; ++i) { const int d = i - (W - 1); const bool ok = s + d >= 0; rv[i] = *(const u32x4*)(p + (size_t)(ok ? lr + d : lr) * PLD); if (!ok) rv[i] = (u32x4){0u, 0u, 0u, 0u}; }
    f32x2 sum[4];
#pragma unroll
    for (int q = 0; q < 4; ++q) sum[q] = (f32x2){0.f, 0.f};
#pragma unroll
    for (int i = 0; i < W - 1; ++i)
#pragma unroll
        for (int q = 0; q < 4; ++q) sum[q] += (f32x2){__uint_as_float(rv[i][q] << 16), __uint_as_float(rv[i][q] & 0xffff0000u)};
#pragma unroll
    for (int t = 0; t < 8; ++t) { const int st = s + t; const float inv = st + 1 >= W ? (1.0f / (float)W) : 1.0f / (float)(st + 1); u32x4 w;
#pragma unroll
        for (int q = 0; q < 4; ++q) { const f32x2 x = (f32x2){__uint_as_float(rv[t + W - 1][q] << 16), __uint_as_float(rv[t + W - 1][q] & 0xffff0000u)}; sum[q] += x;
            const f32x2 o = sum[q] * inv - x; w[q] = pk2(o.x, o.y);
            sum[q] -= (f32x2){__uint_as_float(rv[t][q] << 16), __uint_as_float(rv[t][q] & 0xffff0000u)}; }
        *(u32x4*)(BR + (size_t)(lr + t) * 1024 + ch) = w; }
}
DI void prep_pool(const Frame& F, const bf16_t* Pb, bf16_t* BR, int unit2) {
    int lane_ = F.lane; LAUNDER_V(lane_);
    const int lane = lane_, g = F.wave & 3, lr0 = (unit2 * 2 + (F.wave >> 2)) * 64, s0 = lr0 & (SEQ - 1);
    if (g == 0) prep_pool_w<2>(Pb, BR, g, lane, lr0, s0); else if (g == 1) prep_pool_w<4>(Pb, BR, g, lane, lr0, s0); else if (g == 2) prep_pool_w<8>(Pb, BR, g, lane, lr0, s0); else prep_pool_w<16>(Pb, BR, g, lane, lr0, s0);
}

DI void prep_moba(const Frame& F, bf16_t* Pb, const float* rope, float* KBAR, bf16_t* VT, int unit) {
    int tid_ = F.tid; LAUNDER_V(tid_);
    const int tid = tid_, lane = tid & 63, wave = F.wave;
    const int bl = unit >> 6, j = (unit >> 1) & 31, hp = unit & 1, lr0 = bl * SEQ + j * 256;
    LAS unsigned* Tt = (LAS unsigned*)F.lds; LAS float* KS1 = (LAS float*)(F.lds + 68 * 1024); LAS float* KS2 = KS1 + 128;
    __syncthreads();
    const int r = tid & 255, hh = tid >> 8; const size_t lr = (size_t)(lr0 + r);
    bf16_t* qb = Pb + lr * PLD + PC_MQ + (2 * hp + hh) * 64; bf16_t* kb = Pb + lr * PLD + PC_MK + (2 * hp + hh) * 64;
    const f32x4 c0 = *(const f32x4*)(rope + lr * 16), c1 = *(const f32x4*)(rope + lr * 16 + 4), s0 = *(const f32x4*)(rope + lr * 16 + 8), s1 = *(const f32x4*)(rope + lr * 16 + 12);
    const u32x4 qa = *(const u32x4*)qb, qc = *(const u32x4*)(qb + 8), ka = *(const u32x4*)kb, kc = *(const u32x4*)(kb + 8);
    const int c8 = tid & 15, rg = tid >> 4; const bool plain = (c8 & 7) >= 2;
    u32x4 vv[8], kk[8];
#pragma unroll
    for (int i = 0; i < 8; ++i) vv[i] = *(const u32x4*)(Pb + (size_t)(lr0 + ((tid + 512 * i) >> 4)) * PLD + PC_MV + hp * 128 + c8 * 8);
#pragma unroll
    for (int i = 0; i < 8; ++i) kk[i] = plain ? *(const u32x4*)(Pb + (size_t)(lr0 + rg * 8 + i) * PLD + PC_MK + hp * 128 + c8 * 8) : (u32x4){0u, 0u, 0u, 0u};
    __builtin_amdgcn_sched_barrier(0);
    {
        const float cs[8] = {c0.x, c0.y, c0.z, c0.w, c1.x, c1.y, c1.z, c1.w}, sn[8] = {s0.x, s0.y, s0.z, s0.w, s1.x, s1.y, s1.z, s1.w};
        float q1[8], q2[8], k1[8], k2[8];
#pragma unroll
        for (int q = 0; q < 4; ++q) { q1[2 * q] = __uint_as_float(qa[q] << 16); q1[2 * q + 1] = __uint_as_float(qa[q] & 0xffff0000u); q2[2 * q] = __uint_as_float(qc[q] << 16); q2[2 * q + 1] = __uint_as_float(qc[q] & 0xffff0000u);
                                      k1[2 * q] = __uint_as_float(ka[q] << 16); k1[2 * q + 1] = __uint_as_float(ka[q] & 0xffff0000u); k2[2 * q] = __uint_as_float(kc[q] << 16); k2[2 * q + 1] = __uint_as_float(kc[q] & 0xffff0000u); }
        float ra[8], rb[8]; u32x4 oa, ob;
#pragma unroll
        for (int e = 0; e < 8; ++e) { ra[e] = q1[e] * cs[e] - q2[e] * sn[e]; rb[e] = q2[e] * cs[e] + q1[e] * sn[e]; }
#pragma unroll
        for (int q = 0; q < 4; ++q) { oa[q] = pk2(ra[2 * q], ra[2 * q + 1]); ob[q] = pk2(rb[2 * q], rb[2 * q + 1]); }
        *(u32x4*)qb = oa; *(u32x4*)(qb + 8) = ob;
#pragma unroll
        for (int e = 0; e < 8; ++e) { ra[e] = k1[e] * cs[e] - k2[e] * sn[e]; rb[e] = k2[e] * cs[e] + k1[e] * sn[e]; }
#pragma unroll
        for (int q = 0; q < 4; ++q) { oa[q] = pk2(ra[2 * q], ra[2 * q + 1]); ob[q] = pk2(rb[2 * q], rb[2 * q + 1]); }
        *(u32x4*)kb = oa; *(u32x4*)(kb + 8) = ob;
#pragma unroll
        for (int e = 0; e < 8; ++e) { const float a = wave_sum(ra[e]), b = wave_sum(rb[e]); if (lane == 0) { KS1[wave * 16 + e] = a; KS1[wave * 16 + 8 + e] = b; } }
    }
    {
        float sacc[8];
#pragma unroll
        for (int e = 0; e < 8; ++e) sacc[e] = 0.f;
#pragma unroll
        for (int i = 0; i < 8; ++i)
#pragma unroll
            for (int q = 0; q < 4; ++q) { sacc[2 * q] += __uint_as_float(kk[i][q] << 16); sacc[2 * q + 1] += __uint_as_float(kk[i][q] & 0xffff0000u); }
#pragma unroll
        for (int e = 0; e < 8; ++e) { sacc[e] += __shfl_xor(sacc[e], 16); sacc[e] += __shfl_xor(sacc[e], 32); }
        if (lane < 16) {
#pragma unroll
            for (int e = 0; e < 8; ++e) KS2[wave * 128 + c8 * 8 + e] = sacc[e]; }
    }
#pragma unroll
    for (int i = 0; i < 8; ++i) { const int tok = (tid + 512 * i) >> 4;
#pragma unroll
        for (int e = 0; e < 4; ++e) Tt[tok * 65 + c8 * 4 + e] = vv[i][e]; }
    __syncthreads();
    if (tid < 128) { const int h2 = tid >> 6, d = tid & 63; float sum = 0.f;
        if (d < 16) {
#pragma unroll
            for (int w = 0; w < 4; ++w) sum += KS1[(4 * h2 + w) * 16 + d]; }
        else {
#pragma unroll
            for (int w = 0; w < 8; ++w) sum += KS2[w * 128 + tid]; }
        KBAR[((size_t)(bl * 4 + 2 * hp + h2) * 32 + j) * 64 + d] = sum * (1.0f / 256.0f); }
    const LAS unsigned char* Tb = (const LAS unsigned char*)Tt;
#pragma unroll
    for (int i = 0; i < 8; ++i) { const int o = tid + 512 * i, t8 = o & 7, cl = (o >> 3) & 7, rest = o >> 6, th = rest & 3, cg = rest >> 2, col = cg * 8 + cl, tg = th * 8 + t8;
        unsigned short hv[8];
#pragma unroll
        for (int e = 0; e < 8; ++e) hv[e] = *(const LAS unsigned short*)(Tb + ((tg * 8 + e) * 65 + (col >> 1)) * 4 + (col & 1) * 2);
        u32x4 w;
#pragma unroll
        for (int e = 0; e < 4; ++e) w[e] = (unsigned)hv[2 * e] | ((unsigned)hv[2 * e + 1] << 16);
        *(u32x4*)(VT + ((size_t)(bl * 256 + hp * 128 + col)) * SEQ + j * 256 + tg * 8) = w; }
    __syncthreads();
}

constexpr int DN_ROWB = 144;
constexpr int DN_TQ = 0, DN_TK = 9216, DN_TKB = 18432, DN_TVB = 27648, DN_MISC = 36864, DN_PAIR = 38400;
__host__ __device__ constexpr int ap_rowoff(int i) { return i == 0 ? 0 : 4 * (((i - 1) / 4) + 1) * (2 * ((i - 1) / 4) + ((i - 1) % 4)); }

template <int I> DI void subst_load(const LAS float* Ap, const LAS unsigned char* Rt, const LAS float* SCL, int lane, f32x4 (&av)[16], float& Ri) {
    constexpr int off = ap_rowoff(I);
#pragma unroll
    for (int j4 = 0; j4 < I; j4 += 4) av[j4 >> 2] = *(const LAS f32x4*)(Ap + off + j4);
#ifdef DBG_LDS2X
#pragma unroll
    for (int j4 = 0; j4 < I; j4 += 4) { f32x4 t_ = *(const volatile LAS f32x4*)(Ap + off + j4); asm volatile("" :: "v"(t_)); }
#endif
    Ri = bf2f(*(const LAS bf16_t*)(Rt + I * DN_ROWB + lane * 2)) * SCL[I];
}
template <int I> struct Subst2 { static DI void run(f32x2 (&x)[32], const LAS float* Ap, const LAS unsigned char* Rt, const LAS float* SCL, int lane, f32x4 (&cur)[16], float Rc, f32x4 (&nxt)[16]) {
    float Rn = 0.f;
    if constexpr (I + 1 < 64) subst_load<I + 1>(Ap, Rt, SCL, lane, nxt, Rn);
    f32x2 a01 = (f32x2){Rc, 0.f}, a23 = (f32x2){0.f, 0.f};
#pragma unroll
    for (int j4 = 0; j4 < I; j4 += 4) { const f32x4 av = cur[j4 >> 2];
        a01 -= (f32x2){av.x, av.y} * x[j4 >> 1];
        if (j4 + 2 < I) a23 -= (f32x2){av.z, av.w} * x[(j4 >> 1) + 1]; }
    const f32x2 sm = a01 + a23; float xi = sm.x + sm.y;
    asm volatile("" : "+v"(xi)); __builtin_amdgcn_sched_barrier(0);
    if constexpr (I & 1) x[I >> 1].y = xi; else x[I >> 1].x = xi;
    if constexpr (I + 1 < 64) Subst2<I + 1>::run(x, Ap, Rt, SCL, lane, nxt, Rn, cur);
} };

DI void conv_w_load(const float* convw, int wcol, f32x2 (&w)[4][4]) {
#pragma unroll
    for (int j = 0; j < 4; ++j) { const f32x4 w0 = *(const f32x4*)(convw + j * 1536 + wcol), w1 = *(const f32x4*)(convw + j * 1536 + wcol + 4);
        w[j][0] = (f32x2){w0.x, w0.y}; w[j][1] = (f32x2){w0.z, w0.w}; w[j][2] = (f32x2){w1.x, w1.y}; w[j][3] = (f32x2){w1.z, w1.w}; }
}
DI void conv8(const bf16_t* Pb, const f32x2 (&w)[4][4], int lr, int s, int pcol8, bool edge, f32x2 (&a)[4]) {
    u32x4 xv[4];
#pragma unroll
    for (int j = 0; j < 4; ++j) { const bool valid = !edge || (s - 3 + j) >= 0; xv[j] = *(const u32x4*)(Pb + (size_t)(valid ? lr - 3 + j : lr) * PLD + pcol8); }
    if (edge) {
#pragma unroll
        for (int j = 0; j < 3; ++j) { const bool valid = (s - 3 + j) >= 0; xv[j].x = valid ? xv[j].x : 0u; xv[j].y = valid ? xv[j].y : 0u; xv[j].z = valid ? xv[j].z : 0u; xv[j].w = valid ? xv[j].w : 0u; } }
#pragma unroll
    for (int q = 0; q < 4; ++q) a[q] = (f32x2){0.f, 0.f};
#pragma unroll
    for (int j = 0; j < 4; ++j)
#pragma unroll
        for (int q = 0; q < 4; ++q) a[q] += w[j][q] * (f32x2){__uint_as_float(xv[j][q] << 16), __uint_as_float(xv[j][q] & 0xffff0000u)};
#pragma unroll
    for (int q = 0; q < 4; ++q) { const f32x2 t = a[q] * -1.44269504089f; f32x2 e = (f32x2){__builtin_amdgcn_exp2f(t.x), __builtin_amdgcn_exp2f(t.y)}; e += 1.0f;
        a[q] *= (f32x2){__builtin_amdgcn_rcpf(e.x), __builtin_amdgcn_rcpf(e.y)}; }
}
DI float ssq8(const f32x2 (&a)[4]) { f32x2 s2 = a[0] * a[0];
#pragma unroll
    for (int q = 1; q < 4; ++q) s2 += a[q] * a[q];
    float ss = s2.x + s2.y;
    ss += __shfl_xor(ss, 1); ss += __shfl_xor(ss, 2); ss += __shfl_xor(ss, 4); return ss; }
DI u32x4 pack8(const f32x2 (&a)[4], float sc) { u32x4 w;
#pragma unroll
    for (int q = 0; q < 4; ++q) { const f32x2 t = a[q] * sc; w[q] = pk2(t.x, t.y); }
    return w; }

template <int NTK, class Sink> DI void conv_slide(const bf16_t* Pb, const f32x2 (&w)[4][4], int lr0, int s0, int pcol8, bool edge, Sink&& sink) {
    u32x4 xv[NTK + 3];
#pragma unroll
    for (int i = 0; i < NTK + 3; ++i) { const bool valid = !edge || (s0 - 3 + i) >= 0; xv[i] = *(const u32x4*)(Pb + (size_t)(valid ? lr0 - 3 + i : lr0) * PLD + pcol8); }
    if (edge) {
#pragma unroll
        for (int i = 0; i < 3; ++i) { const bool valid = (s0 - 3 + i) >= 0; xv[i].x = valid ? xv[i].x : 0u; xv[i].y = valid ? xv[i].y : 0u; xv[i].z = valid ? xv[i].z : 0u; xv[i].w = valid ? xv[i].w : 0u; } }
    f32x2 xr[4][4];
#pragma unroll
    for (int i = 0; i < 3; ++i)
#pragma unroll
        for (int q = 0; q < 4; ++q) xr[i][q] = (f32x2){__uint_as_float(xv[i][q] << 16), __uint_as_float(xv[i][q] & 0xffff0000u)};
#pragma unroll
    for (int i = 0; i < NTK; ++i) {
#pragma unroll
        for (int q = 0; q < 4; ++q) xr[(i + 3) & 3][q] = (f32x2){__uint_as_float(xv[i + 3][q] << 16), __uint_as_float(xv[i + 3][q] & 0xffff0000u)};
        f32x2 a[4];
#pragma unroll
        for (int q = 0; q < 4; ++q) { a[q] = w[0][q] * xr[i & 3][q];
#pragma unroll
            for (int jt = 1; jt < 4; ++jt) a[q] += w[jt][q] * xr[(i + jt) & 3][q]; }
#pragma unroll
        for (int q = 0; q < 4; ++q) { const f32x2 t = a[q] * -1.44269504089f; f32x2 e = (f32x2){__builtin_amdgcn_exp2f(t.x), __builtin_amdgcn_exp2f(t.y)}; e += 1.0f;
            a[q] *= (f32x2){__builtin_amdgcn_rcpf(e.x), __builtin_amdgcn_rcpf(e.y)}; }
        sink(i, a);
    }
}

#ifndef DBG_RA
#define DBG_RA 1
#endif
#ifndef DBG_RB
#define DBG_RB 1
#endif
#ifndef DBG_RC
#define DBG_RC 1
#endif
#ifndef DBG_RD
#define DBG_RD 1
#endif
#ifndef DBG_RB2
#define DBG_RB2 1
#endif
constexpr int DN_PCNT = 4 * DN_PAIR;
DI void pair_bar(LAS unsigned* cnt, unsigned& gen, int lane) {
    asm volatile("s_waitcnt lgkmcnt(0)" ::: "memory");
    gen += 2u;
    if (lane == 0) __hip_atomic_fetch_add(cnt, 1u, __ATOMIC_RELAXED, __HIP_MEMORY_SCOPE_WORKGROUP);
    for (;;) { const unsigned v = __builtin_amdgcn_readfirstlane(__hip_atomic_load(cnt, __ATOMIC_RELAXED, __HIP_MEMORY_SCOPE_WORKGROUP)); if (v >= gen) break; __builtin_amdgcn_s_sleep(1); }
    asm volatile("" ::: "memory");
}
DI void prep_dn(const Frame& F, const bf16_t* Pb, const float* BA, const float* convw, const float* alog, const float* dtb,
                bf16_t* QD, bf16_t* MM, bf16_t* NT, bf16_t* WN, bf16_t* UT, bf16_t* AQK, float* GL, int unit, unsigned& pgen) {
    int lane_ = F.lane; LAUNDER_V(lane_);
    const int lane = lane_, wave = F.wave, pr = wave >> 1, role = wave & 1;
    const int bl = unit >> 8, rem = unit & 255, n = rem >> 1, hq = rem & 1, h = 4 * hq + pr;
    const int lr0 = bl * SEQ + n * 64;
    const int chidx = (bl * 128 + n) * 8 + h;
    LAS unsigned char* L = F.lds + pr * DN_PAIR;
    LAS unsigned* const pcnt = (LAS unsigned*)(F.lds + DN_PCNT) + pr * 16;
#define PAIR_BAR() pair_bar(pcnt, pgen, lane)
    LAS float* Gs = (LAS float*)(L + DN_MISC); LAS float* EG = Gs + 64; LAS float* EGL = Gs + 128; LAS float* ONES = Gs + 192; LAS float* BETA = Gs + 256 + 64 * role;
    {
        const int lr = lr0 + lane;
        const float braw = BA[(size_t)lr * 16 + h], araw = BA[(size_t)lr * 16 + 8 + h];
        const float beta = fsigmoid(braw);
        const float xa = araw + dtb[h]; const float sp = xa > 20.f ? xa : log1pf(__expf(xa));
        float G = -__expf(alog[h]) * sp;
#pragma unroll
        for (int o = 1; o < 64; o <<= 1) { const float up = __shfl_up(G, o); if (lane >= o) G += up; }
        const float Glast = __shfl(G, 63);
        BETA[lane] = beta;
        if (role == 0) { Gs[lane] = G; EG[lane] = __expf(G); EGL[lane] = __expf(Glast - G); ONES[lane] = 1.0f; if (lane == 0) GL[chidx] = __expf(Glast); }
    }
    LDS_WAIT();
    for (int rpA = 0; rpA < DBG_RA; ++rpA) {
        const int cg = lane & 7, tl = lane >> 3; f32x2 w[4][4]; const bool edge = (n == 0);
        if (role == 0) {
            conv_w_load(convw, h * 64 + cg * 8, w);
            conv_slide<8>(Pb, w, lr0 + 8 * tl, n * 64 + 8 * tl, PC_DQ + h * 64 + cg * 8, edge, [&](int i, const f32x2 (&a)[4]) { const int t = 8 * tl + i;
                const float rn = rsqrtf(ssq8(a) + RMS_EPS) * 0.125f;
                *(LAS u32x4*)(L + DN_TQ + t * DN_ROWB + cg * 16) = pack8(a, rn); });
        } else {
            conv_w_load(convw, 512 + h * 64 + cg * 8, w);
            conv_slide<8>(Pb, w, lr0 + 8 * tl, n * 64 + 8 * tl, PC_DK + h * 64 + cg * 8, edge, [&](int i, const f32x2 (&a)[4]) { const int t = 8 * tl + i;
                const float rn = rsqrtf(ssq8(a) + RMS_EPS);
                *(LAS u32x4*)(L + DN_TK + t * DN_ROWB + cg * 16) = pack8(a, rn); *(LAS u32x4*)(L + DN_TKB + t * DN_ROWB + cg * 16) = pack8(a, rn * BETA[t]); });
        }
        { const int cgv = 4 * role + (lane & 3), tv = lane >> 2;
          conv_w_load(convw, 1024 + h * 64 + cgv * 8, w);
          conv_slide<4>(Pb, w, lr0 + 4 * tv, n * 64 + 4 * tv, PC_DV + h * 64 + cgv * 8, edge, [&](int i, const f32x2 (&a)[4]) { const int t = 4 * tv + i;
              *(LAS u32x4*)(L + DN_TVB + t * DN_ROWB + cgv * 16) = pack8(a, BETA[t]); }); }
    }
    PAIR_BAR();
    for (int rpB = 0; rpB < DBG_RB; ++rpB) {
        const int fr = lane & 15, fq = lane >> 4;
#pragma unroll
        for (int tt = 0; tt < 8; ++tt) { const int tile = 2 * tt + role, it = tile >> 2, jt = tile & 3;
            f32x4 acc = (f32x4){0.f, 0.f, 0.f, 0.f};
            if (jt <= it) {
#pragma unroll
                for (int ks = 0; ks < 2; ++ks) { const bf16x8 a = *(const LAS bf16x8*)(L + DN_TK + (16 * jt + fr) * DN_ROWB + (fq * 8 + 32 * ks) * 2);
                    const bf16x8 b = *(const LAS bf16x8*)(L + DN_TQ + (16 * it + fr) * DN_ROWB + (fq * 8 + 32 * ks) * 2); acc = MFMA16(a, b, acc); } }
            const int ii = 16 * it + fr; const float Gi = Gs[ii]; float v[4];
#pragma unroll
            for (int r = 0; r < 4; ++r) { const int jj = 16 * jt + 4 * fq + r; v[r] = (jj <= ii) ? acc[r] * __expf(Gi - Gs[jj]) : 0.f; }
            u32x2 w; w.x = pk2(v[0], v[1]); w.y = pk2(v[2], v[3]);
            *(u32x2*)(AQK + (size_t)chidx * 4096 + ii * 64 + 16 * jt + 4 * fq) = w;
        }
#pragma unroll
        for (int i = 0; i < 4; ++i) { const int idx = lane + 64 * role + 128 * i, t = 16 * (idx >> 7) + (idx & 15), cg = 4 * ((idx >> 6) & 1) + ((idx >> 4) & 3); const u32x4 qv = *(const LAS u32x4*)(L + DN_TQ + t * DN_ROWB + cg * 16); const float eg = EG[t]; u32x4 w;
#pragma unroll
            for (int e = 0; e < 4; ++e) w[e] = pk2(__uint_as_float(qv[e] << 16) * eg, __uint_as_float(qv[e] & 0xffff0000u) * eg);
            *(u32x4*)(QD + (size_t)chidx * 4096 + idx * 8) = w; }
    }
    PAIR_BAR();
    for (int rpB2 = 0; rpB2 < DBG_RB2; ++rpB2) {
        const int fr = lane & 15, fq = lane >> 4; LAS float* Ap = (LAS float*)(L + DN_TQ);
#pragma unroll
        for (int tt = 0; tt < 5; ++tt) { const int q = 2 * tt + role;
            const int it = q < 1 ? 0 : (q < 3 ? 1 : (q < 6 ? 2 : 3)), jt = q - (it * (it + 1)) / 2;
            f32x4 acc = (f32x4){0.f, 0.f, 0.f, 0.f};
#pragma unroll
            for (int ks = 0; ks < 2; ++ks) { const bf16x8 a = *(const LAS bf16x8*)(L + DN_TKB + (16 * it + fr) * DN_ROWB + (fq * 8 + 32 * ks) * 2);
                const bf16x8 b = *(const LAS bf16x8*)(L + DN_TK + (16 * jt + fr) * DN_ROWB + (fq * 8 + 32 * ks) * 2); acc = MFMA16(a, b, acc); }
            const int jj = 16 * jt + fr; const float Gj = Gs[jj];
#pragma unroll
            for (int r = 0; r < 4; ++r) { const int ii = 16 * it + 4 * fq + r;
                if (jj < ((ii + 3) & ~3) && ii > 0) { const int m1 = ii - 1, gf = m1 >> 2, rm = m1 & 3; Ap[4 * (gf + 1) * (2 * gf + rm) + jj] = jj < ii ? acc[r] * __expf(Gs[ii] - Gj) : 0.f; } }
        }
    }
    u32x4 kdt[4];
#pragma unroll
    for (int i = 0; i < 4; ++i) { const int idx = lane + 64 * role + 128 * i, d = idx >> 3, tc = idx & 7; unsigned short kv[8];
#pragma unroll
        for (int e = 0; e < 8; ++e) kv[e] = *(const LAS bf16_t*)(L + DN_TK + (tc * 8 + e) * DN_ROWB + d * 2);
#pragma unroll
        for (int e = 0; e < 4; ++e) kdt[i][e] = pk2(bf2f(kv[2 * e]) * EGL[tc * 8 + 2 * e], bf2f(kv[2 * e + 1]) * EGL[tc * 8 + 2 * e + 1]); }
    PAIR_BAR();
#pragma unroll
    for (int i = 0; i < 4; ++i) { const int idx = lane + 64 * role + 128 * i, d = idx >> 3, tc = idx & 7; *(LAS u32x4*)(L + DN_TK + d * DN_ROWB + tc * 16) = kdt[i]; }
    for (int rpC = 0; rpC < DBG_RC; ++rpC) {
        f32x2 x[32];
#pragma unroll
        for (int i = 0; i < 32; ++i) x[i] = (f32x2){0.f, 0.f};
        LAS unsigned char* const RT = L + DN_TVB - role * (DN_TVB - DN_TKB);
        { f32x4 avA[16], avB[16]; float R0; subst_load<0>((const LAS float*)(L + DN_TQ), RT, Gs + 192 - role * 128, lane, avA, R0);
          Subst2<0>::run(x, (const LAS float*)(L + DN_TQ), RT, Gs + 192 - role * 128, lane, avA, R0, avB); }
        { LAS unsigned char* T = RT + lane * DN_ROWB;
#pragma unroll
          for (int cg = 0; cg < 8; ++cg) { u32x4 w; w.x = pk2(x[cg * 4].x, x[cg * 4].y); w.y = pk2(x[cg * 4 + 1].x, x[cg * 4 + 1].y); w.z = pk2(x[cg * 4 + 2].x, x[cg * 4 + 2].y); w.w = pk2(x[cg * 4 + 3].x, x[cg * 4 + 3].y);
              *(LAS u32x4*)(T + cg * 16) = w; if (role == 0) *((u32x4*)(UT + (size_t)chidx * 4096 + lane * 64) + cg) = w; } }
    }
    PAIR_BAR();
#pragma unroll
    for (int i = 0; i < 4; ++i) { const int idx = lane + 64 * role + 128 * i, t = 16 * (idx >> 7) + (idx & 15), cg = 4 * ((idx >> 6) & 1) + ((idx >> 4) & 3); unsigned short wv[8];
#pragma unroll
        for (int e = 0; e < 8; ++e) wv[e] = *(const LAS bf16_t*)(L + DN_TKB + (cg * 8 + e) * DN_ROWB + t * 2);
        u32x4 w;
#pragma unroll
        for (int e = 0; e < 4; ++e) w[e] = ((unsigned)wv[2 * e] | ((unsigned)wv[2 * e + 1] << 16)) ^ 0x80008000u;
        *(u32x4*)(WN + (size_t)chidx * 4096 + idx * 8) = w; }
    for (int rpD = 0; rpD < DBG_RD; ++rpD) {
        const int fr = lane & 15, fq = lane >> 4; const float glast = EG[63]; u32x2 nw[2];
#pragma unroll
        for (int tt = 0; tt < 8; ++tt) { const int mt = 2 * role + (tt >> 2), nt = tt & 3;
            f32x4 acc = (f32x4){0.f, 0.f, 0.f, 0.f};
#pragma unroll
            for (int ks = 0; ks < 2; ++ks) { const bf16x8 a = *(const LAS bf16x8*)(L + DN_TKB + (16 * mt + fr) * DN_ROWB + (fq * 8 + 32 * ks) * 2);
                const bf16x8 b = *(const LAS bf16x8*)(L + DN_TK + (16 * nt + fr) * DN_ROWB + (fq * 8 + 32 * ks) * 2); acc = MFMA16(a, b, acc); }
            { const int dko = 16 * nt + fr, dki0 = 16 * mt + 4 * fq; u32x2 w;
              w.x = pk2((dko == dki0 ? glast : 0.f) - acc[0], (dko == dki0 + 1 ? glast : 0.f) - acc[1]); w.y = pk2((dko == dki0 + 2 ? glast : 0.f) - acc[2], (dko == dki0 + 3 ? glast : 0.f) - acc[3]);
              *(u32x2*)(MM + (size_t)chidx * 4096 + (((nt * 2 + (mt >> 1)) * 64 + (2 * (mt & 1) + (fq >> 1)) * 16 + fr) * 8 + 4 * (fq & 1))) = w; }
            acc = (f32x4){0.f, 0.f, 0.f, 0.f};
#pragma unroll
            for (int ks = 0; ks < 2; ++ks) { const bf16x8 a = *(const LAS bf16x8*)(L + DN_TK + (16 * mt + fr) * DN_ROWB + (fq * 8 + 32 * ks) * 2);
                const bf16x8 b = *(const LAS bf16x8*)(L + DN_TVB + (16 * nt + fr) * DN_ROWB + (fq * 8 + 32 * ks) * 2); acc = MFMA16(a, b, acc); }
            { nw[nt & 1] = (u32x2){pk2(acc[0], acc[1]), pk2(acc[2], acc[3])};
              if (nt & 1) *(u32x4*)(NT + (size_t)chidx * 4096 + ((mt * 2 + (nt >> 1)) * 64 + lane) * 8) = (u32x4){nw[0].x, nw[0].y, nw[1].x, nw[1].y}; }
        }
    }
    PAIR_BAR();
}
#undef PAIR_BAR
constexpr int SC_ROWB = 144;
constexpr int SC_ST = 0, SC_VT = 64 * SC_ROWB, SC_RS = 2 * 64 * SC_ROWB;
constexpr int SCAN_CUT = 24;
constexpr int SCAN_D = 6;
template <int NS> DI void scan_steps(LAS unsigned char* L, const bf16_t* MM, const bf16_t* NT, bf16_t* SG, size_t& cb, int n0, int rt, int fr, int fq, int aoffs, int coff0, int noff, bool do_store, bf16x8 (&a)[SCAN_D][2], u32x2 (&nc)[SCAN_D][4]) {
    const size_t cstride = (size_t)8 * 4096;
#pragma unroll
    for (int jj = 0; jj < NS; ++jj) { const int j = jj % SCAN_D; const int n = n0 + jj;
        const size_t cbn = cb + cstride;
        LAS unsigned char* SR = L + (jj & 1) * 64 * SC_ROWB; LAS unsigned char* SW = L + ((jj + 1) & 1) * 64 * SC_ROWB;
        u32x2 wst[4];
#pragma unroll
        for (int nt = 0; nt < 4; ++nt) {
            f32x4 acc = (f32x4){__uint_as_float(nc[j][nt].x << 16), __uint_as_float(nc[j][nt].x & 0xffff0000u), __uint_as_float(nc[j][nt].y << 16), __uint_as_float(nc[j][nt].y & 0xffff0000u)};
#pragma unroll
            for (int ks = 0; ks < 2; ++ks) { const bf16x8 sb = *(const LAS bf16x8*)(SR + (16 * nt + fr) * SC_ROWB + (fq * 8 + 32 * ks) * 2); acc = MFMA16(a[j][ks], sb, acc); }
            u32x2 w; w.x = cvt_pk_bf16(acc[0], acc[1]); w.y = cvt_pk_bf16(acc[2], acc[3]);
            *(LAS u32x2*)(SW + (16 * nt + fr) * SC_ROWB + (16 * rt + 4 * fq) * 2) = w;
            wst[nt] = w;
        }
        if (do_store) { *(u32x4*)(SG + cbn + coff0) = (u32x4){wst[0].x, wst[0].y, wst[1].x, wst[1].y}; *(u32x4*)(SG + cbn + coff0 + 512) = (u32x4){wst[2].x, wst[2].y, wst[3].x, wst[3].y}; }
        { const size_t c4 = cb + (size_t)(n + SCAN_D < 127 ? SCAN_D : 0) * cstride;
#pragma unroll
          for (int ks = 0; ks < 2; ++ks) a[j][ks] = *(const bf16x8*)(MM + c4 + aoffs + 512 * ks);
          { const u32x4 n0 = *(const u32x4*)(NT + c4 + noff), n1 = *(const u32x4*)(NT + c4 + noff + 512); nc[j][0] = (u32x2){n0.x, n0.y}; nc[j][1] = (u32x2){n0.z, n0.w}; nc[j][2] = (u32x2){n1.x, n1.y}; nc[j][3] = (u32x2){n1.z, n1.w}; } }
        WG_BAR();
        cb = cbn;
    }
}
DI void dn_scan(const Frame& F, int chain, const bf16_t* MM, const bf16_t* NT, bf16_t* SG, int nb, int ne, bool do_store = true) {
    const int lane = F.lane, wave = F.wave, rt = wave & 3, fr = lane & 15, fq = lane >> 4; const bool worker = wave < 4;
    const int bl = chain >> 3, h = chain & 7;
    LAS unsigned char* L = F.lds;
    if (nb == 0) for (int i = F.tid; i < 64 * SC_ROWB / 4; i += 512) ((LAS unsigned*)L)[i] = 0u;
    const size_t cstride = (size_t)8 * 4096;
    size_t cb = (size_t)((bl * 128 + nb) * 8 + h) * 4096;
    const int aoffs = (rt * 128 + lane) * 8;
    const int coff0 = (rt * 128 + lane) * 8;
    const int noff = (rt * 128 + lane) * 8;
    if (worker && nb == 0) {
#pragma unroll
        for (int q = 0; q < 2; ++q) { unsigned z = 0u; LAUNDER_V(z); *(u32x4*)(SG + cb + coff0 + 512 * q) = (u32x4){z, z, z, z}; } }
    if (worker) {
        bf16x8 a[SCAN_D][2]; u32x2 nc[SCAN_D][4];
#pragma unroll
        for (int j = 0; j < SCAN_D; ++j) { const size_t cj = cb + (size_t)(nb + j < 127 ? j : 0) * cstride;
#pragma unroll
            for (int ks = 0; ks < 2; ++ks) a[j][ks] = *(const bf16x8*)(MM + cj + aoffs + 512 * ks);
            { const u32x4 n0 = *(const u32x4*)(NT + cj + noff), n1 = *(const u32x4*)(NT + cj + noff + 512); nc[j][0] = (u32x2){n0.x, n0.y}; nc[j][1] = (u32x2){n0.z, n0.w}; nc[j][2] = (u32x2){n1.x, n1.y}; nc[j][3] = (u32x2){n1.z, n1.w}; } }
        __syncthreads();
        int n0 = nb;
#pragma unroll 1
        for (; n0 + 12 <= ne; n0 += 12) scan_steps<12>(L, MM, NT, SG, cb, n0, rt, fr, fq, aoffs, coff0, noff, do_store, a, nc);
        if (n0 < ne) scan_steps<(127 - SCAN_CUT) % 12>(L, MM, NT, SG, cb, n0, rt, fr, fq, aoffs, coff0, noff, do_store, a, nc);
    } else {
        __syncthreads();
#pragma unroll 1
        for (int n = nb; n < ne; ++n) WG_BAR();
    }
    __syncthreads();
}

struct OutOps { bf16x8 wn[2], qd[2], aq[2], sb[4][2]; u32x2 uv[4]; unsigned short zv[16]; };
DI void out_load(OutOps& o, int k, int rt, int fr, int fq, const bf16_t* QD, const bf16_t* WN, const bf16_t* UT, const bf16_t* AQK, const bf16_t* SG, const bf16_t* ZB) {
    const size_t cb = (size_t)k * 4096; const int arow = 16 * rt + fr; const int h = k & 7, n = (k >> 3) & 127, bl = k >> 10;
#pragma unroll
    for (int ks = 0; ks < 2; ++ks) { const size_t off = cb + arow * 64 + fq * 8 + 32 * ks;
        o.wn[ks] = *(const bf16x8*)(WN + cb + ((rt * 2 + ks) * 64 + fq * 16 + fr) * 8); o.qd[ks] = *(const bf16x8*)(QD + cb + ((rt * 2 + ks) * 64 + fq * 16 + fr) * 8); o.aq[ks] = *(const bf16x8*)(AQK + off); }
#pragma unroll
    for (int nt = 0; nt < 4; ++nt) { o.uv[nt] = *(const u32x2*)(UT + cb + (16 * nt + fr) * 64 + 16 * rt + 4 * fq);
#pragma unroll
        for (int ks = 0; ks < 2; ++ks) { const bf16_t* sp = SG + cb + ((((2 * ks + (fq >> 1)) * 2 + (nt >> 1)) * 64 + (fq & 1) * 32 + fr) * 8 + (nt & 1) * 4);
            const u32x2 p0 = *(const u32x2*)sp, p1 = *(const u32x2*)(sp + 128); o.sb[nt][ks] = __builtin_bit_cast(bf16x8, (u32x4){p0.x, p0.y, p1.x, p1.y}); } }
    const int lrb = bl * SEQ + n * 64 + 16 * rt + 4 * fq;
#pragma unroll
    for (int r = 0; r < 4; ++r)
#pragma unroll
        for (int nt = 0; nt < 4; ++nt) o.zv[r * 4 + nt] = ZB[(size_t)(lrb + r) * 512 + h * 64 + 16 * nt + fr];
}
DI void dn_out_pass(const Frame& F, const bf16_t* QD, const bf16_t* WN, const bf16_t* UT, const bf16_t* AQK, const bf16_t* SG, const bf16_t* ZB, const float* dng, bf16_t* BR) {
    int lane_ = F.lane; LAUNDER_V(lane_);
    const int lane = lane_, wave = F.wave, rt = wave & 3, half = wave >> 2, fr = lane & 15, fq = lane >> 4;
    LAS unsigned char* L = F.lds;
    float ng[4];
#pragma unroll
    for (int nt = 0; nt < 4; ++nt) ng[nt] = dng[16 * nt + fr];
    int p = F.blk; if (p >= NCH / 2) return;
    OutOps cur, nxt;
    out_load(cur, 2 * p + half, rt, fr, fq, QD, WN, UT, AQK, SG, ZB);
    __syncthreads();
    for (int it = 0; p < NCH / 2; p += F.G, ++it) {
        const int k = 2 * p + half, pn = p + F.G < NCH / 2 ? p + F.G : p;
        out_load(nxt, 2 * pn + half, rt, fr, fq, QD, WN, UT, AQK, SG, ZB);
        const int h = k & 7, n = (k >> 3) & 127, bl = k >> 10;
        LAS unsigned char* VT = L + ((it & 1) * 2 + half) * 64 * SC_ROWB;
        f32x4 vn[4], o[4];
#pragma unroll
        for (int nt = 0; nt < 4; ++nt) { vn[nt] = (f32x4){__uint_as_float(cur.uv[nt].x << 16), __uint_as_float(cur.uv[nt].x & 0xffff0000u), __uint_as_float(cur.uv[nt].y << 16), __uint_as_float(cur.uv[nt].y & 0xffff0000u)};
            o[nt] = (f32x4){0.f, 0.f, 0.f, 0.f};
#pragma unroll
            for (int ks = 0; ks < 2; ++ks) { vn[nt] = MFMA16(cur.wn[ks], cur.sb[nt][ks], vn[nt]); o[nt] = MFMA16(cur.qd[ks], cur.sb[nt][ks], o[nt]); } }
#pragma unroll
        for (int nt = 0; nt < 4; ++nt) { u32x2 w; w.x = cvt_pk_bf16(vn[nt][0], vn[nt][1]); w.y = cvt_pk_bf16(vn[nt][2], vn[nt][3]);
            *(LAS u32x2*)(VT + (16 * nt + fr) * SC_ROWB + (16 * rt + 4 * fq) * 2) = w; }
        WG_BAR();
#pragma unroll
        for (int nt = 0; nt < 4; ++nt)
#pragma unroll
            for (int ks = 0; ks < 2; ++ks) { const bf16x8 vb = *(const LAS bf16x8*)(VT + (16 * nt + fr) * SC_ROWB + (fq * 8 + 32 * ks) * 2); o[nt] = MFMA16(cur.aq[ks], vb, o[nt]); }
        const int lrb = bl * SEQ + n * 64 + 16 * rt + 4 * fq;
#pragma unroll
        for (int r = 0; r < 4; ++r) { float q = (o[0][r] * o[0][r] + o[1][r] * o[1][r]) + (o[2][r] * o[2][r] + o[3][r] * o[3][r]);
            q += __shfl_xor(q, 1); q += __shfl_xor(q, 2); q += __shfl_xor(q, 4); q += __shfl_xor(q, 8);
            const float rs = rsqrtf(q * (1.0f / 64.0f) + RMS_EPS); const size_t lr = (size_t)(lrb + r);
#pragma unroll
            for (int nt = 0; nt < 4; ++nt) { const float z = bf2f(cur.zv[r * 4 + nt]);
                BR[lr * 1024 + 512 + h * 64 + 16 * nt + fr] = (bf16_t)f2bf(o[nt][r] * rs * ng[nt] * (z * fsigmoid(z))); } }
        cur = nxt;
    }
    __syncthreads();
}

constexpr int MG_QS = 0, MG_KBH = 36864, MG_SC = MG_KBH + 64 * 144, MG_SEL = MG_SC + 256 * 33 * 4;
DI void moba_gate_unit(const Frame& F, const bf16_t* Pb, const float* KBAR, unsigned* SELG, unsigned char* LISTG, int* CNTG, int bl, int h, int c) {
    int lane_ = F.lane; LAUNDER_V(lane_);
    const int lane = lane_, wave = F.wave, tid = wave * 64 + lane, fr = lane & 15, fq = lane >> 4;
    LAS unsigned char* L = F.lds; LAS float* SC = (LAS float*)(L + MG_SC); LAS unsigned* SEL = (LAS unsigned*)(L + MG_SEL);
    const int q0 = bl * SEQ + c * 256, bh = bl * 4 + h;
    __syncthreads();
    {
        u32x4 qv4[4]; float kbv[4];
#pragma unroll
        for (int i = 0; i < 4; ++i) { const int q = tid + 512 * i, r = q >> 3, c8 = q & 7; qv4[i] = *(const u32x4*)(Pb + (size_t)(q0 + r) * PLD + PC_MQ + h * 64 + c8 * 8); }
#pragma unroll
        for (int i = 0; i < 4; ++i) { const int idx = tid + 512 * i; kbv[i] = idx < c * 64 ? KBAR[(size_t)bh * 2048 + idx] : 0.f; }
        __builtin_amdgcn_sched_barrier(0);
#pragma unroll
        for (int i = 0; i < 4; ++i) { const int q = tid + 512 * i, r = q >> 3, c8 = q & 7; *(LAS u32x4*)(L + MG_QS + r * 144 + c8 * 16) = qv4[i]; }
#pragma unroll
        for (int i = 0; i < 4; ++i) { const int idx = tid + 512 * i, n = idx >> 6, d = idx & 63; const unsigned hi = f2bf(kbv[i]); const unsigned lo = f2bf(kbv[i] - __uint_as_float(hi << 16));
            *(LAS bf16_t*)(L + MG_KBH + n * 144 + d * 2) = (bf16_t)hi; *(LAS bf16_t*)(L + MG_KBH + (32 + n) * 144 + d * 2) = (bf16_t)lo; } }
    __syncthreads();
    {
#pragma unroll
        for (int qt = 0; qt < 2; ++qt) { const int qrow = wave * 32 + qt * 16; f32x4 acc[4];
#pragma unroll
            for (int nt = 0; nt < 4; ++nt) { acc[nt] = (f32x4){0.f, 0.f, 0.f, 0.f};
#pragma unroll
                for (int ks = 0; ks < 2; ++ks) { const bf16x8 a = *(const LAS bf16x8*)(L + MG_QS + (qrow + fr) * 144 + (fq * 8 + 32 * ks) * 2), b = *(const LAS bf16x8*)(L + MG_KBH + (16 * nt + fr) * 144 + (fq * 8 + 32 * ks) * 2);
                    acc[nt] = MFMA16(a, b, acc[nt]); } }
#pragma unroll
            for (int nt = 0; nt < 2; ++nt)
#pragma unroll
                for (int r = 0; r < 4; ++r) SC[(qrow + 4 * fq + r) * 33 + 16 * nt + fr] = acc[nt][r] + acc[nt + 2][r]; } }
    __syncthreads();
    if (tid < 256) {
        const int qi = tid; float v1 = -INFINITY, v2 = -INFINITY, v3 = -INFINITY; int i1 = -1, i2 = -1, i3 = -1;
        for (int n = 0; n < c; ++n) { const float g = SC[qi * 33 + n];
            if (g > v1) { v3 = v2; i3 = i2; v2 = v1; i2 = i1; v1 = g; i1 = n; } else if (g > v2) { v3 = v2; i3 = i2; v2 = g; i2 = n; } else if (g > v3) { v3 = g; i3 = n; } }
        const unsigned s4 = (unsigned)(i1 & 255) | ((unsigned)(i2 & 255) << 8) | ((unsigned)(i3 & 255) << 16) | 0xff000000u;
        SEL[qi] = s4; SELG[(size_t)(q0 + qi) * 4 + h] = s4;
    }
    __syncthreads();
    for (int n = wave; n < c; n += 8) { int base = 0; unsigned char* lp = LISTG + ((size_t)(bh * 32 + c) * 32 + n) * 256;
#pragma unroll
        for (int ck = 0; ck < 4; ++ck) { const int q = ck * 64 + lane; const unsigned s4 = SEL[q]; const bool f = (s4 & 255u) == (unsigned)n || ((s4 >> 8) & 255u) == (unsigned)n || ((s4 >> 16) & 255u) == (unsigned)n;
            const unsigned long long bal = __ballot(f); const int pos = base + __popcll(bal & ((1ull << lane) - 1ull)); if (f) lp[pos] = (unsigned char)q; base += __popcll(bal); }
        if (lane == 0) CNTG[(bh * 32 + c) * 32 + n] = base; }
}
constexpr int KV_KL = 0, KV_VL = 36864, KV_PRE = KV_VL + 64 * 528;
DI void kv_tile(const LAS unsigned char* KL, const LAS unsigned char* VL, const bf16x8 (&qf)[2], int nsteps, bool causal, int qloc, int fr, int fq, f32x4 (&O)[4], float& m_out, float& l_out) {
    const float sc2 = 0.125f * 1.44269504089f;
    f32x4 s[16];
    const LAS unsigned char* kr0 = KL + (8 * (fr >> 2) + (fr & 3)) * 144 + fq * 16;
#pragma unroll
    for (int s8 = 0; s8 < 8; ++s8)
#pragma unroll
        for (int j = 0; j < 2; ++j) { f32x4 acc = (f32x4){0.f, 0.f, 0.f, 0.f};
#pragma unroll
            for (int ks = 0; ks < 2; ++ks) { const bf16x8 a = *(const LAS bf16x8*)(kr0 + (32 * s8 + 4 * j) * 144 + 64 * ks); acc = MFMA16(a, qf[ks], acc); }
            s[2 * s8 + j] = (s8 < nsteps) ? acc : (f32x4){-INFINITY, -INFINITY, -INFINITY, -INFINITY}; }
    if (causal) {
#pragma unroll
        for (int t = 0; t < 16; ++t)
#pragma unroll
            for (int r = 0; r < 4; ++r) { const int key = 32 * (t >> 1) + 8 * fq + 4 * (t & 1) + r; s[t][r] = key <= qloc ? s[t][r] : -INFINITY; } }
    float m = -INFINITY;
#pragma unroll
    for (int t = 0; t < 16; ++t) m = fmaxf(m, fmaxf(fmaxf(s[t][0], s[t][1]), fmaxf(s[t][2], s[t][3])));
    m = fmaxf(m, __shfl_xor(m, 16)); m = fmaxf(m, __shfl_xor(m, 32));
    const float mb = -m * sc2; float l = 0.f;
#pragma unroll
    for (int t = 0; t < 16; ++t)
#pragma unroll
        for (int r = 0; r < 4; ++r) { const float p = __builtin_amdgcn_exp2f(fmaf(s[t][r], sc2, mb)); s[t][r] = p; l += p; }
    l += __shfl_xor(l, 16); l += __shfl_xor(l, 32);
#pragma unroll
    for (int dt = 0; dt < 4; ++dt) O[dt] = (f32x4){0.f, 0.f, 0.f, 0.f};
    const LAS unsigned char* vr0 = VL + fr * 528 + fq * 16;
#pragma unroll
    for (int s8 = 0; s8 < 8; ++s8) {
        u32x4 pw; pw.x = cvt_pk_bf16(s[2 * s8][0], s[2 * s8][1]); pw.y = cvt_pk_bf16(s[2 * s8][2], s[2 * s8][3]); pw.z = cvt_pk_bf16(s[2 * s8 + 1][0], s[2 * s8 + 1][1]); pw.w = cvt_pk_bf16(s[2 * s8 + 1][2], s[2 * s8 + 1][3]);
        const bf16x8 pb = __builtin_bit_cast(bf16x8, pw);
#pragma unroll
        for (int dt = 0; dt < 4; ++dt) { const bf16x8 a = *(const LAS bf16x8*)(vr0 + (16 * dt) * 528 + 64 * s8); O[dt] = MFMA16(a, pb, O[dt]); } }
    m_out = m; l_out = l;
}
DI void kv_store(bf16_t* OPG, float* MLG, size_t row, int h, int slot, const f32x4 (&O)[4], float m, float l, int fq) {
    const float inv = 1.0f / l; const size_t base = ((row * 4 + h) * 4 + slot);
#pragma unroll
    for (int dp = 0; dp < 2; ++dp) { u32x4 w;
        w.x = cvt_pk_bf16(O[2 * dp][0] * inv, O[2 * dp][1] * inv); w.y = cvt_pk_bf16(O[2 * dp][2] * inv, O[2 * dp][3] * inv); w.z = cvt_pk_bf16(O[2 * dp + 1][0] * inv, O[2 * dp + 1][1] * inv); w.w = cvt_pk_bf16(O[2 * dp + 1][2] * inv, O[2 * dp + 1][3] * inv);
        *(u32x4*)(OPG + base * 64 + 16 * fq + 8 * dp) = w; }
    if (fq == 0) { MLG[base * 2] = m; MLG[base * 2 + 1] = l; }
}
DI void moba_kv_unit(const Frame& F, const bf16_t* Pb, const bf16_t* VT, const unsigned* SELG, const unsigned char* LISTG, const int* CNTG, bf16_t* OPG, float* MLG, int bl, int h, int n, int part, int nparts) {
    int lane_ = F.lane; LAUNDER_V(lane_);
    const int lane = lane_, wave = F.wave, tid = wave * 64 + lane, fr = lane & 15, fq = lane >> 4;
    LAS unsigned char* L = F.lds; LAS int* PRE = (LAS int*)(L + KV_PRE);
    const int bh = bl * 4 + h;
    const bf16_t* Kg = Pb + (size_t)(bl * SEQ + n * 256) * PLD + PC_MK + h * 64;
    const bf16_t* Vg = VT + (size_t)(bh * 64) * SEQ + n * 256;
    const bf16_t* Qg = Pb + (size_t)(bl * SEQ) * PLD + PC_MQ + h * 64;
    __syncthreads();
#pragma unroll
    for (int i = 0; i < 4; ++i) { const int q = tid + 512 * i, r = q >> 3, c8 = q & 7; *(LAS u32x4*)(L + KV_KL + r * 144 + c8 * 16) = *(const u32x4*)(Kg + (size_t)r * PLD + c8 * 8); }
#pragma unroll
    for (int i = 0; i < 4; ++i) { const int q = tid + 512 * i, d = q >> 5, c16 = q & 31; *(LAS u32x4*)(L + KV_VL + d * 528 + c16 * 16) = *(const u32x4*)(Vg + (size_t)d * SEQ + c16 * 8); }
    if (wave == 0) {
        const int cq = lane; int cnt = (cq > n && cq < 32) ? CNTG[(bh * 32 + cq) * 32 + n] : 0; int inc = cnt;
#pragma unroll
        for (int o = 1; o < 32; o <<= 1) { const int up = __shfl_up(inc, o); if (lane >= o) inc += up; }
        if (lane < 32) PRE[lane] = inc - cnt; if (lane == 31) PRE[32] = inc;
    }
    __syncthreads();
    const int T = PRE[32], nsp = (T + 15) >> 4, ntl = nsp + 16;
    for (int tt = part + nparts * wave; tt < ntl; tt += nparts * 8) {
        f32x4 O[4]; float m, l; bf16x8 qf[2];
        if (tt < nsp) {
            const int e = 16 * tt + fr; const bool valid = e < T; const int ee = valid ? e : 0;
            int cq = 0;
#pragma unroll
            for (int i = 1; i < 32; ++i) cq += (PRE[i] <= ee) ? 1 : 0;
            const int q = LISTG[((size_t)(bh * 32 + cq) * 32 + n) * 256 + (ee - PRE[cq])];
            const int tok = cq * 256 + q; const size_t row = (size_t)(bl * SEQ + tok);
#pragma unroll
            for (int ks = 0; ks < 2; ++ks) qf[ks] = *(const bf16x8*)(Qg + (size_t)tok * PLD + fq * 8 + 32 * ks);
            kv_tile(L + KV_KL, L + KV_VL, qf, 8, false, 0, fr, fq, O, m, l);
            const unsigned s4 = SELG[row * 4 + h]; const int slot = (s4 & 255u) == (unsigned)n ? 0 : (((s4 >> 8) & 255u) == (unsigned)n ? 1 : 2);
            if (valid) kv_store(OPG, MLG, row, h, slot, O, m, l, fq);
        } else {
            const int to = tt - nsp, qloc = 16 * to + fr, tok = n * 256 + qloc; const size_t row = (size_t)(bl * SEQ + tok);
#pragma unroll
            for (int ks = 0; ks < 2; ++ks) qf[ks] = *(const bf16x8*)(Qg + (size_t)tok * PLD + fq * 8 + 32 * ks);
            kv_tile(L + KV_KL, L + KV_VL, qf, (16 * to + 15) / 32 + 1, true, qloc, fr, fq, O, m, l);
            kv_store(OPG, MLG, row, h, 3, O, m, l, fq);
        }
    }
}
DI void moba_combine(const Frame& F, const unsigned* SELG, const bf16_t* OPG, const float* MLG, bf16_t* BR) {
    int lane_ = F.lane; LAUNDER_V(lane_);
    const int lane = lane_, sub = lane & 7, gw = F.blk * 8 + F.wave, NGW = F.G * 8;
    const float sc2 = 0.125f * 1.44269504089f;
    for (int it = gw; it < NG * 4 / 8; it += NGW) { const size_t idx = (size_t)it * 8 + (lane >> 3); const size_t row = idx >> 2; const int h = (int)(idx & 3);
        const unsigned s4 = SELG[idx]; float mk[4], lk[4]; float M = -INFINITY;
#pragma unroll
        for (int k = 0; k < 4; ++k) { const bool ok = (k == 3) || (((s4 >> (8 * k)) & 255u) != 255u); const f32x2 ml = *(const f32x2*)(MLG + (idx * 4 + k) * 2); mk[k] = ok ? ml.x : -INFINITY; lk[k] = ok ? ml.y : 0.f; M = fmaxf(M, mk[k]); }
        float o[8]; float den = 0.f;
#pragma unroll
        for (int e = 0; e < 8; ++e) o[e] = 0.f;
#pragma unroll
        for (int k = 0; k < 4; ++k) { const bool ok = (k == 3) || (((s4 >> (8 * k)) & 255u) != 255u); const float w = ok ? lk[k] * __builtin_amdgcn_exp2f((mk[k] - M) * sc2) : 0.f; den += w;
            u32x4 pv = *(const u32x4*)(OPG + (idx * 4 + k) * 64 + sub * 8);
            if (!ok) pv = (u32x4){0u, 0u, 0u, 0u};
#pragma unroll
            for (int e = 0; e < 4; ++e) { o[2 * e] += w * __uint_as_float(pv[e] << 16); o[2 * e + 1] += w * __uint_as_float(pv[e] & 0xffff0000u); } }
        const float inv = 1.0f / den; u32x4 wv;
#pragma unroll
        for (int e = 0; e < 4; ++e) wv[e] = cvt_pk_bf16(o[2 * e] * inv, o[2 * e + 1] * inv);
        { bf16_t* bo = BR + row * 1024 + 256 + h * 64 + 32 * (sub & 1) + 4 * (sub >> 1);
          *(u32x2*)bo = (u32x2){wv.x, wv.y}; *(u32x2*)(bo + 16) = (u32x2){wv.z, wv.w}; } }
}
__host__ __device__ constexpr int kv_parts(int n) { return n == 0 ? 3 : (n < 8 ? 2 : 1); }
__host__ __device__ constexpr int kv_items_before(int n) { int s = 0; for (int i = 0; i < n; ++i) s += kv_parts(i) * GB * 4; return s; }
constexpr int KV_NITEMS = kv_items_before(32);

constexpr int XA_K = 0;
constexpr int XA_VT = 69632;
DI void xattn_wg(const Frame& F, const bf16_t* KVM, const bf16_t* QX, bf16_t* AO, int w) {
    int lane_ = F.lane; LAUNDER_V(lane_);
    const int lane = lane_, wave = F.wave, tid = wave * 64 + lane, fr = lane & 15, fq = lane >> 4;
    const int b = w >> 5, h = (w >> 3) & 3, qpart = w & 7;
    LAS unsigned char* L = F.lds;
    __syncthreads();
#pragma unroll
    for (int i = 0; i < 8; ++i) { const int q = tid + 512 * i, m = q >> 4, c16 = q & 15; *(LAS u32x4*)(L + XA_K + m * 272 + c16 * 16) = *(const u32x4*)(KVM + (size_t)(b * 256 + m) * 1024 + h * 128 + c16 * 8); }
#pragma unroll
    for (int i = 0; i < 8; ++i) { const int q = tid + 512 * i, m = q & 255, c16 = q >> 8; const u32x4 v = *(const u32x4*)(KVM + (size_t)(b * 256 + m) * 1024 + 512 + h * 128 + c16 * 8);
#pragma unroll
        for (int e = 0; e < 4; ++e) { *(LAS bf16_t*)(L + XA_VT + (c16 * 8 + 2 * e) * 528 + m * 2) = (bf16_t)(v[e] & 0xffffu); *(LAS bf16_t*)(L + XA_VT + (c16 * 8 + 2 * e + 1) * 528 + m * 2) = (bf16_t)(v[e] >> 16); } }
    __syncthreads();
    const float sc2 = 0.08838834764831845f * 1.44269504089f;
    for (int rtile = 0; rtile < 8; ++rtile) {
        const size_t tok = (size_t)b * SEQ + qpart * 1024 + wave * 128 + rtile * 16 + fr;
        bf16x8 qf[4];
#pragma unroll
        for (int ks = 0; ks < 4; ++ks) qf[ks] = *(const bf16x8*)(QX + tok * 512 + h * 128 + fq * 8 + 32 * ks);
        f32x4 s[16]; float mx = -INFINITY;
#pragma unroll
        for (int kt = 0; kt < 16; ++kt) { s[kt] = (f32x4){0.f, 0.f, 0.f, 0.f};
#pragma unroll
            for (int ks = 0; ks < 4; ++ks) { const bf16x8 a = *(const LAS bf16x8*)(L + XA_K + (16 * kt + fr) * 272 + (fq * 8 + 32 * ks) * 2); s[kt] = MFMA16(a, qf[ks], s[kt]); }
            mx = fmaxf(mx, fmaxf(fmaxf(s[kt][0], s[kt][1]), fmaxf(s[kt][2], s[kt][3]))); __builtin_amdgcn_sched_barrier(0); }
        mx = fmaxf(mx, __shfl_xor(mx, 16)); mx = fmaxf(mx, __shfl_xor(mx, 32));
        float l = 0.f;
#pragma unroll
        for (int kt = 0; kt < 16; ++kt)
#pragma unroll
            for (int r = 0; r < 4; ++r) { const float p = __builtin_amdgcn_exp2f((s[kt][r] - mx) * sc2); s[kt][r] = p; l += p; }
        l += __shfl_xor(l, 16); l += __shfl_xor(l, 32); const float inv = 1.0f / l;
        f32x4 O[8];
#pragma unroll
        for (int dt = 0; dt < 8; ++dt) O[dt] = (f32x4){0.f, 0.f, 0.f, 0.f};
#pragma unroll
        for (int s8 = 0; s8 < 8; ++s8) {
            u32x4 pw; pw.x = pk2(s[2 * s8][0], s[2 * s8][1]); pw.y = pk2(s[2 * s8][2], s[2 * s8][3]); pw.z = pk2(s[2 * s8 + 1][0], s[2 * s8 + 1][1]); pw.w = pk2(s[2 * s8 + 1][2], s[2 * s8 + 1][3]);
            const bf16x8 pb = __builtin_bit_cast(bf16x8, pw);
#pragma unroll
            for (int dt = 0; dt < 8; ++dt) {
                const u32x2 lo = *(const LAS u32x2*)(L + XA_VT + (16 * dt + fr) * 528 + (32 * s8 + 4 * fq) * 2), hi = *(const LAS u32x2*)(L + XA_VT + (16 * dt + fr) * 528 + (32 * s8 + 16 + 4 * fq) * 2);
                const u32x4 av = (u32x4){lo.x, lo.y, hi.x, hi.y};
                O[dt] = MFMA16(__builtin_bit_cast(bf16x8, av), pb, O[dt]); }
            __builtin_amdgcn_sched_barrier(0);
        }
#pragma unroll
        for (int dt = 0; dt < 8; ++dt) { u32x2 wv; wv.x = pk2(O[dt][0] * inv, O[dt][1] * inv); wv.y = pk2(O[dt][2] * inv, O[dt][3] * inv);
            *(u32x2*)(AO + tok * 512 + h * 128 + 16 * dt + 4 * fq) = wv; }
    }
    __syncthreads();
}
DI void moe_route1(const Frame& F, const bf16_t* x, const float* Wr, const float* ssqp, int* TE, float* TW, float* RR, int* CNT) {
    int lane_ = F.lane; LAUNDER_V(lane_);
    const int lane = lane_, wave = F.wave, tid = wave * 64 + lane;
    constexpr int WP = 2064;
    LAS float* LG = (LAS float*)(F.lds + 16 * WP) + wave * 16 * 17;
    LAS int* HC = (LAS int*)(F.lds + 16 * WP + 8 * 16 * 17 * 4);
    __syncthreads();
    { const int e = tid >> 6, k0 = (tid & 63) * 16; f32x4 w[4];
#pragma unroll
      for (int i = 0; i < 4; ++i) w[i] = *(const f32x4*)(Wr + (size_t)e * 1024 + k0 + 4 * i);
      unsigned hi[8], lo[8];
#pragma unroll
      for (int i = 0; i < 4; ++i)
#pragma unroll
          for (int j = 0; j < 2; ++j) { const float a = w[i][2 * j], b = w[i][2 * j + 1]; const unsigned ha = f2bf(a), hb = f2bf(b);
              hi[2 * i + j] = ha | (hb << 16); lo[2 * i + j] = pk2(a - __uint_as_float(ha << 16), b - __uint_as_float(hb << 16)); }
      *(LAS u32x4*)(F.lds + e * WP + k0 * 2) = (u32x4){hi[0], hi[1], hi[2], hi[3]}; *(LAS u32x4*)(F.lds + e * WP + k0 * 2 + 16) = (u32x4){hi[4], hi[5], hi[6], hi[7]};
      *(LAS u32x4*)(F.lds + (8 + e) * WP + k0 * 2) = (u32x4){lo[0], lo[1], lo[2], lo[3]}; *(LAS u32x4*)(F.lds + (8 + e) * WP + k0 * 2 + 16) = (u32x4){lo[4], lo[5], lo[6], lo[7]}; }
    for (int tb = F.blk; tb < NTOK / 256; tb += F.G) {
        if (tid < 8) HC[tid] = 0;
        __syncthreads();
        for (int tt = 0; tt < 2; ++tt) {
            const int row0 = tb * 256 + wave * 32 + tt * 16; f32x4 acc = (f32x4){0.f, 0.f, 0.f, 0.f};
            const bf16_t* ap = x + (size_t)(row0 + (lane & 15)) * 1024 + (lane >> 4) * 8; const LAS unsigned char* bp = F.lds + (lane & 15) * WP + (lane >> 4) * 16;
            bf16x8 a[32];
#pragma unroll
            for (int ks = 0; ks < 32; ++ks) a[ks] = *(const bf16x8*)(ap + 32 * ks);
            float rs[4];
#pragma unroll
            for (int i = 0; i < 4; ++i) rs[i] = row_rstd(ssqp, row0 + 4 * (lane >> 4) + i);
            __builtin_amdgcn_sched_barrier(0);
#pragma unroll
            for (int ks = 0; ks < 32; ++ks) { const bf16x8 b = *(const LAS bf16x8*)(bp + 64 * ks); acc = MFMA16(a[ks], b, acc); }
#pragma unroll
            for (int i = 0; i < 4; ++i) LG[(4 * (lane >> 4) + i) * 17 + (lane & 15)] = acc[i] * rs[i];
            LDS_WAIT();
            if (lane < 16) { const int row = row0 + lane; float lg[8];
#pragma unroll
                for (int e = 0; e < 8; ++e) lg[e] = LG[lane * 17 + e] + LG[lane * 17 + 8 + e];
                int e0 = 0; float l0 = lg[0];
#pragma unroll
                for (int e = 1; e < 8; ++e) if (lg[e] > l0) { l0 = lg[e]; e0 = e; }
                int e1 = -1; float l1 = -INFINITY;
#pragma unroll
                for (int e = 0; e < 8; ++e) if (e != e0 && lg[e] > l1) { l1 = lg[e]; e1 = e; }
                const float w0 = 1.0f / (1.0f + __expf(l1 - l0));
                TE[2 * (size_t)row] = e0; TE[2 * (size_t)row + 1] = e1; TW[2 * (size_t)row] = w0; TW[2 * (size_t)row + 1] = 1.0f - w0; RR[row] = row_rstd(ssqp, row);
                __hip_atomic_fetch_add(&HC[e0], 1, __ATOMIC_RELAXED, __HIP_MEMORY_SCOPE_WORKGROUP); __hip_atomic_fetch_add(&HC[e1], 1, __ATOMIC_RELAXED, __HIP_MEMORY_SCOPE_WORKGROUP); }
            LDS_WAIT();
        }
        __syncthreads();
        if (tid < 8) CNT[tb * 8 + tid] = HC[tid];
        __syncthreads();
    }
}
DI void moe_bases(const Frame& F, const int* CNT, int tb, LAS int* OUT  ) {
    const int tid = F.tid; LAS int* SC = (LAS int*)(F.lds + 40960);
    __syncthreads();
    { const int e = tid & 7, seg = tid >> 3; int all = 0, lt = 0;
#pragma unroll
      for (int q = 0; q < 4; ++q) { const int w = 4 * seg + q; const int c = CNT[w * 8 + e]; all += c; lt += (w < tb) ? c : 0; }
      SC[seg * 8 + e] = all; SC[512 + seg * 8 + e] = lt; }
    __syncthreads();
    if (tid < 8) { int all = 0, lt = 0; for (int s = 0; s < 64; ++s) { all += SC[s * 8 + tid]; lt += SC[512 + s * 8 + tid]; } SC[1024 + tid] = (all + 255) >> 8; OUT[16 + tid] = lt; }
    __syncthreads();
    if (tid == 0) { int b = 0; for (int e = 0; e < 8; ++e) { OUT[e] = b; b += SC[1024 + e]; } OUT[8] = b; }
    __syncthreads();
}
DI void moe_route2(const Frame& F, const int* TE, const float* RR, const int* CNT, const bf16_t* xb, int* POS, bf16_t* XP, float* RP) {
    const int tid = F.tid, lane = F.lane, wave = F.wave;
    LAS int* MB = (LAS int*)(F.lds + 49152);
    LAS int* WT = (LAS int*)(F.lds + 49152 + 256);
    LAS int* PL = (LAS int*)(F.lds + 49152 + 512);
    for (int tb = F.blk; tb < NTOK / 256; tb += F.G) {
        moe_bases(F, CNT, tb, MB);
        int e0 = -1, e1 = -1; const int tok = tb * 256 + tid;
        if (tid < 256) { e0 = TE[2 * (size_t)tok]; e1 = TE[2 * (size_t)tok + 1]; }
        int pw[2] = {0, 0};
#pragma unroll
        for (int e = 0; e < 8; ++e) { const bool f = (e0 == e) || (e1 == e); const unsigned long long bal = __ballot(f);
            const int before = __popcll(bal & ((1ull << lane) - 1ull)); if (lane == 0 && wave < 4) WT[wave * 8 + e] = __popcll(bal);
            if (e0 == e) pw[0] = before; if (e1 == e) pw[1] = before; }
        __syncthreads();
        if (tid < 256) {
#pragma unroll
            for (int sl = 0; sl < 2; ++sl) { const int e = sl ? e1 : e0; int rank = pw[sl]; for (int w2 = 0; w2 < wave; ++w2) rank += WT[w2 * 8 + e];
                const int pos = MB[e] * 256 + MB[16 + e] + rank; PL[2 * tid + sl] = pos; POS[2 * (size_t)tok + sl] = pos; RP[pos] = RR[tok]; } }
        __syncthreads();
        for (int pr0 = wave * 64; pr0 < wave * 64 + 64; pr0 += 8) { u32x4 ra[8], rb[8];
#pragma unroll
            for (int q = 0; q < 8; ++q) { const int t2 = (pr0 + q) >> 1; const u32x4* src = (const u32x4*)(xb + (size_t)(tb * 256 + t2) * 1024); ra[q] = src[lane]; rb[q] = src[lane + 64]; }
#pragma unroll
            for (int q = 0; q < 8; ++q) { const int pos = PL[pr0 + q]; u32x4* dst = (u32x4*)(XP + (size_t)pos * 1024); dst[lane] = ra[q]; dst[lane + 64] = rb[q]; } }
        __syncthreads();
    }
}
DI void moe_final(const Frame& F, const bf16_t* xb, float* out, const bf16_t* Y, const int* POS, const float* TW, const float* fg) {
    const int lane = F.lane, gw = F.blk * 8 + F.wave, NGW = F.G * 8;
    f32x4 g[4];
#pragma unroll
    for (int c = 0; c < 2; ++c) { g[2 * c] = *(const f32x4*)(fg + 512 * c + 8 * lane); g[2 * c + 1] = *(const f32x4*)(fg + 512 * c + 8 * lane + 4); }
    u32x2 pn = (u32x2){0u, 0u}; f32x2 wn = (f32x2){0.f, 0.f};
    if (gw < NTOK) { pn = *(const u32x2*)(POS + 2 * (size_t)gw); wn = *(const f32x2*)(TW + 2 * (size_t)gw); }
    for (int row = gw; row < NTOK; row += NGW) {
        const int p0 = (int)pn.x, p1 = (int)pn.y; const float w0 = wn.x, w1 = wn.y;
        { const size_t rn = (size_t)(row + NGW < NTOK ? row + NGW : row); pn = *(const u32x2*)(POS + 2 * rn); wn = *(const f32x2*)(TW + 2 * rn); }
        const bf16_t* xs = xb + (size_t)row * 1024 + 8 * lane; const bf16_t* y0 = Y + (size_t)p0 * 1024 + 8 * lane; const bf16_t* y1 = Y + (size_t)p1 * 1024 + 8 * lane;
        u32x4 xv[2], ya[2], yb[2];
#pragma unroll
        for (int c = 0; c < 2; ++c) { xv[c] = *(const u32x4*)(xs + 512 * c); ya[c] = *(const u32x4*)(y0 + 512 * c); yb[c] = *(const u32x4*)(y1 + 512 * c); }
        f32x4 v[4]; float ss = 0.f;
#pragma unroll
        for (int c = 0; c < 2; ++c)
#pragma unroll
            for (int hq = 0; hq < 2; ++hq) { const unsigned xa = xv[c][2 * hq], xc = xv[c][2 * hq + 1], a0 = ya[c][2 * hq], a1 = ya[c][2 * hq + 1], b0 = yb[c][2 * hq], b1 = yb[c][2 * hq + 1]; f32x4 t;
                t.x = __uint_as_float(xa << 16) + w0 * __uint_as_float(a0 << 16) + w1 * __uint_as_float(b0 << 16); t.y = __uint_as_float(xa & 0xffff0000u) + w0 * __uint_as_float(a0 & 0xffff0000u) + w1 * __uint_as_float(b0 & 0xffff0000u);
                t.z = __uint_as_float(xc << 16) + w0 * __uint_as_float(a1 << 16) + w1 * __uint_as_float(b1 << 16); t.w = __uint_as_float(xc & 0xffff0000u) + w0 * __uint_as_float(a1 & 0xffff0000u) + w1 * __uint_as_float(b1 & 0xffff0000u);
                v[2 * c + hq] = t; ss += (t.x * t.x + t.y * t.y) + (t.z * t.z + t.w * t.w); }
        ss = wave_sum(ss); const float r = rsqrtf(ss * (1.0f / 1024.0f) + RMS_EPS);
        float* xr = out + (size_t)row * 1024 + 8 * lane;
#pragma unroll
        for (int c = 0; c < 2; ++c)
#pragma unroll
            for (int hq = 0; hq < 2; ++hq) { const f32x4 t = v[2 * c + hq], gg = g[2 * c + hq]; *(f32x4*)(xr + 512 * c + 4 * hq) = (f32x4){t.x * r * gg.x, t.y * r * gg.y, t.z * r * gg.z, t.w * r * gg.w}; }
    }
}
__global__ void __launch_bounds__(512, 2) mk_fwd(Params prm) {
    extern __shared__ __attribute__((aligned(16))) unsigned char lds_raw[];
    Frame F0;
    F0.lds = (LAS unsigned char*)lds_raw;
    F0.tid = threadIdx.x; F0.lane = F0.tid & 63; F0.wave = __builtin_amdgcn_readfirstlane(F0.tid >> 6); F0.G = gridDim.x; F0.blk = blockIdx.x;
    F0.ws = prm.ws;
    volatile LAS unsigned* MISC = (volatile LAS unsigned*)(F0.lds + LDS_MISC);
    if (F0.tid < 64) MISC[F0.tid] = 0u;
    __syncthreads();
    XcdBarrier bar; bar.bar = (unsigned*)(prm.ws + WS_CTL); bar.x = 0; bar.st = MISC;
#if MK_SINGLE
    bar = xcd_barrier_post((unsigned*)(prm.ws + WS_CTL), MISC);
#endif
    const int lo = prm.ph_lo, hi = prm.ph_hi; int ph = 0;
#ifndef DBG_REP_CLASS
#define DBG_REP_CLASS 0
#endif
#ifndef DBG_RBA
#define DBG_RBA 1
#endif
#ifndef DBG_RCMB
#define DBG_RCMB 1
#endif
#ifndef DBG_ROUT
#define DBG_ROUT 1
#endif
#ifndef DBG_RFIN
#define DBG_RFIN 1
#endif
#define REPEAT(cls) for (int rep_ = 0; rep_ < ((DBG_REP_CLASS == (cls)) ? 2 : 1); ++rep_)
#define REPBAR(cls) do { if (DBG_REP_CLASS == (cls) && rep_ == 0) xcd_barrier(bar); } while (0)
#define ACTIVE() (ph >= lo && ph < hi)
#define SEAM() do { if (ph + 1 < hi) xcd_barrier(bar); } while (0)
    LAS unsigned char* glds = F0.lds;
#define PTRS() unsigned char* ws = prm.ws; asm volatile("" : "+s"(ws)); Frame F = F0; { int w_ = F0.wave; asm volatile("" : "+s"(w_)); int l_ = (int)__builtin_amdgcn_mbcnt_hi(~0u, __builtin_amdgcn_mbcnt_lo(~0u, 0u)); asm volatile("" : "+v"(l_)); F.wave = w_; F.lane = l_; F.tid = w_ * 64 + l_; } F.ws = ws; unsigned char* ar = ws + WS_ARENA; (void)ar; \
    bf16_t* xb = (bf16_t*)(ws + WS_XB); float* ssq = (float*)(ws + WS_SSQ); const float* rope = (const float*)(ws + WS_ROPE); float* xout = prm.out; (void)xb; (void)ssq; (void)rope; (void)xout; \
    unsigned char* lw = ws + WS_LW + (size_t)layer * LW_STRIDE; (void)lw; const float* sm = (const float*)(ws + WS_SMALL); (void)sm
#define GPTRS() PTRS(); const bf16_t* xbg = xb + (size_t)grp * NG * 1024; const float* ssqg = ssq + (size_t)grp * NG * 16; const float* ropeg = rope + (size_t)grp * NG * 16; \
    bf16_t* Pb = (bf16_t*)(ar + AR_P); float* BA = (float*)(ar + AR_BA); bf16_t* const BR0 = (bf16_t*)xout; bf16_t* const GT0 = BR0 + (size_t)NG * 1024; bf16_t* BR = grp == 0 ? BR0 : (bf16_t*)(ar + AR_BR); bf16_t* GT = grp == 0 ? GT0 : Pb; (void)GT; (void)GT0; float* KBAR = (float*)(ar + AR_KBAR); bf16_t* VT = (bf16_t*)(ar + AR_VT); \
    bf16_t* QD = (bf16_t*)(ar + AR_QD); bf16_t* MM = (bf16_t*)(ar + AR_KDT); bf16_t* NT = (bf16_t*)(ar + AR_NT); bf16_t* SG = (bf16_t*)(ar + AR_SG); bf16_t* ZB = (bf16_t*)(ar + AR_ZB); unsigned* SELG = (unsigned*)(ar + AR_SELG); int* CNTG = (int*)(ar + AR_CNTG); unsigned char* LISTG = (unsigned char*)(ar + AR_LISTG); bf16_t* OPG = (bf16_t*)(ar + AR_OPG); float* MLG = (float*)(ar + AR_MLG); bf16_t* WN = (bf16_t*)(ar + AR_WN); bf16_t* UT = (bf16_t*)(ar + AR_UT); bf16_t* AQK = (bf16_t*)(ar + AR_AQK); float* GL = (float*)(ar + AR_GL); \
    bf16_t* MG = (bf16_t*)(ar + AR_MERGED); \
    (void)xbg; (void)ssqg; (void)ropeg; (void)Pb; (void)BA; (void)BR; (void)KBAR; (void)VT; (void)QD; (void)MM; (void)NT; (void)SG; (void)ZB; (void)SELG; (void)CNTG; (void)LISTG; (void)OPG; (void)MLG; (void)WN; (void)UT; (void)AQK; (void)GL; (void)MG
#define MPTRS() PTRS(); int* TE = (int*)(ar + AR_TE); float* TW = (float*)(ar + AR_TW); float* RR = (float*)(ar + AR_RR); int* POS = (int*)(ar + AR_POS); int* CNT = (int*)(ar + AR_CNT); \
    bf16_t* XP = (bf16_t*)(ar + AR_XP); float* RP = (float*)(ar + AR_RP); bf16_t* HM = (bf16_t*)(ar + AR_HM); (void)TE; (void)TW; (void)RR; (void)POS; (void)CNT; (void)XP; (void)RP; (void)HM

    if (ACTIVE()) { REPEAT(1) { const int layer = 0; PTRS();
        const __attribute__((address_space(4))) Params* kp = (const __attribute__((address_space(4))) Params*)__builtin_amdgcn_kernarg_segment_ptr(); asm volatile("" : "+s"(kp));
        Params lp;
#pragma unroll
        for (int i = 0; i < 27; ++i) lp.in[i] = kp->in[i];
        lp.out = nullptr; lp.ws = ws; lp.ph_lo = 0; lp.ph_hi = 0; lp.pad0 = 0; lp.pad1 = 0;
        phase_prologue(F, lp); REPBAR(1); } SEAM(); } ++ph;
    for (int layer = 0; layer < 2; ++layer) {
        for (int grp = 0; grp < NGRP; ++grp) {
            if (ACTIVE()) { REPEAT(3) {
                GPTRS();
                pg8::Gemm g{INPROJ_F8 ? (const bf16_t*)(ws + WS_X8 + (size_t)grp * NG * 1024) : xbg, (const bf16_t*)(lw + LW_WIN), 1024, 1024};
                pg8::SchedPlain S; S.init(NG, 3072, 1024, 1024, 1024, F.G, F.blk, INPROJ_F8 ? 1 : 2);
                pg8::build_rtab(glds, S, ssqg, nullptr, F.tid);
                pg8::EpiScaleBf16 E{Pb, PLD, ssqg, 0, ZB, 512, 10, (const LAS float*)(glds + pg8::RTAB_OFF)};
                pg8::gemm_phase<pg8::EpiScaleBf16, pg8::SchedPlain, INPROJ_F8 != 0>(glds, g, S, E, F.wave);
                for (int rq_ = 0; rq_ < DBG_RBA; ++rq_) ba_tiles(F, xbg, (const bf16_t*)(lw + LW_WBA), ssqg, BA);
                REPBAR(3); }
                SEAM();
            } ++ph;
            if (ACTIVE()) {
                GPTRS();
                REPEAT(4) {
                __syncthreads();
                if (F.tid < 64) ((LAS unsigned*)(F.lds + DN_PCNT))[F.tid] = 0u;
                __syncthreads();
                { unsigned pgen = 0u;
#ifdef DBG_STAGGER
                if (F.wave >= 4) { for (int z_ = 0; z_ < DBG_STAGGER; ++z_) __builtin_amdgcn_s_sleep(127); }
#endif
                for (int u = F.blk; u < 1024; u += F.G)
                    prep_dn(F, Pb, BA, sm + SM_CONVW + (size_t)layer * 4 * 1536, sm + SM_ALOG + layer * 8, sm + SM_DTB + layer * 8, QD, MM, NT, WN, UT, AQK, GL, u, pgen); }
                __syncthreads();
#ifndef DBG_RPOOL
#define DBG_RPOOL 1
#endif
                for (int rpP = 0; rpP < DBG_RPOOL; ++rpP) for (int u = F.blk; u < NG / 128; u += F.G) prep_pool(F, Pb, BR, u);
                REPBAR(4); }
#ifndef DBG_RMOBA
#define DBG_RMOBA 1
#endif
                for (int rpM = 0; rpM < DBG_RMOBA; ++rpM) for (int u = F.blk; u < GB * 64; u += F.G) prep_moba(F, Pb, ropeg, KBAR, VT, u);
                SEAM();
            } ++ph;
            if (ACTIVE()) { REPEAT(18) {
                GPTRS();
                if (F.blk < GB * 8) { if (MK_SINGLE) dn_scan(F, F.blk, MM, NT, SG, 0, SCAN_CUT); }
                else { const int nw = F.G - GB * 8;
                    for (int u = F.blk - GB * 8; u < GB * 4 * 32; u += nw) { const int c = 31 - u / (GB * 4), bh = u % (GB * 4); moba_gate_unit(F, Pb, KBAR, SELG, LISTG, CNTG, bh >> 2, bh & 3, c); } }
                REPBAR(18); }
                SEAM();
            } ++ph;
            if (ACTIVE()) { REPEAT(5) {
                GPTRS();
                if (F.blk < GB * 8) { for (int r2_ = 0; r2_ < ((DBG_REP_CLASS == 16) ? 2 : 1); ++r2_) dn_scan(F, F.blk, MM, NT, SG, MK_SINGLE ? SCAN_CUT : 0, 127, r2_ == 0); }
                else { const int nw = F.G - GB * 8, wq = F.blk - GB * 8;
                    for (int r2_ = 0; r2_ < ((DBG_REP_CLASS == 17) ? 2 : 1); ++r2_)
                    for (int rd = 0; rd * nw < KV_NITEMS; ++rd) { const int i = rd * nw + ((rd & 1) ? nw - 1 - wq : wq); if (i >= KV_NITEMS) continue;
                        int n, part, bh;
                        if (i < 48) { n = 0; part = i >> 4; bh = i & 15; } else if (i < 272) { const int j = i - 48; n = 1 + (j >> 5); part = (j >> 4) & 1; bh = j & 15; } else { const int j = i - 272; n = 8 + (j >> 4); part = 0; bh = j & 15; }
                        moba_kv_unit(F, Pb, VT, SELG, LISTG, CNTG, OPG, MLG, bh >> 2, bh & 3, n, part, n == 0 ? 3 : (n < 8 ? 2 : 1)); } }
                if (layer == 0 && grp == 0) {
                    __syncthreads();
                    pg8::Gemm gk{(const bf16_t*)(ws + WS_MEMN), (const bf16_t*)(ws + WS_LW + LW_WKV), 1024, 1024};
                    pg8::SchedKV Sk; Sk.c = F.blk - GB * 8; Sk.lstride = LW_STRIDE;
                    pg8::EpiScaleBf16 Ek{(bf16_t*)(ws + WS_KVM), 1024, nullptr, 0, nullptr, 0, 1 << 30, nullptr};
                    pg8::gemm_phase(glds, gk, Sk, Ek, F.wave); }
                REPBAR(5); }
                SEAM();
            } ++ph;
            if (ACTIVE()) { REPEAT(6) {
                GPTRS();
                pg8::Gemm g{(const bf16_t*)(ws + WS_X8 + (size_t)grp * NG * 1024), (const bf16_t*)(ws + WS_WG8 + (size_t)layer * 3072 * 1024), 1024, 1024};
                pg8::SchedPlain S; S.init(NG, 3072, 1024, 1024, 1024, F.G, F.blk, 1);
                for (int rq_ = 0; rq_ < DBG_RCMB; ++rq_) moba_combine(F, SELG, OPG, MLG, BR);
                for (int rq_ = 0; rq_ < DBG_ROUT; ++rq_) dn_out_pass(F, QD, WN, UT, AQK, SG, ZB, sm + SM_DNG + layer * 64, BR);
                pg8::build_rtab(glds, S, ssqg, nullptr, F.tid);
                pg8::EpiScaleBf16 E{GT, PLD, ssqg, 1, nullptr, 0, 1 << 30, (const LAS float*)(glds + pg8::RTAB_OFF)};
                pg8::gemm_phase<pg8::EpiScaleBf16, pg8::SchedPlain, true>(glds, g, S, E, F.wave);
                REPBAR(6); }
                SEAM();
            } ++ph;
        }
        if (ACTIVE()) { REPEAT(7) {
            const int grp = 1; GPTRS();
            pg8::Gemm g{BR0, (const bf16_t*)(lw + LW_WCAT), 1024, 1024};
            pg8::SchedPlain S; S.init(NTOK, 1024, 1024, 1024, 1024, F.G, F.blk); S.gapm = NG / 256; S.agap = (size_t)((const char*)BR - (const char*)BR0) - (size_t)(NG / 256) * S.astep;
            pg8::EpiMerge E{GT0, (bf16_t*)(ar + AR_MG2)}; E.gates1 = Pb; E.gapm = NG / 256;
            pg8::gemm_phase(glds, g, S, E, F.wave);
            REPBAR(7); }
            SEAM();
        } ++ph;
        if (ACTIVE()) {
            PTRS();
            pg8::Gemm g{(const bf16_t*)(ar + AR_MG2), (const bf16_t*)(lw + LW_WOUT), 1024, 1024};
            pg8::SchedPlain S; S.init(NTOK, 1024, 1024, 1024, 1024, F.G, F.blk);
            pg8::EpiResid E{xb, ssq, nullptr};
            pg8::gemm_phase(glds, g, S, E, F.wave);
            SEAM();
        } ++ph;
        if (ACTIVE()) { REPEAT(9) {
            PTRS();
            pg8::Gemm g{xb, (const bf16_t*)(lw + LW_WQ), 1024, 1024};
            pg8::SchedPlain S; S.init(NTOK, 512, 1024, 1024, 1024, F.G, F.blk);
            pg8::build_rtab(glds, S, ssq, nullptr, F.tid);
            pg8::EpiScaleBf16 E{(bf16_t*)(ar + AR_QX), 512, ssq, 0, nullptr, 0, 1 << 30, (const LAS float*)(glds + pg8::RTAB_OFF)};
            pg8::gemm_phase(glds, g, S, E, F.wave);
            REPBAR(9); }
                SEAM();
        } ++ph;
        if (ACTIVE()) { REPEAT(10) {
            PTRS();
            for (int w = F.blk; w < 256; w += F.G) xattn_wg(F, (const bf16_t*)(ws + WS_KVM) + (size_t)layer * 2048 * 1024, (const bf16_t*)(ar + AR_QX), (bf16_t*)(ar + AR_AO), w);
            REPBAR(10); }
                SEAM();
        } ++ph;
        if (ACTIVE()) {
            PTRS();
            pg8::Gemm g{(const bf16_t*)(ar + AR_AO), (const bf16_t*)(lw + LW_WO), 512, 512};
            pg8::SchedPlain S; S.init(NTOK, 1024, 512, 512, 512, F.G, F.blk);
            pg8::EpiResid E{xb, ssq, layer == 0 ? ws + WS_X8 : nullptr};
            pg8::gemm_phase(glds, g, S, E, F.wave);
            SEAM();
        } ++ph;
        if (layer == 0) {
            if (ACTIVE()) { REPEAT(11) {
                PTRS();
                pg8::Gemm g{FFN1_F8 ? (const bf16_t*)(ws + WS_X8) : xb, (const bf16_t*)(ws + WS_WGU), 1024, 1024};
                pg8::SchedPlain S; S.init(NTOK, 2 * FF, 1024, 1024, 1024, F.G, F.blk, FFN1_F8 ? 1 : 2);
                pg8::build_rtab(glds, S, ssq, nullptr, F.tid);
                pg8::EpiSwiglu E{(bf16_t*)(ar + AR_HID), FF, (const LAS float*)(glds + pg8::RTAB_OFF)};
                pg8::gemm_phase<pg8::EpiSwiglu, pg8::SchedPlain, FFN1_F8 != 0>(glds, g, S, E, F.wave);
                REPBAR(11); }
                SEAM();
            } ++ph;
            if (ACTIVE()) {
                PTRS();
                pg8::Gemm g{(const bf16_t*)(ar + AR_HID), (const bf16_t*)(ws + WS_WD), FF, FF};
                pg8::SchedPlain S; S.init(NTOK, 1024, FF, FF, FF, F.G, F.blk);
                pg8::EpiResid E{xb, ssq, ws + WS_X8};
                pg8::gemm_phase(glds, g, S, E, F.wave);
                SEAM();
            } ++ph;
        } else {
            if (ACTIVE()) { REPEAT(12) { MPTRS(); moe_route1(F, xb, (const float*)(ws + WS_WR), ssq, TE, TW, RR, CNT); REPBAR(12); } SEAM(); } ++ph;
            if (ACTIVE()) { REPEAT(13) { MPTRS(); moe_route2(F, TE, RR, CNT, xb, POS, XP, RP); REPBAR(13); } SEAM(); } ++ph;
            if (ACTIVE()) { REPEAT(14) {
                MPTRS();
                LAS int* MB = (LAS int*)(F.lds + 49152); moe_bases(F, CNT, 0, MB);
                pg8::SchedMoe S;
#pragma unroll
                for (int e = 0; e < 9; ++e) S.pbase[e] = __builtin_amdgcn_readfirstlane(MB[e]);
                S.nN = 2 * EFF / 256; S.nt = 16; S.G = F.G; S.c = F.blk; S.astep = (size_t)256 * 1024 * 2; S.bstep = (size_t)256 * 1024 * 2; S.estep = (size_t)2 * EFF * 1024 * 2;
                __syncthreads();
                pg8::Gemm g{XP, (const bf16_t*)(ws + WS_WMGU), 1024, 1024};
                pg8::build_rtab(glds, S, nullptr, RP, F.tid);
                pg8::EpiSwiglu E{HM, EFF, (const LAS float*)(glds + pg8::RTAB_OFF)};
                pg8::gemm_phase(glds, g, S, E, F.wave);
                REPBAR(14); }
                SEAM();
            } ++ph;
            if (ACTIVE()) { REPEAT(15) {
                MPTRS();
                LAS int* MB = (LAS int*)(F.lds + 49152); moe_bases(F, CNT, 0, MB);
                pg8::SchedMoe S;
#pragma unroll
                for (int e = 0; e < 9; ++e) S.pbase[e] = __builtin_amdgcn_readfirstlane(MB[e]);
                S.nN = 4; S.nt = EFF / 64; S.G = F.G; S.c = F.blk; S.astep = (size_t)256 * EFF * 2; S.bstep = (size_t)256 * EFF * 2; S.estep = (size_t)1024 * EFF * 2;
                __syncthreads();
                pg8::Gemm g{HM, (const bf16_t*)(ws + WS_WMD), EFF, EFF};
                pg8::EpiScaleBf16 E{XP, 1024, nullptr, 0, nullptr, 0, 1 << 30, nullptr};
                pg8::gemm_phase(glds, g, S, E, F.wave);
                REPBAR(15); }
                SEAM();
            } ++ph;
            if (ACTIVE()) { MPTRS(); for (int rq_ = 0; rq_ < DBG_RFIN; ++rq_) moe_final(F, xb, xout, XP, POS, TW, sm + SM_FING); SEAM(); } ++ph;
        }
    }
#undef ACTIVE
#undef REPEAT
#undef REPBAR
#undef SEAM
#undef PTRS
#undef GPTRS
#undef MPTRS
}

#ifdef DBG_DUMP_OFF
__global__ void dbg_dump(float* out, const unsigned char* ws) {
    const bf16_t* src = (const bf16_t*)(ws + (size_t)DBG_DUMP_OFF);
    for (size_t i = (size_t)blockIdx.x * blockDim.x + threadIdx.x; i < (size_t)NTOK * 1024; i += (size_t)gridDim.x * blockDim.x) { float v = i < (size_t)DBG_DUMP_N ? bf2f(src[i]) : 0.f; if (!(v == v) || v > 1e30f || v < -1e30f) v = 12345.0f; out[i] = v; }
}
#endif
extern "C" void kernel_launch(void* const* d_in, const int* in_sizes, int n_in, void* d_out, int out_size, void* d_ws, size_t ws_size, hipStream_t stream) {
    static int grid = 0;
    if (grid == 0) {
        if (n_in != 27 || in_sizes[0] != NTOK * DM || out_size != NTOK * DM || ws_size < WS_END) {
            fprintf(stderr, "kernel_launch: unexpected problem (n_in %d, in0 %d, out %d, ws %zu < %zu); nothing launched\n", n_in, n_in > 0 ? in_sizes[0] : -1, out_size, ws_size, (size_t)WS_END); grid = -1; return; }
        int dev = 0, cus = 0;
        if (hipGetDevice(&dev) != hipSuccess || hipDeviceGetAttribute(&cus, hipDeviceAttributeMultiprocessorCount, dev) != hipSuccess) { grid = -1; return; }
        if (hipFuncSetAttribute((const void*)mk_fwd, hipFuncAttributeMaxDynamicSharedMemorySize, LDS_BYTES) != hipSuccess) { fprintf(stderr, "kernel_launch: hipFuncSetAttribute failed\n"); grid = -1; return; }
        int per_cu = 0;
        if (hipOccupancyMaxActiveBlocksPerMultiprocessor(&per_cu, (const void*)mk_fwd, 512, LDS_BYTES) != hipSuccess || per_cu < 1) { fprintf(stderr, "kernel_launch: occupancy query says %d\n", per_cu); }
        (void)hipGetLastError();
        grid = cus > 256 ? 256 : cus;
    }
    if (grid < 0) return;
    (void)hipMemsetAsync((char*)d_ws + WS_CTL, 0, CTL_BYTES, stream);
    Params p{};
    for (int i = 0; i < 27; ++i) p.in[i] = (const float*)d_in[i];
    p.out = (float*)d_out; p.ws = (unsigned char*)d_ws; p.pad0 = 0; p.pad1 = 0;
#if MK_SINGLE
    p.ph_lo = 0; p.ph_hi = NPH;
    hipLaunchKernelGGL(mk_fwd, dim3(grid), dim3(512), LDS_BYTES, stream, p);
#else
#ifndef DBG_NPH
#define DBG_NPH NPH
#endif
    for (int k = 0; k < DBG_NPH; ++k) { p.ph_lo = k; p.ph_hi = k + 1; hipLaunchKernelGGL(mk_fwd, dim3(grid), dim3(512), LDS_BYTES, stream, p); }
#ifdef DBG_DUMP_OFF
    hipLaunchKernelGGL(dbg_dump, dim3(2048), dim3(256), 0, stream, (float*)d_out, (const unsigned char*)d_ws);
#endif
#endif
}
```
